# Optimizing an MI355X kernel written in HIP

```python
import math
import jax, jax.numpy as jnp
from jax import lax
import numpy as np

D_MODEL = 1024
BATCH = 8
SEQ = 4096
DEPTH = 2

HEAD_DIM = 64
ROPE_THETA = 500000.0
ROPE_FRAC = 4
QBLK = 128
EPS = 1e-6

DIFF_HEADS = 4
DIFF_DC = HEAD_DIM // 2
DIFF_DV = HEAD_DIM
MLSTM_HEADS = 4
MLSTM_DQK = HEAD_DIM
MLSTM_DV = HEAD_DIM
MLSTM_CHUNK = 64
CONV_W = 4
SB_HEADS = 4
SB_D = HEAD_DIM
DSA_HEADS = 4
DSA_D = HEAD_DIM
IDX_HEADS = 8
IDX_D = 32
DSA_TOPK_MAX = 256
N_BRANCH = 4
BRANCH_W = 4 * HEAD_DIM
D_FF = 2816

IN_COLS = (
    ("diff_q", DIFF_HEADS * 2 * DIFF_DC),
    ("diff_k", DIFF_HEADS * 2 * DIFF_DC),
    ("diff_v", DIFF_HEADS * DIFF_DV),
    ("ml_qk", 2 * MLSTM_HEADS * MLSTM_DQK),
    ("ml_v", MLSTM_HEADS * MLSTM_DV),
    ("ml_i", MLSTM_HEADS),
    ("ml_f", MLSTM_HEADS),
    ("ml_o", MLSTM_HEADS * MLSTM_DV),
    ("sb_q", SB_HEADS * SB_D),
    ("sb_k", SB_HEADS * SB_D),
    ("sb_v", SB_HEADS * SB_D),
    ("dsa_q", DSA_HEADS * DSA_D),
    ("dsa_k", DSA_D),
    ("dsa_v", DSA_D),
    ("idx_q", IDX_HEADS * IDX_D),
    ("idx_k", IDX_D),
    ("idx_w", IDX_HEADS),
    ("gates", N_BRANCH * D_MODEL),
)
N_IN = sum(w for _, w in IN_COLS)

kernel_name = "hybrid_gated_diff_mlstm_stickbreak_dsa"


def rmsnorm(x, g):
    xf = x.astype(jnp.float32)
    y = xf * lax.rsqrt(jnp.mean(xf * xf, axis=-1, keepdims=True) + EPS)
    return (y * g.astype(jnp.float32)).astype(x.dtype)


def rope(x, pos, rot_dim):
    half = rot_dim // 2
    inv = ROPE_THETA ** (-jnp.arange(half, dtype=jnp.float32) / half)
    ang = pos.astype(jnp.float32)[..., None] * inv
    ang = ang.reshape(ang.shape[:2] + (1,) * (x.ndim - 3) + (half,))
    cos, sin = jnp.cos(ang).astype(x.dtype), jnp.sin(ang).astype(x.dtype)
    x1, x2, rest = x[..., :half], x[..., half:rot_dim], x[..., rot_dim:]
    return jnp.concatenate([x1 * cos - x2 * sin, x1 * sin + x2 * cos, rest], axis=-1)


def split_cols(z):
    out, off = {}, 0
    for name, w in IN_COLS:
        out[name] = z[..., off:off + w]
        off += w
    return out


def causal_mask(q0, q1, strict):
    qpos = jnp.arange(q0, q1)[:, None]
    kpos = jnp.arange(q1)[None, :]
    return (kpos < qpos) if strict else (kpos <= qpos)


def sweep(block_fn, seq):
    return jnp.concatenate([block_fn(q0, q0 + QBLK) for q0 in range(0, seq, QBLK)], axis=1)


def swiglu(h, w_gu, w_down):
    g, u = jnp.split(h @ w_gu, 2, axis=-1)
    return (jax.nn.silu(g) * u) @ w_down


def causal_conv(x, w, b):
    y = lax.conv_general_dilated(x, w[:, None, :].astype(x.dtype), window_strides=(1,),
                                 padding=[(CONV_W - 1, 0)],
                                 dimension_numbers=("NWC", "WIO", "NWC"),
                                 feature_group_count=x.shape[-1])
    return y + b


def diff_attention(c, pos, qk_g, lam_p, head_g, layer_idx):
    B, S, _ = c["diff_q"].shape
    q = c["diff_q"].reshape(B, S, DIFF_HEADS, 2, DIFF_DC)
    k = c["diff_k"].reshape(B, S, DIFF_HEADS, 2, DIFF_DC)
    v = c["diff_v"].reshape(B, S, DIFF_HEADS, DIFF_DV)
    q = rope(rmsnorm(q, qk_g[0]), pos, DIFF_DC // ROPE_FRAC)
    k = rope(rmsnorm(k, qk_g[1]), pos, DIFF_DC // ROPE_FRAC)
    lam_init = 0.8 - 0.6 * math.exp(-0.3 * layer_idx)
    lp = lam_p.astype(jnp.float32)
    lam = jnp.exp(jnp.sum(lp[0] * lp[1])) - jnp.exp(jnp.sum(lp[2] * lp[3])) + lam_init
    scale = DIFF_DC ** -0.5

    def block(q0, q1):
        s = jnp.einsum("bqhcd,bkhcd->bhcqk", q[:, q0:q1], k[:, :q1]).astype(jnp.float32) * scale
        p = jax.nn.softmax(jnp.where(causal_mask(q0, q1, False), s, -jnp.inf), axis=-1)
        a = p[:, :, 0] - lam * p[:, :, 1]
        return jnp.einsum("bhqk,bkhd->bqhd", a.astype(v.dtype), v[:, :q1])

    o = rmsnorm(sweep(block, S), head_g) * (1.0 - lam_init)
    return o.reshape(B, S, DIFF_HEADS * DIFF_DV)


def mlstm_chunkwise(q, k, v, ig, lf):
    B, S, H, DK = q.shape
    DV = v.shape[-1]
    L = MLSTM_CHUNK
    NC = S // L

    def chunks(a):
        a = a.reshape((B, NC, L, H) + a.shape[3:])
        return jnp.moveaxis(a, (1, 3), (0, 2))

    tri = jnp.tril(jnp.ones((L, L), dtype=bool))

    def step(carry, inp):
        C, n, m = carry
        qb, kb, vb, ib, fb = inp
        b = jnp.cumsum(fb, axis=-1)
        dl = jnp.where(tri, b[..., :, None] - b[..., None, :] + ib[..., None, :], -jnp.inf)
        inter = b + m[..., None]
        mt = jnp.maximum(inter, jnp.max(dl, axis=-1))
        dw = jnp.exp(dl - mt[..., None])
        iw = jnp.exp(inter - mt)
        s = jnp.einsum("bhtd,bhsd->bhts", qb, kb) * dw
        num = iw[..., None] * jnp.einsum("bhtd,bhde->bhte", qb, C) + jnp.einsum("bhts,bhse->bhte", s, vb)
        den = iw * jnp.einsum("bhtd,bhd->bht", qb, n) + jnp.sum(s, axis=-1)
        h = num / jnp.maximum(jnp.abs(den), jnp.exp(-mt))[..., None]
        bl = b[..., -1]
        g = bl[..., None] - b + ib
        m_new = jnp.maximum(bl + m, jnp.max(g, axis=-1))
        decay = jnp.exp(bl + m - m_new)
        wk = jnp.exp(g - m_new[..., None])
        C = decay[..., None, None] * C + jnp.einsum("bhs,bhsd,bhse->bhde", wk, kb, vb)
        n = decay[..., None] * n + jnp.einsum("bhs,bhsd->bhd", wk, kb)
        return (C, n, m_new), h

    f32 = jnp.float32
    init = (jnp.zeros((B, H, DK, DV), f32), jnp.zeros((B, H, DK), f32), jnp.zeros((B, H), f32))
    _, hs = lax.scan(step, init, (chunks(q.astype(f32)), chunks(k.astype(f32)), chunks(v.astype(f32)),
                                  chunks(ig), chunks(lf)))
    return jnp.moveaxis(hs, (0, 2), (1, 3)).reshape(B, S, H, DV)


def mlstm(c, conv_w, conv_b, gate_b, head_g):
    B, S, _ = c["ml_v"].shape
    qk = jax.nn.silu(causal_conv(c["ml_qk"], conv_w, conv_b))
    q, k = jnp.split(qk, 2, axis=-1)
    q = q.reshape(B, S, MLSTM_HEADS, MLSTM_DQK) * (MLSTM_DQK ** -0.5)
    k = k.reshape(B, S, MLSTM_HEADS, MLSTM_DQK)
    v = c["ml_v"].reshape(B, S, MLSTM_HEADS, MLSTM_DV)
    gb = gate_b.astype(jnp.float32)
    ig = c["ml_i"].astype(jnp.float32) + gb[0]
    lf = jax.nn.log_sigmoid(c["ml_f"].astype(jnp.float32) + gb[1])
    h = mlstm_chunkwise(q, k, v, ig, lf).astype(c["ml_v"].dtype)
    o = jax.nn.sigmoid(c["ml_o"]).reshape(B, S, MLSTM_HEADS, MLSTM_DV)
    return (o * rmsnorm(h, head_g)).reshape(B, S, MLSTM_HEADS * MLSTM_DV)


def stick_breaking(c):
    B, S, _ = c["sb_q"].shape
    q = c["sb_q"].reshape(B, S, SB_HEADS, SB_D)
    k = c["sb_k"].reshape(B, S, SB_HEADS, SB_D)
    v = c["sb_v"].reshape(B, S, SB_HEADS, SB_D)
    scale = SB_D ** -0.5

    def block(q0, q1):
        z = jnp.einsum("bqhd,bkhd->bhqk", q[:, q0:q1], k[:, :q1]).astype(jnp.float32) * scale
        mask = causal_mask(q0, q1, True)
        log_1m = jnp.where(mask, jax.nn.log_sigmoid(-z), 0.0)
        after = lax.cumsum(log_1m, axis=3, reverse=True) - log_1m
        a = jnp.where(mask, jnp.exp(jax.nn.log_sigmoid(z) + after), 0.0)
        return jnp.einsum("bhqk,bkhd->bqhd", a.astype(v.dtype), v[:, :q1])

    return sweep(block, S).reshape(B, S, SB_HEADS * SB_D)


def dsa(c, pos, qk_g):
    B, S, _ = c["dsa_q"].shape
    q = rope(rmsnorm(c["dsa_q"].reshape(B, S, DSA_HEADS, DSA_D), qk_g[0]), pos, DSA_D // ROPE_FRAC)
    k = rope(rmsnorm(c["dsa_k"], qk_g[1]), pos, DSA_D // ROPE_FRAC)
    v = c["dsa_v"]
    qi = rope(c["idx_q"].reshape(B, S, IDX_HEADS, IDX_D), pos, IDX_D // ROPE_FRAC)
    ki = rope(c["idx_k"], pos, IDX_D // ROPE_FRAC)
    wi = c["idx_w"]
    topk = min(DSA_TOPK_MAX, S // 4)
    scale = DSA_D ** -0.5
    gather = jax.vmap(lambda a, i: a[i])

    def block(q0, q1):
        qpos = jnp.arange(q0, q1)
        r = jax.nn.relu(jnp.einsum("bqhd,bkd->bqhk", qi[:, q0:q1], ki[:, :q1]).astype(jnp.float32))
        score = jnp.einsum("bqh,bqhk->bqk", wi[:, q0:q1].astype(jnp.float32), r)
        score = jnp.where(jnp.arange(q1)[None, None, :] <= qpos[None, :, None], score, -jnp.inf)
        _, sel = lax.top_k(score, min(topk, q1))
        valid = sel <= qpos[None, :, None]
        ks, vs = gather(k, sel), gather(v, sel)
        s = jnp.einsum("bqhd,bqnd->bhqn", q[:, q0:q1], ks).astype(jnp.float32) * scale
        p = jax.nn.softmax(jnp.where(valid[:, None], s, -jnp.inf), axis=-1)
        return jnp.einsum("bhqn,bqnd->bqhd", p.astype(v.dtype), vs)

    return sweep(block, S).reshape(B, S, DSA_HEADS * DSA_D)


def setup_inputs(seed: int = 0) -> dict:
    key = jax.random.key(seed)
    ks = jax.random.split(key, 24)
    nrm = lambda k, shape, s: jax.random.normal(k, shape, jnp.float32) * s
    gain = lambda k, shape: 1.0 + 0.01 * jax.random.normal(k, shape, jnp.float32)
    ml_w = 2 * MLSTM_HEADS * MLSTM_DQK
    i_bias = nrm(ks[10], (DEPTH, MLSTM_HEADS), 0.1)
    f_bias = jnp.linspace(3.0, 6.0, MLSTM_HEADS)[None, :] + nrm(ks[11], (DEPTH, MLSTM_HEADS), 0.1)
    positions = (jnp.arange(SEQ, dtype=jnp.int32)[None, :]
                 + jax.random.randint(ks[1], (BATCH, 1), 0, 1024, dtype=jnp.int32))
    return {
        "x": nrm(ks[0], (BATCH, SEQ, D_MODEL), 1.0),
        "positions": positions,
        "ffn1_norm": gain(ks[2], (DEPTH, D_MODEL)),
        "ffn1_w_gu": nrm(ks[3], (DEPTH, D_MODEL, 2 * D_FF), D_MODEL ** -0.5),
        "ffn1_w_down": nrm(ks[4], (DEPTH, D_FF, D_MODEL), D_FF ** -0.5),
        "mix_norm": gain(ks[5], (DEPTH, D_MODEL)),
        "w_in": nrm(ks[6], (DEPTH, D_MODEL, N_IN), D_MODEL ** -0.5),
        "diff_qk_norm": gain(ks[7], (DEPTH, 2, DIFF_DC)),
        "diff_lambda": nrm(ks[8], (DEPTH, 4, DIFF_DC), 0.1),
        "diff_head_norm": gain(ks[9], (DEPTH, DIFF_DV)),
        "ml_conv_w": nrm(ks[12], (DEPTH, CONV_W, ml_w), CONV_W ** -0.5),
        "ml_conv_b": nrm(ks[13], (DEPTH, ml_w), 0.01),
        "ml_gate_bias": jnp.stack([i_bias, f_bias], axis=1),
        "ml_head_norm": gain(ks[14], (DEPTH, MLSTM_DV)),
        "dsa_qk_norm": gain(ks[15], (DEPTH, 2, DSA_D)),
        "w_branch": nrm(ks[16], (DEPTH, N_BRANCH, BRANCH_W, D_MODEL), BRANCH_W ** -0.5),
        "w_out": nrm(ks[17], (DEPTH, D_MODEL, D_MODEL), D_MODEL ** -0.5),
        "ffn2_norm": gain(ks[18], (DEPTH, D_MODEL)),
        "ffn2_w_gu": nrm(ks[19], (DEPTH, D_MODEL, 2 * D_FF), D_MODEL ** -0.5),
        "ffn2_w_down": nrm(ks[20], (DEPTH, D_FF, D_MODEL), D_FF ** -0.5),
    }


def reference(x, positions, ffn1_norm, ffn1_w_gu, ffn1_w_down, mix_norm, w_in, diff_qk_norm,
              diff_lambda, diff_head_norm, ml_conv_w, ml_conv_b, ml_gate_bias, ml_head_norm,
              dsa_qk_norm, w_branch, w_out, ffn2_norm, ffn2_w_gu, ffn2_w_down):
    B, S, _ = x.shape
    for l in range(DEPTH):
        x = x + 0.5 * swiglu(rmsnorm(x, ffn1_norm[l]), ffn1_w_gu[l], ffn1_w_down[l])
        h = rmsnorm(x, mix_norm[l])
        c = split_cols(h @ w_in[l])
        outs = (
            diff_attention(c, positions, diff_qk_norm[l], diff_lambda[l], diff_head_norm[l], l),
            mlstm(c, ml_conv_w[l], ml_conv_b[l], ml_gate_bias[l], ml_head_norm[l]),
            stick_breaking(c),
            dsa(c, positions, dsa_qk_norm[l]),
        )
        gates = jax.nn.sigmoid(c["gates"]).reshape(B, S, N_BRANCH, D_MODEL)
        y = gates[:, :, 0] * (outs[0] @ w_branch[l, 0])
        for bi in range(1, N_BRANCH):
            y = y + gates[:, :, bi] * (outs[bi] @ w_branch[l, bi])
        x = x + y @ w_out[l]
        x = x + 0.5 * swiglu(rmsnorm(x, ffn2_norm[l]), ffn2_w_gu[l], ffn2_w_down[l])
    return x
```

```cpp
#include <hip/hip_runtime.h>
#include <hip/hip_cooperative_groups.h>
#include <cstdio>
#include <cstdint>
namespace cg = cooperative_groups;
namespace pg8 {
#define PG8_LAS __attribute__((address_space(3)))
typedef unsigned short bf16_t;
typedef short bf16x8 __attribute__((ext_vector_type(8)));
typedef float f32x4 __attribute__((ext_vector_type(4)));
typedef unsigned u32x4 __attribute__((ext_vector_type(4)));
constexpr int BM = 256, BK = 64, HALF = 128, HTB = HALF * BK * 2  , STAGE_BYTES = 8 * HTB, NXCD = 8, WGM = 8;

__host__ __device__ __forceinline__ int lds_byte(int r, int c) { const int st = (r >> 4) * 2 + (c >> 5), rr = r & 15, cc = c & 31, ob = rr * 64 + cc * 2; return st * 1024 + (ob ^ (((ob >> 9) & 1) << 5)); }
__host__ __device__ __forceinline__ void stage_rc(int b, int& R, int& C) { const int st = b / 1024, sb = b % 1024, swz = sb ^ (((sb >> 9) & 1) << 5); R = (st >> 1) * 16 + swz / 64; C = (st & 1) * 32 + (swz % 64) / 2; }
__host__ __device__ __forceinline__ int perm32(int rho) { const int n = rho >> 4, i = rho & 15; return 8 * (i >> 2) + 4 * n + (i & 3); }

struct Unit { int pm, pn; };
struct Gemm { const bf16_t* A; const bf16_t* Bt; int M, N, K; };

struct StaticOrder {
    int nM, nN, nwg, G, c;
    __host__ __device__ void init(int M, int N, int G_, int c_) { nM = M / BM; nN = N / BM; nwg = nM * nN; G = G_; c = c_; }
    __host__ __device__ bool next(int i, Unit& u) const {
        const long L = (long)i * G + c; if (L >= nwg) return false;
        int wgid = (int)L; { const int q = nwg / NXCD, r = nwg % NXCD, xcd = wgid % NXCD, off = wgid / NXCD; wgid = (xcd < r ? xcd * (q + 1) : r * (q + 1) + (xcd - r) * q) + off; }
        const int nig = WGM * nN, gid = wgid / nig, fm = gid * WGM, gsz = (nM - fm) < WGM ? (nM - fm) : WGM;
        u.pm = fm + ((wgid % nig) % gsz); u.pn = (wgid % nig) / gsz; return true;
    }
    __device__ __forceinline__ void a_ready(const Unit&) const {}
    __device__ __forceinline__ void done(const Unit&) const {}
};

__device__ __forceinline__ unsigned cvt_pk_bf16(float lo, float hi) { unsigned r; asm volatile("v_cvt_pk_bf16_f32 %0, %1, %2" : "=v"(r) : "v"(lo), "v"(hi)); return r; }
template <class Epi, class Sched, bool ALIGN_EPI = false, bool SP2 = false>
__device__ __forceinline__ void gemm_phase(PG8_LAS unsigned char* lds, const Gemm g, const Sched& S, const Epi& E, const int wave_in) {
    unsigned z_ = 0u; asm volatile("" : "+v"(z_)); int w_ = wave_in; asm volatile("" : "+s"(w_));
    const int tid_ = w_ * 64 + (int)__builtin_amdgcn_mbcnt_hi(~0u, __builtin_amdgcn_mbcnt_lo(~0u, z_));
    const int tid = tid_, wid = __builtin_amdgcn_readfirstlane(tid >> 6), lane = tid & 63, wr = wid >> 2, wc = wid & 3, fr = lane & 15, fq = lane >> 4;
    const int K = g.K, nt = K / BK;
    unsigned voffA[2], voffB[2];
#pragma unroll
    for (int i = 0; i < 2; ++i) { int R, C; stage_rc(tid * 16 + i * 8192, R, C); const int Rb = Epi::PERM ? ((R & ~31) + perm32(R & 31)) : R;
        voffA[i] = (unsigned)(R * K + C) * 2u; voffB[i] = (unsigned)(Rb * K + C) * 2u; }
    const size_t kstep = (size_t)(BK * 2);
    const size_t hstep = (size_t)HALF * K * 2;
    const size_t tstep = 2 * hstep;
    const unsigned ldsw = (unsigned)wid * 1024u;
    const int aoff = lds_byte(wr * 64 + fr, fq * 8), boff = lds_byte(wc * 32 + fr, fq * 8);
#define PG8_SA(b, h) (((b) * 2 + (h)) * HTB)
#define PG8_SB(b, h) ((4 + (b) * 2 + (h)) * HTB)
#define PG8_STAGE(bufoff, gbase, voff) do { _Pragma("unroll") for (int _i = 0; _i < 2; ++_i) \
        __builtin_amdgcn_global_load_lds((const unsigned*)((const char*)(gbase) + (voff)[_i]), (PG8_LAS unsigned*)(lds + (bufoff) + ldsw + _i * 8192), 16, 0, 0); } while (0)
#define PG8_LDA(dst, b, h) do { _Pragma("unroll") for (int m = 0; m < 4; ++m) _Pragma("unroll") for (int k = 0; k < 2; ++k) dst[m][k] = *(const PG8_LAS bf16x8*)(lds + PG8_SA(b, h) + aoff + m * 2048 + k * 1024); } while (0)
#define PG8_LDB(dst, b, h) do { _Pragma("unroll") for (int n = 0; n < 2; ++n) _Pragma("unroll") for (int k = 0; k < 2; ++k) dst[n][k] = *(const PG8_LAS bf16x8*)(lds + PG8_SB(b, h) + boff + n * 2048 + k * 1024); } while (0)
#define PG8_MMA(ai, bj, At, Bt) do { __builtin_amdgcn_s_setprio(1); _Pragma("unroll") for (int m = 0; m < 4; ++m) _Pragma("unroll") for (int n = 0; n < 2; ++n) _Pragma("unroll") for (int k = 0; k < 2; ++k) \
        acc[ai][bj][m][n] = __builtin_amdgcn_mfma_f32_16x16x32_bf16(Bt[n][k], At[m][k], acc[ai][bj][m][n], 0, 0, 0); __builtin_amdgcn_s_setprio(0); } while (0)
#define PG8_WAIT_V(n) asm volatile("s_waitcnt vmcnt(" #n ")" ::: "memory")
#define PG8_WAIT_L(n) asm volatile("s_waitcnt lgkmcnt(" #n ")" ::: "memory")
#define PG8_BAR __builtin_amdgcn_s_barrier()
#define PG8_SCHED __builtin_amdgcn_sched_barrier(0)
    Unit cur, nxt; int ui = 0;
    if (!S.next(0, cur)) return;
    f32x4 acc[2][2][4][2];
#pragma unroll
    for (int a = 0; a < 2; ++a)
#pragma unroll
        for (int b = 0; b < 2; ++b)
#pragma unroll
            for (int m = 0; m < 4; ++m)
#pragma unroll
                for (int n = 0; n < 2; ++n) acc[a][b][m][n] = (f32x4){0.f, 0.f, 0.f, 0.f};
    bf16x8 At[4][2], B0[2][2], B1[2][2];
    const char* cA = (const char*)g.A + (size_t)cur.pm * tstep; const char* cB = (const char*)g.Bt + (size_t)cur.pn * tstep;
    S.a_ready(cur);
    if constexpr (SP2) {
        PG8_STAGE(PG8_SB(0, 0), cB, voffB); PG8_STAGE(PG8_SB(0, 1), cB + hstep, voffB); PG8_STAGE(PG8_SA(0, 0), cA, voffA); PG8_STAGE(PG8_SA(0, 1), cA + hstep, voffA);
        if (wr == 1) PG8_BAR;
        PG8_WAIT_V(2); PG8_BAR;
        PG8_STAGE(PG8_SB(1, 0), cB + kstep, voffB); PG8_STAGE(PG8_SA(1, 0), cA + kstep, voffA); PG8_STAGE(PG8_SB(1, 1), cB + hstep + kstep, voffB);
        PG8_WAIT_V(6); PG8_BAR;
    } else {
        PG8_STAGE(PG8_SB(0, 0), cB, voffB); PG8_STAGE(PG8_SA(0, 0), cA, voffA); PG8_STAGE(PG8_SB(0, 1), cB + hstep, voffB); PG8_STAGE(PG8_SA(0, 1), cA + hstep, voffA);
        if (wr == 1) PG8_BAR;
        PG8_WAIT_V(4); PG8_BAR;
        PG8_STAGE(PG8_SB(1, 0), cB + kstep, voffB); PG8_STAGE(PG8_SA(1, 0), cA + kstep, voffA); PG8_STAGE(PG8_SB(1, 1), cB + hstep + kstep, voffB);
        PG8_WAIT_V(6); PG8_BAR;
    }
    for (;;) {
        const bool has_next = S.next(ui + 1, nxt);
        const char* nA = has_next ? (const char*)g.A + (size_t)nxt.pm * tstep : cA; const char* nB = has_next ? (const char*)g.Bt + (size_t)nxt.pn * tstep : cB;
        for (int t = 0; t < nt; t += 2) {
            const bool last = (t == nt - 2);
            const char* a1 = cA + (size_t)(t + 1) * kstep;
            const char* a2 = last ? nA : cA + (size_t)(t + 2) * kstep; const char* b2 = last ? nB : cB + (size_t)(t + 2) * kstep;
            const char* a3 = a2 + kstep; const char* b3 = b2 + kstep;
            if (last && has_next) S.a_ready(nxt);
            if constexpr (SP2) {
            PG8_LDB(B0, 0, 0); PG8_LDB(B1, 0, 1); PG8_SCHED; PG8_LDA(At, 0, 0); PG8_STAGE(PG8_SA(1, 1), a1 + hstep, voffA);
            PG8_WAIT_V(8); PG8_WAIT_L(0); PG8_BAR; PG8_MMA(0, 0, At, B0); PG8_MMA(0, 1, At, B1); PG8_BAR; PG8_SCHED;
            PG8_LDA(At, 0, 1); PG8_STAGE(PG8_SB(0, 0), b2, voffB); PG8_STAGE(PG8_SB(0, 1), b2 + hstep, voffB); PG8_STAGE(PG8_SA(0, 0), a2, voffA);
            PG8_WAIT_V(8); PG8_WAIT_L(0); PG8_BAR; PG8_MMA(1, 0, At, B0); PG8_MMA(1, 1, At, B1); PG8_BAR; PG8_SCHED;
            PG8_LDB(B0, 1, 0); PG8_LDB(B1, 1, 1); PG8_SCHED; PG8_LDA(At, 1, 0); PG8_STAGE(PG8_SA(0, 1), a2 + hstep, voffA);
            PG8_WAIT_V(8); PG8_WAIT_L(0); PG8_BAR; PG8_MMA(0, 0, At, B0); PG8_MMA(0, 1, At, B1); PG8_BAR; PG8_SCHED;
            PG8_LDA(At, 1, 1); PG8_STAGE(PG8_SB(1, 0), b3, voffB); PG8_STAGE(PG8_SB(1, 1), b3 + hstep, voffB); PG8_STAGE(PG8_SA(1, 0), a3, voffA);
            PG8_WAIT_V(8); PG8_WAIT_L(0); PG8_BAR; PG8_MMA(1, 0, At, B0); PG8_MMA(1, 1, At, B1); PG8_BAR; PG8_SCHED;
            } else {
            PG8_LDB(B0, 0, 0); PG8_SCHED; PG8_LDA(At, 0, 0); PG8_STAGE(PG8_SA(1, 1), a1 + hstep, voffA);
            PG8_WAIT_L(8); PG8_BAR; PG8_WAIT_L(0); PG8_MMA(0, 0, At, B0); PG8_BAR; PG8_SCHED;
            PG8_LDB(B1, 0, 1); PG8_STAGE(PG8_SB(0, 0), b2, voffB);
            PG8_BAR; PG8_WAIT_L(0); PG8_MMA(0, 1, At, B1); PG8_BAR;
            PG8_LDA(At, 0, 1); PG8_STAGE(PG8_SA(0, 0), a2, voffA);
            PG8_BAR; PG8_WAIT_L(0); PG8_MMA(1, 0, At, B0); PG8_BAR; PG8_SCHED;
            PG8_STAGE(PG8_SB(0, 1), b2 + hstep, voffB);
            PG8_WAIT_V(6); PG8_BAR; PG8_MMA(1, 1, At, B1); PG8_BAR;
            PG8_LDB(B0, 1, 0); PG8_SCHED; PG8_LDA(At, 1, 0); PG8_STAGE(PG8_SA(0, 1), a2 + hstep, voffA);
            PG8_WAIT_L(8); PG8_BAR; PG8_WAIT_L(0); PG8_MMA(0, 0, At, B0); PG8_BAR; PG8_SCHED;
            PG8_LDB(B1, 1, 1); PG8_STAGE(PG8_SB(1, 0), b3, voffB);
            PG8_BAR; PG8_WAIT_L(0); PG8_MMA(0, 1, At, B1); PG8_BAR;
            PG8_LDA(At, 1, 1); PG8_STAGE(PG8_SA(1, 0), a3, voffA);
            PG8_BAR; PG8_WAIT_L(0); PG8_MMA(1, 0, At, B0); PG8_BAR; PG8_SCHED;
            PG8_STAGE(PG8_SB(1, 1), b3 + hstep, voffB);
            PG8_WAIT_V(6); PG8_BAR; PG8_MMA(1, 1, At, B1); PG8_BAR;
            }
        }
        if constexpr (ALIGN_EPI) { if (wr == 0) PG8_BAR; }
        if constexpr (!Epi::AFTER_DRAIN) { E(acc, cur, wr, wc, fr, fq); S.done(cur); }
        if (!has_next) break;
#pragma unroll
        for (int a = 0; a < 2; ++a)
#pragma unroll
            for (int b = 0; b < 2; ++b)
#pragma unroll
                for (int m = 0; m < 4; ++m)
#pragma unroll
                    for (int n = 0; n < 2; ++n) acc[a][b][m][n] = (f32x4){0.f, 0.f, 0.f, 0.f};
        cur = nxt; cA = nA; cB = nB; ++ui;
        if constexpr (ALIGN_EPI) { if (wr == 1) PG8_BAR; }
    }
    PG8_WAIT_V(0);
    if constexpr (!ALIGN_EPI) { if (wr == 0) PG8_BAR; }
    PG8_BAR;
    if constexpr (Epi::AFTER_DRAIN) { E.fused(acc, cur, wr, wc, fr, fq, lds, wid, lane); S.done(cur); }
#undef PG8_SA
#undef PG8_SB
#undef PG8_STAGE
#undef PG8_LDA
#undef PG8_LDB
#undef PG8_MMA
#undef PG8_WAIT_V
#undef PG8_WAIT_L
#undef PG8_BAR
#undef PG8_SCHED
}
}
#define LAS __attribute__((address_space(3)))
typedef unsigned short bf16;
typedef float f32x4 __attribute__((ext_vector_type(4)));
typedef float f32x16 __attribute__((ext_vector_type(16)));
typedef unsigned u32x4 __attribute__((ext_vector_type(4)));
typedef unsigned u32x2 __attribute__((ext_vector_type(2)));
typedef short s16x8 __attribute__((ext_vector_type(8)));

constexpr int NB = 8, SEQ = 4096, T = NB * SEQ, D = 1024, FF = 2816, DEPTH = 2, NIN = 7344, ZP = 3072, ZSP = 256;
constexpr int NTHR = 512, NWAVES = 8;
constexpr int LDS_BYTES = 147456;
constexpr float EPS = 1e-6f;

constexpr size_t MiB = (size_t)1 << 20;
constexpr size_t WS_CTL = 0;
constexpr size_t WS_W = 1 * MiB, WL_STRIDE = 52 * MiB;
constexpr size_t WL_GU1 = 0, WL_D1 = 11534336, WL_INA = 17301504, WL_G = 24117248, WL_BR = 32505856, WL_OUT = 34603008, WL_GU2 = 36700160, WL_D2 = 48234496;
constexpr size_t WS_HN = 106 * MiB, WS_BIG = 170 * MiB, WS_ZS = 362 * MiB, WS_O = 394 * MiB, WS_IK = 458 * MiB, WS_END = 460 * MiB;
constexpr size_t OB_STRIDE = (size_t)T * 256 * 2;

struct Params {
    const float* x; const int* pos;
    const float *ffn1_norm, *ffn1_gu, *ffn1_down, *mix_norm, *w_in, *diff_qk_norm, *diff_lambda, *diff_head_norm, *ml_conv_w, *ml_conv_b, *ml_gate_bias, *ml_head_norm,
        *dsa_qk_norm, *w_branch, *w_out, *ffn2_norm, *ffn2_gu, *ffn2_down;
    float* out; unsigned char* ws;
};

__device__ __forceinline__ unsigned f2bf(float f) { unsigned u = __float_as_uint(f); return (u + 0x7fffu + ((u >> 16) & 1u)) >> 16; }
__device__ __forceinline__ unsigned pk2(float lo, float hi) { return f2bf(lo) | (f2bf(hi) << 16); }
__device__ __forceinline__ float bflo(unsigned w) { return __uint_as_float(w << 16); }
__device__ __forceinline__ float bfhi(unsigned w) { return __uint_as_float(w & 0xffff0000u); }
__device__ __forceinline__ float wave_sum(float v) {
#pragma unroll
    for (int o = 1; o < 64; o <<= 1) v += __shfl_xor(v, o);
    return v;
}
__device__ __forceinline__ float wave_max(float v) {
#pragma unroll
    for (int o = 1; o < 64; o <<= 1) v = fmaxf(v, __shfl_xor(v, o));
    return v;
}
__device__ __forceinline__ int lane_fresh() { unsigned z = 0u; asm volatile("" : "+v"(z)); return (int)__builtin_amdgcn_mbcnt_hi(~0u, __builtin_amdgcn_mbcnt_lo(~0u, z)); }
__device__ __forceinline__ int tid_fresh(int wv) { int w = wv; asm volatile("" : "+s"(w)); return w * 64 + lane_fresh(); }
#define LDS_WAIT() asm volatile("s_waitcnt lgkmcnt(0)" ::: "memory")
__device__ __forceinline__ float sigmoidf_(float x) { return 1.f / (1.f + __expf(-x)); }

struct EpiSwiglu {
    static constexpr bool PERM = true, AFTER_DRAIN = false;
    bf16* O;
    __device__ __forceinline__ void operator()(const f32x4 (&acc)[2][2][4][2], const pg8::Unit& u, int wr, int wc, int fr_in, int fq_in) const {
        const int ln_ = lane_fresh(); const int fr = ln_ & 15, fq = ln_ >> 4; (void)fr_in; (void)fq_in;
        const int row0 = u.pm * 256 + wr * 64 + fr, col0 = u.pn * 128 + wc * 32 + 8 * fq;
#pragma unroll
        for (int ai = 0; ai < 2; ++ai)
#pragma unroll
            for (int m = 0; m < 4; ++m) {
                bf16* rowp = O + (size_t)(row0 + ai * 128 + m * 16) * FF + col0;
                float r[8];
#pragma unroll
                for (int n = 0; n < 2; ++n)
#pragma unroll
                    for (int j = 0; j < 4; ++j) { const float g = acc[ai][0][m][n][j], uu = acc[ai][1][m][n][j]; r[4 * n + j] = g * sigmoidf_(g) * uu; }
                u32x4 w; w.x = pk2(r[0], r[1]); w.y = pk2(r[2], r[3]); w.z = pk2(r[4], r[5]); w.w = pk2(r[6], r[7]);
                *(u32x4*)rowp = w;
            }
    }
};
struct EpiResid {
    static constexpr bool PERM = true, AFTER_DRAIN = false;
    const float* base; float* out; float scale;
    __device__ __forceinline__ void operator()(const f32x4 (&acc)[2][2][4][2], const pg8::Unit& u, int wr, int wc, int fr_in, int fq_in) const {
        const int ln_ = lane_fresh(); const int fr = ln_ & 15, fq = ln_ >> 4; (void)fr_in; (void)fq_in;
        const int row0 = u.pm * 256 + wr * 64 + fr, col0 = u.pn * 256 + wc * 32 + 8 * fq;
#pragma unroll
        for (int ai = 0; ai < 2; ++ai)
#pragma unroll
            for (int m = 0; m < 4; ++m) {
                const size_t ro = (size_t)(row0 + ai * 128 + m * 16) * D + col0;
#pragma unroll
                for (int bj = 0; bj < 2; ++bj)
#pragma unroll
                    for (int n = 0; n < 2; ++n) { const f32x4 b = *(const f32x4*)(base + ro + bj * 128 + 4 * n); *(f32x4*)(out + ro + bj * 128 + 4 * n) = b + acc[ai][bj][m][n] * scale; }
            }
    }
};
struct EpiZ {
    static constexpr bool PERM = true, AFTER_DRAIN = false;
    bf16* Z; float* ZS;
    __device__ __forceinline__ void operator()(const f32x4 (&acc)[2][2][4][2], const pg8::Unit& u, int wr, int wc, int fr_in, int fq_in) const {
        const int ln_ = lane_fresh(); const int fr = ln_ & 15, fq = ln_ >> 4; (void)fr_in; (void)fq_in;
        const int row0 = u.pm * 256 + wr * 64 + fr, cw = wc * 32 + 8 * fq;
        if (u.pn < 12) {
#pragma unroll
            for (int ai = 0; ai < 2; ++ai)
#pragma unroll
                for (int m = 0; m < 4; ++m) {
                    bf16* rowp = Z + (size_t)(row0 + ai * 128 + m * 16) * ZP + u.pn * 256 + cw;
#pragma unroll
                    for (int bj = 0; bj < 2; ++bj) { const f32x4 v0 = acc[ai][bj][m][0], v1 = acc[ai][bj][m][1];
                        u32x4 w; w.x = pk2(v0[0], v0[1]); w.y = pk2(v0[2], v0[3]); w.z = pk2(v1[0], v1[1]); w.w = pk2(v1[2], v1[3]);
                        *(u32x4*)(rowp + bj * 128) = w; }
                }
        } else {
#pragma unroll
            for (int ai = 0; ai < 2; ++ai)
#pragma unroll
                for (int m = 0; m < 4; ++m) {
                    float* rowp = ZS + (size_t)(row0 + ai * 128 + m * 16) * ZSP + cw;
#pragma unroll
                    for (int bj = 0; bj < 2; ++bj)
#pragma unroll
                        for (int n = 0; n < 2; ++n) *(f32x4*)(rowp + bj * 128 + 4 * n) = acc[ai][bj][m][n];
                }
        }
    }
};
struct EpiSig {
    static constexpr bool PERM = true, AFTER_DRAIN = false;
    bf16* SG;
    __device__ __forceinline__ void operator()(const f32x4 (&acc)[2][2][4][2], const pg8::Unit& u, int wr, int wc, int fr_in, int fq_in) const {
        const int ln_ = lane_fresh(); const int fr = ln_ & 15, fq = ln_ >> 4; (void)fr_in; (void)fq_in;
        const int row0 = u.pm * 256 + wr * 64 + fr, col0 = u.pn * 256 + wc * 32 + 8 * fq;
#pragma unroll
        for (int ai = 0; ai < 2; ++ai)
#pragma unroll
            for (int m = 0; m < 4; ++m) {
                bf16* rowp = SG + (size_t)(row0 + ai * 128 + m * 16) * D + col0;
#pragma unroll
                for (int bj = 0; bj < 2; ++bj) { const f32x4 v0 = acc[ai][bj][m][0], v1 = acc[ai][bj][m][1];
                    u32x4 w; w.x = pk2(sigmoidf_(v0[0]), sigmoidf_(v0[1])); w.y = pk2(sigmoidf_(v0[2]), sigmoidf_(v0[3]));
                    w.z = pk2(sigmoidf_(v1[0]), sigmoidf_(v1[1])); w.w = pk2(sigmoidf_(v1[2]), sigmoidf_(v1[3]));
                    *(u32x4*)(rowp + bj * 128) = w; }
            }
    }
};
struct EpiGate {
    static constexpr bool PERM = true, AFTER_DRAIN = false;
    const bf16* SG; float* YF; bf16* YB; int mode;
    __device__ __forceinline__ void operator()(const f32x4 (&acc)[2][2][4][2], const pg8::Unit& u, int wr, int wc, int fr_in, int fq_in) const {
        const int ln_ = lane_fresh(); const int fr = ln_ & 15, fq = ln_ >> 4; (void)fr_in; (void)fq_in;
        const int row0 = u.pm * 256 + wr * 64 + fr, col0 = u.pn * 256 + wc * 32 + 8 * fq;
#pragma unroll
        for (int ai = 0; ai < 2; ++ai)
#pragma unroll
            for (int m = 0; m < 4; ++m) {
                const size_t ro = (size_t)(row0 + ai * 128 + m * 16) * D + col0;
#pragma unroll
                for (int bj = 0; bj < 2; ++bj) {
                    const u32x4 sg = *(const u32x4*)(SG + ro + bj * 128);
                    f32x4 g0 = (f32x4){bflo(sg.x), bfhi(sg.x), bflo(sg.y), bfhi(sg.y)}, g1 = (f32x4){bflo(sg.z), bfhi(sg.z), bflo(sg.w), bfhi(sg.w)};
                    f32x4 v0 = g0 * acc[ai][bj][m][0], v1 = g1 * acc[ai][bj][m][1];
                    float* yp = YF + ro + bj * 128;
                    if (mode != 0) { v0 = v0 + *(const f32x4*)yp; v1 = v1 + *(const f32x4*)(yp + 4); }
                    if (mode != 2) { *(f32x4*)yp = v0; *(f32x4*)(yp + 4) = v1; }
                    else { u32x4 w; w.x = pk2(v0[0], v0[1]); w.y = pk2(v0[2], v0[3]); w.z = pk2(v1[0], v1[1]); w.w = pk2(v1[2], v1[3]); *(u32x4*)(YB + ro + bj * 128) = w; }
                }
            }
    }
};

template <class Epi>
__device__ __forceinline__ void run_gemm(LAS unsigned char* lds, const bf16* A, const bf16* Bt, int M, int N, int K, const Epi& E, int wv) {
    pg8::Gemm g{A, Bt, M, N, K}; pg8::StaticOrder S; S.init(M, N, (int)gridDim.x, (int)blockIdx.x);
    pg8::gemm_phase<Epi, pg8::StaticOrder, true, true>((PG8_LAS unsigned char*)lds, g, S, E, wv);
}

__device__ __forceinline__ void tr_item(const float* W, int K, int srcN, int c0, int nv, bf16* WT, int r0, int k0, LAS float* scr, int lane) {
    const int c = lane & 31;
#pragma unroll 8
    for (int i = 0; i < 32; ++i) { const int kk = 2 * i + (lane >> 5); scr[kk * 33 + c] = (c < nv) ? W[(size_t)(k0 + kk) * srcN + c0 + c] : 0.f; }
    LDS_WAIT();
    const int c8 = lane & 7;
#pragma unroll
    for (int j = 0; j < 4; ++j) { const int n = (lane >> 3) + 8 * j; const LAS float* s = scr + (8 * c8) * 33 + n;
        u32x4 o; o.x = pk2(s[0 * 33], s[1 * 33]); o.y = pk2(s[2 * 33], s[3 * 33]); o.z = pk2(s[4 * 33], s[5 * 33]); o.w = pk2(s[6 * 33], s[7 * 33]);
        if (n < nv) *(u32x4*)(WT + (size_t)(r0 + n) * K + k0 + 8 * c8) = o; }
    LDS_WAIT();
}
struct SegRun { int base, gw, ngw, lane; LAS float* scr; };
__device__ __forceinline__ void run_seg(SegRun& R, const float* W, int K, int srcN, int c0, int ncols, bf16* WT, int r0) {
    const int nblk = (ncols + 31) >> 5, nitems = (K >> 6) * nblk;
    int first = (R.gw - (R.base % R.ngw) + R.ngw) % R.ngw;
    for (int it = first; it < nitems; it += R.ngw) { const int kb = it / nblk, nb = it - kb * nblk; const int nv = min(32, ncols - nb * 32);
        tr_item(W, K, srcN, c0 + nb * 32, nv, WT, r0 + nb * 32, kb * 64, R.scr, R.lane); }
    R.base += nitems;
}
__device__ __forceinline__ void convert_weights(const Params& p, int l, SegRun& R) {
    unsigned char* wl = p.ws + WS_W + (size_t)l * WL_STRIDE;
    for (int f = 0; f < 2; ++f) {
        const float* gu = (f ? p.ffn2_gu : p.ffn1_gu) + (size_t)l * D * 2 * FF; bf16* gut = (bf16*)(wl + (f ? WL_GU2 : WL_GU1));
        for (int sg = 0; sg < 44; ++sg) run_seg(R, gu, D, 2 * FF, sg * 128, 128, gut, (sg % 22) * 256 + (sg / 22) * 128);
        const float* dn = (f ? p.ffn2_down : p.ffn1_down) + (size_t)l * FF * D; bf16* dnt = (bf16*)(wl + (f ? WL_D2 : WL_D1));
        run_seg(R, dn, FF, D, 0, D, dnt, 0);
    }
    const float* wi = p.w_in + (size_t)l * D * NIN; bf16* ina = (bf16*)(wl + WL_INA);
    run_seg(R, wi, D, NIN, 0, 768, ina, 0);
    run_seg(R, wi, D, NIN, 768, 512, ina, 768);
    run_seg(R, wi, D, NIN, 1280, 256, ina, 1280);
    run_seg(R, wi, D, NIN, 1544, 256, ina, 1536);
    run_seg(R, wi, D, NIN, 1800, 768, ina, 1792);
    run_seg(R, wi, D, NIN, 2568, 256, ina, 2560);
    run_seg(R, wi, D, NIN, 2952, 256, ina, 2816);
    run_seg(R, wi, D, NIN, 2824, 128, ina, 3072);
    run_seg(R, wi, D, NIN, 3208, 40, ina, 3200);
    run_seg(R, wi, D, NIN, 1536, 8, ina, 3240);
    run_seg(R, wi, D, NIN, 3248, 4096, (bf16*)(wl + WL_G), 0);
    for (int b = 0; b < 4; ++b) run_seg(R, p.w_branch + ((size_t)l * 4 + b) * 256 * D, 256, D, 0, D, (bf16*)(wl + WL_BR) + (size_t)b * D * 256, 0);
    run_seg(R, p.w_out + (size_t)l * D * D, D, D, 0, D, (bf16*)(wl + WL_OUT), 0);
    for (int i = R.gw * 64 + R.lane; i < 80 * 128; i += R.ngw * 64) *((u32x4*)(ina + (size_t)3248 * D) + i) = (u32x4){0u, 0u, 0u, 0u};
}

__device__ __forceinline__ void rms_rows(const float* X, const float* g, bf16* HN, int gw, int ngw, int lane) {
    f32x4 gv[4];
#pragma unroll
    for (int j = 0; j < 4; ++j) gv[j] = ((const f32x4*)g)[lane + 64 * j];
    for (int m = gw; m < T; m += ngw) {
        const f32x4* xr = (const f32x4*)(X + (size_t)m * D) + lane;
        f32x4 v[4]; float s = 0.f;
#pragma unroll
        for (int j = 0; j < 4; ++j) { v[j] = xr[64 * j]; s += (v[j].x * v[j].x + v[j].y * v[j].y) + (v[j].z * v[j].z + v[j].w * v[j].w); }
        const float r = 1.f / sqrtf(wave_sum(s) * (1.f / D) + EPS);
        unsigned long long* o8 = (unsigned long long*)(HN + (size_t)m * D) + lane;
#pragma unroll
        for (int j = 0; j < 4; ++j) { const f32x4 y = v[j] * r * gv[j]; o8[64 * j] = (unsigned long long)pk2(y.x, y.y) | ((unsigned long long)pk2(y.z, y.w) << 32); }
    }
}

__device__ __forceinline__ void sincos_red(float ang, float& sn, float& cs) {
    const float n = rintf(ang * 0.15915494309189535f);
    float r = fmaf(-n, 6.28125f, ang); r = fmaf(-n, 0.0019353071795864769f, r);
    sn = __sinf(r); cs = __cosf(r);
}
template <int HALF>
__device__ __forceinline__ void rope4(float (&v)[4], int sl, float pos) {
    constexpr int LH = HALF / 4;
    float pv[4];
#pragma unroll
    for (int j = 0; j < 4; ++j) pv[j] = __shfl_xor(v[j], LH);
    if (sl < 2 * LH) {
        const bool first = sl < LH; const int i0 = (sl & (LH - 1)) * 4;
#pragma unroll
        for (int j = 0; j < 4; ++j) {
            constexpr float I4[4] = {1.0f, 0.03760603070259094f, 0.0014142135623842478f, 5.318296098266728e-05f};
            constexpr float I8[8] = {1.0f, 0.1939227432012558f, 0.03760603070259094f, 0.007292664609849453f, 0.0014142135623842478f, 0.00027424818836152554f, 5.318296098266728e-05f, 1.0313386155758053e-05f};
            const float inv = (HALF == 4) ? I4[j] : (i0 ? I8[4 + j] : I8[j]);
            float sn, cs; sincos_red(pos * inv, sn, cs);
            v[j] = first ? (v[j] * cs - pv[j] * sn) : (pv[j] * sn + v[j] * cs);
        }
    }
}
__device__ __forceinline__ void prep_phase(const Params& p, int l, int gw, int ngw, int lane) {
    bf16* Z = (bf16*)(p.ws + WS_BIG); float* ZS = (float*)(p.ws + WS_ZS); bf16* IK = (bf16*)(p.ws + WS_IK);
    const float* dg = p.diff_qk_norm + l * 64; const float* sg = p.dsa_qk_norm + l * 128;
    for (int tok = gw; tok < T; tok += ngw) {
        const float pos = (float)p.pos[tok];
#pragma unroll
        for (int which = 0; which < 2; ++which) {
            unsigned long long* ptr = (unsigned long long*)(Z + (size_t)tok * ZP + which * 256) + lane;
            const unsigned long long w = *ptr; float v[4] = {bflo((unsigned)w), bfhi((unsigned)w), bflo((unsigned)(w >> 32)), bfhi((unsigned)(w >> 32))};
            float ss = (v[0] * v[0] + v[1] * v[1]) + (v[2] * v[2] + v[3] * v[3]);
            ss += __shfl_xor(ss, 1); ss += __shfl_xor(ss, 2); ss += __shfl_xor(ss, 4);
            const float r = 1.f / sqrtf(ss * (1.f / 32.f) + EPS);
            const f32x4 g = *(const f32x4*)(dg + which * 32 + (lane & 7) * 4);
#pragma unroll
            for (int j = 0; j < 4; ++j) v[j] = v[j] * r * g[j];
            rope4<4>(v, lane & 7, pos);
            if (which == 0) {
#pragma unroll
                for (int j = 0; j < 4; ++j) v[j] *= 0.17677669529663687f;
            }
            *ptr = (unsigned long long)pk2(v[0], v[1]) | ((unsigned long long)pk2(v[2], v[3]) << 32);
        }
        {
            unsigned long long* ptr = (unsigned long long*)(Z + (size_t)tok * ZP + 2560) + lane;
            const unsigned long long w = *ptr; float v[4] = {bflo((unsigned)w), bfhi((unsigned)w), bflo((unsigned)(w >> 32)), bfhi((unsigned)(w >> 32))};
            float ss = (v[0] * v[0] + v[1] * v[1]) + (v[2] * v[2] + v[3] * v[3]);
            ss += __shfl_xor(ss, 1); ss += __shfl_xor(ss, 2); ss += __shfl_xor(ss, 4); ss += __shfl_xor(ss, 8);
            const float r = 1.f / sqrtf(ss * (1.f / 64.f) + EPS);
            const f32x4 g = *(const f32x4*)(sg + (lane & 15) * 4);
#pragma unroll
            for (int j = 0; j < 4; ++j) v[j] = v[j] * r * g[j];
            rope4<8>(v, lane & 15, pos);
#pragma unroll
            for (int j = 0; j < 4; ++j) v[j] *= 0.125f;
            *ptr = (unsigned long long)pk2(v[0], v[1]) | ((unsigned long long)pk2(v[2], v[3]) << 32);
        }
        {
            unsigned long long* ptr = (unsigned long long*)(Z + (size_t)tok * ZP + 2816) + lane;
            const unsigned long long w = *ptr; float v[4] = {bflo((unsigned)w), bfhi((unsigned)w), bflo((unsigned)(w >> 32)), bfhi((unsigned)(w >> 32))};
            rope4<4>(v, lane & 7, pos);
            *ptr = (unsigned long long)pk2(v[0], v[1]) | ((unsigned long long)pk2(v[2], v[3]) << 32);
        }
        {
            float* ptr = ZS + (size_t)tok * ZSP + (lane & 15) * 4;
            const f32x4 x = *(const f32x4*)ptr; float v[4] = {x[0], x[1], x[2], x[3]};
            float ss = (v[0] * v[0] + v[1] * v[1]) + (v[2] * v[2] + v[3] * v[3]);
            ss += __shfl_xor(ss, 1); ss += __shfl_xor(ss, 2); ss += __shfl_xor(ss, 4); ss += __shfl_xor(ss, 8);
            const float r = 1.f / sqrtf(ss * (1.f / 64.f) + EPS);
            const f32x4 g = *(const f32x4*)(sg + 64 + (lane & 15) * 4);
#pragma unroll
            for (int j = 0; j < 4; ++j) v[j] = v[j] * r * g[j];
            rope4<8>(v, lane & 15, pos);
            if (lane < 16) *(f32x4*)ptr = (f32x4){v[0], v[1], v[2], v[3]};
        }
        {
            const float* ptr = ZS + (size_t)tok * ZSP + 128 + (lane & 7) * 4;
            const f32x4 x = *(const f32x4*)ptr; float v[4] = {x[0], x[1], x[2], x[3]};
            rope4<4>(v, lane & 7, pos);
            if (lane < 8) *((unsigned long long*)(IK + (size_t)tok * 32) + lane) = (unsigned long long)pk2(v[0], v[1]) | ((unsigned long long)pk2(v[2], v[3]) << 32);
        }
    }
}
__device__ __forceinline__ void mlstm_item(const Params& p, int l, int bh, LAS unsigned char* lds, int wv) {
    const int tid = tid_fresh(wv), lane = tid & 63, b = bh >> 2, h = bh & 3;
    const bf16* Z = (const bf16*)(p.ws + WS_BIG); const float* ZS = (const float*)(p.ws + WS_ZS); bf16* O1 = (bf16*)(p.ws + WS_O + OB_STRIDE);
    LAS float* nv = (LAS float*)lds; LAS float* bc = nv + 64; LAS float* igs = bc + 64; LAS float* wks = igs + 64; LAS float* sc = wks + 64;
    LAS float* Qs = sc + 64; LAS float* Ks = Qs + 64 * 65; LAS float* Vs = Ks + 64 * 65; LAS float* Ss = Vs + 64 * 65; LAS float* Cs = Ss + 64 * 65;
    for (int i = tid; i < 64 * 65; i += NTHR) Cs[i] = 0.f;
    if (tid < 64) nv[tid] = 0.f;
    float mcar = 0.f;
    const int r = tid >> 3, sg = tid & 7;
    const int cc0 = sg * 16; const int ch0 = (cc0 < 64) ? (h * 64 + cc0) : (256 + h * 64 + cc0 - 64);
    const float* cw0 = p.ml_conv_w + (size_t)l * 4 * 512; const float* cb0 = p.ml_conv_b + (size_t)l * 512;
    const int zc0 = (cc0 < 64) ? (768 + h * 64 + cc0) : (1024 + h * 64 + cc0 - 64);
    const float gb_i = p.ml_gate_bias[(l * 2 + 0) * 4 + h], gb_f = p.ml_gate_bias[(l * 2 + 1) * 4 + h];
    const float qsc = (cc0 < 64) ? 0.125f : 1.0f;
    __syncthreads();
    for (int c = 0; c < 64; ++c) {
        const int t0 = c * 64; const size_t tok0 = (size_t)b * SEQ + t0;
        const float* cw = cw0; const float* cb = cb0; asm volatile("" : "+s"(cw), "+s"(cb));
        {
            float y[16];
#pragma unroll
            for (int i = 0; i < 16; ++i) y[i] = cb[ch0 + i];
#pragma unroll
            for (int j = 0; j < 4; ++j) {
                const int tt = t0 + r - 3 + j;
                if (tt >= 0) {
                    const u32x4* xp = (const u32x4*)(Z + ((size_t)b * SEQ + tt) * ZP + zc0); const u32x4 x0 = xp[0], x1 = xp[1];
                    const float xv[16] = {bflo(x0.x), bfhi(x0.x), bflo(x0.y), bfhi(x0.y), bflo(x0.z), bfhi(x0.z), bflo(x0.w), bfhi(x0.w),
                                          bflo(x1.x), bfhi(x1.x), bflo(x1.y), bfhi(x1.y), bflo(x1.z), bfhi(x1.z), bflo(x1.w), bfhi(x1.w)};
#pragma unroll
                    for (int i = 0; i < 16; ++i) y[i] = fmaf(cw[j * 512 + ch0 + i], xv[i], y[i]);
                }
            }
            LAS float* dst = (cc0 < 64) ? (Qs + r * 65 + cc0) : (Ks + r * 65 + cc0 - 64);
#pragma unroll
            for (int i = 0; i < 16; ++i) dst[i] = y[i] * sigmoidf_(y[i]) * qsc;
            const u32x4 vv = *(const u32x4*)(Z + (tok0 + r) * ZP + 1280 + h * 64 + sg * 8);
            LAS float* vd = Vs + r * 65 + sg * 8;
            vd[0] = bflo(vv.x); vd[1] = bfhi(vv.x); vd[2] = bflo(vv.y); vd[3] = bfhi(vv.y); vd[4] = bflo(vv.z); vd[5] = bfhi(vv.z); vd[6] = bflo(vv.w); vd[7] = bfhi(vv.w);
        }
        if (tid < 64) {
            const float ig = ZS[(tok0 + tid) * ZSP + 168 + h] + gb_i;
            const float fz = ZS[(tok0 + tid) * ZSP + 172 + h] + gb_f;
            const float lf = fminf(fz, 0.f) - log1pf(__expf(-fabsf(fz)));
            float bsum = lf;
#pragma unroll
            for (int d = 1; d < 64; d <<= 1) { const float n = __shfl_up(bsum, d); if (lane >= d) bsum += n; }
            const float bl = __shfl(bsum, 63);
            const float g = bl - bsum + ig;
            const float mnew = fmaxf(bl + mcar, wave_max(g));
            bc[tid] = bsum; igs[tid] = ig; wks[tid] = __expf(g - mnew);
            if (tid == 0) { sc[0] = mnew; sc[1] = __expf(bl + mcar - mnew); sc[2] = bl; }
        }
        __syncthreads();
        const float bt = bc[r];
        float mx = -INFINITY;
#pragma unroll
        for (int i = 0; i < 8; ++i) { const int s = sg * 8 + i; const float dli = (s <= r) ? (bt - bc[s] + igs[s]) : -INFINITY; mx = fmaxf(mx, dli); }
        mx = fmaxf(mx, __shfl_xor(mx, 1)); mx = fmaxf(mx, __shfl_xor(mx, 2)); mx = fmaxf(mx, __shfl_xor(mx, 4));
        const float inter = bt + mcar; const float mt = fmaxf(inter, mx); const float iw = __expf(inter - mt);
        float ssum = 0.f;
#pragma unroll 1
        for (int i = 0; i < 8; ++i) { const int s = sg * 8 + i; float dot = 0.f;
#pragma unroll 16
            for (int d = 0; d < 64; ++d) dot = fmaf(Qs[r * 65 + d], Ks[s * 65 + d], dot);
            const float dli = (s <= r) ? (bt - bc[s] + igs[s]) : -INFINITY;
            const float sv = dot * __expf(dli - mt); Ss[r * 65 + s] = sv; ssum += sv; }
        ssum += __shfl_xor(ssum, 1); ssum += __shfl_xor(ssum, 2); ssum += __shfl_xor(ssum, 4);
        float qn = 0.f;
#pragma unroll
        for (int d = 0; d < 64; ++d) qn = fmaf(Qs[r * 65 + d], nv[d], qn);
        const float den = iw * qn + ssum;
        __syncthreads();
        {
            float num[8];
#pragma unroll
            for (int i = 0; i < 8; ++i) num[i] = 0.f;
#pragma unroll 8
            for (int d = 0; d < 64; ++d) { const float qd = Qs[r * 65 + d];
#pragma unroll
                for (int i = 0; i < 8; ++i) num[i] = fmaf(qd, Cs[d * 65 + sg * 8 + i], num[i]); }
#pragma unroll
            for (int i = 0; i < 8; ++i) num[i] *= iw;
#pragma unroll 8
            for (int s = 0; s < 64; ++s) { const float sv = Ss[r * 65 + s];
#pragma unroll
                for (int i = 0; i < 8; ++i) num[i] = fmaf(sv, Vs[s * 65 + sg * 8 + i], num[i]); }
            const float dn = 1.f / fmaxf(fabsf(den), __expf(-mt));
            float hs = 0.f;
#pragma unroll
            for (int i = 0; i < 8; ++i) { num[i] *= dn; hs = fmaf(num[i], num[i], hs); }
            hs += __shfl_xor(hs, 1); hs += __shfl_xor(hs, 2); hs += __shfl_xor(hs, 4);
            const float rr = 1.f / sqrtf(hs * (1.f / 64.f) + EPS);
            const u32x4 og = *(const u32x4*)(Z + (tok0 + r) * ZP + 1536 + h * 64 + sg * 8);
            const float ogv[8] = {bflo(og.x), bfhi(og.x), bflo(og.y), bfhi(og.y), bflo(og.z), bfhi(og.z), bflo(og.w), bfhi(og.w)};
            const float* hg = p.ml_head_norm + l * 64 + sg * 8;
            float o[8];
#pragma unroll
            for (int i = 0; i < 8; ++i) o[i] = sigmoidf_(ogv[i]) * (num[i] * rr * hg[i]);
            u32x4 w; w.x = pk2(o[0], o[1]); w.y = pk2(o[2], o[3]); w.z = pk2(o[4], o[5]); w.w = pk2(o[6], o[7]);
            *(u32x4*)(O1 + (tok0 + r) * 256 + h * 64 + sg * 8) = w;
        }
        __syncthreads();
        {
            const float decay = sc[1];
            float cacc[8]; float nacc = 0.f;
#pragma unroll
            for (int i = 0; i < 8; ++i) cacc[i] = 0.f;
#pragma unroll 8
            for (int s = 0; s < 64; ++s) { const float kw = wks[s] * Ks[s * 65 + r]; nacc += kw;
#pragma unroll
                for (int i = 0; i < 8; ++i) cacc[i] = fmaf(kw, Vs[s * 65 + sg * 8 + i], cacc[i]); }
#pragma unroll
            for (int i = 0; i < 8; ++i) Cs[r * 65 + sg * 8 + i] = decay * Cs[r * 65 + sg * 8 + i] + cacc[i];
            if (sg == 0) nv[r] = decay * nv[r] + nacc;
            mcar = sc[0];
        }
        __syncthreads();
    }
}

__device__ __forceinline__ void diff_item(const Params& p, int l, int bh, int qt, LAS unsigned char* lds, int wv) {
    const int tid = tid_fresh(wv), b = bh >> 2, h = bh & 3, q0 = qt * 128;
    const bf16* Z = (const bf16*)(p.ws + WS_BIG); bf16* O0 = (bf16*)(p.ws + WS_O);
    LAS float* Kt = (LAS float*)lds; LAS float* Vt = Kt + 64 * 64;
    const int ql = tid >> 2, part = tid & 3, c = part & 1, dvh = part >> 1, t = q0 + ql; const size_t tok = (size_t)b * SEQ + t;
    const float* lp = p.diff_lambda + l * 128; float s01 = 0.f, s23 = 0.f, gqm = 0.f, gkm = 0.f;
    for (int i = 0; i < 32; ++i) { s01 = fmaf(lp[i], lp[32 + i], s01); s23 = fmaf(lp[64 + i], lp[96 + i], s23);
        gqm = fmaxf(gqm, fabsf(p.diff_qk_norm[l * 64 + i])); gkm = fmaxf(gkm, fabsf(p.diff_qk_norm[l * 64 + 32 + i])); }
    const float lam_init = 0.8f - 0.6f * __expf(-0.3f * (float)l); const float lam = __expf(s01) - __expf(s23) + lam_init;
    const float coff = 5.65685424949238f * gqm * gkm;
    float q[32], o[32];
    { const u32x4* qp = (const u32x4*)(Z + tok * ZP + h * 64 + c * 32);
#pragma unroll
      for (int i = 0; i < 4; ++i) { const u32x4 w = qp[i]; q[8 * i] = bflo(w.x); q[8 * i + 1] = bfhi(w.x); q[8 * i + 2] = bflo(w.y); q[8 * i + 3] = bfhi(w.y); q[8 * i + 4] = bflo(w.z); q[8 * i + 5] = bfhi(w.z); q[8 * i + 6] = bflo(w.w); q[8 * i + 7] = bfhi(w.w); } }
#pragma unroll
    for (int i = 0; i < 32; ++i) o[i] = 0.f;
    float lsum = 0.f;
    const int nkt = (q0 + 128) / 64;
    const int lk = tid >> 3, lsg = tid & 7;
    for (int kt = 0; kt < nkt; ++kt) {
        __syncthreads();
        { const size_t ktok = (size_t)b * SEQ + kt * 64 + lk;
          const bf16* src = Z + ktok * ZP + ((lsg < 4) ? (256 + h * 64 + lsg * 16) : (512 + h * 64 + (lsg - 4) * 16));
          const u32x4 x0 = ((const u32x4*)src)[0], x1 = ((const u32x4*)src)[1];
          LAS float* dst = ((lsg < 4) ? (Kt + lk * 64 + lsg * 16) : (Vt + lk * 64 + (lsg - 4) * 16));
          *(LAS f32x4*)(dst) = (f32x4){bflo(x0.x), bfhi(x0.x), bflo(x0.y), bfhi(x0.y)}; *(LAS f32x4*)(dst + 4) = (f32x4){bflo(x0.z), bfhi(x0.z), bflo(x0.w), bfhi(x0.w)};
          *(LAS f32x4*)(dst + 8) = (f32x4){bflo(x1.x), bfhi(x1.x), bflo(x1.y), bfhi(x1.y)}; *(LAS f32x4*)(dst + 12) = (f32x4){bflo(x1.z), bfhi(x1.z), bflo(x1.w), bfhi(x1.w)}; }
        __syncthreads();
        const int kmax = t - kt * 64 + 1;
        for (int key = 0; key < 64; ++key) {
            const LAS f32x4* kr = (const LAS f32x4*)(Kt + key * 64 + c * 32);
            float s = 0.f;
#pragma unroll
            for (int i = 0; i < 8; ++i) { const f32x4 kv = kr[i]; s = fmaf(q[4 * i], kv[0], s); s = fmaf(q[4 * i + 1], kv[1], s); s = fmaf(q[4 * i + 2], kv[2], s); s = fmaf(q[4 * i + 3], kv[3], s); }
            const float pe = (key < kmax) ? __expf(s - coff) : 0.f;
            lsum += pe;
            const LAS f32x4* vr = (const LAS f32x4*)(Vt + key * 64 + dvh * 32);
#pragma unroll
            for (int i = 0; i < 8; ++i) { const f32x4 vv = vr[i]; o[4 * i] = fmaf(pe, vv[0], o[4 * i]); o[4 * i + 1] = fmaf(pe, vv[1], o[4 * i + 1]); o[4 * i + 2] = fmaf(pe, vv[2], o[4 * i + 2]); o[4 * i + 3] = fmaf(pe, vv[3], o[4 * i + 3]); }
        }
    }
    const float inv = 1.f / lsum; float ss = 0.f;
#pragma unroll
    for (int i = 0; i < 32; ++i) { const float my = o[i] * inv; const float ot = __shfl_xor(my, 1); o[i] = (c == 0) ? (my - lam * ot) : (ot - lam * my); ss = fmaf(o[i], o[i], ss); }
    ss += __shfl_xor(ss, 2);
    const float rr = (1.f - lam_init) / sqrtf(ss * (1.f / 64.f) + EPS);
    if (c == 0) {
        const float* hg = p.diff_head_norm + l * 64 + dvh * 32; u32x4* dst = (u32x4*)(O0 + tok * 256 + h * 64 + dvh * 32);
#pragma unroll
        for (int i = 0; i < 4; ++i) { u32x4 w; w.x = pk2(o[8 * i] * rr * hg[8 * i], o[8 * i + 1] * rr * hg[8 * i + 1]); w.y = pk2(o[8 * i + 2] * rr * hg[8 * i + 2], o[8 * i + 3] * rr * hg[8 * i + 3]);
            w.z = pk2(o[8 * i + 4] * rr * hg[8 * i + 4], o[8 * i + 5] * rr * hg[8 * i + 5]); w.w = pk2(o[8 * i + 6] * rr * hg[8 * i + 6], o[8 * i + 7] * rr * hg[8 * i + 7]); dst[i] = w; }
    }
    __syncthreads();
}

__device__ __forceinline__ void sb_item(const Params& p, int bh, int g, LAS unsigned char* lds, int wv) {
    const int tid = tid_fresh(wv), lane = tid & 63, w = tid >> 6, b = bh >> 2, h = bh & 3;
    const bf16* Z = (const bf16*)(p.ws + WS_BIG); bf16* O2 = (bf16*)(p.ws + WS_O + 2 * OB_STRIDE);
    LAS float* KV = (LAS float*)lds + w * 4096;
    const int t0 = g * 512 + w * 64, t = t0 + lane; const size_t tok = (size_t)b * SEQ + t;
    float q[64], o[64];
    { const u32x4* qp = (const u32x4*)(Z + tok * ZP + 1792 + h * 64);
#pragma unroll
      for (int i = 0; i < 8; ++i) { const u32x4 x = qp[i]; q[8 * i] = bflo(x.x); q[8 * i + 1] = bfhi(x.x); q[8 * i + 2] = bflo(x.y); q[8 * i + 3] = bfhi(x.y); q[8 * i + 4] = bflo(x.z); q[8 * i + 5] = bfhi(x.z); q[8 * i + 6] = bflo(x.w); q[8 * i + 7] = bfhi(x.w); } }
#pragma unroll
    for (int i = 0; i < 64; ++i) o[i] = 0.f;
    float R = 0.f;
    const int lkey = lane >> 1, lhalf = lane & 1;
    for (int slo = t0 + 32; slo >= 0; slo -= 32) {
        asm volatile("s_waitcnt lgkmcnt(0)" ::: "memory");
        { const size_t ktok = (size_t)b * SEQ + slo + lkey;
          const u32x4* ks = (const u32x4*)(Z + ktok * ZP + 2048 + h * 64 + lhalf * 32); const u32x4* vs = (const u32x4*)(Z + ktok * ZP + 2304 + h * 64 + lhalf * 32);
          LAS float* kd = KV + lkey * 128 + lhalf * 32; LAS float* vd = kd + 64;
#pragma unroll
          for (int i = 0; i < 4; ++i) { const u32x4 x = ks[i]; *(LAS f32x4*)(kd + 8 * i) = (f32x4){bflo(x.x), bfhi(x.x), bflo(x.y), bfhi(x.y)}; *(LAS f32x4*)(kd + 8 * i + 4) = (f32x4){bflo(x.z), bfhi(x.z), bflo(x.w), bfhi(x.w)}; }
#pragma unroll
          for (int i = 0; i < 4; ++i) { const u32x4 x = vs[i]; *(LAS f32x4*)(vd + 8 * i) = (f32x4){bflo(x.x), bfhi(x.x), bflo(x.y), bfhi(x.y)}; *(LAS f32x4*)(vd + 8 * i + 4) = (f32x4){bflo(x.z), bfhi(x.z), bflo(x.w), bfhi(x.w)}; } }
        asm volatile("s_waitcnt lgkmcnt(0)" ::: "memory");
        for (int kk = 31; kk >= 0; --kk) {
            const int s = slo + kk; const bool act = s < t;
            const LAS f32x4* kr = (const LAS f32x4*)(KV + kk * 128);
            float z = 0.f;
#pragma unroll
            for (int i = 0; i < 16; ++i) { const f32x4 kv = kr[i]; z = fmaf(q[4 * i], kv[0], z); z = fmaf(q[4 * i + 1], kv[1], z); z = fmaf(q[4 * i + 2], kv[2], z); z = fmaf(q[4 * i + 3], kv[3], z); }
            z *= 0.125f;
            const float lb = fminf(z, 0.f) - __logf(1.f + __expf(-fabsf(z)));
            const float a = act ? __expf(lb + R) : 0.f;
            R += act ? (lb - z) : 0.f;
#pragma unroll
            for (int i = 0; i < 16; ++i) { const f32x4 vv = kr[16 + i]; o[4 * i] = fmaf(a, vv[0], o[4 * i]); o[4 * i + 1] = fmaf(a, vv[1], o[4 * i + 1]); o[4 * i + 2] = fmaf(a, vv[2], o[4 * i + 2]); o[4 * i + 3] = fmaf(a, vv[3], o[4 * i + 3]); }
        }
        if (__all(R < -104.f)) break;
    }
    u32x4* dst = (u32x4*)(O2 + tok * 256 + h * 64);
#pragma unroll
    for (int i = 0; i < 8; ++i) { u32x4 x; x.x = pk2(o[8 * i], o[8 * i + 1]); x.y = pk2(o[8 * i + 2], o[8 * i + 3]); x.z = pk2(o[8 * i + 4], o[8 * i + 5]); x.w = pk2(o[8 * i + 6], o[8 * i + 7]); dst[i] = x; }
    asm volatile("s_waitcnt lgkmcnt(0)" ::: "memory");
}
__device__ __forceinline__ unsigned mono_bits(float s) { s = (s == 0.f) ? 0.f : s; const unsigned u = __float_as_uint(s); return (u & 0x80000000u) ? ~u : (u | 0x80000000u); }
__device__ __forceinline__ void dsa_item(const Params& p, int b, int qt, LAS unsigned char* lds, int wv) {
    const int tid = tid_fresh(wv), lane = tid & 63, w = tid >> 6, half = lane >> 5, r32 = lane & 31;
    const bf16* Z = (const bf16*)(p.ws + WS_BIG); const float* ZS = (const float*)(p.ws + WS_ZS); const bf16* IK = (const bf16*)(p.ws + WS_IK); bf16* O3 = (bf16*)(p.ws + WS_O + 3 * OB_STRIDE);
    LAS unsigned* hist = (LAS unsigned*)lds + w * 1024;
    LAS int* list = (LAS int*)(lds + 32768) + w * 1024;
    LAS float* qs = (LAS float*)(lds + 65536) + w * 256;
    LAS float* P = (LAS float*)(lds + 98304) + w * 1024;
    const size_t tokb = (size_t)b * SEQ; const int tb = qt * 32 + 4 * w;
    const int ntiles = ((tb + 3) >> 5) + 1;
    s16x8 aq0, aq1;
    { const bf16* ap = Z + (tokb + tb + (r32 >> 3)) * ZP + 2816 + (r32 & 7) * 32 + half * 8; aq0 = *(const s16x8*)ap; aq1 = *(const s16x8*)(ap + 16); }
    float wq[4][4];
#pragma unroll
    for (int g = 0; g < 4; ++g) { const f32x4 x = *(const f32x4*)(ZS + (tokb + tb + g) * ZSP + 160 + 4 * half); wq[g][0] = x[0]; wq[g][1] = x[1]; wq[g][2] = x[2]; wq[g][3] = x[3]; }
    unsigned tau[4] = {0u, 0u, 0u, 0u}; int quota[4] = {1 << 30, 1 << 30, 1 << 30, 1 << 30};
#define DSA_SCORES(kt, sc) do { const bf16* kp_ = IK + (tokb + (size_t)(kt) * 32 + r32) * 32 + half * 8; \
        const s16x8 b0_ = *(const s16x8*)kp_, b1_ = *(const s16x8*)(kp_ + 16); f32x16 a_ = {0.f, 0.f, 0.f, 0.f, 0.f, 0.f, 0.f, 0.f, 0.f, 0.f, 0.f, 0.f, 0.f, 0.f, 0.f, 0.f}; \
        a_ = __builtin_amdgcn_mfma_f32_32x32x16_bf16(aq0, b0_, a_, 0, 0, 0); a_ = __builtin_amdgcn_mfma_f32_32x32x16_bf16(aq1, b1_, a_, 0, 0, 0); \
        _Pragma("unroll") for (int g_ = 0; g_ < 4; ++g_) { float pt_ = wq[g_][0] * fmaxf(a_[4 * g_], 0.f); pt_ = fmaf(wq[g_][1], fmaxf(a_[4 * g_ + 1], 0.f), pt_); \
            pt_ = fmaf(wq[g_][2], fmaxf(a_[4 * g_ + 2], 0.f), pt_); pt_ = fmaf(wq[g_][3], fmaxf(a_[4 * g_ + 3], 0.f), pt_); sc[g_] = pt_ + __shfl_xor(pt_, 32); } } while (0)
    if (tb >= 256) {
        unsigned prefix[4] = {0u, 0u, 0u, 0u}; int krem[4] = {256, 256, 256, 256}; int cnteq[4] = {0, 0, 0, 0};
#pragma unroll 1
        for (int pass = 0; pass < 4; ++pass) {
            const int shift = 24 - 8 * pass;
#pragma unroll
            for (int i = 0; i < 4; ++i) *(LAS u32x4*)(hist + (i * 64 + lane) * 4) = (u32x4){0u, 0u, 0u, 0u};
            LDS_WAIT();
            const unsigned pfa = half ? prefix[2] : prefix[0], pfb = half ? prefix[3] : prefix[1];
            const int ta = tb + 2 * half, tbq = ta + 1;
#pragma unroll 1
            for (int kt = 0; kt < ntiles; ++kt) {
                float sc[4]; DSA_SCORES(kt, sc);
                const int key = kt * 32 + r32;
                const unsigned ma = mono_bits(half ? sc[2] : sc[0]), mb = mono_bits(half ? sc[3] : sc[1]);
                const bool oka = (key <= ta) && (pass == 0 || (ma >> (shift + 8)) == pfa);
                const bool okb = (key <= tbq) && (pass == 0 || (mb >> (shift + 8)) == pfb);
                if (oka) atomicAdd((unsigned*)(hist + (2 * half) * 256 + ((ma >> shift) & 255u)), 1u);
                if (okb) atomicAdd((unsigned*)(hist + (2 * half + 1) * 256 + ((mb >> shift) & 255u)), 1u);
            }
            LDS_WAIT();
#pragma unroll
            for (int g = 0; g < 4; ++g) {
                const u32x4 cv = *(const LAS u32x4*)(hist + g * 256 + lane * 4);
                const int c0 = (int)cv.x, c1 = (int)cv.y, c2 = (int)cv.z, c3 = (int)cv.w, tot = c0 + c1 + c2 + c3;
                int v = tot;
#pragma unroll
                for (int d = 1; d < 64; d <<= 1) { const int n = __shfl_down(v, d); if (lane + d < 64) v += n; }
                const int a3 = v - tot, a2 = a3 + c3, a1 = a2 + c2, a0 = a1 + c1; const int k = krem[g];
                int fb = -1, fa = 0, fc = 0;
                if (a3 < k && a3 + c3 >= k) { fb = 3; fa = a3; fc = c3; }
                else if (a2 < k && a2 + c2 >= k) { fb = 2; fa = a2; fc = c2; }
                else if (a1 < k && a1 + c1 >= k) { fb = 1; fa = a1; fc = c1; }
                else if (a0 < k && a0 + c0 >= k) { fb = 0; fa = a0; fc = c0; }
                const unsigned long long mk = __ballot(fb >= 0);
                const int src = (int)__builtin_ctzll(mk | (1ull << 63));
                const int bin = __shfl(4 * lane + fb, src), above = __shfl(fa, src), cnt = __shfl(fc, src);
                prefix[g] = (prefix[g] << 8) | (unsigned)bin; krem[g] = k - above; cnteq[g] = cnt;
            }
        }
#pragma unroll
        for (int g = 0; g < 4; ++g) { tau[g] = prefix[g]; quota[g] = krem[g]; }
        (void)cnteq;
    }
    int base[4] = {0, 0, 0, 0}, eqseen[4] = {0, 0, 0, 0};
    const unsigned lowmask = (1u << r32) - 1u;
#pragma unroll 1
    for (int kt = 0; kt < ntiles; ++kt) {
        float sc[4]; DSA_SCORES(kt, sc);
        const int key = kt * 32 + r32;
#pragma unroll
        for (int g = 0; g < 4; ++g) {
            const unsigned m = mono_bits(sc[g]); const bool valid = key <= tb + g;
            const bool eq = valid && (m == tau[g]);
            const unsigned beq = (unsigned)__ballot(eq);
            const int rank = eqseen[g] + __popc(beq & lowmask);
            const bool sel = valid && ((m > tau[g]) || (eq && rank < quota[g]));
            const unsigned bsel = (unsigned)__ballot(sel);
            if (sel && half == 0) { const int pos = base[g] + __popc(bsel & lowmask); if (pos < 256) list[g * 256 + pos] = key; }
            base[g] += __popc(bsel); eqseen[g] += __popc(beq);
        }
    }
    LDS_WAIT();
#pragma unroll 1
    for (int g = 0; g < 4; ++g) {
        const int cnt = min(base[g], 256); const size_t tok = tokb + tb + g;
        { const unsigned long long wv = *((const unsigned long long*)(Z + tok * ZP + 2560) + lane);
          *(LAS f32x4*)(qs + lane * 4) = (f32x4){bflo((unsigned)wv), bfhi((unsigned)wv), bflo((unsigned)(wv >> 32)), bfhi((unsigned)(wv >> 32))}; }
        LDS_WAIT();
        float acc[4][4]; const float* kp[4]; bool vld[4];
#pragma unroll
        for (int i = 0; i < 4; ++i) { const int n = lane + 64 * i; vld[i] = n < cnt; const int s = vld[i] ? list[g * 256 + n] : 0; kp[i] = ZS + (tokb + s) * ZSP;
#pragma unroll
            for (int hh = 0; hh < 4; ++hh) acc[i][hh] = 0.f; }
#pragma unroll 4
        for (int dc = 0; dc < 16; ++dc) {
            f32x4 kv[4];
#pragma unroll
            for (int i = 0; i < 4; ++i) kv[i] = *(const f32x4*)(kp[i] + dc * 4);
#pragma unroll
            for (int hh = 0; hh < 4; ++hh) { const f32x4 qv = *(const LAS f32x4*)(qs + hh * 64 + dc * 4);
#pragma unroll
                for (int i = 0; i < 4; ++i) acc[i][hh] = fmaf(qv[0], kv[i][0], fmaf(qv[1], kv[i][1], fmaf(qv[2], kv[i][2], fmaf(qv[3], kv[i][3], acc[i][hh])))); }
        }
        float sum[4];
#pragma unroll
        for (int hh = 0; hh < 4; ++hh) { float mx = -INFINITY;
#pragma unroll
            for (int i = 0; i < 4; ++i) mx = fmaxf(mx, vld[i] ? acc[i][hh] : -INFINITY);
            mx = wave_max(mx); float sm = 0.f;
#pragma unroll
            for (int i = 0; i < 4; ++i) { acc[i][hh] = vld[i] ? __expf(acc[i][hh] - mx) : 0.f; sm += acc[i][hh]; }
            sum[hh] = wave_sum(sm); }
#pragma unroll
        for (int i = 0; i < 4; ++i) *(LAS f32x4*)(P + (lane + 64 * i) * 4) = (f32x4){acc[i][0], acc[i][1], acc[i][2], acc[i][3]};
        LDS_WAIT();
        float oa[4] = {0.f, 0.f, 0.f, 0.f};
        const float* vb = ZS + tokb * ZSP + 64 + lane;
#pragma unroll 8
        for (int n = 0; n < cnt; ++n) { const int s = list[g * 256 + n]; const f32x4 pv = *(const LAS f32x4*)(P + n * 4); const float v = vb[(size_t)s * ZSP];
            oa[0] = fmaf(pv[0], v, oa[0]); oa[1] = fmaf(pv[1], v, oa[1]); oa[2] = fmaf(pv[2], v, oa[2]); oa[3] = fmaf(pv[3], v, oa[3]); }
#pragma unroll
        for (int hh = 0; hh < 4; ++hh) O3[tok * 256 + hh * 64 + lane] = (bf16)f2bf(oa[hh] / sum[hh]);
        LDS_WAIT();
    }
#undef DSA_SCORES
}

constexpr int Q_ML = 32, Q_DIFF = 1024, Q_DSA = 1024, Q_SB = 256, Q_TOTAL = Q_ML + Q_DIFF + Q_DSA + Q_SB;
__device__ __forceinline__ Params load_params() {
#if defined(__HIP_DEVICE_COMPILE__)
    const __attribute__((address_space(4))) Params* pp = (const __attribute__((address_space(4))) Params*)__builtin_amdgcn_kernarg_segment_ptr();
    asm volatile("" : "+s"(pp));
    Params r;
    r.x = pp->x; r.pos = pp->pos; r.ffn1_norm = pp->ffn1_norm; r.ffn1_gu = pp->ffn1_gu; r.ffn1_down = pp->ffn1_down; r.mix_norm = pp->mix_norm; r.w_in = pp->w_in; r.diff_qk_norm = pp->diff_qk_norm;
    r.diff_lambda = pp->diff_lambda; r.diff_head_norm = pp->diff_head_norm; r.ml_conv_w = pp->ml_conv_w; r.ml_conv_b = pp->ml_conv_b; r.ml_gate_bias = pp->ml_gate_bias; r.ml_head_norm = pp->ml_head_norm;
    r.dsa_qk_norm = pp->dsa_qk_norm; r.w_branch = pp->w_branch; r.w_out = pp->w_out; r.ffn2_norm = pp->ffn2_norm; r.ffn2_gu = pp->ffn2_gu; r.ffn2_down = pp->ffn2_down; r.out = pp->out; r.ws = pp->ws;
    return r;
#else
    return Params{};
#endif
}
__device__ __forceinline__ int next_item(unsigned* ctr, LAS int* slot, int wv) {
    __syncthreads();
    if (tid_fresh(wv) == 0) *slot = (int)atomicAdd(ctr, 1u);
    __syncthreads();
    return *slot;
}
__device__ __forceinline__ void mixer_phase(int l, LAS unsigned char* lds, int wv) {
    LAS int* slot = (LAS int*)(lds + LDS_BYTES - 64);
    { const Params p = load_params(); unsigned* ctr = (unsigned*)(p.ws + WS_CTL) + 64 * (4 * l + 0);
      for (;;) { const int it = next_item(ctr, slot, wv); if (it >= Q_ML) break; mlstm_item(p, l, it, lds, wv); } }
    { const Params p = load_params(); unsigned* ctr = (unsigned*)(p.ws + WS_CTL) + 64 * (4 * l + 1);
      for (;;) { const int it = next_item(ctr, slot, wv); if (it >= Q_DIFF) break; diff_item(p, l, it & 31, 31 - (it >> 5), lds, wv); } }
    { const Params p = load_params(); unsigned* ctr = (unsigned*)(p.ws + WS_CTL) + 64 * (4 * l + 2);
      for (;;) { const int it = next_item(ctr, slot, wv); if (it >= Q_DSA) break; dsa_item(p, it & 7, 127 - (it >> 3), lds, wv); } }
    { const Params p = load_params(); unsigned* ctr = (unsigned*)(p.ws + WS_CTL) + 64 * (4 * l + 3);
      for (;;) { const int it = next_item(ctr, slot, wv); if (it >= Q_SB) break; sb_item(p, it >> 3, it & 7, lds, wv); } }
}

#define PH_LOCALS const Params p = load_params(); const int tid = tid_fresh(wv), lane = tid & 63, wave = tid >> 6; const int gw = (int)blockIdx.x * NWAVES + wave, ngw = (int)gridDim.x * NWAVES; \
    (void)lane; (void)gw; (void)ngw; bf16* HN = (bf16*)(p.ws + WS_HN); bf16* BIGB = (bf16*)(p.ws + WS_BIG); (void)HN; (void)BIGB;
template <int l> __device__ __forceinline__ void layer_body(cg::grid_group& grid, LAS unsigned char* lds, const int wv) {
        { PH_LOCALS const unsigned char* wl = p.ws + WS_W + (size_t)l * WL_STRIDE; EpiSwiglu E{BIGB}; run_gemm(lds, HN, (const bf16*)(wl + WL_GU1), T, 2 * FF, D, E, wv); }
        grid.sync();
        { PH_LOCALS const unsigned char* wl = p.ws + WS_W + (size_t)l * WL_STRIDE; EpiResid E{l == 0 ? p.x : p.out, p.out, 0.5f}; run_gemm(lds, BIGB, (const bf16*)(wl + WL_D1), T, D, FF, E, wv); }
        grid.sync();
        { PH_LOCALS rms_rows(p.out, p.mix_norm + l * D, HN, gw, ngw, lane); }
        grid.sync();
        { PH_LOCALS const unsigned char* wl = p.ws + WS_W + (size_t)l * WL_STRIDE; EpiZ E{BIGB, (float*)(p.ws + WS_ZS)}; run_gemm(lds, HN, (const bf16*)(wl + WL_INA), T, 3328, D, E, wv); }
        grid.sync();
        { PH_LOCALS prep_phase(p, l, gw, ngw, lane); }
        grid.sync();
        mixer_phase(l, lds, wv);
        grid.sync();
#pragma unroll 1
        for (int b = 0; b < 4; ++b) {
            { PH_LOCALS const unsigned char* wl = p.ws + WS_W + (size_t)l * WL_STRIDE; EpiSig E{BIGB}; run_gemm(lds, HN, (const bf16*)(wl + WL_G) + (size_t)b * D * D, T, D, D, E, wv); }
            grid.sync();
            { PH_LOCALS const unsigned char* wl = p.ws + WS_W + (size_t)l * WL_STRIDE; EpiGate E{BIGB, (float*)(p.ws + WS_BIG + 64 * MiB), HN, b == 0 ? 0 : (b == 3 ? 2 : 1)};
              run_gemm(lds, (const bf16*)(p.ws + WS_O + b * OB_STRIDE), (const bf16*)(wl + WL_BR) + (size_t)b * D * 256, T, D, 256, E, wv); }
            grid.sync();
        }
        { PH_LOCALS const unsigned char* wl = p.ws + WS_W + (size_t)l * WL_STRIDE; EpiResid E{p.out, p.out, 1.0f}; run_gemm(lds, HN, (const bf16*)(wl + WL_OUT), T, D, D, E, wv); }
        grid.sync();
        { PH_LOCALS rms_rows(p.out, p.ffn2_norm + l * D, HN, gw, ngw, lane); }
        grid.sync();
        { PH_LOCALS const unsigned char* wl = p.ws + WS_W + (size_t)l * WL_STRIDE; EpiSwiglu E{BIGB}; run_gemm(lds, HN, (const bf16*)(wl + WL_GU2), T, 2 * FF, D, E, wv); }
        grid.sync();
        { PH_LOCALS const unsigned char* wl = p.ws + WS_W + (size_t)l * WL_STRIDE; EpiResid E{p.out, p.out, 0.5f}; run_gemm(lds, BIGB, (const bf16*)(wl + WL_D2), T, D, FF, E, wv); }
        if (l + 1 < DEPTH) {
            grid.sync();
            { PH_LOCALS rms_rows(p.out, p.ffn1_norm + (l + 1) * D, HN, gw, ngw, lane); }
            grid.sync();
        }
    }

__global__ void __launch_bounds__(NTHR, 2) hybrid_fwd(Params p_unused) {
    extern __shared__ __attribute__((aligned(16))) unsigned char lds_raw[];
    LAS unsigned char* lds = (LAS unsigned char*)lds_raw;
    cg::grid_group grid = cg::this_grid();
    const int wv = __builtin_amdgcn_readfirstlane((int)threadIdx.x >> 6);
    {
        PH_LOCALS
        SegRun R; R.base = 0; R.gw = gw; R.ngw = ngw; R.lane = lane; R.scr = (LAS float*)(lds + wave * 8704);
        for (int l = 0; l < DEPTH; ++l) convert_weights(p, l, R);
        if (blockIdx.x == 0 && tid < 16) ((unsigned*)(p.ws + WS_CTL))[64 * tid] = 0u;
        rms_rows(p.x, p.ffn1_norm, HN, gw, ngw, lane);
    }
    grid.sync();
    layer_body<0>(grid, lds, wv);
    layer_body<1>(grid, lds, wv);
}

extern "C" void kernel_launch(void* const* d_in, const int* in_sizes, int n_in, void* d_out, int out_size, void* d_ws, size_t ws_size, hipStream_t stream) {
    static int grid = 0;
    if (grid == 0) {
        if (n_in != 20 || out_size != T * D || ws_size < WS_END) { fprintf(stderr, "kernel_launch: unexpected shapes (n_in %d out %d ws %zu)\n", n_in, out_size, ws_size); grid = -1; return; }
        int dev = 0, cus = 0, per_cu = 0;
        hipGetDevice(&dev); hipDeviceGetAttribute(&cus, hipDeviceAttributeMultiprocessorCount, dev);
        hipFuncSetAttribute((const void*)hybrid_fwd, hipFuncAttributeMaxDynamicSharedMemorySize, LDS_BYTES);
        hipOccupancyMaxActiveBlocksPerMultiprocessor(&per_cu, (const void*)hybrid_fwd, NTHR, LDS_BYTES);
        if (per_cu < 1) { fprintf(stderr, "kernel_launch: occupancy query says %d\n", per_cu); per_cu = 1; }
        (void)hipGetLastError();
        grid = cus * 1;
    }
    if (grid < 0) return;
    Params p{};
    p.x = (const float*)d_in[0]; p.pos = (const int*)d_in[1];
    p.ffn1_norm = (const float*)d_in[2]; p.ffn1_gu = (const float*)d_in[3]; p.ffn1_down = (const float*)d_in[4]; p.mix_norm = (const float*)d_in[5]; p.w_in = (const float*)d_in[6];
    p.diff_qk_norm = (const float*)d_in[7]; p.diff_lambda = (const float*)d_in[8]; p.diff_head_norm = (const float*)d_in[9]; p.ml_conv_w = (const float*)d_in[10]; p.ml_conv_b = (const float*)d_in[11];
    p.ml_gate_bias = (const float*)d_in[12]; p.ml_head_norm = (const float*)d_in[13]; p.dsa_qk_norm = (const float*)d_in[14]; p.w_branch = (const float*)d_in[15]; p.w_out = (const float*)d_in[16];
    p.ffn2_norm = (const float*)d_in[17]; p.ffn2_gu = (const float*)d_in[18]; p.ffn2_down = (const float*)d_in[19];
    p.out = (float*)d_out; p.ws = (unsigned char*)d_ws;
    void* args[] = {&p};
    hipError_t e = hipLaunchCooperativeKernel((const void*)hybrid_fwd, dim3(grid), dim3(NTHR), args, LDS_BYTES, stream);
    if (e != hipSuccess) fprintf(stderr, "cooperative launch failed: %s (grid %d)\n", hipGetErrorString(e), grid);
}
```

```cpp
#include <hip/hip_runtime.h>
#include <hip/hip_cooperative_groups.h>
#include <cstdio>
#include <cstdint>
namespace cg = cooperative_groups;
namespace pg8 {
#define PG8_LAS __attribute__((address_space(3)))
typedef unsigned short bf16_t;
typedef short bf16x8 __attribute__((ext_vector_type(8)));
typedef float f32x4 __attribute__((ext_vector_type(4)));
typedef unsigned u32x4 __attribute__((ext_vector_type(4)));
constexpr int BM = 256, BK = 64, HALF = 128, HTB = HALF * BK * 2  , STAGE_BYTES = 8 * HTB, NXCD = 8, WGM = 8;

__host__ __device__ __forceinline__ int lds_byte(int r, int c) { const int st = (r >> 4) * 2 + (c >> 5), rr = r & 15, cc = c & 31, ob = rr * 64 + cc * 2; return st * 1024 + (ob ^ (((ob >> 9) & 1) << 5)); }
__host__ __device__ __forceinline__ void stage_rc(int b, int& R, int& C) { const int st = b / 1024, sb = b % 1024, swz = sb ^ (((sb >> 9) & 1) << 5); R = (st >> 1) * 16 + swz / 64; C = (st & 1) * 32 + (swz % 64) / 2; }
__host__ __device__ __forceinline__ int perm32(int rho) { const int n = rho >> 4, i = rho & 15; return 8 * (i >> 2) + 4 * n + (i & 3); }

struct Unit { int pm, pn; };
struct Gemm { const bf16_t* A; const bf16_t* Bt; int M, N, K; };

struct StaticOrder {
    int nM, nN, nwg, G, c;
    __host__ __device__ void init(int M, int N, int G_, int c_) { nM = M / BM; nN = N / BM; nwg = nM * nN; G = G_; c = c_; }
    __host__ __device__ bool next(int i, Unit& u) const {
        const long L = (long)i * G + c; if (L >= nwg) return false;
        int wgid = (int)L; { const int q = nwg / NXCD, r = nwg % NXCD, xcd = wgid % NXCD, off = wgid / NXCD; wgid = (xcd < r ? xcd * (q + 1) : r * (q + 1) + (xcd - r) * q) + off; }
        const int nig = WGM * nN, gid = wgid / nig, fm = gid * WGM, gsz = (nM - fm) < WGM ? (nM - fm) : WGM;
        u.pm = fm + ((wgid % nig) % gsz); u.pn = (wgid % nig) / gsz; return true;
    }
    __device__ __forceinline__ void a_ready(const Unit&) const {}
    __device__ __forceinline__ void done(const Unit&) const {}
};

__device__ __forceinline__ unsigned cvt_pk_bf16(float lo, float hi) { unsigned r; asm volatile("v_cvt_pk_bf16_f32 %0, %1, %2" : "=v"(r) : "v"(lo), "v"(hi)); return r; }
template <class Epi, class Sched, bool ALIGN_EPI = false, bool SP2 = false>
__device__ __forceinline__ void gemm_phase(PG8_LAS unsigned char* lds, const Gemm g, const Sched& S, const Epi& E, const int wave_in) {
    unsigned z_ = 0u; asm volatile("" : "+v"(z_)); int w_ = wave_in; asm volatile("" : "+s"(w_));
    const int tid_ = w_ * 64 + (int)__builtin_amdgcn_mbcnt_hi(~0u, __builtin_amdgcn_mbcnt_lo(~0u, z_));
    const int tid = tid_, wid = __builtin_amdgcn_readfirstlane(tid >> 6), lane = tid & 63, wr = wid >> 2, wc = wid & 3, fr = lane & 15, fq = lane >> 4;
    const int K = g.K, nt = K / BK;
    unsigned voffA[2], voffB[2];
#pragma unroll
    for (int i = 0; i < 2; ++i) { int R, C; stage_rc(tid * 16 + i * 8192, R, C); const int Rb = Epi::PERM ? ((R & ~31) + perm32(R & 31)) : R;
        voffA[i] = (unsigned)(R * K + C) * 2u; voffB[i] = (unsigned)(Rb * K + C) * 2u; }
    const size_t kstep = (size_t)(BK * 2);
    const size_t hstep = (size_t)HALF * K * 2;
    const size_t tstep = 2 * hstep;
    const unsigned ldsw = (unsigned)wid * 1024u;
    const int aoff = lds_byte(wr * 64 + fr, fq * 8), boff = lds_byte(wc * 32 + fr, fq * 8);
#define PG8_SA(b, h) (((b) * 2 + (h)) * HTB)
#define PG8_SB(b, h) ((4 + (b) * 2 + (h)) * HTB)
#define PG8_STAGE(bufoff, gbase, voff) do { _Pragma("unroll") for (int _i = 0; _i < 2; ++_i) \
        __builtin_amdgcn_global_load_lds((const unsigned*)((const char*)(gbase) + (voff)[_i]), (PG8_LAS unsigned*)(lds + (bufoff) + ldsw + _i * 8192), 16, 0, 0); } while (0)
#define PG8_LDA(dst, b, h) do { _Pragma("unroll") for (int m = 0; m < 4; ++m) _Pragma("unroll") for (int k = 0; k < 2; ++k) dst[m][k] = *(const PG8_LAS bf16x8*)(lds + PG8_SA(b, h) + aoff + m * 2048 + k * 1024); } while (0)
#define PG8_LDB(dst, b, h) do { _Pragma("unroll") for (int n = 0; n < 2; ++n) _Pragma("unroll") for (int k = 0; k < 2; ++k) dst[n][k] = *(const PG8_LAS bf16x8*)(lds + PG8_SB(b, h) + boff + n * 2048 + k * 1024); } while (0)
#define PG8_MMA(ai, bj, At, Bt) do { __builtin_amdgcn_s_setprio(1); _Pragma("unroll") for (int m = 0; m < 4; ++m) _Pragma("unroll") for (int n = 0; n < 2; ++n) _Pragma("unroll") for (int k = 0; k < 2; ++k) \
        acc[ai][bj][m][n] = __builtin_amdgcn_mfma_f32_16x16x32_bf16(Bt[n][k], At[m][k], acc[ai][bj][m][n], 0, 0, 0); __builtin_amdgcn_s_setprio(0); } while (0)
#define PG8_WAIT_V(n) asm volatile("s_waitcnt vmcnt(" #n ")" ::: "memory")
#define PG8_WAIT_L(n) asm volatile("s_waitcnt lgkmcnt(" #n ")" ::: "memory")
#define PG8_BAR __builtin_amdgcn_s_barrier()
#define PG8_SCHED __builtin_amdgcn_sched_barrier(0)
    Unit cur, nxt; int ui = 0;
    if (!S.next(0, cur)) return;
    f32x4 acc[2][2][4][2];
#pragma unroll
    for (int a = 0; a < 2; ++a)
#pragma unroll
        for (int b = 0; b < 2; ++b)
#pragma unroll
            for (int m = 0; m < 4; ++m)
#pragma unroll
                for (int n = 0; n < 2; ++n) acc[a][b][m][n] = (f32x4){0.f, 0.f, 0.f, 0.f};
    bf16x8 At[4][2], B0[2][2], B1[2][2];
    const char* cA = (const char*)g.A + (size_t)cur.pm * tstep; const char* cB = (const char*)g.Bt + (size_t)cur.pn * tstep;
    S.a_ready(cur);
    if constexpr (SP2) {
        PG8_STAGE(PG8_SB(0, 0), cB, voffB); PG8_STAGE(PG8_SB(0, 1), cB + hstep, voffB); PG8_STAGE(PG8_SA(0, 0), cA, voffA); PG8_STAGE(PG8_SA(0, 1), cA + hstep, voffA);
        if (wr == 1) PG8_BAR;
        PG8_WAIT_V(2); PG8_BAR;
        PG8_STAGE(PG8_SB(1, 0), cB + kstep, voffB); PG8_STAGE(PG8_SA(1, 0), cA + kstep, voffA); PG8_STAGE(PG8_SB(1, 1), cB + hstep + kstep, voffB);
        PG8_WAIT_V(6); PG8_BAR;
    } else {
        PG8_STAGE(PG8_SB(0, 0), cB, voffB); PG8_STAGE(PG8_SA(0, 0), cA, voffA); PG8_STAGE(PG8_SB(0, 1), cB + hstep, voffB); PG8_STAGE(PG8_SA(0, 1), cA + hstep, voffA);
        if (wr == 1) PG8_BAR;
        PG8_WAIT_V(4); PG8_BAR;
        PG8_STAGE(PG8_SB(1, 0), cB + kstep, voffB); PG8_STAGE(PG8_SA(1, 0), cA + kstep, voffA); PG8_STAGE(PG8_SB(1, 1), cB + hstep + kstep, voffB);
        PG8_WAIT_V(6); PG8_BAR;
    }
    for (;;) {
        const bool has_next = S.next(ui + 1, nxt);
        const char* nA = has_next ? (const char*)g.A + (size_t)nxt.pm * tstep : cA; const char* nB = has_next ? (const char*)g.Bt + (size_t)nxt.pn * tstep : cB;
        for (int t = 0; t < nt; t += 2) {
            const bool last = (t == nt - 2);
            const char* a1 = cA + (size_t)(t + 1) * kstep;
            const char* a2 = last ? nA : cA + (size_t)(t + 2) * kstep; const char* b2 = last ? nB : cB + (size_t)(t + 2) * kstep;
            const char* a3 = a2 + kstep; const char* b3 = b2 + kstep;
            if (last && has_next) S.a_ready(nxt);
            if constexpr (SP2) {
            PG8_LDB(B0, 0, 0); PG8_LDB(B1, 0, 1); PG8_SCHED; PG8_LDA(At, 0, 0); PG8_STAGE(PG8_SA(1, 1), a1 + hstep, voffA);
            PG8_WAIT_V(8); PG8_WAIT_L(0); PG8_BAR; PG8_MMA(0, 0, At, B0); PG8_MMA(0, 1, At, B1); PG8_BAR; PG8_SCHED;
            PG8_LDA(At, 0, 1); PG8_STAGE(PG8_SB(0, 0), b2, voffB); PG8_STAGE(PG8_SB(0, 1), b2 + hstep, voffB); PG8_STAGE(PG8_SA(0, 0), a2, voffA);
            PG8_WAIT_V(8); PG8_WAIT_L(0); PG8_BAR; PG8_MMA(1, 0, At, B0); PG8_MMA(1, 1, At, B1); PG8_BAR; PG8_SCHED;
            PG8_LDB(B0, 1, 0); PG8_LDB(B1, 1, 1); PG8_SCHED; PG8_LDA(At, 1, 0); PG8_STAGE(PG8_SA(0, 1), a2 + hstep, voffA);
            PG8_WAIT_V(8); PG8_WAIT_L(0); PG8_BAR; PG8_MMA(0, 0, At, B0); PG8_MMA(0, 1, At, B1); PG8_BAR; PG8_SCHED;
            PG8_LDA(At, 1, 1); PG8_STAGE(PG8_SB(1, 0), b3, voffB); PG8_STAGE(PG8_SB(1, 1), b3 + hstep, voffB); PG8_STAGE(PG8_SA(1, 0), a3, voffA);
            PG8_WAIT_V(8); PG8_WAIT_L(0); PG8_BAR; PG8_MMA(1, 0, At, B0); PG8_MMA(1, 1, At, B1); PG8_BAR; PG8_SCHED;
            } else {
            PG8_LDB(B0, 0, 0); PG8_SCHED; PG8_LDA(At, 0, 0); PG8_STAGE(PG8_SA(1, 1), a1 + hstep, voffA);
            PG8_WAIT_L(8); PG8_BAR; PG8_WAIT_L(0); PG8_MMA(0, 0, At, B0); PG8_BAR; PG8_SCHED;
            PG8_LDB(B1, 0, 1); PG8_STAGE(PG8_SB(0, 0), b2, voffB);
            PG8_BAR; PG8_WAIT_L(0); PG8_MMA(0, 1, At, B1); PG8_BAR;
            PG8_LDA(At, 0, 1); PG8_STAGE(PG8_SA(0, 0), a2, voffA);
            PG8_BAR; PG8_WAIT_L(0); PG8_MMA(1, 0, At, B0); PG8_BAR; PG8_SCHED;
            PG8_STAGE(PG8_SB(0, 1), b2 + hstep, voffB);
            PG8_WAIT_V(6); PG8_BAR; PG8_MMA(1, 1, At, B1); PG8_BAR;
            PG8_LDB(B0, 1, 0); PG8_SCHED; PG8_LDA(At, 1, 0); PG8_STAGE(PG8_SA(0, 1), a2 + hstep, voffA);
            PG8_WAIT_L(8); PG8_BAR; PG8_WAIT_L(0); PG8_MMA(0, 0, At, B0); PG8_BAR; PG8_SCHED;
            PG8_LDB(B1, 1, 1); PG8_STAGE(PG8_SB(1, 0), b3, voffB);
            PG8_BAR; PG8_WAIT_L(0); PG8_MMA(0, 1, At, B1); PG8_BAR;
            PG8_LDA(At, 1, 1); PG8_STAGE(PG8_SA(1, 0), a3, voffA);
            PG8_BAR; PG8_WAIT_L(0); PG8_MMA(1, 0, At, B0); PG8_BAR; PG8_SCHED;
            PG8_STAGE(PG8_SB(1, 1), b3 + hstep, voffB);
            PG8_WAIT_V(6); PG8_BAR; PG8_MMA(1, 1, At, B1); PG8_BAR;
            }
        }
        if constexpr (ALIGN_EPI) { if (wr == 0) PG8_BAR; }
        if constexpr (!Epi::AFTER_DRAIN) { E(acc, cur, wr, wc, fr, fq); S.done(cur); }
        if (!has_next) break;
#pragma unroll
        for (int a = 0; a < 2; ++a)
#pragma unroll
            for (int b = 0; b < 2; ++b)
#pragma unroll
                for (int m = 0; m < 4; ++m)
#pragma unroll
                    for (int n = 0; n < 2; ++n) acc[a][b][m][n] = (f32x4){0.f, 0.f, 0.f, 0.f};
        cur = nxt; cA = nA; cB = nB; ++ui;
        if constexpr (ALIGN_EPI) { if (wr == 1) PG8_BAR; }
    }
    PG8_WAIT_V(0);
    if constexpr (!ALIGN_EPI) { if (wr == 0) PG8_BAR; }
    PG8_BAR;
    if constexpr (Epi::AFTER_DRAIN) { E.fused(acc, cur, wr, wc, fr, fq, lds, wid, lane); S.done(cur); }
#undef PG8_SA
#undef PG8_SB
#undef PG8_STAGE
#undef PG8_LDA
#undef PG8_LDB
#undef PG8_MMA
#undef PG8_WAIT_V
#undef PG8_WAIT_L
#undef PG8_BAR
#undef PG8_SCHED
}
}
#define LAS __attribute__((address_space(3)))
typedef unsigned short bf16;
typedef float f32x4 __attribute__((ext_vector_type(4)));
typedef float f32x16 __attribute__((ext_vector_type(16)));
typedef unsigned u32x4 __attribute__((ext_vector_type(4)));
typedef unsigned u32x2 __attribute__((ext_vector_type(2)));
typedef short s16x8 __attribute__((ext_vector_type(8)));

constexpr int NB = 8, SEQ = 4096, T = NB * SEQ, D = 1024, FF = 2816, DEPTH = 2, NIN = 7344, ZP = 3072, ZSP = 256;
constexpr int NTHR = 512, NWAVES = 8;
constexpr int LDS_BYTES = 147456;
constexpr float EPS = 1e-6f;

constexpr size_t MiB = (size_t)1 << 20;
constexpr size_t WS_CTL = 0;
constexpr size_t WS_W = 1 * MiB, WL_STRIDE = 52 * MiB;
constexpr size_t WL_GU1 = 0, WL_D1 = 11534336, WL_INA = 17301504, WL_G = 24117248, WL_BR = 32505856, WL_OUT = 34603008, WL_GU2 = 36700160, WL_D2 = 48234496;
constexpr size_t WS_HN = 106 * MiB, WS_BIG = 170 * MiB, WS_ZS = 362 * MiB, WS_O = 394 * MiB, WS_IK = 458 * MiB, WS_END = 460 * MiB;
constexpr size_t OB_STRIDE = (size_t)T * 256 * 2;

struct Params {
    const float* x; const int* pos;
    const float *ffn1_norm, *ffn1_gu, *ffn1_down, *mix_norm, *w_in, *diff_qk_norm, *diff_lambda, *diff_head_norm, *ml_conv_w, *ml_conv_b, *ml_gate_bias, *ml_head_norm,
        *dsa_qk_norm, *w_branch, *w_out, *ffn2_norm, *ffn2_gu, *ffn2_down;
    float* out; unsigned char* ws;
};

__device__ __forceinline__ unsigned f2bf(float f) { unsigned u = __float_as_uint(f); return (u + 0x7fffu + ((u >> 16) & 1u)) >> 16; }
__device__ __forceinline__ unsigned pk2(float lo, float hi) { return f2bf(lo) | (f2bf(hi) << 16); }
__device__ __forceinline__ float bflo(unsigned w) { return __uint_as_float(w << 16); }
__device__ __forceinline__ float bfhi(unsigned w) { return __uint_as_float(w & 0xffff0000u); }
__device__ __forceinline__ float wave_sum(float v) {
#pragma unroll
    for (int o = 1; o < 64; o <<= 1) v += __shfl_xor(v, o);
    return v;
}
__device__ __forceinline__ float wave_max(float v) {
#pragma unroll
    for (int o = 1; o < 64; o <<= 1) v = fmaxf(v, __shfl_xor(v, o));
    return v;
}
__device__ __forceinline__ int lane_fresh() { unsigned z = 0u; asm volatile("" : "+v"(z)); return (int)__builtin_amdgcn_mbcnt_hi(~0u, __builtin_amdgcn_mbcnt_lo(~0u, z)); }
__device__ __forceinline__ int tid_fresh(int wv) { int w = wv; asm volatile("" : "+s"(w)); return w * 64 + lane_fresh(); }
#define LDS_WAIT() asm volatile("s_waitcnt lgkmcnt(0)" ::: "memory")
__device__ __forceinline__ float sigmoidf_(float x) { return 1.f / (1.f + __expf(-x)); }

struct EpiSwiglu {
    static constexpr bool PERM = true, AFTER_DRAIN = false;
    bf16* O;
    __device__ __forceinline__ void operator()(const f32x4 (&acc)[2][2][4][2], const pg8::Unit& u, int wr, int wc, int fr_in, int fq_in) const {
        const int ln_ = lane_fresh(); const int fr = ln_ & 15, fq = ln_ >> 4; (void)fr_in; (void)fq_in;
        const int row0 = u.pm * 256 + wr * 64 + fr, col0 = u.pn * 128 + wc * 32 + 8 * fq;
#pragma unroll
        for (int ai = 0; ai < 2; ++ai)
#pragma unroll
            for (int m = 0; m < 4; ++m) {
                bf16* rowp = O + (size_t)(row0 + ai * 128 + m * 16) * FF + col0;
                float r[8];
#pragma unroll
                for (int n = 0; n < 2; ++n)
#pragma unroll
                    for (int j = 0; j < 4; ++j) { const float g = acc[ai][0][m][n][j], uu = acc[ai][1][m][n][j]; r[4 * n + j] = g * sigmoidf_(g) * uu; }
                u32x4 w; w.x = pk2(r[0], r[1]); w.y = pk2(r[2], r[3]); w.z = pk2(r[4], r[5]); w.w = pk2(r[6], r[7]);
                *(u32x4*)rowp = w;
            }
    }
};
struct EpiResid {
    static constexpr bool PERM = true, AFTER_DRAIN = false;
    const float* base; float* out; float scale;
    __device__ __forceinline__ void operator()(const f32x4 (&acc)[2][2][4][2], const pg8::Unit& u, int wr, int wc, int fr_in, int fq_in) const {
        const int ln_ = lane_fresh(); const int fr = ln_ & 15, fq = ln_ >> 4; (void)fr_in; (void)fq_in;
        const int row0 = u.pm * 256 + wr * 64 + fr, col0 = u.pn * 256 + wc * 32 + 8 * fq;
#pragma unroll
        for (int ai = 0; ai < 2; ++ai)
#pragma unroll
            for (int m = 0; m < 4; ++m) {
                const size_t ro = (size_t)(row0 + ai * 128 + m * 16) * D + col0;
#pragma unroll
                for (int bj = 0; bj < 2; ++bj)
#pragma unroll
                    for (int n = 0; n < 2; ++n) { const f32x4 b = *(const f32x4*)(base + ro + bj * 128 + 4 * n); *(f32x4*)(out + ro + bj * 128 + 4 * n) = b + acc[ai][bj][m][n] * scale; }
            }
    }
};
struct EpiZ {
    static constexpr bool PERM = true, AFTER_DRAIN = false;
    bf16* Z; float* ZS;
    __device__ __forceinline__ void operator()(const f32x4 (&acc)[2][2][4][2], const pg8::Unit& u, int wr, int wc, int fr_in, int fq_in) const {
        const int ln_ = lane_fresh(); const int fr = ln_ & 15, fq = ln_ >> 4; (void)fr_in; (void)fq_in;
        const int row0 = u.pm * 256 + wr * 64 + fr, cw = wc * 32 + 8 * fq;
        if (u.pn < 12) {
#pragma unroll
            for (int ai = 0; ai < 2; ++ai)
#pragma unroll
                for (int m = 0; m < 4; ++m) {
                    bf16* rowp = Z + (size_t)(row0 + ai * 128 + m * 16) * ZP + u.pn * 256 + cw;
#pragma unroll
                    for (int bj = 0; bj < 2; ++bj) { const f32x4 v0 = acc[ai][bj][m][0], v1 = acc[ai][bj][m][1];
                        u32x4 w; w.x = pk2(v0[0], v0[1]); w.y = pk2(v0[2], v0[3]); w.z = pk2(v1[0], v1[1]); w.w = pk2(v1[2], v1[3]);
                        *(u32x4*)(rowp + bj * 128) = w; }
                }
        } else {
#pragma unroll
            for (int ai = 0; ai < 2; ++ai)
#pragma unroll
                for (int m = 0; m < 4; ++m) {
                    float* rowp = ZS + (size_t)(row0 + ai * 128 + m * 16) * ZSP + cw;
#pragma unroll
                    for (int bj = 0; bj < 2; ++bj)
#pragma unroll
                        for (int n = 0; n < 2; ++n) *(f32x4*)(rowp + bj * 128 + 4 * n) = acc[ai][bj][m][n];
                }
        }
    }
};
struct EpiSig {
    static constexpr bool PERM = true, AFTER_DRAIN = false;
    bf16* SG;
    __device__ __forceinline__ void operator()(const f32x4 (&acc)[2][2][4][2], const pg8::Unit& u, int wr, int wc, int fr_in, int fq_in) const {
        const int ln_ = lane_fresh(); const int fr = ln_ & 15, fq = ln_ >> 4; (void)fr_in; (void)fq_in;
        const int row0 = u.pm * 256 + wr * 64 + fr, col0 = u.pn * 256 + wc * 32 + 8 * fq;
#pragma unroll
        for (int ai = 0; ai < 2; ++ai)
#pragma unroll
            for (int m = 0; m < 4; ++m) {
                bf16* rowp = SG + (size_t)(row0 + ai * 128 + m * 16) * D + col0;
#pragma unroll
                for (int bj = 0; bj < 2; ++bj) { const f32x4 v0 = acc[ai][bj][m][0], v1 = acc[ai][bj][m][1];
                    u32x4 w; w.x = pk2(sigmoidf_(v0[0]), sigmoidf_(v0[1])); w.y = pk2(sigmoidf_(v0[2]), sigmoidf_(v0[3]));
                    w.z = pk2(sigmoidf_(v1[0]), sigmoidf_(v1[1])); w.w = pk2(sigmoidf_(v1[2]), sigmoidf_(v1[3]));
                    *(u32x4*)(rowp + bj * 128) = w; }
            }
    }
};
struct EpiGate {
    static constexpr bool PERM = true, AFTER_DRAIN = false;
    const bf16* SG; float* YF; bf16* YB; int mode;
    __device__ __forceinline__ void operator()(const f32x4 (&acc)[2][2][4][2], const pg8::Unit& u, int wr, int wc, int fr_in, int fq_in) const {
        const int ln_ = lane_fresh(); const int fr = ln_ & 15, fq = ln_ >> 4; (void)fr_in; (void)fq_in;
        const int row0 = u.pm * 256 + wr * 64 + fr, col0 = u.pn * 256 + wc * 32 + 8 * fq;
#pragma unroll
        for (int ai = 0; ai < 2; ++ai)
#pragma unroll
            for (int m = 0; m < 4; ++m) {
                const size_t ro = (size_t)(row0 + ai * 128 + m * 16) * D + col0;
#pragma unroll
                for (int bj = 0; bj < 2; ++bj) {
                    const u32x4 sg = *(const u32x4*)(SG + ro + bj * 128);
                    f32x4 g0 = (f32x4){bflo(sg.x), bfhi(sg.x), bflo(sg.y), bfhi(sg.y)}, g1 = (f32x4){bflo(sg.z), bfhi(sg.z), bflo(sg.w), bfhi(sg.w)};
                    f32x4 v0 = g0 * acc[ai][bj][m][0], v1 = g1 * acc[ai][bj][m][1];
                    float* yp = YF + ro + bj * 128;
                    if (mode != 0) { v0 = v0 + *(const f32x4*)yp; v1 = v1 + *(const f32x4*)(yp + 4); }
                    if (mode != 2) { *(f32x4*)yp = v0; *(f32x4*)(yp + 4) = v1; }
                    else { u32x4 w; w.x = pk2(v0[0], v0[1]); w.y = pk2(v0[2], v0[3]); w.z = pk2(v1[0], v1[1]); w.w = pk2(v1[2], v1[3]); *(u32x4*)(YB + ro + bj * 128) = w; }
                }
            }
    }
};

template <class Epi>
__device__ __forceinline__ void run_gemm(LAS unsigned char* lds, const bf16* A, const bf16* Bt, int M, int N, int K, const Epi& E, int wv) {
    pg8::Gemm g{A, Bt, M, N, K}; pg8::StaticOrder S; S.init(M, N, (int)gridDim.x, (int)blockIdx.x);
    pg8::gemm_phase<Epi, pg8::StaticOrder, true, true>((PG8_LAS unsigned char*)lds, g, S, E, wv);
}

__device__ __forceinline__ void tr_item(const float* W, int K, int srcN, int c0, int nv, bf16* WT, int r0, int k0, LAS float* scr, int lane) {
    const int c = lane & 31;
#pragma unroll 8
    for (int i = 0; i < 32; ++i) { const int kk = 2 * i + (lane >> 5); scr[kk * 33 + c] = (c < nv) ? W[(size_t)(k0 + kk) * srcN + c0 + c] : 0.f; }
    LDS_WAIT();
    const int c8 = lane & 7;
#pragma unroll
    for (int j = 0; j < 4; ++j) { const int n = (lane >> 3) + 8 * j; const LAS float* s = scr + (8 * c8) * 33 + n;
        u32x4 o; o.x = pk2(s[0 * 33], s[1 * 33]); o.y = pk2(s[2 * 33], s[3 * 33]); o.z = pk2(s[4 * 33], s[5 * 33]); o.w = pk2(s[6 * 33], s[7 * 33]);
        if (n < nv) *(u32x4*)(WT + (size_t)(r0 + n) * K + k0 + 8 * c8) = o; }
    LDS_WAIT();
}
struct SegRun { int base, gw, ngw, lane; LAS float* scr; };
__device__ __forceinline__ void run_seg(SegRun& R, const float* W, int K, int srcN, int c0, int ncols, bf16* WT, int r0) {
    const int nblk = (ncols + 31) >> 5, nitems = (K >> 6) * nblk;
    int first = (R.gw - (R.base % R.ngw) + R.ngw) % R.ngw;
    for (int it = first; it < nitems; it += R.ngw) { const int kb = it / nblk, nb = it - kb * nblk; const int nv = min(32, ncols - nb * 32);
        tr_item(W, K, srcN, c0 + nb * 32, nv, WT, r0 + nb * 32, kb * 64, R.scr, R.lane); }
    R.base += nitems;
}
__device__ __forceinline__ void convert_weights(const Params& p, int l, SegRun& R) {
    unsigned char* wl = p.ws + WS_W + (size_t)l * WL_STRIDE;
    for (int f = 0; f < 2; ++f) {
        const float* gu = (f ? p.ffn2_gu : p.ffn1_gu) + (size_t)l * D * 2 * FF; bf16* gut = (bf16*)(wl + (f ? WL_GU2 : WL_GU1));
        for (int sg = 0; sg < 44; ++sg) run_seg(R, gu, D, 2 * FF, sg * 128, 128, gut, (sg % 22) * 256 + (sg / 22) * 128);
        const float* dn = (f ? p.ffn2_down : p.ffn1_down) + (size_t)l * FF * D; bf16* dnt = (bf16*)(wl + (f ? WL_D2 : WL_D1));
        run_seg(R, dn, FF, D, 0, D, dnt, 0);
    }
    const float* wi = p.w_in + (size_t)l * D * NIN; bf16* ina = (bf16*)(wl + WL_INA);
    run_seg(R, wi, D, NIN, 0, 768, ina, 0);
    run_seg(R, wi, D, NIN, 768, 512, ina, 768);
    run_seg(R, wi, D, NIN, 1280, 256, ina, 1280);
    run_seg(R, wi, D, NIN, 1544, 256, ina, 1536);
    run_seg(R, wi, D, NIN, 1800, 768, ina, 1792);
    run_seg(R, wi, D, NIN, 2568, 256, ina, 2560);
    run_seg(R, wi, D, NIN, 2952, 256, ina, 2816);
    run_seg(R, wi, D, NIN, 2824, 128, ina, 3072);
    run_seg(R, wi, D, NIN, 3208, 40, ina, 3200);
    run_seg(R, wi, D, NIN, 1536, 8, ina, 3240);
    run_seg(R, wi, D, NIN, 3248, 4096, (bf16*)(wl + WL_G), 0);
    for (int b = 0; b < 4; ++b) run_seg(R, p.w_branch + ((size_t)l * 4 + b) * 256 * D, 256, D, 0, D, (bf16*)(wl + WL_BR) + (size_t)b * D * 256, 0);
    run_seg(R, p.w_out + (size_t)l * D * D, D, D, 0, D, (bf16*)(wl + WL_OUT), 0);
    for (int i = R.gw * 64 + R.lane; i < 80 * 128; i += R.ngw * 64) *((u32x4*)(ina + (size_t)3248 * D) + i) = (u32x4){0u, 0u, 0u, 0u};
}

__device__ __forceinline__ void rms_rows(const float* X, const float* g, bf16* HN, int gw, int ngw, int lane) {
    f32x4 gv[4];
#pragma unroll
    for (int j = 0; j < 4; ++j) gv[j] = ((const f32x4*)g)[lane + 64 * j];
    for (int m = gw; m < T; m += ngw) {
        const f32x4* xr = (const f32x4*)(X + (size_t)m * D) + lane;
        f32x4 v[4]; float s = 0.f;
#pragma unroll
        for (int j = 0; j < 4; ++j) { v[j] = xr[64 * j]; s += (v[j].x * v[j].x + v[j].y * v[j].y) + (v[j].z * v[j].z + v[j].w * v[j].w); }
        const float r = 1.f / sqrtf(wave_sum(s) * (1.f / D) + EPS);
        unsigned long long* o8 = (unsigned long long*)(HN + (size_t)m * D) + lane;
#pragma unroll
        for (int j = 0; j < 4; ++j) { const f32x4 y = v[j] * r * gv[j]; o8[64 * j] = (unsigned long long)pk2(y.x, y.y) | ((unsigned long long)pk2(y.z, y.w) << 32); }
    }
}

__device__ __forceinline__ void sincos_red(float ang, float& sn, float& cs) {
    const float n = rintf(ang * 0.15915494309189535f);
    float r = fmaf(-n, 6.28125f, ang); r = fmaf(-n, 0.0019353071795864769f, r);
    sn = __sinf(r); cs = __cosf(r);
}
template <int HALF>
__device__ __forceinline__ void rope4(float (&v)[4], int sl, float pos) {
    constexpr int LH = HALF / 4;
    float pv[4];
#pragma unroll
    for (int j = 0; j < 4; ++j) pv[j] = __shfl_xor(v[j], LH);
    if (sl < 2 * LH) {
        const bool first = sl < LH; const int i0 = (sl & (LH - 1)) * 4;
#pragma unroll
        for (int j = 0; j < 4; ++j) {
            constexpr float I4[4] = {1.0f, 0.03760603070259094f, 0.0014142135623842478f, 5.318296098266728e-05f};
            constexpr float I8[8] = {1.0f, 0.1939227432012558f, 0.03760603070259094f, 0.007292664609849453f, 0.0014142135623842478f, 0.00027424818836152554f, 5.318296098266728e-05f, 1.0313386155758053e-05f};
            const float inv = (HALF == 4) ? I4[j] : (i0 ? I8[4 + j] : I8[j]);
            float sn, cs; sincos_red(pos * inv, sn, cs);
            v[j] = first ? (v[j] * cs - pv[j] * sn) : (pv[j] * sn + v[j] * cs);
        }
    }
}
__device__ __forceinline__ void prep_phase(const Params& p, int l, int gw, int ngw, int lane) {
    bf16* Z = (bf16*)(p.ws + WS_BIG); float* ZS = (float*)(p.ws + WS_ZS); bf16* IK = (bf16*)(p.ws + WS_IK);
    const float* dg = p.diff_qk_norm + l * 64; const float* sg = p.dsa_qk_norm + l * 128;
    for (int tok = gw; tok < T; tok += ngw) {
        const float pos = (float)p.pos[tok];
#pragma unroll
        for (int which = 0; which < 2; ++which) {
            unsigned long long* ptr = (unsigned long long*)(Z + (size_t)tok * ZP + which * 256) + lane;
            const unsigned long long w = *ptr; float v[4] = {bflo((unsigned)w), bfhi((unsigned)w), bflo((unsigned)(w >> 32)), bfhi((unsigned)(w >> 32))};
            float ss = (v[0] * v[0] + v[1] * v[1]) + (v[2] * v[2] + v[3] * v[3]);
            ss += __shfl_xor(ss, 1); ss += __shfl_xor(ss, 2); ss += __shfl_xor(ss, 4);
            const float r = 1.f / sqrtf(ss * (1.f / 32.f) + EPS);
            const f32x4 g = *(const f32x4*)(dg + which * 32 + (lane & 7) * 4);
#pragma unroll
            for (int j = 0; j < 4; ++j) v[j] = v[j] * r * g[j];
            rope4<4>(v, lane & 7, pos);
            if (which == 0) {
#pragma unroll
                for (int j = 0; j < 4; ++j) v[j] *= 0.17677669529663687f;
            }
            *ptr = (unsigned long long)pk2(v[0], v[1]) | ((unsigned long long)pk2(v[2], v[3]) << 32);
        }
        {
            unsigned long long* ptr = (unsigned long long*)(Z + (size_t)tok * ZP + 2560) + lane;
            const unsigned long long w = *ptr; float v[4] = {bflo((unsigned)w), bfhi((unsigned)w), bflo((unsigned)(w >> 32)), bfhi((unsigned)(w >> 32))};
            float ss = (v[0] * v[0] + v[1] * v[1]) + (v[2] * v[2] + v[3] * v[3]);
            ss += __shfl_xor(ss, 1); ss += __shfl_xor(ss, 2); ss += __shfl_xor(ss, 4); ss += __shfl_xor(ss, 8);
            const float r = 1.f / sqrtf(ss * (1.f / 64.f) + EPS);
            const f32x4 g = *(const f32x4*)(sg + (lane & 15) * 4);
#pragma unroll
            for (int j = 0; j < 4; ++j) v[j] = v[j] * r * g[j];
            rope4<8>(v, lane & 15, pos);
#pragma unroll
            for (int j = 0; j < 4; ++j) v[j] *= 0.125f;
            *ptr = (unsigned long long)pk2(v[0], v[1]) | ((unsigned long long)pk2(v[2], v[3]) << 32);
        }
        {
            unsigned long long* ptr = (unsigned long long*)(Z + (size_t)tok * ZP + 2816) + lane;
            const unsigned long long w = *ptr; float v[4] = {bflo((unsigned)w), bfhi((unsigned)w), bflo((unsigned)(w >> 32)), bfhi((unsigned)(w >> 32))};
            rope4<4>(v, lane & 7, pos);
            *ptr = (unsigned long long)pk2(v[0], v[1]) | ((unsigned long long)pk2(v[2], v[3]) << 32);
        }
        {
            float* ptr = ZS + (size_t)tok * ZSP + (lane & 15) * 4;
            const f32x4 x = *(const f32x4*)ptr; float v[4] = {x[0], x[1], x[2], x[3]};
            float ss = (v[0] * v[0] + v[1] * v[1]) + (v[2] * v[2] + v[3] * v[3]);
            ss += __shfl_xor(ss, 1); ss += __shfl_xor(ss, 2); ss += __shfl_xor(ss, 4); ss += __shfl_xor(ss, 8);
            const float r = 1.f / sqrtf(ss * (1.f / 64.f) + EPS);
            const f32x4 g = *(const f32x4*)(sg + 64 + (lane & 15) * 4);
#pragma unroll
            for (int j = 0; j < 4; ++j) v[j] = v[j] * r * g[j];
            rope4<8>(v, lane & 15, pos);
            if (lane < 16) *(f32x4*)ptr = (f32x4){v[0], v[1], v[2], v[3]};
        }
        {
            const float* ptr = ZS + (size_t)tok * ZSP + 128 + (lane & 7) * 4;
            const f32x4 x = *(const f32x4*)ptr; float v[4] = {x[0], x[1], x[2], x[3]};
            rope4<4>(v, lane & 7, pos);
            if (lane < 8) *((unsigned long long*)(IK + (size_t)tok * 32) + lane) = (unsigned long long)pk2(v[0], v[1]) | ((unsigned long long)pk2(v[2], v[3]) << 32);
        }
    }
}
__device__ __forceinline__ void mlstm_item(const Params& p, int l, int bh, LAS unsigned char* lds, int wv) {
    const int tid = tid_fresh(wv), lane = tid & 63, b = bh >> 2, h = bh & 3;
    const bf16* Z = (const bf16*)(p.ws + WS_BIG); const float* ZS = (const float*)(p.ws + WS_ZS); bf16* O1 = (bf16*)(p.ws + WS_O + OB_STRIDE);
    LAS float* nv = (LAS float*)lds; LAS float* bc = nv + 64; LAS float* igs = bc + 64; LAS float* wks = igs + 64; LAS float* sc = wks + 64;
    LAS float* Qs = sc + 64; LAS float* Ks = Qs + 64 * 65; LAS float* Vs = Ks + 64 * 65; LAS float* Ss = Vs + 64 * 65; LAS float* Cs = Ss + 64 * 65;
    for (int i = tid; i < 64 * 65; i += NTHR) Cs[i] = 0.f;
    if (tid < 64) nv[tid] = 0.f;
    float mcar = 0.f;
    const int r = tid >> 3, sg = tid & 7;
    const int cc0 = sg * 16; const int ch0 = (cc0 < 64) ? (h * 64 + cc0) : (256 + h * 64 + cc0 - 64);
    const float* cw0 = p.ml_conv_w + (size_t)l * 4 * 512; const float* cb0 = p.ml_conv_b + (size_t)l * 512;
    const int zc0 = (cc0 < 64) ? (768 + h * 64 + cc0) : (1024 + h * 64 + cc0 - 64);
    const float gb_i = p.ml_gate_bias[(l * 2 + 0) * 4 + h], gb_f = p.ml_gate_bias[(l * 2 + 1) * 4 + h];
    const float qsc = (cc0 < 64) ? 0.125f : 1.0f;
    __syncthreads();
    for (int c = 0; c < 64; ++c) {
        const int t0 = c * 64; const size_t tok0 = (size_t)b * SEQ + t0;
        const float* cw = cw0; const float* cb = cb0; asm volatile("" : "+s"(cw), "+s"(cb));
        {
            float y[16];
#pragma unroll
            for (int i = 0; i < 16; ++i) y[i] = cb[ch0 + i];
#pragma unroll
            for (int j = 0; j < 4; ++j) {
                const int tt = t0 + r - 3 + j;
                if (tt >= 0) {
                    const u32x4* xp = (const u32x4*)(Z + ((size_t)b * SEQ + tt) * ZP + zc0); const u32x4 x0 = xp[0], x1 = xp[1];
                    const float xv[16] = {bflo(x0.x), bfhi(x0.x), bflo(x0.y), bfhi(x0.y), bflo(x0.z), bfhi(x0.z), bflo(x0.w), bfhi(x0.w),
                                          bflo(x1.x), bfhi(x1.x), bflo(x1.y), bfhi(x1.y), bflo(x1.z), bfhi(x1.z), bflo(x1.w), bfhi(x1.w)};
#pragma unroll
                    for (int i = 0; i < 16; ++i) y[i] = fmaf(cw[j * 512 + ch0 + i], xv[i], y[i]);
                }
            }
            LAS float* dst = (cc0 < 64) ? (Qs + r * 65 + cc0) : (Ks + r * 65 + cc0 - 64);
#pragma unroll
            for (int i = 0; i < 16; ++i) dst[i] = y[i] * sigmoidf_(y[i]) * qsc;
            const u32x4 vv = *(const u32x4*)(Z + (tok0 + r) * ZP + 1280 + h * 64 + sg * 8);
            LAS float* vd = Vs + r * 65 + sg * 8;
            vd[0] = bflo(vv.x); vd[1] = bfhi(vv.x); vd[2] = bflo(vv.y); vd[3] = bfhi(vv.y); vd[4] = bflo(vv.z); vd[5] = bfhi(vv.z); vd[6] = bflo(vv.w); vd[7] = bfhi(vv.w);
        }
        if (tid < 64) {
            const float ig = ZS[(tok0 + tid) * ZSP + 168 + h] + gb_i;
            const float fz = ZS[(tok0 + tid) * ZSP + 172 + h] + gb_f;
            const float lf = fminf(fz, 0.f) - log1pf(__expf(-fabsf(fz)));
            float bsum = lf;
#pragma unroll
            for (int d = 1; d < 64; d <<= 1) { const float n = __shfl_up(bsum, d); if (lane >= d) bsum += n; }
            const float bl = __shfl(bsum, 63);
            const float g = bl - bsum + ig;
            const float mnew = fmaxf(bl + mcar, wave_max(g));
            bc[tid] = bsum; igs[tid] = ig; wks[tid] = __expf(g - mnew);
            if (tid == 0) { sc[0] = mnew; sc[1] = __expf(bl + mcar - mnew); sc[2] = bl; }
        }
        __syncthreads();
        const float bt = bc[r];
        float mx = -INFINITY;
#pragma unroll
        for (int i = 0; i < 8; ++i) { const int s = sg * 8 + i; const float dli = (s <= r) ? (bt - bc[s] + igs[s]) : -INFINITY; mx = fmaxf(mx, dli); }
        mx = fmaxf(mx, __shfl_xor(mx, 1)); mx = fmaxf(mx, __shfl_xor(mx, 2)); mx = fmaxf(mx, __shfl_xor(mx, 4));
        const float inter = bt + mcar; const float mt = fmaxf(inter, mx); const float iw = __expf(inter - mt);
        float ssum = 0.f;
#pragma unroll 1
        for (int i = 0; i < 8; ++i) { const int s = sg * 8 + i; float dot = 0.f;
#pragma unroll 16
            for (int d = 0; d < 64; ++d) dot = fmaf(Qs[r * 65 + d], Ks[s * 65 + d], dot);
            const float dli = (s <= r) ? (bt - bc[s] + igs[s]) : -INFINITY;
            const float sv = dot * __expf(dli - mt); Ss[r * 65 + s] = sv; ssum += sv; }
        ssum += __shfl_xor(ssum, 1); ssum += __shfl_xor(ssum, 2); ssum += __shfl_xor(ssum, 4);
        float qn = 0.f;
#pragma unroll
        for (int d = 0; d < 64; ++d) qn = fmaf(Qs[r * 65 + d], nv[d], qn);
        const float den = iw * qn + ssum;
        __syncthreads();
        {
            float num[8];
#pragma unroll
            for (int i = 0; i < 8; ++i) num[i] = 0.f;
#pragma unroll 8
            for (int d = 0; d < 64; ++d) { const float qd = Qs[r * 65 + d];
#pragma unroll
                for (int i = 0; i < 8; ++i) num[i] = fmaf(qd, Cs[d * 65 + sg * 8 + i], num[i]); }
#pragma unroll
            for (int i = 0; i < 8; ++i) num[i] *= iw;
#pragma unroll 8
            for (int s = 0; s < 64; ++s) { const float sv = Ss[r * 65 + s];
#pragma unroll
                for (int i = 0; i < 8; ++i) num[i] = fmaf(sv, Vs[s * 65 + sg * 8 + i], num[i]); }
            const float dn = 1.f / fmaxf(fabsf(den), __expf(-mt));
            float hs = 0.f;
#pragma unroll
            for (int i = 0; i < 8; ++i) { num[i] *= dn; hs = fmaf(num[i], num[i], hs); }
            hs += __shfl_xor(hs, 1); hs += __shfl_xor(hs, 2); hs += __shfl_xor(hs, 4);
            const float rr = 1.f / sqrtf(hs * (1.f / 64.f) + EPS);
            const u32x4 og = *(const u32x4*)(Z + (tok0 + r) * ZP + 1536 + h * 64 + sg * 8);
            const float ogv[8] = {bflo(og.x), bfhi(og.x), bflo(og.y), bfhi(og.y), bflo(og.z), bfhi(og.z), bflo(og.w), bfhi(og.w)};
            const float* hg = p.ml_head_norm + l * 64 + sg * 8;
            float o[8];
#pragma unroll
            for (int i = 0; i < 8; ++i) o[i] = sigmoidf_(ogv[i]) * (num[i] * rr * hg[i]);
            u32x4 w; w.x = pk2(o[0], o[1]); w.y = pk2(o[2], o[3]); w.z = pk2(o[4], o[5]); w.w = pk2(o[6], o[7]);
            *(u32x4*)(O1 + (tok0 + r) * 256 + h * 64 + sg * 8) = w;
        }
        __syncthreads();
        {
            const float decay = sc[1];
            float cacc[8]; float nacc = 0.f;
#pragma unroll
            for (int i = 0; i < 8; ++i) cacc[i] = 0.f;
#pragma unroll 8
            for (int s = 0; s < 64; ++s) { const float kw = wks[s] * Ks[s * 65 + r]; nacc += kw;
#pragma unroll
                for (int i = 0; i < 8; ++i) cacc[i] = fmaf(kw, Vs[s * 65 + sg * 8 + i], cacc[i]); }
#pragma unroll
            for (int i = 0; i < 8; ++i) Cs[r * 65 + sg * 8 + i] = decay * Cs[r * 65 + sg * 8 + i] + cacc[i];
            if (sg == 0) nv[r] = decay * nv[r] + nacc;
            mcar = sc[0];
        }
        __syncthreads();
    }
}

__device__ __forceinline__ void diff_item(const Params& p, int l, int bh, int qt, LAS unsigned char* lds, int wv) {
    const int tid = tid_fresh(wv), b = bh >> 2, h = bh & 3, q0 = qt * 128;
    const bf16* Z = (const bf16*)(p.ws + WS_BIG); bf16* O0 = (bf16*)(p.ws + WS_O);
    LAS float* Kt = (LAS float*)lds; LAS float* Vt = Kt + 64 * 64;
    const int ql = tid >> 2, part = tid & 3, c = part & 1, dvh = part >> 1, t = q0 + ql; const size_t tok = (size_t)b * SEQ + t;
    const float* lp = p.diff_lambda + l * 128; float s01 = 0.f, s23 = 0.f, gqm = 0.f, gkm = 0.f;
#pragma unroll 2
    for (int i = 0; i < 32; ++i) { s01 = fmaf(lp[i], lp[32 + i], s01); s23 = fmaf(lp[64 + i], lp[96 + i], s23);
        gqm = fmaxf(gqm, fabsf(p.diff_qk_norm[l * 64 + i])); gkm = fmaxf(gkm, fabsf(p.diff_qk_norm[l * 64 + 32 + i])); }
    const float lam_init = 0.8f - 0.6f * __expf(-0.3f * (float)l); const float lam = __expf(s01) - __expf(s23) + lam_init;
    const float coff = 5.65685424949238f * gqm * gkm;
    float q[32], o[32];
    { const u32x4* qp = (const u32x4*)(Z + tok * ZP + h * 64 + c * 32);
#pragma unroll
      for (int i = 0; i < 4; ++i) { const u32x4 w = qp[i]; q[8 * i] = bflo(w.x); q[8 * i + 1] = bfhi(w.x); q[8 * i + 2] = bflo(w.y); q[8 * i + 3] = bfhi(w.y); q[8 * i + 4] = bflo(w.z); q[8 * i + 5] = bfhi(w.z); q[8 * i + 6] = bflo(w.w); q[8 * i + 7] = bfhi(w.w); } }
#pragma unroll
    for (int i = 0; i < 32; ++i) o[i] = 0.f;
    float lsum = 0.f;
    const int nkt = (q0 + 128) / 64;
    const int lk = tid >> 3, lsg = tid & 7;
    for (int kt = 0; kt < nkt; ++kt) {
        __syncthreads();
        { const size_t ktok = (size_t)b * SEQ + kt * 64 + lk;
          const bf16* src = Z + ktok * ZP + ((lsg < 4) ? (256 + h * 64 + lsg * 16) : (512 + h * 64 + (lsg - 4) * 16));
          const u32x4 x0 = ((const u32x4*)src)[0], x1 = ((const u32x4*)src)[1];
          LAS float* dst = ((lsg < 4) ? (Kt + lk * 64 + lsg * 16) : (Vt + lk * 64 + (lsg - 4) * 16));
          *(LAS f32x4*)(dst) = (f32x4){bflo(x0.x), bfhi(x0.x), bflo(x0.y), bfhi(x0.y)}; *(LAS f32x4*)(dst + 4) = (f32x4){bflo(x0.z), bfhi(x0.z), bflo(x0.w), bfhi(x0.w)};
          *(LAS f32x4*)(dst + 8) = (f32x4){bflo(x1.x), bfhi(x1.x), bflo(x1.y), bfhi(x1.y)}; *(LAS f32x4*)(dst + 12) = (f32x4){bflo(x1.z), bfhi(x1.z), bflo(x1.w), bfhi(x1.w)}; }
        __syncthreads();
        const int kmax = t - kt * 64 + 1;
        for (int key = 0; key < 64; ++key) {
            const LAS f32x4* kr = (const LAS f32x4*)(Kt + key * 64 + c * 32);
            float s = 0.f;
#pragma unroll
            for (int i = 0; i < 8; ++i) { const f32x4 kv = kr[i]; s = fmaf(q[4 * i], kv[0], s); s = fmaf(q[4 * i + 1], kv[1], s); s = fmaf(q[4 * i + 2], kv[2], s); s = fmaf(q[4 * i + 3], kv[3], s); }
            const float pe = (key < kmax) ? __expf(s - coff) : 0.f;
            lsum += pe;
            const LAS f32x4* vr = (const LAS f32x4*)(Vt + key * 64 + dvh * 32);
#pragma unroll
            for (int i = 0; i < 8; ++i) { const f32x4 vv = vr[i]; o[4 * i] = fmaf(pe, vv[0], o[4 * i]); o[4 * i + 1] = fmaf(pe, vv[1], o[4 * i + 1]); o[4 * i + 2] = fmaf(pe, vv[2], o[4 * i + 2]); o[4 * i + 3] = fmaf(pe, vv[3], o[4 * i + 3]); }
        }
    }
    const float inv = 1.f / lsum; float ss = 0.f;
#pragma unroll
    for (int i = 0; i < 32; ++i) { const float my = o[i] * inv; const float ot = __shfl_xor(my, 1); o[i] = (c == 0) ? (my - lam * ot) : (ot - lam * my); ss = fmaf(o[i], o[i], ss); }
    ss += __shfl_xor(ss, 2);
    const float rr = (1.f - lam_init) / sqrtf(ss * (1.f / 64.f) + EPS);
    if (c == 0) {
        const float* hg = p.diff_head_norm + l * 64 + dvh * 32; u32x4* dst = (u32x4*)(O0 + tok * 256 + h * 64 + dvh * 32);
#pragma unroll
        for (int i = 0; i < 4; ++i) { u32x4 w; w.x = pk2(o[8 * i] * rr * hg[8 * i], o[8 * i + 1] * rr * hg[8 * i + 1]); w.y = pk2(o[8 * i + 2] * rr * hg[8 * i + 2], o[8 * i + 3] * rr * hg[8 * i + 3]);
            w.z = pk2(o[8 * i + 4] * rr * hg[8 * i + 4], o[8 * i + 5] * rr * hg[8 * i + 5]); w.w = pk2(o[8 * i + 6] * rr * hg[8 * i + 6], o[8 * i + 7] * rr * hg[8 * i + 7]); dst[i] = w; }
    }
    __syncthreads();
}

__device__ __forceinline__ unsigned pkbf(float lo, float hi) { unsigned r; asm("v_cvt_pk_bf16_f32 %0, %1, %2" : "=v"(r) : "v"(lo), "v"(hi)); return r; }
__device__ __forceinline__ void diffm_item(const Params& p, int l, int bh, int qb, LAS unsigned char* lds, int wv) {
    const int tid = tid_fresh(wv), lane = tid & 63, half = lane >> 5, r32 = lane & 31, b = bh >> 2, h = bh & 3;
    const bf16* Z = (const bf16*)(p.ws + WS_BIG); bf16* O0 = (bf16*)(p.ws + WS_O);
    LAS bf16* Ks = (LAS bf16*)lds; LAS bf16* Vt = Ks + 64 * 72;
    const float* lp = p.diff_lambda + l * 128; float s01 = 0.f, s23 = 0.f, gqm = 0.f, gkm = 0.f;
#pragma unroll 2
    for (int i = 0; i < 32; ++i) { s01 = fmaf(lp[i], lp[32 + i], s01); s23 = fmaf(lp[64 + i], lp[96 + i], s23);
        gqm = fmaxf(gqm, fabsf(p.diff_qk_norm[l * 64 + i])); gkm = fmaxf(gkm, fabsf(p.diff_qk_norm[l * 64 + 32 + i])); }
    const float lam_init = 0.8f - 0.6f * __expf(-0.3f * (float)l); const float lam = __expf(s01) - __expf(s23) + lam_init;
    const float coff = 5.65685424949238f * gqm * gkm;
    const int qw = qb * 256 + 32 * wv;
    const size_t tokb = (size_t)b * SEQ;
    s16x8 qf[2][2];
    { const bf16* qp = Z + (tokb + qw + r32) * ZP + h * 64 + half * 8;
#pragma unroll
      for (int c = 0; c < 2; ++c)
#pragma unroll
          for (int s = 0; s < 2; ++s) qf[c][s] = *(const s16x8*)(qp + c * 32 + 16 * s); }
    f32x16 oacc[2][2];
#pragma unroll
    for (int c = 0; c < 2; ++c)
#pragma unroll
        for (int db = 0; db < 2; ++db)
#pragma unroll
            for (int r = 0; r < 16; ++r) oacc[c][db][r] = 0.f;
    float ls0 = 0.f, ls1 = 0.f;
    const int nt = (qb + 1) * 4;
    const int kkey = tid >> 3, kch = tid & 7, vkey = tid & 63, vdc = tid >> 6;
    const bf16* kgp = Z + (tokb + kkey) * ZP + 256 + h * 64 + kch * 8;
    const bf16* vgp = Z + (tokb + vkey) * ZP + 512 + h * 64 + vdc * 8;
    u32x4 kreg = *(const u32x4*)kgp, vreg = *(const u32x4*)vgp;
#pragma unroll 1
    for (int t = 0; t < nt; ++t) {
        __syncthreads();
        *(LAS u32x4*)(Ks + kkey * 72 + kch * 8) = kreg;
        { LAS bf16* vd = Vt + (vdc * 8) * 72 + vkey;
          vd[0] = (bf16)(vreg.x & 0xffffu); vd[72] = (bf16)(vreg.x >> 16); vd[144] = (bf16)(vreg.y & 0xffffu); vd[216] = (bf16)(vreg.y >> 16);
          vd[288] = (bf16)(vreg.z & 0xffffu); vd[360] = (bf16)(vreg.z >> 16); vd[432] = (bf16)(vreg.w & 0xffffu); vd[504] = (bf16)(vreg.w >> 16); }
        __syncthreads();
        if (t + 1 < nt) { kreg = *(const u32x4*)(kgp + (size_t)(t + 1) * 64 * ZP); vreg = *(const u32x4*)(vgp + (size_t)(t + 1) * 64 * ZP); }
        const int k0 = t * 64;
#pragma unroll 1
        for (int sub = 0; sub < 2; ++sub) {
            const int kb = k0 + 32 * sub;
            if (kb <= qw + 31) {
                f32x16 s0, s1;
#pragma unroll
                for (int r = 0; r < 16; ++r) { s0[r] = 0.f; s1[r] = 0.f; }
                const LAS bf16* kr = Ks + (32 * sub + r32) * 72 + 8 * half;
#pragma unroll
                for (int s = 0; s < 2; ++s) {
                    const s16x8 a0 = *(const LAS s16x8*)(kr + 16 * s), a1 = *(const LAS s16x8*)(kr + 32 + 16 * s);
                    s0 = __builtin_amdgcn_mfma_f32_32x32x16_bf16(a0, qf[0][s], s0, 0, 0, 0);
                    s1 = __builtin_amdgcn_mfma_f32_32x32x16_bf16(a1, qf[1][s], s1, 0, 0, 0);
                }
                const bool diag = (kb + 31 > qw);
#pragma unroll
                for (int r = 0; r < 16; ++r) {
                    float p0 = __expf(s0[r] - coff), p1 = __expf(s1[r] - coff);
                    if (diag) { const int key = kb + 8 * (r >> 2) + 4 * half + (r & 3); if (key > qw + r32) { p0 = 0.f; p1 = 0.f; } }
                    ls0 += p0; ls1 += p1; s0[r] = p0; s1[r] = p1;
                }
#pragma unroll
                for (int s = 0; s < 2; ++s) {
                    u32x4 w0, w1;
                    w0.x = pkbf(s0[8 * s], s0[8 * s + 1]); w0.y = pkbf(s0[8 * s + 2], s0[8 * s + 3]); w0.z = pkbf(s0[8 * s + 4], s0[8 * s + 5]); w0.w = pkbf(s0[8 * s + 6], s0[8 * s + 7]);
                    w1.x = pkbf(s1[8 * s], s1[8 * s + 1]); w1.y = pkbf(s1[8 * s + 2], s1[8 * s + 3]); w1.z = pkbf(s1[8 * s + 4], s1[8 * s + 5]); w1.w = pkbf(s1[8 * s + 6], s1[8 * s + 7]);
                    const s16x8 pf0 = __builtin_bit_cast(s16x8, w0), pf1 = __builtin_bit_cast(s16x8, w1);
#pragma unroll
                    for (int db = 0; db < 2; ++db) {
                        const LAS bf16* vr = Vt + (db * 32 + r32) * 72 + 32 * sub + 16 * s + 4 * half;
                        const u32x2 v0 = *(const LAS u32x2*)vr, v1 = *(const LAS u32x2*)(vr + 8);
                        const u32x4 vv = (u32x4){v0.x, v0.y, v1.x, v1.y};
                        const s16x8 vf = __builtin_bit_cast(s16x8, vv);
                        oacc[0][db] = __builtin_amdgcn_mfma_f32_32x32x16_bf16(vf, pf0, oacc[0][db], 0, 0, 0);
                        oacc[1][db] = __builtin_amdgcn_mfma_f32_32x32x16_bf16(vf, pf1, oacc[1][db], 0, 0, 0);
                    }
                }
            }
        }
    }
    ls0 += __shfl_xor(ls0, 32); ls1 += __shfl_xor(ls1, 32);
    const float i0 = 1.f / ls0, i1 = lam / ls1;
    float ss = 0.f;
#pragma unroll
    for (int db = 0; db < 2; ++db)
#pragma unroll
        for (int r = 0; r < 16; ++r) { const float v = oacc[0][db][r] * i0 - oacc[1][db][r] * i1; oacc[0][db][r] = v; ss = fmaf(v, v, ss); }
    ss += __shfl_xor(ss, 32);
    const float rr = (1.f - lam_init) / sqrtf(ss * (1.f / 64.f) + EPS);
    const float* hg = p.diff_head_norm + l * 64;
    bf16* orow = O0 + (tokb + qw + r32) * 256 + h * 64;
#pragma unroll
    for (int db = 0; db < 2; ++db)
#pragma unroll
        for (int g = 0; g < 4; ++g) { const int d0 = db * 32 + 8 * g + 4 * half; const f32x4 gg = *(const f32x4*)(hg + d0);
            u32x2 w; w.x = pkbf(oacc[0][db][4 * g] * rr * gg[0], oacc[0][db][4 * g + 1] * rr * gg[1]); w.y = pkbf(oacc[0][db][4 * g + 2] * rr * gg[2], oacc[0][db][4 * g + 3] * rr * gg[3]);
            *(u32x2*)(orow + d0) = w; }
    __syncthreads();
}

__device__ __forceinline__ void sb_item(const Params& p, int bh, int g, LAS unsigned char* lds, int wv) {
    const int tid = tid_fresh(wv), lane = tid & 63, w = tid >> 6, b = bh >> 2, h = bh & 3;
    const bf16* Z = (const bf16*)(p.ws + WS_BIG); bf16* O2 = (bf16*)(p.ws + WS_O + 2 * OB_STRIDE);
    LAS float* KV = (LAS float*)lds + w * 4096;
    const int t0 = g * 512 + w * 64, t = t0 + lane; const size_t tok = (size_t)b * SEQ + t;
    float q[64], o[64];
    { const u32x4* qp = (const u32x4*)(Z + tok * ZP + 1792 + h * 64);
#pragma unroll
      for (int i = 0; i < 8; ++i) { const u32x4 x = qp[i]; q[8 * i] = bflo(x.x); q[8 * i + 1] = bfhi(x.x); q[8 * i + 2] = bflo(x.y); q[8 * i + 3] = bfhi(x.y); q[8 * i + 4] = bflo(x.z); q[8 * i + 5] = bfhi(x.z); q[8 * i + 6] = bflo(x.w); q[8 * i + 7] = bfhi(x.w); } }
#pragma unroll
    for (int i = 0; i < 64; ++i) o[i] = 0.f;
    float R = 0.f;
    const int lkey = lane >> 1, lhalf = lane & 1;
    for (int slo = t0 + 32; slo >= 0; slo -= 32) {
        asm volatile("s_waitcnt lgkmcnt(0)" ::: "memory");
        { const size_t ktok = (size_t)b * SEQ + slo + lkey;
          const u32x4* ks = (const u32x4*)(Z + ktok * ZP + 2048 + h * 64 + lhalf * 32); const u32x4* vs = (const u32x4*)(Z + ktok * ZP + 2304 + h * 64 + lhalf * 32);
          LAS float* kd = KV + lkey * 128 + lhalf * 32; LAS float* vd = kd + 64;
#pragma unroll
          for (int i = 0; i < 4; ++i) { const u32x4 x = ks[i]; *(LAS f32x4*)(kd + 8 * i) = (f32x4){bflo(x.x), bfhi(x.x), bflo(x.y), bfhi(x.y)}; *(LAS f32x4*)(kd + 8 * i + 4) = (f32x4){bflo(x.z), bfhi(x.z), bflo(x.w), bfhi(x.w)}; }
#pragma unroll
          for (int i = 0; i < 4; ++i) { const u32x4 x = vs[i]; *(LAS f32x4*)(vd + 8 * i) = (f32x4){bflo(x.x), bfhi(x.x), bflo(x.y), bfhi(x.y)}; *(LAS f32x4*)(vd + 8 * i + 4) = (f32x4){bflo(x.z), bfhi(x.z), bflo(x.w), bfhi(x.w)}; } }
        asm volatile("s_waitcnt lgkmcnt(0)" ::: "memory");
        for (int kk = 31; kk >= 0; --kk) {
            const int s = slo + kk; const bool act = s < t;
            const LAS f32x4* kr = (const LAS f32x4*)(KV + kk * 128);
            float z = 0.f;
#pragma unroll
            for (int i = 0; i < 16; ++i) { const f32x4 kv = kr[i]; z = fmaf(q[4 * i], kv[0], z); z = fmaf(q[4 * i + 1], kv[1], z); z = fmaf(q[4 * i + 2], kv[2], z); z = fmaf(q[4 * i + 3], kv[3], z); }
            z *= 0.125f;
            const float lb = fminf(z, 0.f) - __logf(1.f + __expf(-fabsf(z)));
            const float a = act ? __expf(lb + R) : 0.f;
            R += act ? (lb - z) : 0.f;
#pragma unroll
            for (int i = 0; i < 16; ++i) { const f32x4 vv = kr[16 + i]; o[4 * i] = fmaf(a, vv[0], o[4 * i]); o[4 * i + 1] = fmaf(a, vv[1], o[4 * i + 1]); o[4 * i + 2] = fmaf(a, vv[2], o[4 * i + 2]); o[4 * i + 3] = fmaf(a, vv[3], o[4 * i + 3]); }
        }
        if (__all(R < -104.f)) break;
    }
    u32x4* dst = (u32x4*)(O2 + tok * 256 + h * 64);
#pragma unroll
    for (int i = 0; i < 8; ++i) { u32x4 x; x.x = pk2(o[8 * i], o[8 * i + 1]); x.y = pk2(o[8 * i + 2], o[8 * i + 3]); x.z = pk2(o[8 * i + 4], o[8 * i + 5]); x.w = pk2(o[8 * i + 6], o[8 * i + 7]); dst[i] = x; }
    asm volatile("s_waitcnt lgkmcnt(0)" ::: "memory");
}
__device__ __forceinline__ unsigned mono_bits(float s) { s = (s == 0.f) ? 0.f : s; const unsigned u = __float_as_uint(s); return (u & 0x80000000u) ? ~u : (u | 0x80000000u); }
__device__ __forceinline__ void dsa_item(const Params& p, int b, int qt, LAS unsigned char* lds, int wv) {
    const int tid = tid_fresh(wv), lane = tid & 63, w = tid >> 6, half = lane >> 5, r32 = lane & 31;
    const bf16* Z = (const bf16*)(p.ws + WS_BIG); const float* ZS = (const float*)(p.ws + WS_ZS); const bf16* IK = (const bf16*)(p.ws + WS_IK); bf16* O3 = (bf16*)(p.ws + WS_O + 3 * OB_STRIDE);
    LAS unsigned* hist = (LAS unsigned*)lds + w * 1024;
    LAS int* list = (LAS int*)(lds + 32768) + w * 1024;
    LAS float* qs = (LAS float*)(lds + 65536) + w * 256;
    LAS float* P = (LAS float*)(lds + 98304) + w * 1024;
    const size_t tokb = (size_t)b * SEQ; const int tb = qt * 32 + 4 * w;
    const int ntiles = ((tb + 3) >> 5) + 1;
    s16x8 aq0, aq1;
    { const bf16* ap = Z + (tokb + tb + (r32 >> 3)) * ZP + 2816 + (r32 & 7) * 32 + half * 8; aq0 = *(const s16x8*)ap; aq1 = *(const s16x8*)(ap + 16); }
    float wq[4][4];
#pragma unroll
    for (int g = 0; g < 4; ++g) { const f32x4 x = *(const f32x4*)(ZS + (tokb + tb + g) * ZSP + 160 + 4 * half); wq[g][0] = x[0]; wq[g][1] = x[1]; wq[g][2] = x[2]; wq[g][3] = x[3]; }
    unsigned tau[4] = {0u, 0u, 0u, 0u}; int quota[4] = {1 << 30, 1 << 30, 1 << 30, 1 << 30};
#define DSA_SCORES(kt, sc) do { const bf16* kp_ = IK + (tokb + (size_t)(kt) * 32 + r32) * 32 + half * 8; \
        const s16x8 b0_ = *(const s16x8*)kp_, b1_ = *(const s16x8*)(kp_ + 16); f32x16 a_ = {0.f, 0.f, 0.f, 0.f, 0.f, 0.f, 0.f, 0.f, 0.f, 0.f, 0.f, 0.f, 0.f, 0.f, 0.f, 0.f}; \
        a_ = __builtin_amdgcn_mfma_f32_32x32x16_bf16(aq0, b0_, a_, 0, 0, 0); a_ = __builtin_amdgcn_mfma_f32_32x32x16_bf16(aq1, b1_, a_, 0, 0, 0); \
        _Pragma("unroll") for (int g_ = 0; g_ < 4; ++g_) { float pt_ = wq[g_][0] * fmaxf(a_[4 * g_], 0.f); pt_ = fmaf(wq[g_][1], fmaxf(a_[4 * g_ + 1], 0.f), pt_); \
            pt_ = fmaf(wq[g_][2], fmaxf(a_[4 * g_ + 2], 0.f), pt_); pt_ = fmaf(wq[g_][3], fmaxf(a_[4 * g_ + 3], 0.f), pt_); sc[g_] = pt_ + __shfl_xor(pt_, 32); } } while (0)
    if (tb >= 256) {
        unsigned prefix[4] = {0u, 0u, 0u, 0u}; int krem[4] = {256, 256, 256, 256}; int cnteq[4] = {0, 0, 0, 0};
#pragma unroll 1
        for (int pass = 0; pass < 4; ++pass) {
            const int shift = 24 - 8 * pass;
#pragma unroll
            for (int i = 0; i < 4; ++i) *(LAS u32x4*)(hist + (i * 64 + lane) * 4) = (u32x4){0u, 0u, 0u, 0u};
            LDS_WAIT();
            const unsigned pfa = half ? prefix[2] : prefix[0], pfb = half ? prefix[3] : prefix[1];
            const int ta = tb + 2 * half, tbq = ta + 1;
#pragma unroll 1
            for (int kt = 0; kt < ntiles; ++kt) {
                float sc[4]; DSA_SCORES(kt, sc);
                const int key = kt * 32 + r32;
                const unsigned ma = mono_bits(half ? sc[2] : sc[0]), mb = mono_bits(half ? sc[3] : sc[1]);
                const bool oka = (key <= ta) && (pass == 0 || (ma >> (shift + 8)) == pfa);
                const bool okb = (key <= tbq) && (pass == 0 || (mb >> (shift + 8)) == pfb);
                if (oka) atomicAdd((unsigned*)(hist + (2 * half) * 256 + ((ma >> shift) & 255u)), 1u);
                if (okb) atomicAdd((unsigned*)(hist + (2 * half + 1) * 256 + ((mb >> shift) & 255u)), 1u);
            }
            LDS_WAIT();
#pragma unroll
            for (int g = 0; g < 4; ++g) {
                const u32x4 cv = *(const LAS u32x4*)(hist + g * 256 + lane * 4);
                const int c0 = (int)cv.x, c1 = (int)cv.y, c2 = (int)cv.z, c3 = (int)cv.w, tot = c0 + c1 + c2 + c3;
                int v = tot;
#pragma unroll
                for (int d = 1; d < 64; d <<= 1) { const int n = __shfl_down(v, d); if (lane + d < 64) v += n; }
                const int a3 = v - tot, a2 = a3 + c3, a1 = a2 + c2, a0 = a1 + c1; const int k = krem[g];
                int fb = -1, fa = 0, fc = 0;
                if (a3 < k && a3 + c3 >= k) { fb = 3; fa = a3; fc = c3; }
                else if (a2 < k && a2 + c2 >= k) { fb = 2; fa = a2; fc = c2; }
                else if (a1 < k && a1 + c1 >= k) { fb = 1; fa = a1; fc = c1; }
                else if (a0 < k && a0 + c0 >= k) { fb = 0; fa = a0; fc = c0; }
                const unsigned long long mk = __ballot(fb >= 0);
                const int src = (int)__builtin_ctzll(mk | (1ull << 63));
                const int bin = __shfl(4 * lane + fb, src), above = __shfl(fa, src), cnt = __shfl(fc, src);
                prefix[g] = (prefix[g] << 8) | (unsigned)bin; krem[g] = k - above; cnteq[g] = cnt;
            }
        }
#pragma unroll
        for (int g = 0; g < 4; ++g) { tau[g] = prefix[g]; quota[g] = krem[g]; }
        (void)cnteq;
    }
    int base[4] = {0, 0, 0, 0}, eqseen[4] = {0, 0, 0, 0};
    const unsigned lowmask = (1u << r32) - 1u;
#pragma unroll 1
    for (int kt = 0; kt < ntiles; ++kt) {
        float sc[4]; DSA_SCORES(kt, sc);
        const int key = kt * 32 + r32;
#pragma unroll
        for (int g = 0; g < 4; ++g) {
            const unsigned m = mono_bits(sc[g]); const bool valid = key <= tb + g;
            const bool eq = valid && (m == tau[g]);
            const unsigned beq = (unsigned)__ballot(eq);
            const int rank = eqseen[g] + __popc(beq & lowmask);
            const bool sel = valid && ((m > tau[g]) || (eq && rank < quota[g]));
            const unsigned bsel = (unsigned)__ballot(sel);
            if (sel && half == 0) { const int pos = base[g] + __popc(bsel & lowmask); if (pos < 256) list[g * 256 + pos] = key; }
            base[g] += __popc(bsel); eqseen[g] += __popc(beq);
        }
    }
    LDS_WAIT();
#pragma unroll 1
    for (int g = 0; g < 4; ++g) {
        const int cnt = min(base[g], 256); const size_t tok = tokb + tb + g;
        { const unsigned long long wv = *((const unsigned long long*)(Z + tok * ZP + 2560) + lane);
          *(LAS f32x4*)(qs + lane * 4) = (f32x4){bflo((unsigned)wv), bfhi((unsigned)wv), bflo((unsigned)(wv >> 32)), bfhi((unsigned)(wv >> 32))}; }
        LDS_WAIT();
        float acc[4][4]; const float* kp[4]; bool vld[4];
#pragma unroll
        for (int i = 0; i < 4; ++i) { const int n = lane + 64 * i; vld[i] = n < cnt; const int s = vld[i] ? list[g * 256 + n] : 0; kp[i] = ZS + (tokb + s) * ZSP;
#pragma unroll
            for (int hh = 0; hh < 4; ++hh) acc[i][hh] = 0.f; }
#pragma unroll 4
        for (int dc = 0; dc < 16; ++dc) {
            f32x4 kv[4];
#pragma unroll
            for (int i = 0; i < 4; ++i) kv[i] = *(const f32x4*)(kp[i] + dc * 4);
#pragma unroll
            for (int hh = 0; hh < 4; ++hh) { const f32x4 qv = *(const LAS f32x4*)(qs + hh * 64 + dc * 4);
#pragma unroll
                for (int i = 0; i < 4; ++i) acc[i][hh] = fmaf(qv[0], kv[i][0], fmaf(qv[1], kv[i][1], fmaf(qv[2], kv[i][2], fmaf(qv[3], kv[i][3], acc[i][hh])))); }
        }
        float sum[4];
#pragma unroll
        for (int hh = 0; hh < 4; ++hh) { float mx = -INFINITY;
#pragma unroll
            for (int i = 0; i < 4; ++i) mx = fmaxf(mx, vld[i] ? acc[i][hh] : -INFINITY);
            mx = wave_max(mx); float sm = 0.f;
#pragma unroll
            for (int i = 0; i < 4; ++i) { acc[i][hh] = vld[i] ? __expf(acc[i][hh] - mx) : 0.f; sm += acc[i][hh]; }
            sum[hh] = wave_sum(sm); }
#pragma unroll
        for (int i = 0; i < 4; ++i) *(LAS f32x4*)(P + (lane + 64 * i) * 4) = (f32x4){acc[i][0], acc[i][1], acc[i][2], acc[i][3]};
        LDS_WAIT();
        float oa[4] = {0.f, 0.f, 0.f, 0.f};
        const float* vb = ZS + tokb * ZSP + 64 + lane;
#pragma unroll 8
        for (int n = 0; n < cnt; ++n) { const int s = list[g * 256 + n]; const f32x4 pv = *(const LAS f32x4*)(P + n * 4); const float v = vb[(size_t)s * ZSP];
            oa[0] = fmaf(pv[0], v, oa[0]); oa[1] = fmaf(pv[1], v, oa[1]); oa[2] = fmaf(pv[2], v, oa[2]); oa[3] = fmaf(pv[3], v, oa[3]); }
#pragma unroll
        for (int hh = 0; hh < 4; ++hh) O3[tok * 256 + hh * 64 + lane] = (bf16)f2bf(oa[hh] / sum[hh]);
        LDS_WAIT();
    }
#undef DSA_SCORES
}

constexpr int Q_ML = 32, Q_DIFF = 512, Q_DSA = 1024, Q_SB = 256, Q_TOTAL = Q_ML + Q_DIFF + Q_DSA + Q_SB;
__device__ __forceinline__ Params load_params() {
#if defined(__HIP_DEVICE_COMPILE__)
    const __attribute__((address_space(4))) Params* pp = (const __attribute__((address_space(4))) Params*)__builtin_amdgcn_kernarg_segment_ptr();
    asm volatile("" : "+s"(pp));
    Params r;
    r.x = pp->x; r.pos = pp->pos; r.ffn1_norm = pp->ffn1_norm; r.ffn1_gu = pp->ffn1_gu; r.ffn1_down = pp->ffn1_down; r.mix_norm = pp->mix_norm; r.w_in = pp->w_in; r.diff_qk_norm = pp->diff_qk_norm;
    r.diff_lambda = pp->diff_lambda; r.diff_head_norm = pp->diff_head_norm; r.ml_conv_w = pp->ml_conv_w; r.ml_conv_b = pp->ml_conv_b; r.ml_gate_bias = pp->ml_gate_bias; r.ml_head_norm = pp->ml_head_norm;
    r.dsa_qk_norm = pp->dsa_qk_norm; r.w_branch = pp->w_branch; r.w_out = pp->w_out; r.ffn2_norm = pp->ffn2_norm; r.ffn2_gu = pp->ffn2_gu; r.ffn2_down = pp->ffn2_down; r.out = pp->out; r.ws = pp->ws;
    return r;
#else
    return Params{};
#endif
}
__device__ __forceinline__ int next_item(unsigned* ctr, LAS int* slot, int wv) {
    __syncthreads();
    if (tid_fresh(wv) == 0) *slot = (int)atomicAdd(ctr, 1u);
    __syncthreads();
    return *slot;
}
__device__ __forceinline__ void mixer_phase(int l, LAS unsigned char* lds, int wv) {
    LAS int* slot = (LAS int*)(lds + LDS_BYTES - 64);
    { const Params p = load_params(); unsigned* ctr = (unsigned*)(p.ws + WS_CTL) + 64 * (4 * l + 0);
      for (;;) { const int it = next_item(ctr, slot, wv); if (it >= Q_ML) break; mlstm_item(p, l, it, lds, wv); } }
    { const Params p = load_params(); unsigned* ctr = (unsigned*)(p.ws + WS_CTL) + 64 * (4 * l + 1);
      for (;;) { const int it = next_item(ctr, slot, wv); if (it >= Q_DIFF) break; diffm_item(p, l, it & 31, 15 - (it >> 5), lds, wv); } }
    { const Params p = load_params(); unsigned* ctr = (unsigned*)(p.ws + WS_CTL) + 64 * (4 * l + 2);
      for (;;) { const int it = next_item(ctr, slot, wv); if (it >= Q_DSA) break; dsa_item(p, it & 7, 127 - (it >> 3), lds, wv); } }
    { const Params p = load_params(); unsigned* ctr = (unsigned*)(p.ws + WS_CTL) + 64 * (4 * l + 3);
      for (;;) { const int it = next_item(ctr, slot, wv); if (it >= Q_SB) break; sb_item(p, it >> 3, it & 7, lds, wv); } }
}

#define PH_LOCALS const Params p = load_params(); const int tid = tid_fresh(wv), lane = tid & 63, wave = tid >> 6; const int gw = (int)blockIdx.x * NWAVES + wave, ngw = (int)gridDim.x * NWAVES; \
    (void)lane; (void)gw; (void)ngw; bf16* HN = (bf16*)(p.ws + WS_HN); bf16* BIGB = (bf16*)(p.ws + WS_BIG); (void)HN; (void)BIGB;
template <int l> __device__ __forceinline__ void layer_body(cg::grid_group& grid, LAS unsigned char* lds, const int wv) {
        { PH_LOCALS const unsigned char* wl = p.ws + WS_W + (size_t)l * WL_STRIDE; EpiSwiglu E{BIGB}; run_gemm(lds, HN, (const bf16*)(wl + WL_GU1), T, 2 * FF, D, E, wv); }
        grid.sync();
        { PH_LOCALS const unsigned char* wl = p.ws + WS_W + (size_t)l * WL_STRIDE; EpiResid E{l == 0 ? p.x : p.out, p.out, 0.5f}; run_gemm(lds, BIGB, (const bf16*)(wl + WL_D1), T, D, FF, E, wv); }
        grid.sync();
        { PH_LOCALS rms_rows(p.out, p.mix_norm + l * D, HN, gw, ngw, lane); }
        grid.sync();
        { PH_LOCALS const unsigned char* wl = p.ws + WS_W + (size_t)l * WL_STRIDE; EpiZ E{BIGB, (float*)(p.ws + WS_ZS)}; run_gemm(lds, HN, (const bf16*)(wl + WL_INA), T, 3328, D, E, wv); }
        grid.sync();
        { PH_LOCALS prep_phase(p, l, gw, ngw, lane); }
        grid.sync();
        mixer_phase(l, lds, wv);
        grid.sync();
#pragma unroll 1
        for (int b = 0; b < 4; ++b) {
            { PH_LOCALS const unsigned char* wl = p.ws + WS_W + (size_t)l * WL_STRIDE; EpiSig E{BIGB}; run_gemm(lds, HN, (const bf16*)(wl + WL_G) + (size_t)b * D * D, T, D, D, E, wv); }
            grid.sync();
            { PH_LOCALS const unsigned char* wl = p.ws + WS_W + (size_t)l * WL_STRIDE; EpiGate E{BIGB, (float*)(p.ws + WS_BIG + 64 * MiB), HN, b == 0 ? 0 : (b == 3 ? 2 : 1)};
              run_gemm(lds, (const bf16*)(p.ws + WS_O + b * OB_STRIDE), (const bf16*)(wl + WL_BR) + (size_t)b * D * 256, T, D, 256, E, wv); }
            grid.sync();
        }
        { PH_LOCALS const unsigned char* wl = p.ws + WS_W + (size_t)l * WL_STRIDE; EpiResid E{p.out, p.out, 1.0f}; run_gemm(lds, HN, (const bf16*)(wl + WL_OUT), T, D, D, E, wv); }
        grid.sync();
        { PH_LOCALS rms_rows(p.out, p.ffn2_norm + l * D, HN, gw, ngw, lane); }
        grid.sync();
        { PH_LOCALS const unsigned char* wl = p.ws + WS_W + (size_t)l * WL_STRIDE; EpiSwiglu E{BIGB}; run_gemm(lds, HN, (const bf16*)(wl + WL_GU2), T, 2 * FF, D, E, wv); }
        grid.sync();
        { PH_LOCALS const unsigned char* wl = p.ws + WS_W + (size_t)l * WL_STRIDE; EpiResid E{p.out, p.out, 0.5f}; run_gemm(lds, BIGB, (const bf16*)(wl + WL_D2), T, D, FF, E, wv); }
        if (l + 1 < DEPTH) {
            grid.sync();
            { PH_LOCALS rms_rows(p.out, p.ffn1_norm + (l + 1) * D, HN, gw, ngw, lane); }
            grid.sync();
        }
    }

__global__ void __launch_bounds__(NTHR, 2) hybrid_fwd(Params p_unused) {
    extern __shared__ __attribute__((aligned(16))) unsigned char lds_raw[];
    LAS unsigned char* lds = (LAS unsigned char*)lds_raw;
    cg::grid_group grid = cg::this_grid();
    const int wv = __builtin_amdgcn_readfirstlane((int)threadIdx.x >> 6);
    {
        PH_LOCALS
        SegRun R; R.base = 0; R.gw = gw; R.ngw = ngw; R.lane = lane; R.scr = (LAS float*)(lds + wave * 8704);
        for (int l = 0; l < DEPTH; ++l) convert_weights(p, l, R);
        if (blockIdx.x == 0 && tid < 16) ((unsigned*)(p.ws + WS_CTL))[64 * tid] = 0u;
        rms_rows(p.x, p.ffn1_norm, HN, gw, ngw, lane);
    }
    grid.sync();
    layer_body<0>(grid, lds, wv);
    layer_body<1>(grid, lds, wv);
}

extern "C" void kernel_launch(void* const* d_in, const int* in_sizes, int n_in, void* d_out, int out_size, void* d_ws, size_t ws_size, hipStream_t stream) {
    static int grid = 0;
    if (grid == 0) {
        if (n_in != 20 || out_size != T * D || ws_size < WS_END) { fprintf(stderr, "kernel_launch: unexpected shapes (n_in %d out %d ws %zu)\n", n_in, out_size, ws_size); grid = -1; return; }
        int dev = 0, cus = 0, per_cu = 0;
        hipGetDevice(&dev); hipDeviceGetAttribute(&cus, hipDeviceAttributeMultiprocessorCount, dev);
        hipFuncSetAttribute((const void*)hybrid_fwd, hipFuncAttributeMaxDynamicSharedMemorySize, LDS_BYTES);
        hipOccupancyMaxActiveBlocksPerMultiprocessor(&per_cu, (const void*)hybrid_fwd, NTHR, LDS_BYTES);
        if (per_cu < 1) { fprintf(stderr, "kernel_launch: occupancy query says %d\n", per_cu); per_cu = 1; }
        (void)hipGetLastError();
        grid = cus * 1;
    }
    if (grid < 0) return;
    Params p{};
    p.x = (const float*)d_in[0]; p.pos = (const int*)d_in[1];
    p.ffn1_norm = (const float*)d_in[2]; p.ffn1_gu = (const float*)d_in[3]; p.ffn1_down = (const float*)d_in[4]; p.mix_norm = (const float*)d_in[5]; p.w_in = (const float*)d_in[6];
    p.diff_qk_norm = (const float*)d_in[7]; p.diff_lambda = (const float*)d_in[8]; p.diff_head_norm = (const float*)d_in[9]; p.ml_conv_w = (const float*)d_in[10]; p.ml_conv_b = (const float*)d_in[11];
    p.ml_gate_bias = (const float*)d_in[12]; p.ml_head_norm = (const float*)d_in[13]; p.dsa_qk_norm = (const float*)d_in[14]; p.w_branch = (const float*)d_in[15]; p.w_out = (const float*)d_in[16];
    p.ffn2_norm = (const float*)d_in[17]; p.ffn2_gu = (const float*)d_in[18]; p.ffn2_down = (const float*)d_in[19];
    p.out = (float*)d_out; p.ws = (unsigned char*)d_ws;
    void* args[] = {&p};
    hipError_t e = hipLaunchCooperativeKernel((const void*)hybrid_fwd, dim3(grid), dim3(NTHR), args, LDS_BYTES, stream);
    if (e != hipSuccess) fprintf(stderr, "cooperative launch failed: %s (grid %d)\n", hipGetErrorString(e), grid);
}
```

```cpp
#include <hip/hip_runtime.h>
#include <hip/hip_cooperative_groups.h>
#include <cstdio>
#include <cstdint>
namespace cg = cooperative_groups;
namespace pg8 {
#define PG8_LAS __attribute__((address_space(3)))
typedef unsigned short bf16_t;
typedef short bf16x8 __attribute__((ext_vector_type(8)));
typedef float f32x4 __attribute__((ext_vector_type(4)));
typedef unsigned u32x4 __attribute__((ext_vector_type(4)));
constexpr int BM = 256, BK = 64, HALF = 128, HTB = HALF * BK * 2  , STAGE_BYTES = 8 * HTB, NXCD = 8, WGM = 8;

__host__ __device__ __forceinline__ int lds_byte(int r, int c) { const int st = (r >> 4) * 2 + (c >> 5), rr = r & 15, cc = c & 31, ob = rr * 64 + cc * 2; return st * 1024 + (ob ^ (((ob >> 9) & 1) << 5)); }
__host__ __device__ __forceinline__ void stage_rc(int b, int& R, int& C) { const int st = b / 1024, sb = b % 1024, swz = sb ^ (((sb >> 9) & 1) << 5); R = (st >> 1) * 16 + swz / 64; C = (st & 1) * 32 + (swz % 64) / 2; }
__host__ __device__ __forceinline__ int perm32(int rho) { const int n = rho >> 4, i = rho & 15; return 8 * (i >> 2) + 4 * n + (i & 3); }

struct Unit { int pm, pn; };
struct Gemm { const bf16_t* A; const bf16_t* Bt; int M, N, K; };

struct StaticOrder {
    int nM, nN, nwg, G, c;
    __host__ __device__ void init(int M, int N, int G_, int c_) { nM = M / BM; nN = N / BM; nwg = nM * nN; G = G_; c = c_; }
    __host__ __device__ bool next(int i, Unit& u) const {
        const long L = (long)i * G + c; if (L >= nwg) return false;
        int wgid = (int)L; { const int q = nwg / NXCD, r = nwg % NXCD, xcd = wgid % NXCD, off = wgid / NXCD; wgid = (xcd < r ? xcd * (q + 1) : r * (q + 1) + (xcd - r) * q) + off; }
        const int nig = WGM * nN, gid = wgid / nig, fm = gid * WGM, gsz = (nM - fm) < WGM ? (nM - fm) : WGM;
        u.pm = fm + ((wgid % nig) % gsz); u.pn = (wgid % nig) / gsz; return true;
    }
    __device__ __forceinline__ void a_ready(const Unit&) const {}
    __device__ __forceinline__ void done(const Unit&) const {}
};

__device__ __forceinline__ unsigned cvt_pk_bf16(float lo, float hi) { unsigned r; asm volatile("v_cvt_pk_bf16_f32 %0, %1, %2" : "=v"(r) : "v"(lo), "v"(hi)); return r; }
template <class Epi, class Sched, bool ALIGN_EPI = false, bool SP2 = false>
__device__ __forceinline__ void gemm_phase(PG8_LAS unsigned char* lds, const Gemm g, const Sched& S, const Epi& E, const int wave_in) {
    unsigned z_ = 0u; asm volatile("" : "+v"(z_)); int w_ = wave_in; asm volatile("" : "+s"(w_));
    const int tid_ = w_ * 64 + (int)__builtin_amdgcn_mbcnt_hi(~0u, __builtin_amdgcn_mbcnt_lo(~0u, z_));
    const int tid = tid_, wid = __builtin_amdgcn_readfirstlane(tid >> 6), lane = tid & 63, wr = wid >> 2, wc = wid & 3, fr = lane & 15, fq = lane >> 4;
    const int K = g.K, nt = K / BK;
    unsigned voffA[2], voffB[2];
#pragma unroll
    for (int i = 0; i < 2; ++i) { int R, C; stage_rc(tid * 16 + i * 8192, R, C); const int Rb = Epi::PERM ? ((R & ~31) + perm32(R & 31)) : R;
        voffA[i] = (unsigned)(R * K + C) * 2u; voffB[i] = (unsigned)(Rb * K + C) * 2u; }
    const size_t kstep = (size_t)(BK * 2);
    const size_t hstep = (size_t)HALF * K * 2;
    const size_t tstep = 2 * hstep;
    const unsigned ldsw = (unsigned)wid * 1024u;
    const int aoff = lds_byte(wr * 64 + fr, fq * 8), boff = lds_byte(wc * 32 + fr, fq * 8);
#define PG8_SA(b, h) (((b) * 2 + (h)) * HTB)
#define PG8_SB(b, h) ((4 + (b) * 2 + (h)) * HTB)
#define PG8_STAGE(bufoff, gbase, voff) do { _Pragma("unroll") for (int _i = 0; _i < 2; ++_i) \
        __builtin_amdgcn_global_load_lds((const unsigned*)((const char*)(gbase) + (voff)[_i]), (PG8_LAS unsigned*)(lds + (bufoff) + ldsw + _i * 8192), 16, 0, 0); } while (0)
#define PG8_LDA(dst, b, h) do { _Pragma("unroll") for (int m = 0; m < 4; ++m) _Pragma("unroll") for (int k = 0; k < 2; ++k) dst[m][k] = *(const PG8_LAS bf16x8*)(lds + PG8_SA(b, h) + aoff + m * 2048 + k * 1024); } while (0)
#define PG8_LDB(dst, b, h) do { _Pragma("unroll") for (int n = 0; n < 2; ++n) _Pragma("unroll") for (int k = 0; k < 2; ++k) dst[n][k] = *(const PG8_LAS bf16x8*)(lds + PG8_SB(b, h) + boff + n * 2048 + k * 1024); } while (0)
#define PG8_MMA(ai, bj, At, Bt) do { __builtin_amdgcn_s_setprio(1); _Pragma("unroll") for (int m = 0; m < 4; ++m) _Pragma("unroll") for (int n = 0; n < 2; ++n) _Pragma("unroll") for (int k = 0; k < 2; ++k) \
        acc[ai][bj][m][n] = __builtin_amdgcn_mfma_f32_16x16x32_bf16(Bt[n][k], At[m][k], acc[ai][bj][m][n], 0, 0, 0); __builtin_amdgcn_s_setprio(0); } while (0)
#define PG8_WAIT_V(n) asm volatile("s_waitcnt vmcnt(" #n ")" ::: "memory")
#define PG8_WAIT_L(n) asm volatile("s_waitcnt lgkmcnt(" #n ")" ::: "memory")
#define PG8_BAR __builtin_amdgcn_s_barrier()
#define PG8_SCHED __builtin_amdgcn_sched_barrier(0)
    Unit cur, nxt; int ui = 0;
    if (!S.next(0, cur)) return;
    f32x4 acc[2][2][4][2];
#pragma unroll
    for (int a = 0; a < 2; ++a)
#pragma unroll
        for (int b = 0; b < 2; ++b)
#pragma unroll
            for (int m = 0; m < 4; ++m)
#pragma unroll
                for (int n = 0; n < 2; ++n) acc[a][b][m][n] = (f32x4){0.f, 0.f, 0.f, 0.f};
    bf16x8 At[4][2], B0[2][2], B1[2][2];
    const char* cA = (const char*)g.A + (size_t)cur.pm * tstep; const char* cB = (const char*)g.Bt + (size_t)cur.pn * tstep;
    S.a_ready(cur);
    if constexpr (SP2) {
        PG8_STAGE(PG8_SB(0, 0), cB, voffB); PG8_STAGE(PG8_SB(0, 1), cB + hstep, voffB); PG8_STAGE(PG8_SA(0, 0), cA, voffA); PG8_STAGE(PG8_SA(0, 1), cA + hstep, voffA);
        if (wr == 1) PG8_BAR;
        PG8_WAIT_V(2); PG8_BAR;
        PG8_STAGE(PG8_SB(1, 0), cB + kstep, voffB); PG8_STAGE(PG8_SA(1, 0), cA + kstep, voffA); PG8_STAGE(PG8_SB(1, 1), cB + hstep + kstep, voffB);
        PG8_WAIT_V(6); PG8_BAR;
    } else {
        PG8_STAGE(PG8_SB(0, 0), cB, voffB); PG8_STAGE(PG8_SA(0, 0), cA, voffA); PG8_STAGE(PG8_SB(0, 1), cB + hstep, voffB); PG8_STAGE(PG8_SA(0, 1), cA + hstep, voffA);
        if (wr == 1) PG8_BAR;
        PG8_WAIT_V(4); PG8_BAR;
        PG8_STAGE(PG8_SB(1, 0), cB + kstep, voffB); PG8_STAGE(PG8_SA(1, 0), cA + kstep, voffA); PG8_STAGE(PG8_SB(1, 1), cB + hstep + kstep, voffB);
        PG8_WAIT_V(6); PG8_BAR;
    }
    for (;;) {
        const bool has_next = S.next(ui + 1, nxt);
        const char* nA = has_next ? (const char*)g.A + (size_t)nxt.pm * tstep : cA; const char* nB = has_next ? (const char*)g.Bt + (size_t)nxt.pn * tstep : cB;
        for (int t = 0; t < nt; t += 2) {
            const bool last = (t == nt - 2);
            const char* a1 = cA + (size_t)(t + 1) * kstep;
            const char* a2 = last ? nA : cA + (size_t)(t + 2) * kstep; const char* b2 = last ? nB : cB + (size_t)(t + 2) * kstep;
            const char* a3 = a2 + kstep; const char* b3 = b2 + kstep;
            if (last && has_next) S.a_ready(nxt);
            if constexpr (SP2) {
            PG8_LDB(B0, 0, 0); PG8_LDB(B1, 0, 1); PG8_SCHED; PG8_LDA(At, 0, 0); PG8_STAGE(PG8_SA(1, 1), a1 + hstep, voffA);
            PG8_WAIT_V(8); PG8_WAIT_L(0); PG8_BAR; PG8_MMA(0, 0, At, B0); PG8_MMA(0, 1, At, B1); PG8_BAR; PG8_SCHED;
            PG8_LDA(At, 0, 1); PG8_STAGE(PG8_SB(0, 0), b2, voffB); PG8_STAGE(PG8_SB(0, 1), b2 + hstep, voffB); PG8_STAGE(PG8_SA(0, 0), a2, voffA);
            PG8_WAIT_V(8); PG8_WAIT_L(0); PG8_BAR; PG8_MMA(1, 0, At, B0); PG8_MMA(1, 1, At, B1); PG8_BAR; PG8_SCHED;
            PG8_LDB(B0, 1, 0); PG8_LDB(B1, 1, 1); PG8_SCHED; PG8_LDA(At, 1, 0); PG8_STAGE(PG8_SA(0, 1), a2 + hstep, voffA);
            PG8_WAIT_V(8); PG8_WAIT_L(0); PG8_BAR; PG8_MMA(0, 0, At, B0); PG8_MMA(0, 1, At, B1); PG8_BAR; PG8_SCHED;
            PG8_LDA(At, 1, 1); PG8_STAGE(PG8_SB(1, 0), b3, voffB); PG8_STAGE(PG8_SB(1, 1), b3 + hstep, voffB); PG8_STAGE(PG8_SA(1, 0), a3, voffA);
            PG8_WAIT_V(8); PG8_WAIT_L(0); PG8_BAR; PG8_MMA(1, 0, At, B0); PG8_MMA(1, 1, At, B1); PG8_BAR; PG8_SCHED;
            } else {
            PG8_LDB(B0, 0, 0); PG8_SCHED; PG8_LDA(At, 0, 0); PG8_STAGE(PG8_SA(1, 1), a1 + hstep, voffA);
            PG8_WAIT_L(8); PG8_BAR; PG8_WAIT_L(0); PG8_MMA(0, 0, At, B0); PG8_BAR; PG8_SCHED;
            PG8_LDB(B1, 0, 1); PG8_STAGE(PG8_SB(0, 0), b2, voffB);
            PG8_BAR; PG8_WAIT_L(0); PG8_MMA(0, 1, At, B1); PG8_BAR;
            PG8_LDA(At, 0, 1); PG8_STAGE(PG8_SA(0, 0), a2, voffA);
            PG8_BAR; PG8_WAIT_L(0); PG8_MMA(1, 0, At, B0); PG8_BAR; PG8_SCHED;
            PG8_STAGE(PG8_SB(0, 1), b2 + hstep, voffB);
            PG8_WAIT_V(6); PG8_BAR; PG8_MMA(1, 1, At, B1); PG8_BAR;
            PG8_LDB(B0, 1, 0); PG8_SCHED; PG8_LDA(At, 1, 0); PG8_STAGE(PG8_SA(0, 1), a2 + hstep, voffA);
            PG8_WAIT_L(8); PG8_BAR; PG8_WAIT_L(0); PG8_MMA(0, 0, At, B0); PG8_BAR; PG8_SCHED;
            PG8_LDB(B1, 1, 1); PG8_STAGE(PG8_SB(1, 0), b3, voffB);
            PG8_BAR; PG8_WAIT_L(0); PG8_MMA(0, 1, At, B1); PG8_BAR;
            PG8_LDA(At, 1, 1); PG8_STAGE(PG8_SA(1, 0), a3, voffA);
            PG8_BAR; PG8_WAIT_L(0); PG8_MMA(1, 0, At, B0); PG8_BAR; PG8_SCHED;
            PG8_STAGE(PG8_SB(1, 1), b3 + hstep, voffB);
            PG8_WAIT_V(6); PG8_BAR; PG8_MMA(1, 1, At, B1); PG8_BAR;
            }
        }
        if constexpr (ALIGN_EPI) { if (wr == 0) PG8_BAR; }
        if constexpr (!Epi::AFTER_DRAIN) { E(acc, cur, wr, wc, fr, fq); S.done(cur); }
        if (!has_next) break;
#pragma unroll
        for (int a = 0; a < 2; ++a)
#pragma unroll
            for (int b = 0; b < 2; ++b)
#pragma unroll
                for (int m = 0; m < 4; ++m)
#pragma unroll
                    for (int n = 0; n < 2; ++n) acc[a][b][m][n] = (f32x4){0.f, 0.f, 0.f, 0.f};
        cur = nxt; cA = nA; cB = nB; ++ui;
        if constexpr (ALIGN_EPI) { if (wr == 1) PG8_BAR; }
    }
    PG8_WAIT_V(0);
    if constexpr (!ALIGN_EPI) { if (wr == 0) PG8_BAR; }
    PG8_BAR;
    if constexpr (Epi::AFTER_DRAIN) { E.fused(acc, cur, wr, wc, fr, fq, lds, wid, lane); S.done(cur); }
#undef PG8_SA
#undef PG8_SB
#undef PG8_STAGE
#undef PG8_LDA
#undef PG8_LDB
#undef PG8_MMA
#undef PG8_WAIT_V
#undef PG8_WAIT_L
#undef PG8_BAR
#undef PG8_SCHED
}
}
#define LAS __attribute__((address_space(3)))
typedef unsigned short bf16;
typedef float f32x4 __attribute__((ext_vector_type(4)));
typedef float f32x16 __attribute__((ext_vector_type(16)));
typedef unsigned u32x4 __attribute__((ext_vector_type(4)));
typedef unsigned u32x2 __attribute__((ext_vector_type(2)));
typedef short s16x8 __attribute__((ext_vector_type(8)));

constexpr int NB = 8, SEQ = 4096, T = NB * SEQ, D = 1024, FF = 2816, DEPTH = 2, NIN = 7344, ZP = 3072, ZSP = 256;
constexpr int NTHR = 512, NWAVES = 8;
constexpr int LDS_BYTES = 147456;
constexpr float EPS = 1e-6f;

constexpr size_t MiB = (size_t)1 << 20;
constexpr size_t WS_CTL = 0;
constexpr size_t WS_W = 1 * MiB, WL_STRIDE = 52 * MiB;
constexpr size_t WL_GU1 = 0, WL_D1 = 11534336, WL_INA = 17301504, WL_G = 24117248, WL_BR = 32505856, WL_OUT = 34603008, WL_GU2 = 36700160, WL_D2 = 48234496;
constexpr size_t WS_HN = 106 * MiB, WS_BIG = 170 * MiB, WS_ZS = 362 * MiB, WS_O = 394 * MiB, WS_IK = 458 * MiB, WS_END = 460 * MiB;
constexpr size_t OB_STRIDE = (size_t)T * 256 * 2;

struct Params {
    const float* x; const int* pos;
    const float *ffn1_norm, *ffn1_gu, *ffn1_down, *mix_norm, *w_in, *diff_qk_norm, *diff_lambda, *diff_head_norm, *ml_conv_w, *ml_conv_b, *ml_gate_bias, *ml_head_norm,
        *dsa_qk_norm, *w_branch, *w_out, *ffn2_norm, *ffn2_gu, *ffn2_down;
    float* out; unsigned char* ws;
};

__device__ __forceinline__ unsigned f2bf(float f) { unsigned u = __float_as_uint(f); return (u + 0x7fffu + ((u >> 16) & 1u)) >> 16; }
__device__ __forceinline__ unsigned pk2(float lo, float hi) { return f2bf(lo) | (f2bf(hi) << 16); }
__device__ __forceinline__ float bflo(unsigned w) { return __uint_as_float(w << 16); }
__device__ __forceinline__ float bfhi(unsigned w) { return __uint_as_float(w & 0xffff0000u); }
__device__ __forceinline__ float wave_sum(float v) {
#pragma unroll
    for (int o = 1; o < 64; o <<= 1) v += __shfl_xor(v, o);
    return v;
}
__device__ __forceinline__ float wave_max(float v) {
#pragma unroll
    for (int o = 1; o < 64; o <<= 1) v = fmaxf(v, __shfl_xor(v, o));
    return v;
}
__device__ __forceinline__ int lane_fresh() { unsigned z = 0u; asm volatile("" : "+v"(z)); return (int)__builtin_amdgcn_mbcnt_hi(~0u, __builtin_amdgcn_mbcnt_lo(~0u, z)); }
__device__ __forceinline__ int tid_fresh(int wv) { int w = wv; asm volatile("" : "+s"(w)); return w * 64 + lane_fresh(); }
#define LDS_WAIT() asm volatile("s_waitcnt lgkmcnt(0)" ::: "memory")
__device__ __forceinline__ float sigmoidf_(float x) { return 1.f / (1.f + __expf(-x)); }

struct EpiSwiglu {
    static constexpr bool PERM = true, AFTER_DRAIN = false;
    bf16* O;
    __device__ __forceinline__ void operator()(const f32x4 (&acc)[2][2][4][2], const pg8::Unit& u, int wr, int wc, int fr_in, int fq_in) const {
        const int ln_ = lane_fresh(); const int fr = ln_ & 15, fq = ln_ >> 4; (void)fr_in; (void)fq_in;
        const int row0 = u.pm * 256 + wr * 64 + fr, col0 = u.pn * 128 + wc * 32 + 8 * fq;
#pragma unroll
        for (int ai = 0; ai < 2; ++ai)
#pragma unroll
            for (int m = 0; m < 4; ++m) {
                bf16* rowp = O + (size_t)(row0 + ai * 128 + m * 16) * FF + col0;
                float r[8];
#pragma unroll
                for (int n = 0; n < 2; ++n)
#pragma unroll
                    for (int j = 0; j < 4; ++j) { const float g = acc[ai][0][m][n][j], uu = acc[ai][1][m][n][j]; r[4 * n + j] = g * sigmoidf_(g) * uu; }
                u32x4 w; w.x = pk2(r[0], r[1]); w.y = pk2(r[2], r[3]); w.z = pk2(r[4], r[5]); w.w = pk2(r[6], r[7]);
                *(u32x4*)rowp = w;
            }
    }
};
struct EpiResid {
    static constexpr bool PERM = true, AFTER_DRAIN = false;
    const float* base; float* out; float scale;
    __device__ __forceinline__ void operator()(const f32x4 (&acc)[2][2][4][2], const pg8::Unit& u, int wr, int wc, int fr_in, int fq_in) const {
        const int ln_ = lane_fresh(); const int fr = ln_ & 15, fq = ln_ >> 4; (void)fr_in; (void)fq_in;
        const int row0 = u.pm * 256 + wr * 64 + fr, col0 = u.pn * 256 + wc * 32 + 8 * fq;
#pragma unroll
        for (int ai = 0; ai < 2; ++ai)
#pragma unroll
            for (int m = 0; m < 4; ++m) {
                const size_t ro = (size_t)(row0 + ai * 128 + m * 16) * D + col0;
#pragma unroll
                for (int bj = 0; bj < 2; ++bj)
#pragma unroll
                    for (int n = 0; n < 2; ++n) { const f32x4 b = *(const f32x4*)(base + ro + bj * 128 + 4 * n); *(f32x4*)(out + ro + bj * 128 + 4 * n) = b + acc[ai][bj][m][n] * scale; }
            }
    }
};
struct EpiZ {
    static constexpr bool PERM = true, AFTER_DRAIN = false;
    bf16* Z; float* ZS;
    __device__ __forceinline__ void operator()(const f32x4 (&acc)[2][2][4][2], const pg8::Unit& u, int wr, int wc, int fr_in, int fq_in) const {
        const int ln_ = lane_fresh(); const int fr = ln_ & 15, fq = ln_ >> 4; (void)fr_in; (void)fq_in;
        const int row0 = u.pm * 256 + wr * 64 + fr, cw = wc * 32 + 8 * fq;
        if (u.pn < 12) {
#pragma unroll
            for (int ai = 0; ai < 2; ++ai)
#pragma unroll
                for (int m = 0; m < 4; ++m) {
                    bf16* rowp = Z + (size_t)(row0 + ai * 128 + m * 16) * ZP + u.pn * 256 + cw;
#pragma unroll
                    for (int bj = 0; bj < 2; ++bj) { const f32x4 v0 = acc[ai][bj][m][0], v1 = acc[ai][bj][m][1];
                        u32x4 w; w.x = pk2(v0[0], v0[1]); w.y = pk2(v0[2], v0[3]); w.z = pk2(v1[0], v1[1]); w.w = pk2(v1[2], v1[3]);
                        *(u32x4*)(rowp + bj * 128) = w; }
                }
        } else {
#pragma unroll
            for (int ai = 0; ai < 2; ++ai)
#pragma unroll
                for (int m = 0; m < 4; ++m) {
                    float* rowp = ZS + (size_t)(row0 + ai * 128 + m * 16) * ZSP + cw;
#pragma unroll
                    for (int bj = 0; bj < 2; ++bj)
#pragma unroll
                        for (int n = 0; n < 2; ++n) *(f32x4*)(rowp + bj * 128 + 4 * n) = acc[ai][bj][m][n];
                }
        }
    }
};
struct EpiSig {
    static constexpr bool PERM = true, AFTER_DRAIN = false;
    bf16* SG;
    __device__ __forceinline__ void operator()(const f32x4 (&acc)[2][2][4][2], const pg8::Unit& u, int wr, int wc, int fr_in, int fq_in) const {
        const int ln_ = lane_fresh(); const int fr = ln_ & 15, fq = ln_ >> 4; (void)fr_in; (void)fq_in;
        const int row0 = u.pm * 256 + wr * 64 + fr, col0 = u.pn * 256 + wc * 32 + 8 * fq;
#pragma unroll
        for (int ai = 0; ai < 2; ++ai)
#pragma unroll
            for (int m = 0; m < 4; ++m) {
                bf16* rowp = SG + (size_t)(row0 + ai * 128 + m * 16) * D + col0;
#pragma unroll
                for (int bj = 0; bj < 2; ++bj) { const f32x4 v0 = acc[ai][bj][m][0], v1 = acc[ai][bj][m][1];
                    u32x4 w; w.x = pk2(sigmoidf_(v0[0]), sigmoidf_(v0[1])); w.y = pk2(sigmoidf_(v0[2]), sigmoidf_(v0[3]));
                    w.z = pk2(sigmoidf_(v1[0]), sigmoidf_(v1[1])); w.w = pk2(sigmoidf_(v1[2]), sigmoidf_(v1[3]));
                    *(u32x4*)(rowp + bj * 128) = w; }
            }
    }
};
struct EpiGate {
    static constexpr bool PERM = true, AFTER_DRAIN = false;
    const bf16* SG; float* YF; bf16* YB; int mode;
    __device__ __forceinline__ void operator()(const f32x4 (&acc)[2][2][4][2], const pg8::Unit& u, int wr, int wc, int fr_in, int fq_in) const {
        const int ln_ = lane_fresh(); const int fr = ln_ & 15, fq = ln_ >> 4; (void)fr_in; (void)fq_in;
        const int row0 = u.pm * 256 + wr * 64 + fr, col0 = u.pn * 256 + wc * 32 + 8 * fq;
#pragma unroll
        for (int ai = 0; ai < 2; ++ai)
#pragma unroll
            for (int m = 0; m < 4; ++m) {
                const size_t ro = (size_t)(row0 + ai * 128 + m * 16) * D + col0;
#pragma unroll
                for (int bj = 0; bj < 2; ++bj) {
                    const u32x4 sg = *(const u32x4*)(SG + ro + bj * 128);
                    f32x4 g0 = (f32x4){bflo(sg.x), bfhi(sg.x), bflo(sg.y), bfhi(sg.y)}, g1 = (f32x4){bflo(sg.z), bfhi(sg.z), bflo(sg.w), bfhi(sg.w)};
                    f32x4 v0 = g0 * acc[ai][bj][m][0], v1 = g1 * acc[ai][bj][m][1];
                    float* yp = YF + ro + bj * 128;
                    if (mode != 0) { v0 = v0 + *(const f32x4*)yp; v1 = v1 + *(const f32x4*)(yp + 4); }
                    if (mode != 2) { *(f32x4*)yp = v0; *(f32x4*)(yp + 4) = v1; }
                    else { u32x4 w; w.x = pk2(v0[0], v0[1]); w.y = pk2(v0[2], v0[3]); w.z = pk2(v1[0], v1[1]); w.w = pk2(v1[2], v1[3]); *(u32x4*)(YB + ro + bj * 128) = w; }
                }
            }
    }
};

template <class Epi>
__device__ __forceinline__ void run_gemm(LAS unsigned char* lds, const bf16* A, const bf16* Bt, int M, int N, int K, const Epi& E, int wv) {
    pg8::Gemm g{A, Bt, M, N, K}; pg8::StaticOrder S; S.init(M, N, (int)gridDim.x, (int)blockIdx.x);
    pg8::gemm_phase<Epi, pg8::StaticOrder, true, true>((PG8_LAS unsigned char*)lds, g, S, E, wv);
}

__device__ __forceinline__ void tr_item(const float* W, int K, int srcN, int c0, int nv, bf16* WT, int r0, int k0, LAS float* scr, int lane) {
    const int c = lane & 31;
#pragma unroll 8
    for (int i = 0; i < 32; ++i) { const int kk = 2 * i + (lane >> 5); scr[kk * 33 + c] = (c < nv) ? W[(size_t)(k0 + kk) * srcN + c0 + c] : 0.f; }
    LDS_WAIT();
    const int c8 = lane & 7;
#pragma unroll
    for (int j = 0; j < 4; ++j) { const int n = (lane >> 3) + 8 * j; const LAS float* s = scr + (8 * c8) * 33 + n;
        u32x4 o; o.x = pk2(s[0 * 33], s[1 * 33]); o.y = pk2(s[2 * 33], s[3 * 33]); o.z = pk2(s[4 * 33], s[5 * 33]); o.w = pk2(s[6 * 33], s[7 * 33]);
        if (n < nv) *(u32x4*)(WT + (size_t)(r0 + n) * K + k0 + 8 * c8) = o; }
    LDS_WAIT();
}
struct SegRun { int base, gw, ngw, lane; LAS float* scr; };
__device__ __forceinline__ void run_seg(SegRun& R, const float* W, int K, int srcN, int c0, int ncols, bf16* WT, int r0) {
    const int nblk = (ncols + 31) >> 5, nitems = (K >> 6) * nblk;
    int first = (R.gw - (R.base % R.ngw) + R.ngw) % R.ngw;
    for (int it = first; it < nitems; it += R.ngw) { const int kb = it / nblk, nb = it - kb * nblk; const int nv = min(32, ncols - nb * 32);
        tr_item(W, K, srcN, c0 + nb * 32, nv, WT, r0 + nb * 32, kb * 64, R.scr, R.lane); }
    R.base += nitems;
}
__device__ __forceinline__ void convert_weights(const Params& p, int l, SegRun& R) {
    unsigned char* wl = p.ws + WS_W + (size_t)l * WL_STRIDE;
    for (int f = 0; f < 2; ++f) {
        const float* gu = (f ? p.ffn2_gu : p.ffn1_gu) + (size_t)l * D * 2 * FF; bf16* gut = (bf16*)(wl + (f ? WL_GU2 : WL_GU1));
        for (int sg = 0; sg < 44; ++sg) run_seg(R, gu, D, 2 * FF, sg * 128, 128, gut, (sg % 22) * 256 + (sg / 22) * 128);
        const float* dn = (f ? p.ffn2_down : p.ffn1_down) + (size_t)l * FF * D; bf16* dnt = (bf16*)(wl + (f ? WL_D2 : WL_D1));
        run_seg(R, dn, FF, D, 0, D, dnt, 0);
    }
    const float* wi = p.w_in + (size_t)l * D * NIN; bf16* ina = (bf16*)(wl + WL_INA);
    run_seg(R, wi, D, NIN, 0, 768, ina, 0);
    run_seg(R, wi, D, NIN, 768, 512, ina, 768);
    run_seg(R, wi, D, NIN, 1280, 256, ina, 1280);
    run_seg(R, wi, D, NIN, 1544, 256, ina, 1536);
    run_seg(R, wi, D, NIN, 1800, 768, ina, 1792);
    run_seg(R, wi, D, NIN, 2568, 256, ina, 2560);
    run_seg(R, wi, D, NIN, 2952, 256, ina, 2816);
    run_seg(R, wi, D, NIN, 2824, 128, ina, 3072);
    run_seg(R, wi, D, NIN, 3208, 40, ina, 3200);
    run_seg(R, wi, D, NIN, 1536, 8, ina, 3240);
    run_seg(R, wi, D, NIN, 3248, 4096, (bf16*)(wl + WL_G), 0);
    for (int b = 0; b < 4; ++b) run_seg(R, p.w_branch + ((size_t)l * 4 + b) * 256 * D, 256, D, 0, D, (bf16*)(wl + WL_BR) + (size_t)b * D * 256, 0);
    run_seg(R, p.w_out + (size_t)l * D * D, D, D, 0, D, (bf16*)(wl + WL_OUT), 0);
    for (int i = R.gw * 64 + R.lane; i < 80 * 128; i += R.ngw * 64) *((u32x4*)(ina + (size_t)3248 * D) + i) = (u32x4){0u, 0u, 0u, 0u};
}

__device__ __forceinline__ void rms_rows(const float* X, const float* g, bf16* HN, int gw, int ngw, int lane) {
    f32x4 gv[4];
#pragma unroll
    for (int j = 0; j < 4; ++j) gv[j] = ((const f32x4*)g)[lane + 64 * j];
    for (int m = gw; m < T; m += ngw) {
        const f32x4* xr = (const f32x4*)(X + (size_t)m * D) + lane;
        f32x4 v[4]; float s = 0.f;
#pragma unroll
        for (int j = 0; j < 4; ++j) { v[j] = xr[64 * j]; s += (v[j].x * v[j].x + v[j].y * v[j].y) + (v[j].z * v[j].z + v[j].w * v[j].w); }
        const float r = 1.f / sqrtf(wave_sum(s) * (1.f / D) + EPS);
        unsigned long long* o8 = (unsigned long long*)(HN + (size_t)m * D) + lane;
#pragma unroll
        for (int j = 0; j < 4; ++j) { const f32x4 y = v[j] * r * gv[j]; o8[64 * j] = (unsigned long long)pk2(y.x, y.y) | ((unsigned long long)pk2(y.z, y.w) << 32); }
    }
}

__device__ __forceinline__ void sincos_red(float ang, float& sn, float& cs) {
    const float n = rintf(ang * 0.15915494309189535f);
    float r = fmaf(-n, 6.28125f, ang); r = fmaf(-n, 0.0019353071795864769f, r);
    sn = __sinf(r); cs = __cosf(r);
}
template <int HALF>
__device__ __forceinline__ void rope4(float (&v)[4], int sl, float pos) {
    constexpr int LH = HALF / 4;
    float pv[4];
#pragma unroll
    for (int j = 0; j < 4; ++j) pv[j] = __shfl_xor(v[j], LH);
    if (sl < 2 * LH) {
        const bool first = sl < LH; const int i0 = (sl & (LH - 1)) * 4;
#pragma unroll
        for (int j = 0; j < 4; ++j) {
            constexpr float I4[4] = {1.0f, 0.03760603070259094f, 0.0014142135623842478f, 5.318296098266728e-05f};
            constexpr float I8[8] = {1.0f, 0.1939227432012558f, 0.03760603070259094f, 0.007292664609849453f, 0.0014142135623842478f, 0.00027424818836152554f, 5.318296098266728e-05f, 1.0313386155758053e-05f};
            const float inv = (HALF == 4) ? I4[j] : (i0 ? I8[4 + j] : I8[j]);
            float sn, cs; sincos_red(pos * inv, sn, cs);
            v[j] = first ? (v[j] * cs - pv[j] * sn) : (pv[j] * sn + v[j] * cs);
        }
    }
}
__device__ __forceinline__ void prep_phase(const Params& p, int l, int gw, int ngw, int lane) {
    bf16* Z = (bf16*)(p.ws + WS_BIG); float* ZS = (float*)(p.ws + WS_ZS); bf16* IK = (bf16*)(p.ws + WS_IK);
    const float* dg = p.diff_qk_norm + l * 64; const float* sg = p.dsa_qk_norm + l * 128;
    for (int tok = gw; tok < T; tok += ngw) {
        const float pos = (float)p.pos[tok];
#pragma unroll
        for (int which = 0; which < 2; ++which) {
            unsigned long long* ptr = (unsigned long long*)(Z + (size_t)tok * ZP + which * 256) + lane;
            const unsigned long long w = *ptr; float v[4] = {bflo((unsigned)w), bfhi((unsigned)w), bflo((unsigned)(w >> 32)), bfhi((unsigned)(w >> 32))};
            float ss = (v[0] * v[0] + v[1] * v[1]) + (v[2] * v[2] + v[3] * v[3]);
            ss += __shfl_xor(ss, 1); ss += __shfl_xor(ss, 2); ss += __shfl_xor(ss, 4);
            const float r = 1.f / sqrtf(ss * (1.f / 32.f) + EPS);
            const f32x4 g = *(const f32x4*)(dg + which * 32 + (lane & 7) * 4);
#pragma unroll
            for (int j = 0; j < 4; ++j) v[j] = v[j] * r * g[j];
            rope4<4>(v, lane & 7, pos);
            if (which == 0) {
#pragma unroll
                for (int j = 0; j < 4; ++j) v[j] *= 0.17677669529663687f;
            }
            *ptr = (unsigned long long)pk2(v[0], v[1]) | ((unsigned long long)pk2(v[2], v[3]) << 32);
        }
        {
            unsigned long long* ptr = (unsigned long long*)(Z + (size_t)tok * ZP + 2560) + lane;
            const unsigned long long w = *ptr; float v[4] = {bflo((unsigned)w), bfhi((unsigned)w), bflo((unsigned)(w >> 32)), bfhi((unsigned)(w >> 32))};
            float ss = (v[0] * v[0] + v[1] * v[1]) + (v[2] * v[2] + v[3] * v[3]);
            ss += __shfl_xor(ss, 1); ss += __shfl_xor(ss, 2); ss += __shfl_xor(ss, 4); ss += __shfl_xor(ss, 8);
            const float r = 1.f / sqrtf(ss * (1.f / 64.f) + EPS);
            const f32x4 g = *(const f32x4*)(sg + (lane & 15) * 4);
#pragma unroll
            for (int j = 0; j < 4; ++j) v[j] = v[j] * r * g[j];
            rope4<8>(v, lane & 15, pos);
#pragma unroll
            for (int j = 0; j < 4; ++j) v[j] *= 0.125f;
            *ptr = (unsigned long long)pk2(v[0], v[1]) | ((unsigned long long)pk2(v[2], v[3]) << 32);
        }
        {
            unsigned long long* ptr = (unsigned long long*)(Z + (size_t)tok * ZP + 2816) + lane;
            const unsigned long long w = *ptr; float v[4] = {bflo((unsigned)w), bfhi((unsigned)w), bflo((unsigned)(w >> 32)), bfhi((unsigned)(w >> 32))};
            rope4<4>(v, lane & 7, pos);
            *ptr = (unsigned long long)pk2(v[0], v[1]) | ((unsigned long long)pk2(v[2], v[3]) << 32);
        }
        {
            float* ptr = ZS + (size_t)tok * ZSP + (lane & 15) * 4;
            const f32x4 x = *(const f32x4*)ptr; float v[4] = {x[0], x[1], x[2], x[3]};
            float ss = (v[0] * v[0] + v[1] * v[1]) + (v[2] * v[2] + v[3] * v[3]);
            ss += __shfl_xor(ss, 1); ss += __shfl_xor(ss, 2); ss += __shfl_xor(ss, 4); ss += __shfl_xor(ss, 8);
            const float r = 1.f / sqrtf(ss * (1.f / 64.f) + EPS);
            const f32x4 g = *(const f32x4*)(sg + 64 + (lane & 15) * 4);
#pragma unroll
            for (int j = 0; j < 4; ++j) v[j] = v[j] * r * g[j];
            rope4<8>(v, lane & 15, pos);
            if (lane < 16) *(f32x4*)ptr = (f32x4){v[0], v[1], v[2], v[3]};
        }
        {
            const float* ptr = ZS + (size_t)tok * ZSP + 128 + (lane & 7) * 4;
            const f32x4 x = *(const f32x4*)ptr; float v[4] = {x[0], x[1], x[2], x[3]};
            rope4<4>(v, lane & 7, pos);
            if (lane < 8) *((unsigned long long*)(IK + (size_t)tok * 32) + lane) = (unsigned long long)pk2(v[0], v[1]) | ((unsigned long long)pk2(v[2], v[3]) << 32);
        }
    }
}
__device__ __forceinline__ void mlstm_item(const Params& p, int l, int bh, LAS unsigned char* lds, int wv) {
    const int tid = tid_fresh(wv), lane = tid & 63, b = bh >> 2, h = bh & 3;
    const bf16* Z = (const bf16*)(p.ws + WS_BIG); const float* ZS = (const float*)(p.ws + WS_ZS); bf16* O1 = (bf16*)(p.ws + WS_O + OB_STRIDE);
    LAS float* nv = (LAS float*)lds; LAS float* bc = nv + 64; LAS float* igs = bc + 64; LAS float* wks = igs + 64; LAS float* sc = wks + 64;
    LAS float* Qs = sc + 64; LAS float* Ks = Qs + 64 * 65; LAS float* Vs = Ks + 64 * 65; LAS float* Ss = Vs + 64 * 65; LAS float* Cs = Ss + 64 * 65;
    for (int i = tid; i < 64 * 65; i += NTHR) Cs[i] = 0.f;
    if (tid < 64) nv[tid] = 0.f;
    float mcar = 0.f;
    const int r = tid >> 3, sg = tid & 7;
    const int cc0 = sg * 16; const int ch0 = (cc0 < 64) ? (h * 64 + cc0) : (256 + h * 64 + cc0 - 64);
    const float* cw0 = p.ml_conv_w + (size_t)l * 4 * 512; const float* cb0 = p.ml_conv_b + (size_t)l * 512;
    const int zc0 = (cc0 < 64) ? (768 + h * 64 + cc0) : (1024 + h * 64 + cc0 - 64);
    const float gb_i = p.ml_gate_bias[(l * 2 + 0) * 4 + h], gb_f = p.ml_gate_bias[(l * 2 + 1) * 4 + h];
    const float qsc = (cc0 < 64) ? 0.125f : 1.0f;
    __syncthreads();
    for (int c = 0; c < 64; ++c) {
        const int t0 = c * 64; const size_t tok0 = (size_t)b * SEQ + t0;
        const float* cw = cw0; const float* cb = cb0; asm volatile("" : "+s"(cw), "+s"(cb));
        {
            float y[16];
#pragma unroll
            for (int i = 0; i < 16; ++i) y[i] = cb[ch0 + i];
#pragma unroll
            for (int j = 0; j < 4; ++j) {
                const int tt = t0 + r - 3 + j;
                if (tt >= 0) {
                    const u32x4* xp = (const u32x4*)(Z + ((size_t)b * SEQ + tt) * ZP + zc0); const u32x4 x0 = xp[0], x1 = xp[1];
                    const float xv[16] = {bflo(x0.x), bfhi(x0.x), bflo(x0.y), bfhi(x0.y), bflo(x0.z), bfhi(x0.z), bflo(x0.w), bfhi(x0.w),
                                          bflo(x1.x), bfhi(x1.x), bflo(x1.y), bfhi(x1.y), bflo(x1.z), bfhi(x1.z), bflo(x1.w), bfhi(x1.w)};
#pragma unroll
                    for (int i = 0; i < 16; ++i) y[i] = fmaf(cw[j * 512 + ch0 + i], xv[i], y[i]);
                }
            }
            LAS float* dst = (cc0 < 64) ? (Qs + r * 65 + cc0) : (Ks + r * 65 + cc0 - 64);
#pragma unroll
            for (int i = 0; i < 16; ++i) dst[i] = y[i] * sigmoidf_(y[i]) * qsc;
            const u32x4 vv = *(const u32x4*)(Z + (tok0 + r) * ZP + 1280 + h * 64 + sg * 8);
            LAS float* vd = Vs + r * 65 + sg * 8;
            vd[0] = bflo(vv.x); vd[1] = bfhi(vv.x); vd[2] = bflo(vv.y); vd[3] = bfhi(vv.y); vd[4] = bflo(vv.z); vd[5] = bfhi(vv.z); vd[6] = bflo(vv.w); vd[7] = bfhi(vv.w);
        }
        if (tid < 64) {
            const float ig = ZS[(tok0 + tid) * ZSP + 168 + h] + gb_i;
            const float fz = ZS[(tok0 + tid) * ZSP + 172 + h] + gb_f;
            const float lf = fminf(fz, 0.f) - log1pf(__expf(-fabsf(fz)));
            float bsum = lf;
#pragma unroll
            for (int d = 1; d < 64; d <<= 1) { const float n = __shfl_up(bsum, d); if (lane >= d) bsum += n; }
            const float bl = __shfl(bsum, 63);
            const float g = bl - bsum + ig;
            const float mnew = fmaxf(bl + mcar, wave_max(g));
            bc[tid] = bsum; igs[tid] = ig; wks[tid] = __expf(g - mnew);
            if (tid == 0) { sc[0] = mnew; sc[1] = __expf(bl + mcar - mnew); sc[2] = bl; }
        }
        __syncthreads();
        const float bt = bc[r];
        float mx = -INFINITY;
#pragma unroll
        for (int i = 0; i < 8; ++i) { const int s = sg * 8 + i; const float dli = (s <= r) ? (bt - bc[s] + igs[s]) : -INFINITY; mx = fmaxf(mx, dli); }
        mx = fmaxf(mx, __shfl_xor(mx, 1)); mx = fmaxf(mx, __shfl_xor(mx, 2)); mx = fmaxf(mx, __shfl_xor(mx, 4));
        const float inter = bt + mcar; const float mt = fmaxf(inter, mx); const float iw = __expf(inter - mt);
        float ssum = 0.f;
#pragma unroll 1
        for (int i = 0; i < 8; ++i) { const int s = sg * 8 + i; float dot = 0.f;
#pragma unroll 16
            for (int d = 0; d < 64; ++d) dot = fmaf(Qs[r * 65 + d], Ks[s * 65 + d], dot);
            const float dli = (s <= r) ? (bt - bc[s] + igs[s]) : -INFINITY;
            const float sv = dot * __expf(dli - mt); Ss[r * 65 + s] = sv; ssum += sv; }
        ssum += __shfl_xor(ssum, 1); ssum += __shfl_xor(ssum, 2); ssum += __shfl_xor(ssum, 4);
        float qn = 0.f;
#pragma unroll
        for (int d = 0; d < 64; ++d) qn = fmaf(Qs[r * 65 + d], nv[d], qn);
        const float den = iw * qn + ssum;
        __syncthreads();
        {
            float num[8];
#pragma unroll
            for (int i = 0; i < 8; ++i) num[i] = 0.f;
#pragma unroll 8
            for (int d = 0; d < 64; ++d) { const float qd = Qs[r * 65 + d];
#pragma unroll
                for (int i = 0; i < 8; ++i) num[i] = fmaf(qd, Cs[d * 65 + sg * 8 + i], num[i]); }
#pragma unroll
            for (int i = 0; i < 8; ++i) num[i] *= iw;
#pragma unroll 8
            for (int s = 0; s < 64; ++s) { const float sv = Ss[r * 65 + s];
#pragma unroll
                for (int i = 0; i < 8; ++i) num[i] = fmaf(sv, Vs[s * 65 + sg * 8 + i], num[i]); }
            const float dn = 1.f / fmaxf(fabsf(den), __expf(-mt));
            float hs = 0.f;
#pragma unroll
            for (int i = 0; i < 8; ++i) { num[i] *= dn; hs = fmaf(num[i], num[i], hs); }
            hs += __shfl_xor(hs, 1); hs += __shfl_xor(hs, 2); hs += __shfl_xor(hs, 4);
            const float rr = 1.f / sqrtf(hs * (1.f / 64.f) + EPS);
            const u32x4 og = *(const u32x4*)(Z + (tok0 + r) * ZP + 1536 + h * 64 + sg * 8);
            const float ogv[8] = {bflo(og.x), bfhi(og.x), bflo(og.y), bfhi(og.y), bflo(og.z), bfhi(og.z), bflo(og.w), bfhi(og.w)};
            const float* hg = p.ml_head_norm + l * 64 + sg * 8;
            float o[8];
#pragma unroll
            for (int i = 0; i < 8; ++i) o[i] = sigmoidf_(ogv[i]) * (num[i] * rr * hg[i]);
            u32x4 w; w.x = pk2(o[0], o[1]); w.y = pk2(o[2], o[3]); w.z = pk2(o[4], o[5]); w.w = pk2(o[6], o[7]);
            *(u32x4*)(O1 + (tok0 + r) * 256 + h * 64 + sg * 8) = w;
        }
        __syncthreads();
        {
            const float decay = sc[1];
            float cacc[8]; float nacc = 0.f;
#pragma unroll
            for (int i = 0; i < 8; ++i) cacc[i] = 0.f;
#pragma unroll 8
            for (int s = 0; s < 64; ++s) { const float kw = wks[s] * Ks[s * 65 + r]; nacc += kw;
#pragma unroll
                for (int i = 0; i < 8; ++i) cacc[i] = fmaf(kw, Vs[s * 65 + sg * 8 + i], cacc[i]); }
#pragma unroll
            for (int i = 0; i < 8; ++i) Cs[r * 65 + sg * 8 + i] = decay * Cs[r * 65 + sg * 8 + i] + cacc[i];
            if (sg == 0) nv[r] = decay * nv[r] + nacc;
            mcar = sc[0];
        }
        __syncthreads();
    }
}

__device__ __forceinline__ void diff_item(const Params& p, int l, int bh, int qt, LAS unsigned char* lds, int wv) {
    const int tid = tid_fresh(wv), b = bh >> 2, h = bh & 3, q0 = qt * 128;
    const bf16* Z = (const bf16*)(p.ws + WS_BIG); bf16* O0 = (bf16*)(p.ws + WS_O);
    LAS float* Kt = (LAS float*)lds; LAS float* Vt = Kt + 64 * 64;
    const int ql = tid >> 2, part = tid & 3, c = part & 1, dvh = part >> 1, t = q0 + ql; const size_t tok = (size_t)b * SEQ + t;
    const float* lp = p.diff_lambda + l * 128; float s01 = 0.f, s23 = 0.f, gqm = 0.f, gkm = 0.f;
#pragma unroll 2
    for (int i = 0; i < 32; ++i) { s01 = fmaf(lp[i], lp[32 + i], s01); s23 = fmaf(lp[64 + i], lp[96 + i], s23);
        gqm = fmaxf(gqm, fabsf(p.diff_qk_norm[l * 64 + i])); gkm = fmaxf(gkm, fabsf(p.diff_qk_norm[l * 64 + 32 + i])); }
    const float lam_init = 0.8f - 0.6f * __expf(-0.3f * (float)l); const float lam = __expf(s01) - __expf(s23) + lam_init;
    const float coff = 5.65685424949238f * gqm * gkm;
    float q[32], o[32];
    { const u32x4* qp = (const u32x4*)(Z + tok * ZP + h * 64 + c * 32);
#pragma unroll
      for (int i = 0; i < 4; ++i) { const u32x4 w = qp[i]; q[8 * i] = bflo(w.x); q[8 * i + 1] = bfhi(w.x); q[8 * i + 2] = bflo(w.y); q[8 * i + 3] = bfhi(w.y); q[8 * i + 4] = bflo(w.z); q[8 * i + 5] = bfhi(w.z); q[8 * i + 6] = bflo(w.w); q[8 * i + 7] = bfhi(w.w); } }
#pragma unroll
    for (int i = 0; i < 32; ++i) o[i] = 0.f;
    float lsum = 0.f;
    const int nkt = (q0 + 128) / 64;
    const int lk = tid >> 3, lsg = tid & 7;
    for (int kt = 0; kt < nkt; ++kt) {
        __syncthreads();
        { const size_t ktok = (size_t)b * SEQ + kt * 64 + lk;
          const bf16* src = Z + ktok * ZP + ((lsg < 4) ? (256 + h * 64 + lsg * 16) : (512 + h * 64 + (lsg - 4) * 16));
          const u32x4 x0 = ((const u32x4*)src)[0], x1 = ((const u32x4*)src)[1];
          LAS float* dst = ((lsg < 4) ? (Kt + lk * 64 + lsg * 16) : (Vt + lk * 64 + (lsg - 4) * 16));
          *(LAS f32x4*)(dst) = (f32x4){bflo(x0.x), bfhi(x0.x), bflo(x0.y), bfhi(x0.y)}; *(LAS f32x4*)(dst + 4) = (f32x4){bflo(x0.z), bfhi(x0.z), bflo(x0.w), bfhi(x0.w)};
          *(LAS f32x4*)(dst + 8) = (f32x4){bflo(x1.x), bfhi(x1.x), bflo(x1.y), bfhi(x1.y)}; *(LAS f32x4*)(dst + 12) = (f32x4){bflo(x1.z), bfhi(x1.z), bflo(x1.w), bfhi(x1.w)}; }
        __syncthreads();
        const int kmax = t - kt * 64 + 1;
        for (int key = 0; key < 64; ++key) {
            const LAS f32x4* kr = (const LAS f32x4*)(Kt + key * 64 + c * 32);
            float s = 0.f;
#pragma unroll
            for (int i = 0; i < 8; ++i) { const f32x4 kv = kr[i]; s = fmaf(q[4 * i], kv[0], s); s = fmaf(q[4 * i + 1], kv[1], s); s = fmaf(q[4 * i + 2], kv[2], s); s = fmaf(q[4 * i + 3], kv[3], s); }
            const float pe = (key < kmax) ? __expf(s - coff) : 0.f;
            lsum += pe;
            const LAS f32x4* vr = (const LAS f32x4*)(Vt + key * 64 + dvh * 32);
#pragma unroll
            for (int i = 0; i < 8; ++i) { const f32x4 vv = vr[i]; o[4 * i] = fmaf(pe, vv[0], o[4 * i]); o[4 * i + 1] = fmaf(pe, vv[1], o[4 * i + 1]); o[4 * i + 2] = fmaf(pe, vv[2], o[4 * i + 2]); o[4 * i + 3] = fmaf(pe, vv[3], o[4 * i + 3]); }
        }
    }
    const float inv = 1.f / lsum; float ss = 0.f;
#pragma unroll
    for (int i = 0; i < 32; ++i) { const float my = o[i] * inv; const float ot = __shfl_xor(my, 1); o[i] = (c == 0) ? (my - lam * ot) : (ot - lam * my); ss = fmaf(o[i], o[i], ss); }
    ss += __shfl_xor(ss, 2);
    const float rr = (1.f - lam_init) / sqrtf(ss * (1.f / 64.f) + EPS);
    if (c == 0) {
        const float* hg = p.diff_head_norm + l * 64 + dvh * 32; u32x4* dst = (u32x4*)(O0 + tok * 256 + h * 64 + dvh * 32);
#pragma unroll
        for (int i = 0; i < 4; ++i) { u32x4 w; w.x = pk2(o[8 * i] * rr * hg[8 * i], o[8 * i + 1] * rr * hg[8 * i + 1]); w.y = pk2(o[8 * i + 2] * rr * hg[8 * i + 2], o[8 * i + 3] * rr * hg[8 * i + 3]);
            w.z = pk2(o[8 * i + 4] * rr * hg[8 * i + 4], o[8 * i + 5] * rr * hg[8 * i + 5]); w.w = pk2(o[8 * i + 6] * rr * hg[8 * i + 6], o[8 * i + 7] * rr * hg[8 * i + 7]); dst[i] = w; }
    }
    __syncthreads();
}

__device__ __forceinline__ unsigned pkbf(float lo, float hi) { unsigned r; asm("v_cvt_pk_bf16_f32 %0, %1, %2" : "=v"(r) : "v"(lo), "v"(hi)); return r; }
__device__ __forceinline__ void diffm_item(const Params& p, int l, int bh, int qb, LAS unsigned char* lds, int wv) {
    const int tid = tid_fresh(wv), lane = tid & 63, half = lane >> 5, r32 = lane & 31, b = bh >> 2, h = bh & 3;
    const bf16* Z = (const bf16*)(p.ws + WS_BIG); bf16* O0 = (bf16*)(p.ws + WS_O);
    LAS bf16* Ks = (LAS bf16*)lds; LAS bf16* Vt = Ks + 64 * 72;
    const float* lp = p.diff_lambda + l * 128; float s01 = 0.f, s23 = 0.f, gqm = 0.f, gkm = 0.f;
#pragma unroll 2
    for (int i = 0; i < 32; ++i) { s01 = fmaf(lp[i], lp[32 + i], s01); s23 = fmaf(lp[64 + i], lp[96 + i], s23);
        gqm = fmaxf(gqm, fabsf(p.diff_qk_norm[l * 64 + i])); gkm = fmaxf(gkm, fabsf(p.diff_qk_norm[l * 64 + 32 + i])); }
    const float lam_init = 0.8f - 0.6f * __expf(-0.3f * (float)l); const float lam = __expf(s01) - __expf(s23) + lam_init;
    const float coff = 5.65685424949238f * gqm * gkm;
    const int qw = qb * 256 + 32 * wv;
    const size_t tokb = (size_t)b * SEQ;
    s16x8 qf[2][2];
    { const bf16* qp = Z + (tokb + qw + r32) * ZP + h * 64 + half * 8;
#pragma unroll
      for (int c = 0; c < 2; ++c)
#pragma unroll
          for (int s = 0; s < 2; ++s) qf[c][s] = *(const s16x8*)(qp + c * 32 + 16 * s); }
    f32x16 oacc[2][2];
#pragma unroll
    for (int c = 0; c < 2; ++c)
#pragma unroll
        for (int db = 0; db < 2; ++db)
#pragma unroll
            for (int r = 0; r < 16; ++r) oacc[c][db][r] = 0.f;
    float ls0 = 0.f, ls1 = 0.f;
    const int nt = (qb + 1) * 4;
    const int kkey = tid >> 3, kch = tid & 7, vkey = tid & 63, vdc = tid >> 6;
    const bf16* kgp = Z + (tokb + kkey) * ZP + 256 + h * 64 + kch * 8;
    const bf16* vgp = Z + (tokb + vkey) * ZP + 512 + h * 64 + vdc * 8;
    u32x4 kreg = *(const u32x4*)kgp, vreg = *(const u32x4*)vgp;
#pragma unroll 1
    for (int t = 0; t < nt; ++t) {
        __syncthreads();
        *(LAS u32x4*)(Ks + kkey * 72 + kch * 8) = kreg;
        { LAS bf16* vd = Vt + (vdc * 8) * 72 + vkey;
          vd[0] = (bf16)(vreg.x & 0xffffu); vd[72] = (bf16)(vreg.x >> 16); vd[144] = (bf16)(vreg.y & 0xffffu); vd[216] = (bf16)(vreg.y >> 16);
          vd[288] = (bf16)(vreg.z & 0xffffu); vd[360] = (bf16)(vreg.z >> 16); vd[432] = (bf16)(vreg.w & 0xffffu); vd[504] = (bf16)(vreg.w >> 16); }
        __syncthreads();
        if (t + 1 < nt) { kreg = *(const u32x4*)(kgp + (size_t)(t + 1) * 64 * ZP); vreg = *(const u32x4*)(vgp + (size_t)(t + 1) * 64 * ZP); }
        const int k0 = t * 64;
#pragma unroll 1
        for (int sub = 0; sub < 2; ++sub) {
            const int kb = k0 + 32 * sub;
            if (kb <= qw + 31) {
                f32x16 s0, s1;
#pragma unroll
                for (int r = 0; r < 16; ++r) { s0[r] = 0.f; s1[r] = 0.f; }
                const LAS bf16* kr = Ks + (32 * sub + r32) * 72 + 8 * half;
#pragma unroll
                for (int s = 0; s < 2; ++s) {
                    const s16x8 a0 = *(const LAS s16x8*)(kr + 16 * s), a1 = *(const LAS s16x8*)(kr + 32 + 16 * s);
                    s0 = __builtin_amdgcn_mfma_f32_32x32x16_bf16(a0, qf[0][s], s0, 0, 0, 0);
                    s1 = __builtin_amdgcn_mfma_f32_32x32x16_bf16(a1, qf[1][s], s1, 0, 0, 0);
                }
                const bool diag = (kb + 31 > qw);
#pragma unroll
                for (int r = 0; r < 16; ++r) {
                    float p0 = __expf(s0[r] - coff), p1 = __expf(s1[r] - coff);
                    if (diag) { const int key = kb + 8 * (r >> 2) + 4 * half + (r & 3); if (key > qw + r32) { p0 = 0.f; p1 = 0.f; } }
                    ls0 += p0; ls1 += p1; s0[r] = p0; s1[r] = p1;
                }
#pragma unroll
                for (int s = 0; s < 2; ++s) {
                    u32x4 w0, w1;
                    w0.x = pkbf(s0[8 * s], s0[8 * s + 1]); w0.y = pkbf(s0[8 * s + 2], s0[8 * s + 3]); w0.z = pkbf(s0[8 * s + 4], s0[8 * s + 5]); w0.w = pkbf(s0[8 * s + 6], s0[8 * s + 7]);
                    w1.x = pkbf(s1[8 * s], s1[8 * s + 1]); w1.y = pkbf(s1[8 * s + 2], s1[8 * s + 3]); w1.z = pkbf(s1[8 * s + 4], s1[8 * s + 5]); w1.w = pkbf(s1[8 * s + 6], s1[8 * s + 7]);
                    const s16x8 pf0 = __builtin_bit_cast(s16x8, w0), pf1 = __builtin_bit_cast(s16x8, w1);
#pragma unroll
                    for (int db = 0; db < 2; ++db) {
                        const LAS bf16* vr = Vt + (db * 32 + r32) * 72 + 32 * sub + 16 * s + 4 * half;
                        const u32x2 v0 = *(const LAS u32x2*)vr, v1 = *(const LAS u32x2*)(vr + 8);
                        const u32x4 vv = (u32x4){v0.x, v0.y, v1.x, v1.y};
                        const s16x8 vf = __builtin_bit_cast(s16x8, vv);
                        oacc[0][db] = __builtin_amdgcn_mfma_f32_32x32x16_bf16(vf, pf0, oacc[0][db], 0, 0, 0);
                        oacc[1][db] = __builtin_amdgcn_mfma_f32_32x32x16_bf16(vf, pf1, oacc[1][db], 0, 0, 0);
                    }
                }
            }
        }
    }
    ls0 += __shfl_xor(ls0, 32); ls1 += __shfl_xor(ls1, 32);
    const float i0 = 1.f / ls0, i1 = lam / ls1;
    float ss = 0.f;
#pragma unroll
    for (int db = 0; db < 2; ++db)
#pragma unroll
        for (int r = 0; r < 16; ++r) { const float v = oacc[0][db][r] * i0 - oacc[1][db][r] * i1; oacc[0][db][r] = v; ss = fmaf(v, v, ss); }
    ss += __shfl_xor(ss, 32);
    const float rr = (1.f - lam_init) / sqrtf(ss * (1.f / 64.f) + EPS);
    const float* hg = p.diff_head_norm + l * 64;
    bf16* orow = O0 + (tokb + qw + r32) * 256 + h * 64;
#pragma unroll
    for (int db = 0; db < 2; ++db)
#pragma unroll
        for (int g = 0; g < 4; ++g) { const int d0 = db * 32 + 8 * g + 4 * half; const f32x4 gg = *(const f32x4*)(hg + d0);
            u32x2 w; w.x = pkbf(oacc[0][db][4 * g] * rr * gg[0], oacc[0][db][4 * g + 1] * rr * gg[1]); w.y = pkbf(oacc[0][db][4 * g + 2] * rr * gg[2], oacc[0][db][4 * g + 3] * rr * gg[3]);
            *(u32x2*)(orow + d0) = w; }
    __syncthreads();
}

__device__ __forceinline__ void sb_item(const Params& p, int bh, int g, LAS unsigned char* lds, int wv) {
    const int tid = tid_fresh(wv), lane = tid & 63, w = tid >> 6, b = bh >> 2, h = bh & 3;
    const bf16* Z = (const bf16*)(p.ws + WS_BIG); bf16* O2 = (bf16*)(p.ws + WS_O + 2 * OB_STRIDE);
    LAS float* KV = (LAS float*)lds + w * 4096;
    const int t0 = g * 512 + w * 64, t = t0 + lane; const size_t tok = (size_t)b * SEQ + t;
    float q[64], o[64];
    { const u32x4* qp = (const u32x4*)(Z + tok * ZP + 1792 + h * 64);
#pragma unroll
      for (int i = 0; i < 8; ++i) { const u32x4 x = qp[i]; q[8 * i] = bflo(x.x); q[8 * i + 1] = bfhi(x.x); q[8 * i + 2] = bflo(x.y); q[8 * i + 3] = bfhi(x.y); q[8 * i + 4] = bflo(x.z); q[8 * i + 5] = bfhi(x.z); q[8 * i + 6] = bflo(x.w); q[8 * i + 7] = bfhi(x.w); } }
#pragma unroll
    for (int i = 0; i < 64; ++i) o[i] = 0.f;
    float R = 0.f;
    const int lkey = lane >> 1, lhalf = lane & 1;
    for (int slo = t0 + 32; slo >= 0; slo -= 32) {
        asm volatile("s_waitcnt lgkmcnt(0)" ::: "memory");
        { const size_t ktok = (size_t)b * SEQ + slo + lkey;
          const u32x4* ks = (const u32x4*)(Z + ktok * ZP + 2048 + h * 64 + lhalf * 32); const u32x4* vs = (const u32x4*)(Z + ktok * ZP + 2304 + h * 64 + lhalf * 32);
          LAS float* kd = KV + lkey * 128 + lhalf * 32; LAS float* vd = kd + 64;
#pragma unroll
          for (int i = 0; i < 4; ++i) { const u32x4 x = ks[i]; *(LAS f32x4*)(kd + 8 * i) = (f32x4){bflo(x.x), bfhi(x.x), bflo(x.y), bfhi(x.y)}; *(LAS f32x4*)(kd + 8 * i + 4) = (f32x4){bflo(x.z), bfhi(x.z), bflo(x.w), bfhi(x.w)}; }
#pragma unroll
          for (int i = 0; i < 4; ++i) { const u32x4 x = vs[i]; *(LAS f32x4*)(vd + 8 * i) = (f32x4){bflo(x.x), bfhi(x.x), bflo(x.y), bfhi(x.y)}; *(LAS f32x4*)(vd + 8 * i + 4) = (f32x4){bflo(x.z), bfhi(x.z), bflo(x.w), bfhi(x.w)}; } }
        asm volatile("s_waitcnt lgkmcnt(0)" ::: "memory");
        for (int kk = 31; kk >= 0; --kk) {
            const int s = slo + kk; const bool act = s < t;
            const LAS f32x4* kr = (const LAS f32x4*)(KV + kk * 128);
            float z = 0.f;
#pragma unroll
            for (int i = 0; i < 16; ++i) { const f32x4 kv = kr[i]; z = fmaf(q[4 * i], kv[0], z); z = fmaf(q[4 * i + 1], kv[1], z); z = fmaf(q[4 * i + 2], kv[2], z); z = fmaf(q[4 * i + 3], kv[3], z); }
            z *= 0.125f;
            const float lb = fminf(z, 0.f) - __logf(1.f + __expf(-fabsf(z)));
            const float a = act ? __expf(lb + R) : 0.f;
            R += act ? (lb - z) : 0.f;
#pragma unroll
            for (int i = 0; i < 16; ++i) { const f32x4 vv = kr[16 + i]; o[4 * i] = fmaf(a, vv[0], o[4 * i]); o[4 * i + 1] = fmaf(a, vv[1], o[4 * i + 1]); o[4 * i + 2] = fmaf(a, vv[2], o[4 * i + 2]); o[4 * i + 3] = fmaf(a, vv[3], o[4 * i + 3]); }
        }
        if (__all(R < -104.f)) break;
    }
    u32x4* dst = (u32x4*)(O2 + tok * 256 + h * 64);
#pragma unroll
    for (int i = 0; i < 8; ++i) { u32x4 x; x.x = pk2(o[8 * i], o[8 * i + 1]); x.y = pk2(o[8 * i + 2], o[8 * i + 3]); x.z = pk2(o[8 * i + 4], o[8 * i + 5]); x.w = pk2(o[8 * i + 6], o[8 * i + 7]); dst[i] = x; }
    asm volatile("s_waitcnt lgkmcnt(0)" ::: "memory");
}
constexpr size_t WS_MLS = 460 * MiB, WS_DEC = WS_MLS + 5 * 32 * 4096 * 4, WS_UN = 463 * MiB, WS_NV = WS_UN + 512 * 1024, WS_UT = 464 * MiB, WS_CT = 496 * MiB, WS_END2 = 512 * MiB;
constexpr int MLN = 32 * 4096;
__device__ __forceinline__ void ml_prepass(const Params& p, int l, int bh, int lane) {
    const int b = bh >> 2, h = bh & 3; const float* ZS = (const float*)(p.ws + WS_ZS);
    float* MLS = (float*)(p.ws + WS_MLS); float* DEC = (float*)(p.ws + WS_DEC);
    const float gb_i = p.ml_gate_bias[(l * 2 + 0) * 4 + h], gb_f = p.ml_gate_bias[(l * 2 + 1) * 4 + h];
    float cA = 0.f, cB = 0.f;
#pragma unroll 1
    for (int c4 = 0; c4 < 16; ++c4) {
        float igv[4], fzv[4];
#pragma unroll
        for (int k = 0; k < 4; ++k) { const size_t tok = (size_t)b * SEQ + (c4 * 4 + k) * 64 + lane; igv[k] = ZS[tok * ZSP + 168 + h]; fzv[k] = ZS[tok * ZSP + 172 + h]; }
#pragma unroll
        for (int k = 0; k < 4; ++k) {
            const int c = c4 * 4 + k;
            const float ig = igv[k] + gb_i, fz = fzv[k] + gb_f;
            const float lf = fminf(fz, 0.f) - __logf(1.f + __expf(-fabsf(fz)));
            float bsum = lf;
#pragma unroll
            for (int d = 1; d < 64; d <<= 1) { const float n = __shfl_up(bsum, d); if (lane >= d) bsum += n; }
            const float bl = __shfl(bsum, 63);
            const float a = ig - bsum;
            float pm = a;
#pragma unroll
            for (int d = 1; d < 64; d <<= 1) { const float n = __shfl_up(pm, d); if (lane >= d) pm = fmaxf(pm, n); }
            const float gmax = bl + __shfl(pm, 63);
            const int ti = bh * 4096 + c * 64 + lane;
            MLS[ti] = bsum; MLS[MLN + ti] = a; MLS[2 * MLN + ti] = pm;
            cA = (lane == c) ? bl : cA; cB = (lane == c) ? gmax : cB;
        }
    }
    float sA = cA, sB = cB;
#pragma unroll
    for (int d = 1; d < 64; d <<= 1) { const float pA = __shfl_up(sA, d), pB = __shfl_up(sB, d); if (lane >= d) { sB = fmaxf(pB + sA, sB); sA = pA + sA; } }
    const float m_out = fmaxf(sA, sB);
    float m_in = __shfl_up(m_out, 1); if (lane == 0) m_in = 0.f;
    DEC[bh * 64 + lane] = __expf(cA + m_in - m_out);
    asm volatile("s_waitcnt vmcnt(0)" ::: "memory");
#pragma unroll 1
    for (int c4 = 0; c4 < 16; ++c4) {
        float bsv[4], av[4], pmv[4];
#pragma unroll
        for (int k = 0; k < 4; ++k) { const int ti = bh * 4096 + (c4 * 4 + k) * 64 + lane; bsv[k] = MLS[ti]; av[k] = MLS[MLN + ti]; pmv[k] = MLS[2 * MLN + ti]; }
#pragma unroll
        for (int k = 0; k < 4; ++k) {
            const int c = c4 * 4 + k;
            const float mi = __shfl(m_in, c), mo = __shfl(m_out, c), bl = __shfl(cA, c);
            const int ti = bh * 4096 + c * 64 + lane;
            const float mt = bsv[k] + fmaxf(mi, pmv[k]);
            MLS[2 * MLN + ti] = mt; MLS[3 * MLN + ti] = __expf(bl + av[k] - mo); MLS[4 * MLN + ti] = __expf(bsv[k] + mi - mt);
        }
    }
}
__device__ __forceinline__ void ml_conv8(const bf16* Z, const float* cw, const float* cb, int b, int t, int ch0, float (&y)[8]) {
    const f32x4 b0 = *(const f32x4*)(cb + ch0), b1 = *(const f32x4*)(cb + ch0 + 4);
    y[0] = b0[0]; y[1] = b0[1]; y[2] = b0[2]; y[3] = b0[3]; y[4] = b1[0]; y[5] = b1[1]; y[6] = b1[2]; y[7] = b1[3];
#pragma unroll
    for (int j = 0; j < 4; ++j) {
        const int tt = t - 3 + j;
        if (tt >= 0) {
            const u32x4 x = *(const u32x4*)(Z + ((size_t)b * SEQ + tt) * ZP + 768 + ch0);
            const f32x4 w0 = *(const f32x4*)(cw + j * 512 + ch0), w1 = *(const f32x4*)(cw + j * 512 + ch0 + 4);
            y[0] = fmaf(w0[0], bflo(x.x), y[0]); y[1] = fmaf(w0[1], bfhi(x.x), y[1]); y[2] = fmaf(w0[2], bflo(x.y), y[2]); y[3] = fmaf(w0[3], bfhi(x.y), y[3]);
            y[4] = fmaf(w1[0], bflo(x.z), y[4]); y[5] = fmaf(w1[1], bfhi(x.z), y[5]); y[6] = fmaf(w1[2], bflo(x.w), y[6]); y[7] = fmaf(w1[3], bfhi(x.w), y[7]);
        }
    }
#pragma unroll
    for (int i = 0; i < 8; ++i) y[i] = y[i] * sigmoidf_(y[i]);
}
__device__ __forceinline__ void mlB_item(const Params& p, int l, int bh, int ci, LAS unsigned char* lds, int wv) {
    const int tid = tid_fresh(wv), lane = tid & 63, half = lane >> 5, r32 = lane & 31, b = bh >> 2, h = bh & 3;
    const bf16* Z = (const bf16*)(p.ws + WS_BIG); const float* MLS = (const float*)(p.ws + WS_MLS);
    float* UT = (float*)(p.ws + WS_UT); float* UN = (float*)(p.ws + WS_UN);
    LAS bf16* KT = (LAS bf16*)lds; LAS bf16* VT = KT + 4 * 64 * 72;
    const float* cw = p.ml_conv_w + (size_t)l * 4 * 512; const float* cb = p.ml_conv_b + (size_t)l * 512;
    __syncthreads();
    {
        const int tt = tid >> 1, hr = tid & 1, cl = tt >> 6, s = tt & 63, t = (ci * 4) * 64 + tt;
        const float wk = MLS[3 * MLN + bh * 4096 + t];
#pragma unroll 1
        for (int q8 = 0; q8 < 4; ++q8) {
            const int d0 = hr * 32 + q8 * 8; float y[8];
            ml_conv8(Z, cw, cb, b, t, 256 + h * 64 + d0, y);
            LAS bf16* dst = KT + (cl * 64 + d0) * 72 + s;
#pragma unroll
            for (int i = 0; i < 8; ++i) dst[i * 72] = (bf16)f2bf(y[i] * wk);
            const u32x4 v = *(const u32x4*)(Z + ((size_t)b * SEQ + t) * ZP + 1280 + h * 64 + d0);
            LAS bf16* vd = VT + (cl * 64 + d0) * 72 + s;
            vd[0] = (bf16)(v.x & 0xffffu); vd[72] = (bf16)(v.x >> 16); vd[144] = (bf16)(v.y & 0xffffu); vd[216] = (bf16)(v.y >> 16);
            vd[288] = (bf16)(v.z & 0xffffu); vd[360] = (bf16)(v.z >> 16); vd[432] = (bf16)(v.w & 0xffffu); vd[504] = (bf16)(v.w >> 16);
        }
    }
    __syncthreads();
    const int cl = wv >> 1, dh = wv & 1, c = ci * 4 + cl;
    f32x16 acc[2];
#pragma unroll
    for (int eb = 0; eb < 2; ++eb)
#pragma unroll
        for (int r = 0; r < 16; ++r) acc[eb][r] = 0.f;
#pragma unroll
    for (int s4 = 0; s4 < 4; ++s4) {
        const s16x8 bk = *(const LAS s16x8*)(KT + (cl * 64 + dh * 32 + r32) * 72 + 16 * s4 + 8 * half);
#pragma unroll
        for (int eb = 0; eb < 2; ++eb) {
            const s16x8 av = *(const LAS s16x8*)(VT + (cl * 64 + eb * 32 + r32) * 72 + 16 * s4 + 8 * half);
            acc[eb] = __builtin_amdgcn_mfma_f32_32x32x16_bf16(av, bk, acc[eb], 0, 0, 0);
        }
    }
    float* ut = UT + ((size_t)(bh * 64 + c) * 64) * 64;
#pragma unroll
    for (int eb = 0; eb < 2; ++eb)
#pragma unroll
        for (int r = 0; r < 16; ++r) { const int e = eb * 32 + 8 * (r >> 2) + 4 * half + (r & 3); ut[e * 64 + dh * 32 + r32] = acc[eb][r]; }
    {
        const LAS bf16* kr = KT + (cl * 64 + dh * 32 + r32) * 72 + half * 32; float sm = 0.f;
#pragma unroll
        for (int i = 0; i < 4; ++i) { const u32x4 x = *(const LAS u32x4*)(kr + 8 * i); sm += (bflo(x.x) + bfhi(x.x)) + (bflo(x.y) + bfhi(x.y)) + (bflo(x.z) + bfhi(x.z)) + (bflo(x.w) + bfhi(x.w)); }
        sm += __shfl_xor(sm, 32);
        if (half == 0) UN[(bh * 64 + c) * 64 + dh * 32 + r32] = sm;
    }
}
__device__ __forceinline__ void mlS_item(const Params& p, int bh, int wv) {
    const int tid = tid_fresh(wv);
    const float* UT = (const float*)(p.ws + WS_UT) + (size_t)bh * 64 * 4096; const float* UN = (const float*)(p.ws + WS_UN) + bh * 4096;
    bf16* CT = (bf16*)(p.ws + WS_CT) + (size_t)bh * 64 * 4096; float* NV = (float*)(p.ws + WS_NV) + bh * 4096; const float* DEC = (const float*)(p.ws + WS_DEC) + bh * 64;
    f32x4 s0 = (f32x4){0.f, 0.f, 0.f, 0.f}, s1 = s0; float ns = 0.f;
#pragma unroll 4
    for (int c = 0; c < 64; ++c) {
        const float dec = DEC[c];
        const f32x4 u0 = *(const f32x4*)(UT + (size_t)c * 4096 + tid * 8), u1 = *(const f32x4*)(UT + (size_t)c * 4096 + tid * 8 + 4);
        u32x4 w; w.x = pk2(s0[0], s0[1]); w.y = pk2(s0[2], s0[3]); w.z = pk2(s1[0], s1[1]); w.w = pk2(s1[2], s1[3]);
        *(u32x4*)(CT + (size_t)c * 4096 + tid * 8) = w;
        s0 = s0 * dec + u0; s1 = s1 * dec + u1;
        if (tid < 64) { NV[c * 64 + tid] = ns; ns = ns * dec + UN[c * 64 + tid]; }
    }
}
__device__ __forceinline__ void mlD_item(const Params& p, int l, int bh, int ci, LAS unsigned char* lds, int wv) {
    const int tid = tid_fresh(wv), lane = tid & 63, half = lane >> 5, r32 = lane & 31, b = bh >> 2, h = bh & 3;
    const bf16* Z = (const bf16*)(p.ws + WS_BIG); const float* MLS = (const float*)(p.ws + WS_MLS); bf16* O1 = (bf16*)(p.ws + WS_O + OB_STRIDE);
    LAS bf16* Qs = (LAS bf16*)lds; LAS bf16* Ks = Qs + 4 * 64 * 72; LAS bf16* VT = Ks + 4 * 64 * 72;
    const float* cw = p.ml_conv_w + (size_t)l * 4 * 512; const float* cb = p.ml_conv_b + (size_t)l * 512;
    __syncthreads();
    {
        const int tt = tid >> 1, hr = tid & 1, cl = tt >> 6, s = tt & 63, t = (ci * 4) * 64 + tt;
#pragma unroll 1
        for (int q8 = 0; q8 < 4; ++q8) {
            const int d0 = hr * 32 + q8 * 8; float y[8];
            ml_conv8(Z, cw, cb, b, t, h * 64 + d0, y);
            u32x4 w; w.x = pk2(y[0] * 0.125f, y[1] * 0.125f); w.y = pk2(y[2] * 0.125f, y[3] * 0.125f); w.z = pk2(y[4] * 0.125f, y[5] * 0.125f); w.w = pk2(y[6] * 0.125f, y[7] * 0.125f);
            *(LAS u32x4*)(Qs + (cl * 64 + s) * 72 + d0) = w;
            ml_conv8(Z, cw, cb, b, t, 256 + h * 64 + d0, y);
            w.x = pk2(y[0], y[1]); w.y = pk2(y[2], y[3]); w.z = pk2(y[4], y[5]); w.w = pk2(y[6], y[7]);
            *(LAS u32x4*)(Ks + (cl * 64 + s) * 72 + d0) = w;
            const u32x4 v = *(const u32x4*)(Z + ((size_t)b * SEQ + t) * ZP + 1280 + h * 64 + d0);
            LAS bf16* vd = VT + (cl * 64 + d0) * 72 + s;
            vd[0] = (bf16)(v.x & 0xffffu); vd[72] = (bf16)(v.x >> 16); vd[144] = (bf16)(v.y & 0xffffu); vd[216] = (bf16)(v.y >> 16);
            vd[288] = (bf16)(v.z & 0xffffu); vd[360] = (bf16)(v.z >> 16); vd[432] = (bf16)(v.w & 0xffffu); vd[504] = (bf16)(v.w >> 16);
        }
    }
    __syncthreads();
    const int cl = wv >> 1, th = wv & 1, c = ci * 4 + cl, tloc = th * 32 + r32, tseq = c * 64 + tloc;
    const int ti = bh * 4096 + tseq;
    const float bs_t = MLS[ti], mt_t = MLS[2 * MLN + ti], iw_t = MLS[4 * MLN + ti];
    s16x8 qf[4];
#pragma unroll
    for (int s4 = 0; s4 < 4; ++s4) qf[s4] = *(const LAS s16x8*)(Qs + (cl * 64 + tloc) * 72 + 16 * s4 + 8 * half);
    f32x16 oacc[2];
#pragma unroll
    for (int eb = 0; eb < 2; ++eb)
#pragma unroll
        for (int r = 0; r < 16; ++r) oacc[eb][r] = 0.f;
    const bf16* CT = (const bf16*)(p.ws + WS_CT) + (size_t)(bh * 64 + c) * 4096;
#pragma unroll
    for (int s4 = 0; s4 < 4; ++s4)
#pragma unroll
        for (int eb = 0; eb < 2; ++eb) { const s16x8 ac = *(const s16x8*)(CT + (eb * 32 + r32) * 64 + 16 * s4 + 8 * half);
            oacc[eb] = __builtin_amdgcn_mfma_f32_32x32x16_bf16(ac, qf[s4], oacc[eb], 0, 0, 0); }
#pragma unroll
    for (int eb = 0; eb < 2; ++eb)
#pragma unroll
        for (int r = 0; r < 16; ++r) oacc[eb][r] *= iw_t;
    float qn = 0.f;
    { const float* nvp = (const float*)(p.ws + WS_NV) + (bh * 64 + c) * 64;
#pragma unroll
      for (int s4 = 0; s4 < 4; ++s4) { const f32x4 n0 = *(const f32x4*)(nvp + 16 * s4 + 8 * half), n1 = *(const f32x4*)(nvp + 16 * s4 + 8 * half + 4);
          const u32x4 qq = __builtin_bit_cast(u32x4, qf[s4]);
          qn += bflo(qq.x) * n0[0] + bfhi(qq.x) * n0[1] + bflo(qq.y) * n0[2] + bfhi(qq.y) * n0[3] + bflo(qq.z) * n1[0] + bfhi(qq.z) * n1[1] + bflo(qq.w) * n1[2] + bfhi(qq.w) * n1[3]; } }
    qn += __shfl_xor(qn, 32);
    float rs = 0.f;
#pragma unroll
    for (int sb = 0; sb < 2; ++sb) {
        if (sb <= th) {
            f32x16 sacc;
#pragma unroll
            for (int r = 0; r < 16; ++r) sacc[r] = 0.f;
#pragma unroll
            for (int s4 = 0; s4 < 4; ++s4) { const s16x8 ak = *(const LAS s16x8*)(Ks + (cl * 64 + sb * 32 + r32) * 72 + 16 * s4 + 8 * half);
                sacc = __builtin_amdgcn_mfma_f32_32x32x16_bf16(ak, qf[s4], sacc, 0, 0, 0); }
            const float* ap = MLS + MLN + bh * 4096 + c * 64 + sb * 32 + 4 * half;
#pragma unroll
            for (int g = 0; g < 4; ++g) { const f32x4 av = *(const f32x4*)(ap + 8 * g);
#pragma unroll
                for (int i = 0; i < 4; ++i) { const int s = sb * 32 + 8 * g + 4 * half + i; const float v = (s <= tloc) ? sacc[4 * g + i] * __expf(bs_t + av[i] - mt_t) : 0.f; sacc[4 * g + i] = v; rs += v; } }
#pragma unroll
            for (int s2 = 0; s2 < 2; ++s2) {
                u32x4 w; w.x = pkbf(sacc[8 * s2], sacc[8 * s2 + 1]); w.y = pkbf(sacc[8 * s2 + 2], sacc[8 * s2 + 3]); w.z = pkbf(sacc[8 * s2 + 4], sacc[8 * s2 + 5]); w.w = pkbf(sacc[8 * s2 + 6], sacc[8 * s2 + 7]);
                const s16x8 pf = __builtin_bit_cast(s16x8, w);
#pragma unroll
                for (int eb = 0; eb < 2; ++eb) {
                    const LAS bf16* vr = VT + (cl * 64 + eb * 32 + r32) * 72 + sb * 32 + 16 * s2 + 4 * half;
                    const u32x2 v0 = *(const LAS u32x2*)vr, v1 = *(const LAS u32x2*)(vr + 8);
                    const u32x4 vv = (u32x4){v0.x, v0.y, v1.x, v1.y};
                    oacc[eb] = __builtin_amdgcn_mfma_f32_32x32x16_bf16(__builtin_bit_cast(s16x8, vv), pf, oacc[eb], 0, 0, 0);
                }
            }
        }
    }
    rs += __shfl_xor(rs, 32);
    const float den = iw_t * qn + rs;
    const float dn = 1.f / fmaxf(fabsf(den), __expf(-mt_t));
    float ss = 0.f;
#pragma unroll
    for (int eb = 0; eb < 2; ++eb)
#pragma unroll
        for (int r = 0; r < 16; ++r) { const float v = oacc[eb][r] * dn; oacc[eb][r] = v; ss = fmaf(v, v, ss); }
    ss += __shfl_xor(ss, 32);
    const float rr = 1.f / sqrtf(ss * (1.f / 64.f) + EPS);
    const size_t tok = (size_t)b * SEQ + tseq;
    const float* hg = p.ml_head_norm + l * 64;
#pragma unroll
    for (int eb = 0; eb < 2; ++eb)
#pragma unroll
        for (int g = 0; g < 4; ++g) { const int e0 = eb * 32 + 8 * g + 4 * half; const f32x4 gg = *(const f32x4*)(hg + e0);
            const u32x2 og = *(const u32x2*)(Z + tok * ZP + 1536 + h * 64 + e0);
            u32x2 w; w.x = pkbf(sigmoidf_(bflo(og.x)) * oacc[eb][4 * g] * rr * gg[0], sigmoidf_(bfhi(og.x)) * oacc[eb][4 * g + 1] * rr * gg[1]);
            w.y = pkbf(sigmoidf_(bflo(og.y)) * oacc[eb][4 * g + 2] * rr * gg[2], sigmoidf_(bfhi(og.y)) * oacc[eb][4 * g + 3] * rr * gg[3]);
            *(u32x2*)(O1 + tok * 256 + h * 64 + e0) = w; }
}
__device__ __forceinline__ unsigned mono_bits(float s) { s = (s == 0.f) ? 0.f : s; const unsigned u = __float_as_uint(s); return (u & 0x80000000u) ? ~u : (u | 0x80000000u); }
__device__ __forceinline__ void dsa_item(const Params& p, int b, int qt, LAS unsigned char* lds, int wv) {
    const int tid = tid_fresh(wv), lane = tid & 63, w = tid >> 6, half = lane >> 5, r32 = lane & 31;
    const bf16* Z = (const bf16*)(p.ws + WS_BIG); const float* ZS = (const float*)(p.ws + WS_ZS); const bf16* IK = (const bf16*)(p.ws + WS_IK); bf16* O3 = (bf16*)(p.ws + WS_O + 3 * OB_STRIDE);
    LAS unsigned* hist = (LAS unsigned*)lds + w * 1024;
    LAS int* list = (LAS int*)(lds + 32768) + w * 1024;
    LAS float* qs = (LAS float*)(lds + 65536) + w * 256;
    LAS float* P = (LAS float*)(lds + 98304) + w * 1024;
    const size_t tokb = (size_t)b * SEQ; const int tb = qt * 32 + 4 * w;
    const int ntiles = ((tb + 3) >> 5) + 1;
    s16x8 aq0, aq1;
    { const bf16* ap = Z + (tokb + tb + (r32 >> 3)) * ZP + 2816 + (r32 & 7) * 32 + half * 8; aq0 = *(const s16x8*)ap; aq1 = *(const s16x8*)(ap + 16); }
    float wq[4][4];
#pragma unroll
    for (int g = 0; g < 4; ++g) { const f32x4 x = *(const f32x4*)(ZS + (tokb + tb + g) * ZSP + 160 + 4 * half); wq[g][0] = x[0]; wq[g][1] = x[1]; wq[g][2] = x[2]; wq[g][3] = x[3]; }
    unsigned tau[4] = {0u, 0u, 0u, 0u}; int quota[4] = {1 << 30, 1 << 30, 1 << 30, 1 << 30};
#define DSA_SCORES(kt, sc) do { const bf16* kp_ = IK + (tokb + (size_t)(kt) * 32 + r32) * 32 + half * 8; \
        const s16x8 b0_ = *(const s16x8*)kp_, b1_ = *(const s16x8*)(kp_ + 16); f32x16 a_ = {0.f, 0.f, 0.f, 0.f, 0.f, 0.f, 0.f, 0.f, 0.f, 0.f, 0.f, 0.f, 0.f, 0.f, 0.f, 0.f}; \
        a_ = __builtin_amdgcn_mfma_f32_32x32x16_bf16(aq0, b0_, a_, 0, 0, 0); a_ = __builtin_amdgcn_mfma_f32_32x32x16_bf16(aq1, b1_, a_, 0, 0, 0); \
        _Pragma("unroll") for (int g_ = 0; g_ < 4; ++g_) { float pt_ = wq[g_][0] * fmaxf(a_[4 * g_], 0.f); pt_ = fmaf(wq[g_][1], fmaxf(a_[4 * g_ + 1], 0.f), pt_); \
            pt_ = fmaf(wq[g_][2], fmaxf(a_[4 * g_ + 2], 0.f), pt_); pt_ = fmaf(wq[g_][3], fmaxf(a_[4 * g_ + 3], 0.f), pt_); sc[g_] = pt_ + __shfl_xor(pt_, 32); } } while (0)
    if (tb >= 256) {
        unsigned prefix[4] = {0u, 0u, 0u, 0u}; int krem[4] = {256, 256, 256, 256}; int cnteq[4] = {0, 0, 0, 0};
#pragma unroll 1
        for (int pass = 0; pass < 4; ++pass) {
            const int shift = 24 - 8 * pass;
#pragma unroll
            for (int i = 0; i < 4; ++i) *(LAS u32x4*)(hist + (i * 64 + lane) * 4) = (u32x4){0u, 0u, 0u, 0u};
            LDS_WAIT();
            const unsigned pfa = half ? prefix[2] : prefix[0], pfb = half ? prefix[3] : prefix[1];
            const int ta = tb + 2 * half, tbq = ta + 1;
#pragma unroll 1
            for (int kt = 0; kt < ntiles; ++kt) {
                float sc[4]; DSA_SCORES(kt, sc);
                const int key = kt * 32 + r32;
                const unsigned ma = mono_bits(half ? sc[2] : sc[0]), mb = mono_bits(half ? sc[3] : sc[1]);
                const bool oka = (key <= ta) && (pass == 0 || (ma >> (shift + 8)) == pfa);
                const bool okb = (key <= tbq) && (pass == 0 || (mb >> (shift + 8)) == pfb);
                if (oka) atomicAdd((unsigned*)(hist + (2 * half) * 256 + ((ma >> shift) & 255u)), 1u);
                if (okb) atomicAdd((unsigned*)(hist + (2 * half + 1) * 256 + ((mb >> shift) & 255u)), 1u);
            }
            LDS_WAIT();
#pragma unroll
            for (int g = 0; g < 4; ++g) {
                const u32x4 cv = *(const LAS u32x4*)(hist + g * 256 + lane * 4);
                const int c0 = (int)cv.x, c1 = (int)cv.y, c2 = (int)cv.z, c3 = (int)cv.w, tot = c0 + c1 + c2 + c3;
                int v = tot;
#pragma unroll
                for (int d = 1; d < 64; d <<= 1) { const int n = __shfl_down(v, d); if (lane + d < 64) v += n; }
                const int a3 = v - tot, a2 = a3 + c3, a1 = a2 + c2, a0 = a1 + c1; const int k = krem[g];
                int fb = -1, fa = 0, fc = 0;
                if (a3 < k && a3 + c3 >= k) { fb = 3; fa = a3; fc = c3; }
                else if (a2 < k && a2 + c2 >= k) { fb = 2; fa = a2; fc = c2; }
                else if (a1 < k && a1 + c1 >= k) { fb = 1; fa = a1; fc = c1; }
                else if (a0 < k && a0 + c0 >= k) { fb = 0; fa = a0; fc = c0; }
                const unsigned long long mk = __ballot(fb >= 0);
                const int src = (int)__builtin_ctzll(mk | (1ull << 63));
                const int bin = __shfl(4 * lane + fb, src), above = __shfl(fa, src), cnt = __shfl(fc, src);
                prefix[g] = (prefix[g] << 8) | (unsigned)bin; krem[g] = k - above; cnteq[g] = cnt;
            }
        }
#pragma unroll
        for (int g = 0; g < 4; ++g) { tau[g] = prefix[g]; quota[g] = krem[g]; }
        (void)cnteq;
    }
    int base[4] = {0, 0, 0, 0}, eqseen[4] = {0, 0, 0, 0};
    const unsigned lowmask = (1u << r32) - 1u;
#pragma unroll 1
    for (int kt = 0; kt < ntiles; ++kt) {
        float sc[4]; DSA_SCORES(kt, sc);
        const int key = kt * 32 + r32;
#pragma unroll
        for (int g = 0; g < 4; ++g) {
            const unsigned m = mono_bits(sc[g]); const bool valid = key <= tb + g;
            const bool eq = valid && (m == tau[g]);
            const unsigned beq = (unsigned)__ballot(eq);
            const int rank = eqseen[g] + __popc(beq & lowmask);
            const bool sel = valid && ((m > tau[g]) || (eq && rank < quota[g]));
            const unsigned bsel = (unsigned)__ballot(sel);
            if (sel && half == 0) { const int pos = base[g] + __popc(bsel & lowmask); if (pos < 256) list[g * 256 + pos] = key; }
            base[g] += __popc(bsel); eqseen[g] += __popc(beq);
        }
    }
    LDS_WAIT();
#pragma unroll 1
    for (int g = 0; g < 4; ++g) {
        const int cnt = min(base[g], 256); const size_t tok = tokb + tb + g;
        { const unsigned long long wv = *((const unsigned long long*)(Z + tok * ZP + 2560) + lane);
          *(LAS f32x4*)(qs + lane * 4) = (f32x4){bflo((unsigned)wv), bfhi((unsigned)wv), bflo((unsigned)(wv >> 32)), bfhi((unsigned)(wv >> 32))}; }
        LDS_WAIT();
        float acc[4][4]; const float* kp[4]; bool vld[4];
#pragma unroll
        for (int i = 0; i < 4; ++i) { const int n = lane + 64 * i; vld[i] = n < cnt; const int s = vld[i] ? list[g * 256 + n] : 0; kp[i] = ZS + (tokb + s) * ZSP;
#pragma unroll
            for (int hh = 0; hh < 4; ++hh) acc[i][hh] = 0.f; }
#pragma unroll 4
        for (int dc = 0; dc < 16; ++dc) {
            f32x4 kv[4];
#pragma unroll
            for (int i = 0; i < 4; ++i) kv[i] = *(const f32x4*)(kp[i] + dc * 4);
#pragma unroll
            for (int hh = 0; hh < 4; ++hh) { const f32x4 qv = *(const LAS f32x4*)(qs + hh * 64 + dc * 4);
#pragma unroll
                for (int i = 0; i < 4; ++i) acc[i][hh] = fmaf(qv[0], kv[i][0], fmaf(qv[1], kv[i][1], fmaf(qv[2], kv[i][2], fmaf(qv[3], kv[i][3], acc[i][hh])))); }
        }
        float sum[4];
#pragma unroll
        for (int hh = 0; hh < 4; ++hh) { float mx = -INFINITY;
#pragma unroll
            for (int i = 0; i < 4; ++i) mx = fmaxf(mx, vld[i] ? acc[i][hh] : -INFINITY);
            mx = wave_max(mx); float sm = 0.f;
#pragma unroll
            for (int i = 0; i < 4; ++i) { acc[i][hh] = vld[i] ? __expf(acc[i][hh] - mx) : 0.f; sm += acc[i][hh]; }
            sum[hh] = wave_sum(sm); }
#pragma unroll
        for (int i = 0; i < 4; ++i) *(LAS f32x4*)(P + (lane + 64 * i) * 4) = (f32x4){acc[i][0], acc[i][1], acc[i][2], acc[i][3]};
        LDS_WAIT();
        float oa[4] = {0.f, 0.f, 0.f, 0.f};
        const float* vb = ZS + tokb * ZSP + 64 + lane;
#pragma unroll 8
        for (int n = 0; n < cnt; ++n) { const int s = list[g * 256 + n]; const f32x4 pv = *(const LAS f32x4*)(P + n * 4); const float v = vb[(size_t)s * ZSP];
            oa[0] = fmaf(pv[0], v, oa[0]); oa[1] = fmaf(pv[1], v, oa[1]); oa[2] = fmaf(pv[2], v, oa[2]); oa[3] = fmaf(pv[3], v, oa[3]); }
#pragma unroll
        for (int hh = 0; hh < 4; ++hh) O3[tok * 256 + hh * 64 + lane] = (bf16)f2bf(oa[hh] / sum[hh]);
        LDS_WAIT();
    }
#undef DSA_SCORES
}

constexpr int Q_ML = 32, Q_DIFF = 512, Q_DSA = 1024, Q_SB = 256, Q_TOTAL = Q_ML + Q_DIFF + Q_DSA + Q_SB;
__device__ __forceinline__ Params load_params() {
#if defined(__HIP_DEVICE_COMPILE__)
    const __attribute__((address_space(4))) Params* pp = (const __attribute__((address_space(4))) Params*)__builtin_amdgcn_kernarg_segment_ptr();
    asm volatile("" : "+s"(pp));
    Params r;
    r.x = pp->x; r.pos = pp->pos; r.ffn1_norm = pp->ffn1_norm; r.ffn1_gu = pp->ffn1_gu; r.ffn1_down = pp->ffn1_down; r.mix_norm = pp->mix_norm; r.w_in = pp->w_in; r.diff_qk_norm = pp->diff_qk_norm;
    r.diff_lambda = pp->diff_lambda; r.diff_head_norm = pp->diff_head_norm; r.ml_conv_w = pp->ml_conv_w; r.ml_conv_b = pp->ml_conv_b; r.ml_gate_bias = pp->ml_gate_bias; r.ml_head_norm = pp->ml_head_norm;
    r.dsa_qk_norm = pp->dsa_qk_norm; r.w_branch = pp->w_branch; r.w_out = pp->w_out; r.ffn2_norm = pp->ffn2_norm; r.ffn2_gu = pp->ffn2_gu; r.ffn2_down = pp->ffn2_down; r.out = pp->out; r.ws = pp->ws;
    return r;
#else
    return Params{};
#endif
}
__device__ __forceinline__ int next_item(unsigned* ctr, LAS int* slot, int wv) {
    __syncthreads();
    if (tid_fresh(wv) == 0) *slot = (int)atomicAdd(ctr, 1u);
    __syncthreads();
    return *slot;
}
__device__ __forceinline__ void mixer_phase1(int l, LAS unsigned char* lds, int wv) {
    LAS int* slot = (LAS int*)(lds + LDS_BYTES - 64);
    { const Params p = load_params(); unsigned* ctr = (unsigned*)(p.ws + WS_CTL) + 64 * (4 * l + 0);
      for (;;) { const int it = next_item(ctr, slot, wv); if (it >= Q_DIFF) break; diffm_item(p, l, it & 31, 15 - (it >> 5), lds, wv); } }
    { const Params p = load_params(); unsigned* ctr = (unsigned*)(p.ws + WS_CTL) + 64 * (4 * l + 1);
      for (;;) { const int it = next_item(ctr, slot, wv); if (it >= 512) break; mlB_item(p, l, it & 31, it >> 5, lds, wv); } }
}
__device__ __forceinline__ void mixer_phase2(int l, LAS unsigned char* lds, int wv) {
    LAS int* slot = (LAS int*)(lds + LDS_BYTES - 64);
    { const Params p = load_params(); unsigned* ctr = (unsigned*)(p.ws + WS_CTL) + 64 * (4 * l + 2);
      for (;;) { const int it = next_item(ctr, slot, wv); if (it >= 32 + Q_DSA) break;
          if (it < 32) mlS_item(p, it, wv); else { const int i = it - 32; dsa_item(p, i & 7, 127 - (i >> 3), lds, wv); } } }
}
__device__ __forceinline__ void mixer_phase3(int l, LAS unsigned char* lds, int wv) {
    LAS int* slot = (LAS int*)(lds + LDS_BYTES - 64);
    { const Params p = load_params(); unsigned* ctr = (unsigned*)(p.ws + WS_CTL) + 64 * (4 * l + 3);
      for (;;) { const int it = next_item(ctr, slot, wv); if (it >= 512) break; mlD_item(p, l, it & 31, it >> 5, lds, wv); } }
    { const Params p = load_params(); unsigned* ctr = (unsigned*)(p.ws + WS_CTL) + 64 * (8 + l);
      for (;;) { const int it = next_item(ctr, slot, wv); if (it >= Q_SB) break; sb_item(p, it >> 3, it & 7, lds, wv); } }
}

#define PH_LOCALS const Params p = load_params(); const int tid = tid_fresh(wv), lane = tid & 63, wave = tid >> 6; const int gw = (int)blockIdx.x * NWAVES + wave, ngw = (int)gridDim.x * NWAVES; \
    (void)lane; (void)gw; (void)ngw; bf16* HN = (bf16*)(p.ws + WS_HN); bf16* BIGB = (bf16*)(p.ws + WS_BIG); (void)HN; (void)BIGB;
template <int l> __device__ __forceinline__ void layer_body(cg::grid_group& grid, LAS unsigned char* lds, const int wv) {
        { PH_LOCALS const unsigned char* wl = p.ws + WS_W + (size_t)l * WL_STRIDE; EpiSwiglu E{BIGB}; run_gemm(lds, HN, (const bf16*)(wl + WL_GU1), T, 2 * FF, D, E, wv); }
        grid.sync();
        { PH_LOCALS const unsigned char* wl = p.ws + WS_W + (size_t)l * WL_STRIDE; EpiResid E{l == 0 ? p.x : p.out, p.out, 0.5f}; run_gemm(lds, BIGB, (const bf16*)(wl + WL_D1), T, D, FF, E, wv); }
        grid.sync();
        { PH_LOCALS rms_rows(p.out, p.mix_norm + l * D, HN, gw, ngw, lane); }
        grid.sync();
        { PH_LOCALS const unsigned char* wl = p.ws + WS_W + (size_t)l * WL_STRIDE; EpiZ E{BIGB, (float*)(p.ws + WS_ZS)}; run_gemm(lds, HN, (const bf16*)(wl + WL_INA), T, 3328, D, E, wv); }
        grid.sync();
        { PH_LOCALS if (gw < 32) ml_prepass(p, l, gw, lane); prep_phase(p, l, gw, ngw, lane); }
        grid.sync();
        mixer_phase1(l, lds, wv);
        grid.sync();
        mixer_phase2(l, lds, wv);
        grid.sync();
        mixer_phase3(l, lds, wv);
        grid.sync();
#pragma unroll 1
        for (int b = 0; b < 4; ++b) {
            { PH_LOCALS const unsigned char* wl = p.ws + WS_W + (size_t)l * WL_STRIDE; EpiSig E{BIGB}; run_gemm(lds, HN, (const bf16*)(wl + WL_G) + (size_t)b * D * D, T, D, D, E, wv); }
            grid.sync();
            { PH_LOCALS const unsigned char* wl = p.ws + WS_W + (size_t)l * WL_STRIDE; EpiGate E{BIGB, (float*)(p.ws + WS_BIG + 64 * MiB), HN, b == 0 ? 0 : (b == 3 ? 2 : 1)};
              run_gemm(lds, (const bf16*)(p.ws + WS_O + b * OB_STRIDE), (const bf16*)(wl + WL_BR) + (size_t)b * D * 256, T, D, 256, E, wv); }
            grid.sync();
        }
        { PH_LOCALS const unsigned char* wl = p.ws + WS_W + (size_t)l * WL_STRIDE; EpiResid E{p.out, p.out, 1.0f}; run_gemm(lds, HN, (const bf16*)(wl + WL_OUT), T, D, D, E, wv); }
        grid.sync();
        { PH_LOCALS rms_rows(p.out, p.ffn2_norm + l * D, HN, gw, ngw, lane); }
        grid.sync();
        { PH_LOCALS const unsigned char* wl = p.ws + WS_W + (size_t)l * WL_STRIDE; EpiSwiglu E{BIGB}; run_gemm(lds, HN, (const bf16*)(wl + WL_GU2), T, 2 * FF, D, E, wv); }
        grid.sync();
        { PH_LOCALS const unsigned char* wl = p.ws + WS_W + (size_t)l * WL_STRIDE; EpiResid E{p.out, p.out, 0.5f}; run_gemm(lds, BIGB, (const bf16*)(wl + WL_D2), T, D, FF, E, wv); }
        if (l + 1 < DEPTH) {
            grid.sync();
            { PH_LOCALS rms_rows(p.out, p.ffn1_norm + (l + 1) * D, HN, gw, ngw, lane); }
            grid.sync();
        }
    }

__global__ void __launch_bounds__(NTHR, 2) hybrid_fwd(Params p_unused) {
    extern __shared__ __attribute__((aligned(16))) unsigned char lds_raw[];
    LAS unsigned char* lds = (LAS unsigned char*)lds_raw;
    cg::grid_group grid = cg::this_grid();
    const int wv = __builtin_amdgcn_readfirstlane((int)threadIdx.x >> 6);
    {
        PH_LOCALS
        SegRun R; R.base = 0; R.gw = gw; R.ngw = ngw; R.lane = lane; R.scr = (LAS float*)(lds + wave * 8704);
        for (int l = 0; l < DEPTH; ++l) convert_weights(p, l, R);
        if (blockIdx.x == 0 && tid < 16) ((unsigned*)(p.ws + WS_CTL))[64 * tid] = 0u;
        rms_rows(p.x, p.ffn1_norm, HN, gw, ngw, lane);
    }
    grid.sync();
    layer_body<0>(grid, lds, wv);
    layer_body<1>(grid, lds, wv);
}

extern "C" void kernel_launch(void* const* d_in, const int* in_sizes, int n_in, void* d_out, int out_size, void* d_ws, size_t ws_size, hipStream_t stream) {
    static int grid = 0;
    if (grid == 0) {
        if (n_in != 20 || out_size != T * D || ws_size < WS_END2) { fprintf(stderr, "kernel_launch: unexpected shapes (n_in %d out %d ws %zu)\n", n_in, out_size, ws_size); grid = -1; return; }
        int dev = 0, cus = 0, per_cu = 0;
        hipGetDevice(&dev); hipDeviceGetAttribute(&cus, hipDeviceAttributeMultiprocessorCount, dev);
        hipFuncSetAttribute((const void*)hybrid_fwd, hipFuncAttributeMaxDynamicSharedMemorySize, LDS_BYTES);
        hipOccupancyMaxActiveBlocksPerMultiprocessor(&per_cu, (const void*)hybrid_fwd, NTHR, LDS_BYTES);
        if (per_cu < 1) { fprintf(stderr, "kernel_launch: occupancy query says %d\n", per_cu); per_cu = 1; }
        (void)hipGetLastError();
        grid = cus * 1;
    }
    if (grid < 0) return;
    Params p{};
    p.x = (const float*)d_in[0]; p.pos = (const int*)d_in[1];
    p.ffn1_norm = (const float*)d_in[2]; p.ffn1_gu = (const float*)d_in[3]; p.ffn1_down = (const float*)d_in[4]; p.mix_norm = (const float*)d_in[5]; p.w_in = (const float*)d_in[6];
    p.diff_qk_norm = (const float*)d_in[7]; p.diff_lambda = (const float*)d_in[8]; p.diff_head_norm = (const float*)d_in[9]; p.ml_conv_w = (const float*)d_in[10]; p.ml_conv_b = (const float*)d_in[11];
    p.ml_gate_bias = (const float*)d_in[12]; p.ml_head_norm = (const float*)d_in[13]; p.dsa_qk_norm = (const float*)d_in[14]; p.w_branch = (const float*)d_in[15]; p.w_out = (const float*)d_in[16];
    p.ffn2_norm = (const float*)d_in[17]; p.ffn2_gu = (const float*)d_in[18]; p.ffn2_down = (const float*)d_in[19];
    p.out = (float*)d_out; p.ws = (unsigned char*)d_ws;
    void* args[] = {&p};
    hipError_t e = hipLaunchCooperativeKernel((const void*)hybrid_fwd, dim3(grid), dim3(NTHR), args, LDS_BYTES, stream);
    if (e != hipSuccess) fprintf(stderr, "cooperative launch failed: %s (grid %d)\n", hipGetErrorString(e), grid);
}
```

```cpp
#include <hip/hip_runtime.h>
#include <hip/hip_cooperative_groups.h>
#include <cstdio>
#include <cstdint>
namespace cg = cooperative_groups;
#ifndef PROBE_DUP
#define PROBE_DUP 0
#endif
namespace pg8 {
#define PG8_LAS __attribute__((address_space(3)))
typedef unsigned short bf16_t;
typedef short bf16x8 __attribute__((ext_vector_type(8)));
typedef float f32x4 __attribute__((ext_vector_type(4)));
typedef unsigned u32x4 __attribute__((ext_vector_type(4)));
constexpr int BM = 256, BK = 64, HALF = 128, HTB = HALF * BK * 2  , STAGE_BYTES = 8 * HTB, NXCD = 8, WGM = 8;

__host__ __device__ __forceinline__ int lds_byte(int r, int c) { const int st = (r >> 4) * 2 + (c >> 5), rr = r & 15, cc = c & 31, ob = rr * 64 + cc * 2; return st * 1024 + (ob ^ (((ob >> 9) & 1) << 5)); }
__host__ __device__ __forceinline__ void stage_rc(int b, int& R, int& C) { const int st = b / 1024, sb = b % 1024, swz = sb ^ (((sb >> 9) & 1) << 5); R = (st >> 1) * 16 + swz / 64; C = (st & 1) * 32 + (swz % 64) / 2; }
__host__ __device__ __forceinline__ int perm32(int rho) { const int n = rho >> 4, i = rho & 15; return 8 * (i >> 2) + 4 * n + (i & 3); }

struct Unit { int pm, pn; };
struct Gemm { const bf16_t* A; const bf16_t* Bt; int M, N, K; };

struct StaticOrder {
    int nM, nN, nwg, G, c;
    __host__ __device__ void init(int M, int N, int G_, int c_) { nM = M / BM; nN = N / BM; nwg = nM * nN; G = G_; c = c_; }
    __host__ __device__ bool next(int i, Unit& u) const {
        const long L = (long)i * G + c; if (L >= nwg) return false;
        int wgid = (int)L; { const int q = nwg / NXCD, r = nwg % NXCD, xcd = wgid % NXCD, off = wgid / NXCD; wgid = (xcd < r ? xcd * (q + 1) : r * (q + 1) + (xcd - r) * q) + off; }
        const int nig = WGM * nN, gid = wgid / nig, fm = gid * WGM, gsz = (nM - fm) < WGM ? (nM - fm) : WGM;
        u.pm = fm + ((wgid % nig) % gsz); u.pn = (wgid % nig) / gsz; return true;
    }
    __device__ __forceinline__ void a_ready(const Unit&) const {}
    __device__ __forceinline__ void done(const Unit&) const {}
};

__device__ __forceinline__ unsigned cvt_pk_bf16(float lo, float hi) { unsigned r; asm volatile("v_cvt_pk_bf16_f32 %0, %1, %2" : "=v"(r) : "v"(lo), "v"(hi)); return r; }
template <class Epi, class Sched, bool ALIGN_EPI = false, bool SP2 = false>
__device__ __forceinline__ void gemm_phase(PG8_LAS unsigned char* lds, const Gemm g, const Sched& S, const Epi& E, const int wave_in) {
    unsigned z_ = 0u; asm volatile("" : "+v"(z_)); int w_ = wave_in; asm volatile("" : "+s"(w_));
    const int tid_ = w_ * 64 + (int)__builtin_amdgcn_mbcnt_hi(~0u, __builtin_amdgcn_mbcnt_lo(~0u, z_));
    const int tid = tid_, wid = __builtin_amdgcn_readfirstlane(tid >> 6), lane = tid & 63, wr = wid >> 2, wc = wid & 3, fr = lane & 15, fq = lane >> 4;
    const int K = g.K, nt = K / BK;
    unsigned voffA[2], voffB[2];
#pragma unroll
    for (int i = 0; i < 2; ++i) { int R, C; stage_rc(tid * 16 + i * 8192, R, C); const int Rb = Epi::PERM ? ((R & ~31) + perm32(R & 31)) : R;
        voffA[i] = (unsigned)(R * K + C) * 2u; voffB[i] = (unsigned)(Rb * K + C) * 2u; }
    const size_t kstep = (size_t)(BK * 2);
    const size_t hstep = (size_t)HALF * K * 2;
    const size_t tstep = 2 * hstep;
    const unsigned ldsw = (unsigned)wid * 1024u;
    const int aoff = lds_byte(wr * 64 + fr, fq * 8), boff = lds_byte(wc * 32 + fr, fq * 8);
#define PG8_SA(b, h) (((b) * 2 + (h)) * HTB)
#define PG8_SB(b, h) ((4 + (b) * 2 + (h)) * HTB)
#define PG8_STAGE(bufoff, gbase, voff) do { _Pragma("unroll") for (int _i = 0; _i < 2; ++_i) \
        __builtin_amdgcn_global_load_lds((const unsigned*)((const char*)(gbase) + (voff)[_i]), (PG8_LAS unsigned*)(lds + (bufoff) + ldsw + _i * 8192), 16, 0, 0); } while (0)
#define PG8_LDA(dst, b, h) do { _Pragma("unroll") for (int m = 0; m < 4; ++m) _Pragma("unroll") for (int k = 0; k < 2; ++k) dst[m][k] = *(const PG8_LAS bf16x8*)(lds + PG8_SA(b, h) + aoff + m * 2048 + k * 1024); } while (0)
#define PG8_LDB(dst, b, h) do { _Pragma("unroll") for (int n = 0; n < 2; ++n) _Pragma("unroll") for (int k = 0; k < 2; ++k) dst[n][k] = *(const PG8_LAS bf16x8*)(lds + PG8_SB(b, h) + boff + n * 2048 + k * 1024); } while (0)
#define PG8_MMA(ai, bj, At, Bt) do { __builtin_amdgcn_s_setprio(1); _Pragma("unroll") for (int m = 0; m < 4; ++m) _Pragma("unroll") for (int n = 0; n < 2; ++n) _Pragma("unroll") for (int k = 0; k < 2; ++k) \
        acc[ai][bj][m][n] = __builtin_amdgcn_mfma_f32_16x16x32_bf16(Bt[n][k], At[m][k], acc[ai][bj][m][n], 0, 0, 0); __builtin_amdgcn_s_setprio(0); } while (0)
#define PG8_WAIT_V(n) asm volatile("s_waitcnt vmcnt(" #n ")" ::: "memory")
#define PG8_WAIT_L(n) asm volatile("s_waitcnt lgkmcnt(" #n ")" ::: "memory")
#define PG8_BAR __builtin_amdgcn_s_barrier()
#define PG8_SCHED __builtin_amdgcn_sched_barrier(0)
    Unit cur, nxt; int ui = 0;
    if (!S.next(0, cur)) return;
    f32x4 acc[2][2][4][2];
#pragma unroll
    for (int a = 0; a < 2; ++a)
#pragma unroll
        for (int b = 0; b < 2; ++b)
#pragma unroll
            for (int m = 0; m < 4; ++m)
#pragma unroll
                for (int n = 0; n < 2; ++n) acc[a][b][m][n] = (f32x4){0.f, 0.f, 0.f, 0.f};
    bf16x8 At[4][2], B0[2][2], B1[2][2];
    const char* cA = (const char*)g.A + (size_t)cur.pm * tstep; const char* cB = (const char*)g.Bt + (size_t)cur.pn * tstep;
    S.a_ready(cur);
    if constexpr (SP2) {
        PG8_STAGE(PG8_SB(0, 0), cB, voffB); PG8_STAGE(PG8_SB(0, 1), cB + hstep, voffB); PG8_STAGE(PG8_SA(0, 0), cA, voffA); PG8_STAGE(PG8_SA(0, 1), cA + hstep, voffA);
        if (wr == 1) PG8_BAR;
        PG8_WAIT_V(2); PG8_BAR;
        PG8_STAGE(PG8_SB(1, 0), cB + kstep, voffB); PG8_STAGE(PG8_SA(1, 0), cA + kstep, voffA); PG8_STAGE(PG8_SB(1, 1), cB + hstep + kstep, voffB);
        PG8_WAIT_V(6); PG8_BAR;
    } else {
        PG8_STAGE(PG8_SB(0, 0), cB, voffB); PG8_STAGE(PG8_SA(0, 0), cA, voffA); PG8_STAGE(PG8_SB(0, 1), cB + hstep, voffB); PG8_STAGE(PG8_SA(0, 1), cA + hstep, voffA);
        if (wr == 1) PG8_BAR;
        PG8_WAIT_V(4); PG8_BAR;
        PG8_STAGE(PG8_SB(1, 0), cB + kstep, voffB); PG8_STAGE(PG8_SA(1, 0), cA + kstep, voffA); PG8_STAGE(PG8_SB(1, 1), cB + hstep + kstep, voffB);
        PG8_WAIT_V(6); PG8_BAR;
    }
    for (;;) {
        const bool has_next = S.next(ui + 1, nxt);
        const char* nA = has_next ? (const char*)g.A + (size_t)nxt.pm * tstep : cA; const char* nB = has_next ? (const char*)g.Bt + (size_t)nxt.pn * tstep : cB;
        for (int t = 0; t < nt; t += 2) {
            const bool last = (t == nt - 2);
            const char* a1 = cA + (size_t)(t + 1) * kstep;
            const char* a2 = last ? nA : cA + (size_t)(t + 2) * kstep; const char* b2 = last ? nB : cB + (size_t)(t + 2) * kstep;
            const char* a3 = a2 + kstep; const char* b3 = b2 + kstep;
            if (last && has_next) S.a_ready(nxt);
            if constexpr (SP2) {
            PG8_LDB(B0, 0, 0); PG8_LDB(B1, 0, 1); PG8_SCHED; PG8_LDA(At, 0, 0); PG8_STAGE(PG8_SA(1, 1), a1 + hstep, voffA);
            PG8_WAIT_V(8); PG8_WAIT_L(0); PG8_BAR; PG8_MMA(0, 0, At, B0); PG8_MMA(0, 1, At, B1); PG8_BAR; PG8_SCHED;
            PG8_LDA(At, 0, 1); PG8_STAGE(PG8_SB(0, 0), b2, voffB); PG8_STAGE(PG8_SB(0, 1), b2 + hstep, voffB); PG8_STAGE(PG8_SA(0, 0), a2, voffA);
            PG8_WAIT_V(8); PG8_WAIT_L(0); PG8_BAR; PG8_MMA(1, 0, At, B0); PG8_MMA(1, 1, At, B1); PG8_BAR; PG8_SCHED;
            PG8_LDB(B0, 1, 0); PG8_LDB(B1, 1, 1); PG8_SCHED; PG8_LDA(At, 1, 0); PG8_STAGE(PG8_SA(0, 1), a2 + hstep, voffA);
            PG8_WAIT_V(8); PG8_WAIT_L(0); PG8_BAR; PG8_MMA(0, 0, At, B0); PG8_MMA(0, 1, At, B1); PG8_BAR; PG8_SCHED;
            PG8_LDA(At, 1, 1); PG8_STAGE(PG8_SB(1, 0), b3, voffB); PG8_STAGE(PG8_SB(1, 1), b3 + hstep, voffB); PG8_STAGE(PG8_SA(1, 0), a3, voffA);
            PG8_WAIT_V(8); PG8_WAIT_L(0); PG8_BAR; PG8_MMA(1, 0, At, B0); PG8_MMA(1, 1, At, B1); PG8_BAR; PG8_SCHED;
            } else {
            PG8_LDB(B0, 0, 0); PG8_SCHED; PG8_LDA(At, 0, 0); PG8_STAGE(PG8_SA(1, 1), a1 + hstep, voffA);
            PG8_WAIT_L(8); PG8_BAR; PG8_WAIT_L(0); PG8_MMA(0, 0, At, B0); PG8_BAR; PG8_SCHED;
            PG8_LDB(B1, 0, 1); PG8_STAGE(PG8_SB(0, 0), b2, voffB);
            PG8_BAR; PG8_WAIT_L(0); PG8_MMA(0, 1, At, B1); PG8_BAR;
            PG8_LDA(At, 0, 1); PG8_STAGE(PG8_SA(0, 0), a2, voffA);
            PG8_BAR; PG8_WAIT_L(0); PG8_MMA(1, 0, At, B0); PG8_BAR; PG8_SCHED;
            PG8_STAGE(PG8_SB(0, 1), b2 + hstep, voffB);
            PG8_WAIT_V(6); PG8_BAR; PG8_MMA(1, 1, At, B1); PG8_BAR;
            PG8_LDB(B0, 1, 0); PG8_SCHED; PG8_LDA(At, 1, 0); PG8_STAGE(PG8_SA(0, 1), a2 + hstep, voffA);
            PG8_WAIT_L(8); PG8_BAR; PG8_WAIT_L(0); PG8_MMA(0, 0, At, B0); PG8_BAR; PG8_SCHED;
            PG8_LDB(B1, 1, 1); PG8_STAGE(PG8_SB(1, 0), b3, voffB);
            PG8_BAR; PG8_WAIT_L(0); PG8_MMA(0, 1, At, B1); PG8_BAR;
            PG8_LDA(At, 1, 1); PG8_STAGE(PG8_SA(1, 0), a3, voffA);
            PG8_BAR; PG8_WAIT_L(0); PG8_MMA(1, 0, At, B0); PG8_BAR; PG8_SCHED;
            PG8_STAGE(PG8_SB(1, 1), b3 + hstep, voffB);
            PG8_WAIT_V(6); PG8_BAR; PG8_MMA(1, 1, At, B1); PG8_BAR;
            }
        }
        if constexpr (ALIGN_EPI) { if (wr == 0) PG8_BAR; }
        if constexpr (!Epi::AFTER_DRAIN) { E(acc, cur, wr, wc, fr, fq); S.done(cur); }
        if (!has_next) break;
#pragma unroll
        for (int a = 0; a < 2; ++a)
#pragma unroll
            for (int b = 0; b < 2; ++b)
#pragma unroll
                for (int m = 0; m < 4; ++m)
#pragma unroll
                    for (int n = 0; n < 2; ++n) acc[a][b][m][n] = (f32x4){0.f, 0.f, 0.f, 0.f};
        cur = nxt; cA = nA; cB = nB; ++ui;
        if constexpr (ALIGN_EPI) { if (wr == 1) PG8_BAR; }
    }
    PG8_WAIT_V(0);
    if constexpr (!ALIGN_EPI) { if (wr == 0) PG8_BAR; }
    PG8_BAR;
    if constexpr (Epi::AFTER_DRAIN) { E.fused(acc, cur, wr, wc, fr, fq, lds, wid, lane); S.done(cur); }
#undef PG8_SA
#undef PG8_SB
#undef PG8_STAGE
#undef PG8_LDA
#undef PG8_LDB
#undef PG8_MMA
#undef PG8_WAIT_V
#undef PG8_WAIT_L
#undef PG8_BAR
#undef PG8_SCHED
}
}
#define LAS __attribute__((address_space(3)))
typedef unsigned short bf16;
typedef float f32x4 __attribute__((ext_vector_type(4)));
typedef float f32x16 __attribute__((ext_vector_type(16)));
typedef unsigned u32x4 __attribute__((ext_vector_type(4)));
typedef unsigned u32x2 __attribute__((ext_vector_type(2)));
typedef short s16x8 __attribute__((ext_vector_type(8)));

constexpr int NB = 8, SEQ = 4096, T = NB * SEQ, D = 1024, FF = 2816, DEPTH = 2, NIN = 7344, ZP = 3072, ZSP = 256;
constexpr int NTHR = 512, NWAVES = 8;
constexpr int LDS_BYTES = 147456;
constexpr float EPS = 1e-6f;

constexpr size_t MiB = (size_t)1 << 20;
constexpr size_t WS_CTL = 0;
constexpr size_t WS_W = 1 * MiB, WL_STRIDE = 52 * MiB;
constexpr size_t WL_GU1 = 0, WL_D1 = 11534336, WL_INA = 17301504, WL_G = 24117248, WL_BR = 32505856, WL_OUT = 34603008, WL_GU2 = 36700160, WL_D2 = 48234496;
constexpr size_t WS_HN = 106 * MiB, WS_BIG = 170 * MiB, WS_ZS = 362 * MiB, WS_O = 394 * MiB, WS_IK = 458 * MiB, WS_END = 460 * MiB;
constexpr size_t OB_STRIDE = (size_t)T * 256 * 2;

struct Params {
    const float* x; const int* pos;
    const float *ffn1_norm, *ffn1_gu, *ffn1_down, *mix_norm, *w_in, *diff_qk_norm, *diff_lambda, *diff_head_norm, *ml_conv_w, *ml_conv_b, *ml_gate_bias, *ml_head_norm,
        *dsa_qk_norm, *w_branch, *w_out, *ffn2_norm, *ffn2_gu, *ffn2_down;
    float* out; unsigned char* ws;
};

__device__ __forceinline__ unsigned f2bf(float f) { unsigned u = __float_as_uint(f); return (u + 0x7fffu + ((u >> 16) & 1u)) >> 16; }
__device__ __forceinline__ unsigned pk2(float lo, float hi) { return f2bf(lo) | (f2bf(hi) << 16); }
__device__ __forceinline__ float bflo(unsigned w) { return __uint_as_float(w << 16); }
__device__ __forceinline__ float bfhi(unsigned w) { return __uint_as_float(w & 0xffff0000u); }
__device__ __forceinline__ float wave_sum(float v) {
#pragma unroll
    for (int o = 1; o < 64; o <<= 1) v += __shfl_xor(v, o);
    return v;
}
__device__ __forceinline__ float wave_max(float v) {
#pragma unroll
    for (int o = 1; o < 64; o <<= 1) v = fmaxf(v, __shfl_xor(v, o));
    return v;
}
__device__ __forceinline__ int lane_fresh() { unsigned z = 0u; asm volatile("" : "+v"(z)); return (int)__builtin_amdgcn_mbcnt_hi(~0u, __builtin_amdgcn_mbcnt_lo(~0u, z)); }
__device__ __forceinline__ int tid_fresh(int wv) { int w = wv; asm volatile("" : "+s"(w)); return w * 64 + lane_fresh(); }
#define LDS_WAIT() asm volatile("s_waitcnt lgkmcnt(0)" ::: "memory")
__device__ __forceinline__ float sigmoidf_(float x) { return 1.f / (1.f + __expf(-x)); }

struct EpiSwiglu {
    static constexpr bool PERM = true, AFTER_DRAIN = false;
    bf16* O;
    __device__ __forceinline__ void operator()(const f32x4 (&acc)[2][2][4][2], const pg8::Unit& u, int wr, int wc, int fr_in, int fq_in) const {
        const int ln_ = lane_fresh(); const int fr = ln_ & 15, fq = ln_ >> 4; (void)fr_in; (void)fq_in;
        const int row0 = u.pm * 256 + wr * 64 + fr, col0 = u.pn * 128 + wc * 32 + 8 * fq;
#pragma unroll
        for (int ai = 0; ai < 2; ++ai)
#pragma unroll
            for (int m = 0; m < 4; ++m) {
                bf16* rowp = O + (size_t)(row0 + ai * 128 + m * 16) * FF + col0;
                float r[8];
#pragma unroll
                for (int n = 0; n < 2; ++n)
#pragma unroll
                    for (int j = 0; j < 4; ++j) { const float g = acc[ai][0][m][n][j], uu = acc[ai][1][m][n][j]; r[4 * n + j] = g * sigmoidf_(g) * uu; }
                u32x4 w; w.x = pk2(r[0], r[1]); w.y = pk2(r[2], r[3]); w.z = pk2(r[4], r[5]); w.w = pk2(r[6], r[7]);
                *(u32x4*)rowp = w;
            }
    }
};
struct EpiResid {
    static constexpr bool PERM = true, AFTER_DRAIN = false;
    const float* base; float* out; float scale;
    __device__ __forceinline__ void operator()(const f32x4 (&acc)[2][2][4][2], const pg8::Unit& u, int wr, int wc, int fr_in, int fq_in) const {
        const int ln_ = lane_fresh(); const int fr = ln_ & 15, fq = ln_ >> 4; (void)fr_in; (void)fq_in;
        const int row0 = u.pm * 256 + wr * 64 + fr, col0 = u.pn * 256 + wc * 32 + 8 * fq;
#pragma unroll
        for (int ai = 0; ai < 2; ++ai)
#pragma unroll
            for (int m = 0; m < 4; ++m) {
                const size_t ro = (size_t)(row0 + ai * 128 + m * 16) * D + col0;
#pragma unroll
                for (int bj = 0; bj < 2; ++bj)
#pragma unroll
                    for (int n = 0; n < 2; ++n) { const f32x4 b = *(const f32x4*)(base + ro + bj * 128 + 4 * n); *(f32x4*)(out + ro + bj * 128 + 4 * n) = b + acc[ai][bj][m][n] * scale; }
            }
    }
};
struct EpiZ {
    static constexpr bool PERM = true, AFTER_DRAIN = false;
    bf16* Z; float* ZS;
    __device__ __forceinline__ void operator()(const f32x4 (&acc)[2][2][4][2], const pg8::Unit& u, int wr, int wc, int fr_in, int fq_in) const {
        const int ln_ = lane_fresh(); const int fr = ln_ & 15, fq = ln_ >> 4; (void)fr_in; (void)fq_in;
        const int row0 = u.pm * 256 + wr * 64 + fr, cw = wc * 32 + 8 * fq;
        if (u.pn < 12) {
#pragma unroll
            for (int ai = 0; ai < 2; ++ai)
#pragma unroll
                for (int m = 0; m < 4; ++m) {
                    bf16* rowp = Z + (size_t)(row0 + ai * 128 + m * 16) * ZP + u.pn * 256 + cw;
#pragma unroll
                    for (int bj = 0; bj < 2; ++bj) { const f32x4 v0 = acc[ai][bj][m][0], v1 = acc[ai][bj][m][1];
                        u32x4 w; w.x = pk2(v0[0], v0[1]); w.y = pk2(v0[2], v0[3]); w.z = pk2(v1[0], v1[1]); w.w = pk2(v1[2], v1[3]);
                        *(u32x4*)(rowp + bj * 128) = w; }
                }
        } else {
#pragma unroll
            for (int ai = 0; ai < 2; ++ai)
#pragma unroll
                for (int m = 0; m < 4; ++m) {
                    float* rowp = ZS + (size_t)(row0 + ai * 128 + m * 16) * ZSP + cw;
#pragma unroll
                    for (int bj = 0; bj < 2; ++bj)
#pragma unroll
                        for (int n = 0; n < 2; ++n) *(f32x4*)(rowp + bj * 128 + 4 * n) = acc[ai][bj][m][n];
                }
        }
    }
};
struct EpiSig {
    static constexpr bool PERM = true, AFTER_DRAIN = false;
    bf16* SG;
    __device__ __forceinline__ void operator()(const f32x4 (&acc)[2][2][4][2], const pg8::Unit& u, int wr, int wc, int fr_in, int fq_in) const {
        const int ln_ = lane_fresh(); const int fr = ln_ & 15, fq = ln_ >> 4; (void)fr_in; (void)fq_in;
        const int row0 = u.pm * 256 + wr * 64 + fr, col0 = u.pn * 256 + wc * 32 + 8 * fq;
#pragma unroll
        for (int ai = 0; ai < 2; ++ai)
#pragma unroll
            for (int m = 0; m < 4; ++m) {
                bf16* rowp = SG + (size_t)(row0 + ai * 128 + m * 16) * D + col0;
#pragma unroll
                for (int bj = 0; bj < 2; ++bj) { const f32x4 v0 = acc[ai][bj][m][0], v1 = acc[ai][bj][m][1];
                    u32x4 w; w.x = pk2(sigmoidf_(v0[0]), sigmoidf_(v0[1])); w.y = pk2(sigmoidf_(v0[2]), sigmoidf_(v0[3]));
                    w.z = pk2(sigmoidf_(v1[0]), sigmoidf_(v1[1])); w.w = pk2(sigmoidf_(v1[2]), sigmoidf_(v1[3]));
                    *(u32x4*)(rowp + bj * 128) = w; }
            }
    }
};
struct EpiGate {
    static constexpr bool PERM = true, AFTER_DRAIN = false;
    const bf16* SG; float* YF; bf16* YB; int mode;
    __device__ __forceinline__ void operator()(const f32x4 (&acc)[2][2][4][2], const pg8::Unit& u, int wr, int wc, int fr_in, int fq_in) const {
        const int ln_ = lane_fresh(); const int fr = ln_ & 15, fq = ln_ >> 4; (void)fr_in; (void)fq_in;
        const int row0 = u.pm * 256 + wr * 64 + fr, col0 = u.pn * 256 + wc * 32 + 8 * fq;
#pragma unroll
        for (int ai = 0; ai < 2; ++ai)
#pragma unroll
            for (int m = 0; m < 4; ++m) {
                const size_t ro = (size_t)(row0 + ai * 128 + m * 16) * D + col0;
#pragma unroll
                for (int bj = 0; bj < 2; ++bj) {
                    const u32x4 sg = *(const u32x4*)(SG + ro + bj * 128);
                    f32x4 g0 = (f32x4){bflo(sg.x), bfhi(sg.x), bflo(sg.y), bfhi(sg.y)}, g1 = (f32x4){bflo(sg.z), bfhi(sg.z), bflo(sg.w), bfhi(sg.w)};
                    f32x4 v0 = g0 * acc[ai][bj][m][0], v1 = g1 * acc[ai][bj][m][1];
                    float* yp = YF + ro + bj * 128;
                    if (mode != 0) { v0 = v0 + *(const f32x4*)yp; v1 = v1 + *(const f32x4*)(yp + 4); }
                    if (mode != 2) { *(f32x4*)yp = v0; *(f32x4*)(yp + 4) = v1; }
                    else { u32x4 w; w.x = pk2(v0[0], v0[1]); w.y = pk2(v0[2], v0[3]); w.z = pk2(v1[0], v1[1]); w.w = pk2(v1[2], v1[3]); *(u32x4*)(YB + ro + bj * 128) = w; }
                }
            }
    }
};

template <class Epi>
__device__ __forceinline__ void run_gemm(LAS unsigned char* lds, const bf16* A, const bf16* Bt, int M, int N, int K, const Epi& E, int wv) {
    pg8::Gemm g{A, Bt, M, N, K}; pg8::StaticOrder S; S.init(M, N, (int)gridDim.x, (int)blockIdx.x);
    pg8::gemm_phase<Epi, pg8::StaticOrder, true, true>((PG8_LAS unsigned char*)lds, g, S, E, wv);
}

__device__ __forceinline__ void tr_item(const float* W, int K, int srcN, int c0, int nv, bf16* WT, int r0, int k0, LAS float* scr, int lane) {
    const int c = lane & 31;
#pragma unroll 8
    for (int i = 0; i < 32; ++i) { const int kk = 2 * i + (lane >> 5); scr[kk * 33 + c] = (c < nv) ? W[(size_t)(k0 + kk) * srcN + c0 + c] : 0.f; }
    LDS_WAIT();
    const int c8 = lane & 7;
#pragma unroll
    for (int j = 0; j < 4; ++j) { const int n = (lane >> 3) + 8 * j; const LAS float* s = scr + (8 * c8) * 33 + n;
        u32x4 o; o.x = pk2(s[0 * 33], s[1 * 33]); o.y = pk2(s[2 * 33], s[3 * 33]); o.z = pk2(s[4 * 33], s[5 * 33]); o.w = pk2(s[6 * 33], s[7 * 33]);
        if (n < nv) *(u32x4*)(WT + (size_t)(r0 + n) * K + k0 + 8 * c8) = o; }
    LDS_WAIT();
}
struct SegRun { int base, gw, ngw, lane; LAS float* scr; };
__device__ __forceinline__ void run_seg(SegRun& R, const float* W, int K, int srcN, int c0, int ncols, bf16* WT, int r0) {
    const int nblk = (ncols + 31) >> 5, nitems = (K >> 6) * nblk;
    int first = (R.gw - (R.base % R.ngw) + R.ngw) % R.ngw;
    for (int it = first; it < nitems; it += R.ngw) { const int kb = it / nblk, nb = it - kb * nblk; const int nv = min(32, ncols - nb * 32);
        tr_item(W, K, srcN, c0 + nb * 32, nv, WT, r0 + nb * 32, kb * 64, R.scr, R.lane); }
    R.base += nitems;
}
__device__ __forceinline__ void convert_weights(const Params& p, int l, SegRun& R) {
    unsigned char* wl = p.ws + WS_W + (size_t)l * WL_STRIDE;
    for (int f = 0; f < 2; ++f) {
        const float* gu = (f ? p.ffn2_gu : p.ffn1_gu) + (size_t)l * D * 2 * FF; bf16* gut = (bf16*)(wl + (f ? WL_GU2 : WL_GU1));
        for (int sg = 0; sg < 44; ++sg) run_seg(R, gu, D, 2 * FF, sg * 128, 128, gut, (sg % 22) * 256 + (sg / 22) * 128);
        const float* dn = (f ? p.ffn2_down : p.ffn1_down) + (size_t)l * FF * D; bf16* dnt = (bf16*)(wl + (f ? WL_D2 : WL_D1));
        run_seg(R, dn, FF, D, 0, D, dnt, 0);
    }
    const float* wi = p.w_in + (size_t)l * D * NIN; bf16* ina = (bf16*)(wl + WL_INA);
    run_seg(R, wi, D, NIN, 0, 768, ina, 0);
    run_seg(R, wi, D, NIN, 768, 512, ina, 768);
    run_seg(R, wi, D, NIN, 1280, 256, ina, 1280);
    run_seg(R, wi, D, NIN, 1544, 256, ina, 1536);
    run_seg(R, wi, D, NIN, 1800, 768, ina, 1792);
    run_seg(R, wi, D, NIN, 2568, 256, ina, 2560);
    run_seg(R, wi, D, NIN, 2952, 256, ina, 2816);
    run_seg(R, wi, D, NIN, 2824, 128, ina, 3072);
    run_seg(R, wi, D, NIN, 3208, 40, ina, 3200);
    run_seg(R, wi, D, NIN, 1536, 8, ina, 3240);
    run_seg(R, wi, D, NIN, 3248, 4096, (bf16*)(wl + WL_G), 0);
    for (int b = 0; b < 4; ++b) run_seg(R, p.w_branch + ((size_t)l * 4 + b) * 256 * D, 256, D, 0, D, (bf16*)(wl + WL_BR) + (size_t)b * D * 256, 0);
    run_seg(R, p.w_out + (size_t)l * D * D, D, D, 0, D, (bf16*)(wl + WL_OUT), 0);
    for (int i = R.gw * 64 + R.lane; i < 80 * 128; i += R.ngw * 64) *((u32x4*)(ina + (size_t)3248 * D) + i) = (u32x4){0u, 0u, 0u, 0u};
}

__device__ __forceinline__ void rms_rows(const float* X, const float* g, bf16* HN, int gw, int ngw, int lane) {
    f32x4 gv[4];
#pragma unroll
    for (int j = 0; j < 4; ++j) gv[j] = ((const f32x4*)g)[lane + 64 * j];
    for (int m = gw; m < T; m += ngw) {
        const f32x4* xr = (const f32x4*)(X + (size_t)m * D) + lane;
        f32x4 v[4]; float s = 0.f;
#pragma unroll
        for (int j = 0; j < 4; ++j) { v[j] = xr[64 * j]; s += (v[j].x * v[j].x + v[j].y * v[j].y) + (v[j].z * v[j].z + v[j].w * v[j].w); }
        const float r = 1.f / sqrtf(wave_sum(s) * (1.f / D) + EPS);
        unsigned long long* o8 = (unsigned long long*)(HN + (size_t)m * D) + lane;
#pragma unroll
        for (int j = 0; j < 4; ++j) { const f32x4 y = v[j] * r * gv[j]; o8[64 * j] = (unsigned long long)pk2(y.x, y.y) | ((unsigned long long)pk2(y.z, y.w) << 32); }
    }
}

__device__ __forceinline__ void sincos_red(float ang, float& sn, float& cs) {
    const float n = rintf(ang * 0.15915494309189535f);
    float r = fmaf(-n, 6.28125f, ang); r = fmaf(-n, 0.0019353071795864769f, r);
    sn = __sinf(r); cs = __cosf(r);
}
template <int HALF>
__device__ __forceinline__ void rope4(float (&v)[4], int sl, float pos) {
    constexpr int LH = HALF / 4;
    float pv[4];
#pragma unroll
    for (int j = 0; j < 4; ++j) pv[j] = __shfl_xor(v[j], LH);
    if (sl < 2 * LH) {
        const bool first = sl < LH; const int i0 = (sl & (LH - 1)) * 4;
#pragma unroll
        for (int j = 0; j < 4; ++j) {
            constexpr float I4[4] = {1.0f, 0.03760603070259094f, 0.0014142135623842478f, 5.318296098266728e-05f};
            constexpr float I8[8] = {1.0f, 0.1939227432012558f, 0.03760603070259094f, 0.007292664609849453f, 0.0014142135623842478f, 0.00027424818836152554f, 5.318296098266728e-05f, 1.0313386155758053e-05f};
            const float inv = (HALF == 4) ? I4[j] : (i0 ? I8[4 + j] : I8[j]);
            float sn, cs; sincos_red(pos * inv, sn, cs);
            v[j] = first ? (v[j] * cs - pv[j] * sn) : (pv[j] * sn + v[j] * cs);
        }
    }
}
__device__ __forceinline__ void prep_phase(const Params& p, int l, int gw, int ngw, int lane) {
    bf16* Z = (bf16*)(p.ws + WS_BIG); float* ZS = (float*)(p.ws + WS_ZS); bf16* IK = (bf16*)(p.ws + WS_IK);
    const float* dg = p.diff_qk_norm + l * 64; const float* sg = p.dsa_qk_norm + l * 128;
    for (int tok = gw; tok < T; tok += ngw) {
        const float pos = (float)p.pos[tok];
#pragma unroll
        for (int which = 0; which < 2; ++which) {
            unsigned long long* ptr = (unsigned long long*)(Z + (size_t)tok * ZP + which * 256) + lane;
            const unsigned long long w = *ptr; float v[4] = {bflo((unsigned)w), bfhi((unsigned)w), bflo((unsigned)(w >> 32)), bfhi((unsigned)(w >> 32))};
            float ss = (v[0] * v[0] + v[1] * v[1]) + (v[2] * v[2] + v[3] * v[3]);
            ss += __shfl_xor(ss, 1); ss += __shfl_xor(ss, 2); ss += __shfl_xor(ss, 4);
            const float r = 1.f / sqrtf(ss * (1.f / 32.f) + EPS);
            const f32x4 g = *(const f32x4*)(dg + which * 32 + (lane & 7) * 4);
#pragma unroll
            for (int j = 0; j < 4; ++j) v[j] = v[j] * r * g[j];
            rope4<4>(v, lane & 7, pos);
            if (which == 0) {
#pragma unroll
                for (int j = 0; j < 4; ++j) v[j] *= 0.17677669529663687f;
            }
            *ptr = (unsigned long long)pk2(v[0], v[1]) | ((unsigned long long)pk2(v[2], v[3]) << 32);
        }
        {
            unsigned long long* ptr = (unsigned long long*)(Z + (size_t)tok * ZP + 2560) + lane;
            const unsigned long long w = *ptr; float v[4] = {bflo((unsigned)w), bfhi((unsigned)w), bflo((unsigned)(w >> 32)), bfhi((unsigned)(w >> 32))};
            float ss = (v[0] * v[0] + v[1] * v[1]) + (v[2] * v[2] + v[3] * v[3]);
            ss += __shfl_xor(ss, 1); ss += __shfl_xor(ss, 2); ss += __shfl_xor(ss, 4); ss += __shfl_xor(ss, 8);
            const float r = 1.f / sqrtf(ss * (1.f / 64.f) + EPS);
            const f32x4 g = *(const f32x4*)(sg + (lane & 15) * 4);
#pragma unroll
            for (int j = 0; j < 4; ++j) v[j] = v[j] * r * g[j];
            rope4<8>(v, lane & 15, pos);
#pragma unroll
            for (int j = 0; j < 4; ++j) v[j] *= 0.125f;
            *ptr = (unsigned long long)pk2(v[0], v[1]) | ((unsigned long long)pk2(v[2], v[3]) << 32);
        }
        {
            unsigned long long* ptr = (unsigned long long*)(Z + (size_t)tok * ZP + 2816) + lane;
            const unsigned long long w = *ptr; float v[4] = {bflo((unsigned)w), bfhi((unsigned)w), bflo((unsigned)(w >> 32)), bfhi((unsigned)(w >> 32))};
            rope4<4>(v, lane & 7, pos);
            *ptr = (unsigned long long)pk2(v[0], v[1]) | ((unsigned long long)pk2(v[2], v[3]) << 32);
        }
        {
            float* ptr = ZS + (size_t)tok * ZSP + (lane & 15) * 4;
            const f32x4 x = *(const f32x4*)ptr; float v[4] = {x[0], x[1], x[2], x[3]};
            float ss = (v[0] * v[0] + v[1] * v[1]) + (v[2] * v[2] + v[3] * v[3]);
            ss += __shfl_xor(ss, 1); ss += __shfl_xor(ss, 2); ss += __shfl_xor(ss, 4); ss += __shfl_xor(ss, 8);
            const float r = 1.f / sqrtf(ss * (1.f / 64.f) + EPS);
            const f32x4 g = *(const f32x4*)(sg + 64 + (lane & 15) * 4);
#pragma unroll
            for (int j = 0; j < 4; ++j) v[j] = v[j] * r * g[j];
            rope4<8>(v, lane & 15, pos);
            if (lane < 16) *(f32x4*)ptr = (f32x4){v[0], v[1], v[2], v[3]};
        }
        {
            const float* ptr = ZS + (size_t)tok * ZSP + 128 + (lane & 7) * 4;
            const f32x4 x = *(const f32x4*)ptr; float v[4] = {x[0], x[1], x[2], x[3]};
            rope4<4>(v, lane & 7, pos);
            if (lane < 8) *((unsigned long long*)(IK + (size_t)tok * 32) + lane) = (unsigned long long)pk2(v[0], v[1]) | ((unsigned long long)pk2(v[2], v[3]) << 32);
        }
    }
}
__device__ __forceinline__ void mlstm_item(const Params& p, int l, int bh, LAS unsigned char* lds, int wv) {
    const int tid = tid_fresh(wv), lane = tid & 63, b = bh >> 2, h = bh & 3;
    const bf16* Z = (const bf16*)(p.ws + WS_BIG); const float* ZS = (const float*)(p.ws + WS_ZS); bf16* O1 = (bf16*)(p.ws + WS_O + OB_STRIDE);
    LAS float* nv = (LAS float*)lds; LAS float* bc = nv + 64; LAS float* igs = bc + 64; LAS float* wks = igs + 64; LAS float* sc = wks + 64;
    LAS float* Qs = sc + 64; LAS float* Ks = Qs + 64 * 65; LAS float* Vs = Ks + 64 * 65; LAS float* Ss = Vs + 64 * 65; LAS float* Cs = Ss + 64 * 65;
    for (int i = tid; i < 64 * 65; i += NTHR) Cs[i] = 0.f;
    if (tid < 64) nv[tid] = 0.f;
    float mcar = 0.f;
    const int r = tid >> 3, sg = tid & 7;
    const int cc0 = sg * 16; const int ch0 = (cc0 < 64) ? (h * 64 + cc0) : (256 + h * 64 + cc0 - 64);
    const float* cw0 = p.ml_conv_w + (size_t)l * 4 * 512; const float* cb0 = p.ml_conv_b + (size_t)l * 512;
    const int zc0 = (cc0 < 64) ? (768 + h * 64 + cc0) : (1024 + h * 64 + cc0 - 64);
    const float gb_i = p.ml_gate_bias[(l * 2 + 0) * 4 + h], gb_f = p.ml_gate_bias[(l * 2 + 1) * 4 + h];
    const float qsc = (cc0 < 64) ? 0.125f : 1.0f;
    __syncthreads();
    for (int c = 0; c < 64; ++c) {
        const int t0 = c * 64; const size_t tok0 = (size_t)b * SEQ + t0;
        const float* cw = cw0; const float* cb = cb0; asm volatile("" : "+s"(cw), "+s"(cb));
        {
            float y[16];
#pragma unroll
            for (int i = 0; i < 16; ++i) y[i] = cb[ch0 + i];
#pragma unroll
            for (int j = 0; j < 4; ++j) {
                const int tt = t0 + r - 3 + j;
                if (tt >= 0) {
                    const u32x4* xp = (const u32x4*)(Z + ((size_t)b * SEQ + tt) * ZP + zc0); const u32x4 x0 = xp[0], x1 = xp[1];
                    const float xv[16] = {bflo(x0.x), bfhi(x0.x), bflo(x0.y), bfhi(x0.y), bflo(x0.z), bfhi(x0.z), bflo(x0.w), bfhi(x0.w),
                                          bflo(x1.x), bfhi(x1.x), bflo(x1.y), bfhi(x1.y), bflo(x1.z), bfhi(x1.z), bflo(x1.w), bfhi(x1.w)};
#pragma unroll
                    for (int i = 0; i < 16; ++i) y[i] = fmaf(cw[j * 512 + ch0 + i], xv[i], y[i]);
                }
            }
            LAS float* dst = (cc0 < 64) ? (Qs + r * 65 + cc0) : (Ks + r * 65 + cc0 - 64);
#pragma unroll
            for (int i = 0; i < 16; ++i) dst[i] = y[i] * sigmoidf_(y[i]) * qsc;
            const u32x4 vv = *(const u32x4*)(Z + (tok0 + r) * ZP + 1280 + h * 64 + sg * 8);
            LAS float* vd = Vs + r * 65 + sg * 8;
            vd[0] = bflo(vv.x); vd[1] = bfhi(vv.x); vd[2] = bflo(vv.y); vd[3] = bfhi(vv.y); vd[4] = bflo(vv.z); vd[5] = bfhi(vv.z); vd[6] = bflo(vv.w); vd[7] = bfhi(vv.w);
        }
        if (tid < 64) {
            const float ig = ZS[(tok0 + tid) * ZSP + 168 + h] + gb_i;
            const float fz = ZS[(tok0 + tid) * ZSP + 172 + h] + gb_f;
            const float lf = fminf(fz, 0.f) - log1pf(__expf(-fabsf(fz)));
            float bsum = lf;
#pragma unroll
            for (int d = 1; d < 64; d <<= 1) { const float n = __shfl_up(bsum, d); if (lane >= d) bsum += n; }
            const float bl = __shfl(bsum, 63);
            const float g = bl - bsum + ig;
            const float mnew = fmaxf(bl + mcar, wave_max(g));
            bc[tid] = bsum; igs[tid] = ig; wks[tid] = __expf(g - mnew);
            if (tid == 0) { sc[0] = mnew; sc[1] = __expf(bl + mcar - mnew); sc[2] = bl; }
        }
        __syncthreads();
        const float bt = bc[r];
        float mx = -INFINITY;
#pragma unroll
        for (int i = 0; i < 8; ++i) { const int s = sg * 8 + i; const float dli = (s <= r) ? (bt - bc[s] + igs[s]) : -INFINITY; mx = fmaxf(mx, dli); }
        mx = fmaxf(mx, __shfl_xor(mx, 1)); mx = fmaxf(mx, __shfl_xor(mx, 2)); mx = fmaxf(mx, __shfl_xor(mx, 4));
        const float inter = bt + mcar; const float mt = fmaxf(inter, mx); const float iw = __expf(inter - mt);
        float ssum = 0.f;
#pragma unroll 1
        for (int i = 0; i < 8; ++i) { const int s = sg * 8 + i; float dot = 0.f;
#pragma unroll 16
            for (int d = 0; d < 64; ++d) dot = fmaf(Qs[r * 65 + d], Ks[s * 65 + d], dot);
            const float dli = (s <= r) ? (bt - bc[s] + igs[s]) : -INFINITY;
            const float sv = dot * __expf(dli - mt); Ss[r * 65 + s] = sv; ssum += sv; }
        ssum += __shfl_xor(ssum, 1); ssum += __shfl_xor(ssum, 2); ssum += __shfl_xor(ssum, 4);
        float qn = 0.f;
#pragma unroll
        for (int d = 0; d < 64; ++d) qn = fmaf(Qs[r * 65 + d], nv[d], qn);
        const float den = iw * qn + ssum;
        __syncthreads();
        {
            float num[8];
#pragma unroll
            for (int i = 0; i < 8; ++i) num[i] = 0.f;
#pragma unroll 8
            for (int d = 0; d < 64; ++d) { const float qd = Qs[r * 65 + d];
#pragma unroll
                for (int i = 0; i < 8; ++i) num[i] = fmaf(qd, Cs[d * 65 + sg * 8 + i], num[i]); }
#pragma unroll
            for (int i = 0; i < 8; ++i) num[i] *= iw;
#pragma unroll 8
            for (int s = 0; s < 64; ++s) { const float sv = Ss[r * 65 + s];
#pragma unroll
                for (int i = 0; i < 8; ++i) num[i] = fmaf(sv, Vs[s * 65 + sg * 8 + i], num[i]); }
            const float dn = 1.f / fmaxf(fabsf(den), __expf(-mt));
            float hs = 0.f;
#pragma unroll
            for (int i = 0; i < 8; ++i) { num[i] *= dn; hs = fmaf(num[i], num[i], hs); }
            hs += __shfl_xor(hs, 1); hs += __shfl_xor(hs, 2); hs += __shfl_xor(hs, 4);
            const float rr = 1.f / sqrtf(hs * (1.f / 64.f) + EPS);
            const u32x4 og = *(const u32x4*)(Z + (tok0 + r) * ZP + 1536 + h * 64 + sg * 8);
            const float ogv[8] = {bflo(og.x), bfhi(og.x), bflo(og.y), bfhi(og.y), bflo(og.z), bfhi(og.z), bflo(og.w), bfhi(og.w)};
            const float* hg = p.ml_head_norm + l * 64 + sg * 8;
            float o[8];
#pragma unroll
            for (int i = 0; i < 8; ++i) o[i] = sigmoidf_(ogv[i]) * (num[i] * rr * hg[i]);
            u32x4 w; w.x = pk2(o[0], o[1]); w.y = pk2(o[2], o[3]); w.z = pk2(o[4], o[5]); w.w = pk2(o[6], o[7]);
            *(u32x4*)(O1 + (tok0 + r) * 256 + h * 64 + sg * 8) = w;
        }
        __syncthreads();
        {
            const float decay = sc[1];
            float cacc[8]; float nacc = 0.f;
#pragma unroll
            for (int i = 0; i < 8; ++i) cacc[i] = 0.f;
#pragma unroll 8
            for (int s = 0; s < 64; ++s) { const float kw = wks[s] * Ks[s * 65 + r]; nacc += kw;
#pragma unroll
                for (int i = 0; i < 8; ++i) cacc[i] = fmaf(kw, Vs[s * 65 + sg * 8 + i], cacc[i]); }
#pragma unroll
            for (int i = 0; i < 8; ++i) Cs[r * 65 + sg * 8 + i] = decay * Cs[r * 65 + sg * 8 + i] + cacc[i];
            if (sg == 0) nv[r] = decay * nv[r] + nacc;
            mcar = sc[0];
        }
        __syncthreads();
    }
}

__device__ __forceinline__ void diff_item(const Params& p, int l, int bh, int qt, LAS unsigned char* lds, int wv) {
    const int tid = tid_fresh(wv), b = bh >> 2, h = bh & 3, q0 = qt * 128;
    const bf16* Z = (const bf16*)(p.ws + WS_BIG); bf16* O0 = (bf16*)(p.ws + WS_O);
    LAS float* Kt = (LAS float*)lds; LAS float* Vt = Kt + 64 * 64;
    const int ql = tid >> 2, part = tid & 3, c = part & 1, dvh = part >> 1, t = q0 + ql; const size_t tok = (size_t)b * SEQ + t;
    const float* lp = p.diff_lambda + l * 128; float s01 = 0.f, s23 = 0.f, gqm = 0.f, gkm = 0.f;
#pragma unroll 2
    for (int i = 0; i < 32; ++i) { s01 = fmaf(lp[i], lp[32 + i], s01); s23 = fmaf(lp[64 + i], lp[96 + i], s23);
        gqm = fmaxf(gqm, fabsf(p.diff_qk_norm[l * 64 + i])); gkm = fmaxf(gkm, fabsf(p.diff_qk_norm[l * 64 + 32 + i])); }
    const float lam_init = 0.8f - 0.6f * __expf(-0.3f * (float)l); const float lam = __expf(s01) - __expf(s23) + lam_init;
    const float coff = 5.65685424949238f * gqm * gkm;
    float q[32], o[32];
    { const u32x4* qp = (const u32x4*)(Z + tok * ZP + h * 64 + c * 32);
#pragma unroll
      for (int i = 0; i < 4; ++i) { const u32x4 w = qp[i]; q[8 * i] = bflo(w.x); q[8 * i + 1] = bfhi(w.x); q[8 * i + 2] = bflo(w.y); q[8 * i + 3] = bfhi(w.y); q[8 * i + 4] = bflo(w.z); q[8 * i + 5] = bfhi(w.z); q[8 * i + 6] = bflo(w.w); q[8 * i + 7] = bfhi(w.w); } }
#pragma unroll
    for (int i = 0; i < 32; ++i) o[i] = 0.f;
    float lsum = 0.f;
    const int nkt = (q0 + 128) / 64;
    const int lk = tid >> 3, lsg = tid & 7;
    for (int kt = 0; kt < nkt; ++kt) {
        __syncthreads();
        { const size_t ktok = (size_t)b * SEQ + kt * 64 + lk;
          const bf16* src = Z + ktok * ZP + ((lsg < 4) ? (256 + h * 64 + lsg * 16) : (512 + h * 64 + (lsg - 4) * 16));
          const u32x4 x0 = ((const u32x4*)src)[0], x1 = ((const u32x4*)src)[1];
          LAS float* dst = ((lsg < 4) ? (Kt + lk * 64 + lsg * 16) : (Vt + lk * 64 + (lsg - 4) * 16));
          *(LAS f32x4*)(dst) = (f32x4){bflo(x0.x), bfhi(x0.x), bflo(x0.y), bfhi(x0.y)}; *(LAS f32x4*)(dst + 4) = (f32x4){bflo(x0.z), bfhi(x0.z), bflo(x0.w), bfhi(x0.w)};
          *(LAS f32x4*)(dst + 8) = (f32x4){bflo(x1.x), bfhi(x1.x), bflo(x1.y), bfhi(x1.y)}; *(LAS f32x4*)(dst + 12) = (f32x4){bflo(x1.z), bfhi(x1.z), bflo(x1.w), bfhi(x1.w)}; }
        __syncthreads();
        const int kmax = t - kt * 64 + 1;
        for (int key = 0; key < 64; ++key) {
            const LAS f32x4* kr = (const LAS f32x4*)(Kt + key * 64 + c * 32);
            float s = 0.f;
#pragma unroll
            for (int i = 0; i < 8; ++i) { const f32x4 kv = kr[i]; s = fmaf(q[4 * i], kv[0], s); s = fmaf(q[4 * i + 1], kv[1], s); s = fmaf(q[4 * i + 2], kv[2], s); s = fmaf(q[4 * i + 3], kv[3], s); }
            const float pe = (key < kmax) ? __expf(s - coff) : 0.f;
            lsum += pe;
            const LAS f32x4* vr = (const LAS f32x4*)(Vt + key * 64 + dvh * 32);
#pragma unroll
            for (int i = 0; i < 8; ++i) { const f32x4 vv = vr[i]; o[4 * i] = fmaf(pe, vv[0], o[4 * i]); o[4 * i + 1] = fmaf(pe, vv[1], o[4 * i + 1]); o[4 * i + 2] = fmaf(pe, vv[2], o[4 * i + 2]); o[4 * i + 3] = fmaf(pe, vv[3], o[4 * i + 3]); }
        }
    }
    const float inv = 1.f / lsum; float ss = 0.f;
#pragma unroll
    for (int i = 0; i < 32; ++i) { const float my = o[i] * inv; const float ot = __shfl_xor(my, 1); o[i] = (c == 0) ? (my - lam * ot) : (ot - lam * my); ss = fmaf(o[i], o[i], ss); }
    ss += __shfl_xor(ss, 2);
    const float rr = (1.f - lam_init) / sqrtf(ss * (1.f / 64.f) + EPS);
    if (c == 0) {
        const float* hg = p.diff_head_norm + l * 64 + dvh * 32; u32x4* dst = (u32x4*)(O0 + tok * 256 + h * 64 + dvh * 32);
#pragma unroll
        for (int i = 0; i < 4; ++i) { u32x4 w; w.x = pk2(o[8 * i] * rr * hg[8 * i], o[8 * i + 1] * rr * hg[8 * i + 1]); w.y = pk2(o[8 * i + 2] * rr * hg[8 * i + 2], o[8 * i + 3] * rr * hg[8 * i + 3]);
            w.z = pk2(o[8 * i + 4] * rr * hg[8 * i + 4], o[8 * i + 5] * rr * hg[8 * i + 5]); w.w = pk2(o[8 * i + 6] * rr * hg[8 * i + 6], o[8 * i + 7] * rr * hg[8 * i + 7]); dst[i] = w; }
    }
    __syncthreads();
}

__device__ __forceinline__ unsigned pkbf(float lo, float hi) { unsigned r; asm("v_cvt_pk_bf16_f32 %0, %1, %2" : "=v"(r) : "v"(lo), "v"(hi)); return r; }
__device__ __forceinline__ void diffm_item(const Params& p, int l, int bh, int qb, LAS unsigned char* lds, int wv) {
    const int tid = tid_fresh(wv), lane = tid & 63, half = lane >> 5, r32 = lane & 31, b = bh >> 2, h = bh & 3;
    const bf16* Z = (const bf16*)(p.ws + WS_BIG); bf16* O0 = (bf16*)(p.ws + WS_O);
    LAS bf16* Ks = (LAS bf16*)lds; LAS bf16* Vt = Ks + 64 * 72;
    const float* lp = p.diff_lambda + l * 128; float s01 = 0.f, s23 = 0.f, gqm = 0.f, gkm = 0.f;
#pragma unroll 2
    for (int i = 0; i < 32; ++i) { s01 = fmaf(lp[i], lp[32 + i], s01); s23 = fmaf(lp[64 + i], lp[96 + i], s23);
        gqm = fmaxf(gqm, fabsf(p.diff_qk_norm[l * 64 + i])); gkm = fmaxf(gkm, fabsf(p.diff_qk_norm[l * 64 + 32 + i])); }
    const float lam_init = 0.8f - 0.6f * __expf(-0.3f * (float)l); const float lam = __expf(s01) - __expf(s23) + lam_init;
    const float coff = 5.65685424949238f * gqm * gkm;
    const int qw = qb * 256 + 32 * wv;
    const size_t tokb = (size_t)b * SEQ;
    s16x8 qf[2][2];
    { const bf16* qp = Z + (tokb + qw + r32) * ZP + h * 64 + half * 8;
#pragma unroll
      for (int c = 0; c < 2; ++c)
#pragma unroll
          for (int s = 0; s < 2; ++s) qf[c][s] = *(const s16x8*)(qp + c * 32 + 16 * s); }
    f32x16 oacc[2][2];
#pragma unroll
    for (int c = 0; c < 2; ++c)
#pragma unroll
        for (int db = 0; db < 2; ++db)
#pragma unroll
            for (int r = 0; r < 16; ++r) oacc[c][db][r] = 0.f;
    float ls0 = 0.f, ls1 = 0.f;
    const int nt = (qb + 1) * 4;
    const int kkey = tid >> 3, kch = tid & 7, vkey = tid & 63, vdc = tid >> 6;
    const bf16* kgp = Z + (tokb + kkey) * ZP + 256 + h * 64 + kch * 8;
    const bf16* vgp = Z + (tokb + vkey) * ZP + 512 + h * 64 + vdc * 8;
    u32x4 kreg = *(const u32x4*)kgp, vreg = *(const u32x4*)vgp;
#pragma unroll 1
    for (int t = 0; t < nt; ++t) {
        __syncthreads();
        *(LAS u32x4*)(Ks + kkey * 72 + kch * 8) = kreg;
        { LAS bf16* vd = Vt + (vdc * 8) * 72 + vkey;
          vd[0] = (bf16)(vreg.x & 0xffffu); vd[72] = (bf16)(vreg.x >> 16); vd[144] = (bf16)(vreg.y & 0xffffu); vd[216] = (bf16)(vreg.y >> 16);
          vd[288] = (bf16)(vreg.z & 0xffffu); vd[360] = (bf16)(vreg.z >> 16); vd[432] = (bf16)(vreg.w & 0xffffu); vd[504] = (bf16)(vreg.w >> 16); }
        __syncthreads();
        if (t + 1 < nt) { kreg = *(const u32x4*)(kgp + (size_t)(t + 1) * 64 * ZP); vreg = *(const u32x4*)(vgp + (size_t)(t + 1) * 64 * ZP); }
        const int k0 = t * 64;
#pragma unroll 1
        for (int sub = 0; sub < 2; ++sub) {
            const int kb = k0 + 32 * sub;
            if (kb <= qw + 31) {
                f32x16 s0, s1;
#pragma unroll
                for (int r = 0; r < 16; ++r) { s0[r] = 0.f; s1[r] = 0.f; }
                const LAS bf16* kr = Ks + (32 * sub + r32) * 72 + 8 * half;
#pragma unroll
                for (int s = 0; s < 2; ++s) {
                    const s16x8 a0 = *(const LAS s16x8*)(kr + 16 * s), a1 = *(const LAS s16x8*)(kr + 32 + 16 * s);
                    s0 = __builtin_amdgcn_mfma_f32_32x32x16_bf16(a0, qf[0][s], s0, 0, 0, 0);
                    s1 = __builtin_amdgcn_mfma_f32_32x32x16_bf16(a1, qf[1][s], s1, 0, 0, 0);
                }
                const bool diag = (kb + 31 > qw);
#pragma unroll
                for (int r = 0; r < 16; ++r) {
                    float p0 = __expf(s0[r] - coff), p1 = __expf(s1[r] - coff);
                    if (diag) { const int key = kb + 8 * (r >> 2) + 4 * half + (r & 3); if (key > qw + r32) { p0 = 0.f; p1 = 0.f; } }
                    ls0 += p0; ls1 += p1; s0[r] = p0; s1[r] = p1;
                }
#pragma unroll
                for (int s = 0; s < 2; ++s) {
                    u32x4 w0, w1;
                    w0.x = pkbf(s0[8 * s], s0[8 * s + 1]); w0.y = pkbf(s0[8 * s + 2], s0[8 * s + 3]); w0.z = pkbf(s0[8 * s + 4], s0[8 * s + 5]); w0.w = pkbf(s0[8 * s + 6], s0[8 * s + 7]);
                    w1.x = pkbf(s1[8 * s], s1[8 * s + 1]); w1.y = pkbf(s1[8 * s + 2], s1[8 * s + 3]); w1.z = pkbf(s1[8 * s + 4], s1[8 * s + 5]); w1.w = pkbf(s1[8 * s + 6], s1[8 * s + 7]);
                    const s16x8 pf0 = __builtin_bit_cast(s16x8, w0), pf1 = __builtin_bit_cast(s16x8, w1);
#pragma unroll
                    for (int db = 0; db < 2; ++db) {
                        const LAS bf16* vr = Vt + (db * 32 + r32) * 72 + 32 * sub + 16 * s + 4 * half;
                        const u32x2 v0 = *(const LAS u32x2*)vr, v1 = *(const LAS u32x2*)(vr + 8);
                        const u32x4 vv = (u32x4){v0.x, v0.y, v1.x, v1.y};
                        const s16x8 vf = __builtin_bit_cast(s16x8, vv);
                        oacc[0][db] = __builtin_amdgcn_mfma_f32_32x32x16_bf16(vf, pf0, oacc[0][db], 0, 0, 0);
                        oacc[1][db] = __builtin_amdgcn_mfma_f32_32x32x16_bf16(vf, pf1, oacc[1][db], 0, 0, 0);
                    }
                }
            }
        }
    }
    ls0 += __shfl_xor(ls0, 32); ls1 += __shfl_xor(ls1, 32);
    const float i0 = 1.f / ls0, i1 = lam / ls1;
    float ss = 0.f;
#pragma unroll
    for (int db = 0; db < 2; ++db)
#pragma unroll
        for (int r = 0; r < 16; ++r) { const float v = oacc[0][db][r] * i0 - oacc[1][db][r] * i1; oacc[0][db][r] = v; ss = fmaf(v, v, ss); }
    ss += __shfl_xor(ss, 32);
    const float rr = (1.f - lam_init) / sqrtf(ss * (1.f / 64.f) + EPS);
    const float* hg = p.diff_head_norm + l * 64;
    bf16* orow = O0 + (tokb + qw + r32) * 256 + h * 64;
#pragma unroll
    for (int db = 0; db < 2; ++db)
#pragma unroll
        for (int g = 0; g < 4; ++g) { const int d0 = db * 32 + 8 * g + 4 * half; const f32x4 gg = *(const f32x4*)(hg + d0);
            u32x2 w; w.x = pkbf(oacc[0][db][4 * g] * rr * gg[0], oacc[0][db][4 * g + 1] * rr * gg[1]); w.y = pkbf(oacc[0][db][4 * g + 2] * rr * gg[2], oacc[0][db][4 * g + 3] * rr * gg[3]);
            *(u32x2*)(orow + d0) = w; }
    __syncthreads();
}

__device__ __forceinline__ void sb_item(const Params& p, int bh, int g, LAS unsigned char* lds, int wv) {
    const int tid = tid_fresh(wv), lane = tid & 63, w = tid >> 6, b = bh >> 2, h = bh & 3;
    const bf16* Z = (const bf16*)(p.ws + WS_BIG); bf16* O2 = (bf16*)(p.ws + WS_O + 2 * OB_STRIDE);
    LAS float* KV = (LAS float*)lds + w * 4096;
    const int t0 = g * 512 + w * 64, t = t0 + lane; const size_t tok = (size_t)b * SEQ + t;
    float q[64], o[64];
    { const u32x4* qp = (const u32x4*)(Z + tok * ZP + 1792 + h * 64);
#pragma unroll
      for (int i = 0; i < 8; ++i) { const u32x4 x = qp[i]; q[8 * i] = bflo(x.x); q[8 * i + 1] = bfhi(x.x); q[8 * i + 2] = bflo(x.y); q[8 * i + 3] = bfhi(x.y); q[8 * i + 4] = bflo(x.z); q[8 * i + 5] = bfhi(x.z); q[8 * i + 6] = bflo(x.w); q[8 * i + 7] = bfhi(x.w); } }
#pragma unroll
    for (int i = 0; i < 64; ++i) o[i] = 0.f;
    float R = 0.f;
    const int lkey = lane >> 1, lhalf = lane & 1;
    for (int slo = t0 + 32; slo >= 0; slo -= 32) {
        asm volatile("s_waitcnt lgkmcnt(0)" ::: "memory");
        { const size_t ktok = (size_t)b * SEQ + slo + lkey;
          const u32x4* ks = (const u32x4*)(Z + ktok * ZP + 2048 + h * 64 + lhalf * 32); const u32x4* vs = (const u32x4*)(Z + ktok * ZP + 2304 + h * 64 + lhalf * 32);
          LAS float* kd = KV + lkey * 128 + lhalf * 32; LAS float* vd = kd + 64;
#pragma unroll
          for (int i = 0; i < 4; ++i) { const u32x4 x = ks[i]; *(LAS f32x4*)(kd + 8 * i) = (f32x4){bflo(x.x), bfhi(x.x), bflo(x.y), bfhi(x.y)}; *(LAS f32x4*)(kd + 8 * i + 4) = (f32x4){bflo(x.z), bfhi(x.z), bflo(x.w), bfhi(x.w)}; }
#pragma unroll
          for (int i = 0; i < 4; ++i) { const u32x4 x = vs[i]; *(LAS f32x4*)(vd + 8 * i) = (f32x4){bflo(x.x), bfhi(x.x), bflo(x.y), bfhi(x.y)}; *(LAS f32x4*)(vd + 8 * i + 4) = (f32x4){bflo(x.z), bfhi(x.z), bflo(x.w), bfhi(x.w)}; } }
        asm volatile("s_waitcnt lgkmcnt(0)" ::: "memory");
        for (int kk = 31; kk >= 0; --kk) {
            const int s = slo + kk; const bool act = s < t;
            const LAS f32x4* kr = (const LAS f32x4*)(KV + kk * 128);
            float z = 0.f;
#pragma unroll
            for (int i = 0; i < 16; ++i) { const f32x4 kv = kr[i]; z = fmaf(q[4 * i], kv[0], z); z = fmaf(q[4 * i + 1], kv[1], z); z = fmaf(q[4 * i + 2], kv[2], z); z = fmaf(q[4 * i + 3], kv[3], z); }
            z *= 0.125f;
            const float lb = fminf(z, 0.f) - __logf(1.f + __expf(-fabsf(z)));
            const float a = act ? __expf(lb + R) : 0.f;
            R += act ? (lb - z) : 0.f;
#pragma unroll
            for (int i = 0; i < 16; ++i) { const f32x4 vv = kr[16 + i]; o[4 * i] = fmaf(a, vv[0], o[4 * i]); o[4 * i + 1] = fmaf(a, vv[1], o[4 * i + 1]); o[4 * i + 2] = fmaf(a, vv[2], o[4 * i + 2]); o[4 * i + 3] = fmaf(a, vv[3], o[4 * i + 3]); }
        }
        if (__all(R < -104.f)) break;
    }
    u32x4* dst = (u32x4*)(O2 + tok * 256 + h * 64);
#pragma unroll
    for (int i = 0; i < 8; ++i) { u32x4 x; x.x = pk2(o[8 * i], o[8 * i + 1]); x.y = pk2(o[8 * i + 2], o[8 * i + 3]); x.z = pk2(o[8 * i + 4], o[8 * i + 5]); x.w = pk2(o[8 * i + 6], o[8 * i + 7]); dst[i] = x; }
    asm volatile("s_waitcnt lgkmcnt(0)" ::: "memory");
}
constexpr size_t WS_MLS = 460 * MiB, WS_DEC = WS_MLS + 5 * 32 * 4096 * 4, WS_UN = 463 * MiB, WS_NV = WS_UN + 512 * 1024, WS_UT = 464 * MiB, WS_CT = 496 * MiB, WS_END2 = 512 * MiB;
constexpr int MLN = 32 * 4096;
__device__ __forceinline__ void ml_prepass(const Params& p, int l, int bh, int lane) {
    const int b = bh >> 2, h = bh & 3; const float* ZS = (const float*)(p.ws + WS_ZS);
    float* MLS = (float*)(p.ws + WS_MLS); float* DEC = (float*)(p.ws + WS_DEC);
    const float gb_i = p.ml_gate_bias[(l * 2 + 0) * 4 + h], gb_f = p.ml_gate_bias[(l * 2 + 1) * 4 + h];
    float cA = 0.f, cB = 0.f;
#pragma unroll 1
    for (int c4 = 0; c4 < 16; ++c4) {
        float igv[4], fzv[4];
#pragma unroll
        for (int k = 0; k < 4; ++k) { const size_t tok = (size_t)b * SEQ + (c4 * 4 + k) * 64 + lane; igv[k] = ZS[tok * ZSP + 168 + h]; fzv[k] = ZS[tok * ZSP + 172 + h]; }
#pragma unroll
        for (int k = 0; k < 4; ++k) {
            const int c = c4 * 4 + k;
            const float ig = igv[k] + gb_i, fz = fzv[k] + gb_f;
            const float lf = fminf(fz, 0.f) - __logf(1.f + __expf(-fabsf(fz)));
            float bsum = lf;
#pragma unroll
            for (int d = 1; d < 64; d <<= 1) { const float n = __shfl_up(bsum, d); if (lane >= d) bsum += n; }
            const float bl = __shfl(bsum, 63);
            const float a = ig - bsum;
            float pm = a;
#pragma unroll
            for (int d = 1; d < 64; d <<= 1) { const float n = __shfl_up(pm, d); if (lane >= d) pm = fmaxf(pm, n); }
            const float gmax = bl + __shfl(pm, 63);
            const int ti = bh * 4096 + c * 64 + lane;
            MLS[ti] = bsum; MLS[MLN + ti] = a; MLS[2 * MLN + ti] = pm;
            cA = (lane == c) ? bl : cA; cB = (lane == c) ? gmax : cB;
        }
    }
    float sA = cA, sB = cB;
#pragma unroll
    for (int d = 1; d < 64; d <<= 1) { const float pA = __shfl_up(sA, d), pB = __shfl_up(sB, d); if (lane >= d) { sB = fmaxf(pB + sA, sB); sA = pA + sA; } }
    const float m_out = fmaxf(sA, sB);
    float m_in = __shfl_up(m_out, 1); if (lane == 0) m_in = 0.f;
    DEC[bh * 64 + lane] = __expf(cA + m_in - m_out);
    asm volatile("s_waitcnt vmcnt(0)" ::: "memory");
#pragma unroll 1
    for (int c4 = 0; c4 < 16; ++c4) {
        float bsv[4], av[4], pmv[4];
#pragma unroll
        for (int k = 0; k < 4; ++k) { const int ti = bh * 4096 + (c4 * 4 + k) * 64 + lane; bsv[k] = MLS[ti]; av[k] = MLS[MLN + ti]; pmv[k] = MLS[2 * MLN + ti]; }
#pragma unroll
        for (int k = 0; k < 4; ++k) {
            const int c = c4 * 4 + k;
            const float mi = __shfl(m_in, c), mo = __shfl(m_out, c), bl = __shfl(cA, c);
            const int ti = bh * 4096 + c * 64 + lane;
            const float mt = bsv[k] + fmaxf(mi, pmv[k]);
            MLS[2 * MLN + ti] = mt; MLS[3 * MLN + ti] = __expf(bl + av[k] - mo); MLS[4 * MLN + ti] = __expf(bsv[k] + mi - mt);
        }
    }
}
__device__ __forceinline__ void ml_conv8(const bf16* Z, const float* cw, const float* cb, int b, int t, int ch0, float (&y)[8]) {
    const f32x4 b0 = *(const f32x4*)(cb + ch0), b1 = *(const f32x4*)(cb + ch0 + 4);
    y[0] = b0[0]; y[1] = b0[1]; y[2] = b0[2]; y[3] = b0[3]; y[4] = b1[0]; y[5] = b1[1]; y[6] = b1[2]; y[7] = b1[3];
#pragma unroll
    for (int j = 0; j < 4; ++j) {
        const int tt = t - 3 + j;
        if (tt >= 0) {
            const u32x4 x = *(const u32x4*)(Z + ((size_t)b * SEQ + tt) * ZP + 768 + ch0);
            const f32x4 w0 = *(const f32x4*)(cw + j * 512 + ch0), w1 = *(const f32x4*)(cw + j * 512 + ch0 + 4);
            y[0] = fmaf(w0[0], bflo(x.x), y[0]); y[1] = fmaf(w0[1], bfhi(x.x), y[1]); y[2] = fmaf(w0[2], bflo(x.y), y[2]); y[3] = fmaf(w0[3], bfhi(x.y), y[3]);
            y[4] = fmaf(w1[0], bflo(x.z), y[4]); y[5] = fmaf(w1[1], bfhi(x.z), y[5]); y[6] = fmaf(w1[2], bflo(x.w), y[6]); y[7] = fmaf(w1[3], bfhi(x.w), y[7]);
        }
    }
#pragma unroll
    for (int i = 0; i < 8; ++i) y[i] = y[i] * sigmoidf_(y[i]);
}
__device__ __forceinline__ void mlB_item(const Params& p, int l, int bh, int ci, LAS unsigned char* lds, int wv) {
    const int tid = tid_fresh(wv), lane = tid & 63, half = lane >> 5, r32 = lane & 31, b = bh >> 2, h = bh & 3;
    const bf16* Z = (const bf16*)(p.ws + WS_BIG); const float* MLS = (const float*)(p.ws + WS_MLS);
    float* UT = (float*)(p.ws + WS_UT); float* UN = (float*)(p.ws + WS_UN);
    LAS bf16* KT = (LAS bf16*)lds; LAS bf16* VT = KT + 4 * 64 * 72;
    const float* cw = p.ml_conv_w + (size_t)l * 4 * 512; const float* cb = p.ml_conv_b + (size_t)l * 512;
    __syncthreads();
    {
        const int tt = tid >> 1, hr = tid & 1, cl = tt >> 6, s = tt & 63, t = (ci * 4) * 64 + tt;
        const float wk = MLS[3 * MLN + bh * 4096 + t];
#pragma unroll 1
        for (int q8 = 0; q8 < 4; ++q8) {
            const int d0 = hr * 32 + q8 * 8; float y[8];
            ml_conv8(Z, cw, cb, b, t, 256 + h * 64 + d0, y);
            LAS bf16* dst = KT + (cl * 64 + d0) * 72 + s;
#pragma unroll
            for (int i = 0; i < 8; ++i) dst[i * 72] = (bf16)f2bf(y[i] * wk);
            const u32x4 v = *(const u32x4*)(Z + ((size_t)b * SEQ + t) * ZP + 1280 + h * 64 + d0);
            LAS bf16* vd = VT + (cl * 64 + d0) * 72 + s;
            vd[0] = (bf16)(v.x & 0xffffu); vd[72] = (bf16)(v.x >> 16); vd[144] = (bf16)(v.y & 0xffffu); vd[216] = (bf16)(v.y >> 16);
            vd[288] = (bf16)(v.z & 0xffffu); vd[360] = (bf16)(v.z >> 16); vd[432] = (bf16)(v.w & 0xffffu); vd[504] = (bf16)(v.w >> 16);
        }
    }
    __syncthreads();
    const int cl = wv >> 1, dh = wv & 1, c = ci * 4 + cl;
    f32x16 acc[2];
#pragma unroll
    for (int eb = 0; eb < 2; ++eb)
#pragma unroll
        for (int r = 0; r < 16; ++r) acc[eb][r] = 0.f;
#pragma unroll
    for (int s4 = 0; s4 < 4; ++s4) {
        const s16x8 bk = *(const LAS s16x8*)(KT + (cl * 64 + dh * 32 + r32) * 72 + 16 * s4 + 8 * half);
#pragma unroll
        for (int eb = 0; eb < 2; ++eb) {
            const s16x8 av = *(const LAS s16x8*)(VT + (cl * 64 + eb * 32 + r32) * 72 + 16 * s4 + 8 * half);
            acc[eb] = __builtin_amdgcn_mfma_f32_32x32x16_bf16(av, bk, acc[eb], 0, 0, 0);
        }
    }
    float* ut = UT + ((size_t)(bh * 64 + c) * 64) * 64;
#pragma unroll
    for (int eb = 0; eb < 2; ++eb)
#pragma unroll
        for (int r = 0; r < 16; ++r) { const int e = eb * 32 + 8 * (r >> 2) + 4 * half + (r & 3); ut[e * 64 + dh * 32 + r32] = acc[eb][r]; }
    {
        const LAS bf16* kr = KT + (cl * 64 + dh * 32 + r32) * 72 + half * 32; float sm = 0.f;
#pragma unroll
        for (int i = 0; i < 4; ++i) { const u32x4 x = *(const LAS u32x4*)(kr + 8 * i); sm += (bflo(x.x) + bfhi(x.x)) + (bflo(x.y) + bfhi(x.y)) + (bflo(x.z) + bfhi(x.z)) + (bflo(x.w) + bfhi(x.w)); }
        sm += __shfl_xor(sm, 32);
        if (half == 0) UN[(bh * 64 + c) * 64 + dh * 32 + r32] = sm;
    }
}
__device__ __forceinline__ void mlS_item(const Params& p, int bh, int wv) {
    const int tid = tid_fresh(wv);
    const float* UT = (const float*)(p.ws + WS_UT) + (size_t)bh * 64 * 4096; const float* UN = (const float*)(p.ws + WS_UN) + bh * 4096;
    bf16* CT = (bf16*)(p.ws + WS_CT) + (size_t)bh * 64 * 4096; float* NV = (float*)(p.ws + WS_NV) + bh * 4096; const float* DEC = (const float*)(p.ws + WS_DEC) + bh * 64;
    f32x4 s0 = (f32x4){0.f, 0.f, 0.f, 0.f}, s1 = s0; float ns = 0.f;
#pragma unroll 4
    for (int c = 0; c < 64; ++c) {
        const float dec = DEC[c];
        const f32x4 u0 = *(const f32x4*)(UT + (size_t)c * 4096 + tid * 8), u1 = *(const f32x4*)(UT + (size_t)c * 4096 + tid * 8 + 4);
        u32x4 w; w.x = pk2(s0[0], s0[1]); w.y = pk2(s0[2], s0[3]); w.z = pk2(s1[0], s1[1]); w.w = pk2(s1[2], s1[3]);
        *(u32x4*)(CT + (size_t)c * 4096 + tid * 8) = w;
        s0 = s0 * dec + u0; s1 = s1 * dec + u1;
        if (tid < 64) { NV[c * 64 + tid] = ns; ns = ns * dec + UN[c * 64 + tid]; }
    }
}
__device__ __forceinline__ void mlD_item(const Params& p, int l, int bh, int ci, LAS unsigned char* lds, int wv) {
    const int tid = tid_fresh(wv), lane = tid & 63, half = lane >> 5, r32 = lane & 31, b = bh >> 2, h = bh & 3;
    const bf16* Z = (const bf16*)(p.ws + WS_BIG); const float* MLS = (const float*)(p.ws + WS_MLS); bf16* O1 = (bf16*)(p.ws + WS_O + OB_STRIDE);
    LAS bf16* Qs = (LAS bf16*)lds; LAS bf16* Ks = Qs + 4 * 64 * 72; LAS bf16* VT = Ks + 4 * 64 * 72;
    const float* cw = p.ml_conv_w + (size_t)l * 4 * 512; const float* cb = p.ml_conv_b + (size_t)l * 512;
    __syncthreads();
    {
        const int tt = tid >> 1, hr = tid & 1, cl = tt >> 6, s = tt & 63, t = (ci * 4) * 64 + tt;
#pragma unroll 1
        for (int q8 = 0; q8 < 4; ++q8) {
            const int d0 = hr * 32 + q8 * 8; float y[8];
            ml_conv8(Z, cw, cb, b, t, h * 64 + d0, y);
            u32x4 w; w.x = pk2(y[0] * 0.125f, y[1] * 0.125f); w.y = pk2(y[2] * 0.125f, y[3] * 0.125f); w.z = pk2(y[4] * 0.125f, y[5] * 0.125f); w.w = pk2(y[6] * 0.125f, y[7] * 0.125f);
            *(LAS u32x4*)(Qs + (cl * 64 + s) * 72 + d0) = w;
            ml_conv8(Z, cw, cb, b, t, 256 + h * 64 + d0, y);
            w.x = pk2(y[0], y[1]); w.y = pk2(y[2], y[3]); w.z = pk2(y[4], y[5]); w.w = pk2(y[6], y[7]);
            *(LAS u32x4*)(Ks + (cl * 64 + s) * 72 + d0) = w;
            const u32x4 v = *(const u32x4*)(Z + ((size_t)b * SEQ + t) * ZP + 1280 + h * 64 + d0);
            LAS bf16* vd = VT + (cl * 64 + d0) * 72 + s;
            vd[0] = (bf16)(v.x & 0xffffu); vd[72] = (bf16)(v.x >> 16); vd[144] = (bf16)(v.y & 0xffffu); vd[216] = (bf16)(v.y >> 16);
            vd[288] = (bf16)(v.z & 0xffffu); vd[360] = (bf16)(v.z >> 16); vd[432] = (bf16)(v.w & 0xffffu); vd[504] = (bf16)(v.w >> 16);
        }
    }
    __syncthreads();
    const int cl = wv >> 1, th = wv & 1, c = ci * 4 + cl, tloc = th * 32 + r32, tseq = c * 64 + tloc;
    const int ti = bh * 4096 + tseq;
    const float bs_t = MLS[ti], mt_t = MLS[2 * MLN + ti], iw_t = MLS[4 * MLN + ti];
    s16x8 qf[4];
#pragma unroll
    for (int s4 = 0; s4 < 4; ++s4) qf[s4] = *(const LAS s16x8*)(Qs + (cl * 64 + tloc) * 72 + 16 * s4 + 8 * half);
    f32x16 oacc[2];
#pragma unroll
    for (int eb = 0; eb < 2; ++eb)
#pragma unroll
        for (int r = 0; r < 16; ++r) oacc[eb][r] = 0.f;
    const bf16* CT = (const bf16*)(p.ws + WS_CT) + (size_t)(bh * 64 + c) * 4096;
#pragma unroll
    for (int s4 = 0; s4 < 4; ++s4)
#pragma unroll
        for (int eb = 0; eb < 2; ++eb) { const s16x8 ac = *(const s16x8*)(CT + (eb * 32 + r32) * 64 + 16 * s4 + 8 * half);
            oacc[eb] = __builtin_amdgcn_mfma_f32_32x32x16_bf16(ac, qf[s4], oacc[eb], 0, 0, 0); }
#pragma unroll
    for (int eb = 0; eb < 2; ++eb)
#pragma unroll
        for (int r = 0; r < 16; ++r) oacc[eb][r] *= iw_t;
    float qn = 0.f;
    { const float* nvp = (const float*)(p.ws + WS_NV) + (bh * 64 + c) * 64;
#pragma unroll
      for (int s4 = 0; s4 < 4; ++s4) { const f32x4 n0 = *(const f32x4*)(nvp + 16 * s4 + 8 * half), n1 = *(const f32x4*)(nvp + 16 * s4 + 8 * half + 4);
          const u32x4 qq = __builtin_bit_cast(u32x4, qf[s4]);
          qn += bflo(qq.x) * n0[0] + bfhi(qq.x) * n0[1] + bflo(qq.y) * n0[2] + bfhi(qq.y) * n0[3] + bflo(qq.z) * n1[0] + bfhi(qq.z) * n1[1] + bflo(qq.w) * n1[2] + bfhi(qq.w) * n1[3]; } }
    qn += __shfl_xor(qn, 32);
    float rs = 0.f;
#pragma unroll
    for (int sb = 0; sb < 2; ++sb) {
        if (sb <= th) {
            f32x16 sacc;
#pragma unroll
            for (int r = 0; r < 16; ++r) sacc[r] = 0.f;
#pragma unroll
            for (int s4 = 0; s4 < 4; ++s4) { const s16x8 ak = *(const LAS s16x8*)(Ks + (cl * 64 + sb * 32 + r32) * 72 + 16 * s4 + 8 * half);
                sacc = __builtin_amdgcn_mfma_f32_32x32x16_bf16(ak, qf[s4], sacc, 0, 0, 0); }
            const float* ap = MLS + MLN + bh * 4096 + c * 64 + sb * 32 + 4 * half;
#pragma unroll
            for (int g = 0; g < 4; ++g) { const f32x4 av = *(const f32x4*)(ap + 8 * g);
#pragma unroll
                for (int i = 0; i < 4; ++i) { const int s = sb * 32 + 8 * g + 4 * half + i; const float v = (s <= tloc) ? sacc[4 * g + i] * __expf(bs_t + av[i] - mt_t) : 0.f; sacc[4 * g + i] = v; rs += v; } }
#pragma unroll
            for (int s2 = 0; s2 < 2; ++s2) {
                u32x4 w; w.x = pkbf(sacc[8 * s2], sacc[8 * s2 + 1]); w.y = pkbf(sacc[8 * s2 + 2], sacc[8 * s2 + 3]); w.z = pkbf(sacc[8 * s2 + 4], sacc[8 * s2 + 5]); w.w = pkbf(sacc[8 * s2 + 6], sacc[8 * s2 + 7]);
                const s16x8 pf = __builtin_bit_cast(s16x8, w);
#pragma unroll
                for (int eb = 0; eb < 2; ++eb) {
                    const LAS bf16* vr = VT + (cl * 64 + eb * 32 + r32) * 72 + sb * 32 + 16 * s2 + 4 * half;
                    const u32x2 v0 = *(const LAS u32x2*)vr, v1 = *(const LAS u32x2*)(vr + 8);
                    const u32x4 vv = (u32x4){v0.x, v0.y, v1.x, v1.y};
                    oacc[eb] = __builtin_amdgcn_mfma_f32_32x32x16_bf16(__builtin_bit_cast(s16x8, vv), pf, oacc[eb], 0, 0, 0);
                }
            }
        }
    }
    rs += __shfl_xor(rs, 32);
    const float den = iw_t * qn + rs;
    const float dn = 1.f / fmaxf(fabsf(den), __expf(-mt_t));
    float ss = 0.f;
#pragma unroll
    for (int eb = 0; eb < 2; ++eb)
#pragma unroll
        for (int r = 0; r < 16; ++r) { const float v = oacc[eb][r] * dn; oacc[eb][r] = v; ss = fmaf(v, v, ss); }
    ss += __shfl_xor(ss, 32);
    const float rr = 1.f / sqrtf(ss * (1.f / 64.f) + EPS);
    const size_t tok = (size_t)b * SEQ + tseq;
    const float* hg = p.ml_head_norm + l * 64;
#pragma unroll
    for (int eb = 0; eb < 2; ++eb)
#pragma unroll
        for (int g = 0; g < 4; ++g) { const int e0 = eb * 32 + 8 * g + 4 * half; const f32x4 gg = *(const f32x4*)(hg + e0);
            const u32x2 og = *(const u32x2*)(Z + tok * ZP + 1536 + h * 64 + e0);
            u32x2 w; w.x = pkbf(sigmoidf_(bflo(og.x)) * oacc[eb][4 * g] * rr * gg[0], sigmoidf_(bfhi(og.x)) * oacc[eb][4 * g + 1] * rr * gg[1]);
            w.y = pkbf(sigmoidf_(bflo(og.y)) * oacc[eb][4 * g + 2] * rr * gg[2], sigmoidf_(bfhi(og.y)) * oacc[eb][4 * g + 3] * rr * gg[3]);
            *(u32x2*)(O1 + tok * 256 + h * 64 + e0) = w; }
}
__device__ __forceinline__ unsigned mono_bits(float s) { s = (s == 0.f) ? 0.f : s; const unsigned u = __float_as_uint(s); return (u & 0x80000000u) ? ~u : (u | 0x80000000u); }
__device__ __forceinline__ void dsa_item(const Params& p, int lds_l, int b, int qt, LAS unsigned char* lds, int wv) {
    const int tid = tid_fresh(wv), lane = tid & 63, w = wv, half = lane >> 5, r32 = lane & 31;
    const bf16* Z = (const bf16*)(p.ws + WS_BIG); const float* ZS = (const float*)(p.ws + WS_ZS); const bf16* IK = (const bf16*)(p.ws + WS_IK); bf16* O3 = (bf16*)(p.ws + WS_O + 3 * OB_STRIDE);
    LAS unsigned* hist = (LAS unsigned*)lds + w * 1024;
    LAS unsigned* maskw = (LAS unsigned*)(lds + 32768);
    LAS bf16* KC = (LAS bf16*)(lds + 49152);
    LAS bf16* Kd = (LAS bf16*)(lds + 81920); LAS bf16* VTd = Kd + 64 * 72;
    const size_t tokb = (size_t)b * SEQ; const int tb = qt * 32 + 4 * w;
    const int ntiles = qt + 1, nkeys = ntiles * 32, nchunks = (ntiles + 15) >> 4;
    s16x8 aq0, aq1;
    { const bf16* ap = Z + (tokb + tb + (r32 >> 3)) * ZP + 2816 + (r32 & 7) * 32 + half * 8; aq0 = *(const s16x8*)ap; aq1 = *(const s16x8*)(ap + 16); }
    float wq[4][4];
#pragma unroll
    for (int g = 0; g < 4; ++g) { const f32x4 x = *(const f32x4*)(ZS + (tokb + tb + g) * ZSP + 160 + 4 * half); wq[g][0] = x[0]; wq[g][1] = x[1]; wq[g][2] = x[2]; wq[g][3] = x[3]; }
    unsigned tau[4] = {0u, 0u, 0u, 0u}; int quota[4] = {1 << 30, 1 << 30, 1 << 30, 1 << 30};
    unsigned prefix[4] = {0u, 0u, 0u, 0u}; int krem[4] = {256, 256, 256, 256};
    int base[4] = {0, 0, 0, 0}, eqseen[4] = {0, 0, 0, 0};
    const unsigned lowmask = (1u << r32) - 1u;
#define DSA_SCORES(ktl, sc) do { const LAS bf16* kp_ = KC + ((ktl) * 32 + r32) * 32 + half * 8; \
        const s16x8 b0_ = *(const LAS s16x8*)kp_, b1_ = *(const LAS s16x8*)(kp_ + 16); f32x16 a_ = {0.f, 0.f, 0.f, 0.f, 0.f, 0.f, 0.f, 0.f, 0.f, 0.f, 0.f, 0.f, 0.f, 0.f, 0.f, 0.f}; \
        a_ = __builtin_amdgcn_mfma_f32_32x32x16_bf16(aq0, b0_, a_, 0, 0, 0); a_ = __builtin_amdgcn_mfma_f32_32x32x16_bf16(aq1, b1_, a_, 0, 0, 0); \
        _Pragma("unroll") for (int g_ = 0; g_ < 4; ++g_) { float pt_ = wq[g_][0] * fmaxf(a_[4 * g_], 0.f); pt_ = fmaf(wq[g_][1], fmaxf(a_[4 * g_ + 1], 0.f), pt_); \
            pt_ = fmaf(wq[g_][2], fmaxf(a_[4 * g_ + 2], 0.f), pt_); pt_ = fmaf(wq[g_][3], fmaxf(a_[4 * g_ + 3], 0.f), pt_); sc[g_] = pt_ + __shfl_xor(pt_, 32); } } while (0)
    const int pass0 = (qt >= 8) ? 0 : 4;
#pragma unroll 1
    for (int pass = pass0; pass < 5; ++pass) {
        const int shift = 24 - 8 * pass;
        if (pass < 4) {
#pragma unroll
            for (int i = 0; i < 4; ++i) *(LAS u32x4*)(hist + (i * 64 + lane) * 4) = (u32x4){0u, 0u, 0u, 0u};
        }
        const unsigned pfa = half ? prefix[2] : prefix[0], pfb = half ? prefix[3] : prefix[1];
        const int ta = tb + 2 * half, tbq = ta + 1;
        u32x4 pre[4];
#pragma unroll
        for (int i = 0; i < 4; ++i) { const int kb = (tid * 16 + i * 8192) >> 6; pre[i] = (kb < nkeys) ? *(const u32x4*)((const unsigned char*)(IK + tokb * 32) + tid * 16 + i * 8192) : (u32x4){0u, 0u, 0u, 0u}; }
#pragma unroll 1
        for (int ch = 0; ch < nchunks; ++ch) {
            __syncthreads();
#pragma unroll
            for (int i = 0; i < 4; ++i) *(LAS u32x4*)((LAS unsigned char*)KC + tid * 16 + i * 8192) = pre[i];
            __syncthreads();
            if (ch + 1 < nchunks) {
#pragma unroll
                for (int i = 0; i < 4; ++i) { const int kb = (ch + 1) * 512 + ((tid * 16 + i * 8192) >> 6);
                    pre[i] = (kb < nkeys) ? *(const u32x4*)((const unsigned char*)(IK + (tokb + (size_t)(ch + 1) * 512) * 32) + tid * 16 + i * 8192) : (u32x4){0u, 0u, 0u, 0u}; }
            }
            const int nt = min(16, ntiles - ch * 16);
            if (pass < 4) {
#pragma unroll 2
                for (int ktl = 0; ktl < nt; ++ktl) {
                    float sc[4]; DSA_SCORES(ktl, sc);
                    const int key = (ch * 16 + ktl) * 32 + r32;
                    const unsigned ma = mono_bits(half ? sc[2] : sc[0]), mb = mono_bits(half ? sc[3] : sc[1]);
                    const bool oka = (key <= ta) && (pass == 0 || (ma >> (shift + 8)) == pfa);
                    const bool okb = (key <= tbq) && (pass == 0 || (mb >> (shift + 8)) == pfb);
                    if (oka) __hip_atomic_fetch_add(hist + (2 * half) * 256 + ((ma >> shift) & 255u), 1u, __ATOMIC_RELAXED, __HIP_MEMORY_SCOPE_WORKGROUP);
                    if (okb) __hip_atomic_fetch_add(hist + (2 * half + 1) * 256 + ((mb >> shift) & 255u), 1u, __ATOMIC_RELAXED, __HIP_MEMORY_SCOPE_WORKGROUP);
                }
            } else {
#pragma unroll 1
                for (int ktl = 0; ktl < nt; ++ktl) {
                    float sc[4]; DSA_SCORES(ktl, sc);
                    const int key = (ch * 16 + ktl) * 32 + r32;
#pragma unroll
                    for (int g = 0; g < 4; ++g) {
                        const unsigned m = mono_bits(sc[g]); const bool valid = key <= tb + g;
                        const bool eq = valid && (m == tau[g]);
                        const unsigned beq = (unsigned)__ballot(eq);
                        const int rank = eqseen[g] + __popc(beq & lowmask);
                        const bool sel = valid && ((m > tau[g]) || (eq && rank < quota[g]));
                        const unsigned bsel = (unsigned)__ballot(sel);
                        if (lane == 0) maskw[(4 * w + g) * 128 + ch * 16 + ktl] = bsel;
                        base[g] += __popc(bsel); eqseen[g] += __popc(beq);
                    }
                }
            }
        }
        if (pass < 4) {
            LDS_WAIT();
#pragma unroll
            for (int g = 0; g < 4; ++g) {
                const u32x4 cv = *(const LAS u32x4*)(hist + g * 256 + lane * 4);
                const int c0 = (int)cv.x, c1 = (int)cv.y, c2 = (int)cv.z, c3 = (int)cv.w, tot = c0 + c1 + c2 + c3;
                int v = tot;
#pragma unroll
                for (int d = 1; d < 64; d <<= 1) { const int n = __shfl_down(v, d); if (lane + d < 64) v += n; }
                const int a3 = v - tot, a2 = a3 + c3, a1 = a2 + c2, a0 = a1 + c1; const int k = krem[g];
                int fb = -1, fa = 0;
                if (a3 < k && a3 + c3 >= k) { fb = 3; fa = a3; }
                else if (a2 < k && a2 + c2 >= k) { fb = 2; fa = a2; }
                else if (a1 < k && a1 + c1 >= k) { fb = 1; fa = a1; }
                else if (a0 < k && a0 + c0 >= k) { fb = 0; fa = a0; }
                const unsigned long long mk = __ballot(fb >= 0);
                const int src = (int)__builtin_ctzll(mk | (1ull << 63));
                const int bin = __shfl(4 * lane + fb, src), above = __shfl(fa, src);
                prefix[g] = (prefix[g] << 8) | (unsigned)bin; krem[g] = k - above;
            }
            if (pass == 3) {
#pragma unroll
                for (int g = 0; g < 4; ++g) { tau[g] = prefix[g]; quota[g] = krem[g]; }
            }
        }
    }
    (void)base;
    __syncthreads();
    {
        const float* sgn = p.dsa_qk_norm + lds_l * 128; float gqm = 0.f, gkm = 0.f;
#pragma unroll 2
        for (int i = 0; i < 64; ++i) { gqm = fmaxf(gqm, fabsf(sgn[i])); gkm = fmaxf(gkm, fabsf(sgn[64 + i])); }
        const float coff = 8.f * gqm * gkm;
        const int cb = w & 3, ksp = w >> 2, ql = 8 * cb + (r32 >> 2), hh = r32 & 3;
        s16x8 qf[4];
        { const bf16* qp = Z + (tokb + qt * 32 + ql) * ZP + 2560 + hh * 64 + 8 * half;
#pragma unroll
          for (int s4 = 0; s4 < 4; ++s4) qf[s4] = *(const s16x8*)(qp + 16 * s4); }
        f32x16 oacc[2];
#pragma unroll
        for (int db = 0; db < 2; ++db)
#pragma unroll
            for (int r = 0; r < 16; ++r) oacc[db][r] = 0.f;
        float lsum = 0.f;
        const int nT = (ntiles + 1) >> 1;
        const int skey = tid >> 3, sseg = tid & 7;
        const float* sgp = ZS + (tokb + skey) * ZSP + sseg * 16;
        f32x4 pr[4];
#pragma unroll
        for (int i = 0; i < 4; ++i) pr[i] = *(const f32x4*)(sgp + 4 * i);
#pragma unroll 1
        for (int tT = 0; tT < nT; ++tT) {
            __syncthreads();
            if (sseg < 4) {
                u32x4 w0, w1; w0.x = pkbf(pr[0][0], pr[0][1]); w0.y = pkbf(pr[0][2], pr[0][3]); w0.z = pkbf(pr[1][0], pr[1][1]); w0.w = pkbf(pr[1][2], pr[1][3]);
                w1.x = pkbf(pr[2][0], pr[2][1]); w1.y = pkbf(pr[2][2], pr[2][3]); w1.z = pkbf(pr[3][0], pr[3][1]); w1.w = pkbf(pr[3][2], pr[3][3]);
                *(LAS u32x4*)(Kd + skey * 72 + sseg * 16) = w0; *(LAS u32x4*)(Kd + skey * 72 + sseg * 16 + 8) = w1;
            } else {
                LAS bf16* vd = VTd + ((sseg - 4) * 16) * 72 + skey;
#pragma unroll
                for (int i = 0; i < 4; ++i) { const unsigned a0 = pkbf(pr[i][0], pr[i][1]), a1 = pkbf(pr[i][2], pr[i][3]);
                    vd[(4 * i) * 72] = (bf16)(a0 & 0xffffu); vd[(4 * i + 1) * 72] = (bf16)(a0 >> 16); vd[(4 * i + 2) * 72] = (bf16)(a1 & 0xffffu); vd[(4 * i + 3) * 72] = (bf16)(a1 >> 16); }
            }
            __syncthreads();
            if (tT + 1 < nT) {
#pragma unroll
                for (int i = 0; i < 4; ++i) pr[i] = *(const f32x4*)(sgp + (size_t)(tT + 1) * 64 * ZSP + 4 * i);
            }
            const int st = 2 * tT + ksp;
            if (st < ntiles) {
                const unsigned mw = maskw[ql * 128 + st];
                f32x16 sacc;
#pragma unroll
                for (int r = 0; r < 16; ++r) sacc[r] = 0.f;
#pragma unroll
                for (int s4 = 0; s4 < 4; ++s4) { const s16x8 ak = *(const LAS s16x8*)(Kd + (32 * ksp + r32) * 72 + 16 * s4 + 8 * half);
                    sacc = __builtin_amdgcn_mfma_f32_32x32x16_bf16(ak, qf[s4], sacc, 0, 0, 0); }
#pragma unroll
                for (int r = 0; r < 16; ++r) { const int kbit = 8 * (r >> 2) + 4 * half + (r & 3); const float pe = ((mw >> kbit) & 1u) ? __expf(sacc[r] - coff) : 0.f; sacc[r] = pe; lsum += pe; }
#pragma unroll
                for (int s2 = 0; s2 < 2; ++s2) {
                    u32x4 wp; wp.x = pkbf(sacc[8 * s2], sacc[8 * s2 + 1]); wp.y = pkbf(sacc[8 * s2 + 2], sacc[8 * s2 + 3]); wp.z = pkbf(sacc[8 * s2 + 4], sacc[8 * s2 + 5]); wp.w = pkbf(sacc[8 * s2 + 6], sacc[8 * s2 + 7]);
                    const s16x8 pf = __builtin_bit_cast(s16x8, wp);
#pragma unroll
                    for (int db = 0; db < 2; ++db) {
                        const LAS bf16* vr = VTd + (db * 32 + r32) * 72 + 32 * ksp + 16 * s2 + 4 * half;
                        const u32x2 v0 = *(const LAS u32x2*)vr, v1 = *(const LAS u32x2*)(vr + 8);
                        const u32x4 vv = (u32x4){v0.x, v0.y, v1.x, v1.y};
                        oacc[db] = __builtin_amdgcn_mfma_f32_32x32x16_bf16(__builtin_bit_cast(s16x8, vv), pf, oacc[db], 0, 0, 0);
                    }
                }
            }
        }
        lsum += __shfl_xor(lsum, 32);
        __syncthreads();
        LAS float* xch = (LAS float*)lds + (w & 3) * (33 * 64);
        if (ksp == 1) {
#pragma unroll
            for (int db = 0; db < 2; ++db)
#pragma unroll
                for (int r = 0; r < 16; ++r) xch[(db * 16 + r) * 64 + lane] = oacc[db][r];
            xch[32 * 64 + lane] = lsum;
        }
        __syncthreads();
        if (ksp == 0) {
            const float is = 1.f / (lsum + xch[32 * 64 + lane]);
            bf16* orow = O3 + (tokb + qt * 32 + ql) * 256 + hh * 64;
#pragma unroll
            for (int db = 0; db < 2; ++db)
#pragma unroll
                for (int g = 0; g < 4; ++g) { const int d0 = db * 32 + 8 * g + 4 * half;
                    const float x0 = (oacc[db][4 * g] + xch[(db * 16 + 4 * g) * 64 + lane]) * is, x1 = (oacc[db][4 * g + 1] + xch[(db * 16 + 4 * g + 1) * 64 + lane]) * is;
                    const float x2 = (oacc[db][4 * g + 2] + xch[(db * 16 + 4 * g + 2) * 64 + lane]) * is, x3 = (oacc[db][4 * g + 3] + xch[(db * 16 + 4 * g + 3) * 64 + lane]) * is;
                    u32x2 wo; wo.x = pkbf(x0, x1); wo.y = pkbf(x2, x3); *(u32x2*)(orow + d0) = wo; }
        }
    }
#undef DSA_SCORES
    __syncthreads();
}

constexpr int Q_ML = 32, Q_DIFF = 512, Q_DSA = 1024, Q_SB = 256, Q_TOTAL = Q_ML + Q_DIFF + Q_DSA + Q_SB;
__device__ __forceinline__ Params load_params() {
#if defined(__HIP_DEVICE_COMPILE__)
    const __attribute__((address_space(4))) Params* pp = (const __attribute__((address_space(4))) Params*)__builtin_amdgcn_kernarg_segment_ptr();
    asm volatile("" : "+s"(pp));
    Params r;
    r.x = pp->x; r.pos = pp->pos; r.ffn1_norm = pp->ffn1_norm; r.ffn1_gu = pp->ffn1_gu; r.ffn1_down = pp->ffn1_down; r.mix_norm = pp->mix_norm; r.w_in = pp->w_in; r.diff_qk_norm = pp->diff_qk_norm;
    r.diff_lambda = pp->diff_lambda; r.diff_head_norm = pp->diff_head_norm; r.ml_conv_w = pp->ml_conv_w; r.ml_conv_b = pp->ml_conv_b; r.ml_gate_bias = pp->ml_gate_bias; r.ml_head_norm = pp->ml_head_norm;
    r.dsa_qk_norm = pp->dsa_qk_norm; r.w_branch = pp->w_branch; r.w_out = pp->w_out; r.ffn2_norm = pp->ffn2_norm; r.ffn2_gu = pp->ffn2_gu; r.ffn2_down = pp->ffn2_down; r.out = pp->out; r.ws = pp->ws;
    return r;
#else
    return Params{};
#endif
}
__device__ __forceinline__ int next_item(unsigned* ctr, LAS int* slot, int wv) {
    __syncthreads();
    if (tid_fresh(wv) == 0) *slot = (int)atomicAdd(ctr, 1u);
    __syncthreads();
    return *slot;
}
__device__ __forceinline__ void mixer_phase1(int l, LAS unsigned char* lds, int wv, int co = 0) {
    LAS int* slot = (LAS int*)(lds + LDS_BYTES - 64);
    { const Params p = load_params(); unsigned* ctr = (unsigned*)(p.ws + WS_CTL) + 64 * (4 * l + 0 + co);
      for (;;) { const int it = next_item(ctr, slot, wv); if (it >= Q_DIFF) break; diffm_item(p, l, it & 31, 15 - (it >> 5), lds, wv); } }
    { const Params p = load_params(); unsigned* ctr = (unsigned*)(p.ws + WS_CTL) + 64 * (4 * l + 1 + co);
      for (;;) { const int it = next_item(ctr, slot, wv); if (it >= 512) break; mlB_item(p, l, it & 31, it >> 5, lds, wv); } }
}
__device__ __forceinline__ void mixer_phase2(int l, LAS unsigned char* lds, int wv, int co = 0) {
    LAS int* slot = (LAS int*)(lds + LDS_BYTES - 64);
    { const Params p = load_params(); unsigned* ctr = (unsigned*)(p.ws + WS_CTL) + 64 * (4 * l + 2 + co);
      for (;;) { const int it = next_item(ctr, slot, wv); if (it >= 32 + Q_DSA) break;
          if (it < 32) mlS_item(p, it, wv); else { const int i = it - 32; dsa_item(p, l, i & 7, 127 - (i >> 3), lds, wv); } } }
}
__device__ __forceinline__ void mixer_phase3(int l, LAS unsigned char* lds, int wv, int co = 0) {
    LAS int* slot = (LAS int*)(lds + LDS_BYTES - 64);
    { const Params p = load_params(); unsigned* ctr = (unsigned*)(p.ws + WS_CTL) + 64 * (4 * l + 3 + co);
      for (;;) { const int it = next_item(ctr, slot, wv); if (it >= 512) break; mlD_item(p, l, it & 31, it >> 5, lds, wv); } }
    { const Params p = load_params(); unsigned* ctr = (unsigned*)(p.ws + WS_CTL) + 64 * (8 + l + co);
      for (;;) { const int it = next_item(ctr, slot, wv); if (it >= Q_SB) break; sb_item(p, it >> 3, it & 7, lds, wv); } }
}

#define PH_LOCALS const Params p = load_params(); const int tid = tid_fresh(wv), lane = tid & 63, wave = tid >> 6; const int gw = (int)blockIdx.x * NWAVES + wave, ngw = (int)gridDim.x * NWAVES; \
    (void)lane; (void)gw; (void)ngw; bf16* HN = (bf16*)(p.ws + WS_HN); bf16* BIGB = (bf16*)(p.ws + WS_BIG); (void)HN; (void)BIGB;
template <int l> __device__ __forceinline__ void layer_body(cg::grid_group& grid, LAS unsigned char* lds, const int wv) {
        { PH_LOCALS const unsigned char* wl = p.ws + WS_W + (size_t)l * WL_STRIDE; EpiSwiglu E{BIGB}; run_gemm(lds, HN, (const bf16*)(wl + WL_GU1), T, 2 * FF, D, E, wv); }
        grid.sync();
#if PROBE_DUP & 8
        { PH_LOCALS const unsigned char* wl = p.ws + WS_W + (size_t)l * WL_STRIDE; EpiSwiglu E{BIGB}; run_gemm(lds, HN, (const bf16*)(wl + WL_GU1), T, 2 * FF, D, E, wv); }
        grid.sync();
#endif
        { PH_LOCALS const unsigned char* wl = p.ws + WS_W + (size_t)l * WL_STRIDE; EpiResid E{l == 0 ? p.x : p.out, p.out, 0.5f}; run_gemm(lds, BIGB, (const bf16*)(wl + WL_D1), T, D, FF, E, wv); }
        grid.sync();
        { PH_LOCALS rms_rows(p.out, p.mix_norm + l * D, HN, gw, ngw, lane); }
        grid.sync();
        { PH_LOCALS const unsigned char* wl = p.ws + WS_W + (size_t)l * WL_STRIDE; EpiZ E{BIGB, (float*)(p.ws + WS_ZS)}; run_gemm(lds, HN, (const bf16*)(wl + WL_INA), T, 3328, D, E, wv); }
        grid.sync();
        { PH_LOCALS if (gw < 32) ml_prepass(p, l, gw, lane); prep_phase(p, l, gw, ngw, lane); }
        grid.sync();
        mixer_phase1(l, lds, wv);
#if PROBE_DUP & 1
        grid.sync(); mixer_phase1(l, lds, wv, 16);
#endif
        grid.sync();
        mixer_phase2(l, lds, wv);
#if PROBE_DUP & 2
        grid.sync(); mixer_phase2(l, lds, wv, 16);
#endif
        grid.sync();
        mixer_phase3(l, lds, wv);
#if PROBE_DUP & 4
        grid.sync(); mixer_phase3(l, lds, wv, 16);
#endif
        grid.sync();
#pragma unroll 1
        for (int b = 0; b < 4; ++b) {
            { PH_LOCALS const unsigned char* wl = p.ws + WS_W + (size_t)l * WL_STRIDE; EpiSig E{BIGB}; run_gemm(lds, HN, (const bf16*)(wl + WL_G) + (size_t)b * D * D, T, D, D, E, wv); }
            grid.sync();
            { PH_LOCALS const unsigned char* wl = p.ws + WS_W + (size_t)l * WL_STRIDE; EpiGate E{BIGB, (float*)(p.ws + WS_BIG + 64 * MiB), HN, b == 0 ? 0 : (b == 3 ? 2 : 1)};
              run_gemm(lds, (const bf16*)(p.ws + WS_O + b * OB_STRIDE), (const bf16*)(wl + WL_BR) + (size_t)b * D * 256, T, D, 256, E, wv); }
            grid.sync();
        }
        { PH_LOCALS const unsigned char* wl = p.ws + WS_W + (size_t)l * WL_STRIDE; EpiResid E{p.out, p.out, 1.0f}; run_gemm(lds, HN, (const bf16*)(wl + WL_OUT), T, D, D, E, wv); }
        grid.sync();
        { PH_LOCALS rms_rows(p.out, p.ffn2_norm + l * D, HN, gw, ngw, lane); }
        grid.sync();
        { PH_LOCALS const unsigned char* wl = p.ws + WS_W + (size_t)l * WL_STRIDE; EpiSwiglu E{BIGB}; run_gemm(lds, HN, (const bf16*)(wl + WL_GU2), T, 2 * FF, D, E, wv); }
        grid.sync();
#if PROBE_DUP & 8
        { PH_LOCALS const unsigned char* wl = p.ws + WS_W + (size_t)l * WL_STRIDE; EpiSwiglu E{BIGB}; run_gemm(lds, HN, (const bf16*)(wl + WL_GU2), T, 2 * FF, D, E, wv); }
        grid.sync();
#endif
        { PH_LOCALS const unsigned char* wl = p.ws + WS_W + (size_t)l * WL_STRIDE; EpiResid E{p.out, p.out, 0.5f}; run_gemm(lds, BIGB, (const bf16*)(wl + WL_D2), T, D, FF, E, wv); }
        if (l + 1 < DEPTH) {
            grid.sync();
            { PH_LOCALS rms_rows(p.out, p.ffn1_norm + (l + 1) * D, HN, gw, ngw, lane); }
            grid.sync();
        }
    }

__global__ void __launch_bounds__(NTHR, 2) hybrid_fwd(Params p_unused) {
    extern __shared__ __attribute__((aligned(16))) unsigned char lds_raw[];
    LAS unsigned char* lds = (LAS unsigned char*)lds_raw;
    cg::grid_group grid = cg::this_grid();
    const int wv = __builtin_amdgcn_readfirstlane((int)threadIdx.x >> 6);
    {
        PH_LOCALS
        SegRun R; R.base = 0; R.gw = gw; R.ngw = ngw; R.lane = lane; R.scr = (LAS float*)(lds + wave * 8704);
        for (int l = 0; l < DEPTH; ++l) convert_weights(p, l, R);
        if (blockIdx.x == 0 && tid < 64) ((unsigned*)(p.ws + WS_CTL))[64 * tid] = 0u;
        rms_rows(p.x, p.ffn1_norm, HN, gw, ngw, lane);
    }
    grid.sync();
    layer_body<0>(grid, lds, wv);
    layer_body<1>(grid, lds, wv);
}

extern "C" void kernel_launch(void* const* d_in, const int* in_sizes, int n_in, void* d_out, int out_size, void* d_ws, size_t ws_size, hipStream_t stream) {
    static int grid = 0;
    if (grid == 0) {
        if (n_in != 20 || out_size != T * D || ws_size < WS_END2) { fprintf(stderr, "kernel_launch: unexpected shapes (n_in %d out %d ws %zu)\n", n_in, out_size, ws_size); grid = -1; return; }
        int dev = 0, cus = 0, per_cu = 0;
        hipGetDevice(&dev); hipDeviceGetAttribute(&cus, hipDeviceAttributeMultiprocessorCount, dev);
        hipFuncSetAttribute((const void*)hybrid_fwd, hipFuncAttributeMaxDynamicSharedMemorySize, LDS_BYTES);
        hipOccupancyMaxActiveBlocksPerMultiprocessor(&per_cu, (const void*)hybrid_fwd, NTHR, LDS_BYTES);
        if (per_cu < 1) { fprintf(stderr, "kernel_launch: occupancy query says %d\n", per_cu); per_cu = 1; }
        (void)hipGetLastError();
        grid = cus * 1;
    }
    if (grid < 0) return;
    Params p{};
    p.x = (const float*)d_in[0]; p.pos = (const int*)d_in[1];
    p.ffn1_norm = (const float*)d_in[2]; p.ffn1_gu = (const float*)d_in[3]; p.ffn1_down = (const float*)d_in[4]; p.mix_norm = (const float*)d_in[5]; p.w_in = (const float*)d_in[6];
    p.diff_qk_norm = (const float*)d_in[7]; p.diff_lambda = (const float*)d_in[8]; p.diff_head_norm = (const float*)d_in[9]; p.ml_conv_w = (const float*)d_in[10]; p.ml_conv_b = (const float*)d_in[11];
    p.ml_gate_bias = (const float*)d_in[12]; p.ml_head_norm = (const float*)d_in[13]; p.dsa_qk_norm = (const float*)d_in[14]; p.w_branch = (const float*)d_in[15]; p.w_out = (const float*)d_in[16];
    p.ffn2_norm = (const float*)d_in[17]; p.ffn2_gu = (const float*)d_in[18]; p.ffn2_down = (const float*)d_in[19];
    p.out = (float*)d_out; p.ws = (unsigned char*)d_ws;
    void* args[] = {&p};
    hipError_t e = hipLaunchCooperativeKernel((const void*)hybrid_fwd, dim3(grid), dim3(NTHR), args, LDS_BYTES, stream);
    if (e != hipSuccess) fprintf(stderr, "cooperative launch failed: %s (grid %d)\n", hipGetErrorString(e), grid);
}
```

```cpp
#include <hip/hip_runtime.h>
#include <hip/hip_cooperative_groups.h>
#include <cstdio>
#include <cstdint>
namespace cg = cooperative_groups;
#ifndef PROBE_DUP
#define PROBE_DUP 0
#endif
namespace pg8 {
#define PG8_LAS __attribute__((address_space(3)))
typedef unsigned short bf16_t;
typedef short bf16x8 __attribute__((ext_vector_type(8)));
typedef float f32x4 __attribute__((ext_vector_type(4)));
typedef unsigned u32x4 __attribute__((ext_vector_type(4)));
constexpr int BM = 256, BK = 64, HALF = 128, HTB = HALF * BK * 2  , STAGE_BYTES = 8 * HTB, NXCD = 8, WGM = 8;

__host__ __device__ __forceinline__ int lds_byte(int r, int c) { const int st = (r >> 4) * 2 + (c >> 5), rr = r & 15, cc = c & 31, ob = rr * 64 + cc * 2; return st * 1024 + (ob ^ (((ob >> 9) & 1) << 5)); }
__host__ __device__ __forceinline__ void stage_rc(int b, int& R, int& C) { const int st = b / 1024, sb = b % 1024, swz = sb ^ (((sb >> 9) & 1) << 5); R = (st >> 1) * 16 + swz / 64; C = (st & 1) * 32 + (swz % 64) / 2; }
__host__ __device__ __forceinline__ int perm32(int rho) { const int n = rho >> 4, i = rho & 15; return 8 * (i >> 2) + 4 * n + (i & 3); }

struct Unit { int pm, pn; };
struct Gemm { const bf16_t* A; const bf16_t* Bt; int M, N, K; };

struct StaticOrder {
    int nM, nN, nwg, G, c;
    __host__ __device__ void init(int M, int N, int G_, int c_) { nM = M / BM; nN = N / BM; nwg = nM * nN; G = G_; c = c_; }
    __host__ __device__ bool next(int i, Unit& u) const {
        const long L = (long)i * G + c; if (L >= nwg) return false;
        int wgid = (int)L; { const int q = nwg / NXCD, r = nwg % NXCD, xcd = wgid % NXCD, off = wgid / NXCD; wgid = (xcd < r ? xcd * (q + 1) : r * (q + 1) + (xcd - r) * q) + off; }
        const int nig = WGM * nN, gid = wgid / nig, fm = gid * WGM, gsz = (nM - fm) < WGM ? (nM - fm) : WGM;
        u.pm = fm + ((wgid % nig) % gsz); u.pn = (wgid % nig) / gsz; return true;
    }
    __device__ __forceinline__ void a_ready(const Unit&) const {}
    __device__ __forceinline__ void done(const Unit&) const {}
};

__device__ __forceinline__ unsigned cvt_pk_bf16(float lo, float hi) { unsigned r; asm volatile("v_cvt_pk_bf16_f32 %0, %1, %2" : "=v"(r) : "v"(lo), "v"(hi)); return r; }
template <class Epi, class Sched, bool ALIGN_EPI = false, bool SP2 = false>
__device__ __forceinline__ void gemm_phase(PG8_LAS unsigned char* lds, const Gemm g, const Sched& S, const Epi& E, const int wave_in) {
    unsigned z_ = 0u; asm volatile("" : "+v"(z_)); int w_ = wave_in; asm volatile("" : "+s"(w_));
    const int tid_ = w_ * 64 + (int)__builtin_amdgcn_mbcnt_hi(~0u, __builtin_amdgcn_mbcnt_lo(~0u, z_));
    const int tid = tid_, wid = __builtin_amdgcn_readfirstlane(tid >> 6), lane = tid & 63, wr = wid >> 2, wc = wid & 3, fr = lane & 15, fq = lane >> 4;
    const int K = g.K, nt = K / BK;
    unsigned voffA[2], voffB[2];
#pragma unroll
    for (int i = 0; i < 2; ++i) { int R, C; stage_rc(tid * 16 + i * 8192, R, C); const int Rb = Epi::PERM ? ((R & ~31) + perm32(R & 31)) : R;
        voffA[i] = (unsigned)(R * K + C) * 2u; voffB[i] = (unsigned)(Rb * K + C) * 2u; }
    const size_t kstep = (size_t)(BK * 2);
    const size_t hstep = (size_t)HALF * K * 2;
    const size_t tstep = 2 * hstep;
    const unsigned ldsw = (unsigned)wid * 1024u;
    const int aoff = lds_byte(wr * 64 + fr, fq * 8), boff = lds_byte(wc * 32 + fr, fq * 8);
#define PG8_SA(b, h) (((b) * 2 + (h)) * HTB)
#define PG8_SB(b, h) ((4 + (b) * 2 + (h)) * HTB)
#define PG8_STAGE(bufoff, gbase, voff) do { _Pragma("unroll") for (int _i = 0; _i < 2; ++_i) \
        __builtin_amdgcn_global_load_lds((const unsigned*)((const char*)(gbase) + (voff)[_i]), (PG8_LAS unsigned*)(lds + (bufoff) + ldsw + _i * 8192), 16, 0, 0); } while (0)
#define PG8_LDA(dst, b, h) do { _Pragma("unroll") for (int m = 0; m < 4; ++m) _Pragma("unroll") for (int k = 0; k < 2; ++k) dst[m][k] = *(const PG8_LAS bf16x8*)(lds + PG8_SA(b, h) + aoff + m * 2048 + k * 1024); } while (0)
#define PG8_LDB(dst, b, h) do { _Pragma("unroll") for (int n = 0; n < 2; ++n) _Pragma("unroll") for (int k = 0; k < 2; ++k) dst[n][k] = *(const PG8_LAS bf16x8*)(lds + PG8_SB(b, h) + boff + n * 2048 + k * 1024); } while (0)
#define PG8_MMA(ai, bj, At, Bt) do { __builtin_amdgcn_s_setprio(1); _Pragma("unroll") for (int m = 0; m < 4; ++m) _Pragma("unroll") for (int n = 0; n < 2; ++n) _Pragma("unroll") for (int k = 0; k < 2; ++k) \
        acc[ai][bj][m][n] = __builtin_amdgcn_mfma_f32_16x16x32_bf16(Bt[n][k], At[m][k], acc[ai][bj][m][n], 0, 0, 0); __builtin_amdgcn_s_setprio(0); } while (0)
#define PG8_WAIT_V(n) asm volatile("s_waitcnt vmcnt(" #n ")" ::: "memory")
#define PG8_WAIT_L(n) asm volatile("s_waitcnt lgkmcnt(" #n ")" ::: "memory")
#define PG8_BAR __builtin_amdgcn_s_barrier()
#define PG8_SCHED __builtin_amdgcn_sched_barrier(0)
    Unit cur, nxt; int ui = 0;
    if (!S.next(0, cur)) return;
    f32x4 acc[2][2][4][2];
#pragma unroll
    for (int a = 0; a < 2; ++a)
#pragma unroll
        for (int b = 0; b < 2; ++b)
#pragma unroll
            for (int m = 0; m < 4; ++m)
#pragma unroll
                for (int n = 0; n < 2; ++n) acc[a][b][m][n] = (f32x4){0.f, 0.f, 0.f, 0.f};
    bf16x8 At[4][2], B0[2][2], B1[2][2];
    const char* cA = (const char*)g.A + (size_t)cur.pm * tstep; const char* cB = (const char*)g.Bt + (size_t)cur.pn * tstep;
    S.a_ready(cur);
    if constexpr (SP2) {
        PG8_STAGE(PG8_SB(0, 0), cB, voffB); PG8_STAGE(PG8_SB(0, 1), cB + hstep, voffB); PG8_STAGE(PG8_SA(0, 0), cA, voffA); PG8_STAGE(PG8_SA(0, 1), cA + hstep, voffA);
        if (wr == 1) PG8_BAR;
        PG8_WAIT_V(2); PG8_BAR;
        PG8_STAGE(PG8_SB(1, 0), cB + kstep, voffB); PG8_STAGE(PG8_SA(1, 0), cA + kstep, voffA); PG8_STAGE(PG8_SB(1, 1), cB + hstep + kstep, voffB);
        PG8_WAIT_V(6); PG8_BAR;
    } else {
        PG8_STAGE(PG8_SB(0, 0), cB, voffB); PG8_STAGE(PG8_SA(0, 0), cA, voffA); PG8_STAGE(PG8_SB(0, 1), cB + hstep, voffB); PG8_STAGE(PG8_SA(0, 1), cA + hstep, voffA);
        if (wr == 1) PG8_BAR;
        PG8_WAIT_V(4); PG8_BAR;
        PG8_STAGE(PG8_SB(1, 0), cB + kstep, voffB); PG8_STAGE(PG8_SA(1, 0), cA + kstep, voffA); PG8_STAGE(PG8_SB(1, 1), cB + hstep + kstep, voffB);
        PG8_WAIT_V(6); PG8_BAR;
    }
    for (;;) {
        const bool has_next = S.next(ui + 1, nxt);
        const char* nA = has_next ? (const char*)g.A + (size_t)nxt.pm * tstep : cA; const char* nB = has_next ? (const char*)g.Bt + (size_t)nxt.pn * tstep : cB;
        for (int t = 0; t < nt; t += 2) {
            const bool last = (t == nt - 2);
            const char* a1 = cA + (size_t)(t + 1) * kstep;
            const char* a2 = last ? nA : cA + (size_t)(t + 2) * kstep; const char* b2 = last ? nB : cB + (size_t)(t + 2) * kstep;
            const char* a3 = a2 + kstep; const char* b3 = b2 + kstep;
            if (last && has_next) S.a_ready(nxt);
            if constexpr (SP2) {
            PG8_LDB(B0, 0, 0); PG8_LDB(B1, 0, 1); PG8_SCHED; PG8_LDA(At, 0, 0); PG8_STAGE(PG8_SA(1, 1), a1 + hstep, voffA);
            PG8_WAIT_V(8); PG8_WAIT_L(0); PG8_BAR; PG8_MMA(0, 0, At, B0); PG8_MMA(0, 1, At, B1); PG8_BAR; PG8_SCHED;
            PG8_LDA(At, 0, 1); PG8_STAGE(PG8_SB(0, 0), b2, voffB); PG8_STAGE(PG8_SB(0, 1), b2 + hstep, voffB); PG8_STAGE(PG8_SA(0, 0), a2, voffA);
            PG8_WAIT_V(8); PG8_WAIT_L(0); PG8_BAR; PG8_MMA(1, 0, At, B0); PG8_MMA(1, 1, At, B1); PG8_BAR; PG8_SCHED;
            PG8_LDB(B0, 1, 0); PG8_LDB(B1, 1, 1); PG8_SCHED; PG8_LDA(At, 1, 0); PG8_STAGE(PG8_SA(0, 1), a2 + hstep, voffA);
            PG8_WAIT_V(8); PG8_WAIT_L(0); PG8_BAR; PG8_MMA(0, 0, At, B0); PG8_MMA(0, 1, At, B1); PG8_BAR; PG8_SCHED;
            PG8_LDA(At, 1, 1); PG8_STAGE(PG8_SB(1, 0), b3, voffB); PG8_STAGE(PG8_SB(1, 1), b3 + hstep, voffB); PG8_STAGE(PG8_SA(1, 0), a3, voffA);
            PG8_WAIT_V(8); PG8_WAIT_L(0); PG8_BAR; PG8_MMA(1, 0, At, B0); PG8_MMA(1, 1, At, B1); PG8_BAR; PG8_SCHED;
            } else {
            PG8_LDB(B0, 0, 0); PG8_SCHED; PG8_LDA(At, 0, 0); PG8_STAGE(PG8_SA(1, 1), a1 + hstep, voffA);
            PG8_WAIT_L(8); PG8_BAR; PG8_WAIT_L(0); PG8_MMA(0, 0, At, B0); PG8_BAR; PG8_SCHED;
            PG8_LDB(B1, 0, 1); PG8_STAGE(PG8_SB(0, 0), b2, voffB);
            PG8_BAR; PG8_WAIT_L(0); PG8_MMA(0, 1, At, B1); PG8_BAR;
            PG8_LDA(At, 0, 1); PG8_STAGE(PG8_SA(0, 0), a2, voffA);
            PG8_BAR; PG8_WAIT_L(0); PG8_MMA(1, 0, At, B0); PG8_BAR; PG8_SCHED;
            PG8_STAGE(PG8_SB(0, 1), b2 + hstep, voffB);
            PG8_WAIT_V(6); PG8_BAR; PG8_MMA(1, 1, At, B1); PG8_BAR;
            PG8_LDB(B0, 1, 0); PG8_SCHED; PG8_LDA(At, 1, 0); PG8_STAGE(PG8_SA(0, 1), a2 + hstep, voffA);
            PG8_WAIT_L(8); PG8_BAR; PG8_WAIT_L(0); PG8_MMA(0, 0, At, B0); PG8_BAR; PG8_SCHED;
            PG8_LDB(B1, 1, 1); PG8_STAGE(PG8_SB(1, 0), b3, voffB);
            PG8_BAR; PG8_WAIT_L(0); PG8_MMA(0, 1, At, B1); PG8_BAR;
            PG8_LDA(At, 1, 1); PG8_STAGE(PG8_SA(1, 0), a3, voffA);
            PG8_BAR; PG8_WAIT_L(0); PG8_MMA(1, 0, At, B0); PG8_BAR; PG8_SCHED;
            PG8_STAGE(PG8_SB(1, 1), b3 + hstep, voffB);
            PG8_WAIT_V(6); PG8_BAR; PG8_MMA(1, 1, At, B1); PG8_BAR;
            }
        }
        if constexpr (ALIGN_EPI) { if (wr == 0) PG8_BAR; }
        if constexpr (!Epi::AFTER_DRAIN) { E(acc, cur, wr, wc, fr, fq); S.done(cur); }
        if (!has_next) break;
#pragma unroll
        for (int a = 0; a < 2; ++a)
#pragma unroll
            for (int b = 0; b < 2; ++b)
#pragma unroll
                for (int m = 0; m < 4; ++m)
#pragma unroll
                    for (int n = 0; n < 2; ++n) acc[a][b][m][n] = (f32x4){0.f, 0.f, 0.f, 0.f};
        cur = nxt; cA = nA; cB = nB; ++ui;
        if constexpr (ALIGN_EPI) { if (wr == 1) PG8_BAR; }
    }
    PG8_WAIT_V(0);
    if constexpr (!ALIGN_EPI) { if (wr == 0) PG8_BAR; }
    PG8_BAR;
    if constexpr (Epi::AFTER_DRAIN) { E.fused(acc, cur, wr, wc, fr, fq, lds, wid, lane); S.done(cur); }
#undef PG8_SA
#undef PG8_SB
#undef PG8_STAGE
#undef PG8_LDA
#undef PG8_LDB
#undef PG8_MMA
#undef PG8_WAIT_V
#undef PG8_WAIT_L
#undef PG8_BAR
#undef PG8_SCHED
}
}
#define LAS __attribute__((address_space(3)))
typedef unsigned short bf16;
typedef float f32x4 __attribute__((ext_vector_type(4)));
typedef float f32x16 __attribute__((ext_vector_type(16)));
typedef unsigned u32x4 __attribute__((ext_vector_type(4)));
typedef unsigned u32x2 __attribute__((ext_vector_type(2)));
typedef short s16x8 __attribute__((ext_vector_type(8)));

constexpr int NB = 8, SEQ = 4096, T = NB * SEQ, D = 1024, FF = 2816, DEPTH = 2, NIN = 7344, ZP = 3072, ZSP = 256;
constexpr int NTHR = 512, NWAVES = 8;
constexpr int LDS_BYTES = 147456;
constexpr float EPS = 1e-6f;

constexpr size_t MiB = (size_t)1 << 20;
constexpr size_t WS_CTL = 0;
constexpr size_t WS_W = 1 * MiB, WL_STRIDE = 52 * MiB;
constexpr size_t WL_GU1 = 0, WL_D1 = 11534336, WL_INA = 17301504, WL_G = 24117248, WL_BR = 32505856, WL_OUT = 34603008, WL_GU2 = 36700160, WL_D2 = 48234496;
constexpr size_t WS_HN = 106 * MiB, WS_BIG = 170 * MiB, WS_ZS = 362 * MiB, WS_O = 394 * MiB, WS_IK = 458 * MiB, WS_END = 460 * MiB;
constexpr size_t OB_STRIDE = (size_t)T * 256 * 2;

struct Params {
    const float* x; const int* pos;
    const float *ffn1_norm, *ffn1_gu, *ffn1_down, *mix_norm, *w_in, *diff_qk_norm, *diff_lambda, *diff_head_norm, *ml_conv_w, *ml_conv_b, *ml_gate_bias, *ml_head_norm,
        *dsa_qk_norm, *w_branch, *w_out, *ffn2_norm, *ffn2_gu, *ffn2_down;
    float* out; unsigned char* ws;
};

__device__ __forceinline__ unsigned f2bf(float f) { unsigned u = __float_as_uint(f); return (u + 0x7fffu + ((u >> 16) & 1u)) >> 16; }
__device__ __forceinline__ unsigned pk2(float lo, float hi) { return f2bf(lo) | (f2bf(hi) << 16); }
__device__ __forceinline__ float bflo(unsigned w) { return __uint_as_float(w << 16); }
__device__ __forceinline__ float bfhi(unsigned w) { return __uint_as_float(w & 0xffff0000u); }
__device__ __forceinline__ float wave_sum(float v) {
#pragma unroll
    for (int o = 1; o < 64; o <<= 1) v += __shfl_xor(v, o);
    return v;
}
__device__ __forceinline__ float wave_max(float v) {
#pragma unroll
    for (int o = 1; o < 64; o <<= 1) v = fmaxf(v, __shfl_xor(v, o));
    return v;
}
__device__ __forceinline__ int lane_fresh() { unsigned z = 0u; asm volatile("" : "+v"(z)); return (int)__builtin_amdgcn_mbcnt_hi(~0u, __builtin_amdgcn_mbcnt_lo(~0u, z)); }
__device__ __forceinline__ int tid_fresh(int wv) { int w = wv; asm volatile("" : "+s"(w)); return w * 64 + lane_fresh(); }
#define LDS_WAIT() asm volatile("s_waitcnt lgkmcnt(0)" ::: "memory")
__device__ __forceinline__ float sigmoidf_(float x) { return 1.f / (1.f + __expf(-x)); }

struct EpiSwiglu {
    static constexpr bool PERM = true, AFTER_DRAIN = false;
    bf16* O;
    __device__ __forceinline__ void operator()(const f32x4 (&acc)[2][2][4][2], const pg8::Unit& u, int wr, int wc, int fr_in, int fq_in) const {
        const int ln_ = lane_fresh(); const int fr = ln_ & 15, fq = ln_ >> 4; (void)fr_in; (void)fq_in;
        const int row0 = u.pm * 256 + wr * 64 + fr, col0 = u.pn * 128 + wc * 32 + 8 * fq;
#pragma unroll
        for (int ai = 0; ai < 2; ++ai)
#pragma unroll
            for (int m = 0; m < 4; ++m) {
                bf16* rowp = O + (size_t)(row0 + ai * 128 + m * 16) * FF + col0;
                float r[8];
#pragma unroll
                for (int n = 0; n < 2; ++n)
#pragma unroll
                    for (int j = 0; j < 4; ++j) { const float g = acc[ai][0][m][n][j], uu = acc[ai][1][m][n][j]; r[4 * n + j] = g * sigmoidf_(g) * uu; }
                u32x4 w; w.x = pk2(r[0], r[1]); w.y = pk2(r[2], r[3]); w.z = pk2(r[4], r[5]); w.w = pk2(r[6], r[7]);
                *(u32x4*)rowp = w;
            }
    }
};
struct EpiResid {
    static constexpr bool PERM = true, AFTER_DRAIN = false;
    const float* base; float* out; float scale;
    __device__ __forceinline__ void operator()(const f32x4 (&acc)[2][2][4][2], const pg8::Unit& u, int wr, int wc, int fr_in, int fq_in) const {
        const int ln_ = lane_fresh(); const int fr = ln_ & 15, fq = ln_ >> 4; (void)fr_in; (void)fq_in;
        const int row0 = u.pm * 256 + wr * 64 + fr, col0 = u.pn * 256 + wc * 32 + 8 * fq;
#pragma unroll
        for (int ai = 0; ai < 2; ++ai)
#pragma unroll
            for (int m = 0; m < 4; ++m) {
                const size_t ro = (size_t)(row0 + ai * 128 + m * 16) * D + col0;
#pragma unroll
                for (int bj = 0; bj < 2; ++bj)
#pragma unroll
                    for (int n = 0; n < 2; ++n) { const f32x4 b = *(const f32x4*)(base + ro + bj * 128 + 4 * n); *(f32x4*)(out + ro + bj * 128 + 4 * n) = b + acc[ai][bj][m][n] * scale; }
            }
    }
};
struct EpiZ {
    static constexpr bool PERM = true, AFTER_DRAIN = false;
    bf16* Z; float* ZS;
    __device__ __forceinline__ void operator()(const f32x4 (&acc)[2][2][4][2], const pg8::Unit& u, int wr, int wc, int fr_in, int fq_in) const {
        const int ln_ = lane_fresh(); const int fr = ln_ & 15, fq = ln_ >> 4; (void)fr_in; (void)fq_in;
        const int row0 = u.pm * 256 + wr * 64 + fr, cw = wc * 32 + 8 * fq;
        if (u.pn < 12) {
#pragma unroll
            for (int ai = 0; ai < 2; ++ai)
#pragma unroll
                for (int m = 0; m < 4; ++m) {
                    bf16* rowp = Z + (size_t)(row0 + ai * 128 + m * 16) * ZP + u.pn * 256 + cw;
#pragma unroll
                    for (int bj = 0; bj < 2; ++bj) { const f32x4 v0 = acc[ai][bj][m][0], v1 = acc[ai][bj][m][1];
                        u32x4 w; w.x = pk2(v0[0], v0[1]); w.y = pk2(v0[2], v0[3]); w.z = pk2(v1[0], v1[1]); w.w = pk2(v1[2], v1[3]);
                        *(u32x4*)(rowp + bj * 128) = w; }
                }
        } else {
#pragma unroll
            for (int ai = 0; ai < 2; ++ai)
#pragma unroll
                for (int m = 0; m < 4; ++m) {
                    float* rowp = ZS + (size_t)(row0 + ai * 128 + m * 16) * ZSP + cw;
#pragma unroll
                    for (int bj = 0; bj < 2; ++bj)
#pragma unroll
                        for (int n = 0; n < 2; ++n) *(f32x4*)(rowp + bj * 128 + 4 * n) = acc[ai][bj][m][n];
                }
        }
    }
};
struct EpiSig {
    static constexpr bool PERM = true, AFTER_DRAIN = false;
    bf16* SG;
    __device__ __forceinline__ void operator()(const f32x4 (&acc)[2][2][4][2], const pg8::Unit& u, int wr, int wc, int fr_in, int fq_in) const {
        const int ln_ = lane_fresh(); const int fr = ln_ & 15, fq = ln_ >> 4; (void)fr_in; (void)fq_in;
        const int row0 = u.pm * 256 + wr * 64 + fr, col0 = u.pn * 256 + wc * 32 + 8 * fq;
#pragma unroll
        for (int ai = 0; ai < 2; ++ai)
#pragma unroll
            for (int m = 0; m < 4; ++m) {
                bf16* rowp = SG + (size_t)(row0 + ai * 128 + m * 16) * D + col0;
#pragma unroll
                for (int bj = 0; bj < 2; ++bj) { const f32x4 v0 = acc[ai][bj][m][0], v1 = acc[ai][bj][m][1];
                    u32x4 w; w.x = pk2(sigmoidf_(v0[0]), sigmoidf_(v0[1])); w.y = pk2(sigmoidf_(v0[2]), sigmoidf_(v0[3]));
                    w.z = pk2(sigmoidf_(v1[0]), sigmoidf_(v1[1])); w.w = pk2(sigmoidf_(v1[2]), sigmoidf_(v1[3]));
                    *(u32x4*)(rowp + bj * 128) = w; }
            }
    }
};
struct EpiGate {
    static constexpr bool PERM = true, AFTER_DRAIN = false;
    const bf16* SG; float* YF; bf16* YB; int mode;
    __device__ __forceinline__ void operator()(const f32x4 (&acc)[2][2][4][2], const pg8::Unit& u, int wr, int wc, int fr_in, int fq_in) const {
        const int ln_ = lane_fresh(); const int fr = ln_ & 15, fq = ln_ >> 4; (void)fr_in; (void)fq_in;
        const int row0 = u.pm * 256 + wr * 64 + fr, col0 = u.pn * 256 + wc * 32 + 8 * fq;
#pragma unroll
        for (int ai = 0; ai < 2; ++ai)
#pragma unroll
            for (int m = 0; m < 4; ++m) {
                const size_t ro = (size_t)(row0 + ai * 128 + m * 16) * D + col0;
#pragma unroll
                for (int bj = 0; bj < 2; ++bj) {
                    const u32x4 sg = *(const u32x4*)(SG + ro + bj * 128);
                    f32x4 g0 = (f32x4){bflo(sg.x), bfhi(sg.x), bflo(sg.y), bfhi(sg.y)}, g1 = (f32x4){bflo(sg.z), bfhi(sg.z), bflo(sg.w), bfhi(sg.w)};
                    f32x4 v0 = g0 * acc[ai][bj][m][0], v1 = g1 * acc[ai][bj][m][1];
                    float* yp = YF + ro + bj * 128;
                    if (mode != 0) { v0 = v0 + *(const f32x4*)yp; v1 = v1 + *(const f32x4*)(yp + 4); }
                    if (mode != 2) { *(f32x4*)yp = v0; *(f32x4*)(yp + 4) = v1; }
                    else { u32x4 w; w.x = pk2(v0[0], v0[1]); w.y = pk2(v0[2], v0[3]); w.z = pk2(v1[0], v1[1]); w.w = pk2(v1[2], v1[3]); *(u32x4*)(YB + ro + bj * 128) = w; }
                }
            }
    }
};

template <class Epi>
__device__ __forceinline__ void run_gemm(LAS unsigned char* lds, const bf16* A, const bf16* Bt, int M, int N, int K, const Epi& E, int wv) {
    pg8::Gemm g{A, Bt, M, N, K}; pg8::StaticOrder S; S.init(M, N, (int)gridDim.x, (int)blockIdx.x);
    pg8::gemm_phase<Epi, pg8::StaticOrder, true, true>((PG8_LAS unsigned char*)lds, g, S, E, wv);
}

__device__ __forceinline__ void tr_item(const float* W, int K, int srcN, int c0, int nv, bf16* WT, int r0, int k0, LAS float* scr, int lane) {
    const int c = lane & 31;
#pragma unroll 8
    for (int i = 0; i < 32; ++i) { const int kk = 2 * i + (lane >> 5); scr[kk * 33 + c] = (c < nv) ? W[(size_t)(k0 + kk) * srcN + c0 + c] : 0.f; }
    LDS_WAIT();
    const int c8 = lane & 7;
#pragma unroll
    for (int j = 0; j < 4; ++j) { const int n = (lane >> 3) + 8 * j; const LAS float* s = scr + (8 * c8) * 33 + n;
        u32x4 o; o.x = pk2(s[0 * 33], s[1 * 33]); o.y = pk2(s[2 * 33], s[3 * 33]); o.z = pk2(s[4 * 33], s[5 * 33]); o.w = pk2(s[6 * 33], s[7 * 33]);
        if (n < nv) *(u32x4*)(WT + (size_t)(r0 + n) * K + k0 + 8 * c8) = o; }
    LDS_WAIT();
}
struct SegRun { int base, gw, ngw, lane; LAS float* scr; };
__device__ __forceinline__ void run_seg(SegRun& R, const float* W, int K, int srcN, int c0, int ncols, bf16* WT, int r0) {
    const int nblk = (ncols + 31) >> 5, nitems = (K >> 6) * nblk;
    int first = (R.gw - (R.base % R.ngw) + R.ngw) % R.ngw;
    for (int it = first; it < nitems; it += R.ngw) { const int kb = it / nblk, nb = it - kb * nblk; const int nv = min(32, ncols - nb * 32);
        tr_item(W, K, srcN, c0 + nb * 32, nv, WT, r0 + nb * 32, kb * 64, R.scr, R.lane); }
    R.base += nitems;
}
__device__ __forceinline__ void convert_weights(const Params& p, int l, SegRun& R) {
    unsigned char* wl = p.ws + WS_W + (size_t)l * WL_STRIDE;
    for (int f = 0; f < 2; ++f) {
        const float* gu = (f ? p.ffn2_gu : p.ffn1_gu) + (size_t)l * D * 2 * FF; bf16* gut = (bf16*)(wl + (f ? WL_GU2 : WL_GU1));
        for (int sg = 0; sg < 44; ++sg) run_seg(R, gu, D, 2 * FF, sg * 128, 128, gut, (sg % 22) * 256 + (sg / 22) * 128);
        const float* dn = (f ? p.ffn2_down : p.ffn1_down) + (size_t)l * FF * D; bf16* dnt = (bf16*)(wl + (f ? WL_D2 : WL_D1));
        run_seg(R, dn, FF, D, 0, D, dnt, 0);
    }
    const float* wi = p.w_in + (size_t)l * D * NIN; bf16* ina = (bf16*)(wl + WL_INA);
    run_seg(R, wi, D, NIN, 0, 768, ina, 0);
    run_seg(R, wi, D, NIN, 768, 512, ina, 768);
    run_seg(R, wi, D, NIN, 1280, 256, ina, 1280);
    run_seg(R, wi, D, NIN, 1544, 256, ina, 1536);
    run_seg(R, wi, D, NIN, 1800, 768, ina, 1792);
    run_seg(R, wi, D, NIN, 2568, 256, ina, 2560);
    run_seg(R, wi, D, NIN, 2952, 256, ina, 2816);
    run_seg(R, wi, D, NIN, 2824, 128, ina, 3072);
    run_seg(R, wi, D, NIN, 3208, 40, ina, 3200);
    run_seg(R, wi, D, NIN, 1536, 8, ina, 3240);
    run_seg(R, wi, D, NIN, 3248, 4096, (bf16*)(wl + WL_G), 0);
    for (int b = 0; b < 4; ++b) run_seg(R, p.w_branch + ((size_t)l * 4 + b) * 256 * D, 256, D, 0, D, (bf16*)(wl + WL_BR) + (size_t)b * D * 256, 0);
    run_seg(R, p.w_out + (size_t)l * D * D, D, D, 0, D, (bf16*)(wl + WL_OUT), 0);
    for (int i = R.gw * 64 + R.lane; i < 80 * 128; i += R.ngw * 64) *((u32x4*)(ina + (size_t)3248 * D) + i) = (u32x4){0u, 0u, 0u, 0u};
}

__device__ __forceinline__ void rms_rows(const float* X, const float* g, bf16* HN, int gw, int ngw, int lane) {
    f32x4 gv[4];
#pragma unroll
    for (int j = 0; j < 4; ++j) gv[j] = ((const f32x4*)g)[lane + 64 * j];
    for (int m = gw; m < T; m += ngw) {
        const f32x4* xr = (const f32x4*)(X + (size_t)m * D) + lane;
        f32x4 v[4]; float s = 0.f;
#pragma unroll
        for (int j = 0; j < 4; ++j) { v[j] = xr[64 * j]; s += (v[j].x * v[j].x + v[j].y * v[j].y) + (v[j].z * v[j].z + v[j].w * v[j].w); }
        const float r = 1.f / sqrtf(wave_sum(s) * (1.f / D) + EPS);
        unsigned long long* o8 = (unsigned long long*)(HN + (size_t)m * D) + lane;
#pragma unroll
        for (int j = 0; j < 4; ++j) { const f32x4 y = v[j] * r * gv[j]; o8[64 * j] = (unsigned long long)pk2(y.x, y.y) | ((unsigned long long)pk2(y.z, y.w) << 32); }
    }
}

__device__ __forceinline__ void sincos_red(float ang, float& sn, float& cs) {
    const float n = rintf(ang * 0.15915494309189535f);
    float r = fmaf(-n, 6.28125f, ang); r = fmaf(-n, 0.0019353071795864769f, r);
    sn = __sinf(r); cs = __cosf(r);
}
template <int HALF>
__device__ __forceinline__ void rope4(float (&v)[4], int sl, float pos) {
    constexpr int LH = HALF / 4;
    float pv[4];
#pragma unroll
    for (int j = 0; j < 4; ++j) pv[j] = __shfl_xor(v[j], LH);
    if (sl < 2 * LH) {
        const bool first = sl < LH; const int i0 = (sl & (LH - 1)) * 4;
#pragma unroll
        for (int j = 0; j < 4; ++j) {
            constexpr float I4[4] = {1.0f, 0.03760603070259094f, 0.0014142135623842478f, 5.318296098266728e-05f};
            constexpr float I8[8] = {1.0f, 0.1939227432012558f, 0.03760603070259094f, 0.007292664609849453f, 0.0014142135623842478f, 0.00027424818836152554f, 5.318296098266728e-05f, 1.0313386155758053e-05f};
            const float inv = (HALF == 4) ? I4[j] : (i0 ? I8[4 + j] : I8[j]);
            float sn, cs; sincos_red(pos * inv, sn, cs);
            v[j] = first ? (v[j] * cs - pv[j] * sn) : (pv[j] * sn + v[j] * cs);
        }
    }
}
__device__ __forceinline__ void prep_phase(const Params& p, int l, int gw, int ngw, int lane) {
    bf16* Z = (bf16*)(p.ws + WS_BIG); float* ZS = (float*)(p.ws + WS_ZS); bf16* IK = (bf16*)(p.ws + WS_IK);
    const float* dg = p.diff_qk_norm + l * 64; const float* sg = p.dsa_qk_norm + l * 128;
    for (int tok = gw; tok < T; tok += ngw) {
        const float pos = (float)p.pos[tok];
#pragma unroll
        for (int which = 0; which < 2; ++which) {
            unsigned long long* ptr = (unsigned long long*)(Z + (size_t)tok * ZP + which * 256) + lane;
            const unsigned long long w = *ptr; float v[4] = {bflo((unsigned)w), bfhi((unsigned)w), bflo((unsigned)(w >> 32)), bfhi((unsigned)(w >> 32))};
            float ss = (v[0] * v[0] + v[1] * v[1]) + (v[2] * v[2] + v[3] * v[3]);
            ss += __shfl_xor(ss, 1); ss += __shfl_xor(ss, 2); ss += __shfl_xor(ss, 4);
            const float r = 1.f / sqrtf(ss * (1.f / 32.f) + EPS);
            const f32x4 g = *(const f32x4*)(dg + which * 32 + (lane & 7) * 4);
#pragma unroll
            for (int j = 0; j < 4; ++j) v[j] = v[j] * r * g[j];
            rope4<4>(v, lane & 7, pos);
            if (which == 0) {
#pragma unroll
                for (int j = 0; j < 4; ++j) v[j] *= 0.17677669529663687f;
            }
            *ptr = (unsigned long long)pk2(v[0], v[1]) | ((unsigned long long)pk2(v[2], v[3]) << 32);
        }
        {
            unsigned long long* ptr = (unsigned long long*)(Z + (size_t)tok * ZP + 2560) + lane;
            const unsigned long long w = *ptr; float v[4] = {bflo((unsigned)w), bfhi((unsigned)w), bflo((unsigned)(w >> 32)), bfhi((unsigned)(w >> 32))};
            float ss = (v[0] * v[0] + v[1] * v[1]) + (v[2] * v[2] + v[3] * v[3]);
            ss += __shfl_xor(ss, 1); ss += __shfl_xor(ss, 2); ss += __shfl_xor(ss, 4); ss += __shfl_xor(ss, 8);
            const float r = 1.f / sqrtf(ss * (1.f / 64.f) + EPS);
            const f32x4 g = *(const f32x4*)(sg + (lane & 15) * 4);
#pragma unroll
            for (int j = 0; j < 4; ++j) v[j] = v[j] * r * g[j];
            rope4<8>(v, lane & 15, pos);
#pragma unroll
            for (int j = 0; j < 4; ++j) v[j] *= 0.125f;
            *ptr = (unsigned long long)pk2(v[0], v[1]) | ((unsigned long long)pk2(v[2], v[3]) << 32);
        }
        {
            unsigned long long* ptr = (unsigned long long*)(Z + (size_t)tok * ZP + 2816) + lane;
            const unsigned long long w = *ptr; float v[4] = {bflo((unsigned)w), bfhi((unsigned)w), bflo((unsigned)(w >> 32)), bfhi((unsigned)(w >> 32))};
            rope4<4>(v, lane & 7, pos);
            *ptr = (unsigned long long)pk2(v[0], v[1]) | ((unsigned long long)pk2(v[2], v[3]) << 32);
        }
        {
            float* ptr = ZS + (size_t)tok * ZSP + (lane & 15) * 4;
            const f32x4 x = *(const f32x4*)ptr; float v[4] = {x[0], x[1], x[2], x[3]};
            float ss = (v[0] * v[0] + v[1] * v[1]) + (v[2] * v[2] + v[3] * v[3]);
            ss += __shfl_xor(ss, 1); ss += __shfl_xor(ss, 2); ss += __shfl_xor(ss, 4); ss += __shfl_xor(ss, 8);
            const float r = 1.f / sqrtf(ss * (1.f / 64.f) + EPS);
            const f32x4 g = *(const f32x4*)(sg + 64 + (lane & 15) * 4);
#pragma unroll
            for (int j = 0; j < 4; ++j) v[j] = v[j] * r * g[j];
            rope4<8>(v, lane & 15, pos);
            if (lane < 16) *(f32x4*)ptr = (f32x4){v[0], v[1], v[2], v[3]};
        }
        {
            const float* ptr = ZS + (size_t)tok * ZSP + 128 + (lane & 7) * 4;
            const f32x4 x = *(const f32x4*)ptr; float v[4] = {x[0], x[1], x[2], x[3]};
            rope4<4>(v, lane & 7, pos);
            if (lane < 8) *((unsigned long long*)(IK + (size_t)tok * 32) + lane) = (unsigned long long)pk2(v[0], v[1]) | ((unsigned long long)pk2(v[2], v[3]) << 32);
        }
    }
}
__device__ __forceinline__ void mlstm_item(const Params& p, int l, int bh, LAS unsigned char* lds, int wv) {
    const int tid = tid_fresh(wv), lane = tid & 63, b = bh >> 2, h = bh & 3;
    const bf16* Z = (const bf16*)(p.ws + WS_BIG); const float* ZS = (const float*)(p.ws + WS_ZS); bf16* O1 = (bf16*)(p.ws + WS_O + OB_STRIDE);
    LAS float* nv = (LAS float*)lds; LAS float* bc = nv + 64; LAS float* igs = bc + 64; LAS float* wks = igs + 64; LAS float* sc = wks + 64;
    LAS float* Qs = sc + 64; LAS float* Ks = Qs + 64 * 65; LAS float* Vs = Ks + 64 * 65; LAS float* Ss = Vs + 64 * 65; LAS float* Cs = Ss + 64 * 65;
    for (int i = tid; i < 64 * 65; i += NTHR) Cs[i] = 0.f;
    if (tid < 64) nv[tid] = 0.f;
    float mcar = 0.f;
    const int r = tid >> 3, sg = tid & 7;
    const int cc0 = sg * 16; const int ch0 = (cc0 < 64) ? (h * 64 + cc0) : (256 + h * 64 + cc0 - 64);
    const float* cw0 = p.ml_conv_w + (size_t)l * 4 * 512; const float* cb0 = p.ml_conv_b + (size_t)l * 512;
    const int zc0 = (cc0 < 64) ? (768 + h * 64 + cc0) : (1024 + h * 64 + cc0 - 64);
    const float gb_i = p.ml_gate_bias[(l * 2 + 0) * 4 + h], gb_f = p.ml_gate_bias[(l * 2 + 1) * 4 + h];
    const float qsc = (cc0 < 64) ? 0.125f : 1.0f;
    __syncthreads();
    for (int c = 0; c < 64; ++c) {
        const int t0 = c * 64; const size_t tok0 = (size_t)b * SEQ + t0;
        const float* cw = cw0; const float* cb = cb0; asm volatile("" : "+s"(cw), "+s"(cb));
        {
            float y[16];
#pragma unroll
            for (int i = 0; i < 16; ++i) y[i] = cb[ch0 + i];
#pragma unroll
            for (int j = 0; j < 4; ++j) {
                const int tt = t0 + r - 3 + j;
                if (tt >= 0) {
                    const u32x4* xp = (const u32x4*)(Z + ((size_t)b * SEQ + tt) * ZP + zc0); const u32x4 x0 = xp[0], x1 = xp[1];
                    const float xv[16] = {bflo(x0.x), bfhi(x0.x), bflo(x0.y), bfhi(x0.y), bflo(x0.z), bfhi(x0.z), bflo(x0.w), bfhi(x0.w),
                                          bflo(x1.x), bfhi(x1.x), bflo(x1.y), bfhi(x1.y), bflo(x1.z), bfhi(x1.z), bflo(x1.w), bfhi(x1.w)};
#pragma unroll
                    for (int i = 0; i < 16; ++i) y[i] = fmaf(cw[j * 512 + ch0 + i], xv[i], y[i]);
                }
            }
            LAS float* dst = (cc0 < 64) ? (Qs + r * 65 + cc0) : (Ks + r * 65 + cc0 - 64);
#pragma unroll
            for (int i = 0; i < 16; ++i) dst[i] = y[i] * sigmoidf_(y[i]) * qsc;
            const u32x4 vv = *(const u32x4*)(Z + (tok0 + r) * ZP + 1280 + h * 64 + sg * 8);
            LAS float* vd = Vs + r * 65 + sg * 8;
            vd[0] = bflo(vv.x); vd[1] = bfhi(vv.x); vd[2] = bflo(vv.y); vd[3] = bfhi(vv.y); vd[4] = bflo(vv.z); vd[5] = bfhi(vv.z); vd[6] = bflo(vv.w); vd[7] = bfhi(vv.w);
        }
        if (tid < 64) {
            const float ig = ZS[(tok0 + tid) * ZSP + 168 + h] + gb_i;
            const float fz = ZS[(tok0 + tid) * ZSP + 172 + h] + gb_f;
            const float lf = fminf(fz, 0.f) - log1pf(__expf(-fabsf(fz)));
            float bsum = lf;
#pragma unroll
            for (int d = 1; d < 64; d <<= 1) { const float n = __shfl_up(bsum, d); if (lane >= d) bsum += n; }
            const float bl = __shfl(bsum, 63);
            const float g = bl - bsum + ig;
            const float mnew = fmaxf(bl + mcar, wave_max(g));
            bc[tid] = bsum; igs[tid] = ig; wks[tid] = __expf(g - mnew);
            if (tid == 0) { sc[0] = mnew; sc[1] = __expf(bl + mcar - mnew); sc[2] = bl; }
        }
        __syncthreads();
        const float bt = bc[r];
        float mx = -INFINITY;
#pragma unroll
        for (int i = 0; i < 8; ++i) { const int s = sg * 8 + i; const float dli = (s <= r) ? (bt - bc[s] + igs[s]) : -INFINITY; mx = fmaxf(mx, dli); }
        mx = fmaxf(mx, __shfl_xor(mx, 1)); mx = fmaxf(mx, __shfl_xor(mx, 2)); mx = fmaxf(mx, __shfl_xor(mx, 4));
        const float inter = bt + mcar; const float mt = fmaxf(inter, mx); const float iw = __expf(inter - mt);
        float ssum = 0.f;
#pragma unroll 1
        for (int i = 0; i < 8; ++i) { const int s = sg * 8 + i; float dot = 0.f;
#pragma unroll 16
            for (int d = 0; d < 64; ++d) dot = fmaf(Qs[r * 65 + d], Ks[s * 65 + d], dot);
            const float dli = (s <= r) ? (bt - bc[s] + igs[s]) : -INFINITY;
            const float sv = dot * __expf(dli - mt); Ss[r * 65 + s] = sv; ssum += sv; }
        ssum += __shfl_xor(ssum, 1); ssum += __shfl_xor(ssum, 2); ssum += __shfl_xor(ssum, 4);
        float qn = 0.f;
#pragma unroll
        for (int d = 0; d < 64; ++d) qn = fmaf(Qs[r * 65 + d], nv[d], qn);
        const float den = iw * qn + ssum;
        __syncthreads();
        {
            float num[8];
#pragma unroll
            for (int i = 0; i < 8; ++i) num[i] = 0.f;
#pragma unroll 8
            for (int d = 0; d < 64; ++d) { const float qd = Qs[r * 65 + d];
#pragma unroll
                for (int i = 0; i < 8; ++i) num[i] = fmaf(qd, Cs[d * 65 + sg * 8 + i], num[i]); }
#pragma unroll
            for (int i = 0; i < 8; ++i) num[i] *= iw;
#pragma unroll 8
            for (int s = 0; s < 64; ++s) { const float sv = Ss[r * 65 + s];
#pragma unroll
                for (int i = 0; i < 8; ++i) num[i] = fmaf(sv, Vs[s * 65 + sg * 8 + i], num[i]); }
            const float dn = 1.f / fmaxf(fabsf(den), __expf(-mt));
            float hs = 0.f;
#pragma unroll
            for (int i = 0; i < 8; ++i) { num[i] *= dn; hs = fmaf(num[i], num[i], hs); }
            hs += __shfl_xor(hs, 1); hs += __shfl_xor(hs, 2); hs += __shfl_xor(hs, 4);
            const float rr = 1.f / sqrtf(hs * (1.f / 64.f) + EPS);
            const u32x4 og = *(const u32x4*)(Z + (tok0 + r) * ZP + 1536 + h * 64 + sg * 8);
            const float ogv[8] = {bflo(og.x), bfhi(og.x), bflo(og.y), bfhi(og.y), bflo(og.z), bfhi(og.z), bflo(og.w), bfhi(og.w)};
            const float* hg = p.ml_head_norm + l * 64 + sg * 8;
            float o[8];
#pragma unroll
            for (int i = 0; i < 8; ++i) o[i] = sigmoidf_(ogv[i]) * (num[i] * rr * hg[i]);
            u32x4 w; w.x = pk2(o[0], o[1]); w.y = pk2(o[2], o[3]); w.z = pk2(o[4], o[5]); w.w = pk2(o[6], o[7]);
            *(u32x4*)(O1 + (tok0 + r) * 256 + h * 64 + sg * 8) = w;
        }
        __syncthreads();
        {
            const float decay = sc[1];
            float cacc[8]; float nacc = 0.f;
#pragma unroll
            for (int i = 0; i < 8; ++i) cacc[i] = 0.f;
#pragma unroll 8
            for (int s = 0; s < 64; ++s) { const float kw = wks[s] * Ks[s * 65 + r]; nacc += kw;
#pragma unroll
                for (int i = 0; i < 8; ++i) cacc[i] = fmaf(kw, Vs[s * 65 + sg * 8 + i], cacc[i]); }
#pragma unroll
            for (int i = 0; i < 8; ++i) Cs[r * 65 + sg * 8 + i] = decay * Cs[r * 65 + sg * 8 + i] + cacc[i];
            if (sg == 0) nv[r] = decay * nv[r] + nacc;
            mcar = sc[0];
        }
        __syncthreads();
    }
}

__device__ __forceinline__ void diff_item(const Params& p, int l, int bh, int qt, LAS unsigned char* lds, int wv) {
    const int tid = tid_fresh(wv), b = bh >> 2, h = bh & 3, q0 = qt * 128;
    const bf16* Z = (const bf16*)(p.ws + WS_BIG); bf16* O0 = (bf16*)(p.ws + WS_O);
    LAS float* Kt = (LAS float*)lds; LAS float* Vt = Kt + 64 * 64;
    const int ql = tid >> 2, part = tid & 3, c = part & 1, dvh = part >> 1, t = q0 + ql; const size_t tok = (size_t)b * SEQ + t;
    const float* lp = p.diff_lambda + l * 128; float s01 = 0.f, s23 = 0.f, gqm = 0.f, gkm = 0.f;
#pragma unroll 2
    for (int i = 0; i < 32; ++i) { s01 = fmaf(lp[i], lp[32 + i], s01); s23 = fmaf(lp[64 + i], lp[96 + i], s23);
        gqm = fmaxf(gqm, fabsf(p.diff_qk_norm[l * 64 + i])); gkm = fmaxf(gkm, fabsf(p.diff_qk_norm[l * 64 + 32 + i])); }
    const float lam_init = 0.8f - 0.6f * __expf(-0.3f * (float)l); const float lam = __expf(s01) - __expf(s23) + lam_init;
    const float coff = 5.65685424949238f * gqm * gkm;
    float q[32], o[32];
    { const u32x4* qp = (const u32x4*)(Z + tok * ZP + h * 64 + c * 32);
#pragma unroll
      for (int i = 0; i < 4; ++i) { const u32x4 w = qp[i]; q[8 * i] = bflo(w.x); q[8 * i + 1] = bfhi(w.x); q[8 * i + 2] = bflo(w.y); q[8 * i + 3] = bfhi(w.y); q[8 * i + 4] = bflo(w.z); q[8 * i + 5] = bfhi(w.z); q[8 * i + 6] = bflo(w.w); q[8 * i + 7] = bfhi(w.w); } }
#pragma unroll
    for (int i = 0; i < 32; ++i) o[i] = 0.f;
    float lsum = 0.f;
    const int nkt = (q0 + 128) / 64;
    const int lk = tid >> 3, lsg = tid & 7;
    for (int kt = 0; kt < nkt; ++kt) {
        __syncthreads();
        { const size_t ktok = (size_t)b * SEQ + kt * 64 + lk;
          const bf16* src = Z + ktok * ZP + ((lsg < 4) ? (256 + h * 64 + lsg * 16) : (512 + h * 64 + (lsg - 4) * 16));
          const u32x4 x0 = ((const u32x4*)src)[0], x1 = ((const u32x4*)src)[1];
          LAS float* dst = ((lsg < 4) ? (Kt + lk * 64 + lsg * 16) : (Vt + lk * 64 + (lsg - 4) * 16));
          *(LAS f32x4*)(dst) = (f32x4){bflo(x0.x), bfhi(x0.x), bflo(x0.y), bfhi(x0.y)}; *(LAS f32x4*)(dst + 4) = (f32x4){bflo(x0.z), bfhi(x0.z), bflo(x0.w), bfhi(x0.w)};
          *(LAS f32x4*)(dst + 8) = (f32x4){bflo(x1.x), bfhi(x1.x), bflo(x1.y), bfhi(x1.y)}; *(LAS f32x4*)(dst + 12) = (f32x4){bflo(x1.z), bfhi(x1.z), bflo(x1.w), bfhi(x1.w)}; }
        __syncthreads();
        const int kmax = t - kt * 64 + 1;
        for (int key = 0; key < 64; ++key) {
            const LAS f32x4* kr = (const LAS f32x4*)(Kt + key * 64 + c * 32);
            float s = 0.f;
#pragma unroll
            for (int i = 0; i < 8; ++i) { const f32x4 kv = kr[i]; s = fmaf(q[4 * i], kv[0], s); s = fmaf(q[4 * i + 1], kv[1], s); s = fmaf(q[4 * i + 2], kv[2], s); s = fmaf(q[4 * i + 3], kv[3], s); }
            const float pe = (key < kmax) ? __expf(s - coff) : 0.f;
            lsum += pe;
            const LAS f32x4* vr = (const LAS f32x4*)(Vt + key * 64 + dvh * 32);
#pragma unroll
            for (int i = 0; i < 8; ++i) { const f32x4 vv = vr[i]; o[4 * i] = fmaf(pe, vv[0], o[4 * i]); o[4 * i + 1] = fmaf(pe, vv[1], o[4 * i + 1]); o[4 * i + 2] = fmaf(pe, vv[2], o[4 * i + 2]); o[4 * i + 3] = fmaf(pe, vv[3], o[4 * i + 3]); }
        }
    }
    const float inv = 1.f / lsum; float ss = 0.f;
#pragma unroll
    for (int i = 0; i < 32; ++i) { const float my = o[i] * inv; const float ot = __shfl_xor(my, 1); o[i] = (c == 0) ? (my - lam * ot) : (ot - lam * my); ss = fmaf(o[i], o[i], ss); }
    ss += __shfl_xor(ss, 2);
    const float rr = (1.f - lam_init) / sqrtf(ss * (1.f / 64.f) + EPS);
    if (c == 0) {
        const float* hg = p.diff_head_norm + l * 64 + dvh * 32; u32x4* dst = (u32x4*)(O0 + tok * 256 + h * 64 + dvh * 32);
#pragma unroll
        for (int i = 0; i < 4; ++i) { u32x4 w; w.x = pk2(o[8 * i] * rr * hg[8 * i], o[8 * i + 1] * rr * hg[8 * i + 1]); w.y = pk2(o[8 * i + 2] * rr * hg[8 * i + 2], o[8 * i + 3] * rr * hg[8 * i + 3]);
            w.z = pk2(o[8 * i + 4] * rr * hg[8 * i + 4], o[8 * i + 5] * rr * hg[8 * i + 5]); w.w = pk2(o[8 * i + 6] * rr * hg[8 * i + 6], o[8 * i + 7] * rr * hg[8 * i + 7]); dst[i] = w; }
    }
    __syncthreads();
}

__device__ __forceinline__ unsigned pkbf(float lo, float hi) { unsigned r; asm("v_cvt_pk_bf16_f32 %0, %1, %2" : "=v"(r) : "v"(lo), "v"(hi)); return r; }
__device__ __forceinline__ void diffm_item(const Params& p, int l, int bh, int qb, LAS unsigned char* lds, int wv) {
    const int tid = tid_fresh(wv), lane = tid & 63, half = lane >> 5, r32 = lane & 31, b = bh >> 2, h = bh & 3;
    const bf16* Z = (const bf16*)(p.ws + WS_BIG); bf16* O0 = (bf16*)(p.ws + WS_O);
    LAS bf16* Ks = (LAS bf16*)lds; LAS bf16* Vt = Ks + 64 * 72;
    const float* lp = p.diff_lambda + l * 128; float s01 = 0.f, s23 = 0.f, gqm = 0.f, gkm = 0.f;
#pragma unroll 2
    for (int i = 0; i < 32; ++i) { s01 = fmaf(lp[i], lp[32 + i], s01); s23 = fmaf(lp[64 + i], lp[96 + i], s23);
        gqm = fmaxf(gqm, fabsf(p.diff_qk_norm[l * 64 + i])); gkm = fmaxf(gkm, fabsf(p.diff_qk_norm[l * 64 + 32 + i])); }
    const float lam_init = 0.8f - 0.6f * __expf(-0.3f * (float)l); const float lam = __expf(s01) - __expf(s23) + lam_init;
    const float coff = 5.65685424949238f * gqm * gkm;
    const int qw = qb * 256 + 32 * wv;
    const size_t tokb = (size_t)b * SEQ;
    s16x8 qf[2][2];
    { const bf16* qp = Z + (tokb + qw + r32) * ZP + h * 64 + half * 8;
#pragma unroll
      for (int c = 0; c < 2; ++c)
#pragma unroll
          for (int s = 0; s < 2; ++s) qf[c][s] = *(const s16x8*)(qp + c * 32 + 16 * s); }
    f32x16 oacc[2][2];
#pragma unroll
    for (int c = 0; c < 2; ++c)
#pragma unroll
        for (int db = 0; db < 2; ++db)
#pragma unroll
            for (int r = 0; r < 16; ++r) oacc[c][db][r] = 0.f;
    float ls0 = 0.f, ls1 = 0.f;
    const int nt = (qb + 1) * 4;
    const int kkey = tid >> 3, kch = tid & 7, vkey = tid & 63, vdc = tid >> 6;
    const bf16* kgp = Z + (tokb + kkey) * ZP + 256 + h * 64 + kch * 8;
    const bf16* vgp = Z + (tokb + vkey) * ZP + 512 + h * 64 + vdc * 8;
    u32x4 kreg = *(const u32x4*)kgp, vreg = *(const u32x4*)vgp;
#pragma unroll 1
    for (int t = 0; t < nt; ++t) {
        __syncthreads();
        *(LAS u32x4*)(Ks + kkey * 72 + kch * 8) = kreg;
        { LAS bf16* vd = Vt + (vdc * 8) * 72 + vkey;
          vd[0] = (bf16)(vreg.x & 0xffffu); vd[72] = (bf16)(vreg.x >> 16); vd[144] = (bf16)(vreg.y & 0xffffu); vd[216] = (bf16)(vreg.y >> 16);
          vd[288] = (bf16)(vreg.z & 0xffffu); vd[360] = (bf16)(vreg.z >> 16); vd[432] = (bf16)(vreg.w & 0xffffu); vd[504] = (bf16)(vreg.w >> 16); }
        __syncthreads();
        if (t + 1 < nt) { kreg = *(const u32x4*)(kgp + (size_t)(t + 1) * 64 * ZP); vreg = *(const u32x4*)(vgp + (size_t)(t + 1) * 64 * ZP); }
        const int k0 = t * 64;
#pragma unroll 1
        for (int sub = 0; sub < 2; ++sub) {
            const int kb = k0 + 32 * sub;
            if (kb <= qw + 31) {
                f32x16 s0, s1;
#pragma unroll
                for (int r = 0; r < 16; ++r) { s0[r] = 0.f; s1[r] = 0.f; }
                const LAS bf16* kr = Ks + (32 * sub + r32) * 72 + 8 * half;
#pragma unroll
                for (int s = 0; s < 2; ++s) {
                    const s16x8 a0 = *(const LAS s16x8*)(kr + 16 * s), a1 = *(const LAS s16x8*)(kr + 32 + 16 * s);
                    s0 = __builtin_amdgcn_mfma_f32_32x32x16_bf16(a0, qf[0][s], s0, 0, 0, 0);
                    s1 = __builtin_amdgcn_mfma_f32_32x32x16_bf16(a1, qf[1][s], s1, 0, 0, 0);
                }
                const bool diag = (kb + 31 > qw);
#pragma unroll
                for (int r = 0; r < 16; ++r) {
                    float p0 = __expf(s0[r] - coff), p1 = __expf(s1[r] - coff);
                    if (diag) { const int key = kb + 8 * (r >> 2) + 4 * half + (r & 3); if (key > qw + r32) { p0 = 0.f; p1 = 0.f; } }
                    ls0 += p0; ls1 += p1; s0[r] = p0; s1[r] = p1;
                }
#pragma unroll
                for (int s = 0; s < 2; ++s) {
                    u32x4 w0, w1;
                    w0.x = pkbf(s0[8 * s], s0[8 * s + 1]); w0.y = pkbf(s0[8 * s + 2], s0[8 * s + 3]); w0.z = pkbf(s0[8 * s + 4], s0[8 * s + 5]); w0.w = pkbf(s0[8 * s + 6], s0[8 * s + 7]);
                    w1.x = pkbf(s1[8 * s], s1[8 * s + 1]); w1.y = pkbf(s1[8 * s + 2], s1[8 * s + 3]); w1.z = pkbf(s1[8 * s + 4], s1[8 * s + 5]); w1.w = pkbf(s1[8 * s + 6], s1[8 * s + 7]);
                    const s16x8 pf0 = __builtin_bit_cast(s16x8, w0), pf1 = __builtin_bit_cast(s16x8, w1);
#pragma unroll
                    for (int db = 0; db < 2; ++db) {
                        const LAS bf16* vr = Vt + (db * 32 + r32) * 72 + 32 * sub + 16 * s + 4 * half;
                        const u32x2 v0 = *(const LAS u32x2*)vr, v1 = *(const LAS u32x2*)(vr + 8);
                        const u32x4 vv = (u32x4){v0.x, v0.y, v1.x, v1.y};
                        const s16x8 vf = __builtin_bit_cast(s16x8, vv);
                        oacc[0][db] = __builtin_amdgcn_mfma_f32_32x32x16_bf16(vf, pf0, oacc[0][db], 0, 0, 0);
                        oacc[1][db] = __builtin_amdgcn_mfma_f32_32x32x16_bf16(vf, pf1, oacc[1][db], 0, 0, 0);
                    }
                }
            }
        }
    }
    ls0 += __shfl_xor(ls0, 32); ls1 += __shfl_xor(ls1, 32);
    const float i0 = 1.f / ls0, i1 = lam / ls1;
    float ss = 0.f;
#pragma unroll
    for (int db = 0; db < 2; ++db)
#pragma unroll
        for (int r = 0; r < 16; ++r) { const float v = oacc[0][db][r] * i0 - oacc[1][db][r] * i1; oacc[0][db][r] = v; ss = fmaf(v, v, ss); }
    ss += __shfl_xor(ss, 32);
    const float rr = (1.f - lam_init) / sqrtf(ss * (1.f / 64.f) + EPS);
    const float* hg = p.diff_head_norm + l * 64;
    bf16* orow = O0 + (tokb + qw + r32) * 256 + h * 64;
#pragma unroll
    for (int db = 0; db < 2; ++db)
#pragma unroll
        for (int g = 0; g < 4; ++g) { const int d0 = db * 32 + 8 * g + 4 * half; const f32x4 gg = *(const f32x4*)(hg + d0);
            u32x2 w; w.x = pkbf(oacc[0][db][4 * g] * rr * gg[0], oacc[0][db][4 * g + 1] * rr * gg[1]); w.y = pkbf(oacc[0][db][4 * g + 2] * rr * gg[2], oacc[0][db][4 * g + 3] * rr * gg[3]);
            *(u32x2*)(orow + d0) = w; }
    __syncthreads();
}

__device__ __forceinline__ void sb_item(const Params& p, int bh, int g, LAS unsigned char* lds, int wv) {
    const int tid = tid_fresh(wv), lane = tid & 63, w = tid >> 6, b = bh >> 2, h = bh & 3;
    const bf16* Z = (const bf16*)(p.ws + WS_BIG); bf16* O2 = (bf16*)(p.ws + WS_O + 2 * OB_STRIDE);
    LAS float* KV = (LAS float*)lds + w * 4096;
    const int t0 = g * 512 + w * 64, t = t0 + lane; const size_t tok = (size_t)b * SEQ + t;
    float q[64], o[64];
    { const u32x4* qp = (const u32x4*)(Z + tok * ZP + 1792 + h * 64);
#pragma unroll
      for (int i = 0; i < 8; ++i) { const u32x4 x = qp[i]; q[8 * i] = bflo(x.x); q[8 * i + 1] = bfhi(x.x); q[8 * i + 2] = bflo(x.y); q[8 * i + 3] = bfhi(x.y); q[8 * i + 4] = bflo(x.z); q[8 * i + 5] = bfhi(x.z); q[8 * i + 6] = bflo(x.w); q[8 * i + 7] = bfhi(x.w); } }
#pragma unroll
    for (int i = 0; i < 64; ++i) o[i] = 0.f;
    float R = 0.f;
    const int lkey = lane >> 1, lhalf = lane & 1;
    for (int slo = t0 + 32; slo >= 0; slo -= 32) {
        asm volatile("s_waitcnt lgkmcnt(0)" ::: "memory");
        { const size_t ktok = (size_t)b * SEQ + slo + lkey;
          const u32x4* ks = (const u32x4*)(Z + ktok * ZP + 2048 + h * 64 + lhalf * 32); const u32x4* vs = (const u32x4*)(Z + ktok * ZP + 2304 + h * 64 + lhalf * 32);
          LAS float* kd = KV + lkey * 128 + lhalf * 32; LAS float* vd = kd + 64;
#pragma unroll
          for (int i = 0; i < 4; ++i) { const u32x4 x = ks[i]; *(LAS f32x4*)(kd + 8 * i) = (f32x4){bflo(x.x), bfhi(x.x), bflo(x.y), bfhi(x.y)}; *(LAS f32x4*)(kd + 8 * i + 4) = (f32x4){bflo(x.z), bfhi(x.z), bflo(x.w), bfhi(x.w)}; }
#pragma unroll
          for (int i = 0; i < 4; ++i) { const u32x4 x = vs[i]; *(LAS f32x4*)(vd + 8 * i) = (f32x4){bflo(x.x), bfhi(x.x), bflo(x.y), bfhi(x.y)}; *(LAS f32x4*)(vd + 8 * i + 4) = (f32x4){bflo(x.z), bfhi(x.z), bflo(x.w), bfhi(x.w)}; } }
        asm volatile("s_waitcnt lgkmcnt(0)" ::: "memory");
        for (int kk = 31; kk >= 0; --kk) {
            const int s = slo + kk; const bool act = s < t;
            const LAS f32x4* kr = (const LAS f32x4*)(KV + kk * 128);
            float z = 0.f;
#pragma unroll
            for (int i = 0; i < 16; ++i) { const f32x4 kv = kr[i]; z = fmaf(q[4 * i], kv[0], z); z = fmaf(q[4 * i + 1], kv[1], z); z = fmaf(q[4 * i + 2], kv[2], z); z = fmaf(q[4 * i + 3], kv[3], z); }
            z *= 0.125f;
            const float lb = fminf(z, 0.f) - __logf(1.f + __expf(-fabsf(z)));
            const float a = act ? __expf(lb + R) : 0.f;
            R += act ? (lb - z) : 0.f;
#pragma unroll
            for (int i = 0; i < 16; ++i) { const f32x4 vv = kr[16 + i]; o[4 * i] = fmaf(a, vv[0], o[4 * i]); o[4 * i + 1] = fmaf(a, vv[1], o[4 * i + 1]); o[4 * i + 2] = fmaf(a, vv[2], o[4 * i + 2]); o[4 * i + 3] = fmaf(a, vv[3], o[4 * i + 3]); }
        }
        if (__all(R < -104.f)) break;
    }
    u32x4* dst = (u32x4*)(O2 + tok * 256 + h * 64);
#pragma unroll
    for (int i = 0; i < 8; ++i) { u32x4 x; x.x = pk2(o[8 * i], o[8 * i + 1]); x.y = pk2(o[8 * i + 2], o[8 * i + 3]); x.z = pk2(o[8 * i + 4], o[8 * i + 5]); x.w = pk2(o[8 * i + 6], o[8 * i + 7]); dst[i] = x; }
    asm volatile("s_waitcnt lgkmcnt(0)" ::: "memory");
}
constexpr size_t WS_MLS = 460 * MiB, WS_DEC = WS_MLS + 5 * 32 * 4096 * 4, WS_UN = 463 * MiB, WS_NV = WS_UN + 512 * 1024, WS_UT = 464 * MiB, WS_CT = 496 * MiB, WS_END2 = 512 * MiB;
constexpr int MLN = 32 * 4096;
__device__ __forceinline__ void ml_prepass(const Params& p, int l, int bh, int lane) {
    const int b = bh >> 2, h = bh & 3; const float* ZS = (const float*)(p.ws + WS_ZS);
    float* MLS = (float*)(p.ws + WS_MLS); float* DEC = (float*)(p.ws + WS_DEC);
    const float gb_i = p.ml_gate_bias[(l * 2 + 0) * 4 + h], gb_f = p.ml_gate_bias[(l * 2 + 1) * 4 + h];
    float cA = 0.f, cB = 0.f;
#pragma unroll 1
    for (int c4 = 0; c4 < 16; ++c4) {
        float igv[4], fzv[4];
#pragma unroll
        for (int k = 0; k < 4; ++k) { const size_t tok = (size_t)b * SEQ + (c4 * 4 + k) * 64 + lane; igv[k] = ZS[tok * ZSP + 168 + h]; fzv[k] = ZS[tok * ZSP + 172 + h]; }
#pragma unroll
        for (int k = 0; k < 4; ++k) {
            const int c = c4 * 4 + k;
            const float ig = igv[k] + gb_i, fz = fzv[k] + gb_f;
            const float lf = fminf(fz, 0.f) - __logf(1.f + __expf(-fabsf(fz)));
            float bsum = lf;
#pragma unroll
            for (int d = 1; d < 64; d <<= 1) { const float n = __shfl_up(bsum, d); if (lane >= d) bsum += n; }
            const float bl = __shfl(bsum, 63);
            const float a = ig - bsum;
            float pm = a;
#pragma unroll
            for (int d = 1; d < 64; d <<= 1) { const float n = __shfl_up(pm, d); if (lane >= d) pm = fmaxf(pm, n); }
            const float gmax = bl + __shfl(pm, 63);
            const int ti = bh * 4096 + c * 64 + lane;
            MLS[ti] = bsum; MLS[MLN + ti] = a; MLS[2 * MLN + ti] = pm;
            cA = (lane == c) ? bl : cA; cB = (lane == c) ? gmax : cB;
        }
    }
    float sA = cA, sB = cB;
#pragma unroll
    for (int d = 1; d < 64; d <<= 1) { const float pA = __shfl_up(sA, d), pB = __shfl_up(sB, d); if (lane >= d) { sB = fmaxf(pB + sA, sB); sA = pA + sA; } }
    const float m_out = fmaxf(sA, sB);
    float m_in = __shfl_up(m_out, 1); if (lane == 0) m_in = 0.f;
    DEC[bh * 64 + lane] = __expf(cA + m_in - m_out);
    asm volatile("s_waitcnt vmcnt(0)" ::: "memory");
#pragma unroll 1
    for (int c4 = 0; c4 < 16; ++c4) {
        float bsv[4], av[4], pmv[4];
#pragma unroll
        for (int k = 0; k < 4; ++k) { const int ti = bh * 4096 + (c4 * 4 + k) * 64 + lane; bsv[k] = MLS[ti]; av[k] = MLS[MLN + ti]; pmv[k] = MLS[2 * MLN + ti]; }
#pragma unroll
        for (int k = 0; k < 4; ++k) {
            const int c = c4 * 4 + k;
            const float mi = __shfl(m_in, c), mo = __shfl(m_out, c), bl = __shfl(cA, c);
            const int ti = bh * 4096 + c * 64 + lane;
            const float mt = bsv[k] + fmaxf(mi, pmv[k]);
            MLS[2 * MLN + ti] = mt; MLS[3 * MLN + ti] = __expf(bl + av[k] - mo); MLS[4 * MLN + ti] = __expf(bsv[k] + mi - mt);
        }
    }
}
__device__ __forceinline__ void ml_conv8(const bf16* Z, const float* cw, const float* cb, int b, int t, int ch0, float (&y)[8]) {
    const f32x4 b0 = *(const f32x4*)(cb + ch0), b1 = *(const f32x4*)(cb + ch0 + 4);
    y[0] = b0[0]; y[1] = b0[1]; y[2] = b0[2]; y[3] = b0[3]; y[4] = b1[0]; y[5] = b1[1]; y[6] = b1[2]; y[7] = b1[3];
#pragma unroll
    for (int j = 0; j < 4; ++j) {
        const int tt = t - 3 + j;
        if (tt >= 0) {
            const u32x4 x = *(const u32x4*)(Z + ((size_t)b * SEQ + tt) * ZP + 768 + ch0);
            const f32x4 w0 = *(const f32x4*)(cw + j * 512 + ch0), w1 = *(const f32x4*)(cw + j * 512 + ch0 + 4);
            y[0] = fmaf(w0[0], bflo(x.x), y[0]); y[1] = fmaf(w0[1], bfhi(x.x), y[1]); y[2] = fmaf(w0[2], bflo(x.y), y[2]); y[3] = fmaf(w0[3], bfhi(x.y), y[3]);
            y[4] = fmaf(w1[0], bflo(x.z), y[4]); y[5] = fmaf(w1[1], bfhi(x.z), y[5]); y[6] = fmaf(w1[2], bflo(x.w), y[6]); y[7] = fmaf(w1[3], bfhi(x.w), y[7]);
        }
    }
#pragma unroll
    for (int i = 0; i < 8; ++i) y[i] = y[i] * sigmoidf_(y[i]);
}
__device__ __forceinline__ void mlB_item(const Params& p, int l, int bh, int ci, LAS unsigned char* lds, int wv) {
    const int tid = tid_fresh(wv), lane = tid & 63, half = lane >> 5, r32 = lane & 31, b = bh >> 2, h = bh & 3;
    const bf16* Z = (const bf16*)(p.ws + WS_BIG); const float* MLS = (const float*)(p.ws + WS_MLS);
    float* UT = (float*)(p.ws + WS_UT); float* UN = (float*)(p.ws + WS_UN);
    LAS bf16* KT = (LAS bf16*)lds; LAS bf16* VT = KT + 4 * 64 * 72;
    const float* cw = p.ml_conv_w + (size_t)l * 4 * 512; const float* cb = p.ml_conv_b + (size_t)l * 512;
    __syncthreads();
    {
        const int tt = tid >> 1, hr = tid & 1, cl = tt >> 6, s = tt & 63, t = (ci * 4) * 64 + tt;
        const float wk = MLS[3 * MLN + bh * 4096 + t];
#pragma unroll 1
        for (int q8 = 0; q8 < 4; ++q8) {
            const int d0 = hr * 32 + q8 * 8; float y[8];
            ml_conv8(Z, cw, cb, b, t, 256 + h * 64 + d0, y);
            LAS bf16* dst = KT + (cl * 64 + d0) * 72 + s;
#pragma unroll
            for (int i = 0; i < 8; ++i) dst[i * 72] = (bf16)f2bf(y[i] * wk);
            const u32x4 v = *(const u32x4*)(Z + ((size_t)b * SEQ + t) * ZP + 1280 + h * 64 + d0);
            LAS bf16* vd = VT + (cl * 64 + d0) * 72 + s;
            vd[0] = (bf16)(v.x & 0xffffu); vd[72] = (bf16)(v.x >> 16); vd[144] = (bf16)(v.y & 0xffffu); vd[216] = (bf16)(v.y >> 16);
            vd[288] = (bf16)(v.z & 0xffffu); vd[360] = (bf16)(v.z >> 16); vd[432] = (bf16)(v.w & 0xffffu); vd[504] = (bf16)(v.w >> 16);
        }
    }
    __syncthreads();
    const int cl = wv >> 1, dh = wv & 1, c = ci * 4 + cl;
    f32x16 acc[2];
#pragma unroll
    for (int eb = 0; eb < 2; ++eb)
#pragma unroll
        for (int r = 0; r < 16; ++r) acc[eb][r] = 0.f;
#pragma unroll
    for (int s4 = 0; s4 < 4; ++s4) {
        const s16x8 bk = *(const LAS s16x8*)(KT + (cl * 64 + dh * 32 + r32) * 72 + 16 * s4 + 8 * half);
#pragma unroll
        for (int eb = 0; eb < 2; ++eb) {
            const s16x8 av = *(const LAS s16x8*)(VT + (cl * 64 + eb * 32 + r32) * 72 + 16 * s4 + 8 * half);
            acc[eb] = __builtin_amdgcn_mfma_f32_32x32x16_bf16(av, bk, acc[eb], 0, 0, 0);
        }
    }
    float* ut = UT + ((size_t)(bh * 64 + c) * 64) * 64;
#pragma unroll
    for (int eb = 0; eb < 2; ++eb)
#pragma unroll
        for (int r = 0; r < 16; ++r) { const int e = eb * 32 + 8 * (r >> 2) + 4 * half + (r & 3); ut[e * 64 + dh * 32 + r32] = acc[eb][r]; }
    {
        const LAS bf16* kr = KT + (cl * 64 + dh * 32 + r32) * 72 + half * 32; float sm = 0.f;
#pragma unroll
        for (int i = 0; i < 4; ++i) { const u32x4 x = *(const LAS u32x4*)(kr + 8 * i); sm += (bflo(x.x) + bfhi(x.x)) + (bflo(x.y) + bfhi(x.y)) + (bflo(x.z) + bfhi(x.z)) + (bflo(x.w) + bfhi(x.w)); }
        sm += __shfl_xor(sm, 32);
        if (half == 0) UN[(bh * 64 + c) * 64 + dh * 32 + r32] = sm;
    }
}
__device__ __forceinline__ void mlS_item(const Params& p, int bh, int wv) {
    const int tid = tid_fresh(wv);
    const float* UT = (const float*)(p.ws + WS_UT) + (size_t)bh * 64 * 4096; const float* UN = (const float*)(p.ws + WS_UN) + bh * 4096;
    bf16* CT = (bf16*)(p.ws + WS_CT) + (size_t)bh * 64 * 4096; float* NV = (float*)(p.ws + WS_NV) + bh * 4096; const float* DEC = (const float*)(p.ws + WS_DEC) + bh * 64;
    f32x4 s0 = (f32x4){0.f, 0.f, 0.f, 0.f}, s1 = s0; float ns = 0.f;
#pragma unroll 4
    for (int c = 0; c < 64; ++c) {
        const float dec = DEC[c];
        const f32x4 u0 = *(const f32x4*)(UT + (size_t)c * 4096 + tid * 8), u1 = *(const f32x4*)(UT + (size_t)c * 4096 + tid * 8 + 4);
        u32x4 w; w.x = pk2(s0[0], s0[1]); w.y = pk2(s0[2], s0[3]); w.z = pk2(s1[0], s1[1]); w.w = pk2(s1[2], s1[3]);
        *(u32x4*)(CT + (size_t)c * 4096 + tid * 8) = w;
        s0 = s0 * dec + u0; s1 = s1 * dec + u1;
        if (tid < 64) { NV[c * 64 + tid] = ns; ns = ns * dec + UN[c * 64 + tid]; }
    }
}
__device__ __forceinline__ void mlD_item(const Params& p, int l, int bh, int ci, LAS unsigned char* lds, int wv) {
    const int tid = tid_fresh(wv), lane = tid & 63, half = lane >> 5, r32 = lane & 31, b = bh >> 2, h = bh & 3;
    const bf16* Z = (const bf16*)(p.ws + WS_BIG); const float* MLS = (const float*)(p.ws + WS_MLS); bf16* O1 = (bf16*)(p.ws + WS_O + OB_STRIDE);
    LAS bf16* Qs = (LAS bf16*)lds; LAS bf16* Ks = Qs + 4 * 64 * 72; LAS bf16* VT = Ks + 4 * 64 * 72;
    const float* cw = p.ml_conv_w + (size_t)l * 4 * 512; const float* cb = p.ml_conv_b + (size_t)l * 512;
    __syncthreads();
    {
        const int tt = tid >> 1, hr = tid & 1, cl = tt >> 6, s = tt & 63, t = (ci * 4) * 64 + tt;
#pragma unroll 1
        for (int q8 = 0; q8 < 4; ++q8) {
            const int d0 = hr * 32 + q8 * 8; float y[8];
            ml_conv8(Z, cw, cb, b, t, h * 64 + d0, y);
            u32x4 w; w.x = pk2(y[0] * 0.125f, y[1] * 0.125f); w.y = pk2(y[2] * 0.125f, y[3] * 0.125f); w.z = pk2(y[4] * 0.125f, y[5] * 0.125f); w.w = pk2(y[6] * 0.125f, y[7] * 0.125f);
            *(LAS u32x4*)(Qs + (cl * 64 + s) * 72 + d0) = w;
            ml_conv8(Z, cw, cb, b, t, 256 + h * 64 + d0, y);
            w.x = pk2(y[0], y[1]); w.y = pk2(y[2], y[3]); w.z = pk2(y[4], y[5]); w.w = pk2(y[6], y[7]);
            *(LAS u32x4*)(Ks + (cl * 64 + s) * 72 + d0) = w;
            const u32x4 v = *(const u32x4*)(Z + ((size_t)b * SEQ + t) * ZP + 1280 + h * 64 + d0);
            LAS bf16* vd = VT + (cl * 64 + d0) * 72 + s;
            vd[0] = (bf16)(v.x & 0xffffu); vd[72] = (bf16)(v.x >> 16); vd[144] = (bf16)(v.y & 0xffffu); vd[216] = (bf16)(v.y >> 16);
            vd[288] = (bf16)(v.z & 0xffffu); vd[360] = (bf16)(v.z >> 16); vd[432] = (bf16)(v.w & 0xffffu); vd[504] = (bf16)(v.w >> 16);
        }
    }
    __syncthreads();
    const int cl = wv >> 1, th = wv & 1, c = ci * 4 + cl, tloc = th * 32 + r32, tseq = c * 64 + tloc;
    const int ti = bh * 4096 + tseq;
    const float bs_t = MLS[ti], mt_t = MLS[2 * MLN + ti], iw_t = MLS[4 * MLN + ti];
    s16x8 qf[4];
#pragma unroll
    for (int s4 = 0; s4 < 4; ++s4) qf[s4] = *(const LAS s16x8*)(Qs + (cl * 64 + tloc) * 72 + 16 * s4 + 8 * half);
    f32x16 oacc[2];
#pragma unroll
    for (int eb = 0; eb < 2; ++eb)
#pragma unroll
        for (int r = 0; r < 16; ++r) oacc[eb][r] = 0.f;
    const bf16* CT = (const bf16*)(p.ws + WS_CT) + (size_t)(bh * 64 + c) * 4096;
#pragma unroll
    for (int s4 = 0; s4 < 4; ++s4)
#pragma unroll
        for (int eb = 0; eb < 2; ++eb) { const s16x8 ac = *(const s16x8*)(CT + (eb * 32 + r32) * 64 + 16 * s4 + 8 * half);
            oacc[eb] = __builtin_amdgcn_mfma_f32_32x32x16_bf16(ac, qf[s4], oacc[eb], 0, 0, 0); }
#pragma unroll
    for (int eb = 0; eb < 2; ++eb)
#pragma unroll
        for (int r = 0; r < 16; ++r) oacc[eb][r] *= iw_t;
    float qn = 0.f;
    { const float* nvp = (const float*)(p.ws + WS_NV) + (bh * 64 + c) * 64;
#pragma unroll
      for (int s4 = 0; s4 < 4; ++s4) { const f32x4 n0 = *(const f32x4*)(nvp + 16 * s4 + 8 * half), n1 = *(const f32x4*)(nvp + 16 * s4 + 8 * half + 4);
          const u32x4 qq = __builtin_bit_cast(u32x4, qf[s4]);
          qn += bflo(qq.x) * n0[0] + bfhi(qq.x) * n0[1] + bflo(qq.y) * n0[2] + bfhi(qq.y) * n0[3] + bflo(qq.z) * n1[0] + bfhi(qq.z) * n1[1] + bflo(qq.w) * n1[2] + bfhi(qq.w) * n1[3]; } }
    qn += __shfl_xor(qn, 32);
    float rs = 0.f;
#pragma unroll
    for (int sb = 0; sb < 2; ++sb) {
        if (sb <= th) {
            f32x16 sacc;
#pragma unroll
            for (int r = 0; r < 16; ++r) sacc[r] = 0.f;
#pragma unroll
            for (int s4 = 0; s4 < 4; ++s4) { const s16x8 ak = *(const LAS s16x8*)(Ks + (cl * 64 + sb * 32 + r32) * 72 + 16 * s4 + 8 * half);
                sacc = __builtin_amdgcn_mfma_f32_32x32x16_bf16(ak, qf[s4], sacc, 0, 0, 0); }
            const float* ap = MLS + MLN + bh * 4096 + c * 64 + sb * 32 + 4 * half;
#pragma unroll
            for (int g = 0; g < 4; ++g) { const f32x4 av = *(const f32x4*)(ap + 8 * g);
#pragma unroll
                for (int i = 0; i < 4; ++i) { const int s = sb * 32 + 8 * g + 4 * half + i; const float v = (s <= tloc) ? sacc[4 * g + i] * __expf(bs_t + av[i] - mt_t) : 0.f; sacc[4 * g + i] = v; rs += v; } }
#pragma unroll
            for (int s2 = 0; s2 < 2; ++s2) {
                u32x4 w; w.x = pkbf(sacc[8 * s2], sacc[8 * s2 + 1]); w.y = pkbf(sacc[8 * s2 + 2], sacc[8 * s2 + 3]); w.z = pkbf(sacc[8 * s2 + 4], sacc[8 * s2 + 5]); w.w = pkbf(sacc[8 * s2 + 6], sacc[8 * s2 + 7]);
                const s16x8 pf = __builtin_bit_cast(s16x8, w);
#pragma unroll
                for (int eb = 0; eb < 2; ++eb) {
                    const LAS bf16* vr = VT + (cl * 64 + eb * 32 + r32) * 72 + sb * 32 + 16 * s2 + 4 * half;
                    const u32x2 v0 = *(const LAS u32x2*)vr, v1 = *(const LAS u32x2*)(vr + 8);
                    const u32x4 vv = (u32x4){v0.x, v0.y, v1.x, v1.y};
                    oacc[eb] = __builtin_amdgcn_mfma_f32_32x32x16_bf16(__builtin_bit_cast(s16x8, vv), pf, oacc[eb], 0, 0, 0);
                }
            }
        }
    }
    rs += __shfl_xor(rs, 32);
    const float den = iw_t * qn + rs;
    const float dn = 1.f / fmaxf(fabsf(den), __expf(-mt_t));
    float ss = 0.f;
#pragma unroll
    for (int eb = 0; eb < 2; ++eb)
#pragma unroll
        for (int r = 0; r < 16; ++r) { const float v = oacc[eb][r] * dn; oacc[eb][r] = v; ss = fmaf(v, v, ss); }
    ss += __shfl_xor(ss, 32);
    const float rr = 1.f / sqrtf(ss * (1.f / 64.f) + EPS);
    const size_t tok = (size_t)b * SEQ + tseq;
    const float* hg = p.ml_head_norm + l * 64;
#pragma unroll
    for (int eb = 0; eb < 2; ++eb)
#pragma unroll
        for (int g = 0; g < 4; ++g) { const int e0 = eb * 32 + 8 * g + 4 * half; const f32x4 gg = *(const f32x4*)(hg + e0);
            const u32x2 og = *(const u32x2*)(Z + tok * ZP + 1536 + h * 64 + e0);
            u32x2 w; w.x = pkbf(sigmoidf_(bflo(og.x)) * oacc[eb][4 * g] * rr * gg[0], sigmoidf_(bfhi(og.x)) * oacc[eb][4 * g + 1] * rr * gg[1]);
            w.y = pkbf(sigmoidf_(bflo(og.y)) * oacc[eb][4 * g + 2] * rr * gg[2], sigmoidf_(bfhi(og.y)) * oacc[eb][4 * g + 3] * rr * gg[3]);
            *(u32x2*)(O1 + tok * 256 + h * 64 + e0) = w; }
}
__device__ __forceinline__ unsigned mono_bits(float s) { s = (s == 0.f) ? 0.f : s; const unsigned u = __float_as_uint(s); return (u & 0x80000000u) ? ~u : (u | 0x80000000u); }
__device__ __forceinline__ void dsa_item(const Params& p, int lds_l, int b, int qt, LAS unsigned char* lds, int wv) {
    const int tid = tid_fresh(wv), lane = tid & 63, w = wv, half = lane >> 5, r32 = lane & 31;
    const bf16* Z = (const bf16*)(p.ws + WS_BIG); const float* ZS = (const float*)(p.ws + WS_ZS); const bf16* IK = (const bf16*)(p.ws + WS_IK); bf16* O3 = (bf16*)(p.ws + WS_O + 3 * OB_STRIDE);
    LAS unsigned* hist = (LAS unsigned*)lds + w * 1024;
    LAS unsigned* maskw = (LAS unsigned*)(lds + 32768);
    LAS bf16* KC = (LAS bf16*)(lds + 49152);
    LAS bf16* Kd = (LAS bf16*)(lds + 81920); LAS bf16* VTd = Kd + 64 * 72;
    const size_t tokb = (size_t)b * SEQ; const int tb = qt * 32 + 4 * w;
    const int ntiles = qt + 1, nkeys = ntiles * 32, nchunks = (ntiles + 15) >> 4;
    s16x8 aq0, aq1;
    { const bf16* ap = Z + (tokb + tb + (r32 >> 3)) * ZP + 2816 + (r32 & 7) * 32 + half * 8; aq0 = *(const s16x8*)ap; aq1 = *(const s16x8*)(ap + 16); }
    float wq[4][4];
#pragma unroll
    for (int g = 0; g < 4; ++g) { const f32x4 x = *(const f32x4*)(ZS + (tokb + tb + g) * ZSP + 160 + 4 * half); wq[g][0] = x[0]; wq[g][1] = x[1]; wq[g][2] = x[2]; wq[g][3] = x[3]; }
    unsigned tau[4] = {0u, 0u, 0u, 0u}; int quota[4] = {1 << 30, 1 << 30, 1 << 30, 1 << 30};
    unsigned prefix[4] = {0u, 0u, 0u, 0u}; int krem[4] = {256, 256, 256, 256};
    int base[4] = {0, 0, 0, 0}, eqseen[4] = {0, 0, 0, 0};
    const unsigned lowmask = (1u << r32) - 1u;
#define DSA_SCORES(ktl, sc) do { const LAS bf16* kp_ = KC + ((ktl) * 32 + r32) * 32 + half * 8; \
        const s16x8 b0_ = *(const LAS s16x8*)kp_, b1_ = *(const LAS s16x8*)(kp_ + 16); f32x16 a_ = {0.f, 0.f, 0.f, 0.f, 0.f, 0.f, 0.f, 0.f, 0.f, 0.f, 0.f, 0.f, 0.f, 0.f, 0.f, 0.f}; \
        a_ = __builtin_amdgcn_mfma_f32_32x32x16_bf16(aq0, b0_, a_, 0, 0, 0); a_ = __builtin_amdgcn_mfma_f32_32x32x16_bf16(aq1, b1_, a_, 0, 0, 0); \
        _Pragma("unroll") for (int g_ = 0; g_ < 4; ++g_) { float pt_ = wq[g_][0] * fmaxf(a_[4 * g_], 0.f); pt_ = fmaf(wq[g_][1], fmaxf(a_[4 * g_ + 1], 0.f), pt_); \
            pt_ = fmaf(wq[g_][2], fmaxf(a_[4 * g_ + 2], 0.f), pt_); pt_ = fmaf(wq[g_][3], fmaxf(a_[4 * g_ + 3], 0.f), pt_); sc[g_] = pt_ + __shfl_xor(pt_, 32); } } while (0)
    const int pass0 = (qt >= 8) ? 0 : 4;
#pragma unroll 1
    for (int pass = pass0; pass < 5; ++pass) {
        const int shift = 24 - 8 * pass;
        if (pass < 4) {
#pragma unroll
            for (int i = 0; i < 4; ++i) *(LAS u32x4*)(hist + (i * 64 + lane) * 4) = (u32x4){0u, 0u, 0u, 0u};
        }
        const unsigned pfa = half ? prefix[2] : prefix[0], pfb = half ? prefix[3] : prefix[1];
        const int ta = tb + 2 * half, tbq = ta + 1;
        u32x4 pre[4];
#pragma unroll
        for (int i = 0; i < 4; ++i) { const int kb = (tid * 16 + i * 8192) >> 6; pre[i] = (kb < nkeys) ? *(const u32x4*)((const unsigned char*)(IK + tokb * 32) + tid * 16 + i * 8192) : (u32x4){0u, 0u, 0u, 0u}; }
#pragma unroll 1
        for (int ch = 0; ch < nchunks; ++ch) {
            __syncthreads();
#pragma unroll
            for (int i = 0; i < 4; ++i) *(LAS u32x4*)((LAS unsigned char*)KC + tid * 16 + i * 8192) = pre[i];
            __syncthreads();
            if (ch + 1 < nchunks) {
#pragma unroll
                for (int i = 0; i < 4; ++i) { const int kb = (ch + 1) * 512 + ((tid * 16 + i * 8192) >> 6);
                    pre[i] = (kb < nkeys) ? *(const u32x4*)((const unsigned char*)(IK + (tokb + (size_t)(ch + 1) * 512) * 32) + tid * 16 + i * 8192) : (u32x4){0u, 0u, 0u, 0u}; }
            }
            const int nt = min(16, ntiles - ch * 16);
            if (pass < 4) {
#pragma unroll 2
                for (int ktl = 0; ktl < nt; ++ktl) {
                    float sc[4]; DSA_SCORES(ktl, sc);
                    const int key = (ch * 16 + ktl) * 32 + r32;
                    const unsigned ma = mono_bits(half ? sc[2] : sc[0]), mb = mono_bits(half ? sc[3] : sc[1]);
                    const bool oka = (key <= ta) && (pass == 0 || (ma >> (shift + 8)) == pfa);
                    const bool okb = (key <= tbq) && (pass == 0 || (mb >> (shift + 8)) == pfb);
                    if (oka) __hip_atomic_fetch_add(hist + (2 * half) * 256 + ((ma >> shift) & 255u), 1u, __ATOMIC_RELAXED, __HIP_MEMORY_SCOPE_WORKGROUP);
                    if (okb) __hip_atomic_fetch_add(hist + (2 * half + 1) * 256 + ((mb >> shift) & 255u), 1u, __ATOMIC_RELAXED, __HIP_MEMORY_SCOPE_WORKGROUP);
                }
            } else {
#pragma unroll 1
                for (int ktl = 0; ktl < nt; ++ktl) {
                    float sc[4]; DSA_SCORES(ktl, sc);
                    const int key = (ch * 16 + ktl) * 32 + r32;
#pragma unroll
                    for (int g = 0; g < 4; ++g) {
                        const unsigned m = mono_bits(sc[g]); const bool valid = key <= tb + g;
                        const bool eq = valid && (m == tau[g]);
                        const unsigned beq = (unsigned)__ballot(eq);
                        const int rank = eqseen[g] + __popc(beq & lowmask);
                        const bool sel = valid && ((m > tau[g]) || (eq && rank < quota[g]));
                        const unsigned bsel = (unsigned)__ballot(sel);
                        if (lane == 0) maskw[(4 * w + g) * 128 + ch * 16 + ktl] = bsel;
                        base[g] += __popc(bsel); eqseen[g] += __popc(beq);
                    }
                }
            }
        }
        if (pass < 4) {
            LDS_WAIT();
#pragma unroll
            for (int g = 0; g < 4; ++g) {
                const u32x4 cv = *(const LAS u32x4*)(hist + g * 256 + lane * 4);
                const int c0 = (int)cv.x, c1 = (int)cv.y, c2 = (int)cv.z, c3 = (int)cv.w, tot = c0 + c1 + c2 + c3;
                int v = tot;
#pragma unroll
                for (int d = 1; d < 64; d <<= 1) { const int n = __shfl_down(v, d); if (lane + d < 64) v += n; }
                const int a3 = v - tot, a2 = a3 + c3, a1 = a2 + c2, a0 = a1 + c1; const int k = krem[g];
                int fb = -1, fa = 0;
                if (a3 < k && a3 + c3 >= k) { fb = 3; fa = a3; }
                else if (a2 < k && a2 + c2 >= k) { fb = 2; fa = a2; }
                else if (a1 < k && a1 + c1 >= k) { fb = 1; fa = a1; }
                else if (a0 < k && a0 + c0 >= k) { fb = 0; fa = a0; }
                const unsigned long long mk = __ballot(fb >= 0);
                const int src = (int)__builtin_ctzll(mk | (1ull << 63));
                const int bin = __shfl(4 * lane + fb, src), above = __shfl(fa, src);
                prefix[g] = (prefix[g] << 8) | (unsigned)bin; krem[g] = k - above;
            }
            if (pass == 3) {
#pragma unroll
                for (int g = 0; g < 4; ++g) { tau[g] = prefix[g]; quota[g] = krem[g]; }
            }
        }
    }
    (void)base;
    __syncthreads();
    {
        const float* sgn = p.dsa_qk_norm + lds_l * 128; float gqm = 0.f, gkm = 0.f;
#pragma unroll 2
        for (int i = 0; i < 64; ++i) { gqm = fmaxf(gqm, fabsf(sgn[i])); gkm = fmaxf(gkm, fabsf(sgn[64 + i])); }
        const float coff = 8.f * gqm * gkm;
        const int cb = w & 3, ksp = w >> 2, ql = 8 * cb + (r32 >> 2), hh = r32 & 3;
        s16x8 qf[4];
        { const bf16* qp = Z + (tokb + qt * 32 + ql) * ZP + 2560 + hh * 64 + 8 * half;
#pragma unroll
          for (int s4 = 0; s4 < 4; ++s4) qf[s4] = *(const s16x8*)(qp + 16 * s4); }
        f32x16 oacc[2];
#pragma unroll
        for (int db = 0; db < 2; ++db)
#pragma unroll
            for (int r = 0; r < 16; ++r) oacc[db][r] = 0.f;
        float lsum = 0.f;
        const int nT = (ntiles + 1) >> 1;
        const int skey = tid >> 3, sseg = tid & 7;
        const float* sgp = ZS + (tokb + skey) * ZSP + sseg * 16;
        f32x4 pr[4];
#pragma unroll
        for (int i = 0; i < 4; ++i) pr[i] = *(const f32x4*)(sgp + 4 * i);
#pragma unroll 1
        for (int tT = 0; tT < nT; ++tT) {
            __syncthreads();
            if (sseg < 4) {
                u32x4 w0, w1; w0.x = pkbf(pr[0][0], pr[0][1]); w0.y = pkbf(pr[0][2], pr[0][3]); w0.z = pkbf(pr[1][0], pr[1][1]); w0.w = pkbf(pr[1][2], pr[1][3]);
                w1.x = pkbf(pr[2][0], pr[2][1]); w1.y = pkbf(pr[2][2], pr[2][3]); w1.z = pkbf(pr[3][0], pr[3][1]); w1.w = pkbf(pr[3][2], pr[3][3]);
                *(LAS u32x4*)(Kd + skey * 72 + sseg * 16) = w0; *(LAS u32x4*)(Kd + skey * 72 + sseg * 16 + 8) = w1;
            } else {
                LAS bf16* vd = VTd + ((sseg - 4) * 16) * 72 + skey;
#pragma unroll
                for (int i = 0; i < 4; ++i) { const unsigned a0 = pkbf(pr[i][0], pr[i][1]), a1 = pkbf(pr[i][2], pr[i][3]);
                    vd[(4 * i) * 72] = (bf16)(a0 & 0xffffu); vd[(4 * i + 1) * 72] = (bf16)(a0 >> 16); vd[(4 * i + 2) * 72] = (bf16)(a1 & 0xffffu); vd[(4 * i + 3) * 72] = (bf16)(a1 >> 16); }
            }
            __syncthreads();
            if (tT + 1 < nT) {
#pragma unroll
                for (int i = 0; i < 4; ++i) pr[i] = *(const f32x4*)(sgp + (size_t)(tT + 1) * 64 * ZSP + 4 * i);
            }
            const int st = 2 * tT + ksp;
            if (st < ntiles) {
                const unsigned mw = maskw[ql * 128 + st];
                f32x16 sacc;
#pragma unroll
                for (int r = 0; r < 16; ++r) sacc[r] = 0.f;
#pragma unroll
                for (int s4 = 0; s4 < 4; ++s4) { const s16x8 ak = *(const LAS s16x8*)(Kd + (32 * ksp + r32) * 72 + 16 * s4 + 8 * half);
                    sacc = __builtin_amdgcn_mfma_f32_32x32x16_bf16(ak, qf[s4], sacc, 0, 0, 0); }
#pragma unroll
                for (int r = 0; r < 16; ++r) { const int kbit = 8 * (r >> 2) + 4 * half + (r & 3); const float pe = ((mw >> kbit) & 1u) ? __expf(sacc[r] - coff) : 0.f; sacc[r] = pe; lsum += pe; }
#pragma unroll
                for (int s2 = 0; s2 < 2; ++s2) {
                    u32x4 wp; wp.x = pkbf(sacc[8 * s2], sacc[8 * s2 + 1]); wp.y = pkbf(sacc[8 * s2 + 2], sacc[8 * s2 + 3]); wp.z = pkbf(sacc[8 * s2 + 4], sacc[8 * s2 + 5]); wp.w = pkbf(sacc[8 * s2 + 6], sacc[8 * s2 + 7]);
                    const s16x8 pf = __builtin_bit_cast(s16x8, wp);
#pragma unroll
                    for (int db = 0; db < 2; ++db) {
                        const LAS bf16* vr = VTd + (db * 32 + r32) * 72 + 32 * ksp + 16 * s2 + 4 * half;
                        const u32x2 v0 = *(const LAS u32x2*)vr, v1 = *(const LAS u32x2*)(vr + 8);
                        const u32x4 vv = (u32x4){v0.x, v0.y, v1.x, v1.y};
                        oacc[db] = __builtin_amdgcn_mfma_f32_32x32x16_bf16(__builtin_bit_cast(s16x8, vv), pf, oacc[db], 0, 0, 0);
                    }
                }
            }
        }
        lsum += __shfl_xor(lsum, 32);
        __syncthreads();
        LAS float* xch = (LAS float*)lds + (w & 3) * (33 * 64);
        if (ksp == 1) {
#pragma unroll
            for (int db = 0; db < 2; ++db)
#pragma unroll
                for (int r = 0; r < 16; ++r) xch[(db * 16 + r) * 64 + lane] = oacc[db][r];
            xch[32 * 64 + lane] = lsum;
        }
        __syncthreads();
        if (ksp == 0) {
            const float is = 1.f / (lsum + xch[32 * 64 + lane]);
            bf16* orow = O3 + (tokb + qt * 32 + ql) * 256 + hh * 64;
#pragma unroll
            for (int db = 0; db < 2; ++db)
#pragma unroll
                for (int g = 0; g < 4; ++g) { const int d0 = db * 32 + 8 * g + 4 * half;
                    const float x0 = (oacc[db][4 * g] + xch[(db * 16 + 4 * g) * 64 + lane]) * is, x1 = (oacc[db][4 * g + 1] + xch[(db * 16 + 4 * g + 1) * 64 + lane]) * is;
                    const float x2 = (oacc[db][4 * g + 2] + xch[(db * 16 + 4 * g + 2) * 64 + lane]) * is, x3 = (oacc[db][4 * g + 3] + xch[(db * 16 + 4 * g + 3) * 64 + lane]) * is;
                    u32x2 wo; wo.x = pkbf(x0, x1); wo.y = pkbf(x2, x3); *(u32x2*)(orow + d0) = wo; }
        }
    }
#undef DSA_SCORES
    __syncthreads();
}

constexpr int Q_ML = 32, Q_DIFF = 512, Q_DSA = 1024, Q_SB = 256, Q_TOTAL = Q_ML + Q_DIFF + Q_DSA + Q_SB;
__device__ __forceinline__ Params load_params() {
#if defined(__HIP_DEVICE_COMPILE__)
    const __attribute__((address_space(4))) Params* pp = (const __attribute__((address_space(4))) Params*)__builtin_amdgcn_kernarg_segment_ptr();
    asm volatile("" : "+s"(pp));
    Params r;
    r.x = pp->x; r.pos = pp->pos; r.ffn1_norm = pp->ffn1_norm; r.ffn1_gu = pp->ffn1_gu; r.ffn1_down = pp->ffn1_down; r.mix_norm = pp->mix_norm; r.w_in = pp->w_in; r.diff_qk_norm = pp->diff_qk_norm;
    r.diff_lambda = pp->diff_lambda; r.diff_head_norm = pp->diff_head_norm; r.ml_conv_w = pp->ml_conv_w; r.ml_conv_b = pp->ml_conv_b; r.ml_gate_bias = pp->ml_gate_bias; r.ml_head_norm = pp->ml_head_norm;
    r.dsa_qk_norm = pp->dsa_qk_norm; r.w_branch = pp->w_branch; r.w_out = pp->w_out; r.ffn2_norm = pp->ffn2_norm; r.ffn2_gu = pp->ffn2_gu; r.ffn2_down = pp->ffn2_down; r.out = pp->out; r.ws = pp->ws;
    return r;
#else
    return Params{};
#endif
}
__device__ __forceinline__ int next_item(unsigned* ctr, LAS int* slot, int wv) {
    __syncthreads();
    if (tid_fresh(wv) == 0) *slot = (int)atomicAdd(ctr, 1u);
    __syncthreads();
    return *slot;
}
__device__ __forceinline__ void mixer_phase1(int l, LAS unsigned char* lds, int wv, int co = 0) {
    LAS int* slot = (LAS int*)(lds + LDS_BYTES - 64);
    { const Params p = load_params(); unsigned* ctr = (unsigned*)(p.ws + WS_CTL) + 64 * (4 * l + 0 + co);
      for (;;) { const int it = next_item(ctr, slot, wv); if (it >= Q_DIFF) break; diffm_item(p, l, it & 31, 15 - (it >> 5), lds, wv); } }
    { const Params p = load_params(); unsigned* ctr = (unsigned*)(p.ws + WS_CTL) + 64 * (4 * l + 1 + co);
      for (;;) { const int it = next_item(ctr, slot, wv); if (it >= 512) break; mlB_item(p, l, it & 31, it >> 5, lds, wv); } }
}
__device__ __forceinline__ void mixer_phase2(int l, LAS unsigned char* lds, int wv, int co = 0) {
    LAS int* slot = (LAS int*)(lds + LDS_BYTES - 64);
    { const Params p = load_params(); unsigned* ctr = (unsigned*)(p.ws + WS_CTL) + 64 * (4 * l + 2 + co);
      for (;;) { const int it = next_item(ctr, slot, wv); if (it >= 32 + Q_DSA) break;
          if (it < 32) mlS_item(p, it, wv); else { const int i = it - 32; dsa_item(p, l, i & 7, 127 - (i >> 3), lds, wv); } } }
}
__device__ __forceinline__ void mixer_phase3(int l, LAS unsigned char* lds, int wv, int co = 0) {
    LAS int* slot = (LAS int*)(lds + LDS_BYTES - 64);
    { const Params p = load_params(); unsigned* ctr = (unsigned*)(p.ws + WS_CTL) + 64 * (4 * l + 3 + co);
      for (;;) { const int it = next_item(ctr, slot, wv); if (it >= 512) break; mlD_item(p, l, it & 31, it >> 5, lds, wv); } }
    { const Params p = load_params(); unsigned* ctr = (unsigned*)(p.ws + WS_CTL) + 64 * (8 + l + co);
      for (;;) { const int it = next_item(ctr, slot, wv); if (it >= Q_SB) break; sb_item(p, it >> 3, it & 7, lds, wv); } }
}

#define XB_TMO      128
#define XB_XCNT(j)  (256  + 64 * (j))
#define XB_XSUB(j)  (1280 + 64 * (j))
#define XB_XGEN(j)  (2304 + 64 * (j))
#define XB_TOP      3328
#define XB_TOPGEN   3392
#define XCD_BAR_WORDS 3456
#define XB_SPIN_CAP (1u << 20)
constexpr int CW_BAR = 8192;
__device__ __forceinline__ unsigned xb_ld(unsigned* p)              { return __hip_atomic_load(p, __ATOMIC_RELAXED, __HIP_MEMORY_SCOPE_AGENT); }
__device__ __forceinline__ unsigned xb_add(unsigned* p, unsigned v) { return __hip_atomic_fetch_add(p, v, __ATOMIC_RELAXED, __HIP_MEMORY_SCOPE_AGENT); }
__device__ __forceinline__ unsigned xb_xcc_id() { return (unsigned)__builtin_amdgcn_s_getreg((3 << 11) | 20) & 0xFu; }
#define XB_SPIN(cond, bar) do { unsigned _sp = 0; while (cond) { __builtin_amdgcn_s_sleep(1); \
    if ((++_sp & 255u) == 0u) { if (xb_ld(&(bar)[XB_TMO])) break; if (_sp > XB_SPIN_CAP) { atomicAdd(&(bar)[XB_TMO], 1u); break; } } } } while (0)
__device__ __forceinline__ void xcd_post(int wv) {
    const Params p = load_params(); unsigned* bar = (unsigned*)(p.ws + WS_CTL) + CW_BAR;
    if (tid_fresh(wv) == 0) (void)xb_add(&bar[XB_XCNT(xb_xcc_id())], 1u);
}
__device__ __forceinline__ void xcd_barrier_complete(unsigned* bar, unsigned x, unsigned& nloc, unsigned& nx) {
    const unsigned G = gridDim.x * gridDim.y * gridDim.z;
    unsigned sum, cnt, mine, sp = 0u;
    for (;;) {
        sum = 0u; cnt = 0u; mine = 0u;
#pragma unroll
        for (unsigned j = 0; j < 16; ++j) { const unsigned c = xb_ld(&bar[XB_XCNT(j)]); sum += c; cnt += (c > 0u) ? 1u : 0u; mine = (j == x) ? c : mine; }
        if (sum == G) break;
        __builtin_amdgcn_s_sleep(1);
        if ((++sp & 255u) == 0u) { if (xb_ld(&bar[XB_TMO])) break; if (sp > XB_SPIN_CAP) { atomicAdd(&bar[XB_TMO], 1u); break; } }
    }
    nloc = mine > 0u ? mine : 1u; nx = cnt > 0u ? cnt : 1u;
}
__device__ __forceinline__ void gsync(LAS unsigned char* lds, int wv) {
    asm volatile("s_waitcnt vmcnt(0)" ::: "memory");
    __syncthreads();
    if (tid_fresh(wv) == 0) {
        const Params p = load_params(); unsigned* bar = (unsigned*)(p.ws + WS_CTL) + CW_BAR;
        volatile LAS unsigned* st = (volatile LAS unsigned*)(lds + LDS_BYTES - 32);
        const unsigned x = xb_xcc_id();
        __builtin_amdgcn_s_waitcnt(0);
        unsigned nloc = st[0], nx = st[1];
        if (nloc == 0u) { xcd_barrier_complete(bar, x, nloc, nx); st[0] = nloc; st[1] = nx; }
        const unsigned old = xb_add(&bar[XB_XSUB(x)], 1u);
        const unsigned gen = old / nloc;
        if (old + 1u == (gen + 1u) * nloc) {
            __builtin_amdgcn_fence(__ATOMIC_RELEASE, "agent");
            asm volatile("s_waitcnt vmcnt(0)" ::: "memory");
            const unsigned og = xb_add(&bar[XB_TOP], 1u);
            const unsigned tg = og / nx;
            if (og + 1u == (tg + 1u) * nx) xb_add(&bar[XB_TOPGEN], 1u);
            else XB_SPIN(xb_ld(&bar[XB_TOPGEN]) == tg, bar);
            __builtin_amdgcn_fence(__ATOMIC_ACQUIRE, "agent");
            xb_add(&bar[XB_XGEN(x)], 1u);
            asm volatile("s_waitcnt vmcnt(0)" ::: "memory");
        } else {
            XB_SPIN(xb_ld(&bar[XB_XGEN(x)]) == gen, bar);
            __builtin_amdgcn_fence(__ATOMIC_ACQUIRE, "agent");
            asm volatile("s_waitcnt vmcnt(0)" ::: "memory");
        }
    }
    __syncthreads();
}

#define PH_LOCALS const Params p = load_params(); const int tid = tid_fresh(wv), lane = tid & 63, wave = tid >> 6; const int gw = (int)blockIdx.x * NWAVES + wave, ngw = (int)gridDim.x * NWAVES; \
    (void)lane; (void)gw; (void)ngw; bf16* HN = (bf16*)(p.ws + WS_HN); bf16* BIGB = (bf16*)(p.ws + WS_BIG); (void)HN; (void)BIGB;
template <int l> __device__ __forceinline__ void layer_body(cg::grid_group& grid, LAS unsigned char* lds, const int wv) {
        { PH_LOCALS const unsigned char* wl = p.ws + WS_W + (size_t)l * WL_STRIDE; EpiSwiglu E{BIGB}; run_gemm(lds, HN, (const bf16*)(wl + WL_GU1), T, 2 * FF, D, E, wv); }
        gsync(lds, wv);
#if PROBE_DUP & 8
        { PH_LOCALS const unsigned char* wl = p.ws + WS_W + (size_t)l * WL_STRIDE; EpiSwiglu E{BIGB}; run_gemm(lds, HN, (const bf16*)(wl + WL_GU1), T, 2 * FF, D, E, wv); }
        gsync(lds, wv);
#endif
        { PH_LOCALS const unsigned char* wl = p.ws + WS_W + (size_t)l * WL_STRIDE; EpiResid E{l == 0 ? p.x : p.out, p.out, 0.5f}; run_gemm(lds, BIGB, (const bf16*)(wl + WL_D1), T, D, FF, E, wv); }
        gsync(lds, wv);
        { PH_LOCALS rms_rows(p.out, p.mix_norm + l * D, HN, gw, ngw, lane); }
        gsync(lds, wv);
        { PH_LOCALS const unsigned char* wl = p.ws + WS_W + (size_t)l * WL_STRIDE; EpiZ E{BIGB, (float*)(p.ws + WS_ZS)}; run_gemm(lds, HN, (const bf16*)(wl + WL_INA), T, 3328, D, E, wv); }
        gsync(lds, wv);
        { PH_LOCALS if (gw < 32) ml_prepass(p, l, gw, lane); prep_phase(p, l, gw, ngw, lane); }
        gsync(lds, wv);
        mixer_phase1(l, lds, wv);
#if PROBE_DUP & 1
        gsync(lds, wv); mixer_phase1(l, lds, wv, 16);
#endif
        gsync(lds, wv);
        mixer_phase2(l, lds, wv);
#if PROBE_DUP & 2
        gsync(lds, wv); mixer_phase2(l, lds, wv, 16);
#endif
        gsync(lds, wv);
        mixer_phase3(l, lds, wv);
#if PROBE_DUP & 4
        gsync(lds, wv); mixer_phase3(l, lds, wv, 16);
#endif
        gsync(lds, wv);
#pragma unroll 1
        for (int b = 0; b < 4; ++b) {
            { PH_LOCALS const unsigned char* wl = p.ws + WS_W + (size_t)l * WL_STRIDE; EpiSig E{BIGB}; run_gemm(lds, HN, (const bf16*)(wl + WL_G) + (size_t)b * D * D, T, D, D, E, wv); }
            gsync(lds, wv);
            { PH_LOCALS const unsigned char* wl = p.ws + WS_W + (size_t)l * WL_STRIDE; EpiGate E{BIGB, (float*)(p.ws + WS_BIG + 64 * MiB), HN, b == 0 ? 0 : (b == 3 ? 2 : 1)};
              run_gemm(lds, (const bf16*)(p.ws + WS_O + b * OB_STRIDE), (const bf16*)(wl + WL_BR) + (size_t)b * D * 256, T, D, 256, E, wv); }
            gsync(lds, wv);
        }
        { PH_LOCALS const unsigned char* wl = p.ws + WS_W + (size_t)l * WL_STRIDE; EpiResid E{p.out, p.out, 1.0f}; run_gemm(lds, HN, (const bf16*)(wl + WL_OUT), T, D, D, E, wv); }
        gsync(lds, wv);
        { PH_LOCALS rms_rows(p.out, p.ffn2_norm + l * D, HN, gw, ngw, lane); }
        gsync(lds, wv);
        { PH_LOCALS const unsigned char* wl = p.ws + WS_W + (size_t)l * WL_STRIDE; EpiSwiglu E{BIGB}; run_gemm(lds, HN, (const bf16*)(wl + WL_GU2), T, 2 * FF, D, E, wv); }
        gsync(lds, wv);
#if PROBE_DUP & 8
        { PH_LOCALS const unsigned char* wl = p.ws + WS_W + (size_t)l * WL_STRIDE; EpiSwiglu E{BIGB}; run_gemm(lds, HN, (const bf16*)(wl + WL_GU2), T, 2 * FF, D, E, wv); }
        gsync(lds, wv);
#endif
        { PH_LOCALS const unsigned char* wl = p.ws + WS_W + (size_t)l * WL_STRIDE; EpiResid E{p.out, p.out, 0.5f}; run_gemm(lds, BIGB, (const bf16*)(wl + WL_D2), T, D, FF, E, wv); }
        if (l + 1 < DEPTH) {
            gsync(lds, wv);
            { PH_LOCALS rms_rows(p.out, p.ffn1_norm + (l + 1) * D, HN, gw, ngw, lane); }
            gsync(lds, wv);
        }
    }

__global__ void __launch_bounds__(NTHR, 2) hybrid_fwd(Params p_unused) {
    extern __shared__ __attribute__((aligned(16))) unsigned char lds_raw[];
    LAS unsigned char* lds = (LAS unsigned char*)lds_raw;
    cg::grid_group grid = cg::this_grid();
    const int wv = __builtin_amdgcn_readfirstlane((int)threadIdx.x >> 6);
    {
        PH_LOCALS
        SegRun R; R.base = 0; R.gw = gw; R.ngw = ngw; R.lane = lane; R.scr = (LAS float*)(lds + wave * 8704);
        for (int l = 0; l < DEPTH; ++l) convert_weights(p, l, R);
        if (blockIdx.x == 0 && tid < 64) ((unsigned*)(p.ws + WS_CTL))[64 * tid] = 0u;
        if (blockIdx.x == 0) for (int i = tid; i < XCD_BAR_WORDS; i += NTHR) ((unsigned*)(p.ws + WS_CTL))[CW_BAR + i] = 0u;
        if (tid < 8) ((LAS unsigned*)(lds + LDS_BYTES - 32))[tid] = 0u;
        rms_rows(p.x, p.ffn1_norm, HN, gw, ngw, lane);
    }
    grid.sync();
    xcd_post(wv);
    layer_body<0>(grid, lds, wv);
    layer_body<1>(grid, lds, wv);
}

extern "C" void kernel_launch(void* const* d_in, const int* in_sizes, int n_in, void* d_out, int out_size, void* d_ws, size_t ws_size, hipStream_t stream) {
    static int grid = 0;
    if (grid == 0) {
        if (n_in != 20 || out_size != T * D || ws_size < WS_END2) { fprintf(stderr, "kernel_launch: unexpected shapes (n_in %d out %d ws %zu)\n", n_in, out_size, ws_size); grid = -1; return; }
        int dev = 0, cus = 0, per_cu = 0;
        hipGetDevice(&dev); hipDeviceGetAttribute(&cus, hipDeviceAttributeMultiprocessorCount, dev);
        hipFuncSetAttribute((const void*)hybrid_fwd, hipFuncAttributeMaxDynamicSharedMemorySize, LDS_BYTES);
        hipOccupancyMaxActiveBlocksPerMultiprocessor(&per_cu, (const void*)hybrid_fwd, NTHR, LDS_BYTES);
        if (per_cu < 1) { fprintf(stderr, "kernel_launch: occupancy query says %d\n", per_cu); per_cu = 1; }
        (void)hipGetLastError();
        grid = cus * 1;
    }
    if (grid < 0) return;
    Params p{};
    p.x = (const float*)d_in[0]; p.pos = (const int*)d_in[1];
    p.ffn1_norm = (const float*)d_in[2]; p.ffn1_gu = (const float*)d_in[3]; p.ffn1_down = (const float*)d_in[4]; p.mix_norm = (const float*)d_in[5]; p.w_in = (const float*)d_in[6];
    p.diff_qk_norm = (const float*)d_in[7]; p.diff_lambda = (const float*)d_in[8]; p.diff_head_norm = (const float*)d_in[9]; p.ml_conv_w = (const float*)d_in[10]; p.ml_conv_b = (const float*)d_in[11];
    p.ml_gate_bias = (const float*)d_in[12]; p.ml_head_norm = (const float*)d_in[13]; p.dsa_qk_norm = (const float*)d_in[14]; p.w_branch = (const float*)d_in[15]; p.w_out = (const float*)d_in[16];
    p.ffn2_norm = (const float*)d_in[17]; p.ffn2_gu = (const float*)d_in[18]; p.ffn2_down = (const float*)d_in[19];
    p.out = (float*)d_out; p.ws = (unsigned char*)d_ws;
    void* args[] = {&p};
    hipError_t e = hipLaunchCooperativeKernel((const void*)hybrid_fwd, dim3(grid), dim3(NTHR), args, LDS_BYTES, stream);
    if (e != hipSuccess) fprintf(stderr, "cooperative launch failed: %s (grid %d)\n", hipGetErrorString(e), grid);
}
```

```cpp
#include <hip/hip_runtime.h>
#include <hip/hip_cooperative_groups.h>
#include <cstdio>
#include <cstdint>
namespace cg = cooperative_groups;
#ifndef PROBE_DUP
#define PROBE_DUP 0
#endif
namespace pg8 {
#define PG8_LAS __attribute__((address_space(3)))
typedef unsigned short bf16_t;
typedef short bf16x8 __attribute__((ext_vector_type(8)));
typedef float f32x4 __attribute__((ext_vector_type(4)));
typedef unsigned u32x4 __attribute__((ext_vector_type(4)));
constexpr int BM = 256, BK = 64, HALF = 128, HTB = HALF * BK * 2  , STAGE_BYTES = 8 * HTB, NXCD = 8, WGM = 8;

__host__ __device__ __forceinline__ int lds_byte(int r, int c) { const int st = (r >> 4) * 2 + (c >> 5), rr = r & 15, cc = c & 31, ob = rr * 64 + cc * 2; return st * 1024 + (ob ^ (((ob >> 9) & 1) << 5)); }
__host__ __device__ __forceinline__ void stage_rc(int b, int& R, int& C) { const int st = b / 1024, sb = b % 1024, swz = sb ^ (((sb >> 9) & 1) << 5); R = (st >> 1) * 16 + swz / 64; C = (st & 1) * 32 + (swz % 64) / 2; }
__host__ __device__ __forceinline__ int perm32(int rho) { const int n = rho >> 4, i = rho & 15; return 8 * (i >> 2) + 4 * n + (i & 3); }

struct Unit { int pm, pn; };
struct Gemm { const bf16_t* A; const bf16_t* Bt; int M, N, K; };

struct StaticOrder {
    int nM, nN, nwg, G, c;
    __host__ __device__ void init(int M, int N, int G_, int c_) { nM = M / BM; nN = N / BM; nwg = nM * nN; G = G_; c = c_; }
    __host__ __device__ bool next(int i, Unit& u) const {
        const long L = (long)i * G + c; if (L >= nwg) return false;
        int wgid = (int)L; { const int q = nwg / NXCD, r = nwg % NXCD, xcd = wgid % NXCD, off = wgid / NXCD; wgid = (xcd < r ? xcd * (q + 1) : r * (q + 1) + (xcd - r) * q) + off; }
        const int nig = WGM * nN, gid = wgid / nig, fm = gid * WGM, gsz = (nM - fm) < WGM ? (nM - fm) : WGM;
        u.pm = fm + ((wgid % nig) % gsz); u.pn = (wgid % nig) / gsz; return true;
    }
    __device__ __forceinline__ void a_ready(const Unit&) const {}
    __device__ __forceinline__ void done(const Unit&) const {}
};

__device__ __forceinline__ unsigned cvt_pk_bf16(float lo, float hi) { unsigned r; asm volatile("v_cvt_pk_bf16_f32 %0, %1, %2" : "=v"(r) : "v"(lo), "v"(hi)); return r; }
template <class Epi, class Sched, bool ALIGN_EPI = false, bool SP2 = false>
__device__ __forceinline__ void gemm_phase(PG8_LAS unsigned char* lds, const Gemm g, const Sched& S, const Epi& E, const int wave_in) {
    unsigned z_ = 0u; asm volatile("" : "+v"(z_)); int w_ = wave_in; asm volatile("" : "+s"(w_));
    const int tid_ = w_ * 64 + (int)__builtin_amdgcn_mbcnt_hi(~0u, __builtin_amdgcn_mbcnt_lo(~0u, z_));
    const int tid = tid_, wid = __builtin_amdgcn_readfirstlane(tid >> 6), lane = tid & 63, wr = wid >> 2, wc = wid & 3, fr = lane & 15, fq = lane >> 4;
    const int K = g.K, nt = K / BK;
    unsigned voffA[2], voffB[2];
#pragma unroll
    for (int i = 0; i < 2; ++i) { int R, C; stage_rc(tid * 16 + i * 8192, R, C); const int Rb = Epi::PERM ? ((R & ~31) + perm32(R & 31)) : R;
        voffA[i] = (unsigned)(R * K + C) * 2u; voffB[i] = (unsigned)(Rb * K + C) * 2u; }
    const size_t kstep = (size_t)(BK * 2);
    const size_t hstep = (size_t)HALF * K * 2;
    const size_t tstep = 2 * hstep;
    const unsigned ldsw = (unsigned)wid * 1024u;
    const int aoff = lds_byte(wr * 64 + fr, fq * 8), boff = lds_byte(wc * 32 + fr, fq * 8);
#define PG8_SA(b, h) (((b) * 2 + (h)) * HTB)
#define PG8_SB(b, h) ((4 + (b) * 2 + (h)) * HTB)
#define PG8_STAGE(bufoff, gbase, voff) do { _Pragma("unroll") for (int _i = 0; _i < 2; ++_i) \
        __builtin_amdgcn_global_load_lds((const unsigned*)((const char*)(gbase) + (voff)[_i]), (PG8_LAS unsigned*)(lds + (bufoff) + ldsw + _i * 8192), 16, 0, 0); } while (0)
#define PG8_LDA(dst, b, h) do { _Pragma("unroll") for (int m = 0; m < 4; ++m) _Pragma("unroll") for (int k = 0; k < 2; ++k) dst[m][k] = *(const PG8_LAS bf16x8*)(lds + PG8_SA(b, h) + aoff + m * 2048 + k * 1024); } while (0)
#define PG8_LDB(dst, b, h) do { _Pragma("unroll") for (int n = 0; n < 2; ++n) _Pragma("unroll") for (int k = 0; k < 2; ++k) dst[n][k] = *(const PG8_LAS bf16x8*)(lds + PG8_SB(b, h) + boff + n * 2048 + k * 1024); } while (0)
#define PG8_MMA(ai, bj, At, Bt) do { __builtin_amdgcn_s_setprio(1); _Pragma("unroll") for (int m = 0; m < 4; ++m) _Pragma("unroll") for (int n = 0; n < 2; ++n) _Pragma("unroll") for (int k = 0; k < 2; ++k) \
        acc[ai][bj][m][n] = __builtin_amdgcn_mfma_f32_16x16x32_bf16(Bt[n][k], At[m][k], acc[ai][bj][m][n], 0, 0, 0); __builtin_amdgcn_s_setprio(0); } while (0)
#define PG8_WAIT_V(n) asm volatile("s_waitcnt vmcnt(" #n ")" ::: "memory")
#define PG8_WAIT_L(n) asm volatile("s_waitcnt lgkmcnt(" #n ")" ::: "memory")
#define PG8_BAR __builtin_amdgcn_s_barrier()
#define PG8_SCHED __builtin_amdgcn_sched_barrier(0)
    Unit cur, nxt; int ui = 0;
    if (!S.next(0, cur)) return;
    f32x4 acc[2][2][4][2];
#pragma unroll
    for (int a = 0; a < 2; ++a)
#pragma unroll
        for (int b = 0; b < 2; ++b)
#pragma unroll
            for (int m = 0; m < 4; ++m)
#pragma unroll
                for (int n = 0; n < 2; ++n) acc[a][b][m][n] = (f32x4){0.f, 0.f, 0.f, 0.f};
    bf16x8 At[4][2], B0[2][2], B1[2][2];
    const char* cA = (const char*)g.A + (size_t)cur.pm * tstep; const char* cB = (const char*)g.Bt + (size_t)cur.pn * tstep;
    S.a_ready(cur);
    if constexpr (SP2) {
        PG8_STAGE(PG8_SB(0, 0), cB, voffB); PG8_STAGE(PG8_SB(0, 1), cB + hstep, voffB); PG8_STAGE(PG8_SA(0, 0), cA, voffA); PG8_STAGE(PG8_SA(0, 1), cA + hstep, voffA);
        if (wr == 1) PG8_BAR;
        PG8_WAIT_V(2); PG8_BAR;
        PG8_STAGE(PG8_SB(1, 0), cB + kstep, voffB); PG8_STAGE(PG8_SA(1, 0), cA + kstep, voffA); PG8_STAGE(PG8_SB(1, 1), cB + hstep + kstep, voffB);
        PG8_WAIT_V(6); PG8_BAR;
    } else {
        PG8_STAGE(PG8_SB(0, 0), cB, voffB); PG8_STAGE(PG8_SA(0, 0), cA, voffA); PG8_STAGE(PG8_SB(0, 1), cB + hstep, voffB); PG8_STAGE(PG8_SA(0, 1), cA + hstep, voffA);
        if (wr == 1) PG8_BAR;
        PG8_WAIT_V(4); PG8_BAR;
        PG8_STAGE(PG8_SB(1, 0), cB + kstep, voffB); PG8_STAGE(PG8_SA(1, 0), cA + kstep, voffA); PG8_STAGE(PG8_SB(1, 1), cB + hstep + kstep, voffB);
        PG8_WAIT_V(6); PG8_BAR;
    }
    for (;;) {
        const bool has_next = S.next(ui + 1, nxt);
        const char* nA = has_next ? (const char*)g.A + (size_t)nxt.pm * tstep : cA; const char* nB = has_next ? (const char*)g.Bt + (size_t)nxt.pn * tstep : cB;
        for (int t = 0; t < nt; t += 2) {
            const bool last = (t == nt - 2);
            const char* a1 = cA + (size_t)(t + 1) * kstep;
            const char* a2 = last ? nA : cA + (size_t)(t + 2) * kstep; const char* b2 = last ? nB : cB + (size_t)(t + 2) * kstep;
            const char* a3 = a2 + kstep; const char* b3 = b2 + kstep;
            if (last && has_next) S.a_ready(nxt);
            if constexpr (SP2) {
            PG8_LDB(B0, 0, 0); PG8_LDB(B1, 0, 1); PG8_SCHED; PG8_LDA(At, 0, 0); PG8_STAGE(PG8_SA(1, 1), a1 + hstep, voffA);
            PG8_WAIT_V(8); PG8_WAIT_L(0); PG8_BAR; PG8_MMA(0, 0, At, B0); PG8_MMA(0, 1, At, B1); PG8_BAR; PG8_SCHED;
            PG8_LDA(At, 0, 1); PG8_STAGE(PG8_SB(0, 0), b2, voffB); PG8_STAGE(PG8_SB(0, 1), b2 + hstep, voffB); PG8_STAGE(PG8_SA(0, 0), a2, voffA);
            PG8_WAIT_V(8); PG8_WAIT_L(0); PG8_BAR; PG8_MMA(1, 0, At, B0); PG8_MMA(1, 1, At, B1); PG8_BAR; PG8_SCHED;
            PG8_LDB(B0, 1, 0); PG8_LDB(B1, 1, 1); PG8_SCHED; PG8_LDA(At, 1, 0); PG8_STAGE(PG8_SA(0, 1), a2 + hstep, voffA);
            PG8_WAIT_V(8); PG8_WAIT_L(0); PG8_BAR; PG8_MMA(0, 0, At, B0); PG8_MMA(0, 1, At, B1); PG8_BAR; PG8_SCHED;
            PG8_LDA(At, 1, 1); PG8_STAGE(PG8_SB(1, 0), b3, voffB); PG8_STAGE(PG8_SB(1, 1), b3 + hstep, voffB); PG8_STAGE(PG8_SA(1, 0), a3, voffA);
            PG8_WAIT_V(8); PG8_WAIT_L(0); PG8_BAR; PG8_MMA(1, 0, At, B0); PG8_MMA(1, 1, At, B1); PG8_BAR; PG8_SCHED;
            } else {
            PG8_LDB(B0, 0, 0); PG8_SCHED; PG8_LDA(At, 0, 0); PG8_STAGE(PG8_SA(1, 1), a1 + hstep, voffA);
            PG8_WAIT_L(8); PG8_BAR; PG8_WAIT_L(0); PG8_MMA(0, 0, At, B0); PG8_BAR; PG8_SCHED;
            PG8_LDB(B1, 0, 1); PG8_STAGE(PG8_SB(0, 0), b2, voffB);
            PG8_BAR; PG8_WAIT_L(0); PG8_MMA(0, 1, At, B1); PG8_BAR;
            PG8_LDA(At, 0, 1); PG8_STAGE(PG8_SA(0, 0), a2, voffA);
            PG8_BAR; PG8_WAIT_L(0); PG8_MMA(1, 0, At, B0); PG8_BAR; PG8_SCHED;
            PG8_STAGE(PG8_SB(0, 1), b2 + hstep, voffB);
            PG8_WAIT_V(6); PG8_BAR; PG8_MMA(1, 1, At, B1); PG8_BAR;
            PG8_LDB(B0, 1, 0); PG8_SCHED; PG8_LDA(At, 1, 0); PG8_STAGE(PG8_SA(0, 1), a2 + hstep, voffA);
            PG8_WAIT_L(8); PG8_BAR; PG8_WAIT_L(0); PG8_MMA(0, 0, At, B0); PG8_BAR; PG8_SCHED;
            PG8_LDB(B1, 1, 1); PG8_STAGE(PG8_SB(1, 0), b3, voffB);
            PG8_BAR; PG8_WAIT_L(0); PG8_MMA(0, 1, At, B1); PG8_BAR;
            PG8_LDA(At, 1, 1); PG8_STAGE(PG8_SA(1, 0), a3, voffA);
            PG8_BAR; PG8_WAIT_L(0); PG8_MMA(1, 0, At, B0); PG8_BAR; PG8_SCHED;
            PG8_STAGE(PG8_SB(1, 1), b3 + hstep, voffB);
            PG8_WAIT_V(6); PG8_BAR; PG8_MMA(1, 1, At, B1); PG8_BAR;
            }
        }
        if constexpr (ALIGN_EPI) { if (wr == 0) PG8_BAR; }
        if constexpr (!Epi::AFTER_DRAIN) { E(acc, cur, wr, wc, fr, fq); S.done(cur); }
        if (!has_next) break;
#pragma unroll
        for (int a = 0; a < 2; ++a)
#pragma unroll
            for (int b = 0; b < 2; ++b)
#pragma unroll
                for (int m = 0; m < 4; ++m)
#pragma unroll
                    for (int n = 0; n < 2; ++n) acc[a][b][m][n] = (f32x4){0.f, 0.f, 0.f, 0.f};
        cur = nxt; cA = nA; cB = nB; ++ui;
        if constexpr (ALIGN_EPI) { if (wr == 1) PG8_BAR; }
    }
    PG8_WAIT_V(0);
    if constexpr (!ALIGN_EPI) { if (wr == 0) PG8_BAR; }
    PG8_BAR;
    if constexpr (Epi::AFTER_DRAIN) { E.fused(acc, cur, wr, wc, fr, fq, lds, wid, lane); S.done(cur); }
#undef PG8_SA
#undef PG8_SB
#undef PG8_STAGE
#undef PG8_LDA
#undef PG8_LDB
#undef PG8_MMA
#undef PG8_WAIT_V
#undef PG8_WAIT_L
#undef PG8_BAR
#undef PG8_SCHED
}
}
#define LAS __attribute__((address_space(3)))
typedef unsigned short bf16;
typedef float f32x4 __attribute__((ext_vector_type(4)));
typedef float f32x16 __attribute__((ext_vector_type(16)));
typedef unsigned u32x4 __attribute__((ext_vector_type(4)));
typedef unsigned u32x2 __attribute__((ext_vector_type(2)));
typedef short s16x8 __attribute__((ext_vector_type(8)));

constexpr int NB = 8, SEQ = 4096, T = NB * SEQ, D = 1024, FF = 2816, DEPTH = 2, NIN = 7344, ZP = 3072, ZSP = 256;
constexpr int NTHR = 512, NWAVES = 8;
constexpr int LDS_BYTES = 147456;
constexpr float EPS = 1e-6f;

constexpr size_t MiB = (size_t)1 << 20;
constexpr size_t WS_CTL = 0;
constexpr size_t WS_W = 1 * MiB, WL_STRIDE = 52 * MiB;
constexpr size_t WL_GU1 = 0, WL_D1 = 11534336, WL_INA = 17301504, WL_G = 24117248, WL_BR = 32505856, WL_OUT = 34603008, WL_GU2 = 36700160, WL_D2 = 48234496;
constexpr size_t WS_HN = 106 * MiB, WS_BIG = 170 * MiB, WS_ZS = 362 * MiB, WS_O = 394 * MiB, WS_IK = 458 * MiB, WS_END = 460 * MiB;
constexpr size_t OB_STRIDE = (size_t)T * 256 * 2;

struct Params {
    const float* x; const int* pos;
    const float *ffn1_norm, *ffn1_gu, *ffn1_down, *mix_norm, *w_in, *diff_qk_norm, *diff_lambda, *diff_head_norm, *ml_conv_w, *ml_conv_b, *ml_gate_bias, *ml_head_norm,
        *dsa_qk_norm, *w_branch, *w_out, *ffn2_norm, *ffn2_gu, *ffn2_down;
    float* out; unsigned char* ws;
};

__device__ __forceinline__ unsigned f2bf(float f) { unsigned u = __float_as_uint(f); return (u + 0x7fffu + ((u >> 16) & 1u)) >> 16; }
__device__ __forceinline__ unsigned pk2(float lo, float hi) { return f2bf(lo) | (f2bf(hi) << 16); }
__device__ __forceinline__ float bflo(unsigned w) { return __uint_as_float(w << 16); }
__device__ __forceinline__ float bfhi(unsigned w) { return __uint_as_float(w & 0xffff0000u); }
__device__ __forceinline__ float wave_sum(float v) {
#pragma unroll
    for (int o = 1; o < 64; o <<= 1) v += __shfl_xor(v, o);
    return v;
}
__device__ __forceinline__ float wave_max(float v) {
#pragma unroll
    for (int o = 1; o < 64; o <<= 1) v = fmaxf(v, __shfl_xor(v, o));
    return v;
}
__device__ __forceinline__ int lane_fresh() { unsigned z = 0u; asm volatile("" : "+v"(z)); return (int)__builtin_amdgcn_mbcnt_hi(~0u, __builtin_amdgcn_mbcnt_lo(~0u, z)); }
__device__ __forceinline__ int tid_fresh(int wv) { int w = wv; asm volatile("" : "+s"(w)); return w * 64 + lane_fresh(); }
#define LDS_WAIT() asm volatile("s_waitcnt lgkmcnt(0)" ::: "memory")
__device__ __forceinline__ float sigmoidf_(float x) { return 1.f / (1.f + __expf(-x)); }

struct EpiSwiglu {
    static constexpr bool PERM = true, AFTER_DRAIN = false;
    bf16* O;
    __device__ __forceinline__ void operator()(const f32x4 (&acc)[2][2][4][2], const pg8::Unit& u, int wr, int wc, int fr_in, int fq_in) const {
        const int ln_ = lane_fresh(); const int fr = ln_ & 15, fq = ln_ >> 4; (void)fr_in; (void)fq_in;
        const int row0 = u.pm * 256 + wr * 64 + fr, col0 = u.pn * 128 + wc * 32 + 8 * fq;
#pragma unroll
        for (int ai = 0; ai < 2; ++ai)
#pragma unroll
            for (int m = 0; m < 4; ++m) {
                bf16* rowp = O + (size_t)(row0 + ai * 128 + m * 16) * FF + col0;
                float r[8];
#pragma unroll
                for (int n = 0; n < 2; ++n)
#pragma unroll
                    for (int j = 0; j < 4; ++j) { const float g = acc[ai][0][m][n][j], uu = acc[ai][1][m][n][j]; r[4 * n + j] = g * sigmoidf_(g) * uu; }
                u32x4 w; w.x = pk2(r[0], r[1]); w.y = pk2(r[2], r[3]); w.z = pk2(r[4], r[5]); w.w = pk2(r[6], r[7]);
                *(u32x4*)rowp = w;
            }
    }
};
struct EpiResid {
    static constexpr bool PERM = true, AFTER_DRAIN = false;
    const float* base; float* out; float scale;
    __device__ __forceinline__ void operator()(const f32x4 (&acc)[2][2][4][2], const pg8::Unit& u, int wr, int wc, int fr_in, int fq_in) const {
        const int ln_ = lane_fresh(); const int fr = ln_ & 15, fq = ln_ >> 4; (void)fr_in; (void)fq_in;
        const int row0 = u.pm * 256 + wr * 64 + fr, col0 = u.pn * 256 + wc * 32 + 8 * fq;
#pragma unroll
        for (int ai = 0; ai < 2; ++ai)
#pragma unroll
            for (int m = 0; m < 4; ++m) {
                const size_t ro = (size_t)(row0 + ai * 128 + m * 16) * D + col0;
#pragma unroll
                for (int bj = 0; bj < 2; ++bj)
#pragma unroll
                    for (int n = 0; n < 2; ++n) { const f32x4 b = *(const f32x4*)(base + ro + bj * 128 + 4 * n); *(f32x4*)(out + ro + bj * 128 + 4 * n) = b + acc[ai][bj][m][n] * scale; }
            }
    }
};
struct EpiZ {
    static constexpr bool PERM = true, AFTER_DRAIN = false;
    bf16* Z; float* ZS;
    __device__ __forceinline__ void operator()(const f32x4 (&acc)[2][2][4][2], const pg8::Unit& u, int wr, int wc, int fr_in, int fq_in) const {
        const int ln_ = lane_fresh(); const int fr = ln_ & 15, fq = ln_ >> 4; (void)fr_in; (void)fq_in;
        const int row0 = u.pm * 256 + wr * 64 + fr, cw = wc * 32 + 8 * fq;
        if (u.pn < 12) {
#pragma unroll
            for (int ai = 0; ai < 2; ++ai)
#pragma unroll
                for (int m = 0; m < 4; ++m) {
                    bf16* rowp = Z + (size_t)(row0 + ai * 128 + m * 16) * ZP + u.pn * 256 + cw;
#pragma unroll
                    for (int bj = 0; bj < 2; ++bj) { const f32x4 v0 = acc[ai][bj][m][0], v1 = acc[ai][bj][m][1];
                        u32x4 w; w.x = pk2(v0[0], v0[1]); w.y = pk2(v0[2], v0[3]); w.z = pk2(v1[0], v1[1]); w.w = pk2(v1[2], v1[3]);
                        *(u32x4*)(rowp + bj * 128) = w; }
                }
        } else {
#pragma unroll
            for (int ai = 0; ai < 2; ++ai)
#pragma unroll
                for (int m = 0; m < 4; ++m) {
                    float* rowp = ZS + (size_t)(row0 + ai * 128 + m * 16) * ZSP + cw;
#pragma unroll
                    for (int bj = 0; bj < 2; ++bj)
#pragma unroll
                        for (int n = 0; n < 2; ++n) *(f32x4*)(rowp + bj * 128 + 4 * n) = acc[ai][bj][m][n];
                }
        }
    }
};
struct EpiSig {
    static constexpr bool PERM = true, AFTER_DRAIN = false;
    bf16* SG;
    __device__ __forceinline__ void operator()(const f32x4 (&acc)[2][2][4][2], const pg8::Unit& u, int wr, int wc, int fr_in, int fq_in) const {
        const int ln_ = lane_fresh(); const int fr = ln_ & 15, fq = ln_ >> 4; (void)fr_in; (void)fq_in;
        const int row0 = u.pm * 256 + wr * 64 + fr, col0 = u.pn * 256 + wc * 32 + 8 * fq;
#pragma unroll
        for (int ai = 0; ai < 2; ++ai)
#pragma unroll
            for (int m = 0; m < 4; ++m) {
                bf16* rowp = SG + (size_t)(row0 + ai * 128 + m * 16) * D + col0;
#pragma unroll
                for (int bj = 0; bj < 2; ++bj) { const f32x4 v0 = acc[ai][bj][m][0], v1 = acc[ai][bj][m][1];
                    u32x4 w; w.x = pk2(sigmoidf_(v0[0]), sigmoidf_(v0[1])); w.y = pk2(sigmoidf_(v0[2]), sigmoidf_(v0[3]));
                    w.z = pk2(sigmoidf_(v1[0]), sigmoidf_(v1[1])); w.w = pk2(sigmoidf_(v1[2]), sigmoidf_(v1[3]));
                    *(u32x4*)(rowp + bj * 128) = w; }
            }
    }
};
struct EpiGate {
    static constexpr bool PERM = true, AFTER_DRAIN = false;
    const bf16* SG; float* YF; bf16* YB; int mode;
    __device__ __forceinline__ void operator()(const f32x4 (&acc)[2][2][4][2], const pg8::Unit& u, int wr, int wc, int fr_in, int fq_in) const {
        const int ln_ = lane_fresh(); const int fr = ln_ & 15, fq = ln_ >> 4; (void)fr_in; (void)fq_in;
        const int row0 = u.pm * 256 + wr * 64 + fr, col0 = u.pn * 256 + wc * 32 + 8 * fq;
#pragma unroll
        for (int ai = 0; ai < 2; ++ai)
#pragma unroll
            for (int m = 0; m < 4; ++m) {
                const size_t ro = (size_t)(row0 + ai * 128 + m * 16) * D + col0;
#pragma unroll
                for (int bj = 0; bj < 2; ++bj) {
                    const u32x4 sg = *(const u32x4*)(SG + ro + bj * 128);
                    f32x4 g0 = (f32x4){bflo(sg.x), bfhi(sg.x), bflo(sg.y), bfhi(sg.y)}, g1 = (f32x4){bflo(sg.z), bfhi(sg.z), bflo(sg.w), bfhi(sg.w)};
                    f32x4 v0 = g0 * acc[ai][bj][m][0], v1 = g1 * acc[ai][bj][m][1];
                    float* yp = YF + ro + bj * 128;
                    if (mode != 0) { v0 = v0 + *(const f32x4*)yp; v1 = v1 + *(const f32x4*)(yp + 4); }
                    if (mode != 2) { *(f32x4*)yp = v0; *(f32x4*)(yp + 4) = v1; }
                    else { u32x4 w; w.x = pk2(v0[0], v0[1]); w.y = pk2(v0[2], v0[3]); w.z = pk2(v1[0], v1[1]); w.w = pk2(v1[2], v1[3]); *(u32x4*)(YB + ro + bj * 128) = w; }
                }
            }
    }
};

template <class Epi>
__device__ __forceinline__ void run_gemm(LAS unsigned char* lds, const bf16* A, const bf16* Bt, int M, int N, int K, const Epi& E, int wv) {
    pg8::Gemm g{A, Bt, M, N, K}; pg8::StaticOrder S; S.init(M, N, (int)gridDim.x, (int)blockIdx.x);
    pg8::gemm_phase<Epi, pg8::StaticOrder, true, true>((PG8_LAS unsigned char*)lds, g, S, E, wv);
}

__device__ __forceinline__ void tr_item(const float* W, int K, int srcN, int c0, int nv, bf16* WT, int r0, int k0, LAS float* scr, int lane) {
    const int c = lane & 31;
#pragma unroll 8
    for (int i = 0; i < 32; ++i) { const int kk = 2 * i + (lane >> 5); scr[kk * 33 + c] = (c < nv) ? W[(size_t)(k0 + kk) * srcN + c0 + c] : 0.f; }
    LDS_WAIT();
    const int c8 = lane & 7;
#pragma unroll
    for (int j = 0; j < 4; ++j) { const int n = (lane >> 3) + 8 * j; const LAS float* s = scr + (8 * c8) * 33 + n;
        u32x4 o; o.x = pk2(s[0 * 33], s[1 * 33]); o.y = pk2(s[2 * 33], s[3 * 33]); o.z = pk2(s[4 * 33], s[5 * 33]); o.w = pk2(s[6 * 33], s[7 * 33]);
        if (n < nv) *(u32x4*)(WT + (size_t)(r0 + n) * K + k0 + 8 * c8) = o; }
    LDS_WAIT();
}
struct SegRun { int base, gw, ngw, lane; LAS float* scr; };
__device__ __forceinline__ void run_seg(SegRun& R, const float* W, int K, int srcN, int c0, int ncols, bf16* WT, int r0) {
    const int nblk = (ncols + 31) >> 5, nitems = (K >> 6) * nblk;
    int first = (R.gw - (R.base % R.ngw) + R.ngw) % R.ngw;
    for (int it = first; it < nitems; it += R.ngw) { const int kb = it / nblk, nb = it - kb * nblk; const int nv = min(32, ncols - nb * 32);
        tr_item(W, K, srcN, c0 + nb * 32, nv, WT, r0 + nb * 32, kb * 64, R.scr, R.lane); }
    R.base += nitems;
}
__device__ __forceinline__ void convert_weights(const Params& p, int l, SegRun& R) {
    unsigned char* wl = p.ws + WS_W + (size_t)l * WL_STRIDE;
    for (int f = 0; f < 2; ++f) {
        const float* gu = (f ? p.ffn2_gu : p.ffn1_gu) + (size_t)l * D * 2 * FF; bf16* gut = (bf16*)(wl + (f ? WL_GU2 : WL_GU1));
        for (int sg = 0; sg < 44; ++sg) run_seg(R, gu, D, 2 * FF, sg * 128, 128, gut, (sg % 22) * 256 + (sg / 22) * 128);
        const float* dn = (f ? p.ffn2_down : p.ffn1_down) + (size_t)l * FF * D; bf16* dnt = (bf16*)(wl + (f ? WL_D2 : WL_D1));
        run_seg(R, dn, FF, D, 0, D, dnt, 0);
    }
    const float* wi = p.w_in + (size_t)l * D * NIN; bf16* ina = (bf16*)(wl + WL_INA);
    run_seg(R, wi, D, NIN, 0, 768, ina, 0);
    run_seg(R, wi, D, NIN, 768, 512, ina, 768);
    run_seg(R, wi, D, NIN, 1280, 256, ina, 1280);
    run_seg(R, wi, D, NIN, 1544, 256, ina, 1536);
    run_seg(R, wi, D, NIN, 1800, 768, ina, 1792);
    run_seg(R, wi, D, NIN, 2568, 256, ina, 2560);
    run_seg(R, wi, D, NIN, 2952, 256, ina, 2816);
    run_seg(R, wi, D, NIN, 2824, 128, ina, 3072);
    run_seg(R, wi, D, NIN, 3208, 40, ina, 3200);
    run_seg(R, wi, D, NIN, 1536, 8, ina, 3240);
    run_seg(R, wi, D, NIN, 3248, 4096, (bf16*)(wl + WL_G), 0);
    for (int b = 0; b < 4; ++b) run_seg(R, p.w_branch + ((size_t)l * 4 + b) * 256 * D, 256, D, 0, D, (bf16*)(wl + WL_BR) + (size_t)b * D * 256, 0);
    run_seg(R, p.w_out + (size_t)l * D * D, D, D, 0, D, (bf16*)(wl + WL_OUT), 0);
    for (int i = R.gw * 64 + R.lane; i < 80 * 128; i += R.ngw * 64) *((u32x4*)(ina + (size_t)3248 * D) + i) = (u32x4){0u, 0u, 0u, 0u};
}

__device__ __forceinline__ void rms_rows(const float* X, const float* g, bf16* HN, int gw, int ngw, int lane) {
    f32x4 gv[4];
#pragma unroll
    for (int j = 0; j < 4; ++j) gv[j] = ((const f32x4*)g)[lane + 64 * j];
    for (int m = gw; m < T; m += ngw) {
        const f32x4* xr = (const f32x4*)(X + (size_t)m * D) + lane;
        f32x4 v[4]; float s = 0.f;
#pragma unroll
        for (int j = 0; j < 4; ++j) { v[j] = xr[64 * j]; s += (v[j].x * v[j].x + v[j].y * v[j].y) + (v[j].z * v[j].z + v[j].w * v[j].w); }
        const float r = 1.f / sqrtf(wave_sum(s) * (1.f / D) + EPS);
        unsigned long long* o8 = (unsigned long long*)(HN + (size_t)m * D) + lane;
#pragma unroll
        for (int j = 0; j < 4; ++j) { const f32x4 y = v[j] * r * gv[j]; o8[64 * j] = (unsigned long long)pk2(y.x, y.y) | ((unsigned long long)pk2(y.z, y.w) << 32); }
    }
}

__device__ __forceinline__ void sincos_red(float ang, float& sn, float& cs) {
    const float n = rintf(ang * 0.15915494309189535f);
    float r = fmaf(-n, 6.28125f, ang); r = fmaf(-n, 0.0019353071795864769f, r);
    sn = __sinf(r); cs = __cosf(r);
}
template <int HALF>
__device__ __forceinline__ void rope4(float (&v)[4], int sl, float pos) {
    constexpr int LH = HALF / 4;
    float pv[4];
#pragma unroll
    for (int j = 0; j < 4; ++j) pv[j] = __shfl_xor(v[j], LH);
    if (sl < 2 * LH) {
        const bool first = sl < LH; const int i0 = (sl & (LH - 1)) * 4;
#pragma unroll
        for (int j = 0; j < 4; ++j) {
            constexpr float I4[4] = {1.0f, 0.03760603070259094f, 0.0014142135623842478f, 5.318296098266728e-05f};
            constexpr float I8[8] = {1.0f, 0.1939227432012558f, 0.03760603070259094f, 0.007292664609849453f, 0.0014142135623842478f, 0.00027424818836152554f, 5.318296098266728e-05f, 1.0313386155758053e-05f};
            const float inv = (HALF == 4) ? I4[j] : (i0 ? I8[4 + j] : I8[j]);
            float sn, cs; sincos_red(pos * inv, sn, cs);
            v[j] = first ? (v[j] * cs - pv[j] * sn) : (pv[j] * sn + v[j] * cs);
        }
    }
}
__device__ __forceinline__ void prep_phase(const Params& p, int l, int gw, int ngw, int lane) {
    bf16* Z = (bf16*)(p.ws + WS_BIG); float* ZS = (float*)(p.ws + WS_ZS); bf16* IK = (bf16*)(p.ws + WS_IK);
    const float* dg = p.diff_qk_norm + l * 64; const float* sg = p.dsa_qk_norm + l * 128;
    for (int tok = gw; tok < T; tok += ngw) {
        const float pos = (float)p.pos[tok];
#pragma unroll
        for (int which = 0; which < 2; ++which) {
            unsigned long long* ptr = (unsigned long long*)(Z + (size_t)tok * ZP + which * 256) + lane;
            const unsigned long long w = *ptr; float v[4] = {bflo((unsigned)w), bfhi((unsigned)w), bflo((unsigned)(w >> 32)), bfhi((unsigned)(w >> 32))};
            float ss = (v[0] * v[0] + v[1] * v[1]) + (v[2] * v[2] + v[3] * v[3]);
            ss += __shfl_xor(ss, 1); ss += __shfl_xor(ss, 2); ss += __shfl_xor(ss, 4);
            const float r = 1.f / sqrtf(ss * (1.f / 32.f) + EPS);
            const f32x4 g = *(const f32x4*)(dg + which * 32 + (lane & 7) * 4);
#pragma unroll
            for (int j = 0; j < 4; ++j) v[j] = v[j] * r * g[j];
            rope4<4>(v, lane & 7, pos);
            if (which == 0) {
#pragma unroll
                for (int j = 0; j < 4; ++j) v[j] *= 0.17677669529663687f;
            }
            *ptr = (unsigned long long)pk2(v[0], v[1]) | ((unsigned long long)pk2(v[2], v[3]) << 32);
        }
        {
            unsigned long long* ptr = (unsigned long long*)(Z + (size_t)tok * ZP + 2560) + lane;
            const unsigned long long w = *ptr; float v[4] = {bflo((unsigned)w), bfhi((unsigned)w), bflo((unsigned)(w >> 32)), bfhi((unsigned)(w >> 32))};
            float ss = (v[0] * v[0] + v[1] * v[1]) + (v[2] * v[2] + v[3] * v[3]);
            ss += __shfl_xor(ss, 1); ss += __shfl_xor(ss, 2); ss += __shfl_xor(ss, 4); ss += __shfl_xor(ss, 8);
            const float r = 1.f / sqrtf(ss * (1.f / 64.f) + EPS);
            const f32x4 g = *(const f32x4*)(sg + (lane & 15) * 4);
#pragma unroll
            for (int j = 0; j < 4; ++j) v[j] = v[j] * r * g[j];
            rope4<8>(v, lane & 15, pos);
#pragma unroll
            for (int j = 0; j < 4; ++j) v[j] *= 0.125f;
            *ptr = (unsigned long long)pk2(v[0], v[1]) | ((unsigned long long)pk2(v[2], v[3]) << 32);
        }
        {
            unsigned long long* ptr = (unsigned long long*)(Z + (size_t)tok * ZP + 2816) + lane;
            const unsigned long long w = *ptr; float v[4] = {bflo((unsigned)w), bfhi((unsigned)w), bflo((unsigned)(w >> 32)), bfhi((unsigned)(w >> 32))};
            rope4<4>(v, lane & 7, pos);
            *ptr = (unsigned long long)pk2(v[0], v[1]) | ((unsigned long long)pk2(v[2], v[3]) << 32);
        }
        {
            float* ptr = ZS + (size_t)tok * ZSP + (lane & 15) * 4;
            const f32x4 x = *(const f32x4*)ptr; float v[4] = {x[0], x[1], x[2], x[3]};
            float ss = (v[0] * v[0] + v[1] * v[1]) + (v[2] * v[2] + v[3] * v[3]);
            ss += __shfl_xor(ss, 1); ss += __shfl_xor(ss, 2); ss += __shfl_xor(ss, 4); ss += __shfl_xor(ss, 8);
            const float r = 1.f / sqrtf(ss * (1.f / 64.f) + EPS);
            const f32x4 g = *(const f32x4*)(sg + 64 + (lane & 15) * 4);
#pragma unroll
            for (int j = 0; j < 4; ++j) v[j] = v[j] * r * g[j];
            rope4<8>(v, lane & 15, pos);
            if (lane < 16) *(f32x4*)ptr = (f32x4){v[0], v[1], v[2], v[3]};
        }
        {
            const float* ptr = ZS + (size_t)tok * ZSP + 128 + (lane & 7) * 4;
            const f32x4 x = *(const f32x4*)ptr; float v[4] = {x[0], x[1], x[2], x[3]};
            rope4<4>(v, lane & 7, pos);
            if (lane < 8) *((unsigned long long*)(IK + (size_t)tok * 32) + lane) = (unsigned long long)pk2(v[0], v[1]) | ((unsigned long long)pk2(v[2], v[3]) << 32);
        }
    }
}
__device__ __forceinline__ void mlstm_item(const Params& p, int l, int bh, LAS unsigned char* lds, int wv) {
    const int tid = tid_fresh(wv), lane = tid & 63, b = bh >> 2, h = bh & 3;
    const bf16* Z = (const bf16*)(p.ws + WS_BIG); const float* ZS = (const float*)(p.ws + WS_ZS); bf16* O1 = (bf16*)(p.ws + WS_O + OB_STRIDE);
    LAS float* nv = (LAS float*)lds; LAS float* bc = nv + 64; LAS float* igs = bc + 64; LAS float* wks = igs + 64; LAS float* sc = wks + 64;
    LAS float* Qs = sc + 64; LAS float* Ks = Qs + 64 * 65; LAS float* Vs = Ks + 64 * 65; LAS float* Ss = Vs + 64 * 65; LAS float* Cs = Ss + 64 * 65;
    for (int i = tid; i < 64 * 65; i += NTHR) Cs[i] = 0.f;
    if (tid < 64) nv[tid] = 0.f;
    float mcar = 0.f;
    const int r = tid >> 3, sg = tid & 7;
    const int cc0 = sg * 16; const int ch0 = (cc0 < 64) ? (h * 64 + cc0) : (256 + h * 64 + cc0 - 64);
    const float* cw0 = p.ml_conv_w + (size_t)l * 4 * 512; const float* cb0 = p.ml_conv_b + (size_t)l * 512;
    const int zc0 = (cc0 < 64) ? (768 + h * 64 + cc0) : (1024 + h * 64 + cc0 - 64);
    const float gb_i = p.ml_gate_bias[(l * 2 + 0) * 4 + h], gb_f = p.ml_gate_bias[(l * 2 + 1) * 4 + h];
    const float qsc = (cc0 < 64) ? 0.125f : 1.0f;
    __syncthreads();
    for (int c = 0; c < 64; ++c) {
        const int t0 = c * 64; const size_t tok0 = (size_t)b * SEQ + t0;
        const float* cw = cw0; const float* cb = cb0; asm volatile("" : "+s"(cw), "+s"(cb));
        {
            float y[16];
#pragma unroll
            for (int i = 0; i < 16; ++i) y[i] = cb[ch0 + i];
#pragma unroll
            for (int j = 0; j < 4; ++j) {
                const int tt = t0 + r - 3 + j;
                if (tt >= 0) {
                    const u32x4* xp = (const u32x4*)(Z + ((size_t)b * SEQ + tt) * ZP + zc0); const u32x4 x0 = xp[0], x1 = xp[1];
                    const float xv[16] = {bflo(x0.x), bfhi(x0.x), bflo(x0.y), bfhi(x0.y), bflo(x0.z), bfhi(x0.z), bflo(x0.w), bfhi(x0.w),
                                          bflo(x1.x), bfhi(x1.x), bflo(x1.y), bfhi(x1.y), bflo(x1.z), bfhi(x1.z), bflo(x1.w), bfhi(x1.w)};
#pragma unroll
                    for (int i = 0; i < 16; ++i) y[i] = fmaf(cw[j * 512 + ch0 + i], xv[i], y[i]);
                }
            }
            LAS float* dst = (cc0 < 64) ? (Qs + r * 65 + cc0) : (Ks + r * 65 + cc0 - 64);
#pragma unroll
            for (int i = 0; i < 16; ++i) dst[i] = y[i] * sigmoidf_(y[i]) * qsc;
            const u32x4 vv = *(const u32x4*)(Z + (tok0 + r) * ZP + 1280 + h * 64 + sg * 8);
            LAS float* vd = Vs + r * 65 + sg * 8;
            vd[0] = bflo(vv.x); vd[1] = bfhi(vv.x); vd[2] = bflo(vv.y); vd[3] = bfhi(vv.y); vd[4] = bflo(vv.z); vd[5] = bfhi(vv.z); vd[6] = bflo(vv.w); vd[7] = bfhi(vv.w);
        }
        if (tid < 64) {
            const float ig = ZS[(tok0 + tid) * ZSP + 168 + h] + gb_i;
            const float fz = ZS[(tok0 + tid) * ZSP + 172 + h] + gb_f;
            const float lf = fminf(fz, 0.f) - log1pf(__expf(-fabsf(fz)));
            float bsum = lf;
#pragma unroll
            for (int d = 1; d < 64; d <<= 1) { const float n = __shfl_up(bsum, d); if (lane >= d) bsum += n; }
            const float bl = __shfl(bsum, 63);
            const float g = bl - bsum + ig;
            const float mnew = fmaxf(bl + mcar, wave_max(g));
            bc[tid] = bsum; igs[tid] = ig; wks[tid] = __expf(g - mnew);
            if (tid == 0) { sc[0] = mnew; sc[1] = __expf(bl + mcar - mnew); sc[2] = bl; }
        }
        __syncthreads();
        const float bt = bc[r];
        float mx = -INFINITY;
#pragma unroll
        for (int i = 0; i < 8; ++i) { const int s = sg * 8 + i; const float dli = (s <= r) ? (bt - bc[s] + igs[s]) : -INFINITY; mx = fmaxf(mx, dli); }
        mx = fmaxf(mx, __shfl_xor(mx, 1)); mx = fmaxf(mx, __shfl_xor(mx, 2)); mx = fmaxf(mx, __shfl_xor(mx, 4));
        const float inter = bt + mcar; const float mt = fmaxf(inter, mx); const float iw = __expf(inter - mt);
        float ssum = 0.f;
#pragma unroll 1
        for (int i = 0; i < 8; ++i) { const int s = sg * 8 + i; float dot = 0.f;
#pragma unroll 16
            for (int d = 0; d < 64; ++d) dot = fmaf(Qs[r * 65 + d], Ks[s * 65 + d], dot);
            const float dli = (s <= r) ? (bt - bc[s] + igs[s]) : -INFINITY;
            const float sv = dot * __expf(dli - mt); Ss[r * 65 + s] = sv; ssum += sv; }
        ssum += __shfl_xor(ssum, 1); ssum += __shfl_xor(ssum, 2); ssum += __shfl_xor(ssum, 4);
        float qn = 0.f;
#pragma unroll
        for (int d = 0; d < 64; ++d) qn = fmaf(Qs[r * 65 + d], nv[d], qn);
        const float den = iw * qn + ssum;
        __syncthreads();
        {
            float num[8];
#pragma unroll
            for (int i = 0; i < 8; ++i) num[i] = 0.f;
#pragma unroll 8
            for (int d = 0; d < 64; ++d) { const float qd = Qs[r * 65 + d];
#pragma unroll
                for (int i = 0; i < 8; ++i) num[i] = fmaf(qd, Cs[d * 65 + sg * 8 + i], num[i]); }
#pragma unroll
            for (int i = 0; i < 8; ++i) num[i] *= iw;
#pragma unroll 8
            for (int s = 0; s < 64; ++s) { const float sv = Ss[r * 65 + s];
#pragma unroll
                for (int i = 0; i < 8; ++i) num[i] = fmaf(sv, Vs[s * 65 + sg * 8 + i], num[i]); }
            const float dn = 1.f / fmaxf(fabsf(den), __expf(-mt));
            float hs = 0.f;
#pragma unroll
            for (int i = 0; i < 8; ++i) { num[i] *= dn; hs = fmaf(num[i], num[i], hs); }
            hs += __shfl_xor(hs, 1); hs += __shfl_xor(hs, 2); hs += __shfl_xor(hs, 4);
            const float rr = 1.f / sqrtf(hs * (1.f / 64.f) + EPS);
            const u32x4 og = *(const u32x4*)(Z + (tok0 + r) * ZP + 1536 + h * 64 + sg * 8);
            const float ogv[8] = {bflo(og.x), bfhi(og.x), bflo(og.y), bfhi(og.y), bflo(og.z), bfhi(og.z), bflo(og.w), bfhi(og.w)};
            const float* hg = p.ml_head_norm + l * 64 + sg * 8;
            float o[8];
#pragma unroll
            for (int i = 0; i < 8; ++i) o[i] = sigmoidf_(ogv[i]) * (num[i] * rr * hg[i]);
            u32x4 w; w.x = pk2(o[0], o[1]); w.y = pk2(o[2], o[3]); w.z = pk2(o[4], o[5]); w.w = pk2(o[6], o[7]);
            *(u32x4*)(O1 + (tok0 + r) * 256 + h * 64 + sg * 8) = w;
        }
        __syncthreads();
        {
            const float decay = sc[1];
            float cacc[8]; float nacc = 0.f;
#pragma unroll
            for (int i = 0; i < 8; ++i) cacc[i] = 0.f;
#pragma unroll 8
            for (int s = 0; s < 64; ++s) { const float kw = wks[s] * Ks[s * 65 + r]; nacc += kw;
#pragma unroll
                for (int i = 0; i < 8; ++i) cacc[i] = fmaf(kw, Vs[s * 65 + sg * 8 + i], cacc[i]); }
#pragma unroll
            for (int i = 0; i < 8; ++i) Cs[r * 65 + sg * 8 + i] = decay * Cs[r * 65 + sg * 8 + i] + cacc[i];
            if (sg == 0) nv[r] = decay * nv[r] + nacc;
            mcar = sc[0];
        }
        __syncthreads();
    }
}

__device__ __forceinline__ void diff_item(const Params& p, int l, int bh, int qt, LAS unsigned char* lds, int wv) {
    const int tid = tid_fresh(wv), b = bh >> 2, h = bh & 3, q0 = qt * 128;
    const bf16* Z = (const bf16*)(p.ws + WS_BIG); bf16* O0 = (bf16*)(p.ws + WS_O);
    LAS float* Kt = (LAS float*)lds; LAS float* Vt = Kt + 64 * 64;
    const int ql = tid >> 2, part = tid & 3, c = part & 1, dvh = part >> 1, t = q0 + ql; const size_t tok = (size_t)b * SEQ + t;
    const float* lp = p.diff_lambda + l * 128; float s01 = 0.f, s23 = 0.f, gqm = 0.f, gkm = 0.f;
#pragma unroll 2
    for (int i = 0; i < 32; ++i) { s01 = fmaf(lp[i], lp[32 + i], s01); s23 = fmaf(lp[64 + i], lp[96 + i], s23);
        gqm = fmaxf(gqm, fabsf(p.diff_qk_norm[l * 64 + i])); gkm = fmaxf(gkm, fabsf(p.diff_qk_norm[l * 64 + 32 + i])); }
    const float lam_init = 0.8f - 0.6f * __expf(-0.3f * (float)l); const float lam = __expf(s01) - __expf(s23) + lam_init;
    const float coff = 5.65685424949238f * gqm * gkm;
    float q[32], o[32];
    { const u32x4* qp = (const u32x4*)(Z + tok * ZP + h * 64 + c * 32);
#pragma unroll
      for (int i = 0; i < 4; ++i) { const u32x4 w = qp[i]; q[8 * i] = bflo(w.x); q[8 * i + 1] = bfhi(w.x); q[8 * i + 2] = bflo(w.y); q[8 * i + 3] = bfhi(w.y); q[8 * i + 4] = bflo(w.z); q[8 * i + 5] = bfhi(w.z); q[8 * i + 6] = bflo(w.w); q[8 * i + 7] = bfhi(w.w); } }
#pragma unroll
    for (int i = 0; i < 32; ++i) o[i] = 0.f;
    float lsum = 0.f;
    const int nkt = (q0 + 128) / 64;
    const int lk = tid >> 3, lsg = tid & 7;
    for (int kt = 0; kt < nkt; ++kt) {
        __syncthreads();
        { const size_t ktok = (size_t)b * SEQ + kt * 64 + lk;
          const bf16* src = Z + ktok * ZP + ((lsg < 4) ? (256 + h * 64 + lsg * 16) : (512 + h * 64 + (lsg - 4) * 16));
          const u32x4 x0 = ((const u32x4*)src)[0], x1 = ((const u32x4*)src)[1];
          LAS float* dst = ((lsg < 4) ? (Kt + lk * 64 + lsg * 16) : (Vt + lk * 64 + (lsg - 4) * 16));
          *(LAS f32x4*)(dst) = (f32x4){bflo(x0.x), bfhi(x0.x), bflo(x0.y), bfhi(x0.y)}; *(LAS f32x4*)(dst + 4) = (f32x4){bflo(x0.z), bfhi(x0.z), bflo(x0.w), bfhi(x0.w)};
          *(LAS f32x4*)(dst + 8) = (f32x4){bflo(x1.x), bfhi(x1.x), bflo(x1.y), bfhi(x1.y)}; *(LAS f32x4*)(dst + 12) = (f32x4){bflo(x1.z), bfhi(x1.z), bflo(x1.w), bfhi(x1.w)}; }
        __syncthreads();
        const int kmax = t - kt * 64 + 1;
        for (int key = 0; key < 64; ++key) {
            const LAS f32x4* kr = (const LAS f32x4*)(Kt + key * 64 + c * 32);
            float s = 0.f;
#pragma unroll
            for (int i = 0; i < 8; ++i) { const f32x4 kv = kr[i]; s = fmaf(q[4 * i], kv[0], s); s = fmaf(q[4 * i + 1], kv[1], s); s = fmaf(q[4 * i + 2], kv[2], s); s = fmaf(q[4 * i + 3], kv[3], s); }
            const float pe = (key < kmax) ? __expf(s - coff) : 0.f;
            lsum += pe;
            const LAS f32x4* vr = (const LAS f32x4*)(Vt + key * 64 + dvh * 32);
#pragma unroll
            for (int i = 0; i < 8; ++i) { const f32x4 vv = vr[i]; o[4 * i] = fmaf(pe, vv[0], o[4 * i]); o[4 * i + 1] = fmaf(pe, vv[1], o[4 * i + 1]); o[4 * i + 2] = fmaf(pe, vv[2], o[4 * i + 2]); o[4 * i + 3] = fmaf(pe, vv[3], o[4 * i + 3]); }
        }
    }
    const float inv = 1.f / lsum; float ss = 0.f;
#pragma unroll
    for (int i = 0; i < 32; ++i) { const float my = o[i] * inv; const float ot = __shfl_xor(my, 1); o[i] = (c == 0) ? (my - lam * ot) : (ot - lam * my); ss = fmaf(o[i], o[i], ss); }
    ss += __shfl_xor(ss, 2);
    const float rr = (1.f - lam_init) / sqrtf(ss * (1.f / 64.f) + EPS);
    if (c == 0) {
        const float* hg = p.diff_head_norm + l * 64 + dvh * 32; u32x4* dst = (u32x4*)(O0 + tok * 256 + h * 64 + dvh * 32);
#pragma unroll
        for (int i = 0; i < 4; ++i) { u32x4 w; w.x = pk2(o[8 * i] * rr * hg[8 * i], o[8 * i + 1] * rr * hg[8 * i + 1]); w.y = pk2(o[8 * i + 2] * rr * hg[8 * i + 2], o[8 * i + 3] * rr * hg[8 * i + 3]);
            w.z = pk2(o[8 * i + 4] * rr * hg[8 * i + 4], o[8 * i + 5] * rr * hg[8 * i + 5]); w.w = pk2(o[8 * i + 6] * rr * hg[8 * i + 6], o[8 * i + 7] * rr * hg[8 * i + 7]); dst[i] = w; }
    }
    __syncthreads();
}

__device__ __forceinline__ unsigned pkbf(float lo, float hi) { unsigned r; asm("v_cvt_pk_bf16_f32 %0, %1, %2" : "=v"(r) : "v"(lo), "v"(hi)); return r; }
__device__ __forceinline__ void diffm_item(const Params& p, int l, int bh, int qb, LAS unsigned char* lds, int wv) {
    const int tid = tid_fresh(wv), lane = tid & 63, half = lane >> 5, r32 = lane & 31, b = bh >> 2, h = bh & 3;
    const bf16* Z = (const bf16*)(p.ws + WS_BIG); bf16* O0 = (bf16*)(p.ws + WS_O);
    LAS bf16* Ks = (LAS bf16*)lds; LAS bf16* Vt = Ks + 64 * 72;
    const float* lp = p.diff_lambda + l * 128; float s01 = 0.f, s23 = 0.f, gqm = 0.f, gkm = 0.f;
#pragma unroll 2
    for (int i = 0; i < 32; ++i) { s01 = fmaf(lp[i], lp[32 + i], s01); s23 = fmaf(lp[64 + i], lp[96 + i], s23);
        gqm = fmaxf(gqm, fabsf(p.diff_qk_norm[l * 64 + i])); gkm = fmaxf(gkm, fabsf(p.diff_qk_norm[l * 64 + 32 + i])); }
    const float lam_init = 0.8f - 0.6f * __expf(-0.3f * (float)l); const float lam = __expf(s01) - __expf(s23) + lam_init;
    const float coff = 5.65685424949238f * gqm * gkm;
    const int qw = qb * 256 + 32 * wv;
    const size_t tokb = (size_t)b * SEQ;
    s16x8 qf[2][2];
    { const bf16* qp = Z + (tokb + qw + r32) * ZP + h * 64 + half * 8;
#pragma unroll
      for (int c = 0; c < 2; ++c)
#pragma unroll
          for (int s = 0; s < 2; ++s) qf[c][s] = *(const s16x8*)(qp + c * 32 + 16 * s); }
    f32x16 oacc[2][2];
#pragma unroll
    for (int c = 0; c < 2; ++c)
#pragma unroll
        for (int db = 0; db < 2; ++db)
#pragma unroll
            for (int r = 0; r < 16; ++r) oacc[c][db][r] = 0.f;
    float ls0 = 0.f, ls1 = 0.f;
    const int nt = (qb + 1) * 4;
    const int kkey = tid >> 3, kch = tid & 7, vkey = tid & 63, vdc = tid >> 6;
    const bf16* kgp = Z + (tokb + kkey) * ZP + 256 + h * 64 + kch * 8;
    const bf16* vgp = Z + (tokb + vkey) * ZP + 512 + h * 64 + vdc * 8;
    u32x4 kreg = *(const u32x4*)kgp, vreg = *(const u32x4*)vgp;
#pragma unroll 1
    for (int t = 0; t < nt; ++t) {
        __syncthreads();
        *(LAS u32x4*)(Ks + kkey * 72 + kch * 8) = kreg;
        { LAS bf16* vd = Vt + (vdc * 8) * 72 + vkey;
          vd[0] = (bf16)(vreg.x & 0xffffu); vd[72] = (bf16)(vreg.x >> 16); vd[144] = (bf16)(vreg.y & 0xffffu); vd[216] = (bf16)(vreg.y >> 16);
          vd[288] = (bf16)(vreg.z & 0xffffu); vd[360] = (bf16)(vreg.z >> 16); vd[432] = (bf16)(vreg.w & 0xffffu); vd[504] = (bf16)(vreg.w >> 16); }
        __syncthreads();
        if (t + 1 < nt) { kreg = *(const u32x4*)(kgp + (size_t)(t + 1) * 64 * ZP); vreg = *(const u32x4*)(vgp + (size_t)(t + 1) * 64 * ZP); }
        const int k0 = t * 64;
#pragma unroll 1
        for (int sub = 0; sub < 2; ++sub) {
            const int kb = k0 + 32 * sub;
            if (kb <= qw + 31) {
                f32x16 s0, s1;
#pragma unroll
                for (int r = 0; r < 16; ++r) { s0[r] = 0.f; s1[r] = 0.f; }
                const LAS bf16* kr = Ks + (32 * sub + r32) * 72 + 8 * half;
#pragma unroll
                for (int s = 0; s < 2; ++s) {
                    const s16x8 a0 = *(const LAS s16x8*)(kr + 16 * s), a1 = *(const LAS s16x8*)(kr + 32 + 16 * s);
                    s0 = __builtin_amdgcn_mfma_f32_32x32x16_bf16(a0, qf[0][s], s0, 0, 0, 0);
                    s1 = __builtin_amdgcn_mfma_f32_32x32x16_bf16(a1, qf[1][s], s1, 0, 0, 0);
                }
                const bool diag = (kb + 31 > qw);
#pragma unroll
                for (int r = 0; r < 16; ++r) {
                    float p0 = __expf(s0[r] - coff), p1 = __expf(s1[r] - coff);
                    if (diag) { const int key = kb + 8 * (r >> 2) + 4 * half + (r & 3); if (key > qw + r32) { p0 = 0.f; p1 = 0.f; } }
                    ls0 += p0; ls1 += p1; s0[r] = p0; s1[r] = p1;
                }
#pragma unroll
                for (int s = 0; s < 2; ++s) {
                    u32x4 w0, w1;
                    w0.x = pkbf(s0[8 * s], s0[8 * s + 1]); w0.y = pkbf(s0[8 * s + 2], s0[8 * s + 3]); w0.z = pkbf(s0[8 * s + 4], s0[8 * s + 5]); w0.w = pkbf(s0[8 * s + 6], s0[8 * s + 7]);
                    w1.x = pkbf(s1[8 * s], s1[8 * s + 1]); w1.y = pkbf(s1[8 * s + 2], s1[8 * s + 3]); w1.z = pkbf(s1[8 * s + 4], s1[8 * s + 5]); w1.w = pkbf(s1[8 * s + 6], s1[8 * s + 7]);
                    const s16x8 pf0 = __builtin_bit_cast(s16x8, w0), pf1 = __builtin_bit_cast(s16x8, w1);
#pragma unroll
                    for (int db = 0; db < 2; ++db) {
                        const LAS bf16* vr = Vt + (db * 32 + r32) * 72 + 32 * sub + 16 * s + 4 * half;
                        const u32x2 v0 = *(const LAS u32x2*)vr, v1 = *(const LAS u32x2*)(vr + 8);
                        const u32x4 vv = (u32x4){v0.x, v0.y, v1.x, v1.y};
                        const s16x8 vf = __builtin_bit_cast(s16x8, vv);
                        oacc[0][db] = __builtin_amdgcn_mfma_f32_32x32x16_bf16(vf, pf0, oacc[0][db], 0, 0, 0);
                        oacc[1][db] = __builtin_amdgcn_mfma_f32_32x32x16_bf16(vf, pf1, oacc[1][db], 0, 0, 0);
                    }
                }
            }
        }
    }
    ls0 += __shfl_xor(ls0, 32); ls1 += __shfl_xor(ls1, 32);
    const float i0 = 1.f / ls0, i1 = lam / ls1;
    float ss = 0.f;
#pragma unroll
    for (int db = 0; db < 2; ++db)
#pragma unroll
        for (int r = 0; r < 16; ++r) { const float v = oacc[0][db][r] * i0 - oacc[1][db][r] * i1; oacc[0][db][r] = v; ss = fmaf(v, v, ss); }
    ss += __shfl_xor(ss, 32);
    const float rr = (1.f - lam_init) / sqrtf(ss * (1.f / 64.f) + EPS);
    const float* hg = p.diff_head_norm + l * 64;
    bf16* orow = O0 + (tokb + qw + r32) * 256 + h * 64;
#pragma unroll
    for (int db = 0; db < 2; ++db)
#pragma unroll
        for (int g = 0; g < 4; ++g) { const int d0 = db * 32 + 8 * g + 4 * half; const f32x4 gg = *(const f32x4*)(hg + d0);
            u32x2 w; w.x = pkbf(oacc[0][db][4 * g] * rr * gg[0], oacc[0][db][4 * g + 1] * rr * gg[1]); w.y = pkbf(oacc[0][db][4 * g + 2] * rr * gg[2], oacc[0][db][4 * g + 3] * rr * gg[3]);
            *(u32x2*)(orow + d0) = w; }
    __syncthreads();
}

__device__ __forceinline__ void sb_item(const Params& p, int bh, int g, LAS unsigned char* lds, int wv) {
    const int tid = tid_fresh(wv), lane = tid & 63, w = tid >> 6, b = bh >> 2, h = bh & 3;
    const bf16* Z = (const bf16*)(p.ws + WS_BIG); bf16* O2 = (bf16*)(p.ws + WS_O + 2 * OB_STRIDE);
    LAS float* KV = (LAS float*)lds + w * 4096;
    const int t0 = g * 512 + w * 64, t = t0 + lane; const size_t tok = (size_t)b * SEQ + t;
    float q[64], o[64];
    { const u32x4* qp = (const u32x4*)(Z + tok * ZP + 1792 + h * 64);
#pragma unroll
      for (int i = 0; i < 8; ++i) { const u32x4 x = qp[i]; q[8 * i] = bflo(x.x); q[8 * i + 1] = bfhi(x.x); q[8 * i + 2] = bflo(x.y); q[8 * i + 3] = bfhi(x.y); q[8 * i + 4] = bflo(x.z); q[8 * i + 5] = bfhi(x.z); q[8 * i + 6] = bflo(x.w); q[8 * i + 7] = bfhi(x.w); } }
#pragma unroll
    for (int i = 0; i < 64; ++i) o[i] = 0.f;
    float R = 0.f;
    const int lkey = lane >> 1, lhalf = lane & 1;
    for (int slo = t0 + 32; slo >= 0; slo -= 32) {
        asm volatile("s_waitcnt lgkmcnt(0)" ::: "memory");
        { const size_t ktok = (size_t)b * SEQ + slo + lkey;
          const u32x4* ks = (const u32x4*)(Z + ktok * ZP + 2048 + h * 64 + lhalf * 32); const u32x4* vs = (const u32x4*)(Z + ktok * ZP + 2304 + h * 64 + lhalf * 32);
          LAS float* kd = KV + lkey * 128 + lhalf * 32; LAS float* vd = kd + 64;
#pragma unroll
          for (int i = 0; i < 4; ++i) { const u32x4 x = ks[i]; *(LAS f32x4*)(kd + 8 * i) = (f32x4){bflo(x.x), bfhi(x.x), bflo(x.y), bfhi(x.y)}; *(LAS f32x4*)(kd + 8 * i + 4) = (f32x4){bflo(x.z), bfhi(x.z), bflo(x.w), bfhi(x.w)}; }
#pragma unroll
          for (int i = 0; i < 4; ++i) { const u32x4 x = vs[i]; *(LAS f32x4*)(vd + 8 * i) = (f32x4){bflo(x.x), bfhi(x.x), bflo(x.y), bfhi(x.y)}; *(LAS f32x4*)(vd + 8 * i + 4) = (f32x4){bflo(x.z), bfhi(x.z), bflo(x.w), bfhi(x.w)}; } }
        asm volatile("s_waitcnt lgkmcnt(0)" ::: "memory");
        for (int kk = 31; kk >= 0; --kk) {
            const int s = slo + kk; const bool act = s < t;
            const LAS f32x4* kr = (const LAS f32x4*)(KV + kk * 128);
            float z = 0.f;
#pragma unroll
            for (int i = 0; i < 16; ++i) { const f32x4 kv = kr[i]; z = fmaf(q[4 * i], kv[0], z); z = fmaf(q[4 * i + 1], kv[1], z); z = fmaf(q[4 * i + 2], kv[2], z); z = fmaf(q[4 * i + 3], kv[3], z); }
            z *= 0.125f;
            const float lb = fminf(z, 0.f) - __logf(1.f + __expf(-fabsf(z)));
            const float a = act ? __expf(lb + R) : 0.f;
            R += act ? (lb - z) : 0.f;
#pragma unroll
            for (int i = 0; i < 16; ++i) { const f32x4 vv = kr[16 + i]; o[4 * i] = fmaf(a, vv[0], o[4 * i]); o[4 * i + 1] = fmaf(a, vv[1], o[4 * i + 1]); o[4 * i + 2] = fmaf(a, vv[2], o[4 * i + 2]); o[4 * i + 3] = fmaf(a, vv[3], o[4 * i + 3]); }
        }
        if (__all(R < -104.f)) break;
    }
    u32x4* dst = (u32x4*)(O2 + tok * 256 + h * 64);
#pragma unroll
    for (int i = 0; i < 8; ++i) { u32x4 x; x.x = pk2(o[8 * i], o[8 * i + 1]); x.y = pk2(o[8 * i + 2], o[8 * i + 3]); x.z = pk2(o[8 * i + 4], o[8 * i + 5]); x.w = pk2(o[8 * i + 6], o[8 * i + 7]); dst[i] = x; }
    asm volatile("s_waitcnt lgkmcnt(0)" ::: "memory");
}
constexpr size_t WS_MLS = 460 * MiB, WS_DEC = WS_MLS + 5 * 32 * 4096 * 4, WS_UN = 463 * MiB, WS_NV = WS_UN + 512 * 1024, WS_UT = 464 * MiB, WS_CT = 496 * MiB, WS_END2 = 512 * MiB;
constexpr int MLN = 32 * 4096;
__device__ __forceinline__ void ml_prepass(const Params& p, int l, int bh, int lane) {
    const int b = bh >> 2, h = bh & 3; const float* ZS = (const float*)(p.ws + WS_ZS);
    float* MLS = (float*)(p.ws + WS_MLS); float* DEC = (float*)(p.ws + WS_DEC);
    const float gb_i = p.ml_gate_bias[(l * 2 + 0) * 4 + h], gb_f = p.ml_gate_bias[(l * 2 + 1) * 4 + h];
    float cA = 0.f, cB = 0.f;
#pragma unroll 1
    for (int c4 = 0; c4 < 16; ++c4) {
        float igv[4], fzv[4];
#pragma unroll
        for (int k = 0; k < 4; ++k) { const size_t tok = (size_t)b * SEQ + (c4 * 4 + k) * 64 + lane; igv[k] = ZS[tok * ZSP + 168 + h]; fzv[k] = ZS[tok * ZSP + 172 + h]; }
#pragma unroll
        for (int k = 0; k < 4; ++k) {
            const int c = c4 * 4 + k;
            const float ig = igv[k] + gb_i, fz = fzv[k] + gb_f;
            const float lf = fminf(fz, 0.f) - __logf(1.f + __expf(-fabsf(fz)));
            float bsum = lf;
#pragma unroll
            for (int d = 1; d < 64; d <<= 1) { const float n = __shfl_up(bsum, d); if (lane >= d) bsum += n; }
            const float bl = __shfl(bsum, 63);
            const float a = ig - bsum;
            float pm = a;
#pragma unroll
            for (int d = 1; d < 64; d <<= 1) { const float n = __shfl_up(pm, d); if (lane >= d) pm = fmaxf(pm, n); }
            const float gmax = bl + __shfl(pm, 63);
            const int ti = bh * 4096 + c * 64 + lane;
            MLS[ti] = bsum; MLS[MLN + ti] = a; MLS[2 * MLN + ti] = pm;
            cA = (lane == c) ? bl : cA; cB = (lane == c) ? gmax : cB;
        }
    }
    float sA = cA, sB = cB;
#pragma unroll
    for (int d = 1; d < 64; d <<= 1) { const float pA = __shfl_up(sA, d), pB = __shfl_up(sB, d); if (lane >= d) { sB = fmaxf(pB + sA, sB); sA = pA + sA; } }
    const float m_out = fmaxf(sA, sB);
    float m_in = __shfl_up(m_out, 1); if (lane == 0) m_in = 0.f;
    DEC[bh * 64 + lane] = __expf(cA + m_in - m_out);
    asm volatile("s_waitcnt vmcnt(0)" ::: "memory");
#pragma unroll 1
    for (int c4 = 0; c4 < 16; ++c4) {
        float bsv[4], av[4], pmv[4];
#pragma unroll
        for (int k = 0; k < 4; ++k) { const int ti = bh * 4096 + (c4 * 4 + k) * 64 + lane; bsv[k] = MLS[ti]; av[k] = MLS[MLN + ti]; pmv[k] = MLS[2 * MLN + ti]; }
#pragma unroll
        for (int k = 0; k < 4; ++k) {
            const int c = c4 * 4 + k;
            const float mi = __shfl(m_in, c), mo = __shfl(m_out, c), bl = __shfl(cA, c);
            const int ti = bh * 4096 + c * 64 + lane;
            const float mt = bsv[k] + fmaxf(mi, pmv[k]);
            MLS[2 * MLN + ti] = mt; MLS[3 * MLN + ti] = __expf(bl + av[k] - mo); MLS[4 * MLN + ti] = __expf(bsv[k] + mi - mt);
        }
    }
}
__device__ __forceinline__ void ml_conv8(const bf16* Z, const float* cw, const float* cb, int b, int t, int ch0, float (&y)[8]) {
    const f32x4 b0 = *(const f32x4*)(cb + ch0), b1 = *(const f32x4*)(cb + ch0 + 4);
    y[0] = b0[0]; y[1] = b0[1]; y[2] = b0[2]; y[3] = b0[3]; y[4] = b1[0]; y[5] = b1[1]; y[6] = b1[2]; y[7] = b1[3];
#pragma unroll
    for (int j = 0; j < 4; ++j) {
        const int tt = t - 3 + j;
        if (tt >= 0) {
            const u32x4 x = *(const u32x4*)(Z + ((size_t)b * SEQ + tt) * ZP + 768 + ch0);
            const f32x4 w0 = *(const f32x4*)(cw + j * 512 + ch0), w1 = *(const f32x4*)(cw + j * 512 + ch0 + 4);
            y[0] = fmaf(w0[0], bflo(x.x), y[0]); y[1] = fmaf(w0[1], bfhi(x.x), y[1]); y[2] = fmaf(w0[2], bflo(x.y), y[2]); y[3] = fmaf(w0[3], bfhi(x.y), y[3]);
            y[4] = fmaf(w1[0], bflo(x.z), y[4]); y[5] = fmaf(w1[1], bfhi(x.z), y[5]); y[6] = fmaf(w1[2], bflo(x.w), y[6]); y[7] = fmaf(w1[3], bfhi(x.w), y[7]);
        }
    }
#pragma unroll
    for (int i = 0; i < 8; ++i) y[i] = y[i] * sigmoidf_(y[i]);
}
__device__ __forceinline__ void mlB_item(const Params& p, int l, int bh, int ci, LAS unsigned char* lds, int wv) {
    const int tid = tid_fresh(wv), lane = tid & 63, half = lane >> 5, r32 = lane & 31, b = bh >> 2, h = bh & 3;
    const bf16* Z = (const bf16*)(p.ws + WS_BIG); const float* MLS = (const float*)(p.ws + WS_MLS);
    float* UT = (float*)(p.ws + WS_UT); float* UN = (float*)(p.ws + WS_UN);
    LAS bf16* KT = (LAS bf16*)lds; LAS bf16* VT = KT + 4 * 64 * 72;
    const float* cw = p.ml_conv_w + (size_t)l * 4 * 512; const float* cb = p.ml_conv_b + (size_t)l * 512;
    __syncthreads();
    {
        const int tt = tid >> 1, hr = tid & 1, cl = tt >> 6, s = tt & 63, t = (ci * 4) * 64 + tt;
        const float wk = MLS[3 * MLN + bh * 4096 + t];
#pragma unroll 1
        for (int q8 = 0; q8 < 4; ++q8) {
            const int d0 = hr * 32 + q8 * 8; float y[8];
            ml_conv8(Z, cw, cb, b, t, 256 + h * 64 + d0, y);
            LAS bf16* dst = KT + (cl * 64 + d0) * 72 + s;
#pragma unroll
            for (int i = 0; i < 8; ++i) dst[i * 72] = (bf16)f2bf(y[i] * wk);
            const u32x4 v = *(const u32x4*)(Z + ((size_t)b * SEQ + t) * ZP + 1280 + h * 64 + d0);
            LAS bf16* vd = VT + (cl * 64 + d0) * 72 + s;
            vd[0] = (bf16)(v.x & 0xffffu); vd[72] = (bf16)(v.x >> 16); vd[144] = (bf16)(v.y & 0xffffu); vd[216] = (bf16)(v.y >> 16);
            vd[288] = (bf16)(v.z & 0xffffu); vd[360] = (bf16)(v.z >> 16); vd[432] = (bf16)(v.w & 0xffffu); vd[504] = (bf16)(v.w >> 16);
        }
    }
    __syncthreads();
    const int cl = wv >> 1, dh = wv & 1, c = ci * 4 + cl;
    f32x16 acc[2];
#pragma unroll
    for (int eb = 0; eb < 2; ++eb)
#pragma unroll
        for (int r = 0; r < 16; ++r) acc[eb][r] = 0.f;
#pragma unroll
    for (int s4 = 0; s4 < 4; ++s4) {
        const s16x8 bk = *(const LAS s16x8*)(KT + (cl * 64 + dh * 32 + r32) * 72 + 16 * s4 + 8 * half);
#pragma unroll
        for (int eb = 0; eb < 2; ++eb) {
            const s16x8 av = *(const LAS s16x8*)(VT + (cl * 64 + eb * 32 + r32) * 72 + 16 * s4 + 8 * half);
            acc[eb] = __builtin_amdgcn_mfma_f32_32x32x16_bf16(av, bk, acc[eb], 0, 0, 0);
        }
    }
    float* ut = UT + ((size_t)(bh * 64 + c) * 64) * 64;
#pragma unroll
    for (int eb = 0; eb < 2; ++eb)
#pragma unroll
        for (int r = 0; r < 16; ++r) { const int e = eb * 32 + 8 * (r >> 2) + 4 * half + (r & 3); ut[e * 64 + dh * 32 + r32] = acc[eb][r]; }
    {
        const LAS bf16* kr = KT + (cl * 64 + dh * 32 + r32) * 72 + half * 32; float sm = 0.f;
#pragma unroll
        for (int i = 0; i < 4; ++i) { const u32x4 x = *(const LAS u32x4*)(kr + 8 * i); sm += (bflo(x.x) + bfhi(x.x)) + (bflo(x.y) + bfhi(x.y)) + (bflo(x.z) + bfhi(x.z)) + (bflo(x.w) + bfhi(x.w)); }
        sm += __shfl_xor(sm, 32);
        if (half == 0) UN[(bh * 64 + c) * 64 + dh * 32 + r32] = sm;
    }
}
__device__ __forceinline__ void mlS_item(const Params& p, int bh, int wv) {
    const int tid = tid_fresh(wv);
    const float* UT = (const float*)(p.ws + WS_UT) + (size_t)bh * 64 * 4096; const float* UN = (const float*)(p.ws + WS_UN) + bh * 4096;
    bf16* CT = (bf16*)(p.ws + WS_CT) + (size_t)bh * 64 * 4096; float* NV = (float*)(p.ws + WS_NV) + bh * 4096; const float* DEC = (const float*)(p.ws + WS_DEC) + bh * 64;
    f32x4 s0 = (f32x4){0.f, 0.f, 0.f, 0.f}, s1 = s0; float ns = 0.f;
#pragma unroll 4
    for (int c = 0; c < 64; ++c) {
        const float dec = DEC[c];
        const f32x4 u0 = *(const f32x4*)(UT + (size_t)c * 4096 + tid * 8), u1 = *(const f32x4*)(UT + (size_t)c * 4096 + tid * 8 + 4);
        u32x4 w; w.x = pk2(s0[0], s0[1]); w.y = pk2(s0[2], s0[3]); w.z = pk2(s1[0], s1[1]); w.w = pk2(s1[2], s1[3]);
        *(u32x4*)(CT + (size_t)c * 4096 + tid * 8) = w;
        s0 = s0 * dec + u0; s1 = s1 * dec + u1;
        if (tid < 64) { NV[c * 64 + tid] = ns; ns = ns * dec + UN[c * 64 + tid]; }
    }
}
__device__ __forceinline__ void mlD_item(const Params& p, int l, int bh, int ci, LAS unsigned char* lds, int wv) {
    const int tid = tid_fresh(wv), lane = tid & 63, half = lane >> 5, r32 = lane & 31, b = bh >> 2, h = bh & 3;
    const bf16* Z = (const bf16*)(p.ws + WS_BIG); const float* MLS = (const float*)(p.ws + WS_MLS); bf16* O1 = (bf16*)(p.ws + WS_O + OB_STRIDE);
    LAS bf16* Qs = (LAS bf16*)lds; LAS bf16* Ks = Qs + 4 * 64 * 72; LAS bf16* VT = Ks + 4 * 64 * 72;
    const float* cw = p.ml_conv_w + (size_t)l * 4 * 512; const float* cb = p.ml_conv_b + (size_t)l * 512;
    __syncthreads();
    {
        const int tt = tid >> 1, hr = tid & 1, cl = tt >> 6, s = tt & 63, t = (ci * 4) * 64 + tt;
#pragma unroll 1
        for (int q8 = 0; q8 < 4; ++q8) {
            const int d0 = hr * 32 + q8 * 8; float y[8];
            ml_conv8(Z, cw, cb, b, t, h * 64 + d0, y);
            u32x4 w; w.x = pk2(y[0] * 0.125f, y[1] * 0.125f); w.y = pk2(y[2] * 0.125f, y[3] * 0.125f); w.z = pk2(y[4] * 0.125f, y[5] * 0.125f); w.w = pk2(y[6] * 0.125f, y[7] * 0.125f);
            *(LAS u32x4*)(Qs + (cl * 64 + s) * 72 + d0) = w;
            ml_conv8(Z, cw, cb, b, t, 256 + h * 64 + d0, y);
            w.x = pk2(y[0], y[1]); w.y = pk2(y[2], y[3]); w.z = pk2(y[4], y[5]); w.w = pk2(y[6], y[7]);
            *(LAS u32x4*)(Ks + (cl * 64 + s) * 72 + d0) = w;
            const u32x4 v = *(const u32x4*)(Z + ((size_t)b * SEQ + t) * ZP + 1280 + h * 64 + d0);
            LAS bf16* vd = VT + (cl * 64 + d0) * 72 + s;
            vd[0] = (bf16)(v.x & 0xffffu); vd[72] = (bf16)(v.x >> 16); vd[144] = (bf16)(v.y & 0xffffu); vd[216] = (bf16)(v.y >> 16);
            vd[288] = (bf16)(v.z & 0xffffu); vd[360] = (bf16)(v.z >> 16); vd[432] = (bf16)(v.w & 0xffffu); vd[504] = (bf16)(v.w >> 16);
        }
    }
    __syncthreads();
    const int cl = wv >> 1, th = wv & 1, c = ci * 4 + cl, tloc = th * 32 + r32, tseq = c * 64 + tloc;
    const int ti = bh * 4096 + tseq;
    const float bs_t = MLS[ti], mt_t = MLS[2 * MLN + ti], iw_t = MLS[4 * MLN + ti];
    s16x8 qf[4];
#pragma unroll
    for (int s4 = 0; s4 < 4; ++s4) qf[s4] = *(const LAS s16x8*)(Qs + (cl * 64 + tloc) * 72 + 16 * s4 + 8 * half);
    f32x16 oacc[2];
#pragma unroll
    for (int eb = 0; eb < 2; ++eb)
#pragma unroll
        for (int r = 0; r < 16; ++r) oacc[eb][r] = 0.f;
    const bf16* CT = (const bf16*)(p.ws + WS_CT) + (size_t)(bh * 64 + c) * 4096;
#pragma unroll
    for (int s4 = 0; s4 < 4; ++s4)
#pragma unroll
        for (int eb = 0; eb < 2; ++eb) { const s16x8 ac = *(const s16x8*)(CT + (eb * 32 + r32) * 64 + 16 * s4 + 8 * half);
            oacc[eb] = __builtin_amdgcn_mfma_f32_32x32x16_bf16(ac, qf[s4], oacc[eb], 0, 0, 0); }
#pragma unroll
    for (int eb = 0; eb < 2; ++eb)
#pragma unroll
        for (int r = 0; r < 16; ++r) oacc[eb][r] *= iw_t;
    float qn = 0.f;
    { const float* nvp = (const float*)(p.ws + WS_NV) + (bh * 64 + c) * 64;
#pragma unroll
      for (int s4 = 0; s4 < 4; ++s4) { const f32x4 n0 = *(const f32x4*)(nvp + 16 * s4 + 8 * half), n1 = *(const f32x4*)(nvp + 16 * s4 + 8 * half + 4);
          const u32x4 qq = __builtin_bit_cast(u32x4, qf[s4]);
          qn += bflo(qq.x) * n0[0] + bfhi(qq.x) * n0[1] + bflo(qq.y) * n0[2] + bfhi(qq.y) * n0[3] + bflo(qq.z) * n1[0] + bfhi(qq.z) * n1[1] + bflo(qq.w) * n1[2] + bfhi(qq.w) * n1[3]; } }
    qn += __shfl_xor(qn, 32);
    float rs = 0.f;
#pragma unroll
    for (int sb = 0; sb < 2; ++sb) {
        if (sb <= th) {
            f32x16 sacc;
#pragma unroll
            for (int r = 0; r < 16; ++r) sacc[r] = 0.f;
#pragma unroll
            for (int s4 = 0; s4 < 4; ++s4) { const s16x8 ak = *(const LAS s16x8*)(Ks + (cl * 64 + sb * 32 + r32) * 72 + 16 * s4 + 8 * half);
                sacc = __builtin_amdgcn_mfma_f32_32x32x16_bf16(ak, qf[s4], sacc, 0, 0, 0); }
            const float* ap = MLS + MLN + bh * 4096 + c * 64 + sb * 32 + 4 * half;
#pragma unroll
            for (int g = 0; g < 4; ++g) { const f32x4 av = *(const f32x4*)(ap + 8 * g);
#pragma unroll
                for (int i = 0; i < 4; ++i) { const int s = sb * 32 + 8 * g + 4 * half + i; const float v = (s <= tloc) ? sacc[4 * g + i] * __expf(bs_t + av[i] - mt_t) : 0.f; sacc[4 * g + i] = v; rs += v; } }
#pragma unroll
            for (int s2 = 0; s2 < 2; ++s2) {
                u32x4 w; w.x = pkbf(sacc[8 * s2], sacc[8 * s2 + 1]); w.y = pkbf(sacc[8 * s2 + 2], sacc[8 * s2 + 3]); w.z = pkbf(sacc[8 * s2 + 4], sacc[8 * s2 + 5]); w.w = pkbf(sacc[8 * s2 + 6], sacc[8 * s2 + 7]);
                const s16x8 pf = __builtin_bit_cast(s16x8, w);
#pragma unroll
                for (int eb = 0; eb < 2; ++eb) {
                    const LAS bf16* vr = VT + (cl * 64 + eb * 32 + r32) * 72 + sb * 32 + 16 * s2 + 4 * half;
                    const u32x2 v0 = *(const LAS u32x2*)vr, v1 = *(const LAS u32x2*)(vr + 8);
                    const u32x4 vv = (u32x4){v0.x, v0.y, v1.x, v1.y};
                    oacc[eb] = __builtin_amdgcn_mfma_f32_32x32x16_bf16(__builtin_bit_cast(s16x8, vv), pf, oacc[eb], 0, 0, 0);
                }
            }
        }
    }
    rs += __shfl_xor(rs, 32);
    const float den = iw_t * qn + rs;
    const float dn = 1.f / fmaxf(fabsf(den), __expf(-mt_t));
    float ss = 0.f;
#pragma unroll
    for (int eb = 0; eb < 2; ++eb)
#pragma unroll
        for (int r = 0; r < 16; ++r) { const float v = oacc[eb][r] * dn; oacc[eb][r] = v; ss = fmaf(v, v, ss); }
    ss += __shfl_xor(ss, 32);
    const float rr = 1.f / sqrtf(ss * (1.f / 64.f) + EPS);
    const size_t tok = (size_t)b * SEQ + tseq;
    const float* hg = p.ml_head_norm + l * 64;
#pragma unroll
    for (int eb = 0; eb < 2; ++eb)
#pragma unroll
        for (int g = 0; g < 4; ++g) { const int e0 = eb * 32 + 8 * g + 4 * half; const f32x4 gg = *(const f32x4*)(hg + e0);
            const u32x2 og = *(const u32x2*)(Z + tok * ZP + 1536 + h * 64 + e0);
            u32x2 w; w.x = pkbf(sigmoidf_(bflo(og.x)) * oacc[eb][4 * g] * rr * gg[0], sigmoidf_(bfhi(og.x)) * oacc[eb][4 * g + 1] * rr * gg[1]);
            w.y = pkbf(sigmoidf_(bflo(og.y)) * oacc[eb][4 * g + 2] * rr * gg[2], sigmoidf_(bfhi(og.y)) * oacc[eb][4 * g + 3] * rr * gg[3]);
            *(u32x2*)(O1 + tok * 256 + h * 64 + e0) = w; }
}
__device__ __forceinline__ float relu_(float x) { return __builtin_amdgcn_fmed3f(x, 0.f, __builtin_inff()); }
__device__ __forceinline__ unsigned key16(float s) { const float f = __builtin_amdgcn_fmed3f(floorf(fmaf(s, 512.f, 32768.f)), 0.f, 65535.f); return (unsigned)f; }
__device__ __forceinline__ unsigned mono_bits(float s) { s = (s == 0.f) ? 0.f : s; const unsigned u = __float_as_uint(s); return (u & 0x80000000u) ? ~u : (u | 0x80000000u); }
__device__ __forceinline__ void dsa_item(const Params& p, int lds_l, int b, int qt, LAS unsigned char* lds, int wv) {
    const int tid = tid_fresh(wv), lane = tid & 63, w = wv, half = lane >> 5, r32 = lane & 31;
    const bf16* Z = (const bf16*)(p.ws + WS_BIG); const float* ZS = (const float*)(p.ws + WS_ZS); const bf16* IK = (const bf16*)(p.ws + WS_IK); bf16* O3 = (bf16*)(p.ws + WS_O + 3 * OB_STRIDE);
    LAS unsigned* hist = (LAS unsigned*)lds + w * 1024;
    LAS unsigned* maskw = (LAS unsigned*)(lds + 32768);
    LAS bf16* KC = (LAS bf16*)(lds + 49152);
    LAS bf16* Kd = (LAS bf16*)(lds + 81920); LAS bf16* VTd = Kd + 64 * 72;
    const size_t tokb = (size_t)b * SEQ; const int tb = qt * 32 + 4 * w;
    const int ntiles = qt + 1, nkeys = ntiles * 32, nchunks = (ntiles + 15) >> 4;
    s16x8 aq0, aq1;
    { const bf16* ap = Z + (tokb + tb + (r32 >> 3)) * ZP + 2816 + (r32 & 7) * 32 + half * 8; aq0 = *(const s16x8*)ap; aq1 = *(const s16x8*)(ap + 16); }
    float wq[4][4];
#pragma unroll
    for (int g = 0; g < 4; ++g) { const f32x4 x = *(const f32x4*)(ZS + (tokb + tb + g) * ZSP + 160 + 4 * half); wq[g][0] = x[0]; wq[g][1] = x[1]; wq[g][2] = x[2]; wq[g][3] = x[3]; }
    unsigned tau[4], prefix[4]; int quota[4], krem[4], eqseen[4]; bool allsel[4];
    LAS unsigned* cand = (LAS unsigned*)(lds + 100352) + w * 1024;
    LAS unsigned* oflag = (LAS unsigned*)(lds + LDS_BYTES - 48);
    const unsigned lowmask = (1u << r32) - 1u;
#define DSA_SCORES(ktl, sc) do { const LAS bf16* kp_ = KC + ((ktl) * 32 + r32) * 32 + half * 8; \
        const s16x8 b0_ = *(const LAS s16x8*)kp_, b1_ = *(const LAS s16x8*)(kp_ + 16); f32x16 a_ = {0.f, 0.f, 0.f, 0.f, 0.f, 0.f, 0.f, 0.f, 0.f, 0.f, 0.f, 0.f, 0.f, 0.f, 0.f, 0.f}; \
        a_ = __builtin_amdgcn_mfma_f32_32x32x16_bf16(aq0, b0_, a_, 0, 0, 0); a_ = __builtin_amdgcn_mfma_f32_32x32x16_bf16(aq1, b1_, a_, 0, 0, 0); \
        _Pragma("unroll") for (int g_ = 0; g_ < 4; ++g_) { float pt_ = wq[g_][0] * relu_(a_[4 * g_]); pt_ = fmaf(wq[g_][1], relu_(a_[4 * g_ + 1]), pt_); \
            pt_ = fmaf(wq[g_][2], relu_(a_[4 * g_ + 2]), pt_); pt_ = fmaf(wq[g_][3], relu_(a_[4 * g_ + 3]), pt_); sc[g_] = pt_ + __shfl_xor(pt_, 32); } } while (0)
    int mode = (qt >= 8) ? 0 : 1;
#pragma unroll 1
    for (int attempt = 0; attempt < 2; ++attempt) {
        const int npass = (qt >= 8) ? (mode ? 4 : 2) : 0;
#pragma unroll
        for (int g = 0; g < 4; ++g) { tau[g] = 0u; prefix[g] = 0u; quota[g] = 1 << 30; krem[g] = 256; eqseen[g] = 0; allsel[g] = true; }
        if (tid == 0) *oflag = 0u;
#pragma unroll 1
        for (int pass = 0; pass <= npass; ++pass) {
            const bool comp = (pass == npass);
            const int shift = 8 * (npass - 1 - pass);
            if (!comp) {
#pragma unroll
                for (int i = 0; i < 4; ++i) *(LAS u32x4*)(hist + (i * 64 + lane) * 4) = (u32x4){0u, 0u, 0u, 0u};
            }
            const unsigned pfa = half ? prefix[2] : prefix[0], pfb = half ? prefix[3] : prefix[1];
            const int ta = tb + 2 * half, tbq = ta + 1;
            u32x4 pre[4];
#pragma unroll
            for (int i = 0; i < 4; ++i) { const int kb = (tid * 16 + i * 8192) >> 6; pre[i] = (kb < nkeys) ? *(const u32x4*)((const unsigned char*)(IK + tokb * 32) + tid * 16 + i * 8192) : (u32x4){0u, 0u, 0u, 0u}; }
#pragma unroll 1
            for (int ch = 0; ch < nchunks; ++ch) {
                __syncthreads();
#pragma unroll
                for (int i = 0; i < 4; ++i) *(LAS u32x4*)((LAS unsigned char*)KC + tid * 16 + i * 8192) = pre[i];
                __syncthreads();
                if (ch + 1 < nchunks) {
#pragma unroll
                    for (int i = 0; i < 4; ++i) { const int kb = (ch + 1) * 512 + ((tid * 16 + i * 8192) >> 6);
                        pre[i] = (kb < nkeys) ? *(const u32x4*)((const unsigned char*)(IK + (tokb + (size_t)(ch + 1) * 512) * 32) + tid * 16 + i * 8192) : (u32x4){0u, 0u, 0u, 0u}; }
                }
                const int nt = min(16, ntiles - ch * 16);
                if (!comp) {
#pragma unroll 2
                    for (int ktl = 0; ktl < nt; ++ktl) {
                        float sc[4]; DSA_SCORES(ktl, sc);
                        const int key = (ch * 16 + ktl) * 32 + r32;
                        const float sa = half ? sc[2] : sc[0], sb = half ? sc[3] : sc[1];
                        const unsigned ma = mode ? mono_bits(sa) : key16(sa), mb = mode ? mono_bits(sb) : key16(sb);
                        const bool oka = (key <= ta) && (pass == 0 || (ma >> (shift + 8)) == pfa);
                        const bool okb = (key <= tbq) && (pass == 0 || (mb >> (shift + 8)) == pfb);
                        if (oka) __hip_atomic_fetch_add(hist + (2 * half) * 256 + ((ma >> shift) & 255u), 1u, __ATOMIC_RELAXED, __HIP_MEMORY_SCOPE_WORKGROUP);
                        if (okb) __hip_atomic_fetch_add(hist + (2 * half + 1) * 256 + ((mb >> shift) & 255u), 1u, __ATOMIC_RELAXED, __HIP_MEMORY_SCOPE_WORKGROUP);
                    }
                } else {
#pragma unroll 1
                    for (int ktl = 0; ktl < nt; ++ktl) {
                        float sc[4]; DSA_SCORES(ktl, sc);
                        const int key = (ch * 16 + ktl) * 32 + r32;
#pragma unroll
                        for (int g = 0; g < 4; ++g) {
                            const unsigned mex = mono_bits(sc[g]); const unsigned m = mode ? mex : key16(sc[g]); const bool valid = key <= tb + g;
                            const bool eq = valid && (m == tau[g]);
                            const unsigned beq = (unsigned)__ballot(eq);
                            const int rank = eqseen[g] + __popc(beq & lowmask);
                            const bool takeeq = mode ? (rank < quota[g]) : allsel[g];
                            const bool sel = valid && ((m > tau[g]) || (eq && takeeq));
                            const unsigned bsel = (unsigned)__ballot(sel);
                            if (lane == 0) maskw[(4 * w + g) * 128 + ch * 16 + ktl] = bsel;
                            if (mode == 0 && !allsel[g] && eq && half == 0 && rank < 128) { cand[(g * 128 + rank) * 2] = mex; cand[(g * 128 + rank) * 2 + 1] = (unsigned)key; }
                            eqseen[g] += __popc(beq);
                        }
                    }
                }
            }
            if (!comp) {
                LDS_WAIT();
#pragma unroll
                for (int g = 0; g < 4; ++g) {
                    const u32x4 cv = *(const LAS u32x4*)(hist + g * 256 + lane * 4);
                    const int c0 = (int)cv.x, c1 = (int)cv.y, c2 = (int)cv.z, c3 = (int)cv.w, tot = c0 + c1 + c2 + c3;
                    int v = tot;
#pragma unroll
                    for (int d = 1; d < 64; d <<= 1) { const int n = __shfl_down(v, d); if (lane + d < 64) v += n; }
                    const int a3 = v - tot, a2 = a3 + c3, a1 = a2 + c2, a0 = a1 + c1; const int k = krem[g];
                    int fb = -1, fa = 0, fc = 0;
                    if (a3 < k && a3 + c3 >= k) { fb = 3; fa = a3; fc = c3; }
                    else if (a2 < k && a2 + c2 >= k) { fb = 2; fa = a2; fc = c2; }
                    else if (a1 < k && a1 + c1 >= k) { fb = 1; fa = a1; fc = c1; }
                    else if (a0 < k && a0 + c0 >= k) { fb = 0; fa = a0; fc = c0; }
                    const unsigned long long mk = __ballot(fb >= 0);
                    const int src = (int)__builtin_ctzll(mk | (1ull << 63));
                    const int bin = __shfl(4 * lane + fb, src), above = __shfl(fa, src), cnt = __shfl(fc, src);
                    prefix[g] = (prefix[g] << 8) | (unsigned)bin; krem[g] = k - above;
                    if (pass == npass - 1) { tau[g] = prefix[g]; quota[g] = krem[g]; allsel[g] = (cnt == krem[g]); }
                }
            }
        }
        if (mode == 0 && npass) {
            LDS_WAIT();
#pragma unroll
            for (int g = 0; g < 4; ++g) {
                if (!allsel[g]) {
                    const int n = eqseen[g], need = quota[g];
                    if (n > 128) { if (lane == 0) *oflag = 1u; }
                    else {
#pragma unroll 1
                        for (int i0 = 0; i0 < n; i0 += 64) {
                            const int i = i0 + lane; const bool act = i < n;
                            const unsigned mi = act ? cand[(g * 128 + i) * 2] : 0u, ki = act ? cand[(g * 128 + i) * 2 + 1] : 0u; int rank = 0;
#pragma unroll 1
                            for (int j = 0; j < n; ++j) { const unsigned mj = cand[(g * 128 + j) * 2], kj = cand[(g * 128 + j) * 2 + 1]; rank += ((mj > mi) || (mj == mi && kj < ki)) ? 1 : 0; }
                            if (act && rank < need) __hip_atomic_fetch_or(maskw + (4 * w + g) * 128 + (ki >> 5), 1u << (ki & 31u), __ATOMIC_RELAXED, __HIP_MEMORY_SCOPE_WORKGROUP);
                        }
                    }
                }
            }
        }
        __syncthreads();
        const unsigned of = *oflag;
        __syncthreads();
        if (mode == 0 && of != 0u) { mode = 1; continue; }
        break;
    }
    __syncthreads();
    {
        const float* sgn = p.dsa_qk_norm + lds_l * 128; float gqm = 0.f, gkm = 0.f;
#pragma unroll 2
        for (int i = 0; i < 64; ++i) { gqm = fmaxf(gqm, fabsf(sgn[i])); gkm = fmaxf(gkm, fabsf(sgn[64 + i])); }
        const float coff = 8.f * gqm * gkm;
        const int cb = w & 3, ksp = w >> 2, ql = 8 * cb + (r32 >> 2), hh = r32 & 3;
        s16x8 qf[4];
        { const bf16* qp = Z + (tokb + qt * 32 + ql) * ZP + 2560 + hh * 64 + 8 * half;
#pragma unroll
          for (int s4 = 0; s4 < 4; ++s4) qf[s4] = *(const s16x8*)(qp + 16 * s4); }
        f32x16 oacc[2];
#pragma unroll
        for (int db = 0; db < 2; ++db)
#pragma unroll
            for (int r = 0; r < 16; ++r) oacc[db][r] = 0.f;
        float lsum = 0.f;
        const int nT = (ntiles + 1) >> 1;
        const int skey = tid >> 3, sseg = tid & 7;
        const float* sgp = ZS + (tokb + skey) * ZSP + sseg * 16;
        f32x4 pr[4];
#pragma unroll
        for (int i = 0; i < 4; ++i) pr[i] = *(const f32x4*)(sgp + 4 * i);
#pragma unroll 1
        for (int tT = 0; tT < nT; ++tT) {
            __syncthreads();
            if (sseg < 4) {
                u32x4 w0, w1; w0.x = pkbf(pr[0][0], pr[0][1]); w0.y = pkbf(pr[0][2], pr[0][3]); w0.z = pkbf(pr[1][0], pr[1][1]); w0.w = pkbf(pr[1][2], pr[1][3]);
                w1.x = pkbf(pr[2][0], pr[2][1]); w1.y = pkbf(pr[2][2], pr[2][3]); w1.z = pkbf(pr[3][0], pr[3][1]); w1.w = pkbf(pr[3][2], pr[3][3]);
                *(LAS u32x4*)(Kd + skey * 72 + sseg * 16) = w0; *(LAS u32x4*)(Kd + skey * 72 + sseg * 16 + 8) = w1;
            } else {
                LAS bf16* vd = VTd + ((sseg - 4) * 16) * 72 + skey;
#pragma unroll
                for (int i = 0; i < 4; ++i) { const unsigned a0 = pkbf(pr[i][0], pr[i][1]), a1 = pkbf(pr[i][2], pr[i][3]);
                    vd[(4 * i) * 72] = (bf16)(a0 & 0xffffu); vd[(4 * i + 1) * 72] = (bf16)(a0 >> 16); vd[(4 * i + 2) * 72] = (bf16)(a1 & 0xffffu); vd[(4 * i + 3) * 72] = (bf16)(a1 >> 16); }
            }
            __syncthreads();
            if (tT + 1 < nT) {
#pragma unroll
                for (int i = 0; i < 4; ++i) pr[i] = *(const f32x4*)(sgp + (size_t)(tT + 1) * 64 * ZSP + 4 * i);
            }
            const int st = 2 * tT + ksp;
            if (st < ntiles) {
                const unsigned mw = maskw[ql * 128 + st];
                f32x16 sacc;
#pragma unroll
                for (int r = 0; r < 16; ++r) sacc[r] = 0.f;
#pragma unroll
                for (int s4 = 0; s4 < 4; ++s4) { const s16x8 ak = *(const LAS s16x8*)(Kd + (32 * ksp + r32) * 72 + 16 * s4 + 8 * half);
                    sacc = __builtin_amdgcn_mfma_f32_32x32x16_bf16(ak, qf[s4], sacc, 0, 0, 0); }
#pragma unroll
                for (int r = 0; r < 16; ++r) { const int kbit = 8 * (r >> 2) + 4 * half + (r & 3); const float pe = ((mw >> kbit) & 1u) ? __expf(sacc[r] - coff) : 0.f; sacc[r] = pe; lsum += pe; }
#pragma unroll
                for (int s2 = 0; s2 < 2; ++s2) {
                    u32x4 wp; wp.x = pkbf(sacc[8 * s2], sacc[8 * s2 + 1]); wp.y = pkbf(sacc[8 * s2 + 2], sacc[8 * s2 + 3]); wp.z = pkbf(sacc[8 * s2 + 4], sacc[8 * s2 + 5]); wp.w = pkbf(sacc[8 * s2 + 6], sacc[8 * s2 + 7]);
                    const s16x8 pf = __builtin_bit_cast(s16x8, wp);
#pragma unroll
                    for (int db = 0; db < 2; ++db) {
                        const LAS bf16* vr = VTd + (db * 32 + r32) * 72 + 32 * ksp + 16 * s2 + 4 * half;
                        const u32x2 v0 = *(const LAS u32x2*)vr, v1 = *(const LAS u32x2*)(vr + 8);
                        const u32x4 vv = (u32x4){v0.x, v0.y, v1.x, v1.y};
                        oacc[db] = __builtin_amdgcn_mfma_f32_32x32x16_bf16(__builtin_bit_cast(s16x8, vv), pf, oacc[db], 0, 0, 0);
                    }
                }
            }
        }
        lsum += __shfl_xor(lsum, 32);
        __syncthreads();
        LAS float* xch = (LAS float*)(lds + 49152) + (w & 3) * (33 * 64);
        if (ksp == 1) {
#pragma unroll
            for (int db = 0; db < 2; ++db)
#pragma unroll
                for (int r = 0; r < 16; ++r) xch[(db * 16 + r) * 64 + lane] = oacc[db][r];
            xch[32 * 64 + lane] = lsum;
        }
        __syncthreads();
        if (ksp == 0) {
            const float is = 1.f / (lsum + xch[32 * 64 + lane]);
            bf16* orow = O3 + (tokb + qt * 32 + ql) * 256 + hh * 64;
#pragma unroll
            for (int db = 0; db < 2; ++db)
#pragma unroll
                for (int g = 0; g < 4; ++g) { const int d0 = db * 32 + 8 * g + 4 * half;
                    const float x0 = (oacc[db][4 * g] + xch[(db * 16 + 4 * g) * 64 + lane]) * is, x1 = (oacc[db][4 * g + 1] + xch[(db * 16 + 4 * g + 1) * 64 + lane]) * is;
                    const float x2 = (oacc[db][4 * g + 2] + xch[(db * 16 + 4 * g + 2) * 64 + lane]) * is, x3 = (oacc[db][4 * g + 3] + xch[(db * 16 + 4 * g + 3) * 64 + lane]) * is;
                    u32x2 wo; wo.x = pkbf(x0, x1); wo.y = pkbf(x2, x3); *(u32x2*)(orow + d0) = wo; }
        }
    }
#undef DSA_SCORES
    __syncthreads();
}

constexpr int Q_ML = 32, Q_DIFF = 512, Q_DSA = 1024, Q_SB = 256, Q_TOTAL = Q_ML + Q_DIFF + Q_DSA + Q_SB;
__device__ __forceinline__ Params load_params() {
#if defined(__HIP_DEVICE_COMPILE__)
    const __attribute__((address_space(4))) Params* pp = (const __attribute__((address_space(4))) Params*)__builtin_amdgcn_kernarg_segment_ptr();
    asm volatile("" : "+s"(pp));
    Params r;
    r.x = pp->x; r.pos = pp->pos; r.ffn1_norm = pp->ffn1_norm; r.ffn1_gu = pp->ffn1_gu; r.ffn1_down = pp->ffn1_down; r.mix_norm = pp->mix_norm; r.w_in = pp->w_in; r.diff_qk_norm = pp->diff_qk_norm;
    r.diff_lambda = pp->diff_lambda; r.diff_head_norm = pp->diff_head_norm; r.ml_conv_w = pp->ml_conv_w; r.ml_conv_b = pp->ml_conv_b; r.ml_gate_bias = pp->ml_gate_bias; r.ml_head_norm = pp->ml_head_norm;
    r.dsa_qk_norm = pp->dsa_qk_norm; r.w_branch = pp->w_branch; r.w_out = pp->w_out; r.ffn2_norm = pp->ffn2_norm; r.ffn2_gu = pp->ffn2_gu; r.ffn2_down = pp->ffn2_down; r.out = pp->out; r.ws = pp->ws;
    return r;
#else
    return Params{};
#endif
}
__device__ __forceinline__ int next_item(unsigned* ctr, LAS int* slot, int wv) {
    __syncthreads();
    if (tid_fresh(wv) == 0) *slot = (int)atomicAdd(ctr, 1u);
    __syncthreads();
    return *slot;
}
__device__ __forceinline__ void mixer_phase1(int l, LAS unsigned char* lds, int wv, int co = 0) {
    LAS int* slot = (LAS int*)(lds + LDS_BYTES - 64);
    { const Params p = load_params(); unsigned* ctr = (unsigned*)(p.ws + WS_CTL) + 64 * (4 * l + 0 + co);
      for (;;) { const int it = next_item(ctr, slot, wv); if (it >= Q_DIFF) break; diffm_item(p, l, it & 31, 15 - (it >> 5), lds, wv); } }
    { const Params p = load_params(); unsigned* ctr = (unsigned*)(p.ws + WS_CTL) + 64 * (4 * l + 1 + co);
      for (;;) { const int it = next_item(ctr, slot, wv); if (it >= 512) break; mlB_item(p, l, it & 31, it >> 5, lds, wv); } }
}
__device__ __forceinline__ void mixer_phase2(int l, LAS unsigned char* lds, int wv, int co = 0) {
    LAS int* slot = (LAS int*)(lds + LDS_BYTES - 64);
    { const Params p = load_params(); unsigned* ctr = (unsigned*)(p.ws + WS_CTL) + 64 * (4 * l + 2 + co);
      for (;;) { const int it = next_item(ctr, slot, wv); if (it >= 32 + Q_DSA) break;
          if (it < 32) mlS_item(p, it, wv); else { const int i = it - 32; dsa_item(p, l, i & 7, 127 - (i >> 3), lds, wv); } } }
}
__device__ __forceinline__ void mixer_phase3(int l, LAS unsigned char* lds, int wv, int co = 0) {
    LAS int* slot = (LAS int*)(lds + LDS_BYTES - 64);
    { const Params p = load_params(); unsigned* ctr = (unsigned*)(p.ws + WS_CTL) + 64 * (4 * l + 3 + co);
      for (;;) { const int it = next_item(ctr, slot, wv); if (it >= 512) break; mlD_item(p, l, it & 31, it >> 5, lds, wv); } }
    { const Params p = load_params(); unsigned* ctr = (unsigned*)(p.ws + WS_CTL) + 64 * (8 + l + co);
      for (;;) { const int it = next_item(ctr, slot, wv); if (it >= Q_SB) break; sb_item(p, it >> 3, it & 7, lds, wv); } }
}

#define XB_TMO      128
#define XB_XCNT(j)  (256  + 64 * (j))
#define XB_XSUB(j)  (1280 + 64 * (j))
#define XB_XGEN(j)  (2304 + 64 * (j))
#define XB_TOP      3328
#define XB_TOPGEN   3392
#define XCD_BAR_WORDS 3456
#define XB_SPIN_CAP (1u << 20)
constexpr int CW_BAR = 8192;
__device__ __forceinline__ unsigned xb_ld(unsigned* p)              { return __hip_atomic_load(p, __ATOMIC_RELAXED, __HIP_MEMORY_SCOPE_AGENT); }
__device__ __forceinline__ unsigned xb_add(unsigned* p, unsigned v) { return __hip_atomic_fetch_add(p, v, __ATOMIC_RELAXED, __HIP_MEMORY_SCOPE_AGENT); }
__device__ __forceinline__ unsigned xb_xcc_id() { return (unsigned)__builtin_amdgcn_s_getreg((3 << 11) | 20) & 0xFu; }
#define XB_SPIN(cond, bar) do { unsigned _sp = 0; while (cond) { __builtin_amdgcn_s_sleep(1); \
    if ((++_sp & 255u) == 0u) { if (xb_ld(&(bar)[XB_TMO])) break; if (_sp > XB_SPIN_CAP) { atomicAdd(&(bar)[XB_TMO], 1u); break; } } } } while (0)
__device__ __forceinline__ void xcd_post(int wv) {
    const Params p = load_params(); unsigned* bar = (unsigned*)(p.ws + WS_CTL) + CW_BAR;
    if (tid_fresh(wv) == 0) (void)xb_add(&bar[XB_XCNT(xb_xcc_id())], 1u);
}
__device__ __forceinline__ void xcd_barrier_complete(unsigned* bar, unsigned x, unsigned& nloc, unsigned& nx) {
    const unsigned G = gridDim.x * gridDim.y * gridDim.z;
    unsigned sum, cnt, mine, sp = 0u;
    for (;;) {
        sum = 0u; cnt = 0u; mine = 0u;
#pragma unroll
        for (unsigned j = 0; j < 16; ++j) { const unsigned c = xb_ld(&bar[XB_XCNT(j)]); sum += c; cnt += (c > 0u) ? 1u : 0u; mine = (j == x) ? c : mine; }
        if (sum == G) break;
        __builtin_amdgcn_s_sleep(1);
        if ((++sp & 255u) == 0u) { if (xb_ld(&bar[XB_TMO])) break; if (sp > XB_SPIN_CAP) { atomicAdd(&bar[XB_TMO], 1u); break; } }
    }
    nloc = mine > 0u ? mine : 1u; nx = cnt > 0u ? cnt : 1u;
}
__device__ __forceinline__ void gsync(LAS unsigned char* lds, int wv) {
    asm volatile("s_waitcnt vmcnt(0)" ::: "memory");
    __syncthreads();
    if (tid_fresh(wv) == 0) {
        const Params p = load_params(); unsigned* bar = (unsigned*)(p.ws + WS_CTL) + CW_BAR;
        volatile LAS unsigned* st = (volatile LAS unsigned*)(lds + LDS_BYTES - 32);
        const unsigned x = xb_xcc_id();
        __builtin_amdgcn_s_waitcnt(0);
        unsigned nloc = st[0], nx = st[1];
        if (nloc == 0u) { xcd_barrier_complete(bar, x, nloc, nx); st[0] = nloc; st[1] = nx; }
        const unsigned old = xb_add(&bar[XB_XSUB(x)], 1u);
        const unsigned gen = old / nloc;
        if (old + 1u == (gen + 1u) * nloc) {
            __builtin_amdgcn_fence(__ATOMIC_RELEASE, "agent");
            asm volatile("s_waitcnt vmcnt(0)" ::: "memory");
            const unsigned og = xb_add(&bar[XB_TOP], 1u);
            const unsigned tg = og / nx;
            if (og + 1u == (tg + 1u) * nx) xb_add(&bar[XB_TOPGEN], 1u);
            else XB_SPIN(xb_ld(&bar[XB_TOPGEN]) == tg, bar);
            __builtin_amdgcn_fence(__ATOMIC_ACQUIRE, "agent");
            xb_add(&bar[XB_XGEN(x)], 1u);
            asm volatile("s_waitcnt vmcnt(0)" ::: "memory");
        } else {
            XB_SPIN(xb_ld(&bar[XB_XGEN(x)]) == gen, bar);
            __builtin_amdgcn_fence(__ATOMIC_ACQUIRE, "agent");
            asm volatile("s_waitcnt vmcnt(0)" ::: "memory");
        }
    }
    __syncthreads();
}

#define PH_LOCALS const Params p = load_params(); const int tid = tid_fresh(wv), lane = tid & 63, wave = tid >> 6; const int gw = (int)blockIdx.x * NWAVES + wave, ngw = (int)gridDim.x * NWAVES; \
    (void)lane; (void)gw; (void)ngw; bf16* HN = (bf16*)(p.ws + WS_HN); bf16* BIGB = (bf16*)(p.ws + WS_BIG); (void)HN; (void)BIGB;
template <int l> __device__ __forceinline__ void layer_body(cg::grid_group& grid, LAS unsigned char* lds, const int wv) {
        { PH_LOCALS const unsigned char* wl = p.ws + WS_W + (size_t)l * WL_STRIDE; EpiSwiglu E{BIGB}; run_gemm(lds, HN, (const bf16*)(wl + WL_GU1), T, 2 * FF, D, E, wv); }
        gsync(lds, wv);
#if PROBE_DUP & 8
        { PH_LOCALS const unsigned char* wl = p.ws + WS_W + (size_t)l * WL_STRIDE; EpiSwiglu E{BIGB}; run_gemm(lds, HN, (const bf16*)(wl + WL_GU1), T, 2 * FF, D, E, wv); }
        gsync(lds, wv);
#endif
        { PH_LOCALS const unsigned char* wl = p.ws + WS_W + (size_t)l * WL_STRIDE; EpiResid E{l == 0 ? p.x : p.out, p.out, 0.5f}; run_gemm(lds, BIGB, (const bf16*)(wl + WL_D1), T, D, FF, E, wv); }
        gsync(lds, wv);
        { PH_LOCALS rms_rows(p.out, p.mix_norm + l * D, HN, gw, ngw, lane); }
        gsync(lds, wv);
        { PH_LOCALS const unsigned char* wl = p.ws + WS_W + (size_t)l * WL_STRIDE; EpiZ E{BIGB, (float*)(p.ws + WS_ZS)}; run_gemm(lds, HN, (const bf16*)(wl + WL_INA), T, 3328, D, E, wv); }
        gsync(lds, wv);
        { PH_LOCALS if (gw < 32) ml_prepass(p, l, gw, lane); prep_phase(p, l, gw, ngw, lane); }
        gsync(lds, wv);
        mixer_phase1(l, lds, wv);
#if PROBE_DUP & 1
        gsync(lds, wv); mixer_phase1(l, lds, wv, 16);
#endif
        gsync(lds, wv);
        mixer_phase2(l, lds, wv);
#if PROBE_DUP & 2
        gsync(lds, wv); mixer_phase2(l, lds, wv, 16);
#endif
        gsync(lds, wv);
        mixer_phase3(l, lds, wv);
#if PROBE_DUP & 4
        gsync(lds, wv); mixer_phase3(l, lds, wv, 16);
#endif
        gsync(lds, wv);
#pragma unroll 1
        for (int b = 0; b < 4; ++b) {
            { PH_LOCALS const unsigned char* wl = p.ws + WS_W + (size_t)l * WL_STRIDE; EpiSig E{BIGB}; run_gemm(lds, HN, (const bf16*)(wl + WL_G) + (size_t)b * D * D, T, D, D, E, wv); }
            gsync(lds, wv);
            { PH_LOCALS const unsigned char* wl = p.ws + WS_W + (size_t)l * WL_STRIDE; EpiGate E{BIGB, (float*)(p.ws + WS_BIG + 64 * MiB), HN, b == 0 ? 0 : (b == 3 ? 2 : 1)};
              run_gemm(lds, (const bf16*)(p.ws + WS_O + b * OB_STRIDE), (const bf16*)(wl + WL_BR) + (size_t)b * D * 256, T, D, 256, E, wv); }
            gsync(lds, wv);
        }
        { PH_LOCALS const unsigned char* wl = p.ws + WS_W + (size_t)l * WL_STRIDE; EpiResid E{p.out, p.out, 1.0f}; run_gemm(lds, HN, (const bf16*)(wl + WL_OUT), T, D, D, E, wv); }
        gsync(lds, wv);
        { PH_LOCALS rms_rows(p.out, p.ffn2_norm + l * D, HN, gw, ngw, lane); }
        gsync(lds, wv);
        { PH_LOCALS const unsigned char* wl = p.ws + WS_W + (size_t)l * WL_STRIDE; EpiSwiglu E{BIGB}; run_gemm(lds, HN, (const bf16*)(wl + WL_GU2), T, 2 * FF, D, E, wv); }
        gsync(lds, wv);
#if PROBE_DUP & 8
        { PH_LOCALS const unsigned char* wl = p.ws + WS_W + (size_t)l * WL_STRIDE; EpiSwiglu E{BIGB}; run_gemm(lds, HN, (const bf16*)(wl + WL_GU2), T, 2 * FF, D, E, wv); }
        gsync(lds, wv);
#endif
        { PH_LOCALS const unsigned char* wl = p.ws + WS_W + (size_t)l * WL_STRIDE; EpiResid E{p.out, p.out, 0.5f}; run_gemm(lds, BIGB, (const bf16*)(wl + WL_D2), T, D, FF, E, wv); }
        if (l + 1 < DEPTH) {
            gsync(lds, wv);
            { PH_LOCALS rms_rows(p.out, p.ffn1_norm + (l + 1) * D, HN, gw, ngw, lane); }
            gsync(lds, wv);
        }
    }

__global__ void __launch_bounds__(NTHR, 2) hybrid_fwd(Params p_unused) {
    extern __shared__ __attribute__((aligned(16))) unsigned char lds_raw[];
    LAS unsigned char* lds = (LAS unsigned char*)lds_raw;
    cg::grid_group grid = cg::this_grid();
    const int wv = __builtin_amdgcn_readfirstlane((int)threadIdx.x >> 6);
    {
        PH_LOCALS
        SegRun R; R.base = 0; R.gw = gw; R.ngw = ngw; R.lane = lane; R.scr = (LAS float*)(lds + wave * 8704);
        for (int l = 0; l < DEPTH; ++l) convert_weights(p, l, R);
        if (blockIdx.x == 0 && tid < 64) ((unsigned*)(p.ws + WS_CTL))[64 * tid] = 0u;
        if (blockIdx.x == 0) for (int i = tid; i < XCD_BAR_WORDS; i += NTHR) ((unsigned*)(p.ws + WS_CTL))[CW_BAR + i] = 0u;
        if (tid < 8) ((LAS unsigned*)(lds + LDS_BYTES - 32))[tid] = 0u;
        rms_rows(p.x, p.ffn1_norm, HN, gw, ngw, lane);
    }
    grid.sync();
    xcd_post(wv);
    layer_body<0>(grid, lds, wv);
    layer_body<1>(grid, lds, wv);
}

extern "C" void kernel_launch(void* const* d_in, const int* in_sizes, int n_in, void* d_out, int out_size, void* d_ws, size_t ws_size, hipStream_t stream) {
    static int grid = 0;
    if (grid == 0) {
        if (n_in != 20 || out_size != T * D || ws_size < WS_END2) { fprintf(stderr, "kernel_launch: unexpected shapes (n_in %d out %d ws %zu)\n", n_in, out_size, ws_size); grid = -1; return; }
        int dev = 0, cus = 0, per_cu = 0;
        hipGetDevice(&dev); hipDeviceGetAttribute(&cus, hipDeviceAttributeMultiprocessorCount, dev);
        hipFuncSetAttribute((const void*)hybrid_fwd, hipFuncAttributeMaxDynamicSharedMemorySize, LDS_BYTES);
        hipOccupancyMaxActiveBlocksPerMultiprocessor(&per_cu, (const void*)hybrid_fwd, NTHR, LDS_BYTES);
        if (per_cu < 1) { fprintf(stderr, "kernel_launch: occupancy query says %d\n", per_cu); per_cu = 1; }
        (void)hipGetLastError();
        grid = cus * 1;
    }
    if (grid < 0) return;
    Params p{};
    p.x = (const float*)d_in[0]; p.pos = (const int*)d_in[1];
    p.ffn1_norm = (const float*)d_in[2]; p.ffn1_gu = (const float*)d_in[3]; p.ffn1_down = (const float*)d_in[4]; p.mix_norm = (const float*)d_in[5]; p.w_in = (const float*)d_in[6];
    p.diff_qk_norm = (const float*)d_in[7]; p.diff_lambda = (const float*)d_in[8]; p.diff_head_norm = (const float*)d_in[9]; p.ml_conv_w = (const float*)d_in[10]; p.ml_conv_b = (const float*)d_in[11];
    p.ml_gate_bias = (const float*)d_in[12]; p.ml_head_norm = (const float*)d_in[13]; p.dsa_qk_norm = (const float*)d_in[14]; p.w_branch = (const float*)d_in[15]; p.w_out = (const float*)d_in[16];
    p.ffn2_norm = (const float*)d_in[17]; p.ffn2_gu = (const float*)d_in[18]; p.ffn2_down = (const float*)d_in[19];
    p.out = (float*)d_out; p.ws = (unsigned char*)d_ws;
    void* args[] = {&p};
    hipError_t e = hipLaunchCooperativeKernel((const void*)hybrid_fwd, dim3(grid), dim3(NTHR), args, LDS_BYTES, stream);
    if (e != hipSuccess) fprintf(stderr, "cooperative launch failed: %s (grid %d)\n", hipGetErrorString(e), grid);
}
```

```cpp
#include <hip/hip_runtime.h>
#include <hip/hip_cooperative_groups.h>
#include <cstdio>
#include <cstdint>
namespace cg = cooperative_groups;
#ifndef PROBE_DUP
#define PROBE_DUP 0
#endif
namespace pg8 {
#define PG8_LAS __attribute__((address_space(3)))
typedef unsigned short bf16_t;
typedef short bf16x8 __attribute__((ext_vector_type(8)));
typedef float f32x4 __attribute__((ext_vector_type(4)));
typedef unsigned u32x4 __attribute__((ext_vector_type(4)));
constexpr int BM = 256, BK = 64, HALF = 128, HTB = HALF * BK * 2  , STAGE_BYTES = 8 * HTB, NXCD = 8, WGM = 8;

__host__ __device__ __forceinline__ int lds_byte(int r, int c) { const int st = (r >> 4) * 2 + (c >> 5), rr = r & 15, cc = c & 31, ob = rr * 64 + cc * 2; return st * 1024 + (ob ^ (((ob >> 9) & 1) << 5)); }
__host__ __device__ __forceinline__ void stage_rc(int b, int& R, int& C) { const int st = b / 1024, sb = b % 1024, swz = sb ^ (((sb >> 9) & 1) << 5); R = (st >> 1) * 16 + swz / 64; C = (st & 1) * 32 + (swz % 64) / 2; }
__host__ __device__ __forceinline__ int perm32(int rho) { const int n = rho >> 4, i = rho & 15; return 8 * (i >> 2) + 4 * n + (i & 3); }

struct Unit { int pm, pn; };
struct Gemm { const bf16_t* A; const bf16_t* Bt; int M, N, K; };

struct StaticOrder {
    int nM, nN, nwg, G, c;
    __host__ __device__ void init(int M, int N, int G_, int c_) { nM = M / BM; nN = N / BM; nwg = nM * nN; G = G_; c = c_; }
    __host__ __device__ bool next(int i, Unit& u) const {
        const long L = (long)i * G + c; if (L >= nwg) return false;
        int wgid = (int)L; { const int q = nwg / NXCD, r = nwg % NXCD, xcd = wgid % NXCD, off = wgid / NXCD; wgid = (xcd < r ? xcd * (q + 1) : r * (q + 1) + (xcd - r) * q) + off; }
        const int nig = WGM * nN, gid = wgid / nig, fm = gid * WGM, gsz = (nM - fm) < WGM ? (nM - fm) : WGM;
        u.pm = fm + ((wgid % nig) % gsz); u.pn = (wgid % nig) / gsz; return true;
    }
    __device__ __forceinline__ void a_ready(const Unit&) const {}
    __device__ __forceinline__ void done(const Unit&) const {}
};

__device__ __forceinline__ unsigned cvt_pk_bf16(float lo, float hi) { unsigned r; asm volatile("v_cvt_pk_bf16_f32 %0, %1, %2" : "=v"(r) : "v"(lo), "v"(hi)); return r; }
template <class Epi, class Sched, bool ALIGN_EPI = false, bool SP2 = false>
__device__ __forceinline__ void gemm_phase(PG8_LAS unsigned char* lds, const Gemm g, const Sched& S, const Epi& E, const int wave_in) {
    unsigned z_ = 0u; asm volatile("" : "+v"(z_)); int w_ = wave_in; asm volatile("" : "+s"(w_));
    const int tid_ = w_ * 64 + (int)__builtin_amdgcn_mbcnt_hi(~0u, __builtin_amdgcn_mbcnt_lo(~0u, z_));
    const int tid = tid_, wid = __builtin_amdgcn_readfirstlane(tid >> 6), lane = tid & 63, wr = wid >> 2, wc = wid & 3, fr = lane & 15, fq = lane >> 4;
    const int K = g.K, nt = K / BK;
    unsigned voffA[2], voffB[2];
#pragma unroll
    for (int i = 0; i < 2; ++i) { int R, C; stage_rc(tid * 16 + i * 8192, R, C); const int Rb = Epi::PERM ? ((R & ~31) + perm32(R & 31)) : R;
        voffA[i] = (unsigned)(R * K + C) * 2u; voffB[i] = (unsigned)(Rb * K + C) * 2u; }
    const size_t kstep = (size_t)(BK * 2);
    const size_t hstep = (size_t)HALF * K * 2;
    const size_t tstep = 2 * hstep;
    const unsigned ldsw = (unsigned)wid * 1024u;
    const int aoff = lds_byte(wr * 64 + fr, fq * 8), boff = lds_byte(wc * 32 + fr, fq * 8);
#define PG8_SA(b, h) (((b) * 2 + (h)) * HTB)
#define PG8_SB(b, h) ((4 + (b) * 2 + (h)) * HTB)
#define PG8_STAGE(bufoff, gbase, voff) do { _Pragma("unroll") for (int _i = 0; _i < 2; ++_i) \
        __builtin_amdgcn_global_load_lds((const unsigned*)((const char*)(gbase) + (voff)[_i]), (PG8_LAS unsigned*)(lds + (bufoff) + ldsw + _i * 8192), 16, 0, 0); } while (0)
#define PG8_LDA(dst, b, h) do { _Pragma("unroll") for (int m = 0; m < 4; ++m) _Pragma("unroll") for (int k = 0; k < 2; ++k) dst[m][k] = *(const PG8_LAS bf16x8*)(lds + PG8_SA(b, h) + aoff + m * 2048 + k * 1024); } while (0)
#define PG8_LDB(dst, b, h) do { _Pragma("unroll") for (int n = 0; n < 2; ++n) _Pragma("unroll") for (int k = 0; k < 2; ++k) dst[n][k] = *(const PG8_LAS bf16x8*)(lds + PG8_SB(b, h) + boff + n * 2048 + k * 1024); } while (0)
#define PG8_MMA(ai, bj, At, Bt) do { __builtin_amdgcn_s_setprio(1); _Pragma("unroll") for (int m = 0; m < 4; ++m) _Pragma("unroll") for (int n = 0; n < 2; ++n) _Pragma("unroll") for (int k = 0; k < 2; ++k) \
        acc[ai][bj][m][n] = __builtin_amdgcn_mfma_f32_16x16x32_bf16(Bt[n][k], At[m][k], acc[ai][bj][m][n], 0, 0, 0); __builtin_amdgcn_s_setprio(0); } while (0)
#define PG8_WAIT_V(n) asm volatile("s_waitcnt vmcnt(" #n ")" ::: "memory")
#define PG8_WAIT_L(n) asm volatile("s_waitcnt lgkmcnt(" #n ")" ::: "memory")
#define PG8_BAR __builtin_amdgcn_s_barrier()
#define PG8_SCHED __builtin_amdgcn_sched_barrier(0)
    Unit cur, nxt; int ui = 0;
    if (!S.next(0, cur)) return;
    f32x4 acc[2][2][4][2];
#pragma unroll
    for (int a = 0; a < 2; ++a)
#pragma unroll
        for (int b = 0; b < 2; ++b)
#pragma unroll
            for (int m = 0; m < 4; ++m)
#pragma unroll
                for (int n = 0; n < 2; ++n) acc[a][b][m][n] = (f32x4){0.f, 0.f, 0.f, 0.f};
    bf16x8 At[4][2], B0[2][2], B1[2][2];
    const char* cA = (const char*)g.A + (size_t)cur.pm * tstep; const char* cB = (const char*)g.Bt + (size_t)cur.pn * tstep;
    S.a_ready(cur);
    if constexpr (SP2) {
        PG8_STAGE(PG8_SB(0, 0), cB, voffB); PG8_STAGE(PG8_SB(0, 1), cB + hstep, voffB); PG8_STAGE(PG8_SA(0, 0), cA, voffA); PG8_STAGE(PG8_SA(0, 1), cA + hstep, voffA);
        if (wr == 1) PG8_BAR;
        PG8_WAIT_V(2); PG8_BAR;
        PG8_STAGE(PG8_SB(1, 0), cB + kstep, voffB); PG8_STAGE(PG8_SA(1, 0), cA + kstep, voffA); PG8_STAGE(PG8_SB(1, 1), cB + hstep + kstep, voffB);
        PG8_WAIT_V(6); PG8_BAR;
    } else {
        PG8_STAGE(PG8_SB(0, 0), cB, voffB); PG8_STAGE(PG8_SA(0, 0), cA, voffA); PG8_STAGE(PG8_SB(0, 1), cB + hstep, voffB); PG8_STAGE(PG8_SA(0, 1), cA + hstep, voffA);
        if (wr == 1) PG8_BAR;
        PG8_WAIT_V(4); PG8_BAR;
        PG8_STAGE(PG8_SB(1, 0), cB + kstep, voffB); PG8_STAGE(PG8_SA(1, 0), cA + kstep, voffA); PG8_STAGE(PG8_SB(1, 1), cB + hstep + kstep, voffB);
        PG8_WAIT_V(6); PG8_BAR;
    }
    for (;;) {
        const bool has_next = S.next(ui + 1, nxt);
        const char* nA = has_next ? (const char*)g.A + (size_t)nxt.pm * tstep : cA; const char* nB = has_next ? (const char*)g.Bt + (size_t)nxt.pn * tstep : cB;
        for (int t = 0; t < nt; t += 2) {
            const bool last = (t == nt - 2);
            const char* a1 = cA + (size_t)(t + 1) * kstep;
            const char* a2 = last ? nA : cA + (size_t)(t + 2) * kstep; const char* b2 = last ? nB : cB + (size_t)(t + 2) * kstep;
            const char* a3 = a2 + kstep; const char* b3 = b2 + kstep;
            if (last && has_next) S.a_ready(nxt);
            if constexpr (SP2) {
            PG8_LDB(B0, 0, 0); PG8_LDB(B1, 0, 1); PG8_SCHED; PG8_LDA(At, 0, 0); PG8_STAGE(PG8_SA(1, 1), a1 + hstep, voffA);
            PG8_WAIT_V(8); PG8_WAIT_L(0); PG8_BAR; PG8_MMA(0, 0, At, B0); PG8_MMA(0, 1, At, B1); PG8_BAR; PG8_SCHED;
            PG8_LDA(At, 0, 1); PG8_STAGE(PG8_SB(0, 0), b2, voffB); PG8_STAGE(PG8_SB(0, 1), b2 + hstep, voffB); PG8_STAGE(PG8_SA(0, 0), a2, voffA);
            PG8_WAIT_V(8); PG8_WAIT_L(0); PG8_BAR; PG8_MMA(1, 0, At, B0); PG8_MMA(1, 1, At, B1); PG8_BAR; PG8_SCHED;
            PG8_LDB(B0, 1, 0); PG8_LDB(B1, 1, 1); PG8_SCHED; PG8_LDA(At, 1, 0); PG8_STAGE(PG8_SA(0, 1), a2 + hstep, voffA);
            PG8_WAIT_V(8); PG8_WAIT_L(0); PG8_BAR; PG8_MMA(0, 0, At, B0); PG8_MMA(0, 1, At, B1); PG8_BAR; PG8_SCHED;
            PG8_LDA(At, 1, 1); PG8_STAGE(PG8_SB(1, 0), b3, voffB); PG8_STAGE(PG8_SB(1, 1), b3 + hstep, voffB); PG8_STAGE(PG8_SA(1, 0), a3, voffA);
            PG8_WAIT_V(8); PG8_WAIT_L(0); PG8_BAR; PG8_MMA(1, 0, At, B0); PG8_MMA(1, 1, At, B1); PG8_BAR; PG8_SCHED;
            } else {
            PG8_LDB(B0, 0, 0); PG8_SCHED; PG8_LDA(At, 0, 0); PG8_STAGE(PG8_SA(1, 1), a1 + hstep, voffA);
            PG8_WAIT_L(8); PG8_BAR; PG8_WAIT_L(0); PG8_MMA(0, 0, At, B0); PG8_BAR; PG8_SCHED;
            PG8_LDB(B1, 0, 1); PG8_STAGE(PG8_SB(0, 0), b2, voffB);
            PG8_BAR; PG8_WAIT_L(0); PG8_MMA(0, 1, At, B1); PG8_BAR;
            PG8_LDA(At, 0, 1); PG8_STAGE(PG8_SA(0, 0), a2, voffA);
            PG8_BAR; PG8_WAIT_L(0); PG8_MMA(1, 0, At, B0); PG8_BAR; PG8_SCHED;
            PG8_STAGE(PG8_SB(0, 1), b2 + hstep, voffB);
            PG8_WAIT_V(6); PG8_BAR; PG8_MMA(1, 1, At, B1); PG8_BAR;
            PG8_LDB(B0, 1, 0); PG8_SCHED; PG8_LDA(At, 1, 0); PG8_STAGE(PG8_SA(0, 1), a2 + hstep, voffA);
            PG8_WAIT_L(8); PG8_BAR; PG8_WAIT_L(0); PG8_MMA(0, 0, At, B0); PG8_BAR; PG8_SCHED;
            PG8_LDB(B1, 1, 1); PG8_STAGE(PG8_SB(1, 0), b3, voffB);
            PG8_BAR; PG8_WAIT_L(0); PG8_MMA(0, 1, At, B1); PG8_BAR;
            PG8_LDA(At, 1, 1); PG8_STAGE(PG8_SA(1, 0), a3, voffA);
            PG8_BAR; PG8_WAIT_L(0); PG8_MMA(1, 0, At, B0); PG8_BAR; PG8_SCHED;
            PG8_STAGE(PG8_SB(1, 1), b3 + hstep, voffB);
            PG8_WAIT_V(6); PG8_BAR; PG8_MMA(1, 1, At, B1); PG8_BAR;
            }
        }
        if constexpr (ALIGN_EPI) { if (wr == 0) PG8_BAR; }
        if constexpr (!Epi::AFTER_DRAIN) { E(acc, cur, wr, wc, fr, fq); S.done(cur); }
        if (!has_next) break;
#pragma unroll
        for (int a = 0; a < 2; ++a)
#pragma unroll
            for (int b = 0; b < 2; ++b)
#pragma unroll
                for (int m = 0; m < 4; ++m)
#pragma unroll
                    for (int n = 0; n < 2; ++n) acc[a][b][m][n] = (f32x4){0.f, 0.f, 0.f, 0.f};
        cur = nxt; cA = nA; cB = nB; ++ui;
        if constexpr (ALIGN_EPI) { if (wr == 1) PG8_BAR; }
    }
    PG8_WAIT_V(0);
    if constexpr (!ALIGN_EPI) { if (wr == 0) PG8_BAR; }
    PG8_BAR;
    if constexpr (Epi::AFTER_DRAIN) { E.fused(acc, cur, wr, wc, fr, fq, lds, wid, lane); S.done(cur); }
#undef PG8_SA
#undef PG8_SB
#undef PG8_STAGE
#undef PG8_LDA
#undef PG8_LDB
#undef PG8_MMA
#undef PG8_WAIT_V
#undef PG8_WAIT_L
#undef PG8_BAR
#undef PG8_SCHED
}
}
#define LAS __attribute__((address_space(3)))
typedef unsigned short bf16;
typedef float f32x4 __attribute__((ext_vector_type(4)));
typedef float f32x16 __attribute__((ext_vector_type(16)));
typedef unsigned u32x4 __attribute__((ext_vector_type(4)));
typedef unsigned u32x2 __attribute__((ext_vector_type(2)));
typedef short s16x8 __attribute__((ext_vector_type(8)));

constexpr int NB = 8, SEQ = 4096, T = NB * SEQ, D = 1024, FF = 2816, DEPTH = 2, NIN = 7344, ZP = 3072, ZSP = 256;
constexpr int NTHR = 512, NWAVES = 8;
constexpr int LDS_BYTES = 147456;
constexpr float EPS = 1e-6f;

constexpr size_t MiB = (size_t)1 << 20;
constexpr size_t WS_CTL = 0;
constexpr size_t WS_W = 1 * MiB, WL_STRIDE = 52 * MiB;
constexpr size_t WL_GU1 = 0, WL_D1 = 11534336, WL_INA = 17301504, WL_G = 24117248, WL_BR = 32505856, WL_OUT = 34603008, WL_GU2 = 36700160, WL_D2 = 48234496;
constexpr size_t WS_HN = 106 * MiB, WS_BIG = 170 * MiB, WS_ZS = 362 * MiB, WS_O = 394 * MiB, WS_IK = 458 * MiB, WS_END = 460 * MiB;
constexpr size_t OB_STRIDE = (size_t)T * 256 * 2;

struct Params {
    const float* x; const int* pos;
    const float *ffn1_norm, *ffn1_gu, *ffn1_down, *mix_norm, *w_in, *diff_qk_norm, *diff_lambda, *diff_head_norm, *ml_conv_w, *ml_conv_b, *ml_gate_bias, *ml_head_norm,
        *dsa_qk_norm, *w_branch, *w_out, *ffn2_norm, *ffn2_gu, *ffn2_down;
    float* out; unsigned char* ws;
};

__device__ __forceinline__ unsigned f2bf(float f) { unsigned u = __float_as_uint(f); return (u + 0x7fffu + ((u >> 16) & 1u)) >> 16; }
__device__ __forceinline__ unsigned pk2(float lo, float hi) { return f2bf(lo) | (f2bf(hi) << 16); }
__device__ __forceinline__ float bflo(unsigned w) { return __uint_as_float(w << 16); }
__device__ __forceinline__ float bfhi(unsigned w) { return __uint_as_float(w & 0xffff0000u); }
__device__ __forceinline__ float wave_sum(float v) {
#pragma unroll
    for (int o = 1; o < 64; o <<= 1) v += __shfl_xor(v, o);
    return v;
}
__device__ __forceinline__ float wave_max(float v) {
#pragma unroll
    for (int o = 1; o < 64; o <<= 1) v = fmaxf(v, __shfl_xor(v, o));
    return v;
}
__device__ __forceinline__ int lane_fresh() { unsigned z = 0u; asm volatile("" : "+v"(z)); return (int)__builtin_amdgcn_mbcnt_hi(~0u, __builtin_amdgcn_mbcnt_lo(~0u, z)); }
__device__ __forceinline__ int tid_fresh(int wv) { int w = wv; asm volatile("" : "+s"(w)); return w * 64 + lane_fresh(); }
#define LDS_WAIT() asm volatile("s_waitcnt lgkmcnt(0)" ::: "memory")
__device__ __forceinline__ float sigmoidf_(float x) { return 1.f / (1.f + __expf(-x)); }

__device__ __forceinline__ Params load_params() {
#if defined(__HIP_DEVICE_COMPILE__)
    const __attribute__((address_space(4))) Params* pp = (const __attribute__((address_space(4))) Params*)__builtin_amdgcn_kernarg_segment_ptr();
    asm volatile("" : "+s"(pp));
    Params r;
    r.x = pp->x; r.pos = pp->pos; r.ffn1_norm = pp->ffn1_norm; r.ffn1_gu = pp->ffn1_gu; r.ffn1_down = pp->ffn1_down; r.mix_norm = pp->mix_norm; r.w_in = pp->w_in; r.diff_qk_norm = pp->diff_qk_norm;
    r.diff_lambda = pp->diff_lambda; r.diff_head_norm = pp->diff_head_norm; r.ml_conv_w = pp->ml_conv_w; r.ml_conv_b = pp->ml_conv_b; r.ml_gate_bias = pp->ml_gate_bias; r.ml_head_norm = pp->ml_head_norm;
    r.dsa_qk_norm = pp->dsa_qk_norm; r.w_branch = pp->w_branch; r.w_out = pp->w_out; r.ffn2_norm = pp->ffn2_norm; r.ffn2_gu = pp->ffn2_gu; r.ffn2_down = pp->ffn2_down; r.out = pp->out; r.ws = pp->ws;
    return r;
#else
    return Params{};
#endif
}
typedef unsigned long long u64_t;
__device__ __forceinline__ u64_t* rs_ptr(const Params& p, int idx) { return (u64_t*)(p.ws + (idx < 3 ? (WS_CTL + 131072) : (105 * MiB))) + (size_t)(idx % 3) * T; }
__device__ __forceinline__ float row_rstd(const u64_t* rs, int row) { return 1.f / sqrtf((float)rs[row] * (1.f / (16777216.f * D)) + EPS); }
struct EpiSwiglu {
    static constexpr bool PERM = true, AFTER_DRAIN = false;
    int rsi;
    __device__ __forceinline__ void operator()(const f32x4 (&acc)[2][2][4][2], const pg8::Unit& u, int wr, int wc, int fr_in, int fq_in) const {
        const int ln_ = lane_fresh(); const int fr = ln_ & 15, fq = ln_ >> 4; (void)fr_in; (void)fq_in;
        const Params p = load_params(); bf16* O = (bf16*)(p.ws + WS_BIG); const u64_t* rs = rs_ptr(p, rsi);
        const int row0 = u.pm * 256 + wr * 64 + fr, col0 = u.pn * 128 + wc * 32 + 8 * fq;
#pragma unroll
        for (int ai = 0; ai < 2; ++ai)
#pragma unroll
            for (int m = 0; m < 4; ++m) {
                const int row = row0 + ai * 128 + m * 16; const float rr = row_rstd(rs, row);
                bf16* rowp = O + (size_t)row * FF + col0;
                float r[8];
#pragma unroll
                for (int n = 0; n < 2; ++n)
#pragma unroll
                    for (int j = 0; j < 4; ++j) { const float g = acc[ai][0][m][n][j] * rr, uu = acc[ai][1][m][n][j] * rr; r[4 * n + j] = g * sigmoidf_(g) * uu; }
                u32x4 w; w.x = pk2(r[0], r[1]); w.y = pk2(r[2], r[3]); w.z = pk2(r[4], r[5]); w.w = pk2(r[6], r[7]);
                *(u32x4*)rowp = w;
            }
    }
};
struct EpiResid {
    static constexpr bool PERM = true, AFTER_DRAIN = false;
    int base_is_x; float scale; int rsi;
    __device__ __forceinline__ void operator()(const f32x4 (&acc)[2][2][4][2], const pg8::Unit& u, int wr, int wc, int fr_in, int fq_in) const {
        const int ln_ = lane_fresh(); const int fr = ln_ & 15, fq = ln_ >> 4; (void)fr_in; (void)fq_in;
        const Params p = load_params(); const float* base = base_is_x ? p.x : p.out; float* out = p.out; bf16* XB = (rsi >= 0) ? (bf16*)(p.ws + WS_HN) : (bf16*)nullptr; u64_t* rs = rs_ptr(p, rsi >= 0 ? rsi : 0);
        const int row0 = u.pm * 256 + wr * 64 + fr, col0 = u.pn * 256 + wc * 32 + 8 * fq;
#pragma unroll
        for (int ai = 0; ai < 2; ++ai)
#pragma unroll
            for (int m = 0; m < 4; ++m) {
                const int row = row0 + ai * 128 + m * 16; const size_t ro = (size_t)row * D + col0; float ss = 0.f;
#pragma unroll
                for (int bj = 0; bj < 2; ++bj) {
                    const f32x4 v0 = *(const f32x4*)(base + ro + bj * 128) + acc[ai][bj][m][0] * scale, v1 = *(const f32x4*)(base + ro + bj * 128 + 4) + acc[ai][bj][m][1] * scale;
                    *(f32x4*)(out + ro + bj * 128) = v0; *(f32x4*)(out + ro + bj * 128 + 4) = v1;
                    if (XB) { u32x4 w; w.x = pk2(v0[0], v0[1]); w.y = pk2(v0[2], v0[3]); w.z = pk2(v1[0], v1[1]); w.w = pk2(v1[2], v1[3]); *(u32x4*)(XB + ro + bj * 128) = w;
                        ss += (v0[0] * v0[0] + v0[1] * v0[1]) + (v0[2] * v0[2] + v0[3] * v0[3]) + (v1[0] * v1[0] + v1[1] * v1[1]) + (v1[2] * v1[2] + v1[3] * v1[3]); }
                }
                if (XB) { ss += __shfl_xor(ss, 16); ss += __shfl_xor(ss, 32); if (fq == 0) atomicAdd(rs + row, (u64_t)(ss * 16777216.f)); }
            }
    }
};
struct EpiZ {
    static constexpr bool PERM = true, AFTER_DRAIN = false;
    int rsi;
    __device__ __forceinline__ void operator()(const f32x4 (&acc)[2][2][4][2], const pg8::Unit& u, int wr, int wc, int fr_in, int fq_in) const {
        const int ln_ = lane_fresh(); const int fr = ln_ & 15, fq = ln_ >> 4; (void)fr_in; (void)fq_in;
        const Params p = load_params(); bf16* Z = (bf16*)(p.ws + WS_BIG); float* ZS = (float*)(p.ws + WS_ZS); const u64_t* rs = rs_ptr(p, rsi);
        const int row0 = u.pm * 256 + wr * 64 + fr, cw = wc * 32 + 8 * fq;
        if (u.pn < 12) {
#pragma unroll
            for (int ai = 0; ai < 2; ++ai)
#pragma unroll
                for (int m = 0; m < 4; ++m) {
                    const int row = row0 + ai * 128 + m * 16; const float rr = row_rstd(rs, row);
                    bf16* rowp = Z + (size_t)row * ZP + u.pn * 256 + cw;
#pragma unroll
                    for (int bj = 0; bj < 2; ++bj) { const f32x4 v0 = acc[ai][bj][m][0] * rr, v1 = acc[ai][bj][m][1] * rr;
                        u32x4 w; w.x = pk2(v0[0], v0[1]); w.y = pk2(v0[2], v0[3]); w.z = pk2(v1[0], v1[1]); w.w = pk2(v1[2], v1[3]);
                        *(u32x4*)(rowp + bj * 128) = w; }
                }
        } else {
#pragma unroll
            for (int ai = 0; ai < 2; ++ai)
#pragma unroll
                for (int m = 0; m < 4; ++m) {
                    const int row = row0 + ai * 128 + m * 16; const float rr = row_rstd(rs, row);
                    float* rowp = ZS + (size_t)row * ZSP + cw;
#pragma unroll
                    for (int bj = 0; bj < 2; ++bj)
#pragma unroll
                        for (int n = 0; n < 2; ++n) *(f32x4*)(rowp + bj * 128 + 4 * n) = acc[ai][bj][m][n] * rr;
                }
        }
    }
};
struct EpiSig {
    static constexpr bool PERM = true, AFTER_DRAIN = false;
    int rsi;
    __device__ __forceinline__ void operator()(const f32x4 (&acc)[2][2][4][2], const pg8::Unit& u, int wr, int wc, int fr_in, int fq_in) const {
        const int ln_ = lane_fresh(); const int fr = ln_ & 15, fq = ln_ >> 4; (void)fr_in; (void)fq_in;
        const Params p = load_params(); bf16* SG = (bf16*)(p.ws + WS_BIG); const u64_t* rs = rs_ptr(p, rsi);
        const int row0 = u.pm * 256 + wr * 64 + fr, col0 = u.pn * 256 + wc * 32 + 8 * fq;
#pragma unroll
        for (int ai = 0; ai < 2; ++ai)
#pragma unroll
            for (int m = 0; m < 4; ++m) {
                const int row = row0 + ai * 128 + m * 16; const float rr = row_rstd(rs, row);
                bf16* rowp = SG + (size_t)row * (2 * D) + col0;
#pragma unroll
                for (int bj = 0; bj < 2; ++bj) { const f32x4 v0 = acc[ai][bj][m][0] * rr, v1 = acc[ai][bj][m][1] * rr;
                    u32x4 w; w.x = pk2(sigmoidf_(v0[0]), sigmoidf_(v0[1])); w.y = pk2(sigmoidf_(v0[2]), sigmoidf_(v0[3]));
                    w.z = pk2(sigmoidf_(v1[0]), sigmoidf_(v1[1])); w.w = pk2(sigmoidf_(v1[2]), sigmoidf_(v1[3]));
                    *(u32x4*)(rowp + bj * 128) = w; }
            }
    }
};
struct EpiGate {
    static constexpr bool PERM = true, AFTER_DRAIN = false;
    int sgoff; int first;
    __device__ __forceinline__ void operator()(const f32x4 (&acc)[2][2][4][2], const pg8::Unit& u, int wr, int wc, int fr_in, int fq_in) const {
        const int ln_ = lane_fresh(); const int fr = ln_ & 15, fq = ln_ >> 4; (void)fr_in; (void)fq_in;
        const Params p = load_params(); const bf16* SG = (const bf16*)(p.ws + WS_BIG); bf16* YB = (bf16*)(p.ws + WS_BIG + 128 * MiB);
        const int row0 = u.pm * 256 + wr * 64 + fr, col0 = u.pn * 256 + wc * 32 + 8 * fq;
#pragma unroll
        for (int ai = 0; ai < 2; ++ai)
#pragma unroll
            for (int m = 0; m < 4; ++m) {
                const int row = row0 + ai * 128 + m * 16; const size_t ro = (size_t)row * D + col0, so = (size_t)row * (2 * D) + sgoff + col0;
#pragma unroll
                for (int bj = 0; bj < 2; ++bj) {
                    const u32x4 sg = *(const u32x4*)(SG + so + bj * 128);
                    f32x4 v0 = (f32x4){bflo(sg.x), bfhi(sg.x), bflo(sg.y), bfhi(sg.y)} * acc[ai][bj][m][0], v1 = (f32x4){bflo(sg.z), bfhi(sg.z), bflo(sg.w), bfhi(sg.w)} * acc[ai][bj][m][1];
                    if (!first) { const u32x4 y = *(const u32x4*)(YB + ro + bj * 128);
                        v0 = v0 + (f32x4){bflo(y.x), bfhi(y.x), bflo(y.y), bfhi(y.y)}; v1 = v1 + (f32x4){bflo(y.z), bfhi(y.z), bflo(y.w), bfhi(y.w)}; }
                    u32x4 w; w.x = pk2(v0[0], v0[1]); w.y = pk2(v0[2], v0[3]); w.z = pk2(v1[0], v1[1]); w.w = pk2(v1[2], v1[3]); *(u32x4*)(YB + ro + bj * 128) = w;
                }
            }
    }
};

template <class Epi>
__device__ __forceinline__ void run_gemm(LAS unsigned char* lds, const bf16* A, const bf16* Bt, int M, int N, int K, const Epi& E, int wv) {
    pg8::Gemm g{A, Bt, M, N, K}; pg8::StaticOrder S; S.init(M, N, (int)gridDim.x, (int)blockIdx.x);
    pg8::gemm_phase<Epi, pg8::StaticOrder, true, true>((PG8_LAS unsigned char*)lds, g, S, E, wv);
}

__device__ __forceinline__ void tr_item(const float* W, int K, int srcN, int c0, int nv, bf16* WT, int r0, int k0, LAS float* scr, int lane, const float* gain) {
    const int c = lane & 31;
#pragma unroll 8
    for (int i = 0; i < 32; ++i) { const int kk = 2 * i + (lane >> 5); scr[kk * 33 + c] = (c < nv) ? W[(size_t)(k0 + kk) * srcN + c0 + c] * (gain ? gain[k0 + kk] : 1.f) : 0.f; }
    LDS_WAIT();
    const int c8 = lane & 7;
#pragma unroll
    for (int j = 0; j < 4; ++j) { const int n = (lane >> 3) + 8 * j; const LAS float* s = scr + (8 * c8) * 33 + n;
        u32x4 o; o.x = pk2(s[0 * 33], s[1 * 33]); o.y = pk2(s[2 * 33], s[3 * 33]); o.z = pk2(s[4 * 33], s[5 * 33]); o.w = pk2(s[6 * 33], s[7 * 33]);
        if (n < nv) *(u32x4*)(WT + (size_t)(r0 + n) * K + k0 + 8 * c8) = o; }
    LDS_WAIT();
}
struct SegRun { int base, gw, ngw, lane; LAS float* scr; };
__device__ __forceinline__ void run_seg(SegRun& R, const float* W, int K, int srcN, int c0, int ncols, bf16* WT, int r0, const float* gain = nullptr) {
    const int nblk = (ncols + 31) >> 5, nitems = (K >> 6) * nblk;
    int first = (R.gw - (R.base % R.ngw) + R.ngw) % R.ngw;
    for (int it = first; it < nitems; it += R.ngw) { const int kb = it / nblk, nb = it - kb * nblk; const int nv = min(32, ncols - nb * 32);
        tr_item(W, K, srcN, c0 + nb * 32, nv, WT, r0 + nb * 32, kb * 64, R.scr, R.lane, gain); }
    R.base += nitems;
}
__device__ __forceinline__ void convert_weights(const Params& p, int l, SegRun& R) {
    unsigned char* wl = p.ws + WS_W + (size_t)l * WL_STRIDE;
    for (int f = 0; f < 2; ++f) {
        const float* gu = (f ? p.ffn2_gu : p.ffn1_gu) + (size_t)l * D * 2 * FF; bf16* gut = (bf16*)(wl + (f ? WL_GU2 : WL_GU1));
        const float* gn = (f ? p.ffn2_norm : p.ffn1_norm) + l * D;
        for (int sg = 0; sg < 44; ++sg) run_seg(R, gu, D, 2 * FF, sg * 128, 128, gut, (sg % 22) * 256 + (sg / 22) * 128, gn);
        const float* dn = (f ? p.ffn2_down : p.ffn1_down) + (size_t)l * FF * D; bf16* dnt = (bf16*)(wl + (f ? WL_D2 : WL_D1));
        run_seg(R, dn, FF, D, 0, D, dnt, 0);
    }
    const float* wi = p.w_in + (size_t)l * D * NIN; bf16* ina = (bf16*)(wl + WL_INA);
    run_seg(R, wi, D, NIN, 0, 768, ina, 0, p.mix_norm + l * D);
    run_seg(R, wi, D, NIN, 768, 512, ina, 768, p.mix_norm + l * D);
    run_seg(R, wi, D, NIN, 1280, 256, ina, 1280, p.mix_norm + l * D);
    run_seg(R, wi, D, NIN, 1544, 256, ina, 1536, p.mix_norm + l * D);
    run_seg(R, wi, D, NIN, 1800, 768, ina, 1792, p.mix_norm + l * D);
    run_seg(R, wi, D, NIN, 2568, 256, ina, 2560, p.mix_norm + l * D);
    run_seg(R, wi, D, NIN, 2952, 256, ina, 2816, p.mix_norm + l * D);
    run_seg(R, wi, D, NIN, 2824, 128, ina, 3072, p.mix_norm + l * D);
    run_seg(R, wi, D, NIN, 3208, 40, ina, 3200, p.mix_norm + l * D);
    run_seg(R, wi, D, NIN, 1536, 8, ina, 3240, p.mix_norm + l * D);
    run_seg(R, wi, D, NIN, 3248, 4096, (bf16*)(wl + WL_G), 0, p.mix_norm + l * D);
    for (int b = 0; b < 4; ++b) run_seg(R, p.w_branch + ((size_t)l * 4 + b) * 256 * D, 256, D, 0, D, (bf16*)(wl + WL_BR) + (size_t)b * D * 256, 0);
    run_seg(R, p.w_out + (size_t)l * D * D, D, D, 0, D, (bf16*)(wl + WL_OUT), 0);
    for (int i = R.gw * 64 + R.lane; i < 80 * 128; i += R.ngw * 64) *((u32x4*)(ina + (size_t)3248 * D) + i) = (u32x4){0u, 0u, 0u, 0u};
}

__device__ __forceinline__ void xb_rows(const float* X, bf16* XB, u64_t* rs, int gw, int ngw, int lane) {
    for (int m = gw; m < T; m += ngw) {
        const f32x4* xr = (const f32x4*)(X + (size_t)m * D) + lane;
        f32x4 v[4]; float s = 0.f;
#pragma unroll
        for (int j = 0; j < 4; ++j) { v[j] = xr[64 * j]; s += (v[j].x * v[j].x + v[j].y * v[j].y) + (v[j].z * v[j].z + v[j].w * v[j].w); }
        s = wave_sum(s);
        unsigned long long* o8 = (unsigned long long*)(XB + (size_t)m * D) + lane;
#pragma unroll
        for (int j = 0; j < 4; ++j) o8[64 * j] = (unsigned long long)pk2(v[j].x, v[j].y) | ((unsigned long long)pk2(v[j].z, v[j].w) << 32);
        if (lane == 0) rs[m] = (u64_t)(s * 16777216.f);
    }
}

__device__ __forceinline__ void sincos_red(float ang, float& sn, float& cs) {
    const float n = rintf(ang * 0.15915494309189535f);
    float r = fmaf(-n, 6.28125f, ang); r = fmaf(-n, 0.0019353071795864769f, r);
    sn = __sinf(r); cs = __cosf(r);
}
template <int HALF>
__device__ __forceinline__ void rope4(float (&v)[4], int sl, float pos) {
    constexpr int LH = HALF / 4;
    float pv[4];
#pragma unroll
    for (int j = 0; j < 4; ++j) pv[j] = __shfl_xor(v[j], LH);
    if (sl < 2 * LH) {
        const bool first = sl < LH; const int i0 = (sl & (LH - 1)) * 4;
#pragma unroll
        for (int j = 0; j < 4; ++j) {
            constexpr float I4[4] = {1.0f, 0.03760603070259094f, 0.0014142135623842478f, 5.318296098266728e-05f};
            constexpr float I8[8] = {1.0f, 0.1939227432012558f, 0.03760603070259094f, 0.007292664609849453f, 0.0014142135623842478f, 0.00027424818836152554f, 5.318296098266728e-05f, 1.0313386155758053e-05f};
            const float inv = (HALF == 4) ? I4[j] : (i0 ? I8[4 + j] : I8[j]);
            float sn, cs; sincos_red(pos * inv, sn, cs);
            v[j] = first ? (v[j] * cs - pv[j] * sn) : (pv[j] * sn + v[j] * cs);
        }
    }
}
__device__ __forceinline__ void prep_phase(const Params& p, int l, int gw, int ngw, int lane) {
    bf16* Z = (bf16*)(p.ws + WS_BIG); float* ZS = (float*)(p.ws + WS_ZS); bf16* IK = (bf16*)(p.ws + WS_IK);
    const float* dg = p.diff_qk_norm + l * 64; const float* sg = p.dsa_qk_norm + l * 128;
    for (int tok = gw; tok < T; tok += ngw) {
        const float pos = (float)p.pos[tok];
#pragma unroll
        for (int which = 0; which < 2; ++which) {
            unsigned long long* ptr = (unsigned long long*)(Z + (size_t)tok * ZP + which * 256) + lane;
            const unsigned long long w = *ptr; float v[4] = {bflo((unsigned)w), bfhi((unsigned)w), bflo((unsigned)(w >> 32)), bfhi((unsigned)(w >> 32))};
            float ss = (v[0] * v[0] + v[1] * v[1]) + (v[2] * v[2] + v[3] * v[3]);
            ss += __shfl_xor(ss, 1); ss += __shfl_xor(ss, 2); ss += __shfl_xor(ss, 4);
            const float r = 1.f / sqrtf(ss * (1.f / 32.f) + EPS);
            const f32x4 g = *(const f32x4*)(dg + which * 32 + (lane & 7) * 4);
#pragma unroll
            for (int j = 0; j < 4; ++j) v[j] = v[j] * r * g[j];
            rope4<4>(v, lane & 7, pos);
            if (which == 0) {
#pragma unroll
                for (int j = 0; j < 4; ++j) v[j] *= 0.17677669529663687f;
            }
            *ptr = (unsigned long long)pk2(v[0], v[1]) | ((unsigned long long)pk2(v[2], v[3]) << 32);
        }
        {
            unsigned long long* ptr = (unsigned long long*)(Z + (size_t)tok * ZP + 2560) + lane;
            const unsigned long long w = *ptr; float v[4] = {bflo((unsigned)w), bfhi((unsigned)w), bflo((unsigned)(w >> 32)), bfhi((unsigned)(w >> 32))};
            float ss = (v[0] * v[0] + v[1] * v[1]) + (v[2] * v[2] + v[3] * v[3]);
            ss += __shfl_xor(ss, 1); ss += __shfl_xor(ss, 2); ss += __shfl_xor(ss, 4); ss += __shfl_xor(ss, 8);
            const float r = 1.f / sqrtf(ss * (1.f / 64.f) + EPS);
            const f32x4 g = *(const f32x4*)(sg + (lane & 15) * 4);
#pragma unroll
            for (int j = 0; j < 4; ++j) v[j] = v[j] * r * g[j];
            rope4<8>(v, lane & 15, pos);
#pragma unroll
            for (int j = 0; j < 4; ++j) v[j] *= 0.125f;
            *ptr = (unsigned long long)pk2(v[0], v[1]) | ((unsigned long long)pk2(v[2], v[3]) << 32);
        }
        {
            unsigned long long* ptr = (unsigned long long*)(Z + (size_t)tok * ZP + 2816) + lane;
            const unsigned long long w = *ptr; float v[4] = {bflo((unsigned)w), bfhi((unsigned)w), bflo((unsigned)(w >> 32)), bfhi((unsigned)(w >> 32))};
            rope4<4>(v, lane & 7, pos);
            *ptr = (unsigned long long)pk2(v[0], v[1]) | ((unsigned long long)pk2(v[2], v[3]) << 32);
        }
        {
            float* ptr = ZS + (size_t)tok * ZSP + (lane & 15) * 4;
            const f32x4 x = *(const f32x4*)ptr; float v[4] = {x[0], x[1], x[2], x[3]};
            float ss = (v[0] * v[0] + v[1] * v[1]) + (v[2] * v[2] + v[3] * v[3]);
            ss += __shfl_xor(ss, 1); ss += __shfl_xor(ss, 2); ss += __shfl_xor(ss, 4); ss += __shfl_xor(ss, 8);
            const float r = 1.f / sqrtf(ss * (1.f / 64.f) + EPS);
            const f32x4 g = *(const f32x4*)(sg + 64 + (lane & 15) * 4);
#pragma unroll
            for (int j = 0; j < 4; ++j) v[j] = v[j] * r * g[j];
            rope4<8>(v, lane & 15, pos);
            if (lane < 16) *(f32x4*)ptr = (f32x4){v[0], v[1], v[2], v[3]};
        }
        {
            const float* ptr = ZS + (size_t)tok * ZSP + 128 + (lane & 7) * 4;
            const f32x4 x = *(const f32x4*)ptr; float v[4] = {x[0], x[1], x[2], x[3]};
            rope4<4>(v, lane & 7, pos);
            if (lane < 8) *((unsigned long long*)(IK + (size_t)tok * 32) + lane) = (unsigned long long)pk2(v[0], v[1]) | ((unsigned long long)pk2(v[2], v[3]) << 32);
        }
    }
}
__device__ __forceinline__ void mlstm_item(const Params& p, int l, int bh, LAS unsigned char* lds, int wv) {
    const int tid = tid_fresh(wv), lane = tid & 63, b = bh >> 2, h = bh & 3;
    const bf16* Z = (const bf16*)(p.ws + WS_BIG); const float* ZS = (const float*)(p.ws + WS_ZS); bf16* O1 = (bf16*)(p.ws + WS_O + OB_STRIDE);
    LAS float* nv = (LAS float*)lds; LAS float* bc = nv + 64; LAS float* igs = bc + 64; LAS float* wks = igs + 64; LAS float* sc = wks + 64;
    LAS float* Qs = sc + 64; LAS float* Ks = Qs + 64 * 65; LAS float* Vs = Ks + 64 * 65; LAS float* Ss = Vs + 64 * 65; LAS float* Cs = Ss + 64 * 65;
    for (int i = tid; i < 64 * 65; i += NTHR) Cs[i] = 0.f;
    if (tid < 64) nv[tid] = 0.f;
    float mcar = 0.f;
    const int r = tid >> 3, sg = tid & 7;
    const int cc0 = sg * 16; const int ch0 = (cc0 < 64) ? (h * 64 + cc0) : (256 + h * 64 + cc0 - 64);
    const float* cw0 = p.ml_conv_w + (size_t)l * 4 * 512; const float* cb0 = p.ml_conv_b + (size_t)l * 512;
    const int zc0 = (cc0 < 64) ? (768 + h * 64 + cc0) : (1024 + h * 64 + cc0 - 64);
    const float gb_i = p.ml_gate_bias[(l * 2 + 0) * 4 + h], gb_f = p.ml_gate_bias[(l * 2 + 1) * 4 + h];
    const float qsc = (cc0 < 64) ? 0.125f : 1.0f;
    __syncthreads();
    for (int c = 0; c < 64; ++c) {
        const int t0 = c * 64; const size_t tok0 = (size_t)b * SEQ + t0;
        const float* cw = cw0; const float* cb = cb0; asm volatile("" : "+s"(cw), "+s"(cb));
        {
            float y[16];
#pragma unroll
            for (int i = 0; i < 16; ++i) y[i] = cb[ch0 + i];
#pragma unroll
            for (int j = 0; j < 4; ++j) {
                const int tt = t0 + r - 3 + j;
                if (tt >= 0) {
                    const u32x4* xp = (const u32x4*)(Z + ((size_t)b * SEQ + tt) * ZP + zc0); const u32x4 x0 = xp[0], x1 = xp[1];
                    const float xv[16] = {bflo(x0.x), bfhi(x0.x), bflo(x0.y), bfhi(x0.y), bflo(x0.z), bfhi(x0.z), bflo(x0.w), bfhi(x0.w),
                                          bflo(x1.x), bfhi(x1.x), bflo(x1.y), bfhi(x1.y), bflo(x1.z), bfhi(x1.z), bflo(x1.w), bfhi(x1.w)};
#pragma unroll
                    for (int i = 0; i < 16; ++i) y[i] = fmaf(cw[j * 512 + ch0 + i], xv[i], y[i]);
                }
            }
            LAS float* dst = (cc0 < 64) ? (Qs + r * 65 + cc0) : (Ks + r * 65 + cc0 - 64);
#pragma unroll
            for (int i = 0; i < 16; ++i) dst[i] = y[i] * sigmoidf_(y[i]) * qsc;
            const u32x4 vv = *(const u32x4*)(Z + (tok0 + r) * ZP + 1280 + h * 64 + sg * 8);
            LAS float* vd = Vs + r * 65 + sg * 8;
            vd[0] = bflo(vv.x); vd[1] = bfhi(vv.x); vd[2] = bflo(vv.y); vd[3] = bfhi(vv.y); vd[4] = bflo(vv.z); vd[5] = bfhi(vv.z); vd[6] = bflo(vv.w); vd[7] = bfhi(vv.w);
        }
        if (tid < 64) {
            const float ig = ZS[(tok0 + tid) * ZSP + 168 + h] + gb_i;
            const float fz = ZS[(tok0 + tid) * ZSP + 172 + h] + gb_f;
            const float lf = fminf(fz, 0.f) - log1pf(__expf(-fabsf(fz)));
            float bsum = lf;
#pragma unroll
            for (int d = 1; d < 64; d <<= 1) { const float n = __shfl_up(bsum, d); if (lane >= d) bsum += n; }
            const float bl = __shfl(bsum, 63);
            const float g = bl - bsum + ig;
            const float mnew = fmaxf(bl + mcar, wave_max(g));
            bc[tid] = bsum; igs[tid] = ig; wks[tid] = __expf(g - mnew);
            if (tid == 0) { sc[0] = mnew; sc[1] = __expf(bl + mcar - mnew); sc[2] = bl; }
        }
        __syncthreads();
        const float bt = bc[r];
        float mx = -INFINITY;
#pragma unroll
        for (int i = 0; i < 8; ++i) { const int s = sg * 8 + i; const float dli = (s <= r) ? (bt - bc[s] + igs[s]) : -INFINITY; mx = fmaxf(mx, dli); }
        mx = fmaxf(mx, __shfl_xor(mx, 1)); mx = fmaxf(mx, __shfl_xor(mx, 2)); mx = fmaxf(mx, __shfl_xor(mx, 4));
        const float inter = bt + mcar; const float mt = fmaxf(inter, mx); const float iw = __expf(inter - mt);
        float ssum = 0.f;
#pragma unroll 1
        for (int i = 0; i < 8; ++i) { const int s = sg * 8 + i; float dot = 0.f;
#pragma unroll 16
            for (int d = 0; d < 64; ++d) dot = fmaf(Qs[r * 65 + d], Ks[s * 65 + d], dot);
            const float dli = (s <= r) ? (bt - bc[s] + igs[s]) : -INFINITY;
            const float sv = dot * __expf(dli - mt); Ss[r * 65 + s] = sv; ssum += sv; }
        ssum += __shfl_xor(ssum, 1); ssum += __shfl_xor(ssum, 2); ssum += __shfl_xor(ssum, 4);
        float qn = 0.f;
#pragma unroll
        for (int d = 0; d < 64; ++d) qn = fmaf(Qs[r * 65 + d], nv[d], qn);
        const float den = iw * qn + ssum;
        __syncthreads();
        {
            float num[8];
#pragma unroll
            for (int i = 0; i < 8; ++i) num[i] = 0.f;
#pragma unroll 8
            for (int d = 0; d < 64; ++d) { const float qd = Qs[r * 65 + d];
#pragma unroll
                for (int i = 0; i < 8; ++i) num[i] = fmaf(qd, Cs[d * 65 + sg * 8 + i], num[i]); }
#pragma unroll
            for (int i = 0; i < 8; ++i) num[i] *= iw;
#pragma unroll 8
            for (int s = 0; s < 64; ++s) { const float sv = Ss[r * 65 + s];
#pragma unroll
                for (int i = 0; i < 8; ++i) num[i] = fmaf(sv, Vs[s * 65 + sg * 8 + i], num[i]); }
            const float dn = 1.f / fmaxf(fabsf(den), __expf(-mt));
            float hs = 0.f;
#pragma unroll
            for (int i = 0; i < 8; ++i) { num[i] *= dn; hs = fmaf(num[i], num[i], hs); }
            hs += __shfl_xor(hs, 1); hs += __shfl_xor(hs, 2); hs += __shfl_xor(hs, 4);
            const float rr = 1.f / sqrtf(hs * (1.f / 64.f) + EPS);
            const u32x4 og = *(const u32x4*)(Z + (tok0 + r) * ZP + 1536 + h * 64 + sg * 8);
            const float ogv[8] = {bflo(og.x), bfhi(og.x), bflo(og.y), bfhi(og.y), bflo(og.z), bfhi(og.z), bflo(og.w), bfhi(og.w)};
            const float* hg = p.ml_head_norm + l * 64 + sg * 8;
            float o[8];
#pragma unroll
            for (int i = 0; i < 8; ++i) o[i] = sigmoidf_(ogv[i]) * (num[i] * rr * hg[i]);
            u32x4 w; w.x = pk2(o[0], o[1]); w.y = pk2(o[2], o[3]); w.z = pk2(o[4], o[5]); w.w = pk2(o[6], o[7]);
            *(u32x4*)(O1 + (tok0 + r) * 256 + h * 64 + sg * 8) = w;
        }
        __syncthreads();
        {
            const float decay = sc[1];
            float cacc[8]; float nacc = 0.f;
#pragma unroll
            for (int i = 0; i < 8; ++i) cacc[i] = 0.f;
#pragma unroll 8
            for (int s = 0; s < 64; ++s) { const float kw = wks[s] * Ks[s * 65 + r]; nacc += kw;
#pragma unroll
                for (int i = 0; i < 8; ++i) cacc[i] = fmaf(kw, Vs[s * 65 + sg * 8 + i], cacc[i]); }
#pragma unroll
            for (int i = 0; i < 8; ++i) Cs[r * 65 + sg * 8 + i] = decay * Cs[r * 65 + sg * 8 + i] + cacc[i];
            if (sg == 0) nv[r] = decay * nv[r] + nacc;
            mcar = sc[0];
        }
        __syncthreads();
    }
}

__device__ __forceinline__ void diff_item(const Params& p, int l, int bh, int qt, LAS unsigned char* lds, int wv) {
    const int tid = tid_fresh(wv), b = bh >> 2, h = bh & 3, q0 = qt * 128;
    const bf16* Z = (const bf16*)(p.ws + WS_BIG); bf16* O0 = (bf16*)(p.ws + WS_O);
    LAS float* Kt = (LAS float*)lds; LAS float* Vt = Kt + 64 * 64;
    const int ql = tid >> 2, part = tid & 3, c = part & 1, dvh = part >> 1, t = q0 + ql; const size_t tok = (size_t)b * SEQ + t;
    const float* lp = p.diff_lambda + l * 128; float s01 = 0.f, s23 = 0.f, gqm = 0.f, gkm = 0.f;
#pragma unroll 2
    for (int i = 0; i < 32; ++i) { s01 = fmaf(lp[i], lp[32 + i], s01); s23 = fmaf(lp[64 + i], lp[96 + i], s23);
        gqm = fmaxf(gqm, fabsf(p.diff_qk_norm[l * 64 + i])); gkm = fmaxf(gkm, fabsf(p.diff_qk_norm[l * 64 + 32 + i])); }
    const float lam_init = 0.8f - 0.6f * __expf(-0.3f * (float)l); const float lam = __expf(s01) - __expf(s23) + lam_init;
    const float coff = 5.65685424949238f * gqm * gkm;
    float q[32], o[32];
    { const u32x4* qp = (const u32x4*)(Z + tok * ZP + h * 64 + c * 32);
#pragma unroll
      for (int i = 0; i < 4; ++i) { const u32x4 w = qp[i]; q[8 * i] = bflo(w.x); q[8 * i + 1] = bfhi(w.x); q[8 * i + 2] = bflo(w.y); q[8 * i + 3] = bfhi(w.y); q[8 * i + 4] = bflo(w.z); q[8 * i + 5] = bfhi(w.z); q[8 * i + 6] = bflo(w.w); q[8 * i + 7] = bfhi(w.w); } }
#pragma unroll
    for (int i = 0; i < 32; ++i) o[i] = 0.f;
    float lsum = 0.f;
    const int nkt = (q0 + 128) / 64;
    const int lk = tid >> 3, lsg = tid & 7;
    for (int kt = 0; kt < nkt; ++kt) {
        __syncthreads();
        { const size_t ktok = (size_t)b * SEQ + kt * 64 + lk;
          const bf16* src = Z + ktok * ZP + ((lsg < 4) ? (256 + h * 64 + lsg * 16) : (512 + h * 64 + (lsg - 4) * 16));
          const u32x4 x0 = ((const u32x4*)src)[0], x1 = ((const u32x4*)src)[1];
          LAS float* dst = ((lsg < 4) ? (Kt + lk * 64 + lsg * 16) : (Vt + lk * 64 + (lsg - 4) * 16));
          *(LAS f32x4*)(dst) = (f32x4){bflo(x0.x), bfhi(x0.x), bflo(x0.y), bfhi(x0.y)}; *(LAS f32x4*)(dst + 4) = (f32x4){bflo(x0.z), bfhi(x0.z), bflo(x0.w), bfhi(x0.w)};
          *(LAS f32x4*)(dst + 8) = (f32x4){bflo(x1.x), bfhi(x1.x), bflo(x1.y), bfhi(x1.y)}; *(LAS f32x4*)(dst + 12) = (f32x4){bflo(x1.z), bfhi(x1.z), bflo(x1.w), bfhi(x1.w)}; }
        __syncthreads();
        const int kmax = t - kt * 64 + 1;
        for (int key = 0; key < 64; ++key) {
            const LAS f32x4* kr = (const LAS f32x4*)(Kt + key * 64 + c * 32);
            float s = 0.f;
#pragma unroll
            for (int i = 0; i < 8; ++i) { const f32x4 kv = kr[i]; s = fmaf(q[4 * i], kv[0], s); s = fmaf(q[4 * i + 1], kv[1], s); s = fmaf(q[4 * i + 2], kv[2], s); s = fmaf(q[4 * i + 3], kv[3], s); }
            const float pe = (key < kmax) ? __expf(s - coff) : 0.f;
            lsum += pe;
            const LAS f32x4* vr = (const LAS f32x4*)(Vt + key * 64 + dvh * 32);
#pragma unroll
            for (int i = 0; i < 8; ++i) { const f32x4 vv = vr[i]; o[4 * i] = fmaf(pe, vv[0], o[4 * i]); o[4 * i + 1] = fmaf(pe, vv[1], o[4 * i + 1]); o[4 * i + 2] = fmaf(pe, vv[2], o[4 * i + 2]); o[4 * i + 3] = fmaf(pe, vv[3], o[4 * i + 3]); }
        }
    }
    const float inv = 1.f / lsum; float ss = 0.f;
#pragma unroll
    for (int i = 0; i < 32; ++i) { const float my = o[i] * inv; const float ot = __shfl_xor(my, 1); o[i] = (c == 0) ? (my - lam * ot) : (ot - lam * my); ss = fmaf(o[i], o[i], ss); }
    ss += __shfl_xor(ss, 2);
    const float rr = (1.f - lam_init) / sqrtf(ss * (1.f / 64.f) + EPS);
    if (c == 0) {
        const float* hg = p.diff_head_norm + l * 64 + dvh * 32; u32x4* dst = (u32x4*)(O0 + tok * 256 + h * 64 + dvh * 32);
#pragma unroll
        for (int i = 0; i < 4; ++i) { u32x4 w; w.x = pk2(o[8 * i] * rr * hg[8 * i], o[8 * i + 1] * rr * hg[8 * i + 1]); w.y = pk2(o[8 * i + 2] * rr * hg[8 * i + 2], o[8 * i + 3] * rr * hg[8 * i + 3]);
            w.z = pk2(o[8 * i + 4] * rr * hg[8 * i + 4], o[8 * i + 5] * rr * hg[8 * i + 5]); w.w = pk2(o[8 * i + 6] * rr * hg[8 * i + 6], o[8 * i + 7] * rr * hg[8 * i + 7]); dst[i] = w; }
    }
    __syncthreads();
}

__device__ __forceinline__ unsigned pkbf(float lo, float hi) { unsigned r; asm("v_cvt_pk_bf16_f32 %0, %1, %2" : "=v"(r) : "v"(lo), "v"(hi)); return r; }
__device__ __forceinline__ void diffm_item(const Params& p, int l, int bh, int qb, LAS unsigned char* lds, int wv) {
    const int tid = tid_fresh(wv), lane = tid & 63, half = lane >> 5, r32 = lane & 31, b = bh >> 2, h = bh & 3;
    const bf16* Z = (const bf16*)(p.ws + WS_BIG); bf16* O0 = (bf16*)(p.ws + WS_O);
    LAS bf16* Ks = (LAS bf16*)lds; LAS bf16* Vt = Ks + 64 * 72;
    const float* lp = p.diff_lambda + l * 128; float s01 = 0.f, s23 = 0.f, gqm = 0.f, gkm = 0.f;
#pragma unroll 2
    for (int i = 0; i < 32; ++i) { s01 = fmaf(lp[i], lp[32 + i], s01); s23 = fmaf(lp[64 + i], lp[96 + i], s23);
        gqm = fmaxf(gqm, fabsf(p.diff_qk_norm[l * 64 + i])); gkm = fmaxf(gkm, fabsf(p.diff_qk_norm[l * 64 + 32 + i])); }
    const float lam_init = 0.8f - 0.6f * __expf(-0.3f * (float)l); const float lam = __expf(s01) - __expf(s23) + lam_init;
    const float coff = 5.65685424949238f * gqm * gkm;
    const int qw = qb * 256 + 32 * wv;
    const size_t tokb = (size_t)b * SEQ;
    s16x8 qf[2][2];
    { const bf16* qp = Z + (tokb + qw + r32) * ZP + h * 64 + half * 8;
#pragma unroll
      for (int c = 0; c < 2; ++c)
#pragma unroll
          for (int s = 0; s < 2; ++s) qf[c][s] = *(const s16x8*)(qp + c * 32 + 16 * s); }
    f32x16 oacc[2][2];
#pragma unroll
    for (int c = 0; c < 2; ++c)
#pragma unroll
        for (int db = 0; db < 2; ++db)
#pragma unroll
            for (int r = 0; r < 16; ++r) oacc[c][db][r] = 0.f;
    float ls0 = 0.f, ls1 = 0.f;
    const int nt = (qb + 1) * 4;
    const int kkey = tid >> 3, kch = tid & 7, vkey = tid & 63, vdc = tid >> 6;
    const bf16* kgp = Z + (tokb + kkey) * ZP + 256 + h * 64 + kch * 8;
    const bf16* vgp = Z + (tokb + vkey) * ZP + 512 + h * 64 + vdc * 8;
    u32x4 kreg = *(const u32x4*)kgp, vreg = *(const u32x4*)vgp;
#pragma unroll 1
    for (int t = 0; t < nt; ++t) {
        __syncthreads();
        *(LAS u32x4*)(Ks + kkey * 72 + kch * 8) = kreg;
        { LAS bf16* vd = Vt + (vdc * 8) * 72 + vkey;
          vd[0] = (bf16)(vreg.x & 0xffffu); vd[72] = (bf16)(vreg.x >> 16); vd[144] = (bf16)(vreg.y & 0xffffu); vd[216] = (bf16)(vreg.y >> 16);
          vd[288] = (bf16)(vreg.z & 0xffffu); vd[360] = (bf16)(vreg.z >> 16); vd[432] = (bf16)(vreg.w & 0xffffu); vd[504] = (bf16)(vreg.w >> 16); }
        __syncthreads();
        if (t + 1 < nt) { kreg = *(const u32x4*)(kgp + (size_t)(t + 1) * 64 * ZP); vreg = *(const u32x4*)(vgp + (size_t)(t + 1) * 64 * ZP); }
        const int k0 = t * 64;
#pragma unroll 1
        for (int sub = 0; sub < 2; ++sub) {
            const int kb = k0 + 32 * sub;
            if (kb <= qw + 31) {
                f32x16 s0, s1;
#pragma unroll
                for (int r = 0; r < 16; ++r) { s0[r] = 0.f; s1[r] = 0.f; }
                const LAS bf16* kr = Ks + (32 * sub + r32) * 72 + 8 * half;
#pragma unroll
                for (int s = 0; s < 2; ++s) {
                    const s16x8 a0 = *(const LAS s16x8*)(kr + 16 * s), a1 = *(const LAS s16x8*)(kr + 32 + 16 * s);
                    s0 = __builtin_amdgcn_mfma_f32_32x32x16_bf16(a0, qf[0][s], s0, 0, 0, 0);
                    s1 = __builtin_amdgcn_mfma_f32_32x32x16_bf16(a1, qf[1][s], s1, 0, 0, 0);
                }
                const bool diag = (kb + 31 > qw);
#pragma unroll
                for (int r = 0; r < 16; ++r) {
                    float p0 = __expf(s0[r] - coff), p1 = __expf(s1[r] - coff);
                    if (diag) { const int key = kb + 8 * (r >> 2) + 4 * half + (r & 3); if (key > qw + r32) { p0 = 0.f; p1 = 0.f; } }
                    ls0 += p0; ls1 += p1; s0[r] = p0; s1[r] = p1;
                }
#pragma unroll
                for (int s = 0; s < 2; ++s) {
                    u32x4 w0, w1;
                    w0.x = pkbf(s0[8 * s], s0[8 * s + 1]); w0.y = pkbf(s0[8 * s + 2], s0[8 * s + 3]); w0.z = pkbf(s0[8 * s + 4], s0[8 * s + 5]); w0.w = pkbf(s0[8 * s + 6], s0[8 * s + 7]);
                    w1.x = pkbf(s1[8 * s], s1[8 * s + 1]); w1.y = pkbf(s1[8 * s + 2], s1[8 * s + 3]); w1.z = pkbf(s1[8 * s + 4], s1[8 * s + 5]); w1.w = pkbf(s1[8 * s + 6], s1[8 * s + 7]);
                    const s16x8 pf0 = __builtin_bit_cast(s16x8, w0), pf1 = __builtin_bit_cast(s16x8, w1);
#pragma unroll
                    for (int db = 0; db < 2; ++db) {
                        const LAS bf16* vr = Vt + (db * 32 + r32) * 72 + 32 * sub + 16 * s + 4 * half;
                        const u32x2 v0 = *(const LAS u32x2*)vr, v1 = *(const LAS u32x2*)(vr + 8);
                        const u32x4 vv = (u32x4){v0.x, v0.y, v1.x, v1.y};
                        const s16x8 vf = __builtin_bit_cast(s16x8, vv);
                        oacc[0][db] = __builtin_amdgcn_mfma_f32_32x32x16_bf16(vf, pf0, oacc[0][db], 0, 0, 0);
                        oacc[1][db] = __builtin_amdgcn_mfma_f32_32x32x16_bf16(vf, pf1, oacc[1][db], 0, 0, 0);
                    }
                }
            }
        }
    }
    ls0 += __shfl_xor(ls0, 32); ls1 += __shfl_xor(ls1, 32);
    const float i0 = 1.f / ls0, i1 = lam / ls1;
    float ss = 0.f;
#pragma unroll
    for (int db = 0; db < 2; ++db)
#pragma unroll
        for (int r = 0; r < 16; ++r) { const float v = oacc[0][db][r] * i0 - oacc[1][db][r] * i1; oacc[0][db][r] = v; ss = fmaf(v, v, ss); }
    ss += __shfl_xor(ss, 32);
    const float rr = (1.f - lam_init) / sqrtf(ss * (1.f / 64.f) + EPS);
    const float* hg = p.diff_head_norm + l * 64;
    bf16* orow = O0 + (tokb + qw + r32) * 256 + h * 64;
#pragma unroll
    for (int db = 0; db < 2; ++db)
#pragma unroll
        for (int g = 0; g < 4; ++g) { const int d0 = db * 32 + 8 * g + 4 * half; const f32x4 gg = *(const f32x4*)(hg + d0);
            u32x2 w; w.x = pkbf(oacc[0][db][4 * g] * rr * gg[0], oacc[0][db][4 * g + 1] * rr * gg[1]); w.y = pkbf(oacc[0][db][4 * g + 2] * rr * gg[2], oacc[0][db][4 * g + 3] * rr * gg[3]);
            *(u32x2*)(orow + d0) = w; }
    __syncthreads();
}

__device__ __forceinline__ void sb_item(const Params& p, int bh, int g, LAS unsigned char* lds, int wv) {
    const int tid = tid_fresh(wv), lane = tid & 63, w = tid >> 6, b = bh >> 2, h = bh & 3;
    const bf16* Z = (const bf16*)(p.ws + WS_BIG); bf16* O2 = (bf16*)(p.ws + WS_O + 2 * OB_STRIDE);
    LAS float* KV = (LAS float*)lds + w * 4096;
    const int t0 = g * 512 + w * 64, t = t0 + lane; const size_t tok = (size_t)b * SEQ + t;
    float q[64], o[64];
    { const u32x4* qp = (const u32x4*)(Z + tok * ZP + 1792 + h * 64);
#pragma unroll
      for (int i = 0; i < 8; ++i) { const u32x4 x = qp[i]; q[8 * i] = bflo(x.x); q[8 * i + 1] = bfhi(x.x); q[8 * i + 2] = bflo(x.y); q[8 * i + 3] = bfhi(x.y); q[8 * i + 4] = bflo(x.z); q[8 * i + 5] = bfhi(x.z); q[8 * i + 6] = bflo(x.w); q[8 * i + 7] = bfhi(x.w); } }
#pragma unroll
    for (int i = 0; i < 64; ++i) o[i] = 0.f;
    float R = 0.f;
    const int lkey = lane >> 1, lhalf = lane & 1;
    for (int slo = t0 + 32; slo >= 0; slo -= 32) {
        asm volatile("s_waitcnt lgkmcnt(0)" ::: "memory");
        { const size_t ktok = (size_t)b * SEQ + slo + lkey;
          const u32x4* ks = (const u32x4*)(Z + ktok * ZP + 2048 + h * 64 + lhalf * 32); const u32x4* vs = (const u32x4*)(Z + ktok * ZP + 2304 + h * 64 + lhalf * 32);
          LAS float* kd = KV + lkey * 128 + lhalf * 32; LAS float* vd = kd + 64;
#pragma unroll
          for (int i = 0; i < 4; ++i) { const u32x4 x = ks[i]; *(LAS f32x4*)(kd + 8 * i) = (f32x4){bflo(x.x), bfhi(x.x), bflo(x.y), bfhi(x.y)}; *(LAS f32x4*)(kd + 8 * i + 4) = (f32x4){bflo(x.z), bfhi(x.z), bflo(x.w), bfhi(x.w)}; }
#pragma unroll
          for (int i = 0; i < 4; ++i) { const u32x4 x = vs[i]; *(LAS f32x4*)(vd + 8 * i) = (f32x4){bflo(x.x), bfhi(x.x), bflo(x.y), bfhi(x.y)}; *(LAS f32x4*)(vd + 8 * i + 4) = (f32x4){bflo(x.z), bfhi(x.z), bflo(x.w), bfhi(x.w)}; } }
        asm volatile("s_waitcnt lgkmcnt(0)" ::: "memory");
        for (int kk = 31; kk >= 0; --kk) {
            const int s = slo + kk; const bool act = s < t;
            const LAS f32x4* kr = (const LAS f32x4*)(KV + kk * 128);
            float z = 0.f;
#pragma unroll
            for (int i = 0; i < 16; ++i) { const f32x4 kv = kr[i]; z = fmaf(q[4 * i], kv[0], z); z = fmaf(q[4 * i + 1], kv[1], z); z = fmaf(q[4 * i + 2], kv[2], z); z = fmaf(q[4 * i + 3], kv[3], z); }
            z *= 0.125f;
            const float lb = fminf(z, 0.f) - __logf(1.f + __expf(-fabsf(z)));
            const float a = act ? __expf(lb + R) : 0.f;
            R += act ? (lb - z) : 0.f;
#pragma unroll
            for (int i = 0; i < 16; ++i) { const f32x4 vv = kr[16 + i]; o[4 * i] = fmaf(a, vv[0], o[4 * i]); o[4 * i + 1] = fmaf(a, vv[1], o[4 * i + 1]); o[4 * i + 2] = fmaf(a, vv[2], o[4 * i + 2]); o[4 * i + 3] = fmaf(a, vv[3], o[4 * i + 3]); }
        }
        if (__all(R < -104.f)) break;
    }
    u32x4* dst = (u32x4*)(O2 + tok * 256 + h * 64);
#pragma unroll
    for (int i = 0; i < 8; ++i) { u32x4 x; x.x = pk2(o[8 * i], o[8 * i + 1]); x.y = pk2(o[8 * i + 2], o[8 * i + 3]); x.z = pk2(o[8 * i + 4], o[8 * i + 5]); x.w = pk2(o[8 * i + 6], o[8 * i + 7]); dst[i] = x; }
    asm volatile("s_waitcnt lgkmcnt(0)" ::: "memory");
}
constexpr size_t WS_MLS = 460 * MiB, WS_DEC = WS_MLS + 5 * 32 * 4096 * 4, WS_UN = 463 * MiB, WS_NV = WS_UN + 512 * 1024, WS_UT = 464 * MiB, WS_CT = 496 * MiB, WS_END2 = 512 * MiB;
constexpr int MLN = 32 * 4096;
__device__ __forceinline__ void ml_prepass(const Params& p, int l, int bh, int lane) {
    const int b = bh >> 2, h = bh & 3; const float* ZS = (const float*)(p.ws + WS_ZS);
    float* MLS = (float*)(p.ws + WS_MLS); float* DEC = (float*)(p.ws + WS_DEC);
    const float gb_i = p.ml_gate_bias[(l * 2 + 0) * 4 + h], gb_f = p.ml_gate_bias[(l * 2 + 1) * 4 + h];
    float cA = 0.f, cB = 0.f;
#pragma unroll 1
    for (int c4 = 0; c4 < 16; ++c4) {
        float igv[4], fzv[4];
#pragma unroll
        for (int k = 0; k < 4; ++k) { const size_t tok = (size_t)b * SEQ + (c4 * 4 + k) * 64 + lane; igv[k] = ZS[tok * ZSP + 168 + h]; fzv[k] = ZS[tok * ZSP + 172 + h]; }
#pragma unroll
        for (int k = 0; k < 4; ++k) {
            const int c = c4 * 4 + k;
            const float ig = igv[k] + gb_i, fz = fzv[k] + gb_f;
            const float lf = fminf(fz, 0.f) - __logf(1.f + __expf(-fabsf(fz)));
            float bsum = lf;
#pragma unroll
            for (int d = 1; d < 64; d <<= 1) { const float n = __shfl_up(bsum, d); if (lane >= d) bsum += n; }
            const float bl = __shfl(bsum, 63);
            const float a = ig - bsum;
            float pm = a;
#pragma unroll
            for (int d = 1; d < 64; d <<= 1) { const float n = __shfl_up(pm, d); if (lane >= d) pm = fmaxf(pm, n); }
            const float gmax = bl + __shfl(pm, 63);
            const int ti = bh * 4096 + c * 64 + lane;
            MLS[ti] = bsum; MLS[MLN + ti] = a; MLS[2 * MLN + ti] = pm;
            cA = (lane == c) ? bl : cA; cB = (lane == c) ? gmax : cB;
        }
    }
    float sA = cA, sB = cB;
#pragma unroll
    for (int d = 1; d < 64; d <<= 1) { const float pA = __shfl_up(sA, d), pB = __shfl_up(sB, d); if (lane >= d) { sB = fmaxf(pB + sA, sB); sA = pA + sA; } }
    const float m_out = fmaxf(sA, sB);
    float m_in = __shfl_up(m_out, 1); if (lane == 0) m_in = 0.f;
    DEC[bh * 64 + lane] = __expf(cA + m_in - m_out);
    asm volatile("s_waitcnt vmcnt(0)" ::: "memory");
#pragma unroll 1
    for (int c4 = 0; c4 < 16; ++c4) {
        float bsv[4], av[4], pmv[4];
#pragma unroll
        for (int k = 0; k < 4; ++k) { const int ti = bh * 4096 + (c4 * 4 + k) * 64 + lane; bsv[k] = MLS[ti]; av[k] = MLS[MLN + ti]; pmv[k] = MLS[2 * MLN + ti]; }
#pragma unroll
        for (int k = 0; k < 4; ++k) {
            const int c = c4 * 4 + k;
            const float mi = __shfl(m_in, c), mo = __shfl(m_out, c), bl = __shfl(cA, c);
            const int ti = bh * 4096 + c * 64 + lane;
            const float mt = bsv[k] + fmaxf(mi, pmv[k]);
            MLS[2 * MLN + ti] = mt; MLS[3 * MLN + ti] = __expf(bl + av[k] - mo); MLS[4 * MLN + ti] = __expf(bsv[k] + mi - mt);
        }
    }
}
__device__ __forceinline__ void ml_conv8(const bf16* Z, const float* cw, const float* cb, int b, int t, int ch0, float (&y)[8]) {
    const f32x4 b0 = *(const f32x4*)(cb + ch0), b1 = *(const f32x4*)(cb + ch0 + 4);
    y[0] = b0[0]; y[1] = b0[1]; y[2] = b0[2]; y[3] = b0[3]; y[4] = b1[0]; y[5] = b1[1]; y[6] = b1[2]; y[7] = b1[3];
#pragma unroll
    for (int j = 0; j < 4; ++j) {
        const int tt = t - 3 + j;
        if (tt >= 0) {
            const u32x4 x = *(const u32x4*)(Z + ((size_t)b * SEQ + tt) * ZP + 768 + ch0);
            const f32x4 w0 = *(const f32x4*)(cw + j * 512 + ch0), w1 = *(const f32x4*)(cw + j * 512 + ch0 + 4);
            y[0] = fmaf(w0[0], bflo(x.x), y[0]); y[1] = fmaf(w0[1], bfhi(x.x), y[1]); y[2] = fmaf(w0[2], bflo(x.y), y[2]); y[3] = fmaf(w0[3], bfhi(x.y), y[3]);
            y[4] = fmaf(w1[0], bflo(x.z), y[4]); y[5] = fmaf(w1[1], bfhi(x.z), y[5]); y[6] = fmaf(w1[2], bflo(x.w), y[6]); y[7] = fmaf(w1[3], bfhi(x.w), y[7]);
        }
    }
#pragma unroll
    for (int i = 0; i < 8; ++i) y[i] = y[i] * sigmoidf_(y[i]);
}
__device__ __forceinline__ void mlB_item(const Params& p, int l, int bh, int ci, LAS unsigned char* lds, int wv) {
    const int tid = tid_fresh(wv), lane = tid & 63, half = lane >> 5, r32 = lane & 31, b = bh >> 2, h = bh & 3;
    const bf16* Z = (const bf16*)(p.ws + WS_BIG); const float* MLS = (const float*)(p.ws + WS_MLS);
    float* UT = (float*)(p.ws + WS_UT); float* UN = (float*)(p.ws + WS_UN);
    LAS bf16* KT = (LAS bf16*)lds; LAS bf16* VT = KT + 4 * 64 * 72;
    const float* cw = p.ml_conv_w + (size_t)l * 4 * 512; const float* cb = p.ml_conv_b + (size_t)l * 512;
    __syncthreads();
    {
        const int tt = tid >> 1, hr = tid & 1, cl = tt >> 6, s = tt & 63, t = (ci * 4) * 64 + tt;
        const float wk = MLS[3 * MLN + bh * 4096 + t];
#pragma unroll 1
        for (int q8 = 0; q8 < 4; ++q8) {
            const int d0 = hr * 32 + q8 * 8; float y[8];
            ml_conv8(Z, cw, cb, b, t, 256 + h * 64 + d0, y);
            LAS bf16* dst = KT + (cl * 64 + d0) * 72 + s;
#pragma unroll
            for (int i = 0; i < 8; ++i) dst[i * 72] = (bf16)f2bf(y[i] * wk);
            const u32x4 v = *(const u32x4*)(Z + ((size_t)b * SEQ + t) * ZP + 1280 + h * 64 + d0);
            LAS bf16* vd = VT + (cl * 64 + d0) * 72 + s;
            vd[0] = (bf16)(v.x & 0xffffu); vd[72] = (bf16)(v.x >> 16); vd[144] = (bf16)(v.y & 0xffffu); vd[216] = (bf16)(v.y >> 16);
            vd[288] = (bf16)(v.z & 0xffffu); vd[360] = (bf16)(v.z >> 16); vd[432] = (bf16)(v.w & 0xffffu); vd[504] = (bf16)(v.w >> 16);
        }
    }
    __syncthreads();
    const int cl = wv >> 1, dh = wv & 1, c = ci * 4 + cl;
    f32x16 acc[2];
#pragma unroll
    for (int eb = 0; eb < 2; ++eb)
#pragma unroll
        for (int r = 0; r < 16; ++r) acc[eb][r] = 0.f;
#pragma unroll
    for (int s4 = 0; s4 < 4; ++s4) {
        const s16x8 bk = *(const LAS s16x8*)(KT + (cl * 64 + dh * 32 + r32) * 72 + 16 * s4 + 8 * half);
#pragma unroll
        for (int eb = 0; eb < 2; ++eb) {
            const s16x8 av = *(const LAS s16x8*)(VT + (cl * 64 + eb * 32 + r32) * 72 + 16 * s4 + 8 * half);
            acc[eb] = __builtin_amdgcn_mfma_f32_32x32x16_bf16(av, bk, acc[eb], 0, 0, 0);
        }
    }
    float* ut = UT + ((size_t)(bh * 64 + c) * 64) * 64;
#pragma unroll
    for (int eb = 0; eb < 2; ++eb)
#pragma unroll
        for (int r = 0; r < 16; ++r) { const int e = eb * 32 + 8 * (r >> 2) + 4 * half + (r & 3); ut[e * 64 + dh * 32 + r32] = acc[eb][r]; }
    {
        const LAS bf16* kr = KT + (cl * 64 + dh * 32 + r32) * 72 + half * 32; float sm = 0.f;
#pragma unroll
        for (int i = 0; i < 4; ++i) { const u32x4 x = *(const LAS u32x4*)(kr + 8 * i); sm += (bflo(x.x) + bfhi(x.x)) + (bflo(x.y) + bfhi(x.y)) + (bflo(x.z) + bfhi(x.z)) + (bflo(x.w) + bfhi(x.w)); }
        sm += __shfl_xor(sm, 32);
        if (half == 0) UN[(bh * 64 + c) * 64 + dh * 32 + r32] = sm;
    }
}
__device__ __forceinline__ void mlS_item(const Params& p, int bh, int wv) {
    const int tid = tid_fresh(wv);
    const float* UT = (const float*)(p.ws + WS_UT) + (size_t)bh * 64 * 4096; const float* UN = (const float*)(p.ws + WS_UN) + bh * 4096;
    bf16* CT = (bf16*)(p.ws + WS_CT) + (size_t)bh * 64 * 4096; float* NV = (float*)(p.ws + WS_NV) + bh * 4096; const float* DEC = (const float*)(p.ws + WS_DEC) + bh * 64;
    f32x4 s0 = (f32x4){0.f, 0.f, 0.f, 0.f}, s1 = s0; float ns = 0.f;
#pragma unroll 4
    for (int c = 0; c < 64; ++c) {
        const float dec = DEC[c];
        const f32x4 u0 = *(const f32x4*)(UT + (size_t)c * 4096 + tid * 8), u1 = *(const f32x4*)(UT + (size_t)c * 4096 + tid * 8 + 4);
        u32x4 w; w.x = pk2(s0[0], s0[1]); w.y = pk2(s0[2], s0[3]); w.z = pk2(s1[0], s1[1]); w.w = pk2(s1[2], s1[3]);
        *(u32x4*)(CT + (size_t)c * 4096 + tid * 8) = w;
        s0 = s0 * dec + u0; s1 = s1 * dec + u1;
        if (tid < 64) { NV[c * 64 + tid] = ns; ns = ns * dec + UN[c * 64 + tid]; }
    }
}
__device__ __forceinline__ void mlD_item(const Params& p, int l, int bh, int ci, LAS unsigned char* lds, int wv) {
    const int tid = tid_fresh(wv), lane = tid & 63, half = lane >> 5, r32 = lane & 31, b = bh >> 2, h = bh & 3;
    const bf16* Z = (const bf16*)(p.ws + WS_BIG); const float* MLS = (const float*)(p.ws + WS_MLS); bf16* O1 = (bf16*)(p.ws + WS_O + OB_STRIDE);
    LAS bf16* Qs = (LAS bf16*)lds; LAS bf16* Ks = Qs + 4 * 64 * 72; LAS bf16* VT = Ks + 4 * 64 * 72;
    const float* cw = p.ml_conv_w + (size_t)l * 4 * 512; const float* cb = p.ml_conv_b + (size_t)l * 512;
    __syncthreads();
    {
        const int tt = tid >> 1, hr = tid & 1, cl = tt >> 6, s = tt & 63, t = (ci * 4) * 64 + tt;
#pragma unroll 1
        for (int q8 = 0; q8 < 4; ++q8) {
            const int d0 = hr * 32 + q8 * 8; float y[8];
            ml_conv8(Z, cw, cb, b, t, h * 64 + d0, y);
            u32x4 w; w.x = pk2(y[0] * 0.125f, y[1] * 0.125f); w.y = pk2(y[2] * 0.125f, y[3] * 0.125f); w.z = pk2(y[4] * 0.125f, y[5] * 0.125f); w.w = pk2(y[6] * 0.125f, y[7] * 0.125f);
            *(LAS u32x4*)(Qs + (cl * 64 + s) * 72 + d0) = w;
            ml_conv8(Z, cw, cb, b, t, 256 + h * 64 + d0, y);
            w.x = pk2(y[0], y[1]); w.y = pk2(y[2], y[3]); w.z = pk2(y[4], y[5]); w.w = pk2(y[6], y[7]);
            *(LAS u32x4*)(Ks + (cl * 64 + s) * 72 + d0) = w;
            const u32x4 v = *(const u32x4*)(Z + ((size_t)b * SEQ + t) * ZP + 1280 + h * 64 + d0);
            LAS bf16* vd = VT + (cl * 64 + d0) * 72 + s;
            vd[0] = (bf16)(v.x & 0xffffu); vd[72] = (bf16)(v.x >> 16); vd[144] = (bf16)(v.y & 0xffffu); vd[216] = (bf16)(v.y >> 16);
            vd[288] = (bf16)(v.z & 0xffffu); vd[360] = (bf16)(v.z >> 16); vd[432] = (bf16)(v.w & 0xffffu); vd[504] = (bf16)(v.w >> 16);
        }
    }
    __syncthreads();
    const int cl = wv >> 1, th = wv & 1, c = ci * 4 + cl, tloc = th * 32 + r32, tseq = c * 64 + tloc;
    const int ti = bh * 4096 + tseq;
    const float bs_t = MLS[ti], mt_t = MLS[2 * MLN + ti], iw_t = MLS[4 * MLN + ti];
    s16x8 qf[4];
#pragma unroll
    for (int s4 = 0; s4 < 4; ++s4) qf[s4] = *(const LAS s16x8*)(Qs + (cl * 64 + tloc) * 72 + 16 * s4 + 8 * half);
    f32x16 oacc[2];
#pragma unroll
    for (int eb = 0; eb < 2; ++eb)
#pragma unroll
        for (int r = 0; r < 16; ++r) oacc[eb][r] = 0.f;
    const bf16* CT = (const bf16*)(p.ws + WS_CT) + (size_t)(bh * 64 + c) * 4096;
#pragma unroll
    for (int s4 = 0; s4 < 4; ++s4)
#pragma unroll
        for (int eb = 0; eb < 2; ++eb) { const s16x8 ac = *(const s16x8*)(CT + (eb * 32 + r32) * 64 + 16 * s4 + 8 * half);
            oacc[eb] = __builtin_amdgcn_mfma_f32_32x32x16_bf16(ac, qf[s4], oacc[eb], 0, 0, 0); }
#pragma unroll
    for (int eb = 0; eb < 2; ++eb)
#pragma unroll
        for (int r = 0; r < 16; ++r) oacc[eb][r] *= iw_t;
    float qn = 0.f;
    { const float* nvp = (const float*)(p.ws + WS_NV) + (bh * 64 + c) * 64;
#pragma unroll
      for (int s4 = 0; s4 < 4; ++s4) { const f32x4 n0 = *(const f32x4*)(nvp + 16 * s4 + 8 * half), n1 = *(const f32x4*)(nvp + 16 * s4 + 8 * half + 4);
          const u32x4 qq = __builtin_bit_cast(u32x4, qf[s4]);
          qn += bflo(qq.x) * n0[0] + bfhi(qq.x) * n0[1] + bflo(qq.y) * n0[2] + bfhi(qq.y) * n0[3] + bflo(qq.z) * n1[0] + bfhi(qq.z) * n1[1] + bflo(qq.w) * n1[2] + bfhi(qq.w) * n1[3]; } }
    qn += __shfl_xor(qn, 32);
    float rs = 0.f;
#pragma unroll
    for (int sb = 0; sb < 2; ++sb) {
        if (sb <= th) {
            f32x16 sacc;
#pragma unroll
            for (int r = 0; r < 16; ++r) sacc[r] = 0.f;
#pragma unroll
            for (int s4 = 0; s4 < 4; ++s4) { const s16x8 ak = *(const LAS s16x8*)(Ks + (cl * 64 + sb * 32 + r32) * 72 + 16 * s4 + 8 * half);
                sacc = __builtin_amdgcn_mfma_f32_32x32x16_bf16(ak, qf[s4], sacc, 0, 0, 0); }
            const float* ap = MLS + MLN + bh * 4096 + c * 64 + sb * 32 + 4 * half;
#pragma unroll
            for (int g = 0; g < 4; ++g) { const f32x4 av = *(const f32x4*)(ap + 8 * g);
#pragma unroll
                for (int i = 0; i < 4; ++i) { const int s = sb * 32 + 8 * g + 4 * half + i; const float v = (s <= tloc) ? sacc[4 * g + i] * __expf(bs_t + av[i] - mt_t) : 0.f; sacc[4 * g + i] = v; rs += v; } }
#pragma unroll
            for (int s2 = 0; s2 < 2; ++s2) {
                u32x4 w; w.x = pkbf(sacc[8 * s2], sacc[8 * s2 + 1]); w.y = pkbf(sacc[8 * s2 + 2], sacc[8 * s2 + 3]); w.z = pkbf(sacc[8 * s2 + 4], sacc[8 * s2 + 5]); w.w = pkbf(sacc[8 * s2 + 6], sacc[8 * s2 + 7]);
                const s16x8 pf = __builtin_bit_cast(s16x8, w);
#pragma unroll
                for (int eb = 0; eb < 2; ++eb) {
                    const LAS bf16* vr = VT + (cl * 64 + eb * 32 + r32) * 72 + sb * 32 + 16 * s2 + 4 * half;
                    const u32x2 v0 = *(const LAS u32x2*)vr, v1 = *(const LAS u32x2*)(vr + 8);
                    const u32x4 vv = (u32x4){v0.x, v0.y, v1.x, v1.y};
                    oacc[eb] = __builtin_amdgcn_mfma_f32_32x32x16_bf16(__builtin_bit_cast(s16x8, vv), pf, oacc[eb], 0, 0, 0);
                }
            }
        }
    }
    rs += __shfl_xor(rs, 32);
    const float den = iw_t * qn + rs;
    const float dn = 1.f / fmaxf(fabsf(den), __expf(-mt_t));
    float ss = 0.f;
#pragma unroll
    for (int eb = 0; eb < 2; ++eb)
#pragma unroll
        for (int r = 0; r < 16; ++r) { const float v = oacc[eb][r] * dn; oacc[eb][r] = v; ss = fmaf(v, v, ss); }
    ss += __shfl_xor(ss, 32);
    const float rr = 1.f / sqrtf(ss * (1.f / 64.f) + EPS);
    const size_t tok = (size_t)b * SEQ + tseq;
    const float* hg = p.ml_head_norm + l * 64;
#pragma unroll
    for (int eb = 0; eb < 2; ++eb)
#pragma unroll
        for (int g = 0; g < 4; ++g) { const int e0 = eb * 32 + 8 * g + 4 * half; const f32x4 gg = *(const f32x4*)(hg + e0);
            const u32x2 og = *(const u32x2*)(Z + tok * ZP + 1536 + h * 64 + e0);
            u32x2 w; w.x = pkbf(sigmoidf_(bflo(og.x)) * oacc[eb][4 * g] * rr * gg[0], sigmoidf_(bfhi(og.x)) * oacc[eb][4 * g + 1] * rr * gg[1]);
            w.y = pkbf(sigmoidf_(bflo(og.y)) * oacc[eb][4 * g + 2] * rr * gg[2], sigmoidf_(bfhi(og.y)) * oacc[eb][4 * g + 3] * rr * gg[3]);
            *(u32x2*)(O1 + tok * 256 + h * 64 + e0) = w; }
}
__device__ __forceinline__ float relu_(float x) { return __builtin_amdgcn_fmed3f(x, 0.f, __builtin_inff()); }
__device__ __forceinline__ unsigned key16(float s) { const float f = __builtin_amdgcn_fmed3f(floorf(fmaf(s, 512.f, 32768.f)), 0.f, 65535.f); return (unsigned)f; }
__device__ __forceinline__ unsigned mono_bits(float s) { s = (s == 0.f) ? 0.f : s; const unsigned u = __float_as_uint(s); return (u & 0x80000000u) ? ~u : (u | 0x80000000u); }
__device__ __forceinline__ void dsa_item(const Params& p, int lds_l, int b, int qt, LAS unsigned char* lds, int wv) {
    const int tid = tid_fresh(wv), lane = tid & 63, w = wv, half = lane >> 5, r32 = lane & 31;
    const bf16* Z = (const bf16*)(p.ws + WS_BIG); const float* ZS = (const float*)(p.ws + WS_ZS); const bf16* IK = (const bf16*)(p.ws + WS_IK); bf16* O3 = (bf16*)(p.ws + WS_O + 3 * OB_STRIDE);
    LAS unsigned* hist = (LAS unsigned*)lds + w * 1024;
    LAS unsigned* maskw = (LAS unsigned*)(lds + 32768);
    LAS bf16* KC = (LAS bf16*)(lds + 49152);
    LAS bf16* Kd = (LAS bf16*)(lds + 81920); LAS bf16* VTd = Kd + 64 * 72;
    const size_t tokb = (size_t)b * SEQ; const int tb = qt * 32 + 4 * w;
    const int ntiles = qt + 1, nkeys = ntiles * 32, nchunks = (ntiles + 15) >> 4;
    s16x8 aq0, aq1;
    { const bf16* ap = Z + (tokb + tb + (r32 >> 3)) * ZP + 2816 + (r32 & 7) * 32 + half * 8; aq0 = *(const s16x8*)ap; aq1 = *(const s16x8*)(ap + 16); }
    float wq[4][4];
#pragma unroll
    for (int g = 0; g < 4; ++g) { const f32x4 x = *(const f32x4*)(ZS + (tokb + tb + g) * ZSP + 160 + 4 * half); wq[g][0] = x[0]; wq[g][1] = x[1]; wq[g][2] = x[2]; wq[g][3] = x[3]; }
    unsigned tau[4], prefix[4]; int quota[4], krem[4], eqseen[4]; bool allsel[4];
    LAS unsigned* cand = (LAS unsigned*)(lds + 100352) + w * 1024;
    LAS unsigned* oflag = (LAS unsigned*)(lds + LDS_BYTES - 48);
    const unsigned lowmask = (1u << r32) - 1u;
#define DSA_SCORES(ktl, sc) do { const LAS bf16* kp_ = KC + ((ktl) * 32 + r32) * 32 + half * 8; \
        const s16x8 b0_ = *(const LAS s16x8*)kp_, b1_ = *(const LAS s16x8*)(kp_ + 16); f32x16 a_ = {0.f, 0.f, 0.f, 0.f, 0.f, 0.f, 0.f, 0.f, 0.f, 0.f, 0.f, 0.f, 0.f, 0.f, 0.f, 0.f}; \
        a_ = __builtin_amdgcn_mfma_f32_32x32x16_bf16(aq0, b0_, a_, 0, 0, 0); a_ = __builtin_amdgcn_mfma_f32_32x32x16_bf16(aq1, b1_, a_, 0, 0, 0); \
        _Pragma("unroll") for (int g_ = 0; g_ < 4; ++g_) { float pt_ = wq[g_][0] * relu_(a_[4 * g_]); pt_ = fmaf(wq[g_][1], relu_(a_[4 * g_ + 1]), pt_); \
            pt_ = fmaf(wq[g_][2], relu_(a_[4 * g_ + 2]), pt_); pt_ = fmaf(wq[g_][3], relu_(a_[4 * g_ + 3]), pt_); sc[g_] = pt_ + __shfl_xor(pt_, 32); } } while (0)
    int mode = (qt >= 8) ? 0 : 1;
#pragma unroll 1
    for (int attempt = 0; attempt < 2; ++attempt) {
        const int npass = (qt >= 8) ? (mode ? 4 : 2) : 0;
#pragma unroll
        for (int g = 0; g < 4; ++g) { tau[g] = 0u; prefix[g] = 0u; quota[g] = 1 << 30; krem[g] = 256; eqseen[g] = 0; allsel[g] = true; }
        if (tid == 0) *oflag = 0u;
#pragma unroll 1
        for (int pass = 0; pass <= npass; ++pass) {
            const bool comp = (pass == npass);
            const int shift = 8 * (npass - 1 - pass);
            if (!comp) {
#pragma unroll
                for (int i = 0; i < 4; ++i) *(LAS u32x4*)(hist + (i * 64 + lane) * 4) = (u32x4){0u, 0u, 0u, 0u};
            }
            const unsigned pfa = half ? prefix[2] : prefix[0], pfb = half ? prefix[3] : prefix[1];
            const int ta = tb + 2 * half, tbq = ta + 1;
            u32x4 pre[4];
#pragma unroll
            for (int i = 0; i < 4; ++i) { const int kb = (tid * 16 + i * 8192) >> 6; pre[i] = (kb < nkeys) ? *(const u32x4*)((const unsigned char*)(IK + tokb * 32) + tid * 16 + i * 8192) : (u32x4){0u, 0u, 0u, 0u}; }
#pragma unroll 1
            for (int ch = 0; ch < nchunks; ++ch) {
                __syncthreads();
#pragma unroll
                for (int i = 0; i < 4; ++i) *(LAS u32x4*)((LAS unsigned char*)KC + tid * 16 + i * 8192) = pre[i];
                __syncthreads();
                if (ch + 1 < nchunks) {
#pragma unroll
                    for (int i = 0; i < 4; ++i) { const int kb = (ch + 1) * 512 + ((tid * 16 + i * 8192) >> 6);
                        pre[i] = (kb < nkeys) ? *(const u32x4*)((const unsigned char*)(IK + (tokb + (size_t)(ch + 1) * 512) * 32) + tid * 16 + i * 8192) : (u32x4){0u, 0u, 0u, 0u}; }
                }
                const int nt = min(16, ntiles - ch * 16);
                if (!comp) {
#pragma unroll 2
                    for (int ktl = 0; ktl < nt; ++ktl) {
                        float sc[4]; DSA_SCORES(ktl, sc);
                        const int key = (ch * 16 + ktl) * 32 + r32;
                        const float sa = half ? sc[2] : sc[0], sb = half ? sc[3] : sc[1];
                        const unsigned ma = mode ? mono_bits(sa) : key16(sa), mb = mode ? mono_bits(sb) : key16(sb);
                        const bool oka = (key <= ta) && (pass == 0 || (ma >> (shift + 8)) == pfa);
                        const bool okb = (key <= tbq) && (pass == 0 || (mb >> (shift + 8)) == pfb);
                        if (oka) __hip_atomic_fetch_add(hist + (2 * half) * 256 + ((ma >> shift) & 255u), 1u, __ATOMIC_RELAXED, __HIP_MEMORY_SCOPE_WORKGROUP);
                        if (okb) __hip_atomic_fetch_add(hist + (2 * half + 1) * 256 + ((mb >> shift) & 255u), 1u, __ATOMIC_RELAXED, __HIP_MEMORY_SCOPE_WORKGROUP);
                    }
                } else {
#pragma unroll 1
                    for (int ktl = 0; ktl < nt; ++ktl) {
                        float sc[4]; DSA_SCORES(ktl, sc);
                        const int key = (ch * 16 + ktl) * 32 + r32;
#pragma unroll
                        for (int g = 0; g < 4; ++g) {
                            const unsigned mex = mono_bits(sc[g]); const unsigned m = mode ? mex : key16(sc[g]); const bool valid = key <= tb + g;
                            const bool eq = valid && (m == tau[g]);
                            const unsigned beq = (unsigned)__ballot(eq);
                            const int rank = eqseen[g] + __popc(beq & lowmask);
                            const bool takeeq = mode ? (rank < quota[g]) : allsel[g];
                            const bool sel = valid && ((m > tau[g]) || (eq && takeeq));
                            const unsigned bsel = (unsigned)__ballot(sel);
                            if (lane == 0) maskw[(4 * w + g) * 128 + ch * 16 + ktl] = bsel;
                            if (mode == 0 && !allsel[g] && eq && half == 0 && rank < 128) { cand[(g * 128 + rank) * 2] = mex; cand[(g * 128 + rank) * 2 + 1] = (unsigned)key; }
                            eqseen[g] += __popc(beq);
                        }
                    }
                }
            }
            if (!comp) {
                LDS_WAIT();
#pragma unroll
                for (int g = 0; g < 4; ++g) {
                    const u32x4 cv = *(const LAS u32x4*)(hist + g * 256 + lane * 4);
                    const int c0 = (int)cv.x, c1 = (int)cv.y, c2 = (int)cv.z, c3 = (int)cv.w, tot = c0 + c1 + c2 + c3;
                    int v = tot;
#pragma unroll
                    for (int d = 1; d < 64; d <<= 1) { const int n = __shfl_down(v, d); if (lane + d < 64) v += n; }
                    const int a3 = v - tot, a2 = a3 + c3, a1 = a2 + c2, a0 = a1 + c1; const int k = krem[g];
                    int fb = -1, fa = 0, fc = 0;
                    if (a3 < k && a3 + c3 >= k) { fb = 3; fa = a3; fc = c3; }
                    else if (a2 < k && a2 + c2 >= k) { fb = 2; fa = a2; fc = c2; }
                    else if (a1 < k && a1 + c1 >= k) { fb = 1; fa = a1; fc = c1; }
                    else if (a0 < k && a0 + c0 >= k) { fb = 0; fa = a0; fc = c0; }
                    const unsigned long long mk = __ballot(fb >= 0);
                    const int src = (int)__builtin_ctzll(mk | (1ull << 63));
                    const int bin = __shfl(4 * lane + fb, src), above = __shfl(fa, src), cnt = __shfl(fc, src);
                    prefix[g] = (prefix[g] << 8) | (unsigned)bin; krem[g] = k - above;
                    if (pass == npass - 1) { tau[g] = prefix[g]; quota[g] = krem[g]; allsel[g] = (cnt == krem[g]); }
                }
            }
        }
        if (mode == 0 && npass) {
            LDS_WAIT();
#pragma unroll
            for (int g = 0; g < 4; ++g) {
                if (!allsel[g]) {
                    const int n = eqseen[g], need = quota[g];
                    if (n > 128) { if (lane == 0) *oflag = 1u; }
                    else {
#pragma unroll 1
                        for (int i0 = 0; i0 < n; i0 += 64) {
                            const int i = i0 + lane; const bool act = i < n;
                            const unsigned mi = act ? cand[(g * 128 + i) * 2] : 0u, ki = act ? cand[(g * 128 + i) * 2 + 1] : 0u; int rank = 0;
#pragma unroll 1
                            for (int j = 0; j < n; ++j) { const unsigned mj = cand[(g * 128 + j) * 2], kj = cand[(g * 128 + j) * 2 + 1]; rank += ((mj > mi) || (mj == mi && kj < ki)) ? 1 : 0; }
                            if (act && rank < need) __hip_atomic_fetch_or(maskw + (4 * w + g) * 128 + (ki >> 5), 1u << (ki & 31u), __ATOMIC_RELAXED, __HIP_MEMORY_SCOPE_WORKGROUP);
                        }
                    }
                }
            }
        }
        __syncthreads();
        const unsigned of = *oflag;
        __syncthreads();
        if (mode == 0 && of != 0u) { mode = 1; continue; }
        break;
    }
    __syncthreads();
    {
        const float* sgn = p.dsa_qk_norm + lds_l * 128; float gqm = 0.f, gkm = 0.f;
#pragma unroll 2
        for (int i = 0; i < 64; ++i) { gqm = fmaxf(gqm, fabsf(sgn[i])); gkm = fmaxf(gkm, fabsf(sgn[64 + i])); }
        const float coff = 8.f * gqm * gkm;
        const int cb = w & 3, ksp = w >> 2, ql = 8 * cb + (r32 >> 2), hh = r32 & 3;
        s16x8 qf[4];
        { const bf16* qp = Z + (tokb + qt * 32 + ql) * ZP + 2560 + hh * 64 + 8 * half;
#pragma unroll
          for (int s4 = 0; s4 < 4; ++s4) qf[s4] = *(const s16x8*)(qp + 16 * s4); }
        f32x16 oacc[2];
#pragma unroll
        for (int db = 0; db < 2; ++db)
#pragma unroll
            for (int r = 0; r < 16; ++r) oacc[db][r] = 0.f;
        float lsum = 0.f;
        const int nT = (ntiles + 1) >> 1;
        const int skey = tid >> 3, sseg = tid & 7;
        const float* sgp = ZS + (tokb + skey) * ZSP + sseg * 16;
        f32x4 pr[4];
#pragma unroll
        for (int i = 0; i < 4; ++i) pr[i] = *(const f32x4*)(sgp + 4 * i);
#pragma unroll 1
        for (int tT = 0; tT < nT; ++tT) {
            __syncthreads();
            if (sseg < 4) {
                u32x4 w0, w1; w0.x = pkbf(pr[0][0], pr[0][1]); w0.y = pkbf(pr[0][2], pr[0][3]); w0.z = pkbf(pr[1][0], pr[1][1]); w0.w = pkbf(pr[1][2], pr[1][3]);
                w1.x = pkbf(pr[2][0], pr[2][1]); w1.y = pkbf(pr[2][2], pr[2][3]); w1.z = pkbf(pr[3][0], pr[3][1]); w1.w = pkbf(pr[3][2], pr[3][3]);
                *(LAS u32x4*)(Kd + skey * 72 + sseg * 16) = w0; *(LAS u32x4*)(Kd + skey * 72 + sseg * 16 + 8) = w1;
            } else {
                LAS bf16* vd = VTd + ((sseg - 4) * 16) * 72 + skey;
#pragma unroll
                for (int i = 0; i < 4; ++i) { const unsigned a0 = pkbf(pr[i][0], pr[i][1]), a1 = pkbf(pr[i][2], pr[i][3]);
                    vd[(4 * i) * 72] = (bf16)(a0 & 0xffffu); vd[(4 * i + 1) * 72] = (bf16)(a0 >> 16); vd[(4 * i + 2) * 72] = (bf16)(a1 & 0xffffu); vd[(4 * i + 3) * 72] = (bf16)(a1 >> 16); }
            }
            __syncthreads();
            if (tT + 1 < nT) {
#pragma unroll
                for (int i = 0; i < 4; ++i) pr[i] = *(const f32x4*)(sgp + (size_t)(tT + 1) * 64 * ZSP + 4 * i);
            }
            const int st = 2 * tT + ksp;
            if (st < ntiles) {
                const unsigned mw = maskw[ql * 128 + st];
                f32x16 sacc;
#pragma unroll
                for (int r = 0; r < 16; ++r) sacc[r] = 0.f;
#pragma unroll
                for (int s4 = 0; s4 < 4; ++s4) { const s16x8 ak = *(const LAS s16x8*)(Kd + (32 * ksp + r32) * 72 + 16 * s4 + 8 * half);
                    sacc = __builtin_amdgcn_mfma_f32_32x32x16_bf16(ak, qf[s4], sacc, 0, 0, 0); }
#pragma unroll
                for (int r = 0; r < 16; ++r) { const int kbit = 8 * (r >> 2) + 4 * half + (r & 3); const float pe = ((mw >> kbit) & 1u) ? __expf(sacc[r] - coff) : 0.f; sacc[r] = pe; lsum += pe; }
#pragma unroll
                for (int s2 = 0; s2 < 2; ++s2) {
                    u32x4 wp; wp.x = pkbf(sacc[8 * s2], sacc[8 * s2 + 1]); wp.y = pkbf(sacc[8 * s2 + 2], sacc[8 * s2 + 3]); wp.z = pkbf(sacc[8 * s2 + 4], sacc[8 * s2 + 5]); wp.w = pkbf(sacc[8 * s2 + 6], sacc[8 * s2 + 7]);
                    const s16x8 pf = __builtin_bit_cast(s16x8, wp);
#pragma unroll
                    for (int db = 0; db < 2; ++db) {
                        const LAS bf16* vr = VTd + (db * 32 + r32) * 72 + 32 * ksp + 16 * s2 + 4 * half;
                        const u32x2 v0 = *(const LAS u32x2*)vr, v1 = *(const LAS u32x2*)(vr + 8);
                        const u32x4 vv = (u32x4){v0.x, v0.y, v1.x, v1.y};
                        oacc[db] = __builtin_amdgcn_mfma_f32_32x32x16_bf16(__builtin_bit_cast(s16x8, vv), pf, oacc[db], 0, 0, 0);
                    }
                }
            }
        }
        lsum += __shfl_xor(lsum, 32);
        __syncthreads();
        LAS float* xch = (LAS float*)(lds + 49152) + (w & 3) * (33 * 64);
        if (ksp == 1) {
#pragma unroll
            for (int db = 0; db < 2; ++db)
#pragma unroll
                for (int r = 0; r < 16; ++r) xch[(db * 16 + r) * 64 + lane] = oacc[db][r];
            xch[32 * 64 + lane] = lsum;
        }
        __syncthreads();
        if (ksp == 0) {
            const float is = 1.f / (lsum + xch[32 * 64 + lane]);
            bf16* orow = O3 + (tokb + qt * 32 + ql) * 256 + hh * 64;
#pragma unroll
            for (int db = 0; db < 2; ++db)
#pragma unroll
                for (int g = 0; g < 4; ++g) { const int d0 = db * 32 + 8 * g + 4 * half;
                    const float x0 = (oacc[db][4 * g] + xch[(db * 16 + 4 * g) * 64 + lane]) * is, x1 = (oacc[db][4 * g + 1] + xch[(db * 16 + 4 * g + 1) * 64 + lane]) * is;
                    const float x2 = (oacc[db][4 * g + 2] + xch[(db * 16 + 4 * g + 2) * 64 + lane]) * is, x3 = (oacc[db][4 * g + 3] + xch[(db * 16 + 4 * g + 3) * 64 + lane]) * is;
                    u32x2 wo; wo.x = pkbf(x0, x1); wo.y = pkbf(x2, x3); *(u32x2*)(orow + d0) = wo; }
        }
    }
#undef DSA_SCORES
    __syncthreads();
}

constexpr int Q_ML = 32, Q_DIFF = 512, Q_DSA = 1024, Q_SB = 256, Q_TOTAL = Q_ML + Q_DIFF + Q_DSA + Q_SB;
__device__ __forceinline__ int next_item(unsigned* ctr, LAS int* slot, int wv) {
    __syncthreads();
    if (tid_fresh(wv) == 0) *slot = (int)atomicAdd(ctr, 1u);
    __syncthreads();
    return *slot;
}
__device__ __forceinline__ void mixer_phase1(int l, LAS unsigned char* lds, int wv, int co = 0) {
    LAS int* slot = (LAS int*)(lds + LDS_BYTES - 64);
    { const Params p = load_params(); unsigned* ctr = (unsigned*)(p.ws + WS_CTL) + 64 * (4 * l + 0 + co);
      for (;;) { const int it = next_item(ctr, slot, wv); if (it >= Q_DIFF) break; diffm_item(p, l, it & 31, 15 - (it >> 5), lds, wv); } }
    { const Params p = load_params(); unsigned* ctr = (unsigned*)(p.ws + WS_CTL) + 64 * (4 * l + 1 + co);
      for (;;) { const int it = next_item(ctr, slot, wv); if (it >= 512) break; mlB_item(p, l, it & 31, it >> 5, lds, wv); } }
}
__device__ __forceinline__ void mixer_phase2(int l, LAS unsigned char* lds, int wv, int co = 0) {
    LAS int* slot = (LAS int*)(lds + LDS_BYTES - 64);
    { const Params p = load_params(); unsigned* ctr = (unsigned*)(p.ws + WS_CTL) + 64 * (4 * l + 2 + co);
      for (;;) { const int it = next_item(ctr, slot, wv); if (it >= 32 + Q_DSA) break;
          if (it < 32) mlS_item(p, it, wv); else { const int i = it - 32; dsa_item(p, l, i & 7, 127 - (i >> 3), lds, wv); } } }
}
__device__ __forceinline__ void mixer_phase3(int l, LAS unsigned char* lds, int wv, int co = 0) {
    LAS int* slot = (LAS int*)(lds + LDS_BYTES - 64);
    { const Params p = load_params(); unsigned* ctr = (unsigned*)(p.ws + WS_CTL) + 64 * (4 * l + 3 + co);
      for (;;) { const int it = next_item(ctr, slot, wv); if (it >= 512) break; mlD_item(p, l, it & 31, it >> 5, lds, wv); } }
    { const Params p = load_params(); unsigned* ctr = (unsigned*)(p.ws + WS_CTL) + 64 * (8 + l + co);
      for (;;) { const int it = next_item(ctr, slot, wv); if (it >= Q_SB) break; sb_item(p, it >> 3, it & 7, lds, wv); } }
}

#define XB_TMO      128
#define XB_XCNT(j)  (256  + 64 * (j))
#define XB_XSUB(j)  (1280 + 64 * (j))
#define XB_XGEN(j)  (2304 + 64 * (j))
#define XB_TOP      3328
#define XB_TOPGEN   3392
#define XCD_BAR_WORDS 3456
#define XB_SPIN_CAP (1u << 20)
constexpr int CW_BAR = 8192;
__device__ __forceinline__ unsigned xb_ld(unsigned* p)              { return __hip_atomic_load(p, __ATOMIC_RELAXED, __HIP_MEMORY_SCOPE_AGENT); }
__device__ __forceinline__ unsigned xb_add(unsigned* p, unsigned v) { return __hip_atomic_fetch_add(p, v, __ATOMIC_RELAXED, __HIP_MEMORY_SCOPE_AGENT); }
__device__ __forceinline__ unsigned xb_xcc_id() { return (unsigned)__builtin_amdgcn_s_getreg((3 << 11) | 20) & 0xFu; }
#define XB_SPIN(cond, bar) do { unsigned _sp = 0; while (cond) { __builtin_amdgcn_s_sleep(1); \
    if ((++_sp & 255u) == 0u) { if (xb_ld(&(bar)[XB_TMO])) break; if (_sp > XB_SPIN_CAP) { atomicAdd(&(bar)[XB_TMO], 1u); break; } } } } while (0)
__device__ __forceinline__ void xcd_post(int wv) {
    const Params p = load_params(); unsigned* bar = (unsigned*)(p.ws + WS_CTL) + CW_BAR;
    if (tid_fresh(wv) == 0) (void)xb_add(&bar[XB_XCNT(xb_xcc_id())], 1u);
}
__device__ __forceinline__ void xcd_barrier_complete(unsigned* bar, unsigned x, unsigned& nloc, unsigned& nx) {
    const unsigned G = gridDim.x * gridDim.y * gridDim.z;
    unsigned sum, cnt, mine, sp = 0u;
    for (;;) {
        sum = 0u; cnt = 0u; mine = 0u;
#pragma unroll
        for (unsigned j = 0; j < 16; ++j) { const unsigned c = xb_ld(&bar[XB_XCNT(j)]); sum += c; cnt += (c > 0u) ? 1u : 0u; mine = (j == x) ? c : mine; }
        if (sum == G) break;
        __builtin_amdgcn_s_sleep(1);
        if ((++sp & 255u) == 0u) { if (xb_ld(&bar[XB_TMO])) break; if (sp > XB_SPIN_CAP) { atomicAdd(&bar[XB_TMO], 1u); break; } }
    }
    nloc = mine > 0u ? mine : 1u; nx = cnt > 0u ? cnt : 1u;
}
__device__ __forceinline__ void gsync(LAS unsigned char* lds, int wv) {
    asm volatile("s_waitcnt vmcnt(0)" ::: "memory");
    __syncthreads();
    if (tid_fresh(wv) == 0) {
        const Params p = load_params(); unsigned* bar = (unsigned*)(p.ws + WS_CTL) + CW_BAR;
        volatile LAS unsigned* st = (volatile LAS unsigned*)(lds + LDS_BYTES - 32);
        const unsigned x = xb_xcc_id();
        __builtin_amdgcn_s_waitcnt(0);
        unsigned nloc = st[0], nx = st[1];
        if (nloc == 0u) { xcd_barrier_complete(bar, x, nloc, nx); st[0] = nloc; st[1] = nx; }
        const unsigned old = xb_add(&bar[XB_XSUB(x)], 1u);
        const unsigned gen = old / nloc;
        if (old + 1u == (gen + 1u) * nloc) {
            __builtin_amdgcn_fence(__ATOMIC_RELEASE, "agent");
            asm volatile("s_waitcnt vmcnt(0)" ::: "memory");
            const unsigned og = xb_add(&bar[XB_TOP], 1u);
            const unsigned tg = og / nx;
            if (og + 1u == (tg + 1u) * nx) xb_add(&bar[XB_TOPGEN], 1u);
            else XB_SPIN(xb_ld(&bar[XB_TOPGEN]) == tg, bar);
            __builtin_amdgcn_fence(__ATOMIC_ACQUIRE, "agent");
            xb_add(&bar[XB_XGEN(x)], 1u);
            asm volatile("s_waitcnt vmcnt(0)" ::: "memory");
        } else {
            XB_SPIN(xb_ld(&bar[XB_XGEN(x)]) == gen, bar);
            __builtin_amdgcn_fence(__ATOMIC_ACQUIRE, "agent");
            asm volatile("s_waitcnt vmcnt(0)" ::: "memory");
        }
    }
    __syncthreads();
}

#define PH_LOCALS const Params p = load_params(); const int tid = tid_fresh(wv), lane = tid & 63, wave = tid >> 6; const int gw = (int)blockIdx.x * NWAVES + wave, ngw = (int)gridDim.x * NWAVES; \
    (void)lane; (void)gw; (void)ngw; bf16* HN = (bf16*)(p.ws + WS_HN); bf16* BIGB = (bf16*)(p.ws + WS_BIG); (void)HN; (void)BIGB;
template <int l> __device__ __forceinline__ void layer_body(cg::grid_group& grid, LAS unsigned char* lds, const int wv) {
        { PH_LOCALS const unsigned char* wl = p.ws + WS_W + (size_t)l * WL_STRIDE; EpiSwiglu E{l * 3 + 0}; run_gemm(lds, HN, (const bf16*)(wl + WL_GU1), T, 2 * FF, D, E, wv); }
        gsync(lds, wv);
        { PH_LOCALS const unsigned char* wl = p.ws + WS_W + (size_t)l * WL_STRIDE; EpiResid E{l == 0 ? 1 : 0, 0.5f, l * 3 + 1}; run_gemm(lds, BIGB, (const bf16*)(wl + WL_D1), T, D, FF, E, wv); }
        gsync(lds, wv);
        { PH_LOCALS const unsigned char* wl = p.ws + WS_W + (size_t)l * WL_STRIDE; EpiZ E{l * 3 + 1}; run_gemm(lds, HN, (const bf16*)(wl + WL_INA), T, 3328, D, E, wv); }
        gsync(lds, wv);
        { PH_LOCALS if (gw < 32) ml_prepass(p, l, gw, lane); prep_phase(p, l, gw, ngw, lane); }
        gsync(lds, wv);
        mixer_phase1(l, lds, wv);
        gsync(lds, wv);
        mixer_phase2(l, lds, wv);
        gsync(lds, wv);
        mixer_phase3(l, lds, wv);
        gsync(lds, wv);
#pragma unroll 1
        for (int hb = 0; hb < 2; ++hb) {
            { PH_LOCALS const unsigned char* wl = p.ws + WS_W + (size_t)l * WL_STRIDE; EpiSig E{l * 3 + 1}; run_gemm(lds, HN, (const bf16*)(wl + WL_G) + (size_t)hb * 2 * D * D, T, 2 * D, D, E, wv); }
            gsync(lds, wv);
#pragma unroll 1
            for (int bb = 0; bb < 2; ++bb) {
                PH_LOCALS const unsigned char* wl = p.ws + WS_W + (size_t)l * WL_STRIDE; const int b = hb * 2 + bb;
                EpiGate E{bb * D, b == 0 ? 1 : 0};
                run_gemm(lds, (const bf16*)(p.ws + WS_O + b * OB_STRIDE), (const bf16*)(wl + WL_BR) + (size_t)b * D * 256, T, D, 256, E, wv);
            }
            gsync(lds, wv);
        }
        { PH_LOCALS const unsigned char* wl = p.ws + WS_W + (size_t)l * WL_STRIDE; EpiResid E{0, 1.0f, l * 3 + 2}; run_gemm(lds, (const bf16*)(p.ws + WS_BIG + 128 * MiB), (const bf16*)(wl + WL_OUT), T, D, D, E, wv); }
        gsync(lds, wv);
        { PH_LOCALS const unsigned char* wl = p.ws + WS_W + (size_t)l * WL_STRIDE; EpiSwiglu E{l * 3 + 2}; run_gemm(lds, HN, (const bf16*)(wl + WL_GU2), T, 2 * FF, D, E, wv); }
        gsync(lds, wv);
        { PH_LOCALS const unsigned char* wl = p.ws + WS_W + (size_t)l * WL_STRIDE; EpiResid E{0, 0.5f, (l + 1 < DEPTH) ? (l + 1) * 3 : -1}; run_gemm(lds, BIGB, (const bf16*)(wl + WL_D2), T, D, FF, E, wv); }
        if (l + 1 < DEPTH) gsync(lds, wv);
    }

__global__ void __launch_bounds__(NTHR, 2) hybrid_fwd(Params p_unused) {
    extern __shared__ __attribute__((aligned(16))) unsigned char lds_raw[];
    LAS unsigned char* lds = (LAS unsigned char*)lds_raw;
    cg::grid_group grid = cg::this_grid();
    const int wv = __builtin_amdgcn_readfirstlane((int)threadIdx.x >> 6);
    {
        PH_LOCALS
        SegRun R; R.base = 0; R.gw = gw; R.ngw = ngw; R.lane = lane; R.scr = (LAS float*)(lds + wave * 8704);
        for (int l = 0; l < DEPTH; ++l) convert_weights(p, l, R);
        if (blockIdx.x == 0 && tid < 64) ((unsigned*)(p.ws + WS_CTL))[64 * tid] = 0u;
        if (blockIdx.x == 0) for (int i = tid; i < XCD_BAR_WORDS; i += NTHR) ((unsigned*)(p.ws + WS_CTL))[CW_BAR + i] = 0u;
        if (tid < 8) ((LAS unsigned*)(lds + LDS_BYTES - 32))[tid] = 0u;
        for (int i = gw * 64 + lane; i < 5 * T; i += ngw * 64) { const int a_ = 1 + i / T; rs_ptr(p, a_)[i % T] = 0ull; }
        xb_rows(p.x, HN, rs_ptr(p, 0), gw, ngw, lane);
    }
    grid.sync();
    xcd_post(wv);
    layer_body<0>(grid, lds, wv);
    layer_body<1>(grid, lds, wv);
}

extern "C" void kernel_launch(void* const* d_in, const int* in_sizes, int n_in, void* d_out, int out_size, void* d_ws, size_t ws_size, hipStream_t stream) {
    static int grid = 0;
    if (grid == 0) {
        if (n_in != 20 || out_size != T * D || ws_size < WS_END2) { fprintf(stderr, "kernel_launch: unexpected shapes (n_in %d out %d ws %zu)\n", n_in, out_size, ws_size); grid = -1; return; }
        int dev = 0, cus = 0, per_cu = 0;
        hipGetDevice(&dev); hipDeviceGetAttribute(&cus, hipDeviceAttributeMultiprocessorCount, dev);
        hipFuncSetAttribute((const void*)hybrid_fwd, hipFuncAttributeMaxDynamicSharedMemorySize, LDS_BYTES);
        hipOccupancyMaxActiveBlocksPerMultiprocessor(&per_cu, (const void*)hybrid_fwd, NTHR, LDS_BYTES);
        if (per_cu < 1) { fprintf(stderr, "kernel_launch: occupancy query says %d\n", per_cu); per_cu = 1; }
        (void)hipGetLastError();
        grid = cus * 1;
    }
    if (grid < 0) return;
    Params p{};
    p.x = (const float*)d_in[0]; p.pos = (const int*)d_in[1];
    p.ffn1_norm = (const float*)d_in[2]; p.ffn1_gu = (const float*)d_in[3]; p.ffn1_down = (const float*)d_in[4]; p.mix_norm = (const float*)d_in[5]; p.w_in = (const float*)d_in[6];
    p.diff_qk_norm = (const float*)d_in[7]; p.diff_lambda = (const float*)d_in[8]; p.diff_head_norm = (const float*)d_in[9]; p.ml_conv_w = (const float*)d_in[10]; p.ml_conv_b = (const float*)d_in[11];
    p.ml_gate_bias = (const float*)d_in[12]; p.ml_head_norm = (const float*)d_in[13]; p.dsa_qk_norm = (const float*)d_in[14]; p.w_branch = (const float*)d_in[15]; p.w_out = (const float*)d_in[16];
    p.ffn2_norm = (const float*)d_in[17]; p.ffn2_gu = (const float*)d_in[18]; p.ffn2_down = (const float*)d_in[19];
    p.out = (float*)d_out; p.ws = (unsigned char*)d_ws;
    void* args[] = {&p};
    hipError_t e = hipLaunchCooperativeKernel((const void*)hybrid_fwd, dim3(grid), dim3(NTHR), args, LDS_BYTES, stream);
    if (e != hipSuccess) fprintf(stderr, "cooperative launch failed: %s (grid %d)\n", hipGetErrorString(e), grid);
}
```

```cpp
#include <hip/hip_runtime.h>
#include <hip/hip_cooperative_groups.h>
#include <cstdio>
#include <cstdint>
namespace cg = cooperative_groups;
#ifndef PROBE_DUP
#define PROBE_DUP 0
#endif
namespace pg8 {
#define PG8_LAS __attribute__((address_space(3)))
typedef unsigned short bf16_t;
typedef short bf16x8 __attribute__((ext_vector_type(8)));
typedef float f32x4 __attribute__((ext_vector_type(4)));
typedef unsigned u32x4 __attribute__((ext_vector_type(4)));
constexpr int BM = 256, BK = 64, HALF = 128, HTB = HALF * BK * 2  , STAGE_BYTES = 8 * HTB, NXCD = 8, WGM = 8;

__host__ __device__ __forceinline__ int lds_byte(int r, int c) { const int st = (r >> 4) * 2 + (c >> 5), rr = r & 15, cc = c & 31, ob = rr * 64 + cc * 2; return st * 1024 + (ob ^ (((ob >> 9) & 1) << 5)); }
__host__ __device__ __forceinline__ void stage_rc(int b, int& R, int& C) { const int st = b / 1024, sb = b % 1024, swz = sb ^ (((sb >> 9) & 1) << 5); R = (st >> 1) * 16 + swz / 64; C = (st & 1) * 32 + (swz % 64) / 2; }
__host__ __device__ __forceinline__ int perm32(int rho) { const int n = rho >> 4, i = rho & 15; return 8 * (i >> 2) + 4 * n + (i & 3); }

struct Unit { int pm, pn; };
struct Gemm { const bf16_t* A; const bf16_t* Bt; int M, N, K; };

struct StaticOrder {
    int nM, nN, nwg, G, c;
    __host__ __device__ void init(int M, int N, int G_, int c_) { nM = M / BM; nN = N / BM; nwg = nM * nN; G = G_; c = c_; }
    __host__ __device__ bool next(int i, Unit& u) const {
        const long L = (long)i * G + c; if (L >= nwg) return false;
        int wgid = (int)L; { const int q = nwg / NXCD, r = nwg % NXCD, xcd = wgid % NXCD, off = wgid / NXCD; wgid = (xcd < r ? xcd * (q + 1) : r * (q + 1) + (xcd - r) * q) + off; }
        const int nig = WGM * nN, gid = wgid / nig, fm = gid * WGM, gsz = (nM - fm) < WGM ? (nM - fm) : WGM;
        u.pm = fm + ((wgid % nig) % gsz); u.pn = (wgid % nig) / gsz; return true;
    }
    __device__ __forceinline__ void a_ready(const Unit&) const {}
    __device__ __forceinline__ void done(const Unit&) const {}
};

__device__ __forceinline__ unsigned cvt_pk_bf16(float lo, float hi) { unsigned r; asm volatile("v_cvt_pk_bf16_f32 %0, %1, %2" : "=v"(r) : "v"(lo), "v"(hi)); return r; }
template <class Epi, class Sched, bool ALIGN_EPI = false, bool SP2 = false>
__device__ __forceinline__ void gemm_phase(PG8_LAS unsigned char* lds, const Gemm g, const Sched& S, const Epi& E, const int wave_in) {
    unsigned z_ = 0u; asm volatile("" : "+v"(z_)); int w_ = wave_in; asm volatile("" : "+s"(w_));
    const int tid_ = w_ * 64 + (int)__builtin_amdgcn_mbcnt_hi(~0u, __builtin_amdgcn_mbcnt_lo(~0u, z_));
    const int tid = tid_, wid = __builtin_amdgcn_readfirstlane(tid >> 6), lane = tid & 63, wr = wid >> 2, wc = wid & 3, fr = lane & 15, fq = lane >> 4;
    const int K = g.K, nt = K / BK;
    unsigned voffA[2], voffB[2];
#pragma unroll
    for (int i = 0; i < 2; ++i) { int R, C; stage_rc(tid * 16 + i * 8192, R, C); const int Rb = Epi::PERM ? ((R & ~31) + perm32(R & 31)) : R;
        voffA[i] = (unsigned)(R * K + C) * 2u; voffB[i] = (unsigned)(Rb * K + C) * 2u; }
    const size_t kstep = (size_t)(BK * 2);
    const size_t hstep = (size_t)HALF * K * 2;
    const size_t tstep = 2 * hstep;
    const unsigned ldsw = (unsigned)wid * 1024u;
    const int aoff = lds_byte(wr * 64 + fr, fq * 8), boff = lds_byte(wc * 32 + fr, fq * 8);
#define PG8_SA(b, h) (((b) * 2 + (h)) * HTB)
#define PG8_SB(b, h) ((4 + (b) * 2 + (h)) * HTB)
#define PG8_STAGE(bufoff, gbase, voff) do { _Pragma("unroll") for (int _i = 0; _i < 2; ++_i) \
        __builtin_amdgcn_global_load_lds((const unsigned*)((const char*)(gbase) + (voff)[_i]), (PG8_LAS unsigned*)(lds + (bufoff) + ldsw + _i * 8192), 16, 0, 0); } while (0)
#define PG8_LDA(dst, b, h) do { _Pragma("unroll") for (int m = 0; m < 4; ++m) _Pragma("unroll") for (int k = 0; k < 2; ++k) dst[m][k] = *(const PG8_LAS bf16x8*)(lds + PG8_SA(b, h) + aoff + m * 2048 + k * 1024); } while (0)
#define PG8_LDB(dst, b, h) do { _Pragma("unroll") for (int n = 0; n < 2; ++n) _Pragma("unroll") for (int k = 0; k < 2; ++k) dst[n][k] = *(const PG8_LAS bf16x8*)(lds + PG8_SB(b, h) + boff + n * 2048 + k * 1024); } while (0)
#define PG8_MMA(ai, bj, At, Bt) do { __builtin_amdgcn_s_setprio(1); _Pragma("unroll") for (int m = 0; m < 4; ++m) _Pragma("unroll") for (int n = 0; n < 2; ++n) _Pragma("unroll") for (int k = 0; k < 2; ++k) \
        acc[ai][bj][m][n] = __builtin_amdgcn_mfma_f32_16x16x32_bf16(Bt[n][k], At[m][k], acc[ai][bj][m][n], 0, 0, 0); __builtin_amdgcn_s_setprio(0); } while (0)
#define PG8_WAIT_V(n) asm volatile("s_waitcnt vmcnt(" #n ")" ::: "memory")
#define PG8_WAIT_L(n) asm volatile("s_waitcnt lgkmcnt(" #n ")" ::: "memory")
#define PG8_BAR __builtin_amdgcn_s_barrier()
#define PG8_SCHED __builtin_amdgcn_sched_barrier(0)
    Unit cur, nxt; int ui = 0;
    if (!S.next(0, cur)) return;
    f32x4 acc[2][2][4][2];
#pragma unroll
    for (int a = 0; a < 2; ++a)
#pragma unroll
        for (int b = 0; b < 2; ++b)
#pragma unroll
            for (int m = 0; m < 4; ++m)
#pragma unroll
                for (int n = 0; n < 2; ++n) acc[a][b][m][n] = (f32x4){0.f, 0.f, 0.f, 0.f};
    bf16x8 At[4][2], B0[2][2], B1[2][2];
    const char* cA = (const char*)g.A + (size_t)cur.pm * tstep; const char* cB = (const char*)g.Bt + (size_t)cur.pn * tstep;
    S.a_ready(cur);
    if constexpr (SP2) {
        PG8_STAGE(PG8_SB(0, 0), cB, voffB); PG8_STAGE(PG8_SB(0, 1), cB + hstep, voffB); PG8_STAGE(PG8_SA(0, 0), cA, voffA); PG8_STAGE(PG8_SA(0, 1), cA + hstep, voffA);
        if (wr == 1) PG8_BAR;
        PG8_WAIT_V(2); PG8_BAR;
        PG8_STAGE(PG8_SB(1, 0), cB + kstep, voffB); PG8_STAGE(PG8_SA(1, 0), cA + kstep, voffA); PG8_STAGE(PG8_SB(1, 1), cB + hstep + kstep, voffB);
        PG8_WAIT_V(6); PG8_BAR;
    } else {
        PG8_STAGE(PG8_SB(0, 0), cB, voffB); PG8_STAGE(PG8_SA(0, 0), cA, voffA); PG8_STAGE(PG8_SB(0, 1), cB + hstep, voffB); PG8_STAGE(PG8_SA(0, 1), cA + hstep, voffA);
        if (wr == 1) PG8_BAR;
        PG8_WAIT_V(4); PG8_BAR;
        PG8_STAGE(PG8_SB(1, 0), cB + kstep, voffB); PG8_STAGE(PG8_SA(1, 0), cA + kstep, voffA); PG8_STAGE(PG8_SB(1, 1), cB + hstep + kstep, voffB);
        PG8_WAIT_V(6); PG8_BAR;
    }
    for (;;) {
        const bool has_next = S.next(ui + 1, nxt);
        const char* nA = has_next ? (const char*)g.A + (size_t)nxt.pm * tstep : cA; const char* nB = has_next ? (const char*)g.Bt + (size_t)nxt.pn * tstep : cB;
        for (int t = 0; t < nt; t += 2) {
            const bool last = (t == nt - 2);
            const char* a1 = cA + (size_t)(t + 1) * kstep;
            const char* a2 = last ? nA : cA + (size_t)(t + 2) * kstep; const char* b2 = last ? nB : cB + (size_t)(t + 2) * kstep;
            const char* a3 = a2 + kstep; const char* b3 = b2 + kstep;
            if (last && has_next) S.a_ready(nxt);
            if constexpr (SP2) {
            PG8_LDB(B0, 0, 0); PG8_LDB(B1, 0, 1); PG8_SCHED; PG8_LDA(At, 0, 0); PG8_STAGE(PG8_SA(1, 1), a1 + hstep, voffA);
            PG8_WAIT_V(8); PG8_WAIT_L(0); PG8_BAR; PG8_MMA(0, 0, At, B0); PG8_MMA(0, 1, At, B1); PG8_BAR; PG8_SCHED;
            PG8_LDA(At, 0, 1); PG8_STAGE(PG8_SB(0, 0), b2, voffB); PG8_STAGE(PG8_SB(0, 1), b2 + hstep, voffB); PG8_STAGE(PG8_SA(0, 0), a2, voffA);
            PG8_WAIT_V(8); PG8_WAIT_L(0); PG8_BAR; PG8_MMA(1, 0, At, B0); PG8_MMA(1, 1, At, B1); PG8_BAR; PG8_SCHED;
            PG8_LDB(B0, 1, 0); PG8_LDB(B1, 1, 1); PG8_SCHED; PG8_LDA(At, 1, 0); PG8_STAGE(PG8_SA(0, 1), a2 + hstep, voffA);
            PG8_WAIT_V(8); PG8_WAIT_L(0); PG8_BAR; PG8_MMA(0, 0, At, B0); PG8_MMA(0, 1, At, B1); PG8_BAR; PG8_SCHED;
            PG8_LDA(At, 1, 1); PG8_STAGE(PG8_SB(1, 0), b3, voffB); PG8_STAGE(PG8_SB(1, 1), b3 + hstep, voffB); PG8_STAGE(PG8_SA(1, 0), a3, voffA);
            PG8_WAIT_V(8); PG8_WAIT_L(0); PG8_BAR; PG8_MMA(1, 0, At, B0); PG8_MMA(1, 1, At, B1); PG8_BAR; PG8_SCHED;
            } else {
            PG8_LDB(B0, 0, 0); PG8_SCHED; PG8_LDA(At, 0, 0); PG8_STAGE(PG8_SA(1, 1), a1 + hstep, voffA);
            PG8_WAIT_L(8); PG8_BAR; PG8_WAIT_L(0); PG8_MMA(0, 0, At, B0); PG8_BAR; PG8_SCHED;
            PG8_LDB(B1, 0, 1); PG8_STAGE(PG8_SB(0, 0), b2, voffB);
            PG8_BAR; PG8_WAIT_L(0); PG8_MMA(0, 1, At, B1); PG8_BAR;
            PG8_LDA(At, 0, 1); PG8_STAGE(PG8_SA(0, 0), a2, voffA);
            PG8_BAR; PG8_WAIT_L(0); PG8_MMA(1, 0, At, B0); PG8_BAR; PG8_SCHED;
            PG8_STAGE(PG8_SB(0, 1), b2 + hstep, voffB);
            PG8_WAIT_V(6); PG8_BAR; PG8_MMA(1, 1, At, B1); PG8_BAR;
            PG8_LDB(B0, 1, 0); PG8_SCHED; PG8_LDA(At, 1, 0); PG8_STAGE(PG8_SA(0, 1), a2 + hstep, voffA);
            PG8_WAIT_L(8); PG8_BAR; PG8_WAIT_L(0); PG8_MMA(0, 0, At, B0); PG8_BAR; PG8_SCHED;
            PG8_LDB(B1, 1, 1); PG8_STAGE(PG8_SB(1, 0), b3, voffB);
            PG8_BAR; PG8_WAIT_L(0); PG8_MMA(0, 1, At, B1); PG8_BAR;
            PG8_LDA(At, 1, 1); PG8_STAGE(PG8_SA(1, 0), a3, voffA);
            PG8_BAR; PG8_WAIT_L(0); PG8_MMA(1, 0, At, B0); PG8_BAR; PG8_SCHED;
            PG8_STAGE(PG8_SB(1, 1), b3 + hstep, voffB);
            PG8_WAIT_V(6); PG8_BAR; PG8_MMA(1, 1, At, B1); PG8_BAR;
            }
        }
        if constexpr (ALIGN_EPI) { if (wr == 0) PG8_BAR; }
        if constexpr (!Epi::AFTER_DRAIN) { E(acc, cur, wr, wc, fr, fq); S.done(cur); }
        if (!has_next) break;
#pragma unroll
        for (int a = 0; a < 2; ++a)
#pragma unroll
            for (int b = 0; b < 2; ++b)
#pragma unroll
                for (int m = 0; m < 4; ++m)
#pragma unroll
                    for (int n = 0; n < 2; ++n) acc[a][b][m][n] = (f32x4){0.f, 0.f, 0.f, 0.f};
        cur = nxt; cA = nA; cB = nB; ++ui;
        if constexpr (ALIGN_EPI) { if (wr == 1) PG8_BAR; }
    }
    PG8_WAIT_V(0);
    if constexpr (!ALIGN_EPI) { if (wr == 0) PG8_BAR; }
    PG8_BAR;
    if constexpr (Epi::AFTER_DRAIN) { E.fused(acc, cur, wr, wc, fr, fq, lds, wid, lane); S.done(cur); }
#undef PG8_SA
#undef PG8_SB
#undef PG8_STAGE
#undef PG8_LDA
#undef PG8_LDB
#undef PG8_MMA
#undef PG8_WAIT_V
#undef PG8_WAIT_L
#undef PG8_BAR
#undef PG8_SCHED
}
}
#define LAS __attribute__((address_space(3)))
typedef unsigned short bf16;
typedef float f32x4 __attribute__((ext_vector_type(4)));
typedef float f32x16 __attribute__((ext_vector_type(16)));
typedef unsigned u32x4 __attribute__((ext_vector_type(4)));
typedef unsigned u32x2 __attribute__((ext_vector_type(2)));
typedef short s16x8 __attribute__((ext_vector_type(8)));

constexpr int NB = 8, SEQ = 4096, T = NB * SEQ, D = 1024, FF = 2816, DEPTH = 2, NIN = 7344, ZP = 3072, ZSP = 256;
constexpr int NTHR = 512, NWAVES = 8;
constexpr int LDS_BYTES = 147456;
constexpr float EPS = 1e-6f;

constexpr size_t MiB = (size_t)1 << 20;
constexpr size_t WS_CTL = 0;
constexpr size_t WS_W = 1 * MiB, WL_STRIDE = 52 * MiB;
constexpr size_t WL_GU1 = 0, WL_D1 = 11534336, WL_INA = 17301504, WL_G = 24117248, WL_BR = 32505856, WL_OUT = 34603008, WL_GU2 = 36700160, WL_D2 = 48234496;
constexpr size_t WS_HN = 106 * MiB, WS_BIG = 170 * MiB, WS_ZS = 362 * MiB, WS_O = 394 * MiB, WS_IK = 458 * MiB, WS_END = 460 * MiB;
constexpr size_t OB_STRIDE = (size_t)T * 256 * 2;

struct Params {
    const float* x; const int* pos;
    const float *ffn1_norm, *ffn1_gu, *ffn1_down, *mix_norm, *w_in, *diff_qk_norm, *diff_lambda, *diff_head_norm, *ml_conv_w, *ml_conv_b, *ml_gate_bias, *ml_head_norm,
        *dsa_qk_norm, *w_branch, *w_out, *ffn2_norm, *ffn2_gu, *ffn2_down;
    float* out; unsigned char* ws;
};

__device__ __forceinline__ unsigned f2bf(float f) { unsigned u = __float_as_uint(f); return (u + 0x7fffu + ((u >> 16) & 1u)) >> 16; }
__device__ __forceinline__ unsigned pk2(float lo, float hi) { unsigned r; asm("v_cvt_pk_bf16_f32 %0, %1, %2" : "=v"(r) : "v"(lo), "v"(hi)); return r; }
__device__ __forceinline__ float bflo(unsigned w) { return __uint_as_float(w << 16); }
__device__ __forceinline__ float bfhi(unsigned w) { return __uint_as_float(w & 0xffff0000u); }
__device__ __forceinline__ float wave_sum(float v) {
#pragma unroll
    for (int o = 1; o < 64; o <<= 1) v += __shfl_xor(v, o);
    return v;
}
__device__ __forceinline__ float wave_max(float v) {
#pragma unroll
    for (int o = 1; o < 64; o <<= 1) v = fmaxf(v, __shfl_xor(v, o));
    return v;
}
__device__ __forceinline__ int lane_fresh() { unsigned z = 0u; asm volatile("" : "+v"(z)); return (int)__builtin_amdgcn_mbcnt_hi(~0u, __builtin_amdgcn_mbcnt_lo(~0u, z)); }
__device__ __forceinline__ int tid_fresh(int wv) { int w = wv; asm volatile("" : "+s"(w)); return w * 64 + lane_fresh(); }
#define LDS_WAIT() asm volatile("s_waitcnt lgkmcnt(0)" ::: "memory")
__device__ __forceinline__ float sigmoidf_(float x) { return 1.f / (1.f + __expf(-x)); }

__device__ __forceinline__ Params load_params() {
#if defined(__HIP_DEVICE_COMPILE__)
    const __attribute__((address_space(4))) Params* pp = (const __attribute__((address_space(4))) Params*)__builtin_amdgcn_kernarg_segment_ptr();
    asm volatile("" : "+s"(pp));
    Params r;
    r.x = pp->x; r.pos = pp->pos; r.ffn1_norm = pp->ffn1_norm; r.ffn1_gu = pp->ffn1_gu; r.ffn1_down = pp->ffn1_down; r.mix_norm = pp->mix_norm; r.w_in = pp->w_in; r.diff_qk_norm = pp->diff_qk_norm;
    r.diff_lambda = pp->diff_lambda; r.diff_head_norm = pp->diff_head_norm; r.ml_conv_w = pp->ml_conv_w; r.ml_conv_b = pp->ml_conv_b; r.ml_gate_bias = pp->ml_gate_bias; r.ml_head_norm = pp->ml_head_norm;
    r.dsa_qk_norm = pp->dsa_qk_norm; r.w_branch = pp->w_branch; r.w_out = pp->w_out; r.ffn2_norm = pp->ffn2_norm; r.ffn2_gu = pp->ffn2_gu; r.ffn2_down = pp->ffn2_down; r.out = pp->out; r.ws = pp->ws;
    return r;
#else
    return Params{};
#endif
}
typedef unsigned long long u64_t;
__device__ __forceinline__ u64_t* rs_ptr(const Params& p, int idx) { return (u64_t*)(p.ws + (idx < 3 ? (WS_CTL + 131072) : (105 * MiB))) + (size_t)(idx % 3) * T; }
__device__ __forceinline__ float row_rstd(const u64_t* rs, int row) { return 1.f / sqrtf((float)rs[row] * (1.f / (16777216.f * D)) + EPS); }
struct EpiSwiglu {
    static constexpr bool PERM = true, AFTER_DRAIN = false;
    int rsi;
    __device__ __forceinline__ void operator()(const f32x4 (&acc)[2][2][4][2], const pg8::Unit& u, int wr, int wc, int fr_in, int fq_in) const {
        const int ln_ = lane_fresh(); const int fr = ln_ & 15, fq = ln_ >> 4; (void)fr_in; (void)fq_in;
        const Params p = load_params(); bf16* O = (bf16*)(p.ws + WS_BIG); const u64_t* rs = rs_ptr(p, rsi);
        const int row0 = u.pm * 256 + wr * 64 + fr, col0 = u.pn * 128 + wc * 32 + 8 * fq;
#pragma unroll
        for (int ai = 0; ai < 2; ++ai)
#pragma unroll
            for (int m = 0; m < 4; ++m) {
                const int row = row0 + ai * 128 + m * 16; const float rr = row_rstd(rs, row);
                bf16* rowp = O + (size_t)row * FF + col0;
                float r[8];
#pragma unroll
                for (int n = 0; n < 2; ++n)
#pragma unroll
                    for (int j = 0; j < 4; ++j) { const float g = acc[ai][0][m][n][j] * rr, uu = acc[ai][1][m][n][j] * rr; r[4 * n + j] = g * sigmoidf_(g) * uu; }
                u32x4 w; w.x = pk2(r[0], r[1]); w.y = pk2(r[2], r[3]); w.z = pk2(r[4], r[5]); w.w = pk2(r[6], r[7]);
                *(u32x4*)rowp = w;
            }
    }
};
struct EpiResid {
    static constexpr bool PERM = true, AFTER_DRAIN = false;
    int base_is_x; float scale; int rsi;
    __device__ __forceinline__ void operator()(const f32x4 (&acc)[2][2][4][2], const pg8::Unit& u, int wr, int wc, int fr_in, int fq_in) const {
        const int ln_ = lane_fresh(); const int fr = ln_ & 15, fq = ln_ >> 4; (void)fr_in; (void)fq_in;
        const Params p = load_params(); const float* base = base_is_x ? p.x : p.out; float* out = p.out; bf16* XB = (rsi >= 0) ? (bf16*)(p.ws + WS_HN) : (bf16*)nullptr; u64_t* rs = rs_ptr(p, rsi >= 0 ? rsi : 0);
        const int row0 = u.pm * 256 + wr * 64 + fr, col0 = u.pn * 256 + wc * 32 + 8 * fq;
#pragma unroll
        for (int ai = 0; ai < 2; ++ai)
#pragma unroll
            for (int m = 0; m < 4; ++m) {
                const int row = row0 + ai * 128 + m * 16; const size_t ro = (size_t)row * D + col0; float ss = 0.f;
#pragma unroll
                for (int bj = 0; bj < 2; ++bj) {
                    const f32x4 v0 = *(const f32x4*)(base + ro + bj * 128) + acc[ai][bj][m][0] * scale, v1 = *(const f32x4*)(base + ro + bj * 128 + 4) + acc[ai][bj][m][1] * scale;
                    *(f32x4*)(out + ro + bj * 128) = v0; *(f32x4*)(out + ro + bj * 128 + 4) = v1;
                    if (XB) { u32x4 w; w.x = pk2(v0[0], v0[1]); w.y = pk2(v0[2], v0[3]); w.z = pk2(v1[0], v1[1]); w.w = pk2(v1[2], v1[3]); *(u32x4*)(XB + ro + bj * 128) = w;
                        ss += (v0[0] * v0[0] + v0[1] * v0[1]) + (v0[2] * v0[2] + v0[3] * v0[3]) + (v1[0] * v1[0] + v1[1] * v1[1]) + (v1[2] * v1[2] + v1[3] * v1[3]); }
                }
                if (XB) { ss += __shfl_xor(ss, 16); ss += __shfl_xor(ss, 32); if (fq == 0) atomicAdd(rs + row, (u64_t)(ss * 16777216.f)); }
            }
    }
};
struct EpiZ {
    static constexpr bool PERM = true, AFTER_DRAIN = false;
    int rsi;
    __device__ __forceinline__ void operator()(const f32x4 (&acc)[2][2][4][2], const pg8::Unit& u, int wr, int wc, int fr_in, int fq_in) const {
        const int ln_ = lane_fresh(); const int fr = ln_ & 15, fq = ln_ >> 4; (void)fr_in; (void)fq_in;
        const Params p = load_params(); bf16* Z = (bf16*)(p.ws + WS_BIG); float* ZS = (float*)(p.ws + WS_ZS); const u64_t* rs = rs_ptr(p, rsi);
        const int row0 = u.pm * 256 + wr * 64 + fr, cw = wc * 32 + 8 * fq;
        if (u.pn < 12) {
#pragma unroll
            for (int ai = 0; ai < 2; ++ai)
#pragma unroll
                for (int m = 0; m < 4; ++m) {
                    const int row = row0 + ai * 128 + m * 16; const float rr = row_rstd(rs, row);
                    bf16* rowp = Z + (size_t)row * ZP + u.pn * 256 + cw;
#pragma unroll
                    for (int bj = 0; bj < 2; ++bj) { const f32x4 v0 = acc[ai][bj][m][0] * rr, v1 = acc[ai][bj][m][1] * rr;
                        u32x4 w; w.x = pk2(v0[0], v0[1]); w.y = pk2(v0[2], v0[3]); w.z = pk2(v1[0], v1[1]); w.w = pk2(v1[2], v1[3]);
                        *(u32x4*)(rowp + bj * 128) = w; }
                }
        } else {
#pragma unroll
            for (int ai = 0; ai < 2; ++ai)
#pragma unroll
                for (int m = 0; m < 4; ++m) {
                    const int row = row0 + ai * 128 + m * 16; const float rr = row_rstd(rs, row);
                    float* rowp = ZS + (size_t)row * ZSP + cw;
#pragma unroll
                    for (int bj = 0; bj < 2; ++bj)
#pragma unroll
                        for (int n = 0; n < 2; ++n) *(f32x4*)(rowp + bj * 128 + 4 * n) = acc[ai][bj][m][n] * rr;
                }
        }
    }
};
struct EpiSig {
    static constexpr bool PERM = true, AFTER_DRAIN = false;
    int rsi;
    __device__ __forceinline__ void operator()(const f32x4 (&acc)[2][2][4][2], const pg8::Unit& u, int wr, int wc, int fr_in, int fq_in) const {
        const int ln_ = lane_fresh(); const int fr = ln_ & 15, fq = ln_ >> 4; (void)fr_in; (void)fq_in;
        const Params p = load_params(); bf16* SG = (bf16*)(p.ws + WS_BIG); const u64_t* rs = rs_ptr(p, rsi);
        const int row0 = u.pm * 256 + wr * 64 + fr, col0 = u.pn * 256 + wc * 32 + 8 * fq;
#pragma unroll
        for (int ai = 0; ai < 2; ++ai)
#pragma unroll
            for (int m = 0; m < 4; ++m) {
                const int row = row0 + ai * 128 + m * 16; const float rr = row_rstd(rs, row);
                bf16* rowp = SG + (size_t)row * (2 * D) + col0;
#pragma unroll
                for (int bj = 0; bj < 2; ++bj) { const f32x4 v0 = acc[ai][bj][m][0] * rr, v1 = acc[ai][bj][m][1] * rr;
                    u32x4 w; w.x = pk2(sigmoidf_(v0[0]), sigmoidf_(v0[1])); w.y = pk2(sigmoidf_(v0[2]), sigmoidf_(v0[3]));
                    w.z = pk2(sigmoidf_(v1[0]), sigmoidf_(v1[1])); w.w = pk2(sigmoidf_(v1[2]), sigmoidf_(v1[3]));
                    *(u32x4*)(rowp + bj * 128) = w; }
            }
    }
};
struct EpiGate {
    static constexpr bool PERM = true, AFTER_DRAIN = false;
    int sgoff; int first;
    __device__ __forceinline__ void operator()(const f32x4 (&acc)[2][2][4][2], const pg8::Unit& u, int wr, int wc, int fr_in, int fq_in) const {
        const int ln_ = lane_fresh(); const int fr = ln_ & 15, fq = ln_ >> 4; (void)fr_in; (void)fq_in;
        const Params p = load_params(); const bf16* SG = (const bf16*)(p.ws + WS_BIG); bf16* YB = (bf16*)(p.ws + WS_BIG + 128 * MiB);
        const int row0 = u.pm * 256 + wr * 64 + fr, col0 = u.pn * 256 + wc * 32 + 8 * fq;
#pragma unroll
        for (int ai = 0; ai < 2; ++ai)
#pragma unroll
            for (int m = 0; m < 4; ++m) {
                const int row = row0 + ai * 128 + m * 16; const size_t ro = (size_t)row * D + col0, so = (size_t)row * (2 * D) + sgoff + col0;
#pragma unroll
                for (int bj = 0; bj < 2; ++bj) {
                    const u32x4 sg = *(const u32x4*)(SG + so + bj * 128);
                    f32x4 v0 = (f32x4){bflo(sg.x), bfhi(sg.x), bflo(sg.y), bfhi(sg.y)} * acc[ai][bj][m][0], v1 = (f32x4){bflo(sg.z), bfhi(sg.z), bflo(sg.w), bfhi(sg.w)} * acc[ai][bj][m][1];
                    if (!first) { const u32x4 y = *(const u32x4*)(YB + ro + bj * 128);
                        v0 = v0 + (f32x4){bflo(y.x), bfhi(y.x), bflo(y.y), bfhi(y.y)}; v1 = v1 + (f32x4){bflo(y.z), bfhi(y.z), bflo(y.w), bfhi(y.w)}; }
                    u32x4 w; w.x = pk2(v0[0], v0[1]); w.y = pk2(v0[2], v0[3]); w.z = pk2(v1[0], v1[1]); w.w = pk2(v1[2], v1[3]); *(u32x4*)(YB + ro + bj * 128) = w;
                }
            }
    }
};

template <class Epi>
__device__ __forceinline__ void run_gemm(LAS unsigned char* lds, const bf16* A, const bf16* Bt, int M, int N, int K, const Epi& E, int wv) {
    pg8::Gemm g{A, Bt, M, N, K}; pg8::StaticOrder S; S.init(M, N, (int)gridDim.x, (int)blockIdx.x);
    pg8::gemm_phase<Epi, pg8::StaticOrder, true, true>((PG8_LAS unsigned char*)lds, g, S, E, wv);
}

__device__ __forceinline__ void tr_item(const float* W, int K, int srcN, int c0, int nv, bf16* WT, int r0, int k0, LAS float* scr, int lane, const float* gain) {
    const int c = lane & 31;
#pragma unroll 8
    for (int i = 0; i < 32; ++i) { const int kk = 2 * i + (lane >> 5); scr[kk * 33 + c] = (c < nv) ? W[(size_t)(k0 + kk) * srcN + c0 + c] * (gain ? gain[k0 + kk] : 1.f) : 0.f; }
    LDS_WAIT();
    const int c8 = lane & 7;
#pragma unroll
    for (int j = 0; j < 4; ++j) { const int n = (lane >> 3) + 8 * j; const LAS float* s = scr + (8 * c8) * 33 + n;
        u32x4 o; o.x = pk2(s[0 * 33], s[1 * 33]); o.y = pk2(s[2 * 33], s[3 * 33]); o.z = pk2(s[4 * 33], s[5 * 33]); o.w = pk2(s[6 * 33], s[7 * 33]);
        if (n < nv) *(u32x4*)(WT + (size_t)(r0 + n) * K + k0 + 8 * c8) = o; }
    LDS_WAIT();
}
struct SegRun { int base, gw, ngw, lane; LAS float* scr; };
__device__ __forceinline__ void run_seg(SegRun& R, const float* W, int K, int srcN, int c0, int ncols, bf16* WT, int r0, const float* gain = nullptr) {
    const int nblk = (ncols + 31) >> 5, nitems = (K >> 6) * nblk;
    int first = (R.gw - (R.base % R.ngw) + R.ngw) % R.ngw;
    for (int it = first; it < nitems; it += R.ngw) { const int kb = it / nblk, nb = it - kb * nblk; const int nv = min(32, ncols - nb * 32);
        tr_item(W, K, srcN, c0 + nb * 32, nv, WT, r0 + nb * 32, kb * 64, R.scr, R.lane, gain); }
    R.base += nitems;
}
__device__ __forceinline__ void convert_weights(const Params& p, int l, SegRun& R) {
    unsigned char* wl = p.ws + WS_W + (size_t)l * WL_STRIDE;
    for (int f = 0; f < 2; ++f) {
        const float* gu = (f ? p.ffn2_gu : p.ffn1_gu) + (size_t)l * D * 2 * FF; bf16* gut = (bf16*)(wl + (f ? WL_GU2 : WL_GU1));
        const float* gn = (f ? p.ffn2_norm : p.ffn1_norm) + l * D;
        for (int sg = 0; sg < 44; ++sg) run_seg(R, gu, D, 2 * FF, sg * 128, 128, gut, (sg % 22) * 256 + (sg / 22) * 128, gn);
        const float* dn = (f ? p.ffn2_down : p.ffn1_down) + (size_t)l * FF * D; bf16* dnt = (bf16*)(wl + (f ? WL_D2 : WL_D1));
        run_seg(R, dn, FF, D, 0, D, dnt, 0);
    }
    const float* wi = p.w_in + (size_t)l * D * NIN; bf16* ina = (bf16*)(wl + WL_INA);
    run_seg(R, wi, D, NIN, 0, 768, ina, 0, p.mix_norm + l * D);
    run_seg(R, wi, D, NIN, 768, 512, ina, 768, p.mix_norm + l * D);
    run_seg(R, wi, D, NIN, 1280, 256, ina, 1280, p.mix_norm + l * D);
    run_seg(R, wi, D, NIN, 1544, 256, ina, 1536, p.mix_norm + l * D);
    run_seg(R, wi, D, NIN, 1800, 768, ina, 1792, p.mix_norm + l * D);
    run_seg(R, wi, D, NIN, 2568, 256, ina, 2560, p.mix_norm + l * D);
    run_seg(R, wi, D, NIN, 2952, 256, ina, 2816, p.mix_norm + l * D);
    run_seg(R, wi, D, NIN, 2824, 128, ina, 3072, p.mix_norm + l * D);
    run_seg(R, wi, D, NIN, 3208, 40, ina, 3200, p.mix_norm + l * D);
    run_seg(R, wi, D, NIN, 1536, 8, ina, 3240, p.mix_norm + l * D);
    run_seg(R, wi, D, NIN, 3248, 4096, (bf16*)(wl + WL_G), 0, p.mix_norm + l * D);
    for (int b = 0; b < 4; ++b) run_seg(R, p.w_branch + ((size_t)l * 4 + b) * 256 * D, 256, D, 0, D, (bf16*)(wl + WL_BR) + (size_t)b * D * 256, 0);
    run_seg(R, p.w_out + (size_t)l * D * D, D, D, 0, D, (bf16*)(wl + WL_OUT), 0);
    for (int i = R.gw * 64 + R.lane; i < 80 * 128; i += R.ngw * 64) *((u32x4*)(ina + (size_t)3248 * D) + i) = (u32x4){0u, 0u, 0u, 0u};
}

__device__ __forceinline__ void xb_rows(const float* X, bf16* XB, u64_t* rs, int gw, int ngw, int lane) {
    for (int m = gw; m < T; m += ngw) {
        const f32x4* xr = (const f32x4*)(X + (size_t)m * D) + lane;
        f32x4 v[4]; float s = 0.f;
#pragma unroll
        for (int j = 0; j < 4; ++j) { v[j] = xr[64 * j]; s += (v[j].x * v[j].x + v[j].y * v[j].y) + (v[j].z * v[j].z + v[j].w * v[j].w); }
        s = wave_sum(s);
        unsigned long long* o8 = (unsigned long long*)(XB + (size_t)m * D) + lane;
#pragma unroll
        for (int j = 0; j < 4; ++j) o8[64 * j] = (unsigned long long)pk2(v[j].x, v[j].y) | ((unsigned long long)pk2(v[j].z, v[j].w) << 32);
        if (lane == 0) rs[m] = (u64_t)(s * 16777216.f);
    }
}

__device__ __forceinline__ void sincos_red(float ang, float& sn, float& cs) {
    const float n = rintf(ang * 0.15915494309189535f);
    float r = fmaf(-n, 6.28125f, ang); r = fmaf(-n, 0.0019353071795864769f, r);
    sn = __sinf(r); cs = __cosf(r);
}
template <int HALF>
__device__ __forceinline__ void rope4(float (&v)[4], int sl, float pos) {
    constexpr int LH = HALF / 4;
    float pv[4];
#pragma unroll
    for (int j = 0; j < 4; ++j) pv[j] = __shfl_xor(v[j], LH);
    if (sl < 2 * LH) {
        const bool first = sl < LH; const int i0 = (sl & (LH - 1)) * 4;
#pragma unroll
        for (int j = 0; j < 4; ++j) {
            constexpr float I4[4] = {1.0f, 0.03760603070259094f, 0.0014142135623842478f, 5.318296098266728e-05f};
            constexpr float I8[8] = {1.0f, 0.1939227432012558f, 0.03760603070259094f, 0.007292664609849453f, 0.0014142135623842478f, 0.00027424818836152554f, 5.318296098266728e-05f, 1.0313386155758053e-05f};
            const float inv = (HALF == 4) ? I4[j] : (i0 ? I8[4 + j] : I8[j]);
            float sn, cs; sincos_red(pos * inv, sn, cs);
            v[j] = first ? (v[j] * cs - pv[j] * sn) : (pv[j] * sn + v[j] * cs);
        }
    }
}
__device__ __forceinline__ void prep_phase(const Params& p, int l, int gw, int ngw, int lane) {
    bf16* Z = (bf16*)(p.ws + WS_BIG); float* ZS = (float*)(p.ws + WS_ZS); bf16* IK = (bf16*)(p.ws + WS_IK);
    const float* dg = p.diff_qk_norm + l * 64; const float* sg = p.dsa_qk_norm + l * 128;
    for (int tok = gw; tok < T; tok += ngw) {
        const float pos = (float)p.pos[tok];
#pragma unroll
        for (int which = 0; which < 2; ++which) {
            unsigned long long* ptr = (unsigned long long*)(Z + (size_t)tok * ZP + which * 256) + lane;
            const unsigned long long w = *ptr; float v[4] = {bflo((unsigned)w), bfhi((unsigned)w), bflo((unsigned)(w >> 32)), bfhi((unsigned)(w >> 32))};
            float ss = (v[0] * v[0] + v[1] * v[1]) + (v[2] * v[2] + v[3] * v[3]);
            ss += __shfl_xor(ss, 1); ss += __shfl_xor(ss, 2); ss += __shfl_xor(ss, 4);
            const float r = 1.f / sqrtf(ss * (1.f / 32.f) + EPS);
            const f32x4 g = *(const f32x4*)(dg + which * 32 + (lane & 7) * 4);
#pragma unroll
            for (int j = 0; j < 4; ++j) v[j] = v[j] * r * g[j];
            rope4<4>(v, lane & 7, pos);
            if (which == 0) {
#pragma unroll
                for (int j = 0; j < 4; ++j) v[j] *= 0.17677669529663687f;
            }
            *ptr = (unsigned long long)pk2(v[0], v[1]) | ((unsigned long long)pk2(v[2], v[3]) << 32);
        }
        {
            unsigned long long* ptr = (unsigned long long*)(Z + (size_t)tok * ZP + 2560) + lane;
            const unsigned long long w = *ptr; float v[4] = {bflo((unsigned)w), bfhi((unsigned)w), bflo((unsigned)(w >> 32)), bfhi((unsigned)(w >> 32))};
            float ss = (v[0] * v[0] + v[1] * v[1]) + (v[2] * v[2] + v[3] * v[3]);
            ss += __shfl_xor(ss, 1); ss += __shfl_xor(ss, 2); ss += __shfl_xor(ss, 4); ss += __shfl_xor(ss, 8);
            const float r = 1.f / sqrtf(ss * (1.f / 64.f) + EPS);
            const f32x4 g = *(const f32x4*)(sg + (lane & 15) * 4);
#pragma unroll
            for (int j = 0; j < 4; ++j) v[j] = v[j] * r * g[j];
            rope4<8>(v, lane & 15, pos);
#pragma unroll
            for (int j = 0; j < 4; ++j) v[j] *= 0.125f;
            *ptr = (unsigned long long)pk2(v[0], v[1]) | ((unsigned long long)pk2(v[2], v[3]) << 32);
        }
        {
            unsigned long long* ptr = (unsigned long long*)(Z + (size_t)tok * ZP + 2816) + lane;
            const unsigned long long w = *ptr; float v[4] = {bflo((unsigned)w), bfhi((unsigned)w), bflo((unsigned)(w >> 32)), bfhi((unsigned)(w >> 32))};
            rope4<4>(v, lane & 7, pos);
            *ptr = (unsigned long long)pk2(v[0], v[1]) | ((unsigned long long)pk2(v[2], v[3]) << 32);
        }
        {
            float* ptr = ZS + (size_t)tok * ZSP + (lane & 15) * 4;
            const f32x4 x = *(const f32x4*)ptr; float v[4] = {x[0], x[1], x[2], x[3]};
            float ss = (v[0] * v[0] + v[1] * v[1]) + (v[2] * v[2] + v[3] * v[3]);
            ss += __shfl_xor(ss, 1); ss += __shfl_xor(ss, 2); ss += __shfl_xor(ss, 4); ss += __shfl_xor(ss, 8);
            const float r = 1.f / sqrtf(ss * (1.f / 64.f) + EPS);
            const f32x4 g = *(const f32x4*)(sg + 64 + (lane & 15) * 4);
#pragma unroll
            for (int j = 0; j < 4; ++j) v[j] = v[j] * r * g[j];
            rope4<8>(v, lane & 15, pos);
            if (lane < 16) *(f32x4*)ptr = (f32x4){v[0], v[1], v[2], v[3]};
        }
        {
            const float* ptr = ZS + (size_t)tok * ZSP + 128 + (lane & 7) * 4;
            const f32x4 x = *(const f32x4*)ptr; float v[4] = {x[0], x[1], x[2], x[3]};
            rope4<4>(v, lane & 7, pos);
            if (lane < 8) *((unsigned long long*)(IK + (size_t)tok * 32) + lane) = (unsigned long long)pk2(v[0], v[1]) | ((unsigned long long)pk2(v[2], v[3]) << 32);
        }
    }
}
__device__ __forceinline__ void mlstm_item(const Params& p, int l, int bh, LAS unsigned char* lds, int wv) {
    const int tid = tid_fresh(wv), lane = tid & 63, b = bh >> 2, h = bh & 3;
    const bf16* Z = (const bf16*)(p.ws + WS_BIG); const float* ZS = (const float*)(p.ws + WS_ZS); bf16* O1 = (bf16*)(p.ws + WS_O + OB_STRIDE);
    LAS float* nv = (LAS float*)lds; LAS float* bc = nv + 64; LAS float* igs = bc + 64; LAS float* wks = igs + 64; LAS float* sc = wks + 64;
    LAS float* Qs = sc + 64; LAS float* Ks = Qs + 64 * 65; LAS float* Vs = Ks + 64 * 65; LAS float* Ss = Vs + 64 * 65; LAS float* Cs = Ss + 64 * 65;
    for (int i = tid; i < 64 * 65; i += NTHR) Cs[i] = 0.f;
    if (tid < 64) nv[tid] = 0.f;
    float mcar = 0.f;
    const int r = tid >> 3, sg = tid & 7;
    const int cc0 = sg * 16; const int ch0 = (cc0 < 64) ? (h * 64 + cc0) : (256 + h * 64 + cc0 - 64);
    const float* cw0 = p.ml_conv_w + (size_t)l * 4 * 512; const float* cb0 = p.ml_conv_b + (size_t)l * 512;
    const int zc0 = (cc0 < 64) ? (768 + h * 64 + cc0) : (1024 + h * 64 + cc0 - 64);
    const float gb_i = p.ml_gate_bias[(l * 2 + 0) * 4 + h], gb_f = p.ml_gate_bias[(l * 2 + 1) * 4 + h];
    const float qsc = (cc0 < 64) ? 0.125f : 1.0f;
    __syncthreads();
    for (int c = 0; c < 64; ++c) {
        const int t0 = c * 64; const size_t tok0 = (size_t)b * SEQ + t0;
        const float* cw = cw0; const float* cb = cb0; asm volatile("" : "+s"(cw), "+s"(cb));
        {
            float y[16];
#pragma unroll
            for (int i = 0; i < 16; ++i) y[i] = cb[ch0 + i];
#pragma unroll
            for (int j = 0; j < 4; ++j) {
                const int tt = t0 + r - 3 + j;
                if (tt >= 0) {
                    const u32x4* xp = (const u32x4*)(Z + ((size_t)b * SEQ + tt) * ZP + zc0); const u32x4 x0 = xp[0], x1 = xp[1];
                    const float xv[16] = {bflo(x0.x), bfhi(x0.x), bflo(x0.y), bfhi(x0.y), bflo(x0.z), bfhi(x0.z), bflo(x0.w), bfhi(x0.w),
                                          bflo(x1.x), bfhi(x1.x), bflo(x1.y), bfhi(x1.y), bflo(x1.z), bfhi(x1.z), bflo(x1.w), bfhi(x1.w)};
#pragma unroll
                    for (int i = 0; i < 16; ++i) y[i] = fmaf(cw[j * 512 + ch0 + i], xv[i], y[i]);
                }
            }
            LAS float* dst = (cc0 < 64) ? (Qs + r * 65 + cc0) : (Ks + r * 65 + cc0 - 64);
#pragma unroll
            for (int i = 0; i < 16; ++i) dst[i] = y[i] * sigmoidf_(y[i]) * qsc;
            const u32x4 vv = *(const u32x4*)(Z + (tok0 + r) * ZP + 1280 + h * 64 + sg * 8);
            LAS float* vd = Vs + r * 65 + sg * 8;
            vd[0] = bflo(vv.x); vd[1] = bfhi(vv.x); vd[2] = bflo(vv.y); vd[3] = bfhi(vv.y); vd[4] = bflo(vv.z); vd[5] = bfhi(vv.z); vd[6] = bflo(vv.w); vd[7] = bfhi(vv.w);
        }
        if (tid < 64) {
            const float ig = ZS[(tok0 + tid) * ZSP + 168 + h] + gb_i;
            const float fz = ZS[(tok0 + tid) * ZSP + 172 + h] + gb_f;
            const float lf = fminf(fz, 0.f) - log1pf(__expf(-fabsf(fz)));
            float bsum = lf;
#pragma unroll
            for (int d = 1; d < 64; d <<= 1) { const float n = __shfl_up(bsum, d); if (lane >= d) bsum += n; }
            const float bl = __shfl(bsum, 63);
            const float g = bl - bsum + ig;
            const float mnew = fmaxf(bl + mcar, wave_max(g));
            bc[tid] = bsum; igs[tid] = ig; wks[tid] = __expf(g - mnew);
            if (tid == 0) { sc[0] = mnew; sc[1] = __expf(bl + mcar - mnew); sc[2] = bl; }
        }
        __syncthreads();
        const float bt = bc[r];
        float mx = -INFINITY;
#pragma unroll
        for (int i = 0; i < 8; ++i) { const int s = sg * 8 + i; const float dli = (s <= r) ? (bt - bc[s] + igs[s]) : -INFINITY; mx = fmaxf(mx, dli); }
        mx = fmaxf(mx, __shfl_xor(mx, 1)); mx = fmaxf(mx, __shfl_xor(mx, 2)); mx = fmaxf(mx, __shfl_xor(mx, 4));
        const float inter = bt + mcar; const float mt = fmaxf(inter, mx); const float iw = __expf(inter - mt);
        float ssum = 0.f;
#pragma unroll 1
        for (int i = 0; i < 8; ++i) { const int s = sg * 8 + i; float dot = 0.f;
#pragma unroll 16
            for (int d = 0; d < 64; ++d) dot = fmaf(Qs[r * 65 + d], Ks[s * 65 + d], dot);
            const float dli = (s <= r) ? (bt - bc[s] + igs[s]) : -INFINITY;
            const float sv = dot * __expf(dli - mt); Ss[r * 65 + s] = sv; ssum += sv; }
        ssum += __shfl_xor(ssum, 1); ssum += __shfl_xor(ssum, 2); ssum += __shfl_xor(ssum, 4);
        float qn = 0.f;
#pragma unroll
        for (int d = 0; d < 64; ++d) qn = fmaf(Qs[r * 65 + d], nv[d], qn);
        const float den = iw * qn + ssum;
        __syncthreads();
        {
            float num[8];
#pragma unroll
            for (int i = 0; i < 8; ++i) num[i] = 0.f;
#pragma unroll 8
            for (int d = 0; d < 64; ++d) { const float qd = Qs[r * 65 + d];
#pragma unroll
                for (int i = 0; i < 8; ++i) num[i] = fmaf(qd, Cs[d * 65 + sg * 8 + i], num[i]); }
#pragma unroll
            for (int i = 0; i < 8; ++i) num[i] *= iw;
#pragma unroll 8
            for (int s = 0; s < 64; ++s) { const float sv = Ss[r * 65 + s];
#pragma unroll
                for (int i = 0; i < 8; ++i) num[i] = fmaf(sv, Vs[s * 65 + sg * 8 + i], num[i]); }
            const float dn = 1.f / fmaxf(fabsf(den), __expf(-mt));
            float hs = 0.f;
#pragma unroll
            for (int i = 0; i < 8; ++i) { num[i] *= dn; hs = fmaf(num[i], num[i], hs); }
            hs += __shfl_xor(hs, 1); hs += __shfl_xor(hs, 2); hs += __shfl_xor(hs, 4);
            const float rr = 1.f / sqrtf(hs * (1.f / 64.f) + EPS);
            const u32x4 og = *(const u32x4*)(Z + (tok0 + r) * ZP + 1536 + h * 64 + sg * 8);
            const float ogv[8] = {bflo(og.x), bfhi(og.x), bflo(og.y), bfhi(og.y), bflo(og.z), bfhi(og.z), bflo(og.w), bfhi(og.w)};
            const float* hg = p.ml_head_norm + l * 64 + sg * 8;
            float o[8];
#pragma unroll
            for (int i = 0; i < 8; ++i) o[i] = sigmoidf_(ogv[i]) * (num[i] * rr * hg[i]);
            u32x4 w; w.x = pk2(o[0], o[1]); w.y = pk2(o[2], o[3]); w.z = pk2(o[4], o[5]); w.w = pk2(o[6], o[7]);
            *(u32x4*)(O1 + (tok0 + r) * 256 + h * 64 + sg * 8) = w;
        }
        __syncthreads();
        {
            const float decay = sc[1];
            float cacc[8]; float nacc = 0.f;
#pragma unroll
            for (int i = 0; i < 8; ++i) cacc[i] = 0.f;
#pragma unroll 8
            for (int s = 0; s < 64; ++s) { const float kw = wks[s] * Ks[s * 65 + r]; nacc += kw;
#pragma unroll
                for (int i = 0; i < 8; ++i) cacc[i] = fmaf(kw, Vs[s * 65 + sg * 8 + i], cacc[i]); }
#pragma unroll
            for (int i = 0; i < 8; ++i) Cs[r * 65 + sg * 8 + i] = decay * Cs[r * 65 + sg * 8 + i] + cacc[i];
            if (sg == 0) nv[r] = decay * nv[r] + nacc;
            mcar = sc[0];
        }
        __syncthreads();
    }
}

__device__ __forceinline__ void diff_item(const Params& p, int l, int bh, int qt, LAS unsigned char* lds, int wv) {
    const int tid = tid_fresh(wv), b = bh >> 2, h = bh & 3, q0 = qt * 128;
    const bf16* Z = (const bf16*)(p.ws + WS_BIG); bf16* O0 = (bf16*)(p.ws + WS_O);
    LAS float* Kt = (LAS float*)lds; LAS float* Vt = Kt + 64 * 64;
    const int ql = tid >> 2, part = tid & 3, c = part & 1, dvh = part >> 1, t = q0 + ql; const size_t tok = (size_t)b * SEQ + t;
    const float* lp = p.diff_lambda + l * 128; float s01 = 0.f, s23 = 0.f, gqm = 0.f, gkm = 0.f;
#pragma unroll 2
    for (int i = 0; i < 32; ++i) { s01 = fmaf(lp[i], lp[32 + i], s01); s23 = fmaf(lp[64 + i], lp[96 + i], s23);
        gqm = fmaxf(gqm, fabsf(p.diff_qk_norm[l * 64 + i])); gkm = fmaxf(gkm, fabsf(p.diff_qk_norm[l * 64 + 32 + i])); }
    const float lam_init = 0.8f - 0.6f * __expf(-0.3f * (float)l); const float lam = __expf(s01) - __expf(s23) + lam_init;
    const float coff = 5.65685424949238f * gqm * gkm;
    float q[32], o[32];
    { const u32x4* qp = (const u32x4*)(Z + tok * ZP + h * 64 + c * 32);
#pragma unroll
      for (int i = 0; i < 4; ++i) { const u32x4 w = qp[i]; q[8 * i] = bflo(w.x); q[8 * i + 1] = bfhi(w.x); q[8 * i + 2] = bflo(w.y); q[8 * i + 3] = bfhi(w.y); q[8 * i + 4] = bflo(w.z); q[8 * i + 5] = bfhi(w.z); q[8 * i + 6] = bflo(w.w); q[8 * i + 7] = bfhi(w.w); } }
#pragma unroll
    for (int i = 0; i < 32; ++i) o[i] = 0.f;
    float lsum = 0.f;
    const int nkt = (q0 + 128) / 64;
    const int lk = tid >> 3, lsg = tid & 7;
    for (int kt = 0; kt < nkt; ++kt) {
        __syncthreads();
        { const size_t ktok = (size_t)b * SEQ + kt * 64 + lk;
          const bf16* src = Z + ktok * ZP + ((lsg < 4) ? (256 + h * 64 + lsg * 16) : (512 + h * 64 + (lsg - 4) * 16));
          const u32x4 x0 = ((const u32x4*)src)[0], x1 = ((const u32x4*)src)[1];
          LAS float* dst = ((lsg < 4) ? (Kt + lk * 64 + lsg * 16) : (Vt + lk * 64 + (lsg - 4) * 16));
          *(LAS f32x4*)(dst) = (f32x4){bflo(x0.x), bfhi(x0.x), bflo(x0.y), bfhi(x0.y)}; *(LAS f32x4*)(dst + 4) = (f32x4){bflo(x0.z), bfhi(x0.z), bflo(x0.w), bfhi(x0.w)};
          *(LAS f32x4*)(dst + 8) = (f32x4){bflo(x1.x), bfhi(x1.x), bflo(x1.y), bfhi(x1.y)}; *(LAS f32x4*)(dst + 12) = (f32x4){bflo(x1.z), bfhi(x1.z), bflo(x1.w), bfhi(x1.w)}; }
        __syncthreads();
        const int kmax = t - kt * 64 + 1;
        for (int key = 0; key < 64; ++key) {
            const LAS f32x4* kr = (const LAS f32x4*)(Kt + key * 64 + c * 32);
            float s = 0.f;
#pragma unroll
            for (int i = 0; i < 8; ++i) { const f32x4 kv = kr[i]; s = fmaf(q[4 * i], kv[0], s); s = fmaf(q[4 * i + 1], kv[1], s); s = fmaf(q[4 * i + 2], kv[2], s); s = fmaf(q[4 * i + 3], kv[3], s); }
            const float pe = (key < kmax) ? __expf(s - coff) : 0.f;
            lsum += pe;
            const LAS f32x4* vr = (const LAS f32x4*)(Vt + key * 64 + dvh * 32);
#pragma unroll
            for (int i = 0; i < 8; ++i) { const f32x4 vv = vr[i]; o[4 * i] = fmaf(pe, vv[0], o[4 * i]); o[4 * i + 1] = fmaf(pe, vv[1], o[4 * i + 1]); o[4 * i + 2] = fmaf(pe, vv[2], o[4 * i + 2]); o[4 * i + 3] = fmaf(pe, vv[3], o[4 * i + 3]); }
        }
    }
    const float inv = 1.f / lsum; float ss = 0.f;
#pragma unroll
    for (int i = 0; i < 32; ++i) { const float my = o[i] * inv; const float ot = __shfl_xor(my, 1); o[i] = (c == 0) ? (my - lam * ot) : (ot - lam * my); ss = fmaf(o[i], o[i], ss); }
    ss += __shfl_xor(ss, 2);
    const float rr = (1.f - lam_init) / sqrtf(ss * (1.f / 64.f) + EPS);
    if (c == 0) {
        const float* hg = p.diff_head_norm + l * 64 + dvh * 32; u32x4* dst = (u32x4*)(O0 + tok * 256 + h * 64 + dvh * 32);
#pragma unroll
        for (int i = 0; i < 4; ++i) { u32x4 w; w.x = pk2(o[8 * i] * rr * hg[8 * i], o[8 * i + 1] * rr * hg[8 * i + 1]); w.y = pk2(o[8 * i + 2] * rr * hg[8 * i + 2], o[8 * i + 3] * rr * hg[8 * i + 3]);
            w.z = pk2(o[8 * i + 4] * rr * hg[8 * i + 4], o[8 * i + 5] * rr * hg[8 * i + 5]); w.w = pk2(o[8 * i + 6] * rr * hg[8 * i + 6], o[8 * i + 7] * rr * hg[8 * i + 7]); dst[i] = w; }
    }
    __syncthreads();
}

__device__ __forceinline__ unsigned pkbf(float lo, float hi) { unsigned r; asm("v_cvt_pk_bf16_f32 %0, %1, %2" : "=v"(r) : "v"(lo), "v"(hi)); return r; }
__device__ __forceinline__ void diffm_item(const Params& p, int l, int bh, int qb, LAS unsigned char* lds, int wv) {
    const int tid = tid_fresh(wv), lane = tid & 63, half = lane >> 5, r32 = lane & 31, b = bh >> 2, h = bh & 3;
    const bf16* Z = (const bf16*)(p.ws + WS_BIG); bf16* O0 = (bf16*)(p.ws + WS_O);
    LAS bf16* Ks = (LAS bf16*)lds; LAS bf16* Vt = Ks + 64 * 72;
    const float* lp = p.diff_lambda + l * 128; float s01 = 0.f, s23 = 0.f, gqm = 0.f, gkm = 0.f;
#pragma unroll 2
    for (int i = 0; i < 32; ++i) { s01 = fmaf(lp[i], lp[32 + i], s01); s23 = fmaf(lp[64 + i], lp[96 + i], s23);
        gqm = fmaxf(gqm, fabsf(p.diff_qk_norm[l * 64 + i])); gkm = fmaxf(gkm, fabsf(p.diff_qk_norm[l * 64 + 32 + i])); }
    const float lam_init = 0.8f - 0.6f * __expf(-0.3f * (float)l); const float lam = __expf(s01) - __expf(s23) + lam_init;
    const float coff = 5.65685424949238f * gqm * gkm;
    const int qw = qb * 256 + 32 * wv;
    const size_t tokb = (size_t)b * SEQ;
    s16x8 qf[2][2];
    { const bf16* qp = Z + (tokb + qw + r32) * ZP + h * 64 + half * 8;
#pragma unroll
      for (int c = 0; c < 2; ++c)
#pragma unroll
          for (int s = 0; s < 2; ++s) qf[c][s] = *(const s16x8*)(qp + c * 32 + 16 * s); }
    f32x16 oacc[2][2];
#pragma unroll
    for (int c = 0; c < 2; ++c)
#pragma unroll
        for (int db = 0; db < 2; ++db)
#pragma unroll
            for (int r = 0; r < 16; ++r) oacc[c][db][r] = 0.f;
    float ls0 = 0.f, ls1 = 0.f;
    const int nt = (qb + 1) * 4;
    const int kkey = tid >> 3, kch = tid & 7, vkey = tid & 63, vdc = tid >> 6;
    const bf16* kgp = Z + (tokb + kkey) * ZP + 256 + h * 64 + kch * 8;
    const bf16* vgp = Z + (tokb + vkey) * ZP + 512 + h * 64 + vdc * 8;
    u32x4 kreg = *(const u32x4*)kgp, vreg = *(const u32x4*)vgp;
#pragma unroll 1
    for (int t = 0; t < nt; ++t) {
        __syncthreads();
        *(LAS u32x4*)(Ks + kkey * 72 + kch * 8) = kreg;
        { LAS bf16* vd = Vt + (vdc * 8) * 72 + vkey;
          vd[0] = (bf16)(vreg.x & 0xffffu); vd[72] = (bf16)(vreg.x >> 16); vd[144] = (bf16)(vreg.y & 0xffffu); vd[216] = (bf16)(vreg.y >> 16);
          vd[288] = (bf16)(vreg.z & 0xffffu); vd[360] = (bf16)(vreg.z >> 16); vd[432] = (bf16)(vreg.w & 0xffffu); vd[504] = (bf16)(vreg.w >> 16); }
        __syncthreads();
        if (t + 1 < nt) { kreg = *(const u32x4*)(kgp + (size_t)(t + 1) * 64 * ZP); vreg = *(const u32x4*)(vgp + (size_t)(t + 1) * 64 * ZP); }
        const int k0 = t * 64;
#pragma unroll 1
        for (int sub = 0; sub < 2; ++sub) {
            const int kb = k0 + 32 * sub;
            if (kb <= qw + 31) {
                f32x16 s0, s1;
#pragma unroll
                for (int r = 0; r < 16; ++r) { s0[r] = 0.f; s1[r] = 0.f; }
                const LAS bf16* kr = Ks + (32 * sub + r32) * 72 + 8 * half;
#pragma unroll
                for (int s = 0; s < 2; ++s) {
                    const s16x8 a0 = *(const LAS s16x8*)(kr + 16 * s), a1 = *(const LAS s16x8*)(kr + 32 + 16 * s);
                    s0 = __builtin_amdgcn_mfma_f32_32x32x16_bf16(a0, qf[0][s], s0, 0, 0, 0);
                    s1 = __builtin_amdgcn_mfma_f32_32x32x16_bf16(a1, qf[1][s], s1, 0, 0, 0);
                }
                const bool diag = (kb + 31 > qw);
#pragma unroll
                for (int r = 0; r < 16; ++r) {
                    float p0 = __expf(s0[r] - coff), p1 = __expf(s1[r] - coff);
                    if (diag) { const int key = kb + 8 * (r >> 2) + 4 * half + (r & 3); if (key > qw + r32) { p0 = 0.f; p1 = 0.f; } }
                    ls0 += p0; ls1 += p1; s0[r] = p0; s1[r] = p1;
                }
#pragma unroll
                for (int s = 0; s < 2; ++s) {
                    u32x4 w0, w1;
                    w0.x = pkbf(s0[8 * s], s0[8 * s + 1]); w0.y = pkbf(s0[8 * s + 2], s0[8 * s + 3]); w0.z = pkbf(s0[8 * s + 4], s0[8 * s + 5]); w0.w = pkbf(s0[8 * s + 6], s0[8 * s + 7]);
                    w1.x = pkbf(s1[8 * s], s1[8 * s + 1]); w1.y = pkbf(s1[8 * s + 2], s1[8 * s + 3]); w1.z = pkbf(s1[8 * s + 4], s1[8 * s + 5]); w1.w = pkbf(s1[8 * s + 6], s1[8 * s + 7]);
                    const s16x8 pf0 = __builtin_bit_cast(s16x8, w0), pf1 = __builtin_bit_cast(s16x8, w1);
#pragma unroll
                    for (int db = 0; db < 2; ++db) {
                        const LAS bf16* vr = Vt + (db * 32 + r32) * 72 + 32 * sub + 16 * s + 4 * half;
                        const u32x2 v0 = *(const LAS u32x2*)vr, v1 = *(const LAS u32x2*)(vr + 8);
                        const u32x4 vv = (u32x4){v0.x, v0.y, v1.x, v1.y};
                        const s16x8 vf = __builtin_bit_cast(s16x8, vv);
                        oacc[0][db] = __builtin_amdgcn_mfma_f32_32x32x16_bf16(vf, pf0, oacc[0][db], 0, 0, 0);
                        oacc[1][db] = __builtin_amdgcn_mfma_f32_32x32x16_bf16(vf, pf1, oacc[1][db], 0, 0, 0);
                    }
                }
            }
        }
    }
    ls0 += __shfl_xor(ls0, 32); ls1 += __shfl_xor(ls1, 32);
    const float i0 = 1.f / ls0, i1 = lam / ls1;
    float ss = 0.f;
#pragma unroll
    for (int db = 0; db < 2; ++db)
#pragma unroll
        for (int r = 0; r < 16; ++r) { const float v = oacc[0][db][r] * i0 - oacc[1][db][r] * i1; oacc[0][db][r] = v; ss = fmaf(v, v, ss); }
    ss += __shfl_xor(ss, 32);
    const float rr = (1.f - lam_init) / sqrtf(ss * (1.f / 64.f) + EPS);
    const float* hg = p.diff_head_norm + l * 64;
    bf16* orow = O0 + (tokb + qw + r32) * 256 + h * 64;
#pragma unroll
    for (int db = 0; db < 2; ++db)
#pragma unroll
        for (int g = 0; g < 4; ++g) { const int d0 = db * 32 + 8 * g + 4 * half; const f32x4 gg = *(const f32x4*)(hg + d0);
            u32x2 w; w.x = pkbf(oacc[0][db][4 * g] * rr * gg[0], oacc[0][db][4 * g + 1] * rr * gg[1]); w.y = pkbf(oacc[0][db][4 * g + 2] * rr * gg[2], oacc[0][db][4 * g + 3] * rr * gg[3]);
            *(u32x2*)(orow + d0) = w; }
    __syncthreads();
}

__device__ __forceinline__ void sb_item(const Params& p, int bh, int g, LAS unsigned char* lds, int wv) {
    const int tid = tid_fresh(wv), lane = tid & 63, w = tid >> 6, b = bh >> 2, h = bh & 3;
    const bf16* Z = (const bf16*)(p.ws + WS_BIG); bf16* O2 = (bf16*)(p.ws + WS_O + 2 * OB_STRIDE);
    LAS float* KV = (LAS float*)lds + w * 4096;
    const int t0 = g * 512 + w * 64, t = t0 + lane; const size_t tok = (size_t)b * SEQ + t;
    float q[64], o[64];
    { const u32x4* qp = (const u32x4*)(Z + tok * ZP + 1792 + h * 64);
#pragma unroll
      for (int i = 0; i < 8; ++i) { const u32x4 x = qp[i]; q[8 * i] = bflo(x.x); q[8 * i + 1] = bfhi(x.x); q[8 * i + 2] = bflo(x.y); q[8 * i + 3] = bfhi(x.y); q[8 * i + 4] = bflo(x.z); q[8 * i + 5] = bfhi(x.z); q[8 * i + 6] = bflo(x.w); q[8 * i + 7] = bfhi(x.w); } }
#pragma unroll
    for (int i = 0; i < 64; ++i) o[i] = 0.f;
    float R = 0.f;
    const int lkey = lane >> 1, lhalf = lane & 1;
    for (int slo = t0 + 32; slo >= 0; slo -= 32) {
        asm volatile("s_waitcnt lgkmcnt(0)" ::: "memory");
        { const size_t ktok = (size_t)b * SEQ + slo + lkey;
          const u32x4* ks = (const u32x4*)(Z + ktok * ZP + 2048 + h * 64 + lhalf * 32); const u32x4* vs = (const u32x4*)(Z + ktok * ZP + 2304 + h * 64 + lhalf * 32);
          LAS float* kd = KV + lkey * 128 + lhalf * 32; LAS float* vd = kd + 64;
#pragma unroll
          for (int i = 0; i < 4; ++i) { const u32x4 x = ks[i]; *(LAS f32x4*)(kd + 8 * i) = (f32x4){bflo(x.x), bfhi(x.x), bflo(x.y), bfhi(x.y)}; *(LAS f32x4*)(kd + 8 * i + 4) = (f32x4){bflo(x.z), bfhi(x.z), bflo(x.w), bfhi(x.w)}; }
#pragma unroll
          for (int i = 0; i < 4; ++i) { const u32x4 x = vs[i]; *(LAS f32x4*)(vd + 8 * i) = (f32x4){bflo(x.x), bfhi(x.x), bflo(x.y), bfhi(x.y)}; *(LAS f32x4*)(vd + 8 * i + 4) = (f32x4){bflo(x.z), bfhi(x.z), bflo(x.w), bfhi(x.w)}; } }
        asm volatile("s_waitcnt lgkmcnt(0)" ::: "memory");
        for (int kk = 31; kk >= 0; --kk) {
            const int s = slo + kk; const bool act = s < t;
            const LAS f32x4* kr = (const LAS f32x4*)(KV + kk * 128);
            float z = 0.f;
#pragma unroll
            for (int i = 0; i < 16; ++i) { const f32x4 kv = kr[i]; z = fmaf(q[4 * i], kv[0], z); z = fmaf(q[4 * i + 1], kv[1], z); z = fmaf(q[4 * i + 2], kv[2], z); z = fmaf(q[4 * i + 3], kv[3], z); }
            z *= 0.125f;
            const float lb = fminf(z, 0.f) - __logf(1.f + __expf(-fabsf(z)));
            const float a = act ? __expf(lb + R) : 0.f;
            R += act ? (lb - z) : 0.f;
#pragma unroll
            for (int i = 0; i < 16; ++i) { const f32x4 vv = kr[16 + i]; o[4 * i] = fmaf(a, vv[0], o[4 * i]); o[4 * i + 1] = fmaf(a, vv[1], o[4 * i + 1]); o[4 * i + 2] = fmaf(a, vv[2], o[4 * i + 2]); o[4 * i + 3] = fmaf(a, vv[3], o[4 * i + 3]); }
        }
        if (__all(R < -104.f)) break;
    }
    u32x4* dst = (u32x4*)(O2 + tok * 256 + h * 64);
#pragma unroll
    for (int i = 0; i < 8; ++i) { u32x4 x; x.x = pk2(o[8 * i], o[8 * i + 1]); x.y = pk2(o[8 * i + 2], o[8 * i + 3]); x.z = pk2(o[8 * i + 4], o[8 * i + 5]); x.w = pk2(o[8 * i + 6], o[8 * i + 7]); dst[i] = x; }
    asm volatile("s_waitcnt lgkmcnt(0)" ::: "memory");
}
constexpr size_t WS_MLS = 460 * MiB, WS_DEC = WS_MLS + 5 * 32 * 4096 * 4, WS_UN = 463 * MiB, WS_NV = WS_UN + 512 * 1024, WS_UT = 464 * MiB, WS_CT = 496 * MiB, WS_END2 = 512 * MiB;
constexpr int MLN = 32 * 4096;
__device__ __forceinline__ void ml_prepass(const Params& p, int l, int bh, int lane) {
    const int b = bh >> 2, h = bh & 3; const float* ZS = (const float*)(p.ws + WS_ZS);
    float* MLS = (float*)(p.ws + WS_MLS); float* DEC = (float*)(p.ws + WS_DEC);
    const float gb_i = p.ml_gate_bias[(l * 2 + 0) * 4 + h], gb_f = p.ml_gate_bias[(l * 2 + 1) * 4 + h];
    float cA = 0.f, cB = 0.f;
#pragma unroll 1
    for (int c4 = 0; c4 < 16; ++c4) {
        float igv[4], fzv[4];
#pragma unroll
        for (int k = 0; k < 4; ++k) { const size_t tok = (size_t)b * SEQ + (c4 * 4 + k) * 64 + lane; igv[k] = ZS[tok * ZSP + 168 + h]; fzv[k] = ZS[tok * ZSP + 172 + h]; }
#pragma unroll
        for (int k = 0; k < 4; ++k) {
            const int c = c4 * 4 + k;
            const float ig = igv[k] + gb_i, fz = fzv[k] + gb_f;
            const float lf = fminf(fz, 0.f) - __logf(1.f + __expf(-fabsf(fz)));
            float bsum = lf;
#pragma unroll
            for (int d = 1; d < 64; d <<= 1) { const float n = __shfl_up(bsum, d); if (lane >= d) bsum += n; }
            const float bl = __shfl(bsum, 63);
            const float a = ig - bsum;
            float pm = a;
#pragma unroll
            for (int d = 1; d < 64; d <<= 1) { const float n = __shfl_up(pm, d); if (lane >= d) pm = fmaxf(pm, n); }
            const float gmax = bl + __shfl(pm, 63);
            const int ti = bh * 4096 + c * 64 + lane;
            MLS[ti] = bsum; MLS[MLN + ti] = a; MLS[2 * MLN + ti] = pm;
            cA = (lane == c) ? bl : cA; cB = (lane == c) ? gmax : cB;
        }
    }
    float sA = cA, sB = cB;
#pragma unroll
    for (int d = 1; d < 64; d <<= 1) { const float pA = __shfl_up(sA, d), pB = __shfl_up(sB, d); if (lane >= d) { sB = fmaxf(pB + sA, sB); sA = pA + sA; } }
    const float m_out = fmaxf(sA, sB);
    float m_in = __shfl_up(m_out, 1); if (lane == 0) m_in = 0.f;
    DEC[bh * 64 + lane] = __expf(cA + m_in - m_out);
    asm volatile("s_waitcnt vmcnt(0)" ::: "memory");
#pragma unroll 1
    for (int c4 = 0; c4 < 16; ++c4) {
        float bsv[4], av[4], pmv[4];
#pragma unroll
        for (int k = 0; k < 4; ++k) { const int ti = bh * 4096 + (c4 * 4 + k) * 64 + lane; bsv[k] = MLS[ti]; av[k] = MLS[MLN + ti]; pmv[k] = MLS[2 * MLN + ti]; }
#pragma unroll
        for (int k = 0; k < 4; ++k) {
            const int c = c4 * 4 + k;
            const float mi = __shfl(m_in, c), mo = __shfl(m_out, c), bl = __shfl(cA, c);
            const int ti = bh * 4096 + c * 64 + lane;
            const float mt = bsv[k] + fmaxf(mi, pmv[k]);
            MLS[2 * MLN + ti] = mt; MLS[3 * MLN + ti] = __expf(bl + av[k] - mo); MLS[4 * MLN + ti] = __expf(bsv[k] + mi - mt);
        }
    }
}
__device__ __forceinline__ void ml_conv8(const bf16* Z, const float* cw, const float* cb, int b, int t, int ch0, float (&y)[8]) {
    const f32x4 b0 = *(const f32x4*)(cb + ch0), b1 = *(const f32x4*)(cb + ch0 + 4);
    y[0] = b0[0]; y[1] = b0[1]; y[2] = b0[2]; y[3] = b0[3]; y[4] = b1[0]; y[5] = b1[1]; y[6] = b1[2]; y[7] = b1[3];
#pragma unroll
    for (int j = 0; j < 4; ++j) {
        const int tt = t - 3 + j;
        if (tt >= 0) {
            const u32x4 x = *(const u32x4*)(Z + ((size_t)b * SEQ + tt) * ZP + 768 + ch0);
            const f32x4 w0 = *(const f32x4*)(cw + j * 512 + ch0), w1 = *(const f32x4*)(cw + j * 512 + ch0 + 4);
            y[0] = fmaf(w0[0], bflo(x.x), y[0]); y[1] = fmaf(w0[1], bfhi(x.x), y[1]); y[2] = fmaf(w0[2], bflo(x.y), y[2]); y[3] = fmaf(w0[3], bfhi(x.y), y[3]);
            y[4] = fmaf(w1[0], bflo(x.z), y[4]); y[5] = fmaf(w1[1], bfhi(x.z), y[5]); y[6] = fmaf(w1[2], bflo(x.w), y[6]); y[7] = fmaf(w1[3], bfhi(x.w), y[7]);
        }
    }
#pragma unroll
    for (int i = 0; i < 8; ++i) y[i] = y[i] * sigmoidf_(y[i]);
}
__device__ __forceinline__ void mlB_item(const Params& p, int l, int bh, int ci, LAS unsigned char* lds, int wv) {
    const int tid = tid_fresh(wv), lane = tid & 63, half = lane >> 5, r32 = lane & 31, b = bh >> 2, h = bh & 3;
    const bf16* Z = (const bf16*)(p.ws + WS_BIG); const float* MLS = (const float*)(p.ws + WS_MLS);
    float* UT = (float*)(p.ws + WS_UT); float* UN = (float*)(p.ws + WS_UN);
    LAS bf16* KT = (LAS bf16*)lds; LAS bf16* VT = KT + 4 * 64 * 72;
    const float* cw = p.ml_conv_w + (size_t)l * 4 * 512; const float* cb = p.ml_conv_b + (size_t)l * 512;
    __syncthreads();
    {
        const int tt = tid >> 1, hr = tid & 1, cl = tt >> 6, s = tt & 63, t = (ci * 4) * 64 + tt;
        const float wk = MLS[3 * MLN + bh * 4096 + t];
#pragma unroll 1
        for (int q8 = 0; q8 < 4; ++q8) {
            const int d0 = hr * 32 + q8 * 8; float y[8];
            ml_conv8(Z, cw, cb, b, t, 256 + h * 64 + d0, y);
            LAS bf16* dst = KT + (cl * 64 + d0) * 72 + s;
#pragma unroll
            for (int i = 0; i < 8; ++i) dst[i * 72] = (bf16)f2bf(y[i] * wk);
            const u32x4 v = *(const u32x4*)(Z + ((size_t)b * SEQ + t) * ZP + 1280 + h * 64 + d0);
            LAS bf16* vd = VT + (cl * 64 + d0) * 72 + s;
            vd[0] = (bf16)(v.x & 0xffffu); vd[72] = (bf16)(v.x >> 16); vd[144] = (bf16)(v.y & 0xffffu); vd[216] = (bf16)(v.y >> 16);
            vd[288] = (bf16)(v.z & 0xffffu); vd[360] = (bf16)(v.z >> 16); vd[432] = (bf16)(v.w & 0xffffu); vd[504] = (bf16)(v.w >> 16);
        }
    }
    __syncthreads();
    const int cl = wv >> 1, dh = wv & 1, c = ci * 4 + cl;
    f32x16 acc[2];
#pragma unroll
    for (int eb = 0; eb < 2; ++eb)
#pragma unroll
        for (int r = 0; r < 16; ++r) acc[eb][r] = 0.f;
#pragma unroll
    for (int s4 = 0; s4 < 4; ++s4) {
        const s16x8 bk = *(const LAS s16x8*)(KT + (cl * 64 + dh * 32 + r32) * 72 + 16 * s4 + 8 * half);
#pragma unroll
        for (int eb = 0; eb < 2; ++eb) {
            const s16x8 av = *(const LAS s16x8*)(VT + (cl * 64 + eb * 32 + r32) * 72 + 16 * s4 + 8 * half);
            acc[eb] = __builtin_amdgcn_mfma_f32_32x32x16_bf16(av, bk, acc[eb], 0, 0, 0);
        }
    }
    float* ut = UT + ((size_t)(bh * 64 + c) * 64) * 64;
#pragma unroll
    for (int eb = 0; eb < 2; ++eb)
#pragma unroll
        for (int r = 0; r < 16; ++r) { const int e = eb * 32 + 8 * (r >> 2) + 4 * half + (r & 3); ut[e * 64 + dh * 32 + r32] = acc[eb][r]; }
    {
        const LAS bf16* kr = KT + (cl * 64 + dh * 32 + r32) * 72 + half * 32; float sm = 0.f;
#pragma unroll
        for (int i = 0; i < 4; ++i) { const u32x4 x = *(const LAS u32x4*)(kr + 8 * i); sm += (bflo(x.x) + bfhi(x.x)) + (bflo(x.y) + bfhi(x.y)) + (bflo(x.z) + bfhi(x.z)) + (bflo(x.w) + bfhi(x.w)); }
        sm += __shfl_xor(sm, 32);
        if (half == 0) UN[(bh * 64 + c) * 64 + dh * 32 + r32] = sm;
    }
}
__device__ __forceinline__ void mlS_item(const Params& p, int bh, int wv) {
    const int tid = tid_fresh(wv);
    const float* UT = (const float*)(p.ws + WS_UT) + (size_t)bh * 64 * 4096; const float* UN = (const float*)(p.ws + WS_UN) + bh * 4096;
    bf16* CT = (bf16*)(p.ws + WS_CT) + (size_t)bh * 64 * 4096; float* NV = (float*)(p.ws + WS_NV) + bh * 4096; const float* DEC = (const float*)(p.ws + WS_DEC) + bh * 64;
    f32x4 s0 = (f32x4){0.f, 0.f, 0.f, 0.f}, s1 = s0; float ns = 0.f;
#pragma unroll 4
    for (int c = 0; c < 64; ++c) {
        const float dec = DEC[c];
        const f32x4 u0 = *(const f32x4*)(UT + (size_t)c * 4096 + tid * 8), u1 = *(const f32x4*)(UT + (size_t)c * 4096 + tid * 8 + 4);
        u32x4 w; w.x = pk2(s0[0], s0[1]); w.y = pk2(s0[2], s0[3]); w.z = pk2(s1[0], s1[1]); w.w = pk2(s1[2], s1[3]);
        *(u32x4*)(CT + (size_t)c * 4096 + tid * 8) = w;
        s0 = s0 * dec + u0; s1 = s1 * dec + u1;
        if (tid < 64) { NV[c * 64 + tid] = ns; ns = ns * dec + UN[c * 64 + tid]; }
    }
}
__device__ __forceinline__ void mlD_item(const Params& p, int l, int bh, int ci, LAS unsigned char* lds, int wv) {
    const int tid = tid_fresh(wv), lane = tid & 63, half = lane >> 5, r32 = lane & 31, b = bh >> 2, h = bh & 3;
    const bf16* Z = (const bf16*)(p.ws + WS_BIG); const float* MLS = (const float*)(p.ws + WS_MLS); bf16* O1 = (bf16*)(p.ws + WS_O + OB_STRIDE);
    LAS bf16* Qs = (LAS bf16*)lds; LAS bf16* Ks = Qs + 4 * 64 * 72; LAS bf16* VT = Ks + 4 * 64 * 72;
    const float* cw = p.ml_conv_w + (size_t)l * 4 * 512; const float* cb = p.ml_conv_b + (size_t)l * 512;
    __syncthreads();
    {
        const int tt = tid >> 1, hr = tid & 1, cl = tt >> 6, s = tt & 63, t = (ci * 4) * 64 + tt;
#pragma unroll 1
        for (int q8 = 0; q8 < 4; ++q8) {
            const int d0 = hr * 32 + q8 * 8; float y[8];
            ml_conv8(Z, cw, cb, b, t, h * 64 + d0, y);
            u32x4 w; w.x = pk2(y[0] * 0.125f, y[1] * 0.125f); w.y = pk2(y[2] * 0.125f, y[3] * 0.125f); w.z = pk2(y[4] * 0.125f, y[5] * 0.125f); w.w = pk2(y[6] * 0.125f, y[7] * 0.125f);
            *(LAS u32x4*)(Qs + (cl * 64 + s) * 72 + d0) = w;
            ml_conv8(Z, cw, cb, b, t, 256 + h * 64 + d0, y);
            w.x = pk2(y[0], y[1]); w.y = pk2(y[2], y[3]); w.z = pk2(y[4], y[5]); w.w = pk2(y[6], y[7]);
            *(LAS u32x4*)(Ks + (cl * 64 + s) * 72 + d0) = w;
            const u32x4 v = *(const u32x4*)(Z + ((size_t)b * SEQ + t) * ZP + 1280 + h * 64 + d0);
            LAS bf16* vd = VT + (cl * 64 + d0) * 72 + s;
            vd[0] = (bf16)(v.x & 0xffffu); vd[72] = (bf16)(v.x >> 16); vd[144] = (bf16)(v.y & 0xffffu); vd[216] = (bf16)(v.y >> 16);
            vd[288] = (bf16)(v.z & 0xffffu); vd[360] = (bf16)(v.z >> 16); vd[432] = (bf16)(v.w & 0xffffu); vd[504] = (bf16)(v.w >> 16);
        }
    }
    __syncthreads();
    const int cl = wv >> 1, th = wv & 1, c = ci * 4 + cl, tloc = th * 32 + r32, tseq = c * 64 + tloc;
    const int ti = bh * 4096 + tseq;
    const float bs_t = MLS[ti], mt_t = MLS[2 * MLN + ti], iw_t = MLS[4 * MLN + ti];
    s16x8 qf[4];
#pragma unroll
    for (int s4 = 0; s4 < 4; ++s4) qf[s4] = *(const LAS s16x8*)(Qs + (cl * 64 + tloc) * 72 + 16 * s4 + 8 * half);
    f32x16 oacc[2];
#pragma unroll
    for (int eb = 0; eb < 2; ++eb)
#pragma unroll
        for (int r = 0; r < 16; ++r) oacc[eb][r] = 0.f;
    const bf16* CT = (const bf16*)(p.ws + WS_CT) + (size_t)(bh * 64 + c) * 4096;
#pragma unroll
    for (int s4 = 0; s4 < 4; ++s4)
#pragma unroll
        for (int eb = 0; eb < 2; ++eb) { const s16x8 ac = *(const s16x8*)(CT + (eb * 32 + r32) * 64 + 16 * s4 + 8 * half);
            oacc[eb] = __builtin_amdgcn_mfma_f32_32x32x16_bf16(ac, qf[s4], oacc[eb], 0, 0, 0); }
#pragma unroll
    for (int eb = 0; eb < 2; ++eb)
#pragma unroll
        for (int r = 0; r < 16; ++r) oacc[eb][r] *= iw_t;
    float qn = 0.f;
    { const float* nvp = (const float*)(p.ws + WS_NV) + (bh * 64 + c) * 64;
#pragma unroll
      for (int s4 = 0; s4 < 4; ++s4) { const f32x4 n0 = *(const f32x4*)(nvp + 16 * s4 + 8 * half), n1 = *(const f32x4*)(nvp + 16 * s4 + 8 * half + 4);
          const u32x4 qq = __builtin_bit_cast(u32x4, qf[s4]);
          qn += bflo(qq.x) * n0[0] + bfhi(qq.x) * n0[1] + bflo(qq.y) * n0[2] + bfhi(qq.y) * n0[3] + bflo(qq.z) * n1[0] + bfhi(qq.z) * n1[1] + bflo(qq.w) * n1[2] + bfhi(qq.w) * n1[3]; } }
    qn += __shfl_xor(qn, 32);
    float rs = 0.f;
#pragma unroll
    for (int sb = 0; sb < 2; ++sb) {
        if (sb <= th) {
            f32x16 sacc;
#pragma unroll
            for (int r = 0; r < 16; ++r) sacc[r] = 0.f;
#pragma unroll
            for (int s4 = 0; s4 < 4; ++s4) { const s16x8 ak = *(const LAS s16x8*)(Ks + (cl * 64 + sb * 32 + r32) * 72 + 16 * s4 + 8 * half);
                sacc = __builtin_amdgcn_mfma_f32_32x32x16_bf16(ak, qf[s4], sacc, 0, 0, 0); }
            const float* ap = MLS + MLN + bh * 4096 + c * 64 + sb * 32 + 4 * half;
#pragma unroll
            for (int g = 0; g < 4; ++g) { const f32x4 av = *(const f32x4*)(ap + 8 * g);
#pragma unroll
                for (int i = 0; i < 4; ++i) { const int s = sb * 32 + 8 * g + 4 * half + i; const float v = (s <= tloc) ? sacc[4 * g + i] * __expf(bs_t + av[i] - mt_t) : 0.f; sacc[4 * g + i] = v; rs += v; } }
#pragma unroll
            for (int s2 = 0; s2 < 2; ++s2) {
                u32x4 w; w.x = pkbf(sacc[8 * s2], sacc[8 * s2 + 1]); w.y = pkbf(sacc[8 * s2 + 2], sacc[8 * s2 + 3]); w.z = pkbf(sacc[8 * s2 + 4], sacc[8 * s2 + 5]); w.w = pkbf(sacc[8 * s2 + 6], sacc[8 * s2 + 7]);
                const s16x8 pf = __builtin_bit_cast(s16x8, w);
#pragma unroll
                for (int eb = 0; eb < 2; ++eb) {
                    const LAS bf16* vr = VT + (cl * 64 + eb * 32 + r32) * 72 + sb * 32 + 16 * s2 + 4 * half;
                    const u32x2 v0 = *(const LAS u32x2*)vr, v1 = *(const LAS u32x2*)(vr + 8);
                    const u32x4 vv = (u32x4){v0.x, v0.y, v1.x, v1.y};
                    oacc[eb] = __builtin_amdgcn_mfma_f32_32x32x16_bf16(__builtin_bit_cast(s16x8, vv), pf, oacc[eb], 0, 0, 0);
                }
            }
        }
    }
    rs += __shfl_xor(rs, 32);
    const float den = iw_t * qn + rs;
    const float dn = 1.f / fmaxf(fabsf(den), __expf(-mt_t));
    float ss = 0.f;
#pragma unroll
    for (int eb = 0; eb < 2; ++eb)
#pragma unroll
        for (int r = 0; r < 16; ++r) { const float v = oacc[eb][r] * dn; oacc[eb][r] = v; ss = fmaf(v, v, ss); }
    ss += __shfl_xor(ss, 32);
    const float rr = 1.f / sqrtf(ss * (1.f / 64.f) + EPS);
    const size_t tok = (size_t)b * SEQ + tseq;
    const float* hg = p.ml_head_norm + l * 64;
#pragma unroll
    for (int eb = 0; eb < 2; ++eb)
#pragma unroll
        for (int g = 0; g < 4; ++g) { const int e0 = eb * 32 + 8 * g + 4 * half; const f32x4 gg = *(const f32x4*)(hg + e0);
            const u32x2 og = *(const u32x2*)(Z + tok * ZP + 1536 + h * 64 + e0);
            u32x2 w; w.x = pkbf(sigmoidf_(bflo(og.x)) * oacc[eb][4 * g] * rr * gg[0], sigmoidf_(bfhi(og.x)) * oacc[eb][4 * g + 1] * rr * gg[1]);
            w.y = pkbf(sigmoidf_(bflo(og.y)) * oacc[eb][4 * g + 2] * rr * gg[2], sigmoidf_(bfhi(og.y)) * oacc[eb][4 * g + 3] * rr * gg[3]);
            *(u32x2*)(O1 + tok * 256 + h * 64 + e0) = w; }
}
__device__ __forceinline__ float relu_(float x) { return __builtin_amdgcn_fmed3f(x, 0.f, __builtin_inff()); }
__device__ __forceinline__ unsigned key16(float s) { const float f = __builtin_amdgcn_fmed3f(floorf(fmaf(s, 512.f, 32768.f)), 0.f, 65535.f); return (unsigned)f; }
__device__ __forceinline__ unsigned mono_bits(float s) { s = (s == 0.f) ? 0.f : s; const unsigned u = __float_as_uint(s); return (u & 0x80000000u) ? ~u : (u | 0x80000000u); }
__device__ __forceinline__ void dsa_item(const Params& p, int lds_l, int b, int qt, LAS unsigned char* lds, int wv) {
    const int tid = tid_fresh(wv), lane = tid & 63, w = wv, half = lane >> 5, r32 = lane & 31;
    const bf16* Z = (const bf16*)(p.ws + WS_BIG); const float* ZS = (const float*)(p.ws + WS_ZS); const bf16* IK = (const bf16*)(p.ws + WS_IK); bf16* O3 = (bf16*)(p.ws + WS_O + 3 * OB_STRIDE);
    LAS unsigned* hist = (LAS unsigned*)lds + w * 1024;
    LAS unsigned* maskw = (LAS unsigned*)(lds + 32768);
    LAS bf16* KC = (LAS bf16*)(lds + 49152);
    LAS bf16* Kd = (LAS bf16*)(lds + 81920); LAS bf16* VTd = Kd + 64 * 72;
    const size_t tokb = (size_t)b * SEQ; const int tb = qt * 32 + 4 * w;
    const int ntiles = qt + 1, nkeys = ntiles * 32, nchunks = (ntiles + 15) >> 4;
    s16x8 aq0, aq1;
    { const int qrow = 2 * ((r32 >> 2) & 1) + (r32 >> 4), hrow = 4 * ((r32 >> 3) & 1) + (r32 & 3);
      const bf16* ap = Z + (tokb + tb + qrow) * ZP + 2816 + hrow * 32 + half * 8; aq0 = *(const s16x8*)ap; aq1 = *(const s16x8*)(ap + 16); }
    float wq[2][8];
#pragma unroll
    for (int s = 0; s < 2; ++s) { const float* wp = ZS + (tokb + tb + 2 * half + s) * ZSP + 160; const f32x4 x0 = *(const f32x4*)wp, x1 = *(const f32x4*)(wp + 4);
        wq[s][0] = x0[0]; wq[s][1] = x0[1]; wq[s][2] = x0[2]; wq[s][3] = x0[3]; wq[s][4] = x1[0]; wq[s][5] = x1[1]; wq[s][6] = x1[2]; wq[s][7] = x1[3]; }
    unsigned tau[4], prefix[4]; int quota[4], krem[4], eqs[2]; bool allsel[4];
    LAS unsigned* cand = (LAS unsigned*)(lds + 100352) + w * 1024;
    LAS unsigned* oflag = (LAS unsigned*)(lds + LDS_BYTES - 48);
    const unsigned lowmask = (1u << r32) - 1u;
#define DSA_SCORES(ktl, sc) do { const LAS bf16* kp_ = KC + ((ktl) * 32 + r32) * 32 + half * 8; \
        const s16x8 b0_ = *(const LAS s16x8*)kp_, b1_ = *(const LAS s16x8*)(kp_ + 16); f32x16 a_ = {0.f, 0.f, 0.f, 0.f, 0.f, 0.f, 0.f, 0.f, 0.f, 0.f, 0.f, 0.f, 0.f, 0.f, 0.f, 0.f}; \
        a_ = __builtin_amdgcn_mfma_f32_32x32x16_bf16(aq0, b0_, a_, 0, 0, 0); a_ = __builtin_amdgcn_mfma_f32_32x32x16_bf16(aq1, b1_, a_, 0, 0, 0); \
        _Pragma("unroll") for (int s_ = 0; s_ < 2; ++s_) { float pt_ = wq[s_][0] * relu_(a_[8 * s_]); \
            _Pragma("unroll") for (int j_ = 1; j_ < 8; ++j_) pt_ = fmaf(wq[s_][j_], relu_(a_[8 * s_ + j_]), pt_); sc[s_] = pt_; } } while (0)
    int mode = (qt >= 8) ? 0 : 1;
#pragma unroll 1
    for (int attempt = 0; attempt < 2; ++attempt) {
        const int npass = (qt >= 8) ? (mode ? 4 : 2) : 0;
#pragma unroll
        for (int g = 0; g < 4; ++g) { tau[g] = 0u; prefix[g] = 0u; quota[g] = 1 << 30; krem[g] = 256; allsel[g] = true; }
        eqs[0] = 0; eqs[1] = 0;
        if (tid == 0) *oflag = 0u;
#pragma unroll 1
        for (int pass = 0; pass <= npass; ++pass) {
            const bool comp = (pass == npass);
            const int shift = 8 * (npass - 1 - pass);
            if (!comp) {
#pragma unroll
                for (int i = 0; i < 4; ++i) *(LAS u32x4*)(hist + (i * 64 + lane) * 4) = (u32x4){0u, 0u, 0u, 0u};
            }
            const unsigned pfa = half ? prefix[2] : prefix[0], pfb = half ? prefix[3] : prefix[1];
            const int ta = tb + 2 * half, tbq = ta + 1;
            u32x4 pre[4];
#pragma unroll
            for (int i = 0; i < 4; ++i) { const int kb = (tid * 16 + i * 8192) >> 6; pre[i] = (kb < nkeys) ? *(const u32x4*)((const unsigned char*)(IK + tokb * 32) + tid * 16 + i * 8192) : (u32x4){0u, 0u, 0u, 0u}; }
#pragma unroll 1
            for (int ch = 0; ch < nchunks; ++ch) {
                __syncthreads();
#pragma unroll
                for (int i = 0; i < 4; ++i) *(LAS u32x4*)((LAS unsigned char*)KC + tid * 16 + i * 8192) = pre[i];
                __syncthreads();
                if (ch + 1 < nchunks) {
#pragma unroll
                    for (int i = 0; i < 4; ++i) { const int kb = (ch + 1) * 512 + ((tid * 16 + i * 8192) >> 6);
                        pre[i] = (kb < nkeys) ? *(const u32x4*)((const unsigned char*)(IK + (tokb + (size_t)(ch + 1) * 512) * 32) + tid * 16 + i * 8192) : (u32x4){0u, 0u, 0u, 0u}; }
                }
                const int nt = min(16, ntiles - ch * 16);
                if (!comp) {
#pragma unroll 2
                    for (int ktl = 0; ktl < nt; ++ktl) {
                        float sc[2]; DSA_SCORES(ktl, sc);
                        const int key = (ch * 16 + ktl) * 32 + r32;
                        const float sa = sc[0], sb = sc[1];
                        const unsigned ma = mode ? mono_bits(sa) : key16(sa), mb = mode ? mono_bits(sb) : key16(sb);
                        const bool oka = (key <= ta) && (pass == 0 || (ma >> (shift + 8)) == pfa);
                        const bool okb = (key <= tbq) && (pass == 0 || (mb >> (shift + 8)) == pfb);
                        if (oka) __hip_atomic_fetch_add(hist + (2 * half) * 256 + ((ma >> shift) & 255u), 1u, __ATOMIC_RELAXED, __HIP_MEMORY_SCOPE_WORKGROUP);
                        if (okb) __hip_atomic_fetch_add(hist + (2 * half + 1) * 256 + ((mb >> shift) & 255u), 1u, __ATOMIC_RELAXED, __HIP_MEMORY_SCOPE_WORKGROUP);
                    }
                } else {
#pragma unroll 1
                    for (int ktl = 0; ktl < nt; ++ktl) {
                        float sc[2]; DSA_SCORES(ktl, sc);
                        const int key = (ch * 16 + ktl) * 32 + r32;
#pragma unroll
                        for (int s = 0; s < 2; ++s) {
                            const unsigned taus = half ? tau[2 + s] : tau[s]; const int quo = half ? quota[2 + s] : quota[s]; const bool alls = half ? allsel[2 + s] : allsel[s];
                            const unsigned mex = mono_bits(sc[s]); const unsigned m = mode ? mex : key16(sc[s]); const bool valid = key <= tb + 2 * half + s;
                            const bool eq = valid && (m == taus);
                            const unsigned beq = (unsigned)(__ballot(eq) >> (32 * half));
                            const int rank = eqs[s] + __popc(beq & lowmask);
                            const bool takeeq = mode ? (rank < quo) : alls;
                            const bool sel = valid && ((m > taus) || (eq && takeeq));
                            const unsigned bsel = (unsigned)(__ballot(sel) >> (32 * half));
                            if (r32 == 0) maskw[(4 * w + 2 * half + s) * 128 + ch * 16 + ktl] = bsel;
                            if (mode == 0 && !alls && eq && rank < 128) { cand[((2 * half + s) * 128 + rank) * 2] = mex; cand[((2 * half + s) * 128 + rank) * 2 + 1] = (unsigned)key; }
                            eqs[s] += __popc(beq);
                        }
                    }
                }
            }
            if (!comp) {
                LDS_WAIT();
#pragma unroll
                for (int g = 0; g < 4; ++g) {
                    const u32x4 cv = *(const LAS u32x4*)(hist + g * 256 + lane * 4);
                    const int c0 = (int)cv.x, c1 = (int)cv.y, c2 = (int)cv.z, c3 = (int)cv.w, tot = c0 + c1 + c2 + c3;
                    int v = tot;
#pragma unroll
                    for (int d = 1; d < 64; d <<= 1) { const int n = __shfl_down(v, d); if (lane + d < 64) v += n; }
                    const int a3 = v - tot, a2 = a3 + c3, a1 = a2 + c2, a0 = a1 + c1; const int k = krem[g];
                    int fb = -1, fa = 0, fc = 0;
                    if (a3 < k && a3 + c3 >= k) { fb = 3; fa = a3; fc = c3; }
                    else if (a2 < k && a2 + c2 >= k) { fb = 2; fa = a2; fc = c2; }
                    else if (a1 < k && a1 + c1 >= k) { fb = 1; fa = a1; fc = c1; }
                    else if (a0 < k && a0 + c0 >= k) { fb = 0; fa = a0; fc = c0; }
                    const unsigned long long mk = __ballot(fb >= 0);
                    const int src = (int)__builtin_ctzll(mk | (1ull << 63));
                    const int bin = __shfl(4 * lane + fb, src), above = __shfl(fa, src), cnt = __shfl(fc, src);
                    prefix[g] = (prefix[g] << 8) | (unsigned)bin; krem[g] = k - above;
                    if (pass == npass - 1) { tau[g] = prefix[g]; quota[g] = krem[g]; allsel[g] = (cnt == krem[g]); }
                }
            }
        }
        if (mode == 0 && npass) {
            LDS_WAIT();
#pragma unroll
            for (int g = 0; g < 4; ++g) {
                if (!allsel[g]) {
                    const int n = __shfl(eqs[g & 1], 32 * (g >> 1)), need = quota[g];
                    if (n > 128) { if (lane == 0) *oflag = 1u; }
                    else {
#pragma unroll 1
                        for (int i0 = 0; i0 < n; i0 += 64) {
                            const int i = i0 + lane; const bool act = i < n;
                            const unsigned mi = act ? cand[(g * 128 + i) * 2] : 0u, ki = act ? cand[(g * 128 + i) * 2 + 1] : 0u; int rank = 0;
#pragma unroll 1
                            for (int j = 0; j < n; ++j) { const unsigned mj = cand[(g * 128 + j) * 2], kj = cand[(g * 128 + j) * 2 + 1]; rank += ((mj > mi) || (mj == mi && kj < ki)) ? 1 : 0; }
                            if (act && rank < need) __hip_atomic_fetch_or(maskw + (4 * w + g) * 128 + (ki >> 5), 1u << (ki & 31u), __ATOMIC_RELAXED, __HIP_MEMORY_SCOPE_WORKGROUP);
                        }
                    }
                }
            }
        }
        __syncthreads();
        const unsigned of = *oflag;
        __syncthreads();
        if (mode == 0 && of != 0u) { mode = 1; continue; }
        break;
    }
    __syncthreads();
    {
        const float* sgn = p.dsa_qk_norm + lds_l * 128; float gqm = 0.f, gkm = 0.f;
#pragma unroll 2
        for (int i = 0; i < 64; ++i) { gqm = fmaxf(gqm, fabsf(sgn[i])); gkm = fmaxf(gkm, fabsf(sgn[64 + i])); }
        const float coff = 8.f * gqm * gkm;
        const int cb = w & 3, ksp = w >> 2, ql = 8 * cb + (r32 >> 2), hh = r32 & 3;
        s16x8 qf[4];
        { const bf16* qp = Z + (tokb + qt * 32 + ql) * ZP + 2560 + hh * 64 + 8 * half;
#pragma unroll
          for (int s4 = 0; s4 < 4; ++s4) qf[s4] = *(const s16x8*)(qp + 16 * s4); }
        f32x16 oacc[2];
#pragma unroll
        for (int db = 0; db < 2; ++db)
#pragma unroll
            for (int r = 0; r < 16; ++r) oacc[db][r] = 0.f;
        float lsum = 0.f;
        const int nT = (ntiles + 1) >> 1;
        const int skey = tid >> 3, sseg = tid & 7;
        const float* sgp = ZS + (tokb + skey) * ZSP + sseg * 16;
        f32x4 pr[4];
#pragma unroll
        for (int i = 0; i < 4; ++i) pr[i] = *(const f32x4*)(sgp + 4 * i);
#pragma unroll 1
        for (int tT = 0; tT < nT; ++tT) {
            __syncthreads();
            if (sseg < 4) {
                u32x4 w0, w1; w0.x = pkbf(pr[0][0], pr[0][1]); w0.y = pkbf(pr[0][2], pr[0][3]); w0.z = pkbf(pr[1][0], pr[1][1]); w0.w = pkbf(pr[1][2], pr[1][3]);
                w1.x = pkbf(pr[2][0], pr[2][1]); w1.y = pkbf(pr[2][2], pr[2][3]); w1.z = pkbf(pr[3][0], pr[3][1]); w1.w = pkbf(pr[3][2], pr[3][3]);
                *(LAS u32x4*)(Kd + skey * 72 + sseg * 16) = w0; *(LAS u32x4*)(Kd + skey * 72 + sseg * 16 + 8) = w1;
            } else {
                LAS bf16* vd = VTd + ((sseg - 4) * 16) * 72 + skey;
#pragma unroll
                for (int i = 0; i < 4; ++i) { const unsigned a0 = pkbf(pr[i][0], pr[i][1]), a1 = pkbf(pr[i][2], pr[i][3]);
                    vd[(4 * i) * 72] = (bf16)(a0 & 0xffffu); vd[(4 * i + 1) * 72] = (bf16)(a0 >> 16); vd[(4 * i + 2) * 72] = (bf16)(a1 & 0xffffu); vd[(4 * i + 3) * 72] = (bf16)(a1 >> 16); }
            }
            __syncthreads();
            if (tT + 1 < nT) {
#pragma unroll
                for (int i = 0; i < 4; ++i) pr[i] = *(const f32x4*)(sgp + (size_t)(tT + 1) * 64 * ZSP + 4 * i);
            }
            const int st = 2 * tT + ksp;
            if (st < ntiles) {
                const unsigned mw = maskw[ql * 128 + st];
                f32x16 sacc;
#pragma unroll
                for (int r = 0; r < 16; ++r) sacc[r] = 0.f;
#pragma unroll
                for (int s4 = 0; s4 < 4; ++s4) { const s16x8 ak = *(const LAS s16x8*)(Kd + (32 * ksp + r32) * 72 + 16 * s4 + 8 * half);
                    sacc = __builtin_amdgcn_mfma_f32_32x32x16_bf16(ak, qf[s4], sacc, 0, 0, 0); }
#pragma unroll
                for (int r = 0; r < 16; ++r) { const int kbit = 8 * (r >> 2) + 4 * half + (r & 3); const float pe = ((mw >> kbit) & 1u) ? __expf(sacc[r] - coff) : 0.f; sacc[r] = pe; lsum += pe; }
#pragma unroll
                for (int s2 = 0; s2 < 2; ++s2) {
                    u32x4 wp; wp.x = pkbf(sacc[8 * s2], sacc[8 * s2 + 1]); wp.y = pkbf(sacc[8 * s2 + 2], sacc[8 * s2 + 3]); wp.z = pkbf(sacc[8 * s2 + 4], sacc[8 * s2 + 5]); wp.w = pkbf(sacc[8 * s2 + 6], sacc[8 * s2 + 7]);
                    const s16x8 pf = __builtin_bit_cast(s16x8, wp);
#pragma unroll
                    for (int db = 0; db < 2; ++db) {
                        const LAS bf16* vr = VTd + (db * 32 + r32) * 72 + 32 * ksp + 16 * s2 + 4 * half;
                        const u32x2 v0 = *(const LAS u32x2*)vr, v1 = *(const LAS u32x2*)(vr + 8);
                        const u32x4 vv = (u32x4){v0.x, v0.y, v1.x, v1.y};
                        oacc[db] = __builtin_amdgcn_mfma_f32_32x32x16_bf16(__builtin_bit_cast(s16x8, vv), pf, oacc[db], 0, 0, 0);
                    }
                }
            }
        }
        lsum += __shfl_xor(lsum, 32);
        __syncthreads();
        LAS float* xch = (LAS float*)(lds + 49152) + (w & 3) * (33 * 64);
        if (ksp == 1) {
#pragma unroll
            for (int db = 0; db < 2; ++db)
#pragma unroll
                for (int r = 0; r < 16; ++r) xch[(db * 16 + r) * 64 + lane] = oacc[db][r];
            xch[32 * 64 + lane] = lsum;
        }
        __syncthreads();
        if (ksp == 0) {
            const float is = 1.f / (lsum + xch[32 * 64 + lane]);
            bf16* orow = O3 + (tokb + qt * 32 + ql) * 256 + hh * 64;
#pragma unroll
            for (int db = 0; db < 2; ++db)
#pragma unroll
                for (int g = 0; g < 4; ++g) { const int d0 = db * 32 + 8 * g + 4 * half;
                    const float x0 = (oacc[db][4 * g] + xch[(db * 16 + 4 * g) * 64 + lane]) * is, x1 = (oacc[db][4 * g + 1] + xch[(db * 16 + 4 * g + 1) * 64 + lane]) * is;
                    const float x2 = (oacc[db][4 * g + 2] + xch[(db * 16 + 4 * g + 2) * 64 + lane]) * is, x3 = (oacc[db][4 * g + 3] + xch[(db * 16 + 4 * g + 3) * 64 + lane]) * is;
                    u32x2 wo; wo.x = pkbf(x0, x1); wo.y = pkbf(x2, x3); *(u32x2*)(orow + d0) = wo; }
        }
    }
#undef DSA_SCORES
    __syncthreads();
}

constexpr int Q_ML = 32, Q_DIFF = 512, Q_DSA = 1024, Q_SB = 256, Q_TOTAL = Q_ML + Q_DIFF + Q_DSA + Q_SB;
__device__ __forceinline__ int next_item(unsigned* ctr, LAS int* slot, int wv) {
    __syncthreads();
    if (tid_fresh(wv) == 0) *slot = (int)atomicAdd(ctr, 1u);
    __syncthreads();
    return *slot;
}
__device__ __forceinline__ void mixer_phase1(int l, LAS unsigned char* lds, int wv, int co = 0) {
    LAS int* slot = (LAS int*)(lds + LDS_BYTES - 64);
    { const Params p = load_params(); unsigned* ctr = (unsigned*)(p.ws + WS_CTL) + 64 * (4 * l + 0 + co);
      for (;;) { const int it = next_item(ctr, slot, wv); if (it >= Q_DIFF) break; diffm_item(p, l, it & 31, 15 - (it >> 5), lds, wv); } }
    { const Params p = load_params(); unsigned* ctr = (unsigned*)(p.ws + WS_CTL) + 64 * (4 * l + 1 + co);
      for (;;) { const int it = next_item(ctr, slot, wv); if (it >= 512) break; mlB_item(p, l, it & 31, it >> 5, lds, wv); } }
}
__device__ __forceinline__ void mixer_phase2(int l, LAS unsigned char* lds, int wv, int co = 0) {
    LAS int* slot = (LAS int*)(lds + LDS_BYTES - 64);
    { const Params p = load_params(); unsigned* ctr = (unsigned*)(p.ws + WS_CTL) + 64 * (4 * l + 2 + co);
      for (;;) { const int it = next_item(ctr, slot, wv); if (it >= 32 + Q_DSA) break;
          if (it < 32) mlS_item(p, it, wv); else { const int i = it - 32; dsa_item(p, l, i & 7, 127 - (i >> 3), lds, wv); } } }
}
__device__ __forceinline__ void mixer_phase3(int l, LAS unsigned char* lds, int wv, int co = 0) {
    LAS int* slot = (LAS int*)(lds + LDS_BYTES - 64);
    { const Params p = load_params(); unsigned* ctr = (unsigned*)(p.ws + WS_CTL) + 64 * (4 * l + 3 + co);
      for (;;) { const int it = next_item(ctr, slot, wv); if (it >= 512) break; mlD_item(p, l, it & 31, it >> 5, lds, wv); } }
    { const Params p = load_params(); unsigned* ctr = (unsigned*)(p.ws + WS_CTL) + 64 * (8 + l + co);
      for (;;) { const int it = next_item(ctr, slot, wv); if (it >= Q_SB) break; sb_item(p, it >> 3, it & 7, lds, wv); } }
}

#define XB_TMO      128
#define XB_XCNT(j)  (256  + 64 * (j))
#define XB_XSUB(j)  (1280 + 64 * (j))
#define XB_XGEN(j)  (2304 + 64 * (j))
#define XB_TOP      3328
#define XB_TOPGEN   3392
#define XCD_BAR_WORDS 3456
#define XB_SPIN_CAP (1u << 20)
constexpr int CW_BAR = 8192;
__device__ __forceinline__ unsigned xb_ld(unsigned* p)              { return __hip_atomic_load(p, __ATOMIC_RELAXED, __HIP_MEMORY_SCOPE_AGENT); }
__device__ __forceinline__ unsigned xb_add(unsigned* p, unsigned v) { return __hip_atomic_fetch_add(p, v, __ATOMIC_RELAXED, __HIP_MEMORY_SCOPE_AGENT); }
__device__ __forceinline__ unsigned xb_xcc_id() { return (unsigned)__builtin_amdgcn_s_getreg((3 << 11) | 20) & 0xFu; }
#define XB_SPIN(cond, bar) do { unsigned _sp = 0; while (cond) { __builtin_amdgcn_s_sleep(1); \
    if ((++_sp & 255u) == 0u) { if (xb_ld(&(bar)[XB_TMO])) break; if (_sp > XB_SPIN_CAP) { atomicAdd(&(bar)[XB_TMO], 1u); break; } } } } while (0)
__device__ __forceinline__ void xcd_post(int wv) {
    const Params p = load_params(); unsigned* bar = (unsigned*)(p.ws + WS_CTL) + CW_BAR;
    if (tid_fresh(wv) == 0) (void)xb_add(&bar[XB_XCNT(xb_xcc_id())], 1u);
}
__device__ __forceinline__ void xcd_barrier_complete(unsigned* bar, unsigned x, unsigned& nloc, unsigned& nx) {
    const unsigned G = gridDim.x * gridDim.y * gridDim.z;
    unsigned sum, cnt, mine, sp = 0u;
    for (;;) {
        sum = 0u; cnt = 0u; mine = 0u;
#pragma unroll
        for (unsigned j = 0; j < 16; ++j) { const unsigned c = xb_ld(&bar[XB_XCNT(j)]); sum += c; cnt += (c > 0u) ? 1u : 0u; mine = (j == x) ? c : mine; }
        if (sum == G) break;
        __builtin_amdgcn_s_sleep(1);
        if ((++sp & 255u) == 0u) { if (xb_ld(&bar[XB_TMO])) break; if (sp > XB_SPIN_CAP) { atomicAdd(&bar[XB_TMO], 1u); break; } }
    }
    nloc = mine > 0u ? mine : 1u; nx = cnt > 0u ? cnt : 1u;
}
__device__ __forceinline__ void gsync(LAS unsigned char* lds, int wv) {
    asm volatile("s_waitcnt vmcnt(0)" ::: "memory");
    __syncthreads();
    if (tid_fresh(wv) == 0) {
        const Params p = load_params(); unsigned* bar = (unsigned*)(p.ws + WS_CTL) + CW_BAR;
        volatile LAS unsigned* st = (volatile LAS unsigned*)(lds + LDS_BYTES - 32);
        const unsigned x = xb_xcc_id();
        __builtin_amdgcn_s_waitcnt(0);
        unsigned nloc = st[0], nx = st[1];
        if (nloc == 0u) { xcd_barrier_complete(bar, x, nloc, nx); st[0] = nloc; st[1] = nx; }
        const unsigned old = xb_add(&bar[XB_XSUB(x)], 1u);
        const unsigned gen = old / nloc;
        if (old + 1u == (gen + 1u) * nloc) {
            __builtin_amdgcn_fence(__ATOMIC_RELEASE, "agent");
            asm volatile("s_waitcnt vmcnt(0)" ::: "memory");
            const unsigned og = xb_add(&bar[XB_TOP], 1u);
            const unsigned tg = og / nx;
            if (og + 1u == (tg + 1u) * nx) xb_add(&bar[XB_TOPGEN], 1u);
            else XB_SPIN(xb_ld(&bar[XB_TOPGEN]) == tg, bar);
            __builtin_amdgcn_fence(__ATOMIC_ACQUIRE, "agent");
            xb_add(&bar[XB_XGEN(x)], 1u);
            asm volatile("s_waitcnt vmcnt(0)" ::: "memory");
        } else {
            XB_SPIN(xb_ld(&bar[XB_XGEN(x)]) == gen, bar);
            __builtin_amdgcn_fence(__ATOMIC_ACQUIRE, "agent");
            asm volatile("s_waitcnt vmcnt(0)" ::: "memory");
        }
    }
    __syncthreads();
}

#define PH_LOCALS const Params p = load_params(); const int tid = tid_fresh(wv), lane = tid & 63, wave = tid >> 6; const int gw = (int)blockIdx.x * NWAVES + wave, ngw = (int)gridDim.x * NWAVES; \
    (void)lane; (void)gw; (void)ngw; bf16* HN = (bf16*)(p.ws + WS_HN); bf16* BIGB = (bf16*)(p.ws + WS_BIG); (void)HN; (void)BIGB;
template <int l> __device__ __forceinline__ void layer_body(cg::grid_group& grid, LAS unsigned char* lds, const int wv) {
        { PH_LOCALS const unsigned char* wl = p.ws + WS_W + (size_t)l * WL_STRIDE; EpiSwiglu E{l * 3 + 0}; run_gemm(lds, HN, (const bf16*)(wl + WL_GU1), T, 2 * FF, D, E, wv); }
        gsync(lds, wv);
        { PH_LOCALS const unsigned char* wl = p.ws + WS_W + (size_t)l * WL_STRIDE; EpiResid E{l == 0 ? 1 : 0, 0.5f, l * 3 + 1}; run_gemm(lds, BIGB, (const bf16*)(wl + WL_D1), T, D, FF, E, wv); }
        gsync(lds, wv);
        { PH_LOCALS const unsigned char* wl = p.ws + WS_W + (size_t)l * WL_STRIDE; EpiZ E{l * 3 + 1}; run_gemm(lds, HN, (const bf16*)(wl + WL_INA), T, 3328, D, E, wv); }
        gsync(lds, wv);
        { PH_LOCALS if (gw < 32) ml_prepass(p, l, gw, lane); prep_phase(p, l, gw, ngw, lane); }
        gsync(lds, wv);
        mixer_phase1(l, lds, wv);
        gsync(lds, wv);
        mixer_phase2(l, lds, wv);
        gsync(lds, wv);
        mixer_phase3(l, lds, wv);
        gsync(lds, wv);
#pragma unroll 1
        for (int hb = 0; hb < 2; ++hb) {
            { PH_LOCALS const unsigned char* wl = p.ws + WS_W + (size_t)l * WL_STRIDE; EpiSig E{l * 3 + 1}; run_gemm(lds, HN, (const bf16*)(wl + WL_G) + (size_t)hb * 2 * D * D, T, 2 * D, D, E, wv); }
            gsync(lds, wv);
#pragma unroll 1
            for (int bb = 0; bb < 2; ++bb) {
                PH_LOCALS const unsigned char* wl = p.ws + WS_W + (size_t)l * WL_STRIDE; const int b = hb * 2 + bb;
                EpiGate E{bb * D, b == 0 ? 1 : 0};
                run_gemm(lds, (const bf16*)(p.ws + WS_O + b * OB_STRIDE), (const bf16*)(wl + WL_BR) + (size_t)b * D * 256, T, D, 256, E, wv);
            }
            gsync(lds, wv);
        }
        { PH_LOCALS const unsigned char* wl = p.ws + WS_W + (size_t)l * WL_STRIDE; EpiResid E{0, 1.0f, l * 3 + 2}; run_gemm(lds, (const bf16*)(p.ws + WS_BIG + 128 * MiB), (const bf16*)(wl + WL_OUT), T, D, D, E, wv); }
        gsync(lds, wv);
        { PH_LOCALS const unsigned char* wl = p.ws + WS_W + (size_t)l * WL_STRIDE; EpiSwiglu E{l * 3 + 2}; run_gemm(lds, HN, (const bf16*)(wl + WL_GU2), T, 2 * FF, D, E, wv); }
        gsync(lds, wv);
        { PH_LOCALS const unsigned char* wl = p.ws + WS_W + (size_t)l * WL_STRIDE; EpiResid E{0, 0.5f, (l + 1 < DEPTH) ? (l + 1) * 3 : -1}; run_gemm(lds, BIGB, (const bf16*)(wl + WL_D2), T, D, FF, E, wv); }
        if (l + 1 < DEPTH) gsync(lds, wv);
    }

__global__ void __launch_bounds__(NTHR, 2) hybrid_fwd(Params p_unused) {
    extern __shared__ __attribute__((aligned(16))) unsigned char lds_raw[];
    LAS unsigned char* lds = (LAS unsigned char*)lds_raw;
    cg::grid_group grid = cg::this_grid();
    const int wv = __builtin_amdgcn_readfirstlane((int)threadIdx.x >> 6);
    {
        PH_LOCALS
        SegRun R; R.base = 0; R.gw = gw; R.ngw = ngw; R.lane = lane; R.scr = (LAS float*)(lds + wave * 8704);
        for (int l = 0; l < DEPTH; ++l) convert_weights(p, l, R);
        if (blockIdx.x == 0 && tid < 64) ((unsigned*)(p.ws + WS_CTL))[64 * tid] = 0u;
        if (blockIdx.x == 0) for (int i = tid; i < XCD_BAR_WORDS; i += NTHR) ((unsigned*)(p.ws + WS_CTL))[CW_BAR + i] = 0u;
        if (tid < 8) ((LAS unsigned*)(lds + LDS_BYTES - 32))[tid] = 0u;
        for (int i = gw * 64 + lane; i < 5 * T; i += ngw * 64) { const int a_ = 1 + i / T; rs_ptr(p, a_)[i % T] = 0ull; }
        xb_rows(p.x, HN, rs_ptr(p, 0), gw, ngw, lane);
    }
    grid.sync();
    xcd_post(wv);
    layer_body<0>(grid, lds, wv);
    layer_body<1>(grid, lds, wv);
}

extern "C" void kernel_launch(void* const* d_in, const int* in_sizes, int n_in, void* d_out, int out_size, void* d_ws, size_t ws_size, hipStream_t stream) {
    static int grid = 0;
    if (grid == 0) {
        if (n_in != 20 || out_size != T * D || ws_size < WS_END2) { fprintf(stderr, "kernel_launch: unexpected shapes (n_in %d out %d ws %zu)\n", n_in, out_size, ws_size); grid = -1; return; }
        int dev = 0, cus = 0, per_cu = 0;
        hipGetDevice(&dev); hipDeviceGetAttribute(&cus, hipDeviceAttributeMultiprocessorCount, dev);
        hipFuncSetAttribute((const void*)hybrid_fwd, hipFuncAttributeMaxDynamicSharedMemorySize, LDS_BYTES);
        hipOccupancyMaxActiveBlocksPerMultiprocessor(&per_cu, (const void*)hybrid_fwd, NTHR, LDS_BYTES);
        if (per_cu < 1) { fprintf(stderr, "kernel_launch: occupancy query says %d\n", per_cu); per_cu = 1; }
        (void)hipGetLastError();
        grid = cus * 1;
    }
    if (grid < 0) return;
    Params p{};
    p.x = (const float*)d_in[0]; p.pos = (const int*)d_in[1];
    p.ffn1_norm = (const float*)d_in[2]; p.ffn1_gu = (const float*)d_in[3]; p.ffn1_down = (const float*)d_in[4]; p.mix_norm = (const float*)d_in[5]; p.w_in = (const float*)d_in[6];
    p.diff_qk_norm = (const float*)d_in[7]; p.diff_lambda = (const float*)d_in[8]; p.diff_head_norm = (const float*)d_in[9]; p.ml_conv_w = (const float*)d_in[10]; p.ml_conv_b = (const float*)d_in[11];
    p.ml_gate_bias = (const float*)d_in[12]; p.ml_head_norm = (const float*)d_in[13]; p.dsa_qk_norm = (const float*)d_in[14]; p.w_branch = (const float*)d_in[15]; p.w_out = (const float*)d_in[16];
    p.ffn2_norm = (const float*)d_in[17]; p.ffn2_gu = (const float*)d_in[18]; p.ffn2_down = (const float*)d_in[19];
    p.out = (float*)d_out; p.ws = (unsigned char*)d_ws;
    void* args[] = {&p};
    hipError_t e = hipLaunchCooperativeKernel((const void*)hybrid_fwd, dim3(grid), dim3(NTHR), args, LDS_BYTES, stream);
    if (e != hipSuccess) fprintf(stderr, "cooperative launch failed: %s (grid %d)\n", hipGetErrorString(e), grid);
}
```

```cpp
#include <hip/hip_runtime.h>
#include <hip/hip_cooperative_groups.h>
#include <cstdio>
#include <cstdint>
namespace cg = cooperative_groups;
#ifndef PROBE_DUP
#define PROBE_DUP 0
#endif
namespace pg8 {
#define PG8_LAS __attribute__((address_space(3)))
typedef unsigned short bf16_t;
typedef short bf16x8 __attribute__((ext_vector_type(8)));
typedef float f32x4 __attribute__((ext_vector_type(4)));
typedef unsigned u32x4 __attribute__((ext_vector_type(4)));
constexpr int BM = 256, BK = 64, HALF = 128, HTB = HALF * BK * 2  , STAGE_BYTES = 8 * HTB, NXCD = 8, WGM = 8;

__host__ __device__ __forceinline__ int lds_byte(int r, int c) { const int st = (r >> 4) * 2 + (c >> 5), rr = r & 15, cc = c & 31, ob = rr * 64 + cc * 2; return st * 1024 + (ob ^ (((ob >> 9) & 1) << 5)); }
__host__ __device__ __forceinline__ void stage_rc(int b, int& R, int& C) { const int st = b / 1024, sb = b % 1024, swz = sb ^ (((sb >> 9) & 1) << 5); R = (st >> 1) * 16 + swz / 64; C = (st & 1) * 32 + (swz % 64) / 2; }
__host__ __device__ __forceinline__ int perm32(int rho) { const int n = rho >> 4, i = rho & 15; return 8 * (i >> 2) + 4 * n + (i & 3); }

struct Unit { int pm, pn; };
struct Gemm { const bf16_t* A; const bf16_t* Bt; int M, N, K; };

struct StaticOrder {
    int nM, nN, nwg, G, c;
    __host__ __device__ void init(int M, int N, int G_, int c_) { nM = M / BM; nN = N / BM; nwg = nM * nN; G = G_; c = c_; }
    __host__ __device__ bool next(int i, Unit& u) const {
        const long L = (long)i * G + c; if (L >= nwg) return false;
        int wgid = (int)L; { const int q = nwg / NXCD, r = nwg % NXCD, xcd = wgid % NXCD, off = wgid / NXCD; wgid = (xcd < r ? xcd * (q + 1) : r * (q + 1) + (xcd - r) * q) + off; }
        const int nig = WGM * nN, gid = wgid / nig, fm = gid * WGM, gsz = (nM - fm) < WGM ? (nM - fm) : WGM;
        u.pm = fm + ((wgid % nig) % gsz); u.pn = (wgid % nig) / gsz; return true;
    }
    __device__ __forceinline__ void a_ready(const Unit&) const {}
    __device__ __forceinline__ void done(const Unit&) const {}
};

__device__ __forceinline__ unsigned cvt_pk_bf16(float lo, float hi) { unsigned r; asm volatile("v_cvt_pk_bf16_f32 %0, %1, %2" : "=v"(r) : "v"(lo), "v"(hi)); return r; }
template <class Epi, class Sched, bool ALIGN_EPI = false, bool SP2 = false>
__device__ __forceinline__ void gemm_phase(PG8_LAS unsigned char* lds, const Gemm g, const Sched& S, const Epi& E, const int wave_in) {
    unsigned z_ = 0u; asm volatile("" : "+v"(z_)); int w_ = wave_in; asm volatile("" : "+s"(w_));
    const int tid_ = w_ * 64 + (int)__builtin_amdgcn_mbcnt_hi(~0u, __builtin_amdgcn_mbcnt_lo(~0u, z_));
    const int tid = tid_, wid = __builtin_amdgcn_readfirstlane(tid >> 6), lane = tid & 63, wr = wid >> 2, wc = wid & 3, fr = lane & 15, fq = lane >> 4;
    const int K = g.K, nt = K / BK;
    unsigned voffA[2], voffB[2];
#pragma unroll
    for (int i = 0; i < 2; ++i) { int R, C; stage_rc(tid * 16 + i * 8192, R, C); const int Rb = Epi::PERM ? ((R & ~31) + perm32(R & 31)) : R;
        voffA[i] = (unsigned)(R * K + C) * 2u; voffB[i] = (unsigned)(Rb * K + C) * 2u; }
    const size_t kstep = (size_t)(BK * 2);
    const size_t hstep = (size_t)HALF * K * 2;
    const size_t tstep = 2 * hstep;
    const unsigned ldsw = (unsigned)wid * 1024u;
    const int aoff = lds_byte(wr * 64 + fr, fq * 8), boff = lds_byte(wc * 32 + fr, fq * 8);
#define PG8_SA(b, h) (((b) * 2 + (h)) * HTB)
#define PG8_SB(b, h) ((4 + (b) * 2 + (h)) * HTB)
#define PG8_STAGE(bufoff, gbase, voff) do { _Pragma("unroll") for (int _i = 0; _i < 2; ++_i) \
        __builtin_amdgcn_global_load_lds((const unsigned*)((const char*)(gbase) + (voff)[_i]), (PG8_LAS unsigned*)(lds + (bufoff) + ldsw + _i * 8192), 16, 0, 0); } while (0)
#define PG8_LDA(dst, b, h) do { _Pragma("unroll") for (int m = 0; m < 4; ++m) _Pragma("unroll") for (int k = 0; k < 2; ++k) dst[m][k] = *(const PG8_LAS bf16x8*)(lds + PG8_SA(b, h) + aoff + m * 2048 + k * 1024); } while (0)
#define PG8_LDB(dst, b, h) do { _Pragma("unroll") for (int n = 0; n < 2; ++n) _Pragma("unroll") for (int k = 0; k < 2; ++k) dst[n][k] = *(const PG8_LAS bf16x8*)(lds + PG8_SB(b, h) + boff + n * 2048 + k * 1024); } while (0)
#define PG8_MMA(ai, bj, At, Bt) do { __builtin_amdgcn_s_setprio(1); _Pragma("unroll") for (int m = 0; m < 4; ++m) _Pragma("unroll") for (int n = 0; n < 2; ++n) _Pragma("unroll") for (int k = 0; k < 2; ++k) \
        acc[ai][bj][m][n] = __builtin_amdgcn_mfma_f32_16x16x32_bf16(Bt[n][k], At[m][k], acc[ai][bj][m][n], 0, 0, 0); __builtin_amdgcn_s_setprio(0); } while (0)
#define PG8_WAIT_V(n) asm volatile("s_waitcnt vmcnt(" #n ")" ::: "memory")
#define PG8_WAIT_L(n) asm volatile("s_waitcnt lgkmcnt(" #n ")" ::: "memory")
#define PG8_BAR __builtin_amdgcn_s_barrier()
#define PG8_SCHED __builtin_amdgcn_sched_barrier(0)
    Unit cur, nxt; int ui = 0;
    if (!S.next(0, cur)) return;
    f32x4 acc[2][2][4][2];
#pragma unroll
    for (int a = 0; a < 2; ++a)
#pragma unroll
        for (int b = 0; b < 2; ++b)
#pragma unroll
            for (int m = 0; m < 4; ++m)
#pragma unroll
                for (int n = 0; n < 2; ++n) acc[a][b][m][n] = (f32x4){0.f, 0.f, 0.f, 0.f};
    bf16x8 At[4][2], B0[2][2], B1[2][2];
    const char* cA = (const char*)g.A + (size_t)cur.pm * tstep; const char* cB = (const char*)g.Bt + (size_t)cur.pn * tstep;
    S.a_ready(cur);
    if constexpr (SP2) {
        PG8_STAGE(PG8_SB(0, 0), cB, voffB); PG8_STAGE(PG8_SB(0, 1), cB + hstep, voffB); PG8_STAGE(PG8_SA(0, 0), cA, voffA); PG8_STAGE(PG8_SA(0, 1), cA + hstep, voffA);
        if (wr == 1) PG8_BAR;
        PG8_WAIT_V(2); PG8_BAR;
        PG8_STAGE(PG8_SB(1, 0), cB + kstep, voffB); PG8_STAGE(PG8_SA(1, 0), cA + kstep, voffA); PG8_STAGE(PG8_SB(1, 1), cB + hstep + kstep, voffB);
        PG8_WAIT_V(6); PG8_BAR;
    } else {
        PG8_STAGE(PG8_SB(0, 0), cB, voffB); PG8_STAGE(PG8_SA(0, 0), cA, voffA); PG8_STAGE(PG8_SB(0, 1), cB + hstep, voffB); PG8_STAGE(PG8_SA(0, 1), cA + hstep, voffA);
        if (wr == 1) PG8_BAR;
        PG8_WAIT_V(4); PG8_BAR;
        PG8_STAGE(PG8_SB(1, 0), cB + kstep, voffB); PG8_STAGE(PG8_SA(1, 0), cA + kstep, voffA); PG8_STAGE(PG8_SB(1, 1), cB + hstep + kstep, voffB);
        PG8_WAIT_V(6); PG8_BAR;
    }
    for (;;) {
        const bool has_next = S.next(ui + 1, nxt);
        const char* nA = has_next ? (const char*)g.A + (size_t)nxt.pm * tstep : cA; const char* nB = has_next ? (const char*)g.Bt + (size_t)nxt.pn * tstep : cB;
        for (int t = 0; t < nt; t += 2) {
            const bool last = (t == nt - 2);
            const char* a1 = cA + (size_t)(t + 1) * kstep;
            const char* a2 = last ? nA : cA + (size_t)(t + 2) * kstep; const char* b2 = last ? nB : cB + (size_t)(t + 2) * kstep;
            const char* a3 = a2 + kstep; const char* b3 = b2 + kstep;
            if (last && has_next) S.a_ready(nxt);
            if constexpr (SP2) {
            PG8_LDB(B0, 0, 0); PG8_LDB(B1, 0, 1); PG8_SCHED; PG8_LDA(At, 0, 0); PG8_STAGE(PG8_SA(1, 1), a1 + hstep, voffA);
            PG8_WAIT_V(8); PG8_WAIT_L(0); PG8_BAR; PG8_MMA(0, 0, At, B0); PG8_MMA(0, 1, At, B1); PG8_BAR; PG8_SCHED;
            PG8_LDA(At, 0, 1); PG8_STAGE(PG8_SB(0, 0), b2, voffB); PG8_STAGE(PG8_SB(0, 1), b2 + hstep, voffB); PG8_STAGE(PG8_SA(0, 0), a2, voffA);
            PG8_WAIT_V(8); PG8_WAIT_L(0); PG8_BAR; PG8_MMA(1, 0, At, B0); PG8_MMA(1, 1, At, B1); PG8_BAR; PG8_SCHED;
            PG8_LDB(B0, 1, 0); PG8_LDB(B1, 1, 1); PG8_SCHED; PG8_LDA(At, 1, 0); PG8_STAGE(PG8_SA(0, 1), a2 + hstep, voffA);
            PG8_WAIT_V(8); PG8_WAIT_L(0); PG8_BAR; PG8_MMA(0, 0, At, B0); PG8_MMA(0, 1, At, B1); PG8_BAR; PG8_SCHED;
            PG8_LDA(At, 1, 1); PG8_STAGE(PG8_SB(1, 0), b3, voffB); PG8_STAGE(PG8_SB(1, 1), b3 + hstep, voffB); PG8_STAGE(PG8_SA(1, 0), a3, voffA);
            PG8_WAIT_V(8); PG8_WAIT_L(0); PG8_BAR; PG8_MMA(1, 0, At, B0); PG8_MMA(1, 1, At, B1); PG8_BAR; PG8_SCHED;
            } else {
            PG8_LDB(B0, 0, 0); PG8_SCHED; PG8_LDA(At, 0, 0); PG8_STAGE(PG8_SA(1, 1), a1 + hstep, voffA);
            PG8_WAIT_L(8); PG8_BAR; PG8_WAIT_L(0); PG8_MMA(0, 0, At, B0); PG8_BAR; PG8_SCHED;
            PG8_LDB(B1, 0, 1); PG8_STAGE(PG8_SB(0, 0), b2, voffB);
            PG8_BAR; PG8_WAIT_L(0); PG8_MMA(0, 1, At, B1); PG8_BAR;
            PG8_LDA(At, 0, 1); PG8_STAGE(PG8_SA(0, 0), a2, voffA);
            PG8_BAR; PG8_WAIT_L(0); PG8_MMA(1, 0, At, B0); PG8_BAR; PG8_SCHED;
            PG8_STAGE(PG8_SB(0, 1), b2 + hstep, voffB);
            PG8_WAIT_V(6); PG8_BAR; PG8_MMA(1, 1, At, B1); PG8_BAR;
            PG8_LDB(B0, 1, 0); PG8_SCHED; PG8_LDA(At, 1, 0); PG8_STAGE(PG8_SA(0, 1), a2 + hstep, voffA);
            PG8_WAIT_L(8); PG8_BAR; PG8_WAIT_L(0); PG8_MMA(0, 0, At, B0); PG8_BAR; PG8_SCHED;
            PG8_LDB(B1, 1, 1); PG8_STAGE(PG8_SB(1, 0), b3, voffB);
            PG8_BAR; PG8_WAIT_L(0); PG8_MMA(0, 1, At, B1); PG8_BAR;
            PG8_LDA(At, 1, 1); PG8_STAGE(PG8_SA(1, 0), a3, voffA);
            PG8_BAR; PG8_WAIT_L(0); PG8_MMA(1, 0, At, B0); PG8_BAR; PG8_SCHED;
            PG8_STAGE(PG8_SB(1, 1), b3 + hstep, voffB);
            PG8_WAIT_V(6); PG8_BAR; PG8_MMA(1, 1, At, B1); PG8_BAR;
            }
        }
        if constexpr (ALIGN_EPI) { if (wr == 0) PG8_BAR; }
        if constexpr (!Epi::AFTER_DRAIN) { E(acc, cur, wr, wc, fr, fq); S.done(cur); }
        if (!has_next) break;
#pragma unroll
        for (int a = 0; a < 2; ++a)
#pragma unroll
            for (int b = 0; b < 2; ++b)
#pragma unroll
                for (int m = 0; m < 4; ++m)
#pragma unroll
                    for (int n = 0; n < 2; ++n) acc[a][b][m][n] = (f32x4){0.f, 0.f, 0.f, 0.f};
        cur = nxt; cA = nA; cB = nB; ++ui;
        if constexpr (ALIGN_EPI) { if (wr == 1) PG8_BAR; }
    }
    PG8_WAIT_V(0);
    if constexpr (!ALIGN_EPI) { if (wr == 0) PG8_BAR; }
    PG8_BAR;
    if constexpr (Epi::AFTER_DRAIN) { E.fused(acc, cur, wr, wc, fr, fq, lds, wid, lane); S.done(cur); }
#undef PG8_SA
#undef PG8_SB
#undef PG8_STAGE
#undef PG8_LDA
#undef PG8_LDB
#undef PG8_MMA
#undef PG8_WAIT_V
#undef PG8_WAIT_L
#undef PG8_BAR
#undef PG8_SCHED
}
}
#define LAS __attribute__((address_space(3)))
typedef unsigned short bf16;
typedef float f32x4 __attribute__((ext_vector_type(4)));
typedef float f32x16 __attribute__((ext_vector_type(16)));
typedef unsigned u32x4 __attribute__((ext_vector_type(4)));
typedef unsigned u32x2 __attribute__((ext_vector_type(2)));
typedef short s16x8 __attribute__((ext_vector_type(8)));

constexpr int NB = 8, SEQ = 4096, T = NB * SEQ, D = 1024, FF = 2816, DEPTH = 2, NIN = 7344, ZP = 3072, ZSP = 256;
constexpr int NTHR = 512, NWAVES = 8;
constexpr int LDS_BYTES = 147456;
constexpr float EPS = 1e-6f;

constexpr size_t MiB = (size_t)1 << 20;
constexpr size_t WS_CTL = 0;
constexpr size_t WS_W = 1 * MiB, WL_STRIDE = 52 * MiB;
constexpr size_t WL_GU1 = 0, WL_D1 = 11534336, WL_INA = 17301504, WL_G = 24117248, WL_BR = 32505856, WL_OUT = 34603008, WL_GU2 = 36700160, WL_D2 = 48234496;
constexpr size_t WS_HN = 106 * MiB, WS_BIG = 170 * MiB, WS_ZS = 362 * MiB, WS_O = 394 * MiB, WS_IK = 458 * MiB, WS_END = 460 * MiB;
constexpr size_t OB_STRIDE = (size_t)T * 256 * 2;

struct Params {
    const float* x; const int* pos;
    const float *ffn1_norm, *ffn1_gu, *ffn1_down, *mix_norm, *w_in, *diff_qk_norm, *diff_lambda, *diff_head_norm, *ml_conv_w, *ml_conv_b, *ml_gate_bias, *ml_head_norm,
        *dsa_qk_norm, *w_branch, *w_out, *ffn2_norm, *ffn2_gu, *ffn2_down;
    float* out; unsigned char* ws;
};

__device__ __forceinline__ unsigned f2bf(float f) { unsigned u = __float_as_uint(f); return (u + 0x7fffu + ((u >> 16) & 1u)) >> 16; }
__device__ __forceinline__ unsigned pk2(float lo, float hi) { unsigned r; asm("v_cvt_pk_bf16_f32 %0, %1, %2" : "=v"(r) : "v"(lo), "v"(hi)); return r; }
__device__ __forceinline__ float bflo(unsigned w) { return __uint_as_float(w << 16); }
__device__ __forceinline__ float bfhi(unsigned w) { return __uint_as_float(w & 0xffff0000u); }
__device__ __forceinline__ float wave_sum(float v) {
#pragma unroll
    for (int o = 1; o < 64; o <<= 1) v += __shfl_xor(v, o);
    return v;
}
__device__ __forceinline__ float wave_max(float v) {
#pragma unroll
    for (int o = 1; o < 64; o <<= 1) v = fmaxf(v, __shfl_xor(v, o));
    return v;
}
__device__ __forceinline__ int lane_fresh() { unsigned z = 0u; asm volatile("" : "+v"(z)); return (int)__builtin_amdgcn_mbcnt_hi(~0u, __builtin_amdgcn_mbcnt_lo(~0u, z)); }
__device__ __forceinline__ int tid_fresh(int wv) { int w = wv; asm volatile("" : "+s"(w)); return w * 64 + lane_fresh(); }
#define LDS_WAIT() asm volatile("s_waitcnt lgkmcnt(0)" ::: "memory")
__device__ __forceinline__ float sigmoidf_(float x) { return 1.f / (1.f + __expf(-x)); }

__device__ __forceinline__ Params load_params() {
#if defined(__HIP_DEVICE_COMPILE__)
    const __attribute__((address_space(4))) Params* pp = (const __attribute__((address_space(4))) Params*)__builtin_amdgcn_kernarg_segment_ptr();
    asm volatile("" : "+s"(pp));
    Params r;
    r.x = pp->x; r.pos = pp->pos; r.ffn1_norm = pp->ffn1_norm; r.ffn1_gu = pp->ffn1_gu; r.ffn1_down = pp->ffn1_down; r.mix_norm = pp->mix_norm; r.w_in = pp->w_in; r.diff_qk_norm = pp->diff_qk_norm;
    r.diff_lambda = pp->diff_lambda; r.diff_head_norm = pp->diff_head_norm; r.ml_conv_w = pp->ml_conv_w; r.ml_conv_b = pp->ml_conv_b; r.ml_gate_bias = pp->ml_gate_bias; r.ml_head_norm = pp->ml_head_norm;
    r.dsa_qk_norm = pp->dsa_qk_norm; r.w_branch = pp->w_branch; r.w_out = pp->w_out; r.ffn2_norm = pp->ffn2_norm; r.ffn2_gu = pp->ffn2_gu; r.ffn2_down = pp->ffn2_down; r.out = pp->out; r.ws = pp->ws;
    return r;
#else
    return Params{};
#endif
}
typedef unsigned long long u64_t;
__device__ __forceinline__ u64_t* rs_ptr(const Params& p, int idx) { return (u64_t*)(p.ws + (idx < 3 ? (WS_CTL + 131072) : (105 * MiB))) + (size_t)(idx % 3) * T; }
__device__ __forceinline__ float row_rstd(const u64_t* rs, int row) { return 1.f / sqrtf((float)rs[row] * (1.f / (16777216.f * D)) + EPS); }
struct EpiSwiglu {
    static constexpr bool PERM = true, AFTER_DRAIN = false;
    int rsi;
    __device__ __forceinline__ void operator()(const f32x4 (&acc)[2][2][4][2], const pg8::Unit& u, int wr, int wc, int fr_in, int fq_in) const {
        const int ln_ = lane_fresh(); const int fr = ln_ & 15, fq = ln_ >> 4; (void)fr_in; (void)fq_in;
        const Params p = load_params(); bf16* O = (bf16*)(p.ws + WS_BIG); const u64_t* rs = rs_ptr(p, rsi);
        const int row0 = u.pm * 256 + wr * 64 + fr, col0 = u.pn * 128 + wc * 32 + 8 * fq;
#pragma unroll
        for (int ai = 0; ai < 2; ++ai)
#pragma unroll
            for (int m = 0; m < 4; ++m) {
                const int row = row0 + ai * 128 + m * 16; const float rr = row_rstd(rs, row);
                bf16* rowp = O + (size_t)row * FF + col0;
                float r[8];
#pragma unroll
                for (int n = 0; n < 2; ++n)
#pragma unroll
                    for (int j = 0; j < 4; ++j) { const float g = acc[ai][0][m][n][j] * rr, uu = acc[ai][1][m][n][j] * rr; r[4 * n + j] = g * sigmoidf_(g) * uu; }
                u32x4 w; w.x = pk2(r[0], r[1]); w.y = pk2(r[2], r[3]); w.z = pk2(r[4], r[5]); w.w = pk2(r[6], r[7]);
                *(u32x4*)rowp = w;
            }
    }
};
struct EpiResid {
    static constexpr bool PERM = true, AFTER_DRAIN = false;
    int base_is_x; float scale; int rsi;
    __device__ __forceinline__ void operator()(const f32x4 (&acc)[2][2][4][2], const pg8::Unit& u, int wr, int wc, int fr_in, int fq_in) const {
        const int ln_ = lane_fresh(); const int fr = ln_ & 15, fq = ln_ >> 4; (void)fr_in; (void)fq_in;
        const Params p = load_params(); const float* base = base_is_x ? p.x : p.out; float* out = p.out; bf16* XB = (rsi >= 0) ? (bf16*)(p.ws + WS_HN) : (bf16*)nullptr; u64_t* rs = rs_ptr(p, rsi >= 0 ? rsi : 0);
        const int row0 = u.pm * 256 + wr * 64 + fr, col0 = u.pn * 256 + wc * 32 + 8 * fq;
#pragma unroll
        for (int ai = 0; ai < 2; ++ai)
#pragma unroll
            for (int m = 0; m < 4; ++m) {
                const int row = row0 + ai * 128 + m * 16; const size_t ro = (size_t)row * D + col0; float ss = 0.f;
#pragma unroll
                for (int bj = 0; bj < 2; ++bj) {
                    const f32x4 v0 = *(const f32x4*)(base + ro + bj * 128) + acc[ai][bj][m][0] * scale, v1 = *(const f32x4*)(base + ro + bj * 128 + 4) + acc[ai][bj][m][1] * scale;
                    *(f32x4*)(out + ro + bj * 128) = v0; *(f32x4*)(out + ro + bj * 128 + 4) = v1;
                    if (XB) { u32x4 w; w.x = pk2(v0[0], v0[1]); w.y = pk2(v0[2], v0[3]); w.z = pk2(v1[0], v1[1]); w.w = pk2(v1[2], v1[3]); *(u32x4*)(XB + ro + bj * 128) = w;
                        ss += (v0[0] * v0[0] + v0[1] * v0[1]) + (v0[2] * v0[2] + v0[3] * v0[3]) + (v1[0] * v1[0] + v1[1] * v1[1]) + (v1[2] * v1[2] + v1[3] * v1[3]); }
                }
                if (XB) { ss += __shfl_xor(ss, 16); ss += __shfl_xor(ss, 32); if (fq == 0) atomicAdd(rs + row, (u64_t)(ss * 16777216.f)); }
            }
    }
};
struct EpiZ {
    static constexpr bool PERM = true, AFTER_DRAIN = false;
    int rsi;
    __device__ __forceinline__ void operator()(const f32x4 (&acc)[2][2][4][2], const pg8::Unit& u, int wr, int wc, int fr_in, int fq_in) const {
        const int ln_ = lane_fresh(); const int fr = ln_ & 15, fq = ln_ >> 4; (void)fr_in; (void)fq_in;
        const Params p = load_params(); bf16* Z = (bf16*)(p.ws + WS_BIG); float* ZS = (float*)(p.ws + WS_ZS); const u64_t* rs = rs_ptr(p, rsi);
        const int row0 = u.pm * 256 + wr * 64 + fr, cw = wc * 32 + 8 * fq;
        if (u.pn < 12) {
#pragma unroll
            for (int ai = 0; ai < 2; ++ai)
#pragma unroll
                for (int m = 0; m < 4; ++m) {
                    const int row = row0 + ai * 128 + m * 16; const float rr = row_rstd(rs, row);
                    bf16* rowp = Z + (size_t)row * ZP + u.pn * 256 + cw;
#pragma unroll
                    for (int bj = 0; bj < 2; ++bj) { const f32x4 v0 = acc[ai][bj][m][0] * rr, v1 = acc[ai][bj][m][1] * rr;
                        u32x4 w; w.x = pk2(v0[0], v0[1]); w.y = pk2(v0[2], v0[3]); w.z = pk2(v1[0], v1[1]); w.w = pk2(v1[2], v1[3]);
                        *(u32x4*)(rowp + bj * 128) = w; }
                }
        } else {
#pragma unroll
            for (int ai = 0; ai < 2; ++ai)
#pragma unroll
                for (int m = 0; m < 4; ++m) {
                    const int row = row0 + ai * 128 + m * 16; const float rr = row_rstd(rs, row);
                    float* rowp = ZS + (size_t)row * ZSP + cw;
#pragma unroll
                    for (int bj = 0; bj < 2; ++bj)
#pragma unroll
                        for (int n = 0; n < 2; ++n) *(f32x4*)(rowp + bj * 128 + 4 * n) = acc[ai][bj][m][n] * rr;
                }
        }
    }
};
struct EpiSig {
    static constexpr bool PERM = true, AFTER_DRAIN = false;
    int rsi;
    __device__ __forceinline__ void operator()(const f32x4 (&acc)[2][2][4][2], const pg8::Unit& u, int wr, int wc, int fr_in, int fq_in) const {
        const int ln_ = lane_fresh(); const int fr = ln_ & 15, fq = ln_ >> 4; (void)fr_in; (void)fq_in;
        const Params p = load_params(); bf16* SG = (bf16*)(p.ws + WS_BIG); const u64_t* rs = rs_ptr(p, rsi);
        const int row0 = u.pm * 256 + wr * 64 + fr, col0 = u.pn * 256 + wc * 32 + 8 * fq;
#pragma unroll
        for (int ai = 0; ai < 2; ++ai)
#pragma unroll
            for (int m = 0; m < 4; ++m) {
                const int row = row0 + ai * 128 + m * 16; const float rr = row_rstd(rs, row);
                bf16* rowp = SG + (size_t)row * (2 * D) + col0;
#pragma unroll
                for (int bj = 0; bj < 2; ++bj) { const f32x4 v0 = acc[ai][bj][m][0] * rr, v1 = acc[ai][bj][m][1] * rr;
                    u32x4 w; w.x = pk2(sigmoidf_(v0[0]), sigmoidf_(v0[1])); w.y = pk2(sigmoidf_(v0[2]), sigmoidf_(v0[3]));
                    w.z = pk2(sigmoidf_(v1[0]), sigmoidf_(v1[1])); w.w = pk2(sigmoidf_(v1[2]), sigmoidf_(v1[3]));
                    *(u32x4*)(rowp + bj * 128) = w; }
            }
    }
};
struct EpiGate {
    static constexpr bool PERM = true, AFTER_DRAIN = false;
    int sgoff; int first;
    __device__ __forceinline__ void operator()(const f32x4 (&acc)[2][2][4][2], const pg8::Unit& u, int wr, int wc, int fr_in, int fq_in) const {
        const int ln_ = lane_fresh(); const int fr = ln_ & 15, fq = ln_ >> 4; (void)fr_in; (void)fq_in;
        const Params p = load_params(); const bf16* SG = (const bf16*)(p.ws + WS_BIG); bf16* YB = (bf16*)(p.ws + WS_BIG + 128 * MiB);
        const int row0 = u.pm * 256 + wr * 64 + fr, col0 = u.pn * 256 + wc * 32 + 8 * fq;
#pragma unroll
        for (int ai = 0; ai < 2; ++ai)
#pragma unroll
            for (int m = 0; m < 4; ++m) {
                const int row = row0 + ai * 128 + m * 16; const size_t ro = (size_t)row * D + col0, so = (size_t)row * (2 * D) + sgoff + col0;
#pragma unroll
                for (int bj = 0; bj < 2; ++bj) {
                    const u32x4 sg = *(const u32x4*)(SG + so + bj * 128);
                    f32x4 v0 = (f32x4){bflo(sg.x), bfhi(sg.x), bflo(sg.y), bfhi(sg.y)} * acc[ai][bj][m][0], v1 = (f32x4){bflo(sg.z), bfhi(sg.z), bflo(sg.w), bfhi(sg.w)} * acc[ai][bj][m][1];
                    if (!first) { const u32x4 y = *(const u32x4*)(YB + ro + bj * 128);
                        v0 = v0 + (f32x4){bflo(y.x), bfhi(y.x), bflo(y.y), bfhi(y.y)}; v1 = v1 + (f32x4){bflo(y.z), bfhi(y.z), bflo(y.w), bfhi(y.w)}; }
                    u32x4 w; w.x = pk2(v0[0], v0[1]); w.y = pk2(v0[2], v0[3]); w.z = pk2(v1[0], v1[1]); w.w = pk2(v1[2], v1[3]); *(u32x4*)(YB + ro + bj * 128) = w;
                }
            }
    }
};

template <class Epi>
__device__ __forceinline__ void run_gemm(LAS unsigned char* lds, const bf16* A, const bf16* Bt, int M, int N, int K, const Epi& E, int wv) {
    pg8::Gemm g{A, Bt, M, N, K}; pg8::StaticOrder S; S.init(M, N, (int)gridDim.x, (int)blockIdx.x);
    pg8::gemm_phase<Epi, pg8::StaticOrder, true, true>((PG8_LAS unsigned char*)lds, g, S, E, wv);
}

__device__ __forceinline__ void tr_item(const float* W, int K, int srcN, int c0, int nv, bf16* WT, int r0, int k0, LAS float* scr, int lane, const float* gain) {
    const int c = lane & 31;
#pragma unroll 8
    for (int i = 0; i < 32; ++i) { const int kk = 2 * i + (lane >> 5); scr[kk * 33 + c] = (c < nv) ? W[(size_t)(k0 + kk) * srcN + c0 + c] * (gain ? gain[k0 + kk] : 1.f) : 0.f; }
    LDS_WAIT();
    const int c8 = lane & 7;
#pragma unroll
    for (int j = 0; j < 4; ++j) { const int n = (lane >> 3) + 8 * j; const LAS float* s = scr + (8 * c8) * 33 + n;
        u32x4 o; o.x = pk2(s[0 * 33], s[1 * 33]); o.y = pk2(s[2 * 33], s[3 * 33]); o.z = pk2(s[4 * 33], s[5 * 33]); o.w = pk2(s[6 * 33], s[7 * 33]);
        if (n < nv) *(u32x4*)(WT + (size_t)(r0 + n) * K + k0 + 8 * c8) = o; }
    LDS_WAIT();
}
struct SegRun { int base, gw, ngw, lane; LAS float* scr; };
__device__ __forceinline__ void run_seg(SegRun& R, const float* W, int K, int srcN, int c0, int ncols, bf16* WT, int r0, const float* gain = nullptr) {
    const int nblk = (ncols + 31) >> 5, nitems = (K >> 6) * nblk;
    int first = (R.gw - (R.base % R.ngw) + R.ngw) % R.ngw;
    for (int it = first; it < nitems; it += R.ngw) { const int kb = it / nblk, nb = it - kb * nblk; const int nv = min(32, ncols - nb * 32);
        tr_item(W, K, srcN, c0 + nb * 32, nv, WT, r0 + nb * 32, kb * 64, R.scr, R.lane, gain); }
    R.base += nitems;
}
__device__ __forceinline__ void convert_weights(const Params& p, int l, SegRun& R) {
    unsigned char* wl = p.ws + WS_W + (size_t)l * WL_STRIDE;
    for (int f = 0; f < 2; ++f) {
        const float* gu = (f ? p.ffn2_gu : p.ffn1_gu) + (size_t)l * D * 2 * FF; bf16* gut = (bf16*)(wl + (f ? WL_GU2 : WL_GU1));
        const float* gn = (f ? p.ffn2_norm : p.ffn1_norm) + l * D;
        for (int sg = 0; sg < 44; ++sg) run_seg(R, gu, D, 2 * FF, sg * 128, 128, gut, (sg % 22) * 256 + (sg / 22) * 128, gn);
        const float* dn = (f ? p.ffn2_down : p.ffn1_down) + (size_t)l * FF * D; bf16* dnt = (bf16*)(wl + (f ? WL_D2 : WL_D1));
        run_seg(R, dn, FF, D, 0, D, dnt, 0);
    }
    const float* wi = p.w_in + (size_t)l * D * NIN; bf16* ina = (bf16*)(wl + WL_INA);
    run_seg(R, wi, D, NIN, 0, 768, ina, 0, p.mix_norm + l * D);
    run_seg(R, wi, D, NIN, 768, 512, ina, 768, p.mix_norm + l * D);
    run_seg(R, wi, D, NIN, 1280, 256, ina, 1280, p.mix_norm + l * D);
    run_seg(R, wi, D, NIN, 1544, 256, ina, 1536, p.mix_norm + l * D);
    run_seg(R, wi, D, NIN, 1800, 768, ina, 1792, p.mix_norm + l * D);
    run_seg(R, wi, D, NIN, 2568, 256, ina, 2560, p.mix_norm + l * D);
    run_seg(R, wi, D, NIN, 2952, 256, ina, 2816, p.mix_norm + l * D);
    run_seg(R, wi, D, NIN, 2824, 128, ina, 3072, p.mix_norm + l * D);
    run_seg(R, wi, D, NIN, 3208, 40, ina, 3200, p.mix_norm + l * D);
    run_seg(R, wi, D, NIN, 1536, 8, ina, 3240, p.mix_norm + l * D);
    run_seg(R, wi, D, NIN, 3248, 4096, (bf16*)(wl + WL_G), 0, p.mix_norm + l * D);
    for (int b = 0; b < 4; ++b) run_seg(R, p.w_branch + ((size_t)l * 4 + b) * 256 * D, 256, D, 0, D, (bf16*)(wl + WL_BR) + (size_t)b * D * 256, 0);
    run_seg(R, p.w_out + (size_t)l * D * D, D, D, 0, D, (bf16*)(wl + WL_OUT), 0);
    for (int i = R.gw * 64 + R.lane; i < 80 * 128; i += R.ngw * 64) *((u32x4*)(ina + (size_t)3248 * D) + i) = (u32x4){0u, 0u, 0u, 0u};
}

__device__ __forceinline__ void xb_rows(const float* X, bf16* XB, u64_t* rs, int gw, int ngw, int lane) {
    for (int m = gw; m < T; m += ngw) {
        const f32x4* xr = (const f32x4*)(X + (size_t)m * D) + lane;
        f32x4 v[4]; float s = 0.f;
#pragma unroll
        for (int j = 0; j < 4; ++j) { v[j] = xr[64 * j]; s += (v[j].x * v[j].x + v[j].y * v[j].y) + (v[j].z * v[j].z + v[j].w * v[j].w); }
        s = wave_sum(s);
        unsigned long long* o8 = (unsigned long long*)(XB + (size_t)m * D) + lane;
#pragma unroll
        for (int j = 0; j < 4; ++j) o8[64 * j] = (unsigned long long)pk2(v[j].x, v[j].y) | ((unsigned long long)pk2(v[j].z, v[j].w) << 32);
        if (lane == 0) rs[m] = (u64_t)(s * 16777216.f);
    }
}

__device__ __forceinline__ void sincos_red(float ang, float& sn, float& cs) {
    const float n = rintf(ang * 0.15915494309189535f);
    float r = fmaf(-n, 6.28125f, ang); r = fmaf(-n, 0.0019353071795864769f, r);
    sn = __sinf(r); cs = __cosf(r);
}
template <int HALF>
__device__ __forceinline__ void rope4(float (&v)[4], int sl, float pos) {
    constexpr int LH = HALF / 4;
    float pv[4];
#pragma unroll
    for (int j = 0; j < 4; ++j) pv[j] = __shfl_xor(v[j], LH);
    if (sl < 2 * LH) {
        const bool first = sl < LH; const int i0 = (sl & (LH - 1)) * 4;
#pragma unroll
        for (int j = 0; j < 4; ++j) {
            constexpr float I4[4] = {1.0f, 0.03760603070259094f, 0.0014142135623842478f, 5.318296098266728e-05f};
            constexpr float I8[8] = {1.0f, 0.1939227432012558f, 0.03760603070259094f, 0.007292664609849453f, 0.0014142135623842478f, 0.00027424818836152554f, 5.318296098266728e-05f, 1.0313386155758053e-05f};
            const float inv = (HALF == 4) ? I4[j] : (i0 ? I8[4 + j] : I8[j]);
            float sn, cs; sincos_red(pos * inv, sn, cs);
            v[j] = first ? (v[j] * cs - pv[j] * sn) : (pv[j] * sn + v[j] * cs);
        }
    }
}
__device__ __forceinline__ void prep_phase(const Params& p, int l, int gw, int ngw, int lane) {
    bf16* Z = (bf16*)(p.ws + WS_BIG); float* ZS = (float*)(p.ws + WS_ZS); bf16* IK = (bf16*)(p.ws + WS_IK);
    const float* dg = p.diff_qk_norm + l * 64; const float* sg = p.dsa_qk_norm + l * 128;
    for (int tok = gw; tok < T; tok += ngw) {
        const float pos = (float)p.pos[tok];
#pragma unroll
        for (int which = 0; which < 2; ++which) {
            unsigned long long* ptr = (unsigned long long*)(Z + (size_t)tok * ZP + which * 256) + lane;
            const unsigned long long w = *ptr; float v[4] = {bflo((unsigned)w), bfhi((unsigned)w), bflo((unsigned)(w >> 32)), bfhi((unsigned)(w >> 32))};
            float ss = (v[0] * v[0] + v[1] * v[1]) + (v[2] * v[2] + v[3] * v[3]);
            ss += __shfl_xor(ss, 1); ss += __shfl_xor(ss, 2); ss += __shfl_xor(ss, 4);
            const float r = 1.f / sqrtf(ss * (1.f / 32.f) + EPS);
            const f32x4 g = *(const f32x4*)(dg + which * 32 + (lane & 7) * 4);
#pragma unroll
            for (int j = 0; j < 4; ++j) v[j] = v[j] * r * g[j];
            rope4<4>(v, lane & 7, pos);
            if (which == 0) {
#pragma unroll
                for (int j = 0; j < 4; ++j) v[j] *= 0.17677669529663687f;
            }
            *ptr = (unsigned long long)pk2(v[0], v[1]) | ((unsigned long long)pk2(v[2], v[3]) << 32);
        }
        {
            unsigned long long* ptr = (unsigned long long*)(Z + (size_t)tok * ZP + 2560) + lane;
            const unsigned long long w = *ptr; float v[4] = {bflo((unsigned)w), bfhi((unsigned)w), bflo((unsigned)(w >> 32)), bfhi((unsigned)(w >> 32))};
            float ss = (v[0] * v[0] + v[1] * v[1]) + (v[2] * v[2] + v[3] * v[3]);
            ss += __shfl_xor(ss, 1); ss += __shfl_xor(ss, 2); ss += __shfl_xor(ss, 4); ss += __shfl_xor(ss, 8);
            const float r = 1.f / sqrtf(ss * (1.f / 64.f) + EPS);
            const f32x4 g = *(const f32x4*)(sg + (lane & 15) * 4);
#pragma unroll
            for (int j = 0; j < 4; ++j) v[j] = v[j] * r * g[j];
            rope4<8>(v, lane & 15, pos);
#pragma unroll
            for (int j = 0; j < 4; ++j) v[j] *= 0.125f;
            *ptr = (unsigned long long)pk2(v[0], v[1]) | ((unsigned long long)pk2(v[2], v[3]) << 32);
        }
        {
            unsigned long long* ptr = (unsigned long long*)(Z + (size_t)tok * ZP + 2816) + lane;
            const unsigned long long w = *ptr; float v[4] = {bflo((unsigned)w), bfhi((unsigned)w), bflo((unsigned)(w >> 32)), bfhi((unsigned)(w >> 32))};
            rope4<4>(v, lane & 7, pos);
            *ptr = (unsigned long long)pk2(v[0], v[1]) | ((unsigned long long)pk2(v[2], v[3]) << 32);
        }
        {
            float* ptr = ZS + (size_t)tok * ZSP + (lane & 15) * 4;
            const f32x4 x = *(const f32x4*)ptr; float v[4] = {x[0], x[1], x[2], x[3]};
            float ss = (v[0] * v[0] + v[1] * v[1]) + (v[2] * v[2] + v[3] * v[3]);
            ss += __shfl_xor(ss, 1); ss += __shfl_xor(ss, 2); ss += __shfl_xor(ss, 4); ss += __shfl_xor(ss, 8);
            const float r = 1.f / sqrtf(ss * (1.f / 64.f) + EPS);
            const f32x4 g = *(const f32x4*)(sg + 64 + (lane & 15) * 4);
#pragma unroll
            for (int j = 0; j < 4; ++j) v[j] = v[j] * r * g[j];
            rope4<8>(v, lane & 15, pos);
            if (lane < 16) *(f32x4*)ptr = (f32x4){v[0], v[1], v[2], v[3]};
        }
        {
            const float* ptr = ZS + (size_t)tok * ZSP + 128 + (lane & 7) * 4;
            const f32x4 x = *(const f32x4*)ptr; float v[4] = {x[0], x[1], x[2], x[3]};
            rope4<4>(v, lane & 7, pos);
            if (lane < 8) *((unsigned long long*)(IK + (size_t)tok * 32) + lane) = (unsigned long long)pk2(v[0], v[1]) | ((unsigned long long)pk2(v[2], v[3]) << 32);
        }
    }
}
__device__ __forceinline__ void mlstm_item(const Params& p, int l, int bh, LAS unsigned char* lds, int wv) {
    const int tid = tid_fresh(wv), lane = tid & 63, b = bh >> 2, h = bh & 3;
    const bf16* Z = (const bf16*)(p.ws + WS_BIG); const float* ZS = (const float*)(p.ws + WS_ZS); bf16* O1 = (bf16*)(p.ws + WS_O + OB_STRIDE);
    LAS float* nv = (LAS float*)lds; LAS float* bc = nv + 64; LAS float* igs = bc + 64; LAS float* wks = igs + 64; LAS float* sc = wks + 64;
    LAS float* Qs = sc + 64; LAS float* Ks = Qs + 64 * 65; LAS float* Vs = Ks + 64 * 65; LAS float* Ss = Vs + 64 * 65; LAS float* Cs = Ss + 64 * 65;
    for (int i = tid; i < 64 * 65; i += NTHR) Cs[i] = 0.f;
    if (tid < 64) nv[tid] = 0.f;
    float mcar = 0.f;
    const int r = tid >> 3, sg = tid & 7;
    const int cc0 = sg * 16; const int ch0 = (cc0 < 64) ? (h * 64 + cc0) : (256 + h * 64 + cc0 - 64);
    const float* cw0 = p.ml_conv_w + (size_t)l * 4 * 512; const float* cb0 = p.ml_conv_b + (size_t)l * 512;
    const int zc0 = (cc0 < 64) ? (768 + h * 64 + cc0) : (1024 + h * 64 + cc0 - 64);
    const float gb_i = p.ml_gate_bias[(l * 2 + 0) * 4 + h], gb_f = p.ml_gate_bias[(l * 2 + 1) * 4 + h];
    const float qsc = (cc0 < 64) ? 0.125f : 1.0f;
    __syncthreads();
    for (int c = 0; c < 64; ++c) {
        const int t0 = c * 64; const size_t tok0 = (size_t)b * SEQ + t0;
        const float* cw = cw0; const float* cb = cb0; asm volatile("" : "+s"(cw), "+s"(cb));
        {
            float y[16];
#pragma unroll
            for (int i = 0; i < 16; ++i) y[i] = cb[ch0 + i];
#pragma unroll
            for (int j = 0; j < 4; ++j) {
                const int tt = t0 + r - 3 + j;
                if (tt >= 0) {
                    const u32x4* xp = (const u32x4*)(Z + ((size_t)b * SEQ + tt) * ZP + zc0); const u32x4 x0 = xp[0], x1 = xp[1];
                    const float xv[16] = {bflo(x0.x), bfhi(x0.x), bflo(x0.y), bfhi(x0.y), bflo(x0.z), bfhi(x0.z), bflo(x0.w), bfhi(x0.w),
                                          bflo(x1.x), bfhi(x1.x), bflo(x1.y), bfhi(x1.y), bflo(x1.z), bfhi(x1.z), bflo(x1.w), bfhi(x1.w)};
#pragma unroll
                    for (int i = 0; i < 16; ++i) y[i] = fmaf(cw[j * 512 + ch0 + i], xv[i], y[i]);
                }
            }
            LAS float* dst = (cc0 < 64) ? (Qs + r * 65 + cc0) : (Ks + r * 65 + cc0 - 64);
#pragma unroll
            for (int i = 0; i < 16; ++i) dst[i] = y[i] * sigmoidf_(y[i]) * qsc;
            const u32x4 vv = *(const u32x4*)(Z + (tok0 + r) * ZP + 1280 + h * 64 + sg * 8);
            LAS float* vd = Vs + r * 65 + sg * 8;
            vd[0] = bflo(vv.x); vd[1] = bfhi(vv.x); vd[2] = bflo(vv.y); vd[3] = bfhi(vv.y); vd[4] = bflo(vv.z); vd[5] = bfhi(vv.z); vd[6] = bflo(vv.w); vd[7] = bfhi(vv.w);
        }
        if (tid < 64) {
            const float ig = ZS[(tok0 + tid) * ZSP + 168 + h] + gb_i;
            const float fz = ZS[(tok0 + tid) * ZSP + 172 + h] + gb_f;
            const float lf = fminf(fz, 0.f) - log1pf(__expf(-fabsf(fz)));
            float bsum = lf;
#pragma unroll
            for (int d = 1; d < 64; d <<= 1) { const float n = __shfl_up(bsum, d); if (lane >= d) bsum += n; }
            const float bl = __shfl(bsum, 63);
            const float g = bl - bsum + ig;
            const float mnew = fmaxf(bl + mcar, wave_max(g));
            bc[tid] = bsum; igs[tid] = ig; wks[tid] = __expf(g - mnew);
            if (tid == 0) { sc[0] = mnew; sc[1] = __expf(bl + mcar - mnew); sc[2] = bl; }
        }
        __syncthreads();
        const float bt = bc[r];
        float mx = -INFINITY;
#pragma unroll
        for (int i = 0; i < 8; ++i) { const int s = sg * 8 + i; const float dli = (s <= r) ? (bt - bc[s] + igs[s]) : -INFINITY; mx = fmaxf(mx, dli); }
        mx = fmaxf(mx, __shfl_xor(mx, 1)); mx = fmaxf(mx, __shfl_xor(mx, 2)); mx = fmaxf(mx, __shfl_xor(mx, 4));
        const float inter = bt + mcar; const float mt = fmaxf(inter, mx); const float iw = __expf(inter - mt);
        float ssum = 0.f;
#pragma unroll 1
        for (int i = 0; i < 8; ++i) { const int s = sg * 8 + i; float dot = 0.f;
#pragma unroll 16
            for (int d = 0; d < 64; ++d) dot = fmaf(Qs[r * 65 + d], Ks[s * 65 + d], dot);
            const float dli = (s <= r) ? (bt - bc[s] + igs[s]) : -INFINITY;
            const float sv = dot * __expf(dli - mt); Ss[r * 65 + s] = sv; ssum += sv; }
        ssum += __shfl_xor(ssum, 1); ssum += __shfl_xor(ssum, 2); ssum += __shfl_xor(ssum, 4);
        float qn = 0.f;
#pragma unroll
        for (int d = 0; d < 64; ++d) qn = fmaf(Qs[r * 65 + d], nv[d], qn);
        const float den = iw * qn + ssum;
        __syncthreads();
        {
            float num[8];
#pragma unroll
            for (int i = 0; i < 8; ++i) num[i] = 0.f;
#pragma unroll 8
            for (int d = 0; d < 64; ++d) { const float qd = Qs[r * 65 + d];
#pragma unroll
                for (int i = 0; i < 8; ++i) num[i] = fmaf(qd, Cs[d * 65 + sg * 8 + i], num[i]); }
#pragma unroll
            for (int i = 0; i < 8; ++i) num[i] *= iw;
#pragma unroll 8
            for (int s = 0; s < 64; ++s) { const float sv = Ss[r * 65 + s];
#pragma unroll
                for (int i = 0; i < 8; ++i) num[i] = fmaf(sv, Vs[s * 65 + sg * 8 + i], num[i]); }
            const float dn = 1.f / fmaxf(fabsf(den), __expf(-mt));
            float hs = 0.f;
#pragma unroll
            for (int i = 0; i < 8; ++i) { num[i] *= dn; hs = fmaf(num[i], num[i], hs); }
            hs += __shfl_xor(hs, 1); hs += __shfl_xor(hs, 2); hs += __shfl_xor(hs, 4);
            const float rr = 1.f / sqrtf(hs * (1.f / 64.f) + EPS);
            const u32x4 og = *(const u32x4*)(Z + (tok0 + r) * ZP + 1536 + h * 64 + sg * 8);
            const float ogv[8] = {bflo(og.x), bfhi(og.x), bflo(og.y), bfhi(og.y), bflo(og.z), bfhi(og.z), bflo(og.w), bfhi(og.w)};
            const float* hg = p.ml_head_norm + l * 64 + sg * 8;
            float o[8];
#pragma unroll
            for (int i = 0; i < 8; ++i) o[i] = sigmoidf_(ogv[i]) * (num[i] * rr * hg[i]);
            u32x4 w; w.x = pk2(o[0], o[1]); w.y = pk2(o[2], o[3]); w.z = pk2(o[4], o[5]); w.w = pk2(o[6], o[7]);
            *(u32x4*)(O1 + (tok0 + r) * 256 + h * 64 + sg * 8) = w;
        }
        __syncthreads();
        {
            const float decay = sc[1];
            float cacc[8]; float nacc = 0.f;
#pragma unroll
            for (int i = 0; i < 8; ++i) cacc[i] = 0.f;
#pragma unroll 8
            for (int s = 0; s < 64; ++s) { const float kw = wks[s] * Ks[s * 65 + r]; nacc += kw;
#pragma unroll
                for (int i = 0; i < 8; ++i) cacc[i] = fmaf(kw, Vs[s * 65 + sg * 8 + i], cacc[i]); }
#pragma unroll
            for (int i = 0; i < 8; ++i) Cs[r * 65 + sg * 8 + i] = decay * Cs[r * 65 + sg * 8 + i] + cacc[i];
            if (sg == 0) nv[r] = decay * nv[r] + nacc;
            mcar = sc[0];
        }
        __syncthreads();
    }
}

__device__ __forceinline__ void diff_item(const Params& p, int l, int bh, int qt, LAS unsigned char* lds, int wv) {
    const int tid = tid_fresh(wv), b = bh >> 2, h = bh & 3, q0 = qt * 128;
    const bf16* Z = (const bf16*)(p.ws + WS_BIG); bf16* O0 = (bf16*)(p.ws + WS_O);
    LAS float* Kt = (LAS float*)lds; LAS float* Vt = Kt + 64 * 64;
    const int ql = tid >> 2, part = tid & 3, c = part & 1, dvh = part >> 1, t = q0 + ql; const size_t tok = (size_t)b * SEQ + t;
    const float* lp = p.diff_lambda + l * 128; float s01 = 0.f, s23 = 0.f, gqm = 0.f, gkm = 0.f;
#pragma unroll 2
    for (int i = 0; i < 32; ++i) { s01 = fmaf(lp[i], lp[32 + i], s01); s23 = fmaf(lp[64 + i], lp[96 + i], s23);
        gqm = fmaxf(gqm, fabsf(p.diff_qk_norm[l * 64 + i])); gkm = fmaxf(gkm, fabsf(p.diff_qk_norm[l * 64 + 32 + i])); }
    const float lam_init = 0.8f - 0.6f * __expf(-0.3f * (float)l); const float lam = __expf(s01) - __expf(s23) + lam_init;
    const float coff = 5.65685424949238f * gqm * gkm;
    float q[32], o[32];
    { const u32x4* qp = (const u32x4*)(Z + tok * ZP + h * 64 + c * 32);
#pragma unroll
      for (int i = 0; i < 4; ++i) { const u32x4 w = qp[i]; q[8 * i] = bflo(w.x); q[8 * i + 1] = bfhi(w.x); q[8 * i + 2] = bflo(w.y); q[8 * i + 3] = bfhi(w.y); q[8 * i + 4] = bflo(w.z); q[8 * i + 5] = bfhi(w.z); q[8 * i + 6] = bflo(w.w); q[8 * i + 7] = bfhi(w.w); } }
#pragma unroll
    for (int i = 0; i < 32; ++i) o[i] = 0.f;
    float lsum = 0.f;
    const int nkt = (q0 + 128) / 64;
    const int lk = tid >> 3, lsg = tid & 7;
    for (int kt = 0; kt < nkt; ++kt) {
        __syncthreads();
        { const size_t ktok = (size_t)b * SEQ + kt * 64 + lk;
          const bf16* src = Z + ktok * ZP + ((lsg < 4) ? (256 + h * 64 + lsg * 16) : (512 + h * 64 + (lsg - 4) * 16));
          const u32x4 x0 = ((const u32x4*)src)[0], x1 = ((const u32x4*)src)[1];
          LAS float* dst = ((lsg < 4) ? (Kt + lk * 64 + lsg * 16) : (Vt + lk * 64 + (lsg - 4) * 16));
          *(LAS f32x4*)(dst) = (f32x4){bflo(x0.x), bfhi(x0.x), bflo(x0.y), bfhi(x0.y)}; *(LAS f32x4*)(dst + 4) = (f32x4){bflo(x0.z), bfhi(x0.z), bflo(x0.w), bfhi(x0.w)};
          *(LAS f32x4*)(dst + 8) = (f32x4){bflo(x1.x), bfhi(x1.x), bflo(x1.y), bfhi(x1.y)}; *(LAS f32x4*)(dst + 12) = (f32x4){bflo(x1.z), bfhi(x1.z), bflo(x1.w), bfhi(x1.w)}; }
        __syncthreads();
        const int kmax = t - kt * 64 + 1;
        for (int key = 0; key < 64; ++key) {
            const LAS f32x4* kr = (const LAS f32x4*)(Kt + key * 64 + c * 32);
            float s = 0.f;
#pragma unroll
            for (int i = 0; i < 8; ++i) { const f32x4 kv = kr[i]; s = fmaf(q[4 * i], kv[0], s); s = fmaf(q[4 * i + 1], kv[1], s); s = fmaf(q[4 * i + 2], kv[2], s); s = fmaf(q[4 * i + 3], kv[3], s); }
            const float pe = (key < kmax) ? __expf(s - coff) : 0.f;
            lsum += pe;
            const LAS f32x4* vr = (const LAS f32x4*)(Vt + key * 64 + dvh * 32);
#pragma unroll
            for (int i = 0; i < 8; ++i) { const f32x4 vv = vr[i]; o[4 * i] = fmaf(pe, vv[0], o[4 * i]); o[4 * i + 1] = fmaf(pe, vv[1], o[4 * i + 1]); o[4 * i + 2] = fmaf(pe, vv[2], o[4 * i + 2]); o[4 * i + 3] = fmaf(pe, vv[3], o[4 * i + 3]); }
        }
    }
    const float inv = 1.f / lsum; float ss = 0.f;
#pragma unroll
    for (int i = 0; i < 32; ++i) { const float my = o[i] * inv; const float ot = __shfl_xor(my, 1); o[i] = (c == 0) ? (my - lam * ot) : (ot - lam * my); ss = fmaf(o[i], o[i], ss); }
    ss += __shfl_xor(ss, 2);
    const float rr = (1.f - lam_init) / sqrtf(ss * (1.f / 64.f) + EPS);
    if (c == 0) {
        const float* hg = p.diff_head_norm + l * 64 + dvh * 32; u32x4* dst = (u32x4*)(O0 + tok * 256 + h * 64 + dvh * 32);
#pragma unroll
        for (int i = 0; i < 4; ++i) { u32x4 w; w.x = pk2(o[8 * i] * rr * hg[8 * i], o[8 * i + 1] * rr * hg[8 * i + 1]); w.y = pk2(o[8 * i + 2] * rr * hg[8 * i + 2], o[8 * i + 3] * rr * hg[8 * i + 3]);
            w.z = pk2(o[8 * i + 4] * rr * hg[8 * i + 4], o[8 * i + 5] * rr * hg[8 * i + 5]); w.w = pk2(o[8 * i + 6] * rr * hg[8 * i + 6], o[8 * i + 7] * rr * hg[8 * i + 7]); dst[i] = w; }
    }
    __syncthreads();
}

__device__ __forceinline__ unsigned pkbf(float lo, float hi) { unsigned r; asm("v_cvt_pk_bf16_f32 %0, %1, %2" : "=v"(r) : "v"(lo), "v"(hi)); return r; }
__device__ __forceinline__ void diffm_item(const Params& p, int l, int bh, int qb, LAS unsigned char* lds, int wv) {
    const int tid = tid_fresh(wv), lane = tid & 63, half = lane >> 5, r32 = lane & 31, b = bh >> 2, h = bh & 3;
    const bf16* Z = (const bf16*)(p.ws + WS_BIG); bf16* O0 = (bf16*)(p.ws + WS_O);
    LAS bf16* Ks = (LAS bf16*)lds; LAS bf16* Vt = Ks + 64 * 72;
    const float* lp = p.diff_lambda + l * 128; float s01 = 0.f, s23 = 0.f, gqm = 0.f, gkm = 0.f;
#pragma unroll 2
    for (int i = 0; i < 32; ++i) { s01 = fmaf(lp[i], lp[32 + i], s01); s23 = fmaf(lp[64 + i], lp[96 + i], s23);
        gqm = fmaxf(gqm, fabsf(p.diff_qk_norm[l * 64 + i])); gkm = fmaxf(gkm, fabsf(p.diff_qk_norm[l * 64 + 32 + i])); }
    const float lam_init = 0.8f - 0.6f * __expf(-0.3f * (float)l); const float lam = __expf(s01) - __expf(s23) + lam_init;
    const float coff = 5.65685424949238f * gqm * gkm;
    const int qw = qb * 256 + 32 * wv;
    const size_t tokb = (size_t)b * SEQ;
    s16x8 qf[2][2];
    { const bf16* qp = Z + (tokb + qw + r32) * ZP + h * 64 + half * 8;
#pragma unroll
      for (int c = 0; c < 2; ++c)
#pragma unroll
          for (int s = 0; s < 2; ++s) qf[c][s] = *(const s16x8*)(qp + c * 32 + 16 * s); }
    f32x16 oacc[2][2];
#pragma unroll
    for (int c = 0; c < 2; ++c)
#pragma unroll
        for (int db = 0; db < 2; ++db)
#pragma unroll
            for (int r = 0; r < 16; ++r) oacc[c][db][r] = 0.f;
    float ls0 = 0.f, ls1 = 0.f;
    const int nt = (qb + 1) * 4;
    const int kkey = tid >> 3, kch = tid & 7, vkey = tid & 63, vdc = tid >> 6;
    const bf16* kgp = Z + (tokb + kkey) * ZP + 256 + h * 64 + kch * 8;
    const bf16* vgp = Z + (tokb + vkey) * ZP + 512 + h * 64 + vdc * 8;
    u32x4 kreg = *(const u32x4*)kgp, vreg = *(const u32x4*)vgp;
#pragma unroll 1
    for (int t = 0; t < nt; ++t) {
        __syncthreads();
        *(LAS u32x4*)(Ks + kkey * 72 + kch * 8) = kreg;
        { LAS bf16* vd = Vt + (vdc * 8) * 72 + vkey;
          vd[0] = (bf16)(vreg.x & 0xffffu); vd[72] = (bf16)(vreg.x >> 16); vd[144] = (bf16)(vreg.y & 0xffffu); vd[216] = (bf16)(vreg.y >> 16);
          vd[288] = (bf16)(vreg.z & 0xffffu); vd[360] = (bf16)(vreg.z >> 16); vd[432] = (bf16)(vreg.w & 0xffffu); vd[504] = (bf16)(vreg.w >> 16); }
        __syncthreads();
        if (t + 1 < nt) { kreg = *(const u32x4*)(kgp + (size_t)(t + 1) * 64 * ZP); vreg = *(const u32x4*)(vgp + (size_t)(t + 1) * 64 * ZP); }
        const int k0 = t * 64;
#pragma unroll
        for (int sub = 0; sub < 2; ++sub) {
            const int kb = k0 + 32 * sub;
            if (kb <= qw + 31) {
                f32x16 s0, s1;
#pragma unroll
                for (int r = 0; r < 16; ++r) { s0[r] = 0.f; s1[r] = 0.f; }
                const LAS bf16* kr = Ks + (32 * sub + r32) * 72 + 8 * half;
#pragma unroll
                for (int s = 0; s < 2; ++s) {
                    const s16x8 a0 = *(const LAS s16x8*)(kr + 16 * s), a1 = *(const LAS s16x8*)(kr + 32 + 16 * s);
                    s0 = __builtin_amdgcn_mfma_f32_32x32x16_bf16(a0, qf[0][s], s0, 0, 0, 0);
                    s1 = __builtin_amdgcn_mfma_f32_32x32x16_bf16(a1, qf[1][s], s1, 0, 0, 0);
                }
                const bool diag = (kb + 31 > qw);
#pragma unroll
                for (int r = 0; r < 16; ++r) {
                    float p0 = __expf(s0[r] - coff), p1 = __expf(s1[r] - coff);
                    if (diag) { const int key = kb + 8 * (r >> 2) + 4 * half + (r & 3); if (key > qw + r32) { p0 = 0.f; p1 = 0.f; } }
                    ls0 += p0; ls1 += p1; s0[r] = p0; s1[r] = p1;
                }
#pragma unroll
                for (int s = 0; s < 2; ++s) {
                    u32x4 w0, w1;
                    w0.x = pkbf(s0[8 * s], s0[8 * s + 1]); w0.y = pkbf(s0[8 * s + 2], s0[8 * s + 3]); w0.z = pkbf(s0[8 * s + 4], s0[8 * s + 5]); w0.w = pkbf(s0[8 * s + 6], s0[8 * s + 7]);
                    w1.x = pkbf(s1[8 * s], s1[8 * s + 1]); w1.y = pkbf(s1[8 * s + 2], s1[8 * s + 3]); w1.z = pkbf(s1[8 * s + 4], s1[8 * s + 5]); w1.w = pkbf(s1[8 * s + 6], s1[8 * s + 7]);
                    const s16x8 pf0 = __builtin_bit_cast(s16x8, w0), pf1 = __builtin_bit_cast(s16x8, w1);
#pragma unroll
                    for (int db = 0; db < 2; ++db) {
                        const LAS bf16* vr = Vt + (db * 32 + r32) * 72 + 32 * sub + 16 * s + 4 * half;
                        const u32x2 v0 = *(const LAS u32x2*)vr, v1 = *(const LAS u32x2*)(vr + 8);
                        const u32x4 vv = (u32x4){v0.x, v0.y, v1.x, v1.y};
                        const s16x8 vf = __builtin_bit_cast(s16x8, vv);
                        oacc[0][db] = __builtin_amdgcn_mfma_f32_32x32x16_bf16(vf, pf0, oacc[0][db], 0, 0, 0);
                        oacc[1][db] = __builtin_amdgcn_mfma_f32_32x32x16_bf16(vf, pf1, oacc[1][db], 0, 0, 0);
                    }
                }
            }
        }
    }
    ls0 += __shfl_xor(ls0, 32); ls1 += __shfl_xor(ls1, 32);
    const float i0 = 1.f / ls0, i1 = lam / ls1;
    float ss = 0.f;
#pragma unroll
    for (int db = 0; db < 2; ++db)
#pragma unroll
        for (int r = 0; r < 16; ++r) { const float v = oacc[0][db][r] * i0 - oacc[1][db][r] * i1; oacc[0][db][r] = v; ss = fmaf(v, v, ss); }
    ss += __shfl_xor(ss, 32);
    const float rr = (1.f - lam_init) / sqrtf(ss * (1.f / 64.f) + EPS);
    const float* hg = p.diff_head_norm + l * 64;
    bf16* orow = O0 + (tokb + qw + r32) * 256 + h * 64;
#pragma unroll
    for (int db = 0; db < 2; ++db)
#pragma unroll
        for (int g = 0; g < 4; ++g) { const int d0 = db * 32 + 8 * g + 4 * half; const f32x4 gg = *(const f32x4*)(hg + d0);
            u32x2 w; w.x = pkbf(oacc[0][db][4 * g] * rr * gg[0], oacc[0][db][4 * g + 1] * rr * gg[1]); w.y = pkbf(oacc[0][db][4 * g + 2] * rr * gg[2], oacc[0][db][4 * g + 3] * rr * gg[3]);
            *(u32x2*)(orow + d0) = w; }
    __syncthreads();
}

__device__ __forceinline__ void sb_item(const Params& p, int bh, int g, LAS unsigned char* lds, int wv) {
    const int tid = tid_fresh(wv), lane = tid & 63, w = tid >> 6, b = bh >> 2, h = bh & 3;
    const bf16* Z = (const bf16*)(p.ws + WS_BIG); bf16* O2 = (bf16*)(p.ws + WS_O + 2 * OB_STRIDE);
    LAS float* KV = (LAS float*)lds + w * 4096;
    const int t0 = g * 512 + w * 64, t = t0 + lane; const size_t tok = (size_t)b * SEQ + t;
    float q[64], o[64];
    { const u32x4* qp = (const u32x4*)(Z + tok * ZP + 1792 + h * 64);
#pragma unroll
      for (int i = 0; i < 8; ++i) { const u32x4 x = qp[i]; q[8 * i] = bflo(x.x); q[8 * i + 1] = bfhi(x.x); q[8 * i + 2] = bflo(x.y); q[8 * i + 3] = bfhi(x.y); q[8 * i + 4] = bflo(x.z); q[8 * i + 5] = bfhi(x.z); q[8 * i + 6] = bflo(x.w); q[8 * i + 7] = bfhi(x.w); } }
#pragma unroll
    for (int i = 0; i < 64; ++i) o[i] = 0.f;
    float R = 0.f;
    const int lkey = lane >> 1, lhalf = lane & 1;
    for (int slo = t0 + 32; slo >= 0; slo -= 32) {
        asm volatile("s_waitcnt lgkmcnt(0)" ::: "memory");
        { const size_t ktok = (size_t)b * SEQ + slo + lkey;
          const u32x4* ks = (const u32x4*)(Z + ktok * ZP + 2048 + h * 64 + lhalf * 32); const u32x4* vs = (const u32x4*)(Z + ktok * ZP + 2304 + h * 64 + lhalf * 32);
          LAS float* kd = KV + lkey * 128 + lhalf * 32; LAS float* vd = kd + 64;
#pragma unroll
          for (int i = 0; i < 4; ++i) { const u32x4 x = ks[i]; *(LAS f32x4*)(kd + 8 * i) = (f32x4){bflo(x.x), bfhi(x.x), bflo(x.y), bfhi(x.y)}; *(LAS f32x4*)(kd + 8 * i + 4) = (f32x4){bflo(x.z), bfhi(x.z), bflo(x.w), bfhi(x.w)}; }
#pragma unroll
          for (int i = 0; i < 4; ++i) { const u32x4 x = vs[i]; *(LAS f32x4*)(vd + 8 * i) = (f32x4){bflo(x.x), bfhi(x.x), bflo(x.y), bfhi(x.y)}; *(LAS f32x4*)(vd + 8 * i + 4) = (f32x4){bflo(x.z), bfhi(x.z), bflo(x.w), bfhi(x.w)}; } }
        asm volatile("s_waitcnt lgkmcnt(0)" ::: "memory");
        for (int kk = 31; kk >= 0; --kk) {
            const int s = slo + kk; const bool act = s < t;
            const LAS f32x4* kr = (const LAS f32x4*)(KV + kk * 128);
            float z = 0.f;
#pragma unroll
            for (int i = 0; i < 16; ++i) { const f32x4 kv = kr[i]; z = fmaf(q[4 * i], kv[0], z); z = fmaf(q[4 * i + 1], kv[1], z); z = fmaf(q[4 * i + 2], kv[2], z); z = fmaf(q[4 * i + 3], kv[3], z); }
            z *= 0.125f;
            const float lb = fminf(z, 0.f) - __logf(1.f + __expf(-fabsf(z)));
            const float a = act ? __expf(lb + R) : 0.f;
            R += act ? (lb - z) : 0.f;
#pragma unroll
            for (int i = 0; i < 16; ++i) { const f32x4 vv = kr[16 + i]; o[4 * i] = fmaf(a, vv[0], o[4 * i]); o[4 * i + 1] = fmaf(a, vv[1], o[4 * i + 1]); o[4 * i + 2] = fmaf(a, vv[2], o[4 * i + 2]); o[4 * i + 3] = fmaf(a, vv[3], o[4 * i + 3]); }
        }
        if (__all(R < -104.f)) break;
    }
    u32x4* dst = (u32x4*)(O2 + tok * 256 + h * 64);
#pragma unroll
    for (int i = 0; i < 8; ++i) { u32x4 x; x.x = pk2(o[8 * i], o[8 * i + 1]); x.y = pk2(o[8 * i + 2], o[8 * i + 3]); x.z = pk2(o[8 * i + 4], o[8 * i + 5]); x.w = pk2(o[8 * i + 6], o[8 * i + 7]); dst[i] = x; }
    asm volatile("s_waitcnt lgkmcnt(0)" ::: "memory");
}
constexpr size_t WS_MLS = 460 * MiB, WS_DEC = WS_MLS + 5 * 32 * 4096 * 4, WS_UN = 463 * MiB, WS_NV = WS_UN + 512 * 1024, WS_UT = 464 * MiB, WS_CT = 496 * MiB, WS_END2 = 512 * MiB;
constexpr int MLN = 32 * 4096;
__device__ __forceinline__ void ml_prepass(const Params& p, int l, int bh, int lane) {
    const int b = bh >> 2, h = bh & 3; const float* ZS = (const float*)(p.ws + WS_ZS);
    float* MLS = (float*)(p.ws + WS_MLS); float* DEC = (float*)(p.ws + WS_DEC);
    const float gb_i = p.ml_gate_bias[(l * 2 + 0) * 4 + h], gb_f = p.ml_gate_bias[(l * 2 + 1) * 4 + h];
    float cA = 0.f, cB = 0.f;
#pragma unroll 1
    for (int c4 = 0; c4 < 16; ++c4) {
        float igv[4], fzv[4];
#pragma unroll
        for (int k = 0; k < 4; ++k) { const size_t tok = (size_t)b * SEQ + (c4 * 4 + k) * 64 + lane; igv[k] = ZS[tok * ZSP + 168 + h]; fzv[k] = ZS[tok * ZSP + 172 + h]; }
#pragma unroll
        for (int k = 0; k < 4; ++k) {
            const int c = c4 * 4 + k;
            const float ig = igv[k] + gb_i, fz = fzv[k] + gb_f;
            const float lf = fminf(fz, 0.f) - __logf(1.f + __expf(-fabsf(fz)));
            float bsum = lf;
#pragma unroll
            for (int d = 1; d < 64; d <<= 1) { const float n = __shfl_up(bsum, d); if (lane >= d) bsum += n; }
            const float bl = __shfl(bsum, 63);
            const float a = ig - bsum;
            float pm = a;
#pragma unroll
            for (int d = 1; d < 64; d <<= 1) { const float n = __shfl_up(pm, d); if (lane >= d) pm = fmaxf(pm, n); }
            const float gmax = bl + __shfl(pm, 63);
            const int ti = bh * 4096 + c * 64 + lane;
            MLS[ti] = bsum; MLS[MLN + ti] = a; MLS[2 * MLN + ti] = pm;
            cA = (lane == c) ? bl : cA; cB = (lane == c) ? gmax : cB;
        }
    }
    float sA = cA, sB = cB;
#pragma unroll
    for (int d = 1; d < 64; d <<= 1) { const float pA = __shfl_up(sA, d), pB = __shfl_up(sB, d); if (lane >= d) { sB = fmaxf(pB + sA, sB); sA = pA + sA; } }
    const float m_out = fmaxf(sA, sB);
    float m_in = __shfl_up(m_out, 1); if (lane == 0) m_in = 0.f;
    DEC[bh * 64 + lane] = __expf(cA + m_in - m_out);
    asm volatile("s_waitcnt vmcnt(0)" ::: "memory");
#pragma unroll 1
    for (int c4 = 0; c4 < 16; ++c4) {
        float bsv[4], av[4], pmv[4];
#pragma unroll
        for (int k = 0; k < 4; ++k) { const int ti = bh * 4096 + (c4 * 4 + k) * 64 + lane; bsv[k] = MLS[ti]; av[k] = MLS[MLN + ti]; pmv[k] = MLS[2 * MLN + ti]; }
#pragma unroll
        for (int k = 0; k < 4; ++k) {
            const int c = c4 * 4 + k;
            const float mi = __shfl(m_in, c), mo = __shfl(m_out, c), bl = __shfl(cA, c);
            const int ti = bh * 4096 + c * 64 + lane;
            const float mt = bsv[k] + fmaxf(mi, pmv[k]);
            MLS[2 * MLN + ti] = mt; MLS[3 * MLN + ti] = __expf(bl + av[k] - mo); MLS[4 * MLN + ti] = __expf(bsv[k] + mi - mt);
        }
    }
}
__device__ __forceinline__ void ml_conv8(const bf16* Z, const float* cw, const float* cb, int b, int t, int ch0, float (&y)[8]) {
    const f32x4 b0 = *(const f32x4*)(cb + ch0), b1 = *(const f32x4*)(cb + ch0 + 4);
    y[0] = b0[0]; y[1] = b0[1]; y[2] = b0[2]; y[3] = b0[3]; y[4] = b1[0]; y[5] = b1[1]; y[6] = b1[2]; y[7] = b1[3];
#pragma unroll
    for (int j = 0; j < 4; ++j) {
        const int tt = t - 3 + j;
        if (tt >= 0) {
            const u32x4 x = *(const u32x4*)(Z + ((size_t)b * SEQ + tt) * ZP + 768 + ch0);
            const f32x4 w0 = *(const f32x4*)(cw + j * 512 + ch0), w1 = *(const f32x4*)(cw + j * 512 + ch0 + 4);
            y[0] = fmaf(w0[0], bflo(x.x), y[0]); y[1] = fmaf(w0[1], bfhi(x.x), y[1]); y[2] = fmaf(w0[2], bflo(x.y), y[2]); y[3] = fmaf(w0[3], bfhi(x.y), y[3]);
            y[4] = fmaf(w1[0], bflo(x.z), y[4]); y[5] = fmaf(w1[1], bfhi(x.z), y[5]); y[6] = fmaf(w1[2], bflo(x.w), y[6]); y[7] = fmaf(w1[3], bfhi(x.w), y[7]);
        }
    }
#pragma unroll
    for (int i = 0; i < 8; ++i) y[i] = y[i] * sigmoidf_(y[i]);
}
__device__ __forceinline__ void mlB_item(const Params& p, int l, int bh, int ci, LAS unsigned char* lds, int wv) {
    const int tid = tid_fresh(wv), lane = tid & 63, half = lane >> 5, r32 = lane & 31, b = bh >> 2, h = bh & 3;
    const bf16* Z = (const bf16*)(p.ws + WS_BIG); const float* MLS = (const float*)(p.ws + WS_MLS);
    float* UT = (float*)(p.ws + WS_UT); float* UN = (float*)(p.ws + WS_UN);
    LAS bf16* KT = (LAS bf16*)lds; LAS bf16* VT = KT + 4 * 64 * 72;
    const float* cw = p.ml_conv_w + (size_t)l * 4 * 512; const float* cb = p.ml_conv_b + (size_t)l * 512;
    __syncthreads();
    {
        const int tt = tid >> 1, hr = tid & 1, cl = tt >> 6, s = tt & 63, t = (ci * 4) * 64 + tt;
        const float wk = MLS[3 * MLN + bh * 4096 + t];
#pragma unroll 1
        for (int q8 = 0; q8 < 4; ++q8) {
            const int d0 = hr * 32 + q8 * 8; float y[8];
            ml_conv8(Z, cw, cb, b, t, 256 + h * 64 + d0, y);
            LAS bf16* dst = KT + (cl * 64 + d0) * 72 + s;
#pragma unroll
            for (int i = 0; i < 8; ++i) dst[i * 72] = (bf16)f2bf(y[i] * wk);
            const u32x4 v = *(const u32x4*)(Z + ((size_t)b * SEQ + t) * ZP + 1280 + h * 64 + d0);
            LAS bf16* vd = VT + (cl * 64 + d0) * 72 + s;
            vd[0] = (bf16)(v.x & 0xffffu); vd[72] = (bf16)(v.x >> 16); vd[144] = (bf16)(v.y & 0xffffu); vd[216] = (bf16)(v.y >> 16);
            vd[288] = (bf16)(v.z & 0xffffu); vd[360] = (bf16)(v.z >> 16); vd[432] = (bf16)(v.w & 0xffffu); vd[504] = (bf16)(v.w >> 16);
        }
    }
    __syncthreads();
    const int cl = wv >> 1, dh = wv & 1, c = ci * 4 + cl;
    f32x16 acc[2];
#pragma unroll
    for (int eb = 0; eb < 2; ++eb)
#pragma unroll
        for (int r = 0; r < 16; ++r) acc[eb][r] = 0.f;
#pragma unroll
    for (int s4 = 0; s4 < 4; ++s4) {
        const s16x8 bk = *(const LAS s16x8*)(KT + (cl * 64 + dh * 32 + r32) * 72 + 16 * s4 + 8 * half);
#pragma unroll
        for (int eb = 0; eb < 2; ++eb) {
            const s16x8 av = *(const LAS s16x8*)(VT + (cl * 64 + eb * 32 + r32) * 72 + 16 * s4 + 8 * half);
            acc[eb] = __builtin_amdgcn_mfma_f32_32x32x16_bf16(av, bk, acc[eb], 0, 0, 0);
        }
    }
    float* ut = UT + ((size_t)(bh * 64 + c) * 64) * 64;
#pragma unroll
    for (int eb = 0; eb < 2; ++eb)
#pragma unroll
        for (int r = 0; r < 16; ++r) { const int e = eb * 32 + 8 * (r >> 2) + 4 * half + (r & 3); ut[e * 64 + dh * 32 + r32] = acc[eb][r]; }
    {
        const LAS bf16* kr = KT + (cl * 64 + dh * 32 + r32) * 72 + half * 32; float sm = 0.f;
#pragma unroll
        for (int i = 0; i < 4; ++i) { const u32x4 x = *(const LAS u32x4*)(kr + 8 * i); sm += (bflo(x.x) + bfhi(x.x)) + (bflo(x.y) + bfhi(x.y)) + (bflo(x.z) + bfhi(x.z)) + (bflo(x.w) + bfhi(x.w)); }
        sm += __shfl_xor(sm, 32);
        if (half == 0) UN[(bh * 64 + c) * 64 + dh * 32 + r32] = sm;
    }
}
__device__ __forceinline__ void mlS_item(const Params& p, int bh, int wv) {
    const int tid = tid_fresh(wv);
    const float* UT = (const float*)(p.ws + WS_UT) + (size_t)bh * 64 * 4096; const float* UN = (const float*)(p.ws + WS_UN) + bh * 4096;
    bf16* CT = (bf16*)(p.ws + WS_CT) + (size_t)bh * 64 * 4096; float* NV = (float*)(p.ws + WS_NV) + bh * 4096; const float* DEC = (const float*)(p.ws + WS_DEC) + bh * 64;
    f32x4 s0 = (f32x4){0.f, 0.f, 0.f, 0.f}, s1 = s0; float ns = 0.f;
#pragma unroll 4
    for (int c = 0; c < 64; ++c) {
        const float dec = DEC[c];
        const f32x4 u0 = *(const f32x4*)(UT + (size_t)c * 4096 + tid * 8), u1 = *(const f32x4*)(UT + (size_t)c * 4096 + tid * 8 + 4);
        u32x4 w; w.x = pk2(s0[0], s0[1]); w.y = pk2(s0[2], s0[3]); w.z = pk2(s1[0], s1[1]); w.w = pk2(s1[2], s1[3]);
        *(u32x4*)(CT + (size_t)c * 4096 + tid * 8) = w;
        s0 = s0 * dec + u0; s1 = s1 * dec + u1;
        if (tid < 64) { NV[c * 64 + tid] = ns; ns = ns * dec + UN[c * 64 + tid]; }
    }
}
__device__ __forceinline__ void mlD_item(const Params& p, int l, int bh, int ci, LAS unsigned char* lds, int wv) {
    const int tid = tid_fresh(wv), lane = tid & 63, half = lane >> 5, r32 = lane & 31, b = bh >> 2, h = bh & 3;
    const bf16* Z = (const bf16*)(p.ws + WS_BIG); const float* MLS = (const float*)(p.ws + WS_MLS); bf16* O1 = (bf16*)(p.ws + WS_O + OB_STRIDE);
    LAS bf16* Qs = (LAS bf16*)lds; LAS bf16* Ks = Qs + 4 * 64 * 72; LAS bf16* VT = Ks + 4 * 64 * 72;
    const float* cw = p.ml_conv_w + (size_t)l * 4 * 512; const float* cb = p.ml_conv_b + (size_t)l * 512;
    __syncthreads();
    {
        const int tt = tid >> 1, hr = tid & 1, cl = tt >> 6, s = tt & 63, t = (ci * 4) * 64 + tt;
#pragma unroll 1
        for (int q8 = 0; q8 < 4; ++q8) {
            const int d0 = hr * 32 + q8 * 8; float y[8];
            ml_conv8(Z, cw, cb, b, t, h * 64 + d0, y);
            u32x4 w; w.x = pk2(y[0] * 0.125f, y[1] * 0.125f); w.y = pk2(y[2] * 0.125f, y[3] * 0.125f); w.z = pk2(y[4] * 0.125f, y[5] * 0.125f); w.w = pk2(y[6] * 0.125f, y[7] * 0.125f);
            *(LAS u32x4*)(Qs + (cl * 64 + s) * 72 + d0) = w;
            ml_conv8(Z, cw, cb, b, t, 256 + h * 64 + d0, y);
            w.x = pk2(y[0], y[1]); w.y = pk2(y[2], y[3]); w.z = pk2(y[4], y[5]); w.w = pk2(y[6], y[7]);
            *(LAS u32x4*)(Ks + (cl * 64 + s) * 72 + d0) = w;
            const u32x4 v = *(const u32x4*)(Z + ((size_t)b * SEQ + t) * ZP + 1280 + h * 64 + d0);
            LAS bf16* vd = VT + (cl * 64 + d0) * 72 + s;
            vd[0] = (bf16)(v.x & 0xffffu); vd[72] = (bf16)(v.x >> 16); vd[144] = (bf16)(v.y & 0xffffu); vd[216] = (bf16)(v.y >> 16);
            vd[288] = (bf16)(v.z & 0xffffu); vd[360] = (bf16)(v.z >> 16); vd[432] = (bf16)(v.w & 0xffffu); vd[504] = (bf16)(v.w >> 16);
        }
    }
    __syncthreads();
    const int cl = wv >> 1, th = wv & 1, c = ci * 4 + cl, tloc = th * 32 + r32, tseq = c * 64 + tloc;
    const int ti = bh * 4096 + tseq;
    const float bs_t = MLS[ti], mt_t = MLS[2 * MLN + ti], iw_t = MLS[4 * MLN + ti];
    s16x8 qf[4];
#pragma unroll
    for (int s4 = 0; s4 < 4; ++s4) qf[s4] = *(const LAS s16x8*)(Qs + (cl * 64 + tloc) * 72 + 16 * s4 + 8 * half);
    f32x16 oacc[2];
#pragma unroll
    for (int eb = 0; eb < 2; ++eb)
#pragma unroll
        for (int r = 0; r < 16; ++r) oacc[eb][r] = 0.f;
    const bf16* CT = (const bf16*)(p.ws + WS_CT) + (size_t)(bh * 64 + c) * 4096;
#pragma unroll
    for (int s4 = 0; s4 < 4; ++s4)
#pragma unroll
        for (int eb = 0; eb < 2; ++eb) { const s16x8 ac = *(const s16x8*)(CT + (eb * 32 + r32) * 64 + 16 * s4 + 8 * half);
            oacc[eb] = __builtin_amdgcn_mfma_f32_32x32x16_bf16(ac, qf[s4], oacc[eb], 0, 0, 0); }
#pragma unroll
    for (int eb = 0; eb < 2; ++eb)
#pragma unroll
        for (int r = 0; r < 16; ++r) oacc[eb][r] *= iw_t;
    float qn = 0.f;
    { const float* nvp = (const float*)(p.ws + WS_NV) + (bh * 64 + c) * 64;
#pragma unroll
      for (int s4 = 0; s4 < 4; ++s4) { const f32x4 n0 = *(const f32x4*)(nvp + 16 * s4 + 8 * half), n1 = *(const f32x4*)(nvp + 16 * s4 + 8 * half + 4);
          const u32x4 qq = __builtin_bit_cast(u32x4, qf[s4]);
          qn += bflo(qq.x) * n0[0] + bfhi(qq.x) * n0[1] + bflo(qq.y) * n0[2] + bfhi(qq.y) * n0[3] + bflo(qq.z) * n1[0] + bfhi(qq.z) * n1[1] + bflo(qq.w) * n1[2] + bfhi(qq.w) * n1[3]; } }
    qn += __shfl_xor(qn, 32);
    float rs = 0.f;
#pragma unroll
    for (int sb = 0; sb < 2; ++sb) {
        if (sb <= th) {
            f32x16 sacc;
#pragma unroll
            for (int r = 0; r < 16; ++r) sacc[r] = 0.f;
#pragma unroll
            for (int s4 = 0; s4 < 4; ++s4) { const s16x8 ak = *(const LAS s16x8*)(Ks + (cl * 64 + sb * 32 + r32) * 72 + 16 * s4 + 8 * half);
                sacc = __builtin_amdgcn_mfma_f32_32x32x16_bf16(ak, qf[s4], sacc, 0, 0, 0); }
            const float* ap = MLS + MLN + bh * 4096 + c * 64 + sb * 32 + 4 * half;
#pragma unroll
            for (int g = 0; g < 4; ++g) { const f32x4 av = *(const f32x4*)(ap + 8 * g);
#pragma unroll
                for (int i = 0; i < 4; ++i) { const int s = sb * 32 + 8 * g + 4 * half + i; const float v = (s <= tloc) ? sacc[4 * g + i] * __expf(bs_t + av[i] - mt_t) : 0.f; sacc[4 * g + i] = v; rs += v; } }
#pragma unroll
            for (int s2 = 0; s2 < 2; ++s2) {
                u32x4 w; w.x = pkbf(sacc[8 * s2], sacc[8 * s2 + 1]); w.y = pkbf(sacc[8 * s2 + 2], sacc[8 * s2 + 3]); w.z = pkbf(sacc[8 * s2 + 4], sacc[8 * s2 + 5]); w.w = pkbf(sacc[8 * s2 + 6], sacc[8 * s2 + 7]);
                const s16x8 pf = __builtin_bit_cast(s16x8, w);
#pragma unroll
                for (int eb = 0; eb < 2; ++eb) {
                    const LAS bf16* vr = VT + (cl * 64 + eb * 32 + r32) * 72 + sb * 32 + 16 * s2 + 4 * half;
                    const u32x2 v0 = *(const LAS u32x2*)vr, v1 = *(const LAS u32x2*)(vr + 8);
                    const u32x4 vv = (u32x4){v0.x, v0.y, v1.x, v1.y};
                    oacc[eb] = __builtin_amdgcn_mfma_f32_32x32x16_bf16(__builtin_bit_cast(s16x8, vv), pf, oacc[eb], 0, 0, 0);
                }
            }
        }
    }
    rs += __shfl_xor(rs, 32);
    const float den = iw_t * qn + rs;
    const float dn = 1.f / fmaxf(fabsf(den), __expf(-mt_t));
    float ss = 0.f;
#pragma unroll
    for (int eb = 0; eb < 2; ++eb)
#pragma unroll
        for (int r = 0; r < 16; ++r) { const float v = oacc[eb][r] * dn; oacc[eb][r] = v; ss = fmaf(v, v, ss); }
    ss += __shfl_xor(ss, 32);
    const float rr = 1.f / sqrtf(ss * (1.f / 64.f) + EPS);
    const size_t tok = (size_t)b * SEQ + tseq;
    const float* hg = p.ml_head_norm + l * 64;
#pragma unroll
    for (int eb = 0; eb < 2; ++eb)
#pragma unroll
        for (int g = 0; g < 4; ++g) { const int e0 = eb * 32 + 8 * g + 4 * half; const f32x4 gg = *(const f32x4*)(hg + e0);
            const u32x2 og = *(const u32x2*)(Z + tok * ZP + 1536 + h * 64 + e0);
            u32x2 w; w.x = pkbf(sigmoidf_(bflo(og.x)) * oacc[eb][4 * g] * rr * gg[0], sigmoidf_(bfhi(og.x)) * oacc[eb][4 * g + 1] * rr * gg[1]);
            w.y = pkbf(sigmoidf_(bflo(og.y)) * oacc[eb][4 * g + 2] * rr * gg[2], sigmoidf_(bfhi(og.y)) * oacc[eb][4 * g + 3] * rr * gg[3]);
            *(u32x2*)(O1 + tok * 256 + h * 64 + e0) = w; }
}
__device__ __forceinline__ float relu_(float x) { return __builtin_amdgcn_fmed3f(x, 0.f, __builtin_inff()); }
__device__ __forceinline__ unsigned key16(float s) { const float f = __builtin_amdgcn_fmed3f(floorf(fmaf(s, 512.f, 32768.f)), 0.f, 65535.f); return (unsigned)f; }
__device__ __forceinline__ unsigned mono_bits(float s) { s = (s == 0.f) ? 0.f : s; const unsigned u = __float_as_uint(s); return (u & 0x80000000u) ? ~u : (u | 0x80000000u); }
__device__ __forceinline__ void dsa_item(const Params& p, int lds_l, int b, int qt, LAS unsigned char* lds, int wv) {
    const int tid = tid_fresh(wv), lane = tid & 63, w = wv, half = lane >> 5, r32 = lane & 31;
    const bf16* Z = (const bf16*)(p.ws + WS_BIG); const float* ZS = (const float*)(p.ws + WS_ZS); const bf16* IK = (const bf16*)(p.ws + WS_IK); bf16* O3 = (bf16*)(p.ws + WS_O + 3 * OB_STRIDE);
    LAS unsigned* hist = (LAS unsigned*)lds + w * 2048;
    LAS unsigned* maskw = (LAS unsigned*)(lds + 65536);
    LAS bf16* KC = (LAS bf16*)(lds + 81920);
    LAS bf16* Kd = (LAS bf16*)lds; LAS bf16* VTd = Kd + 64 * 72;
    const size_t tokb = (size_t)b * SEQ; const int tb = qt * 32 + 4 * w;
    const int ntiles = qt + 1, nkeys = ntiles * 32, nchunks = (ntiles + 15) >> 4;
    s16x8 aq0, aq1;
    { const int qrow = 2 * ((r32 >> 2) & 1) + (r32 >> 4), hrow = 4 * ((r32 >> 3) & 1) + (r32 & 3);
      const bf16* ap = Z + (tokb + tb + qrow) * ZP + 2816 + hrow * 32 + half * 8; aq0 = *(const s16x8*)ap; aq1 = *(const s16x8*)(ap + 16); }
    float wq[2][8];
#pragma unroll
    for (int s = 0; s < 2; ++s) { const float* wp = ZS + (tokb + tb + 2 * half + s) * ZSP + 160; const f32x4 x0 = *(const f32x4*)wp, x1 = *(const f32x4*)(wp + 4);
        wq[s][0] = x0[0]; wq[s][1] = x0[1]; wq[s][2] = x0[2]; wq[s][3] = x0[3]; wq[s][4] = x1[0]; wq[s][5] = x1[1]; wq[s][6] = x1[2]; wq[s][7] = x1[3]; }
    unsigned tau[4], prefix[4]; int quota[4], krem[4], eqs[2]; bool allsel[4];
    LAS unsigned* cand = (LAS unsigned*)(lds + 114688) + w * 768;
    LAS unsigned* oflag = (LAS unsigned*)(lds + LDS_BYTES - 48);
    const unsigned lowmask = (1u << r32) - 1u;
#define DSA_SCORES(ktl, sc) do { const LAS bf16* kp_ = KC + ((ktl) * 32 + r32) * 32 + half * 8; \
        const s16x8 b0_ = *(const LAS s16x8*)kp_, b1_ = *(const LAS s16x8*)(kp_ + 16); f32x16 a_ = {0.f, 0.f, 0.f, 0.f, 0.f, 0.f, 0.f, 0.f, 0.f, 0.f, 0.f, 0.f, 0.f, 0.f, 0.f, 0.f}; \
        a_ = __builtin_amdgcn_mfma_f32_32x32x16_bf16(aq0, b0_, a_, 0, 0, 0); a_ = __builtin_amdgcn_mfma_f32_32x32x16_bf16(aq1, b1_, a_, 0, 0, 0); \
        _Pragma("unroll") for (int s_ = 0; s_ < 2; ++s_) { float pt_ = wq[s_][0] * relu_(a_[8 * s_]); \
            _Pragma("unroll") for (int j_ = 1; j_ < 8; ++j_) pt_ = fmaf(wq[s_][j_], relu_(a_[8 * s_ + j_]), pt_); sc[s_] = pt_; } } while (0)
    int mode = (qt >= 8) ? 0 : 1;
#pragma unroll 1
    for (int attempt = 0; attempt < 2; ++attempt) {
        const int npass = (qt >= 8) ? (mode ? 4 : 1) : 0;
#pragma unroll
        for (int g = 0; g < 4; ++g) { tau[g] = 0u; prefix[g] = 0u; quota[g] = 1 << 30; krem[g] = 256; allsel[g] = true; }
        eqs[0] = 0; eqs[1] = 0;
        if (tid == 0) *oflag = 0u;
#pragma unroll 1
        for (int pass = 0; pass <= npass; ++pass) {
            const bool comp = (pass == npass);
            const int shift = 8 * (npass - 1 - pass);
            if (!comp) {
#pragma unroll
                for (int i = 0; i < 8; ++i) *(LAS u32x4*)(hist + (i * 64 + lane) * 4) = (u32x4){0u, 0u, 0u, 0u};
            }
            const unsigned pfa = half ? prefix[2] : prefix[0], pfb = half ? prefix[3] : prefix[1];
            const int ta = tb + 2 * half, tbq = ta + 1;
            u32x4 pre[4];
#pragma unroll
            for (int i = 0; i < 4; ++i) { const int kb = (tid * 16 + i * 8192) >> 6; pre[i] = (kb < nkeys) ? *(const u32x4*)((const unsigned char*)(IK + tokb * 32) + tid * 16 + i * 8192) : (u32x4){0u, 0u, 0u, 0u}; }
#pragma unroll 1
            for (int ch = 0; ch < nchunks; ++ch) {
                __syncthreads();
#pragma unroll
                for (int i = 0; i < 4; ++i) *(LAS u32x4*)((LAS unsigned char*)KC + tid * 16 + i * 8192) = pre[i];
                __syncthreads();
                if (ch + 1 < nchunks) {
#pragma unroll
                    for (int i = 0; i < 4; ++i) { const int kb = (ch + 1) * 512 + ((tid * 16 + i * 8192) >> 6);
                        pre[i] = (kb < nkeys) ? *(const u32x4*)((const unsigned char*)(IK + (tokb + (size_t)(ch + 1) * 512) * 32) + tid * 16 + i * 8192) : (u32x4){0u, 0u, 0u, 0u}; }
                }
                const int nt = min(16, ntiles - ch * 16);
                if (!comp) {
#pragma unroll 4
                    for (int ktl = 0; ktl < nt; ++ktl) {
                        float sc[2]; DSA_SCORES(ktl, sc);
                        const int key = (ch * 16 + ktl) * 32 + r32;
                        const float sa = sc[0], sb = sc[1];
                        if (mode == 0) {
                            const unsigned ba = key16(sa) >> 6, bb = key16(sb) >> 6;
                            if (key <= ta) __hip_atomic_fetch_add(hist + (2 * half) * 512 + (ba >> 1), (ba & 1u) ? 0x10000u : 1u, __ATOMIC_RELAXED, __HIP_MEMORY_SCOPE_WORKGROUP);
                            if (key <= tbq) __hip_atomic_fetch_add(hist + (2 * half + 1) * 512 + (bb >> 1), (bb & 1u) ? 0x10000u : 1u, __ATOMIC_RELAXED, __HIP_MEMORY_SCOPE_WORKGROUP);
                        } else {
                        const unsigned ma = mono_bits(sa), mb = mono_bits(sb);
                        const bool oka = (key <= ta) && (pass == 0 || (ma >> (shift + 8)) == pfa);
                        const bool okb = (key <= tbq) && (pass == 0 || (mb >> (shift + 8)) == pfb);
                        if (oka) __hip_atomic_fetch_add(hist + (2 * half) * 256 + ((ma >> shift) & 255u), 1u, __ATOMIC_RELAXED, __HIP_MEMORY_SCOPE_WORKGROUP);
                        if (okb) __hip_atomic_fetch_add(hist + (2 * half + 1) * 256 + ((mb >> shift) & 255u), 1u, __ATOMIC_RELAXED, __HIP_MEMORY_SCOPE_WORKGROUP);
                        }
                    }
                } else {
#pragma unroll 1
                    for (int ktl = 0; ktl < nt; ++ktl) {
                        float sc[2]; DSA_SCORES(ktl, sc);
                        const int key = (ch * 16 + ktl) * 32 + r32;
#pragma unroll
                        for (int s = 0; s < 2; ++s) {
                            const unsigned taus = half ? tau[2 + s] : tau[s]; const int quo = half ? quota[2 + s] : quota[s]; const bool alls = half ? allsel[2 + s] : allsel[s];
                            const unsigned m = mode ? mono_bits(sc[s]) : (key16(sc[s]) >> 6); const bool valid = key <= tb + 2 * half + s;
                            const bool eq = valid && (m == taus);
                            const unsigned beq = (unsigned)(__ballot(eq) >> (32 * half));
                            const int rank = eqs[s] + __popc(beq & lowmask);
                            const bool takeeq = mode ? (rank < quo) : alls;
                            const bool sel = valid && ((m > taus) || (eq && takeeq));
                            const unsigned bsel = (unsigned)(__ballot(sel) >> (32 * half));
                            if (r32 == 0) maskw[(4 * w + 2 * half + s) * 128 + ch * 16 + ktl] = bsel;
                            if (mode == 0 && !alls && eq && rank < 96) { cand[((2 * half + s) * 96 + rank) * 2] = mono_bits(sc[s]); cand[((2 * half + s) * 96 + rank) * 2 + 1] = (unsigned)key; }
                            eqs[s] += __popc(beq);
                        }
                    }
                }
            }
            if (!comp) {
                LDS_WAIT();
                if (mode == 0) {
#pragma unroll
                    for (int g = 0; g < 4; ++g) {
                        const u32x4 w0 = *(const LAS u32x4*)(hist + g * 512 + lane * 8), w1 = *(const LAS u32x4*)(hist + g * 512 + lane * 8 + 4);
                        const unsigned wd[8] = {w0.x, w0.y, w0.z, w0.w, w1.x, w1.y, w1.z, w1.w};
                        int c[16], tot = 0;
#pragma unroll
                        for (int j = 0; j < 8; ++j) { c[2 * j] = (int)(wd[j] & 0xffffu); c[2 * j + 1] = (int)(wd[j] >> 16); tot += c[2 * j] + c[2 * j + 1]; }
                        int v = tot;
#pragma unroll
                        for (int d = 1; d < 64; d <<= 1) { const int n = __shfl_down(v, d); if (lane + d < 64) v += n; }
                        const int k = krem[g]; int a = v - tot, fb = -1, fa = 0, fc = 0;
#pragma unroll
                        for (int j = 15; j >= 0; --j) { if (fb < 0 && a < k && a + c[j] >= k) { fb = j; fa = a; fc = c[j]; } a += c[j]; }
                        const unsigned long long mk = __ballot(fb >= 0);
                        const int src = (int)__builtin_ctzll(mk | (1ull << 63));
                        const int bin = __shfl(16 * lane + fb, src), above = __shfl(fa, src), cnt = __shfl(fc, src);
                        prefix[g] = (unsigned)bin; krem[g] = k - above;
                        tau[g] = prefix[g]; quota[g] = krem[g]; allsel[g] = (cnt == krem[g]);
                    }
                } else {
#pragma unroll
                for (int g = 0; g < 4; ++g) {
                    const u32x4 cv = *(const LAS u32x4*)(hist + g * 256 + lane * 4);
                    const int c0 = (int)cv.x, c1 = (int)cv.y, c2 = (int)cv.z, c3 = (int)cv.w, tot = c0 + c1 + c2 + c3;
                    int v = tot;
#pragma unroll
                    for (int d = 1; d < 64; d <<= 1) { const int n = __shfl_down(v, d); if (lane + d < 64) v += n; }
                    const int a3 = v - tot, a2 = a3 + c3, a1 = a2 + c2, a0 = a1 + c1; const int k = krem[g];
                    int fb = -1, fa = 0, fc = 0;
                    if (a3 < k && a3 + c3 >= k) { fb = 3; fa = a3; fc = c3; }
                    else if (a2 < k && a2 + c2 >= k) { fb = 2; fa = a2; fc = c2; }
                    else if (a1 < k && a1 + c1 >= k) { fb = 1; fa = a1; fc = c1; }
                    else if (a0 < k && a0 + c0 >= k) { fb = 0; fa = a0; fc = c0; }
                    const unsigned long long mk = __ballot(fb >= 0);
                    const int src = (int)__builtin_ctzll(mk | (1ull << 63));
                    const int bin = __shfl(4 * lane + fb, src), above = __shfl(fa, src), cnt = __shfl(fc, src);
                    prefix[g] = (prefix[g] << 8) | (unsigned)bin; krem[g] = k - above;
                    if (pass == npass - 1) { tau[g] = prefix[g]; quota[g] = krem[g]; allsel[g] = (cnt == krem[g]); }
                }
                }
            }
        }
        if (mode == 0 && npass) {
            LDS_WAIT();
#pragma unroll
            for (int g = 0; g < 4; ++g) {
                if (!allsel[g]) {
                    const int n = __shfl(eqs[g & 1], 32 * (g >> 1)), need = quota[g];
                    if (n > 96) { if (lane == 0) *oflag = 1u; }
                    else {
#pragma unroll 1
                        for (int i0 = 0; i0 < n; i0 += 64) {
                            const int i = i0 + lane; const bool act = i < n;
                            const unsigned mi = act ? cand[(g * 96 + i) * 2] : 0u, ki = act ? cand[(g * 96 + i) * 2 + 1] : 0u; int rank = 0;
#pragma unroll 1
                            for (int j = 0; j < n; ++j) { const unsigned mj = cand[(g * 96 + j) * 2], kj = cand[(g * 96 + j) * 2 + 1]; rank += ((mj > mi) || (mj == mi && kj < ki)) ? 1 : 0; }
                            if (act && rank < need) __hip_atomic_fetch_or(maskw + (4 * w + g) * 128 + (ki >> 5), 1u << (ki & 31u), __ATOMIC_RELAXED, __HIP_MEMORY_SCOPE_WORKGROUP);
                        }
                    }
                }
            }
        }
        __syncthreads();
        const unsigned of = *oflag;
        __syncthreads();
        if (mode == 0 && of != 0u) { mode = 1; continue; }
        break;
    }
    __syncthreads();
    {
        const float* sgn = p.dsa_qk_norm + lds_l * 128; float gqm = 0.f, gkm = 0.f;
#pragma unroll 2
        for (int i = 0; i < 64; ++i) { gqm = fmaxf(gqm, fabsf(sgn[i])); gkm = fmaxf(gkm, fabsf(sgn[64 + i])); }
        const float coff = 8.f * gqm * gkm;
        const int cb = w & 3, ksp = w >> 2, ql = 8 * cb + (r32 >> 2), hh = r32 & 3;
        s16x8 qf[4];
        { const bf16* qp = Z + (tokb + qt * 32 + ql) * ZP + 2560 + hh * 64 + 8 * half;
#pragma unroll
          for (int s4 = 0; s4 < 4; ++s4) qf[s4] = *(const s16x8*)(qp + 16 * s4); }
        f32x16 oacc[2];
#pragma unroll
        for (int db = 0; db < 2; ++db)
#pragma unroll
            for (int r = 0; r < 16; ++r) oacc[db][r] = 0.f;
        float lsum = 0.f;
        const int nT = (ntiles + 1) >> 1;
        const int skey = tid >> 3, sseg = tid & 7;
        const float* sgp = ZS + (tokb + skey) * ZSP + sseg * 16;
        f32x4 pr[4];
#pragma unroll
        for (int i = 0; i < 4; ++i) pr[i] = *(const f32x4*)(sgp + 4 * i);
#pragma unroll 1
        for (int tT = 0; tT < nT; ++tT) {
            __syncthreads();
            if (sseg < 4) {
                u32x4 w0, w1; w0.x = pkbf(pr[0][0], pr[0][1]); w0.y = pkbf(pr[0][2], pr[0][3]); w0.z = pkbf(pr[1][0], pr[1][1]); w0.w = pkbf(pr[1][2], pr[1][3]);
                w1.x = pkbf(pr[2][0], pr[2][1]); w1.y = pkbf(pr[2][2], pr[2][3]); w1.z = pkbf(pr[3][0], pr[3][1]); w1.w = pkbf(pr[3][2], pr[3][3]);
                *(LAS u32x4*)(Kd + skey * 72 + sseg * 16) = w0; *(LAS u32x4*)(Kd + skey * 72 + sseg * 16 + 8) = w1;
            } else {
                LAS bf16* vd = VTd + ((sseg - 4) * 16) * 72 + skey;
#pragma unroll
                for (int i = 0; i < 4; ++i) { const unsigned a0 = pkbf(pr[i][0], pr[i][1]), a1 = pkbf(pr[i][2], pr[i][3]);
                    vd[(4 * i) * 72] = (bf16)(a0 & 0xffffu); vd[(4 * i + 1) * 72] = (bf16)(a0 >> 16); vd[(4 * i + 2) * 72] = (bf16)(a1 & 0xffffu); vd[(4 * i + 3) * 72] = (bf16)(a1 >> 16); }
            }
            __syncthreads();
            if (tT + 1 < nT) {
#pragma unroll
                for (int i = 0; i < 4; ++i) pr[i] = *(const f32x4*)(sgp + (size_t)(tT + 1) * 64 * ZSP + 4 * i);
            }
            const int st = 2 * tT + ksp;
            if (st < ntiles) {
                const unsigned mw = maskw[ql * 128 + st];
                f32x16 sacc;
#pragma unroll
                for (int r = 0; r < 16; ++r) sacc[r] = 0.f;
#pragma unroll
                for (int s4 = 0; s4 < 4; ++s4) { const s16x8 ak = *(const LAS s16x8*)(Kd + (32 * ksp + r32) * 72 + 16 * s4 + 8 * half);
                    sacc = __builtin_amdgcn_mfma_f32_32x32x16_bf16(ak, qf[s4], sacc, 0, 0, 0); }
#pragma unroll
                for (int r = 0; r < 16; ++r) { const int kbit = 8 * (r >> 2) + 4 * half + (r & 3); const float pe = ((mw >> kbit) & 1u) ? __expf(sacc[r] - coff) : 0.f; sacc[r] = pe; lsum += pe; }
#pragma unroll
                for (int s2 = 0; s2 < 2; ++s2) {
                    u32x4 wp; wp.x = pkbf(sacc[8 * s2], sacc[8 * s2 + 1]); wp.y = pkbf(sacc[8 * s2 + 2], sacc[8 * s2 + 3]); wp.z = pkbf(sacc[8 * s2 + 4], sacc[8 * s2 + 5]); wp.w = pkbf(sacc[8 * s2 + 6], sacc[8 * s2 + 7]);
                    const s16x8 pf = __builtin_bit_cast(s16x8, wp);
#pragma unroll
                    for (int db = 0; db < 2; ++db) {
                        const LAS bf16* vr = VTd + (db * 32 + r32) * 72 + 32 * ksp + 16 * s2 + 4 * half;
                        const u32x2 v0 = *(const LAS u32x2*)vr, v1 = *(const LAS u32x2*)(vr + 8);
                        const u32x4 vv = (u32x4){v0.x, v0.y, v1.x, v1.y};
                        oacc[db] = __builtin_amdgcn_mfma_f32_32x32x16_bf16(__builtin_bit_cast(s16x8, vv), pf, oacc[db], 0, 0, 0);
                    }
                }
            }
        }
        lsum += __shfl_xor(lsum, 32);
        __syncthreads();
        LAS float* xch = (LAS float*)(lds + 81920) + (w & 3) * (33 * 64);
        if (ksp == 1) {
#pragma unroll
            for (int db = 0; db < 2; ++db)
#pragma unroll
                for (int r = 0; r < 16; ++r) xch[(db * 16 + r) * 64 + lane] = oacc[db][r];
            xch[32 * 64 + lane] = lsum;
        }
        __syncthreads();
        if (ksp == 0) {
            const float is = 1.f / (lsum + xch[32 * 64 + lane]);
            bf16* orow = O3 + (tokb + qt * 32 + ql) * 256 + hh * 64;
#pragma unroll
            for (int db = 0; db < 2; ++db)
#pragma unroll
                for (int g = 0; g < 4; ++g) { const int d0 = db * 32 + 8 * g + 4 * half;
                    const float x0 = (oacc[db][4 * g] + xch[(db * 16 + 4 * g) * 64 + lane]) * is, x1 = (oacc[db][4 * g + 1] + xch[(db * 16 + 4 * g + 1) * 64 + lane]) * is;
                    const float x2 = (oacc[db][4 * g + 2] + xch[(db * 16 + 4 * g + 2) * 64 + lane]) * is, x3 = (oacc[db][4 * g + 3] + xch[(db * 16 + 4 * g + 3) * 64 + lane]) * is;
                    u32x2 wo; wo.x = pkbf(x0, x1); wo.y = pkbf(x2, x3); *(u32x2*)(orow + d0) = wo; }
        }
    }
#undef DSA_SCORES
    __syncthreads();
}

constexpr int Q_ML = 32, Q_DIFF = 512, Q_DSA = 1024, Q_SB = 256, Q_TOTAL = Q_ML + Q_DIFF + Q_DSA + Q_SB;
__device__ __forceinline__ int next_item(unsigned* ctr, LAS int* slot, int wv) {
    __syncthreads();
    if (tid_fresh(wv) == 0) *slot = (int)atomicAdd(ctr, 1u);
    __syncthreads();
    return *slot;
}
__device__ __forceinline__ void mixer_phase1(int l, LAS unsigned char* lds, int wv, int co = 0) {
    LAS int* slot = (LAS int*)(lds + LDS_BYTES - 64);
    { const Params p = load_params(); unsigned* ctr = (unsigned*)(p.ws + WS_CTL) + 64 * (4 * l + 0 + co);
      for (;;) { const int it = next_item(ctr, slot, wv); if (it >= Q_DIFF) break; diffm_item(p, l, it & 31, 15 - (it >> 5), lds, wv); } }
    { const Params p = load_params(); unsigned* ctr = (unsigned*)(p.ws + WS_CTL) + 64 * (4 * l + 1 + co);
      for (;;) { const int it = next_item(ctr, slot, wv); if (it >= 512) break; mlB_item(p, l, it & 31, it >> 5, lds, wv); } }
}
__device__ __forceinline__ void mixer_phase2(int l, LAS unsigned char* lds, int wv, int co = 0) {
    LAS int* slot = (LAS int*)(lds + LDS_BYTES - 64);
    { const Params p = load_params(); unsigned* ctr = (unsigned*)(p.ws + WS_CTL) + 64 * (4 * l + 2 + co);
      for (;;) { const int it = next_item(ctr, slot, wv); if (it >= 32 + Q_DSA) break;
          if (it < 32) mlS_item(p, it, wv); else { const int i = it - 32; dsa_item(p, l, i & 7, 127 - (i >> 3), lds, wv); } } }
}
__device__ __forceinline__ void mixer_phase3(int l, LAS unsigned char* lds, int wv, int co = 0) {
    LAS int* slot = (LAS int*)(lds + LDS_BYTES - 64);
    { const Params p = load_params(); unsigned* ctr = (unsigned*)(p.ws + WS_CTL) + 64 * (4 * l + 3 + co);
      for (;;) { const int it = next_item(ctr, slot, wv); if (it >= 512) break; mlD_item(p, l, it & 31, it >> 5, lds, wv); } }
    { const Params p = load_params(); unsigned* ctr = (unsigned*)(p.ws + WS_CTL) + 64 * (8 + l + co);
      for (;;) { const int it = next_item(ctr, slot, wv); if (it >= Q_SB) break; sb_item(p, it >> 3, it & 7, lds, wv); } }
}

#define XB_TMO      128
#define XB_XCNT(j)  (256  + 64 * (j))
#define XB_XSUB(j)  (1280 + 64 * (j))
#define XB_XGEN(j)  (2304 + 64 * (j))
#define XB_TOP      3328
#define XB_TOPGEN   3392
#define XCD_BAR_WORDS 3456
#define XB_SPIN_CAP (1u << 20)
constexpr int CW_BAR = 8192;
__device__ __forceinline__ unsigned xb_ld(unsigned* p)              { return __hip_atomic_load(p, __ATOMIC_RELAXED, __HIP_MEMORY_SCOPE_AGENT); }
__device__ __forceinline__ unsigned xb_add(unsigned* p, unsigned v) { return __hip_atomic_fetch_add(p, v, __ATOMIC_RELAXED, __HIP_MEMORY_SCOPE_AGENT); }
__device__ __forceinline__ unsigned xb_xcc_id() { return (unsigned)__builtin_amdgcn_s_getreg((3 << 11) | 20) & 0xFu; }
#define XB_SPIN(cond, bar) do { unsigned _sp = 0; while (cond) { __builtin_amdgcn_s_sleep(1); \
    if ((++_sp & 255u) == 0u) { if (xb_ld(&(bar)[XB_TMO])) break; if (_sp > XB_SPIN_CAP) { atomicAdd(&(bar)[XB_TMO], 1u); break; } } } } while (0)
__device__ __forceinline__ void xcd_post(int wv) {
    const Params p = load_params(); unsigned* bar = (unsigned*)(p.ws + WS_CTL) + CW_BAR;
    if (tid_fresh(wv) == 0) (void)xb_add(&bar[XB_XCNT(xb_xcc_id())], 1u);
}
__device__ __forceinline__ void xcd_barrier_complete(unsigned* bar, unsigned x, unsigned& nloc, unsigned& nx) {
    const unsigned G = gridDim.x * gridDim.y * gridDim.z;
    unsigned sum, cnt, mine, sp = 0u;
    for (;;) {
        sum = 0u; cnt = 0u; mine = 0u;
#pragma unroll
        for (unsigned j = 0; j < 16; ++j) { const unsigned c = xb_ld(&bar[XB_XCNT(j)]); sum += c; cnt += (c > 0u) ? 1u : 0u; mine = (j == x) ? c : mine; }
        if (sum == G) break;
        __builtin_amdgcn_s_sleep(1);
        if ((++sp & 255u) == 0u) { if (xb_ld(&bar[XB_TMO])) break; if (sp > XB_SPIN_CAP) { atomicAdd(&bar[XB_TMO], 1u); break; } }
    }
    nloc = mine > 0u ? mine : 1u; nx = cnt > 0u ? cnt : 1u;
}
__device__ __forceinline__ void gsync(LAS unsigned char* lds, int wv) {
    asm volatile("s_waitcnt vmcnt(0)" ::: "memory");
    __syncthreads();
    if (tid_fresh(wv) == 0) {
        const Params p = load_params(); unsigned* bar = (unsigned*)(p.ws + WS_CTL) + CW_BAR;
        volatile LAS unsigned* st = (volatile LAS unsigned*)(lds + LDS_BYTES - 32);
        const unsigned x = xb_xcc_id();
        __builtin_amdgcn_s_waitcnt(0);
        unsigned nloc = st[0], nx = st[1];
        if (nloc == 0u) { xcd_barrier_complete(bar, x, nloc, nx); st[0] = nloc; st[1] = nx; }
        const unsigned old = xb_add(&bar[XB_XSUB(x)], 1u);
        const unsigned gen = old / nloc;
        if (old + 1u == (gen + 1u) * nloc) {
            __builtin_amdgcn_fence(__ATOMIC_RELEASE, "agent");
            asm volatile("s_waitcnt vmcnt(0)" ::: "memory");
            const unsigned og = xb_add(&bar[XB_TOP], 1u);
            const unsigned tg = og / nx;
            if (og + 1u == (tg + 1u) * nx) xb_add(&bar[XB_TOPGEN], 1u);
            else XB_SPIN(xb_ld(&bar[XB_TOPGEN]) == tg, bar);
            __builtin_amdgcn_fence(__ATOMIC_ACQUIRE, "agent");
            xb_add(&bar[XB_XGEN(x)], 1u);
            asm volatile("s_waitcnt vmcnt(0)" ::: "memory");
        } else {
            XB_SPIN(xb_ld(&bar[XB_XGEN(x)]) == gen, bar);
            __builtin_amdgcn_fence(__ATOMIC_ACQUIRE, "agent");
            asm volatile("s_waitcnt vmcnt(0)" ::: "memory");
        }
    }
    __syncthreads();
}

#define PH_LOCALS const Params p = load_params(); const int tid = tid_fresh(wv), lane = tid & 63, wave = tid >> 6; const int gw = (int)blockIdx.x * NWAVES + wave, ngw = (int)gridDim.x * NWAVES; \
    (void)lane; (void)gw; (void)ngw; bf16* HN = (bf16*)(p.ws + WS_HN); bf16* BIGB = (bf16*)(p.ws + WS_BIG); (void)HN; (void)BIGB;
template <int l> __device__ __forceinline__ void layer_body(cg::grid_group& grid, LAS unsigned char* lds, const int wv) {
        { PH_LOCALS const unsigned char* wl = p.ws + WS_W + (size_t)l * WL_STRIDE; EpiSwiglu E{l * 3 + 0}; run_gemm(lds, HN, (const bf16*)(wl + WL_GU1), T, 2 * FF, D, E, wv); }
        gsync(lds, wv);
        { PH_LOCALS const unsigned char* wl = p.ws + WS_W + (size_t)l * WL_STRIDE; EpiResid E{l == 0 ? 1 : 0, 0.5f, l * 3 + 1}; run_gemm(lds, BIGB, (const bf16*)(wl + WL_D1), T, D, FF, E, wv); }
        gsync(lds, wv);
        { PH_LOCALS const unsigned char* wl = p.ws + WS_W + (size_t)l * WL_STRIDE; EpiZ E{l * 3 + 1}; run_gemm(lds, HN, (const bf16*)(wl + WL_INA), T, 3328, D, E, wv); }
        gsync(lds, wv);
        { PH_LOCALS if (gw < 32) ml_prepass(p, l, gw, lane); prep_phase(p, l, gw, ngw, lane); }
        gsync(lds, wv);
        mixer_phase1(l, lds, wv);
#if PROBE_DUP & 1
        gsync(lds, wv); mixer_phase1(l, lds, wv, 16);
#endif
        gsync(lds, wv);
        mixer_phase2(l, lds, wv);
#if PROBE_DUP & 2
        gsync(lds, wv); mixer_phase2(l, lds, wv, 16);
#endif
        gsync(lds, wv);
        mixer_phase3(l, lds, wv);
#if PROBE_DUP & 4
        gsync(lds, wv); mixer_phase3(l, lds, wv, 16);
#endif
        gsync(lds, wv);
#pragma unroll 1
        for (int hb = 0; hb < 2; ++hb) {
            { PH_LOCALS const unsigned char* wl = p.ws + WS_W + (size_t)l * WL_STRIDE; EpiSig E{l * 3 + 1}; run_gemm(lds, HN, (const bf16*)(wl + WL_G) + (size_t)hb * 2 * D * D, T, 2 * D, D, E, wv); }
            gsync(lds, wv);
#pragma unroll 1
            for (int bb = 0; bb < 2; ++bb) {
                PH_LOCALS const unsigned char* wl = p.ws + WS_W + (size_t)l * WL_STRIDE; const int b = hb * 2 + bb;
                EpiGate E{bb * D, b == 0 ? 1 : 0};
                run_gemm(lds, (const bf16*)(p.ws + WS_O + b * OB_STRIDE), (const bf16*)(wl + WL_BR) + (size_t)b * D * 256, T, D, 256, E, wv);
            }
            gsync(lds, wv);
        }
        { PH_LOCALS const unsigned char* wl = p.ws + WS_W + (size_t)l * WL_STRIDE; EpiResid E{0, 1.0f, l * 3 + 2}; run_gemm(lds, (const bf16*)(p.ws + WS_BIG + 128 * MiB), (const bf16*)(wl + WL_OUT), T, D, D, E, wv); }
        gsync(lds, wv);
        { PH_LOCALS const unsigned char* wl = p.ws + WS_W + (size_t)l * WL_STRIDE; EpiSwiglu E{l * 3 + 2}; run_gemm(lds, HN, (const bf16*)(wl + WL_GU2), T, 2 * FF, D, E, wv); }
        gsync(lds, wv);
        { PH_LOCALS const unsigned char* wl = p.ws + WS_W + (size_t)l * WL_STRIDE; EpiResid E{0, 0.5f, (l + 1 < DEPTH) ? (l + 1) * 3 : -1}; run_gemm(lds, BIGB, (const bf16*)(wl + WL_D2), T, D, FF, E, wv); }
        if (l + 1 < DEPTH) gsync(lds, wv);
    }

__global__ void __launch_bounds__(NTHR, 2) hybrid_fwd(Params p_unused) {
    extern __shared__ __attribute__((aligned(16))) unsigned char lds_raw[];
    LAS unsigned char* lds = (LAS unsigned char*)lds_raw;
    cg::grid_group grid = cg::this_grid();
    const int wv = __builtin_amdgcn_readfirstlane((int)threadIdx.x >> 6);
    {
        PH_LOCALS
        SegRun R; R.base = 0; R.gw = gw; R.ngw = ngw; R.lane = lane; R.scr = (LAS float*)(lds + wave * 8704);
        for (int l = 0; l < DEPTH; ++l) convert_weights(p, l, R);
        if (blockIdx.x == 0 && tid < 64) ((unsigned*)(p.ws + WS_CTL))[64 * tid] = 0u;
        if (blockIdx.x == 0) for (int i = tid; i < XCD_BAR_WORDS; i += NTHR) ((unsigned*)(p.ws + WS_CTL))[CW_BAR + i] = 0u;
        if (tid < 8) ((LAS unsigned*)(lds + LDS_BYTES - 32))[tid] = 0u;
        for (int i = gw * 64 + lane; i < 5 * T; i += ngw * 64) { const int a_ = 1 + i / T; rs_ptr(p, a_)[i % T] = 0ull; }
        xb_rows(p.x, HN, rs_ptr(p, 0), gw, ngw, lane);
    }
    grid.sync();
    xcd_post(wv);
    layer_body<0>(grid, lds, wv);
    layer_body<1>(grid, lds, wv);
}

extern "C" void kernel_launch(void* const* d_in, const int* in_sizes, int n_in, void* d_out, int out_size, void* d_ws, size_t ws_size, hipStream_t stream) {
    static int grid = 0;
    if (grid == 0) {
        if (n_in != 20 || out_size != T * D || ws_size < WS_END2) { fprintf(stderr, "kernel_launch: unexpected shapes (n_in %d out %d ws %zu)\n", n_in, out_size, ws_size); grid = -1; return; }
        int dev = 0, cus = 0, per_cu = 0;
        hipGetDevice(&dev); hipDeviceGetAttribute(&cus, hipDeviceAttributeMultiprocessorCount, dev);
        hipFuncSetAttribute((const void*)hybrid_fwd, hipFuncAttributeMaxDynamicSharedMemorySize, LDS_BYTES);
        hipOccupancyMaxActiveBlocksPerMultiprocessor(&per_cu, (const void*)hybrid_fwd, NTHR, LDS_BYTES);
        if (per_cu < 1) { fprintf(stderr, "kernel_launch: occupancy query says %d\n", per_cu); per_cu = 1; }
        (void)hipGetLastError();
        grid = cus * 1;
    }
    if (grid < 0) return;
    Params p{};
    p.x = (const float*)d_in[0]; p.pos = (const int*)d_in[1];
    p.ffn1_norm = (const float*)d_in[2]; p.ffn1_gu = (const float*)d_in[3]; p.ffn1_down = (const float*)d_in[4]; p.mix_norm = (const float*)d_in[5]; p.w_in = (const float*)d_in[6];
    p.diff_qk_norm = (const float*)d_in[7]; p.diff_lambda = (const float*)d_in[8]; p.diff_head_norm = (const float*)d_in[9]; p.ml_conv_w = (const float*)d_in[10]; p.ml_conv_b = (const float*)d_in[11];
    p.ml_gate_bias = (const float*)d_in[12]; p.ml_head_norm = (const float*)d_in[13]; p.dsa_qk_norm = (const float*)d_in[14]; p.w_branch = (const float*)d_in[15]; p.w_out = (const float*)d_in[16];
    p.ffn2_norm = (const float*)d_in[17]; p.ffn2_gu = (const float*)d_in[18]; p.ffn2_down = (const float*)d_in[19];
    p.out = (float*)d_out; p.ws = (unsigned char*)d_ws;
    void* args[] = {&p};
    hipError_t e = hipLaunchCooperativeKernel((const void*)hybrid_fwd, dim3(grid), dim3(NTHR), args, LDS_BYTES, stream);
    if (e != hipSuccess) fprintf(stderr, "cooperative launch failed: %s (grid %d)\n", hipGetErrorString(e), grid);
}
```

```cpp
#include <hip/hip_runtime.h>
#include <hip/hip_cooperative_groups.h>
#include <cstdio>
#include <cstdint>
namespace cg = cooperative_groups;
#ifndef PROBE_DUP
#define PROBE_DUP 0
#endif
namespace pg8 {
#define PG8_LAS __attribute__((address_space(3)))
typedef unsigned short bf16_t;
typedef short bf16x8 __attribute__((ext_vector_type(8)));
typedef float f32x4 __attribute__((ext_vector_type(4)));
typedef unsigned u32x4 __attribute__((ext_vector_type(4)));
constexpr int BM = 256, BK = 64, HALF = 128, HTB = HALF * BK * 2  , STAGE_BYTES = 8 * HTB, NXCD = 8, WGM = 8;

__host__ __device__ __forceinline__ int lds_byte(int r, int c) { const int st = (r >> 4) * 2 + (c >> 5), rr = r & 15, cc = c & 31, ob = rr * 64 + cc * 2; return st * 1024 + (ob ^ (((ob >> 9) & 1) << 5)); }
__host__ __device__ __forceinline__ void stage_rc(int b, int& R, int& C) { const int st = b / 1024, sb = b % 1024, swz = sb ^ (((sb >> 9) & 1) << 5); R = (st >> 1) * 16 + swz / 64; C = (st & 1) * 32 + (swz % 64) / 2; }
__host__ __device__ __forceinline__ int perm32(int rho) { const int n = rho >> 4, i = rho & 15; return 8 * (i >> 2) + 4 * n + (i & 3); }

struct Unit { int pm, pn; };
struct Gemm { const bf16_t* A; const bf16_t* Bt; int M, N, K; };

struct StaticOrder {
    int nM, nN, nwg, G, c;
    __host__ __device__ void init(int M, int N, int G_, int c_) { nM = M / BM; nN = N / BM; nwg = nM * nN; G = G_; c = c_; }
    __host__ __device__ bool next(int i, Unit& u) const {
        const long L = (long)i * G + c; if (L >= nwg) return false;
        int wgid = (int)L; { const int q = nwg / NXCD, r = nwg % NXCD, xcd = wgid % NXCD, off = wgid / NXCD; wgid = (xcd < r ? xcd * (q + 1) : r * (q + 1) + (xcd - r) * q) + off; }
        const int nig = WGM * nN, gid = wgid / nig, fm = gid * WGM, gsz = (nM - fm) < WGM ? (nM - fm) : WGM;
        u.pm = fm + ((wgid % nig) % gsz); u.pn = (wgid % nig) / gsz; return true;
    }
    __device__ __forceinline__ void a_ready(const Unit&) const {}
    __device__ __forceinline__ void done(const Unit&) const {}
};

__device__ __forceinline__ unsigned cvt_pk_bf16(float lo, float hi) { unsigned r; asm volatile("v_cvt_pk_bf16_f32 %0, %1, %2" : "=v"(r) : "v"(lo), "v"(hi)); return r; }
template <class Epi, class Sched, bool ALIGN_EPI = false, bool SP2 = false>
__device__ __forceinline__ void gemm_phase(PG8_LAS unsigned char* lds, const Gemm g, const Sched& S, const Epi& E, const int wave_in) {
    unsigned z_ = 0u; asm volatile("" : "+v"(z_)); int w_ = wave_in; asm volatile("" : "+s"(w_));
    const int tid_ = w_ * 64 + (int)__builtin_amdgcn_mbcnt_hi(~0u, __builtin_amdgcn_mbcnt_lo(~0u, z_));
    const int tid = tid_, wid = __builtin_amdgcn_readfirstlane(tid >> 6), lane = tid & 63, wr = wid >> 2, wc = wid & 3, fr = lane & 15, fq = lane >> 4;
    const int K = g.K, nt = K / BK;
    unsigned voffA[2], voffB[2];
#pragma unroll
    for (int i = 0; i < 2; ++i) { int R, C; stage_rc(tid * 16 + i * 8192, R, C); const int Rb = Epi::PERM ? ((R & ~31) + perm32(R & 31)) : R;
        voffA[i] = (unsigned)(R * K + C) * 2u; voffB[i] = (unsigned)(Rb * K + C) * 2u; }
    const size_t kstep = (size_t)(BK * 2);
    const size_t hstep = (size_t)HALF * K * 2;
    const size_t tstep = 2 * hstep;
    const unsigned ldsw = (unsigned)wid * 1024u;
    const int aoff = lds_byte(wr * 64 + fr, fq * 8), boff = lds_byte(wc * 32 + fr, fq * 8);
#define PG8_SA(b, h) (((b) * 2 + (h)) * HTB)
#define PG8_SB(b, h) ((4 + (b) * 2 + (h)) * HTB)
#define PG8_STAGE(bufoff, gbase, voff) do { _Pragma("unroll") for (int _i = 0; _i < 2; ++_i) \
        __builtin_amdgcn_global_load_lds((const unsigned*)((const char*)(gbase) + (voff)[_i]), (PG8_LAS unsigned*)(lds + (bufoff) + ldsw + _i * 8192), 16, 0, 0); } while (0)
#define PG8_LDA(dst, b, h) do { _Pragma("unroll") for (int m = 0; m < 4; ++m) _Pragma("unroll") for (int k = 0; k < 2; ++k) dst[m][k] = *(const PG8_LAS bf16x8*)(lds + PG8_SA(b, h) + aoff + m * 2048 + k * 1024); } while (0)
#define PG8_LDB(dst, b, h) do { _Pragma("unroll") for (int n = 0; n < 2; ++n) _Pragma("unroll") for (int k = 0; k < 2; ++k) dst[n][k] = *(const PG8_LAS bf16x8*)(lds + PG8_SB(b, h) + boff + n * 2048 + k * 1024); } while (0)
#define PG8_MMA(ai, bj, At, Bt) do { __builtin_amdgcn_s_setprio(1); _Pragma("unroll") for (int m = 0; m < 4; ++m) _Pragma("unroll") for (int n = 0; n < 2; ++n) _Pragma("unroll") for (int k = 0; k < 2; ++k) \
        acc[ai][bj][m][n] = __builtin_amdgcn_mfma_f32_16x16x32_bf16(Bt[n][k], At[m][k], acc[ai][bj][m][n], 0, 0, 0); __builtin_amdgcn_s_setprio(0); } while (0)
#define PG8_WAIT_V(n) asm volatile("s_waitcnt vmcnt(" #n ")" ::: "memory")
#define PG8_WAIT_L(n) asm volatile("s_waitcnt lgkmcnt(" #n ")" ::: "memory")
#define PG8_BAR __builtin_amdgcn_s_barrier()
#define PG8_SCHED __builtin_amdgcn_sched_barrier(0)
    Unit cur, nxt; int ui = 0;
    if (!S.next(0, cur)) return;
    f32x4 acc[2][2][4][2];
#pragma unroll
    for (int a = 0; a < 2; ++a)
#pragma unroll
        for (int b = 0; b < 2; ++b)
#pragma unroll
            for (int m = 0; m < 4; ++m)
#pragma unroll
                for (int n = 0; n < 2; ++n) acc[a][b][m][n] = (f32x4){0.f, 0.f, 0.f, 0.f};
    bf16x8 At[4][2], B0[2][2], B1[2][2];
    const char* cA = (const char*)g.A + (size_t)cur.pm * tstep; const char* cB = (const char*)g.Bt + (size_t)cur.pn * tstep;
    S.a_ready(cur);
    if constexpr (SP2) {
        PG8_STAGE(PG8_SB(0, 0), cB, voffB); PG8_STAGE(PG8_SB(0, 1), cB + hstep, voffB); PG8_STAGE(PG8_SA(0, 0), cA, voffA); PG8_STAGE(PG8_SA(0, 1), cA + hstep, voffA);
        if (wr == 1) PG8_BAR;
        PG8_WAIT_V(2); PG8_BAR;
        PG8_STAGE(PG8_SB(1, 0), cB + kstep, voffB); PG8_STAGE(PG8_SA(1, 0), cA + kstep, voffA); PG8_STAGE(PG8_SB(1, 1), cB + hstep + kstep, voffB);
        PG8_WAIT_V(6); PG8_BAR;
    } else {
        PG8_STAGE(PG8_SB(0, 0), cB, voffB); PG8_STAGE(PG8_SA(0, 0), cA, voffA); PG8_STAGE(PG8_SB(0, 1), cB + hstep, voffB); PG8_STAGE(PG8_SA(0, 1), cA + hstep, voffA);
        if (wr == 1) PG8_BAR;
        PG8_WAIT_V(4); PG8_BAR;
        PG8_STAGE(PG8_SB(1, 0), cB + kstep, voffB); PG8_STAGE(PG8_SA(1, 0), cA + kstep, voffA); PG8_STAGE(PG8_SB(1, 1), cB + hstep + kstep, voffB);
        PG8_WAIT_V(6); PG8_BAR;
    }
    for (;;) {
        const bool has_next = S.next(ui + 1, nxt);
        const char* nA = has_next ? (const char*)g.A + (size_t)nxt.pm * tstep : cA; const char* nB = has_next ? (const char*)g.Bt + (size_t)nxt.pn * tstep : cB;
        for (int t = 0; t < nt; t += 2) {
            const bool last = (t == nt - 2);
            const char* a1 = cA + (size_t)(t + 1) * kstep;
            const char* a2 = last ? nA : cA + (size_t)(t + 2) * kstep; const char* b2 = last ? nB : cB + (size_t)(t + 2) * kstep;
            const char* a3 = a2 + kstep; const char* b3 = b2 + kstep;
            if (last && has_next) S.a_ready(nxt);
            if constexpr (SP2) {
            PG8_LDB(B0, 0, 0); PG8_LDB(B1, 0, 1); PG8_SCHED; PG8_LDA(At, 0, 0); PG8_STAGE(PG8_SA(1, 1), a1 + hstep, voffA);
            PG8_WAIT_V(8); PG8_WAIT_L(0); PG8_BAR; PG8_MMA(0, 0, At, B0); PG8_MMA(0, 1, At, B1); PG8_BAR; PG8_SCHED;
            PG8_LDA(At, 0, 1); PG8_STAGE(PG8_SB(0, 0), b2, voffB); PG8_STAGE(PG8_SB(0, 1), b2 + hstep, voffB); PG8_STAGE(PG8_SA(0, 0), a2, voffA);
            PG8_WAIT_V(8); PG8_WAIT_L(0); PG8_BAR; PG8_MMA(1, 0, At, B0); PG8_MMA(1, 1, At, B1); PG8_BAR; PG8_SCHED;
            PG8_LDB(B0, 1, 0); PG8_LDB(B1, 1, 1); PG8_SCHED; PG8_LDA(At, 1, 0); PG8_STAGE(PG8_SA(0, 1), a2 + hstep, voffA);
            PG8_WAIT_V(8); PG8_WAIT_L(0); PG8_BAR; PG8_MMA(0, 0, At, B0); PG8_MMA(0, 1, At, B1); PG8_BAR; PG8_SCHED;
            PG8_LDA(At, 1, 1); PG8_STAGE(PG8_SB(1, 0), b3, voffB); PG8_STAGE(PG8_SB(1, 1), b3 + hstep, voffB); PG8_STAGE(PG8_SA(1, 0), a3, voffA);
            PG8_WAIT_V(8); PG8_WAIT_L(0); PG8_BAR; PG8_MMA(1, 0, At, B0); PG8_MMA(1, 1, At, B1); PG8_BAR; PG8_SCHED;
            } else {
            PG8_LDB(B0, 0, 0); PG8_SCHED; PG8_LDA(At, 0, 0); PG8_STAGE(PG8_SA(1, 1), a1 + hstep, voffA);
            PG8_WAIT_L(8); PG8_BAR; PG8_WAIT_L(0); PG8_MMA(0, 0, At, B0); PG8_BAR; PG8_SCHED;
            PG8_LDB(B1, 0, 1); PG8_STAGE(PG8_SB(0, 0), b2, voffB);
            PG8_BAR; PG8_WAIT_L(0); PG8_MMA(0, 1, At, B1); PG8_BAR;
            PG8_LDA(At, 0, 1); PG8_STAGE(PG8_SA(0, 0), a2, voffA);
            PG8_BAR; PG8_WAIT_L(0); PG8_MMA(1, 0, At, B0); PG8_BAR; PG8_SCHED;
            PG8_STAGE(PG8_SB(0, 1), b2 + hstep, voffB);
            PG8_WAIT_V(6); PG8_BAR; PG8_MMA(1, 1, At, B1); PG8_BAR;
            PG8_LDB(B0, 1, 0); PG8_SCHED; PG8_LDA(At, 1, 0); PG8_STAGE(PG8_SA(0, 1), a2 + hstep, voffA);
            PG8_WAIT_L(8); PG8_BAR; PG8_WAIT_L(0); PG8_MMA(0, 0, At, B0); PG8_BAR; PG8_SCHED;
            PG8_LDB(B1, 1, 1); PG8_STAGE(PG8_SB(1, 0), b3, voffB);
            PG8_BAR; PG8_WAIT_L(0); PG8_MMA(0, 1, At, B1); PG8_BAR;
            PG8_LDA(At, 1, 1); PG8_STAGE(PG8_SA(1, 0), a3, voffA);
            PG8_BAR; PG8_WAIT_L(0); PG8_MMA(1, 0, At, B0); PG8_BAR; PG8_SCHED;
            PG8_STAGE(PG8_SB(1, 1), b3 + hstep, voffB);
            PG8_WAIT_V(6); PG8_BAR; PG8_MMA(1, 1, At, B1); PG8_BAR;
            }
        }
        if constexpr (ALIGN_EPI) { if (wr == 0) PG8_BAR; }
        if constexpr (!Epi::AFTER_DRAIN) { E(acc, cur, wr, wc, fr, fq); S.done(cur); }
        if (!has_next) break;
#pragma unroll
        for (int a = 0; a < 2; ++a)
#pragma unroll
            for (int b = 0; b < 2; ++b)
#pragma unroll
                for (int m = 0; m < 4; ++m)
#pragma unroll
                    for (int n = 0; n < 2; ++n) acc[a][b][m][n] = (f32x4){0.f, 0.f, 0.f, 0.f};
        cur = nxt; cA = nA; cB = nB; ++ui;
        if constexpr (ALIGN_EPI) { if (wr == 1) PG8_BAR; }
    }
    PG8_WAIT_V(0);
    if constexpr (!ALIGN_EPI) { if (wr == 0) PG8_BAR; }
    PG8_BAR;
    if constexpr (Epi::AFTER_DRAIN) { E.fused(acc, cur, wr, wc, fr, fq, lds, wid, lane); S.done(cur); }
#undef PG8_SA
#undef PG8_SB
#undef PG8_STAGE
#undef PG8_LDA
#undef PG8_LDB
#undef PG8_MMA
#undef PG8_WAIT_V
#undef PG8_WAIT_L
#undef PG8_BAR
#undef PG8_SCHED
}
}
#define LAS __attribute__((address_space(3)))
typedef unsigned short bf16;
typedef float f32x4 __attribute__((ext_vector_type(4)));
typedef float f32x16 __attribute__((ext_vector_type(16)));
typedef unsigned u32x4 __attribute__((ext_vector_type(4)));
typedef unsigned u32x2 __attribute__((ext_vector_type(2)));
typedef short s16x8 __attribute__((ext_vector_type(8)));

constexpr int NB = 8, SEQ = 4096, T = NB * SEQ, D = 1024, FF = 2816, DEPTH = 2, NIN = 7344, ZP = 3072, ZSP = 256;
constexpr int NTHR = 512, NWAVES = 8;
__host__ __device__ constexpr int col_dq(int l) { return l ? 2048 : 0; }
__host__ __device__ constexpr int col_dk(int l) { return l ? 2304 : 256; }
__host__ __device__ constexpr int col_sbk(int l) { return l ? 0 : 2048; }
constexpr int LDS_BYTES = 147456;
constexpr float EPS = 1e-6f;

constexpr size_t MiB = (size_t)1 << 20;
constexpr size_t WS_CTL = 0;
constexpr size_t WS_W = 1 * MiB, WL_STRIDE = 52 * MiB;
constexpr size_t WL_GU1 = 0, WL_D1 = 11534336, WL_INA = 17301504, WL_G = 24117248, WL_BR = 32505856, WL_OUT = 34603008, WL_GU2 = 36700160, WL_D2 = 48234496;
constexpr size_t WS_HN = 106 * MiB, WS_BIG = 170 * MiB, WS_ZS = 362 * MiB, WS_O = 394 * MiB, WS_IK = 458 * MiB, WS_END = 460 * MiB;
constexpr size_t OB_STRIDE = (size_t)T * 256 * 2;

struct Params {
    const float* x; const int* pos;
    const float *ffn1_norm, *ffn1_gu, *ffn1_down, *mix_norm, *w_in, *diff_qk_norm, *diff_lambda, *diff_head_norm, *ml_conv_w, *ml_conv_b, *ml_gate_bias, *ml_head_norm,
        *dsa_qk_norm, *w_branch, *w_out, *ffn2_norm, *ffn2_gu, *ffn2_down;
    float* out; unsigned char* ws;
};

__device__ __forceinline__ unsigned f2bf(float f) { unsigned u = __float_as_uint(f); return (u + 0x7fffu + ((u >> 16) & 1u)) >> 16; }
__device__ __forceinline__ unsigned pk2(float lo, float hi) { unsigned r; asm("v_cvt_pk_bf16_f32 %0, %1, %2" : "=v"(r) : "v"(lo), "v"(hi)); return r; }
__device__ __forceinline__ float bflo(unsigned w) { return __uint_as_float(w << 16); }
__device__ __forceinline__ float bfhi(unsigned w) { return __uint_as_float(w & 0xffff0000u); }
__device__ __forceinline__ float wave_sum(float v) {
#pragma unroll
    for (int o = 1; o < 64; o <<= 1) v += __shfl_xor(v, o);
    return v;
}
__device__ __forceinline__ float wave_max(float v) {
#pragma unroll
    for (int o = 1; o < 64; o <<= 1) v = fmaxf(v, __shfl_xor(v, o));
    return v;
}
__device__ __forceinline__ int lane_fresh() { unsigned z = 0u; asm volatile("" : "+v"(z)); return (int)__builtin_amdgcn_mbcnt_hi(~0u, __builtin_amdgcn_mbcnt_lo(~0u, z)); }
__device__ __forceinline__ int tid_fresh(int wv) { int w = wv; asm volatile("" : "+s"(w)); return w * 64 + lane_fresh(); }
#define LDS_WAIT() asm volatile("s_waitcnt lgkmcnt(0)" ::: "memory")
__device__ __forceinline__ float sigmoidf_(float x) { return 1.f / (1.f + __expf(-x)); }

__device__ __forceinline__ Params load_params() {
#if defined(__HIP_DEVICE_COMPILE__)
    const __attribute__((address_space(4))) Params* pp = (const __attribute__((address_space(4))) Params*)__builtin_amdgcn_kernarg_segment_ptr();
    asm volatile("" : "+s"(pp));
    Params r;
    r.x = pp->x; r.pos = pp->pos; r.ffn1_norm = pp->ffn1_norm; r.ffn1_gu = pp->ffn1_gu; r.ffn1_down = pp->ffn1_down; r.mix_norm = pp->mix_norm; r.w_in = pp->w_in; r.diff_qk_norm = pp->diff_qk_norm;
    r.diff_lambda = pp->diff_lambda; r.diff_head_norm = pp->diff_head_norm; r.ml_conv_w = pp->ml_conv_w; r.ml_conv_b = pp->ml_conv_b; r.ml_gate_bias = pp->ml_gate_bias; r.ml_head_norm = pp->ml_head_norm;
    r.dsa_qk_norm = pp->dsa_qk_norm; r.w_branch = pp->w_branch; r.w_out = pp->w_out; r.ffn2_norm = pp->ffn2_norm; r.ffn2_gu = pp->ffn2_gu; r.ffn2_down = pp->ffn2_down; r.out = pp->out; r.ws = pp->ws;
    return r;
#else
    return Params{};
#endif
}
typedef unsigned long long u64_t;
__device__ __forceinline__ u64_t* rs_ptr(const Params& p, int idx) { return (u64_t*)(p.ws + (idx < 3 ? (WS_CTL + 131072) : (105 * MiB))) + (size_t)(idx % 3) * T; }
__device__ __forceinline__ float row_rstd(const u64_t* rs, int row) { return 1.f / sqrtf((float)rs[row] * (1.f / (16777216.f * D)) + EPS); }
struct EpiSwiglu {
    static constexpr bool PERM = true, AFTER_DRAIN = false;
    int rsi;
    __device__ __forceinline__ void operator()(const f32x4 (&acc)[2][2][4][2], const pg8::Unit& u, int wr, int wc, int fr_in, int fq_in) const {
        const int ln_ = lane_fresh(); const int fr = ln_ & 15, fq = ln_ >> 4; (void)fr_in; (void)fq_in;
        const Params p = load_params(); bf16* O = (bf16*)(p.ws + WS_BIG); const u64_t* rs = rs_ptr(p, rsi);
        const int row0 = u.pm * 256 + wr * 64 + fr, col0 = u.pn * 128 + wc * 32 + 8 * fq;
#pragma unroll
        for (int ai = 0; ai < 2; ++ai)
#pragma unroll
            for (int m = 0; m < 4; ++m) {
                const int row = row0 + ai * 128 + m * 16; const float rr = row_rstd(rs, row);
                bf16* rowp = O + (size_t)row * FF + col0;
                float r[8];
#pragma unroll
                for (int n = 0; n < 2; ++n)
#pragma unroll
                    for (int j = 0; j < 4; ++j) { const float g = acc[ai][0][m][n][j] * rr, uu = acc[ai][1][m][n][j] * rr; r[4 * n + j] = g * sigmoidf_(g) * uu; }
                u32x4 w; w.x = pk2(r[0], r[1]); w.y = pk2(r[2], r[3]); w.z = pk2(r[4], r[5]); w.w = pk2(r[6], r[7]);
                *(u32x4*)rowp = w;
            }
    }
};
struct EpiResid {
    static constexpr bool PERM = true, AFTER_DRAIN = false;
    int base_is_x; float scale; int rsi;
    __device__ __forceinline__ void operator()(const f32x4 (&acc)[2][2][4][2], const pg8::Unit& u, int wr, int wc, int fr_in, int fq_in) const {
        const int ln_ = lane_fresh(); const int fr = ln_ & 15, fq = ln_ >> 4; (void)fr_in; (void)fq_in;
        const Params p = load_params(); const float* base = base_is_x ? p.x : p.out; float* out = p.out; bf16* XB = (rsi >= 0) ? (bf16*)(p.ws + WS_HN) : (bf16*)nullptr; u64_t* rs = rs_ptr(p, rsi >= 0 ? rsi : 0);
        const int row0 = u.pm * 256 + wr * 64 + fr, col0 = u.pn * 256 + wc * 32 + 8 * fq;
#pragma unroll
        for (int ai = 0; ai < 2; ++ai)
#pragma unroll
            for (int m = 0; m < 4; ++m) {
                const int row = row0 + ai * 128 + m * 16; const size_t ro = (size_t)row * D + col0; float ss = 0.f;
#pragma unroll
                for (int bj = 0; bj < 2; ++bj) {
                    const f32x4 v0 = *(const f32x4*)(base + ro + bj * 128) + acc[ai][bj][m][0] * scale, v1 = *(const f32x4*)(base + ro + bj * 128 + 4) + acc[ai][bj][m][1] * scale;
                    *(f32x4*)(out + ro + bj * 128) = v0; *(f32x4*)(out + ro + bj * 128 + 4) = v1;
                    if (XB) { u32x4 w; w.x = pk2(v0[0], v0[1]); w.y = pk2(v0[2], v0[3]); w.z = pk2(v1[0], v1[1]); w.w = pk2(v1[2], v1[3]); *(u32x4*)(XB + ro + bj * 128) = w;
                        ss += (v0[0] * v0[0] + v0[1] * v0[1]) + (v0[2] * v0[2] + v0[3] * v0[3]) + (v1[0] * v1[0] + v1[1] * v1[1]) + (v1[2] * v1[2] + v1[3] * v1[3]); }
                }
                if (XB) { ss += __shfl_xor(ss, 16); ss += __shfl_xor(ss, 32); if (fq == 0) atomicAdd(rs + row, (u64_t)(ss * 16777216.f)); }
            }
    }
};
struct EpiZ {
    static constexpr bool PERM = true, AFTER_DRAIN = false;
    int rsi;
    __device__ __forceinline__ void operator()(const f32x4 (&acc)[2][2][4][2], const pg8::Unit& u, int wr, int wc, int fr_in, int fq_in) const {
        const int ln_ = lane_fresh(); const int fr = ln_ & 15, fq = ln_ >> 4; (void)fr_in; (void)fq_in;
        const Params p = load_params(); bf16* Z = (bf16*)(p.ws + WS_BIG); float* ZS = (float*)(p.ws + WS_ZS); const u64_t* rs = rs_ptr(p, rsi);
        const int row0 = u.pm * 256 + wr * 64 + fr, cw = wc * 32 + 8 * fq;
        if (u.pn < 12) {
#pragma unroll
            for (int ai = 0; ai < 2; ++ai)
#pragma unroll
                for (int m = 0; m < 4; ++m) {
                    const int row = row0 + ai * 128 + m * 16; const float rr = row_rstd(rs, row);
                    bf16* rowp = Z + (size_t)row * ZP + u.pn * 256 + cw;
#pragma unroll
                    for (int bj = 0; bj < 2; ++bj) { const f32x4 v0 = acc[ai][bj][m][0] * rr, v1 = acc[ai][bj][m][1] * rr;
                        u32x4 w; w.x = pk2(v0[0], v0[1]); w.y = pk2(v0[2], v0[3]); w.z = pk2(v1[0], v1[1]); w.w = pk2(v1[2], v1[3]);
                        *(u32x4*)(rowp + bj * 128) = w; }
                }
        } else {
#pragma unroll
            for (int ai = 0; ai < 2; ++ai)
#pragma unroll
                for (int m = 0; m < 4; ++m) {
                    const int row = row0 + ai * 128 + m * 16; const float rr = row_rstd(rs, row);
                    float* rowp = ZS + (size_t)row * ZSP + cw;
#pragma unroll
                    for (int bj = 0; bj < 2; ++bj)
#pragma unroll
                        for (int n = 0; n < 2; ++n) *(f32x4*)(rowp + bj * 128 + 4 * n) = acc[ai][bj][m][n] * rr;
                }
        }
    }
};
struct EpiSig {
    static constexpr bool PERM = true, AFTER_DRAIN = false;
    int rsi;
    __device__ __forceinline__ void operator()(const f32x4 (&acc)[2][2][4][2], const pg8::Unit& u, int wr, int wc, int fr_in, int fq_in) const {
        const int ln_ = lane_fresh(); const int fr = ln_ & 15, fq = ln_ >> 4; (void)fr_in; (void)fq_in;
        const Params p = load_params(); bf16* SG = (bf16*)(p.ws + WS_BIG); const u64_t* rs = rs_ptr(p, rsi);
        const int row0 = u.pm * 256 + wr * 64 + fr, col0 = u.pn * 256 + wc * 32 + 8 * fq;
#pragma unroll
        for (int ai = 0; ai < 2; ++ai)
#pragma unroll
            for (int m = 0; m < 4; ++m) {
                const int row = row0 + ai * 128 + m * 16; const float rr = row_rstd(rs, row);
                bf16* rowp = SG + (size_t)row * (2 * D) + col0;
#pragma unroll
                for (int bj = 0; bj < 2; ++bj) { const f32x4 v0 = acc[ai][bj][m][0] * rr, v1 = acc[ai][bj][m][1] * rr;
                    u32x4 w; w.x = pk2(sigmoidf_(v0[0]), sigmoidf_(v0[1])); w.y = pk2(sigmoidf_(v0[2]), sigmoidf_(v0[3]));
                    w.z = pk2(sigmoidf_(v1[0]), sigmoidf_(v1[1])); w.w = pk2(sigmoidf_(v1[2]), sigmoidf_(v1[3]));
                    *(u32x4*)(rowp + bj * 128) = w; }
            }
    }
};
struct EpiGate {
    static constexpr bool PERM = true, AFTER_DRAIN = false;
    int sgoff; int first;
    __device__ __forceinline__ void operator()(const f32x4 (&acc)[2][2][4][2], const pg8::Unit& u, int wr, int wc, int fr_in, int fq_in) const {
        const int ln_ = lane_fresh(); const int fr = ln_ & 15, fq = ln_ >> 4; (void)fr_in; (void)fq_in;
        const Params p = load_params(); const bf16* SG = (const bf16*)(p.ws + WS_BIG); bf16* YB = (bf16*)(p.ws + WS_BIG + 128 * MiB);
        const int row0 = u.pm * 256 + wr * 64 + fr, col0 = u.pn * 256 + wc * 32 + 8 * fq;
#pragma unroll
        for (int ai = 0; ai < 2; ++ai)
#pragma unroll
            for (int m = 0; m < 4; ++m) {
                const int row = row0 + ai * 128 + m * 16; const size_t ro = (size_t)row * D + col0, so = (size_t)row * (2 * D) + sgoff + col0;
#pragma unroll
                for (int bj = 0; bj < 2; ++bj) {
                    const u32x4 sg = *(const u32x4*)(SG + so + bj * 128);
                    f32x4 v0 = (f32x4){bflo(sg.x), bfhi(sg.x), bflo(sg.y), bfhi(sg.y)} * acc[ai][bj][m][0], v1 = (f32x4){bflo(sg.z), bfhi(sg.z), bflo(sg.w), bfhi(sg.w)} * acc[ai][bj][m][1];
                    if (!first) { const u32x4 y = *(const u32x4*)(YB + ro + bj * 128);
                        v0 = v0 + (f32x4){bflo(y.x), bfhi(y.x), bflo(y.y), bfhi(y.y)}; v1 = v1 + (f32x4){bflo(y.z), bfhi(y.z), bflo(y.w), bfhi(y.w)}; }
                    u32x4 w; w.x = pk2(v0[0], v0[1]); w.y = pk2(v0[2], v0[3]); w.z = pk2(v1[0], v1[1]); w.w = pk2(v1[2], v1[3]); *(u32x4*)(YB + ro + bj * 128) = w;
                }
            }
    }
};

template <class Epi>
__device__ __forceinline__ void run_gemm(LAS unsigned char* lds, const bf16* A, const bf16* Bt, int M, int N, int K, const Epi& E, int wv) {
    pg8::Gemm g{A, Bt, M, N, K}; pg8::StaticOrder S; S.init(M, N, (int)gridDim.x, (int)blockIdx.x);
    pg8::gemm_phase<Epi, pg8::StaticOrder, true, true>((PG8_LAS unsigned char*)lds, g, S, E, wv);
}

__device__ __forceinline__ void tr_item(const float* W, int K, int srcN, int c0, int nv, bf16* WT, int r0, int k0, LAS float* scr, int lane, const float* gain) {
    const int c = lane & 31;
#pragma unroll 8
    for (int i = 0; i < 32; ++i) { const int kk = 2 * i + (lane >> 5); scr[kk * 33 + c] = (c < nv) ? W[(size_t)(k0 + kk) * srcN + c0 + c] * (gain ? gain[k0 + kk] : 1.f) : 0.f; }
    LDS_WAIT();
    const int c8 = lane & 7;
#pragma unroll
    for (int j = 0; j < 4; ++j) { const int n = (lane >> 3) + 8 * j; const LAS float* s = scr + (8 * c8) * 33 + n;
        u32x4 o; o.x = pk2(s[0 * 33], s[1 * 33]); o.y = pk2(s[2 * 33], s[3 * 33]); o.z = pk2(s[4 * 33], s[5 * 33]); o.w = pk2(s[6 * 33], s[7 * 33]);
        if (n < nv) *(u32x4*)(WT + (size_t)(r0 + n) * K + k0 + 8 * c8) = o; }
    LDS_WAIT();
}
struct SegRun { int base, gw, ngw, lane; LAS float* scr; };
__device__ __forceinline__ void run_seg(SegRun& R, const float* W, int K, int srcN, int c0, int ncols, bf16* WT, int r0, const float* gain = nullptr) {
    const int nblk = (ncols + 31) >> 5, nitems = (K >> 6) * nblk;
    int first = (R.gw - (R.base % R.ngw) + R.ngw) % R.ngw;
    for (int it = first; it < nitems; it += R.ngw) { const int kb = it / nblk, nb = it - kb * nblk; const int nv = min(32, ncols - nb * 32);
        tr_item(W, K, srcN, c0 + nb * 32, nv, WT, r0 + nb * 32, kb * 64, R.scr, R.lane, gain); }
    R.base += nitems;
}
__device__ __forceinline__ void convert_weights(const Params& p, int l, SegRun& R) {
    unsigned char* wl = p.ws + WS_W + (size_t)l * WL_STRIDE;
    for (int f = 0; f < 2; ++f) {
        const float* gu = (f ? p.ffn2_gu : p.ffn1_gu) + (size_t)l * D * 2 * FF; bf16* gut = (bf16*)(wl + (f ? WL_GU2 : WL_GU1));
        const float* gn = (f ? p.ffn2_norm : p.ffn1_norm) + l * D;
        for (int sg = 0; sg < 44; ++sg) run_seg(R, gu, D, 2 * FF, sg * 128, 128, gut, (sg % 22) * 256 + (sg / 22) * 128, gn);
        const float* dn = (f ? p.ffn2_down : p.ffn1_down) + (size_t)l * FF * D; bf16* dnt = (bf16*)(wl + (f ? WL_D2 : WL_D1));
        run_seg(R, dn, FF, D, 0, D, dnt, 0);
    }
    const float* wi = p.w_in + (size_t)l * D * NIN; bf16* ina = (bf16*)(wl + WL_INA);
    run_seg(R, wi, D, NIN, 0, 256, ina, col_dq(l), p.mix_norm + l * D);
    run_seg(R, wi, D, NIN, 256, 256, ina, col_dk(l), p.mix_norm + l * D);
    run_seg(R, wi, D, NIN, 512, 256, ina, 512, p.mix_norm + l * D);
    run_seg(R, wi, D, NIN, 768, 512, ina, 768, p.mix_norm + l * D);
    run_seg(R, wi, D, NIN, 1280, 256, ina, 1280, p.mix_norm + l * D);
    run_seg(R, wi, D, NIN, 1544, 256, ina, 1536, p.mix_norm + l * D);
    run_seg(R, wi, D, NIN, 1800, 256, ina, 1792, p.mix_norm + l * D);
    run_seg(R, wi, D, NIN, 2056, 256, ina, col_sbk(l), p.mix_norm + l * D);
    run_seg(R, wi, D, NIN, 2312, 256, ina, col_sbk(l) + 256, p.mix_norm + l * D);
    run_seg(R, wi, D, NIN, 2568, 256, ina, 2560, p.mix_norm + l * D);
    run_seg(R, wi, D, NIN, 2952, 256, ina, 2816, p.mix_norm + l * D);
    run_seg(R, wi, D, NIN, 2824, 128, ina, 3072, p.mix_norm + l * D);
    run_seg(R, wi, D, NIN, 3208, 40, ina, 3200, p.mix_norm + l * D);
    run_seg(R, wi, D, NIN, 1536, 8, ina, 3240, p.mix_norm + l * D);
    run_seg(R, wi, D, NIN, 3248, 4096, (bf16*)(wl + WL_G), 0, p.mix_norm + l * D);
    for (int b = 0; b < 4; ++b) run_seg(R, p.w_branch + ((size_t)l * 4 + b) * 256 * D, 256, D, 0, D, (bf16*)(wl + WL_BR) + (size_t)b * D * 256, 0);
    run_seg(R, p.w_out + (size_t)l * D * D, D, D, 0, D, (bf16*)(wl + WL_OUT), 0);
    for (int i = R.gw * 64 + R.lane; i < 80 * 128; i += R.ngw * 64) *((u32x4*)(ina + (size_t)3248 * D) + i) = (u32x4){0u, 0u, 0u, 0u};
}

__device__ __forceinline__ void xb_rows(const float* X, bf16* XB, u64_t* rs, int gw, int ngw, int lane) {
    for (int m = gw; m < T; m += ngw) {
        const f32x4* xr = (const f32x4*)(X + (size_t)m * D) + lane;
        f32x4 v[4]; float s = 0.f;
#pragma unroll
        for (int j = 0; j < 4; ++j) { v[j] = xr[64 * j]; s += (v[j].x * v[j].x + v[j].y * v[j].y) + (v[j].z * v[j].z + v[j].w * v[j].w); }
        s = wave_sum(s);
        unsigned long long* o8 = (unsigned long long*)(XB + (size_t)m * D) + lane;
#pragma unroll
        for (int j = 0; j < 4; ++j) o8[64 * j] = (unsigned long long)pk2(v[j].x, v[j].y) | ((unsigned long long)pk2(v[j].z, v[j].w) << 32);
        if (lane == 0) rs[m] = (u64_t)(s * 16777216.f);
    }
}

__device__ __forceinline__ void sincos_red(float ang, float& sn, float& cs) {
    const float n = rintf(ang * 0.15915494309189535f);
    float r = fmaf(-n, 6.28125f, ang); r = fmaf(-n, 0.0019353071795864769f, r);
    sn = __sinf(r); cs = __cosf(r);
}
template <int HALF>
__device__ __forceinline__ void rope4(float (&v)[4], int sl, float pos) {
    constexpr int LH = HALF / 4;
    float pv[4];
#pragma unroll
    for (int j = 0; j < 4; ++j) pv[j] = __shfl_xor(v[j], LH);
    if (sl < 2 * LH) {
        const bool first = sl < LH; const int i0 = (sl & (LH - 1)) * 4;
#pragma unroll
        for (int j = 0; j < 4; ++j) {
            constexpr float I4[4] = {1.0f, 0.03760603070259094f, 0.0014142135623842478f, 5.318296098266728e-05f};
            constexpr float I8[8] = {1.0f, 0.1939227432012558f, 0.03760603070259094f, 0.007292664609849453f, 0.0014142135623842478f, 0.00027424818836152554f, 5.318296098266728e-05f, 1.0313386155758053e-05f};
            const float inv = (HALF == 4) ? I4[j] : (i0 ? I8[4 + j] : I8[j]);
            float sn, cs; sincos_red(pos * inv, sn, cs);
            v[j] = first ? (v[j] * cs - pv[j] * sn) : (pv[j] * sn + v[j] * cs);
        }
    }
}
__device__ __forceinline__ void prep_phase(const Params& p, int l, int gw, int ngw, int lane) {
    bf16* Z = (bf16*)(p.ws + WS_BIG); float* ZS = (float*)(p.ws + WS_ZS); bf16* IK = (bf16*)(p.ws + WS_IK);
    const float* dg = p.diff_qk_norm + l * 64; const float* sg = p.dsa_qk_norm + l * 128;
    for (int tok = gw; tok < T; tok += ngw) {
        const float pos = (float)p.pos[tok];
#pragma unroll
        for (int which = 0; which < 2; ++which) {
            unsigned long long* ptr = (unsigned long long*)(Z + (size_t)tok * ZP + (which ? col_dk(l) : col_dq(l))) + lane;
            const unsigned long long w = *ptr; float v[4] = {bflo((unsigned)w), bfhi((unsigned)w), bflo((unsigned)(w >> 32)), bfhi((unsigned)(w >> 32))};
            float ss = (v[0] * v[0] + v[1] * v[1]) + (v[2] * v[2] + v[3] * v[3]);
            ss += __shfl_xor(ss, 1); ss += __shfl_xor(ss, 2); ss += __shfl_xor(ss, 4);
            const float r = 1.f / sqrtf(ss * (1.f / 32.f) + EPS);
            const f32x4 g = *(const f32x4*)(dg + which * 32 + (lane & 7) * 4);
#pragma unroll
            for (int j = 0; j < 4; ++j) v[j] = v[j] * r * g[j];
            rope4<4>(v, lane & 7, pos);
            if (which == 0) {
#pragma unroll
                for (int j = 0; j < 4; ++j) v[j] *= 0.17677669529663687f;
            }
            *ptr = (unsigned long long)pk2(v[0], v[1]) | ((unsigned long long)pk2(v[2], v[3]) << 32);
        }
        {
            unsigned long long* ptr = (unsigned long long*)(Z + (size_t)tok * ZP + 2560) + lane;
            const unsigned long long w = *ptr; float v[4] = {bflo((unsigned)w), bfhi((unsigned)w), bflo((unsigned)(w >> 32)), bfhi((unsigned)(w >> 32))};
            float ss = (v[0] * v[0] + v[1] * v[1]) + (v[2] * v[2] + v[3] * v[3]);
            ss += __shfl_xor(ss, 1); ss += __shfl_xor(ss, 2); ss += __shfl_xor(ss, 4); ss += __shfl_xor(ss, 8);
            const float r = 1.f / sqrtf(ss * (1.f / 64.f) + EPS);
            const f32x4 g = *(const f32x4*)(sg + (lane & 15) * 4);
#pragma unroll
            for (int j = 0; j < 4; ++j) v[j] = v[j] * r * g[j];
            rope4<8>(v, lane & 15, pos);
#pragma unroll
            for (int j = 0; j < 4; ++j) v[j] *= 0.125f;
            *ptr = (unsigned long long)pk2(v[0], v[1]) | ((unsigned long long)pk2(v[2], v[3]) << 32);
        }
        {
            unsigned long long* ptr = (unsigned long long*)(Z + (size_t)tok * ZP + 2816) + lane;
            const unsigned long long w = *ptr; float v[4] = {bflo((unsigned)w), bfhi((unsigned)w), bflo((unsigned)(w >> 32)), bfhi((unsigned)(w >> 32))};
            rope4<4>(v, lane & 7, pos);
            *ptr = (unsigned long long)pk2(v[0], v[1]) | ((unsigned long long)pk2(v[2], v[3]) << 32);
        }
        {
            float* ptr = ZS + (size_t)tok * ZSP + (lane & 15) * 4;
            const f32x4 x = *(const f32x4*)ptr; float v[4] = {x[0], x[1], x[2], x[3]};
            float ss = (v[0] * v[0] + v[1] * v[1]) + (v[2] * v[2] + v[3] * v[3]);
            ss += __shfl_xor(ss, 1); ss += __shfl_xor(ss, 2); ss += __shfl_xor(ss, 4); ss += __shfl_xor(ss, 8);
            const float r = 1.f / sqrtf(ss * (1.f / 64.f) + EPS);
            const f32x4 g = *(const f32x4*)(sg + 64 + (lane & 15) * 4);
#pragma unroll
            for (int j = 0; j < 4; ++j) v[j] = v[j] * r * g[j];
            rope4<8>(v, lane & 15, pos);
            if (lane < 16) *(f32x4*)ptr = (f32x4){v[0], v[1], v[2], v[3]};
        }
        {
            const float* ptr = ZS + (size_t)tok * ZSP + 128 + (lane & 7) * 4;
            const f32x4 x = *(const f32x4*)ptr; float v[4] = {x[0], x[1], x[2], x[3]};
            rope4<4>(v, lane & 7, pos);
            if (lane < 8) *((unsigned long long*)(IK + (size_t)tok * 32) + lane) = (unsigned long long)pk2(v[0], v[1]) | ((unsigned long long)pk2(v[2], v[3]) << 32);
        }
    }
}
__device__ __forceinline__ void mlstm_item(const Params& p, int l, int bh, LAS unsigned char* lds, int wv) {
    const int tid = tid_fresh(wv), lane = tid & 63, b = bh >> 2, h = bh & 3;
    const bf16* Z = (const bf16*)(p.ws + WS_BIG); const float* ZS = (const float*)(p.ws + WS_ZS); bf16* O1 = (bf16*)(p.ws + WS_O + OB_STRIDE);
    LAS float* nv = (LAS float*)lds; LAS float* bc = nv + 64; LAS float* igs = bc + 64; LAS float* wks = igs + 64; LAS float* sc = wks + 64;
    LAS float* Qs = sc + 64; LAS float* Ks = Qs + 64 * 65; LAS float* Vs = Ks + 64 * 65; LAS float* Ss = Vs + 64 * 65; LAS float* Cs = Ss + 64 * 65;
    for (int i = tid; i < 64 * 65; i += NTHR) Cs[i] = 0.f;
    if (tid < 64) nv[tid] = 0.f;
    float mcar = 0.f;
    const int r = tid >> 3, sg = tid & 7;
    const int cc0 = sg * 16; const int ch0 = (cc0 < 64) ? (h * 64 + cc0) : (256 + h * 64 + cc0 - 64);
    const float* cw0 = p.ml_conv_w + (size_t)l * 4 * 512; const float* cb0 = p.ml_conv_b + (size_t)l * 512;
    const int zc0 = (cc0 < 64) ? (768 + h * 64 + cc0) : (1024 + h * 64 + cc0 - 64);
    const float gb_i = p.ml_gate_bias[(l * 2 + 0) * 4 + h], gb_f = p.ml_gate_bias[(l * 2 + 1) * 4 + h];
    const float qsc = (cc0 < 64) ? 0.125f : 1.0f;
    __syncthreads();
    for (int c = 0; c < 64; ++c) {
        const int t0 = c * 64; const size_t tok0 = (size_t)b * SEQ + t0;
        const float* cw = cw0; const float* cb = cb0; asm volatile("" : "+s"(cw), "+s"(cb));
        {
            float y[16];
#pragma unroll
            for (int i = 0; i < 16; ++i) y[i] = cb[ch0 + i];
#pragma unroll
            for (int j = 0; j < 4; ++j) {
                const int tt = t0 + r - 3 + j;
                if (tt >= 0) {
                    const u32x4* xp = (const u32x4*)(Z + ((size_t)b * SEQ + tt) * ZP + zc0); const u32x4 x0 = xp[0], x1 = xp[1];
                    const float xv[16] = {bflo(x0.x), bfhi(x0.x), bflo(x0.y), bfhi(x0.y), bflo(x0.z), bfhi(x0.z), bflo(x0.w), bfhi(x0.w),
                                          bflo(x1.x), bfhi(x1.x), bflo(x1.y), bfhi(x1.y), bflo(x1.z), bfhi(x1.z), bflo(x1.w), bfhi(x1.w)};
#pragma unroll
                    for (int i = 0; i < 16; ++i) y[i] = fmaf(cw[j * 512 + ch0 + i], xv[i], y[i]);
                }
            }
            LAS float* dst = (cc0 < 64) ? (Qs + r * 65 + cc0) : (Ks + r * 65 + cc0 - 64);
#pragma unroll
            for (int i = 0; i < 16; ++i) dst[i] = y[i] * sigmoidf_(y[i]) * qsc;
            const u32x4 vv = *(const u32x4*)(Z + (tok0 + r) * ZP + 1280 + h * 64 + sg * 8);
            LAS float* vd = Vs + r * 65 + sg * 8;
            vd[0] = bflo(vv.x); vd[1] = bfhi(vv.x); vd[2] = bflo(vv.y); vd[3] = bfhi(vv.y); vd[4] = bflo(vv.z); vd[5] = bfhi(vv.z); vd[6] = bflo(vv.w); vd[7] = bfhi(vv.w);
        }
        if (tid < 64) {
            const float ig = ZS[(tok0 + tid) * ZSP + 168 + h] + gb_i;
            const float fz = ZS[(tok0 + tid) * ZSP + 172 + h] + gb_f;
            const float lf = fminf(fz, 0.f) - log1pf(__expf(-fabsf(fz)));
            float bsum = lf;
#pragma unroll
            for (int d = 1; d < 64; d <<= 1) { const float n = __shfl_up(bsum, d); if (lane >= d) bsum += n; }
            const float bl = __shfl(bsum, 63);
            const float g = bl - bsum + ig;
            const float mnew = fmaxf(bl + mcar, wave_max(g));
            bc[tid] = bsum; igs[tid] = ig; wks[tid] = __expf(g - mnew);
            if (tid == 0) { sc[0] = mnew; sc[1] = __expf(bl + mcar - mnew); sc[2] = bl; }
        }
        __syncthreads();
        const float bt = bc[r];
        float mx = -INFINITY;
#pragma unroll
        for (int i = 0; i < 8; ++i) { const int s = sg * 8 + i; const float dli = (s <= r) ? (bt - bc[s] + igs[s]) : -INFINITY; mx = fmaxf(mx, dli); }
        mx = fmaxf(mx, __shfl_xor(mx, 1)); mx = fmaxf(mx, __shfl_xor(mx, 2)); mx = fmaxf(mx, __shfl_xor(mx, 4));
        const float inter = bt + mcar; const float mt = fmaxf(inter, mx); const float iw = __expf(inter - mt);
        float ssum = 0.f;
#pragma unroll 1
        for (int i = 0; i < 8; ++i) { const int s = sg * 8 + i; float dot = 0.f;
#pragma unroll 16
            for (int d = 0; d < 64; ++d) dot = fmaf(Qs[r * 65 + d], Ks[s * 65 + d], dot);
            const float dli = (s <= r) ? (bt - bc[s] + igs[s]) : -INFINITY;
            const float sv = dot * __expf(dli - mt); Ss[r * 65 + s] = sv; ssum += sv; }
        ssum += __shfl_xor(ssum, 1); ssum += __shfl_xor(ssum, 2); ssum += __shfl_xor(ssum, 4);
        float qn = 0.f;
#pragma unroll
        for (int d = 0; d < 64; ++d) qn = fmaf(Qs[r * 65 + d], nv[d], qn);
        const float den = iw * qn + ssum;
        __syncthreads();
        {
            float num[8];
#pragma unroll
            for (int i = 0; i < 8; ++i) num[i] = 0.f;
#pragma unroll 8
            for (int d = 0; d < 64; ++d) { const float qd = Qs[r * 65 + d];
#pragma unroll
                for (int i = 0; i < 8; ++i) num[i] = fmaf(qd, Cs[d * 65 + sg * 8 + i], num[i]); }
#pragma unroll
            for (int i = 0; i < 8; ++i) num[i] *= iw;
#pragma unroll 8
            for (int s = 0; s < 64; ++s) { const float sv = Ss[r * 65 + s];
#pragma unroll
                for (int i = 0; i < 8; ++i) num[i] = fmaf(sv, Vs[s * 65 + sg * 8 + i], num[i]); }
            const float dn = 1.f / fmaxf(fabsf(den), __expf(-mt));
            float hs = 0.f;
#pragma unroll
            for (int i = 0; i < 8; ++i) { num[i] *= dn; hs = fmaf(num[i], num[i], hs); }
            hs += __shfl_xor(hs, 1); hs += __shfl_xor(hs, 2); hs += __shfl_xor(hs, 4);
            const float rr = 1.f / sqrtf(hs * (1.f / 64.f) + EPS);
            const u32x4 og = *(const u32x4*)(Z + (tok0 + r) * ZP + 1536 + h * 64 + sg * 8);
            const float ogv[8] = {bflo(og.x), bfhi(og.x), bflo(og.y), bfhi(og.y), bflo(og.z), bfhi(og.z), bflo(og.w), bfhi(og.w)};
            const float* hg = p.ml_head_norm + l * 64 + sg * 8;
            float o[8];
#pragma unroll
            for (int i = 0; i < 8; ++i) o[i] = sigmoidf_(ogv[i]) * (num[i] * rr * hg[i]);
            u32x4 w; w.x = pk2(o[0], o[1]); w.y = pk2(o[2], o[3]); w.z = pk2(o[4], o[5]); w.w = pk2(o[6], o[7]);
            *(u32x4*)(O1 + (tok0 + r) * 256 + h * 64 + sg * 8) = w;
        }
        __syncthreads();
        {
            const float decay = sc[1];
            float cacc[8]; float nacc = 0.f;
#pragma unroll
            for (int i = 0; i < 8; ++i) cacc[i] = 0.f;
#pragma unroll 8
            for (int s = 0; s < 64; ++s) { const float kw = wks[s] * Ks[s * 65 + r]; nacc += kw;
#pragma unroll
                for (int i = 0; i < 8; ++i) cacc[i] = fmaf(kw, Vs[s * 65 + sg * 8 + i], cacc[i]); }
#pragma unroll
            for (int i = 0; i < 8; ++i) Cs[r * 65 + sg * 8 + i] = decay * Cs[r * 65 + sg * 8 + i] + cacc[i];
            if (sg == 0) nv[r] = decay * nv[r] + nacc;
            mcar = sc[0];
        }
        __syncthreads();
    }
}

__device__ __forceinline__ void diff_item(const Params& p, int l, int bh, int qt, LAS unsigned char* lds, int wv) {
    const int tid = tid_fresh(wv), b = bh >> 2, h = bh & 3, q0 = qt * 128;
    const bf16* Z = (const bf16*)(p.ws + WS_BIG); bf16* O0 = (bf16*)(p.ws + WS_O);
    LAS float* Kt = (LAS float*)lds; LAS float* Vt = Kt + 64 * 64;
    const int ql = tid >> 2, part = tid & 3, c = part & 1, dvh = part >> 1, t = q0 + ql; const size_t tok = (size_t)b * SEQ + t;
    const float* lp = p.diff_lambda + l * 128; float s01 = 0.f, s23 = 0.f, gqm = 0.f, gkm = 0.f;
#pragma unroll 2
    for (int i = 0; i < 32; ++i) { s01 = fmaf(lp[i], lp[32 + i], s01); s23 = fmaf(lp[64 + i], lp[96 + i], s23);
        gqm = fmaxf(gqm, fabsf(p.diff_qk_norm[l * 64 + i])); gkm = fmaxf(gkm, fabsf(p.diff_qk_norm[l * 64 + 32 + i])); }
    const float lam_init = 0.8f - 0.6f * __expf(-0.3f * (float)l); const float lam = __expf(s01) - __expf(s23) + lam_init;
    const float coff = 5.65685424949238f * gqm * gkm;
    float q[32], o[32];
    { const u32x4* qp = (const u32x4*)(Z + tok * ZP + h * 64 + c * 32);
#pragma unroll
      for (int i = 0; i < 4; ++i) { const u32x4 w = qp[i]; q[8 * i] = bflo(w.x); q[8 * i + 1] = bfhi(w.x); q[8 * i + 2] = bflo(w.y); q[8 * i + 3] = bfhi(w.y); q[8 * i + 4] = bflo(w.z); q[8 * i + 5] = bfhi(w.z); q[8 * i + 6] = bflo(w.w); q[8 * i + 7] = bfhi(w.w); } }
#pragma unroll
    for (int i = 0; i < 32; ++i) o[i] = 0.f;
    float lsum = 0.f;
    const int nkt = (q0 + 128) / 64;
    const int lk = tid >> 3, lsg = tid & 7;
    for (int kt = 0; kt < nkt; ++kt) {
        __syncthreads();
        { const size_t ktok = (size_t)b * SEQ + kt * 64 + lk;
          const bf16* src = Z + ktok * ZP + ((lsg < 4) ? (256 + h * 64 + lsg * 16) : (512 + h * 64 + (lsg - 4) * 16));
          const u32x4 x0 = ((const u32x4*)src)[0], x1 = ((const u32x4*)src)[1];
          LAS float* dst = ((lsg < 4) ? (Kt + lk * 64 + lsg * 16) : (Vt + lk * 64 + (lsg - 4) * 16));
          *(LAS f32x4*)(dst) = (f32x4){bflo(x0.x), bfhi(x0.x), bflo(x0.y), bfhi(x0.y)}; *(LAS f32x4*)(dst + 4) = (f32x4){bflo(x0.z), bfhi(x0.z), bflo(x0.w), bfhi(x0.w)};
          *(LAS f32x4*)(dst + 8) = (f32x4){bflo(x1.x), bfhi(x1.x), bflo(x1.y), bfhi(x1.y)}; *(LAS f32x4*)(dst + 12) = (f32x4){bflo(x1.z), bfhi(x1.z), bflo(x1.w), bfhi(x1.w)}; }
        __syncthreads();
        const int kmax = t - kt * 64 + 1;
        for (int key = 0; key < 64; ++key) {
            const LAS f32x4* kr = (const LAS f32x4*)(Kt + key * 64 + c * 32);
            float s = 0.f;
#pragma unroll
            for (int i = 0; i < 8; ++i) { const f32x4 kv = kr[i]; s = fmaf(q[4 * i], kv[0], s); s = fmaf(q[4 * i + 1], kv[1], s); s = fmaf(q[4 * i + 2], kv[2], s); s = fmaf(q[4 * i + 3], kv[3], s); }
            const float pe = (key < kmax) ? __expf(s - coff) : 0.f;
            lsum += pe;
            const LAS f32x4* vr = (const LAS f32x4*)(Vt + key * 64 + dvh * 32);
#pragma unroll
            for (int i = 0; i < 8; ++i) { const f32x4 vv = vr[i]; o[4 * i] = fmaf(pe, vv[0], o[4 * i]); o[4 * i + 1] = fmaf(pe, vv[1], o[4 * i + 1]); o[4 * i + 2] = fmaf(pe, vv[2], o[4 * i + 2]); o[4 * i + 3] = fmaf(pe, vv[3], o[4 * i + 3]); }
        }
    }
    const float inv = 1.f / lsum; float ss = 0.f;
#pragma unroll
    for (int i = 0; i < 32; ++i) { const float my = o[i] * inv; const float ot = __shfl_xor(my, 1); o[i] = (c == 0) ? (my - lam * ot) : (ot - lam * my); ss = fmaf(o[i], o[i], ss); }
    ss += __shfl_xor(ss, 2);
    const float rr = (1.f - lam_init) / sqrtf(ss * (1.f / 64.f) + EPS);
    if (c == 0) {
        const float* hg = p.diff_head_norm + l * 64 + dvh * 32; u32x4* dst = (u32x4*)(O0 + tok * 256 + h * 64 + dvh * 32);
#pragma unroll
        for (int i = 0; i < 4; ++i) { u32x4 w; w.x = pk2(o[8 * i] * rr * hg[8 * i], o[8 * i + 1] * rr * hg[8 * i + 1]); w.y = pk2(o[8 * i + 2] * rr * hg[8 * i + 2], o[8 * i + 3] * rr * hg[8 * i + 3]);
            w.z = pk2(o[8 * i + 4] * rr * hg[8 * i + 4], o[8 * i + 5] * rr * hg[8 * i + 5]); w.w = pk2(o[8 * i + 6] * rr * hg[8 * i + 6], o[8 * i + 7] * rr * hg[8 * i + 7]); dst[i] = w; }
    }
    __syncthreads();
}

__device__ __forceinline__ unsigned pkbf(float lo, float hi) { unsigned r; asm("v_cvt_pk_bf16_f32 %0, %1, %2" : "=v"(r) : "v"(lo), "v"(hi)); return r; }
__device__ __forceinline__ void diffm_item(const Params& p, int l, int bh, int qb, LAS unsigned char* lds, int wv) {
    const int tid = tid_fresh(wv), lane = tid & 63, half = lane >> 5, r32 = lane & 31, b = bh >> 2, h = bh & 3;
    const bf16* Z = (const bf16*)(p.ws + WS_BIG); bf16* O0 = (bf16*)(p.ws + WS_O);
    LAS bf16* Ks = (LAS bf16*)lds; LAS bf16* Vt = Ks + 64 * 72;
    const float* lp = p.diff_lambda + l * 128; float s01 = 0.f, s23 = 0.f, gqm = 0.f, gkm = 0.f;
#pragma unroll 2
    for (int i = 0; i < 32; ++i) { s01 = fmaf(lp[i], lp[32 + i], s01); s23 = fmaf(lp[64 + i], lp[96 + i], s23);
        gqm = fmaxf(gqm, fabsf(p.diff_qk_norm[l * 64 + i])); gkm = fmaxf(gkm, fabsf(p.diff_qk_norm[l * 64 + 32 + i])); }
    const float lam_init = 0.8f - 0.6f * __expf(-0.3f * (float)l); const float lam = __expf(s01) - __expf(s23) + lam_init;
    const float coff = 5.65685424949238f * gqm * gkm;
    const int qw = qb * 256 + 32 * wv;
    const size_t tokb = (size_t)b * SEQ;
    s16x8 qf[2][2];
    { const bf16* qp = Z + (tokb + qw + r32) * ZP + col_dq(l) + h * 64 + half * 8;
#pragma unroll
      for (int c = 0; c < 2; ++c)
#pragma unroll
          for (int s = 0; s < 2; ++s) qf[c][s] = *(const s16x8*)(qp + c * 32 + 16 * s); }
    f32x16 oacc[2][2];
#pragma unroll
    for (int c = 0; c < 2; ++c)
#pragma unroll
        for (int db = 0; db < 2; ++db)
#pragma unroll
            for (int r = 0; r < 16; ++r) oacc[c][db][r] = 0.f;
    float ls0 = 0.f, ls1 = 0.f;
    const int nt = (qb + 1) * 4;
    const int kkey = tid >> 3, kch = tid & 7, vkey = tid & 63, vdc = tid >> 6;
    const bf16* kgp = Z + (tokb + kkey) * ZP + col_dk(l) + h * 64 + kch * 8;
    const bf16* vgp = Z + (tokb + vkey) * ZP + 512 + h * 64 + vdc * 8;
    u32x4 kreg = *(const u32x4*)kgp, vreg = *(const u32x4*)vgp;
#pragma unroll 1
    for (int t = 0; t < nt; ++t) {
        __syncthreads();
        *(LAS u32x4*)(Ks + kkey * 72 + kch * 8) = kreg;
        { LAS bf16* vd = Vt + (vdc * 8) * 72 + vkey;
          vd[0] = (bf16)(vreg.x & 0xffffu); vd[72] = (bf16)(vreg.x >> 16); vd[144] = (bf16)(vreg.y & 0xffffu); vd[216] = (bf16)(vreg.y >> 16);
          vd[288] = (bf16)(vreg.z & 0xffffu); vd[360] = (bf16)(vreg.z >> 16); vd[432] = (bf16)(vreg.w & 0xffffu); vd[504] = (bf16)(vreg.w >> 16); }
        __syncthreads();
        if (t + 1 < nt) { kreg = *(const u32x4*)(kgp + (size_t)(t + 1) * 64 * ZP); vreg = *(const u32x4*)(vgp + (size_t)(t + 1) * 64 * ZP); }
        const int k0 = t * 64;
#pragma unroll
        for (int sub = 0; sub < 2; ++sub) {
            const int kb = k0 + 32 * sub;
            if (kb <= qw + 31) {
                f32x16 s0, s1;
#pragma unroll
                for (int r = 0; r < 16; ++r) { s0[r] = 0.f; s1[r] = 0.f; }
                const LAS bf16* kr = Ks + (32 * sub + r32) * 72 + 8 * half;
#pragma unroll
                for (int s = 0; s < 2; ++s) {
                    const s16x8 a0 = *(const LAS s16x8*)(kr + 16 * s), a1 = *(const LAS s16x8*)(kr + 32 + 16 * s);
                    s0 = __builtin_amdgcn_mfma_f32_32x32x16_bf16(a0, qf[0][s], s0, 0, 0, 0);
                    s1 = __builtin_amdgcn_mfma_f32_32x32x16_bf16(a1, qf[1][s], s1, 0, 0, 0);
                }
                const bool diag = (kb + 31 > qw);
#pragma unroll
                for (int r = 0; r < 16; ++r) {
                    float p0 = __expf(s0[r] - coff), p1 = __expf(s1[r] - coff);
                    if (diag) { const int key = kb + 8 * (r >> 2) + 4 * half + (r & 3); if (key > qw + r32) { p0 = 0.f; p1 = 0.f; } }
                    ls0 += p0; ls1 += p1; s0[r] = p0; s1[r] = p1;
                }
#pragma unroll
                for (int s = 0; s < 2; ++s) {
                    u32x4 w0, w1;
                    w0.x = pkbf(s0[8 * s], s0[8 * s + 1]); w0.y = pkbf(s0[8 * s + 2], s0[8 * s + 3]); w0.z = pkbf(s0[8 * s + 4], s0[8 * s + 5]); w0.w = pkbf(s0[8 * s + 6], s0[8 * s + 7]);
                    w1.x = pkbf(s1[8 * s], s1[8 * s + 1]); w1.y = pkbf(s1[8 * s + 2], s1[8 * s + 3]); w1.z = pkbf(s1[8 * s + 4], s1[8 * s + 5]); w1.w = pkbf(s1[8 * s + 6], s1[8 * s + 7]);
                    const s16x8 pf0 = __builtin_bit_cast(s16x8, w0), pf1 = __builtin_bit_cast(s16x8, w1);
#pragma unroll
                    for (int db = 0; db < 2; ++db) {
                        const LAS bf16* vr = Vt + (db * 32 + r32) * 72 + 32 * sub + 16 * s + 4 * half;
                        const u32x2 v0 = *(const LAS u32x2*)vr, v1 = *(const LAS u32x2*)(vr + 8);
                        const u32x4 vv = (u32x4){v0.x, v0.y, v1.x, v1.y};
                        const s16x8 vf = __builtin_bit_cast(s16x8, vv);
                        oacc[0][db] = __builtin_amdgcn_mfma_f32_32x32x16_bf16(vf, pf0, oacc[0][db], 0, 0, 0);
                        oacc[1][db] = __builtin_amdgcn_mfma_f32_32x32x16_bf16(vf, pf1, oacc[1][db], 0, 0, 0);
                    }
                }
            }
        }
    }
    ls0 += __shfl_xor(ls0, 32); ls1 += __shfl_xor(ls1, 32);
    const float i0 = 1.f / ls0, i1 = lam / ls1;
    float ss = 0.f;
#pragma unroll
    for (int db = 0; db < 2; ++db)
#pragma unroll
        for (int r = 0; r < 16; ++r) { const float v = oacc[0][db][r] * i0 - oacc[1][db][r] * i1; oacc[0][db][r] = v; ss = fmaf(v, v, ss); }
    ss += __shfl_xor(ss, 32);
    const float rr = (1.f - lam_init) / sqrtf(ss * (1.f / 64.f) + EPS);
    const float* hg = p.diff_head_norm + l * 64;
    bf16* orow = O0 + (tokb + qw + r32) * 256 + h * 64;
#pragma unroll
    for (int db = 0; db < 2; ++db)
#pragma unroll
        for (int g = 0; g < 4; ++g) { const int d0 = db * 32 + 8 * g + 4 * half; const f32x4 gg = *(const f32x4*)(hg + d0);
            u32x2 w; w.x = pkbf(oacc[0][db][4 * g] * rr * gg[0], oacc[0][db][4 * g + 1] * rr * gg[1]); w.y = pkbf(oacc[0][db][4 * g + 2] * rr * gg[2], oacc[0][db][4 * g + 3] * rr * gg[3]);
            *(u32x2*)(orow + d0) = w; }
    __syncthreads();
}

typedef unsigned u32x16 __attribute__((ext_vector_type(16)));
__device__ __forceinline__ void sb_item(const Params& p, int l, int bh, int g, LAS unsigned char* lds, int wv) {
    const int tid = tid_fresh(wv), lane = tid & 63, w = wv, b = bh >> 2, h = bh & 3; (void)lds;
    const bf16* Z = (const bf16*)(p.ws + WS_BIG); bf16* O2 = (bf16*)(p.ws + WS_O + 2 * OB_STRIDE);
    const int t0 = g * 512 + w * 64, t = t0 + lane; const size_t tok = (size_t)b * SEQ + t;
    float q[64], o[64];
    { const u32x4* qp = (const u32x4*)(Z + tok * ZP + 1792 + h * 64);
#pragma unroll
      for (int i = 0; i < 8; ++i) { const u32x4 x = qp[i]; q[8 * i] = bflo(x.x); q[8 * i + 1] = bfhi(x.x); q[8 * i + 2] = bflo(x.y); q[8 * i + 3] = bfhi(x.y); q[8 * i + 4] = bflo(x.z); q[8 * i + 5] = bfhi(x.z); q[8 * i + 6] = bflo(x.w); q[8 * i + 7] = bfhi(x.w); } }
#pragma unroll
    for (int i = 0; i < 64; ++i) o[i] = 0.f;
    float R = 0.f;
    const bf16* kbase = Z + (size_t)b * SEQ * ZP + col_sbk(l) + h * 64;
#pragma unroll 1
    for (int s = t0 + 62; s >= 0; --s) {
        const bf16* kp = kbase + (size_t)s * ZP;
        u32x16 k0, k1, v0, v1;
        asm volatile("s_load_dwordx16 %0, %4, 0x0\n\ts_load_dwordx16 %1, %4, 0x40\n\ts_load_dwordx16 %2, %4, 0x200\n\ts_load_dwordx16 %3, %4, 0x240\n\ts_waitcnt lgkmcnt(0)"
                     : "=s"(k0), "=s"(k1), "=s"(v0), "=s"(v1) : "s"(kp) : "memory");
        const bool act = s < t;
        float z = 0.f;
#pragma unroll
        for (int i = 0; i < 16; ++i) { z = fmaf(q[2 * i], bflo(k0[i]), z); z = fmaf(q[2 * i + 1], bfhi(k0[i]), z); }
#pragma unroll
        for (int i = 0; i < 16; ++i) { z = fmaf(q[32 + 2 * i], bflo(k1[i]), z); z = fmaf(q[33 + 2 * i], bfhi(k1[i]), z); }
        z *= 0.125f;
        const float lb = fminf(z, 0.f) - __logf(1.f + __expf(-fabsf(z)));
        const float a = act ? __expf(lb + R) : 0.f;
        R += act ? (lb - z) : 0.f;
#pragma unroll
        for (int i = 0; i < 16; ++i) { o[2 * i] = fmaf(a, bflo(v0[i]), o[2 * i]); o[2 * i + 1] = fmaf(a, bfhi(v0[i]), o[2 * i + 1]); }
#pragma unroll
        for (int i = 0; i < 16; ++i) { o[32 + 2 * i] = fmaf(a, bflo(v1[i]), o[32 + 2 * i]); o[33 + 2 * i] = fmaf(a, bfhi(v1[i]), o[33 + 2 * i]); }
        if ((s & 31) == 0) { if (__all(R < -104.f)) break; }
    }
    u32x4* dst = (u32x4*)(O2 + tok * 256 + h * 64);
#pragma unroll
    for (int i = 0; i < 8; ++i) { u32x4 x; x.x = pk2(o[8 * i], o[8 * i + 1]); x.y = pk2(o[8 * i + 2], o[8 * i + 3]); x.z = pk2(o[8 * i + 4], o[8 * i + 5]); x.w = pk2(o[8 * i + 6], o[8 * i + 7]); dst[i] = x; }
}
constexpr size_t WS_MLS = 460 * MiB, WS_DEC = WS_MLS + 5 * 32 * 4096 * 4, WS_UN = 463 * MiB, WS_NV = WS_UN + 512 * 1024, WS_UT = 464 * MiB, WS_CT = 496 * MiB, WS_END2 = 512 * MiB;
constexpr int MLN = 32 * 4096;
__device__ __forceinline__ void ml_prepass(const Params& p, int l, int bh, int lane) {
    const int b = bh >> 2, h = bh & 3; const float* ZS = (const float*)(p.ws + WS_ZS);
    float* MLS = (float*)(p.ws + WS_MLS); float* DEC = (float*)(p.ws + WS_DEC);
    const float gb_i = p.ml_gate_bias[(l * 2 + 0) * 4 + h], gb_f = p.ml_gate_bias[(l * 2 + 1) * 4 + h];
    float cA = 0.f, cB = 0.f;
#pragma unroll 1
    for (int c4 = 0; c4 < 16; ++c4) {
        float igv[4], fzv[4];
#pragma unroll
        for (int k = 0; k < 4; ++k) { const size_t tok = (size_t)b * SEQ + (c4 * 4 + k) * 64 + lane; igv[k] = ZS[tok * ZSP + 168 + h]; fzv[k] = ZS[tok * ZSP + 172 + h]; }
#pragma unroll
        for (int k = 0; k < 4; ++k) {
            const int c = c4 * 4 + k;
            const float ig = igv[k] + gb_i, fz = fzv[k] + gb_f;
            const float lf = fminf(fz, 0.f) - __logf(1.f + __expf(-fabsf(fz)));
            float bsum = lf;
#pragma unroll
            for (int d = 1; d < 64; d <<= 1) { const float n = __shfl_up(bsum, d); if (lane >= d) bsum += n; }
            const float bl = __shfl(bsum, 63);
            const float a = ig - bsum;
            float pm = a;
#pragma unroll
            for (int d = 1; d < 64; d <<= 1) { const float n = __shfl_up(pm, d); if (lane >= d) pm = fmaxf(pm, n); }
            const float gmax = bl + __shfl(pm, 63);
            const int ti = bh * 4096 + c * 64 + lane;
            MLS[ti] = bsum; MLS[MLN + ti] = a; MLS[2 * MLN + ti] = pm;
            cA = (lane == c) ? bl : cA; cB = (lane == c) ? gmax : cB;
        }
    }
    float sA = cA, sB = cB;
#pragma unroll
    for (int d = 1; d < 64; d <<= 1) { const float pA = __shfl_up(sA, d), pB = __shfl_up(sB, d); if (lane >= d) { sB = fmaxf(pB + sA, sB); sA = pA + sA; } }
    const float m_out = fmaxf(sA, sB);
    float m_in = __shfl_up(m_out, 1); if (lane == 0) m_in = 0.f;
    DEC[bh * 64 + lane] = __expf(cA + m_in - m_out);
    asm volatile("s_waitcnt vmcnt(0)" ::: "memory");
#pragma unroll 1
    for (int c4 = 0; c4 < 16; ++c4) {
        float bsv[4], av[4], pmv[4];
#pragma unroll
        for (int k = 0; k < 4; ++k) { const int ti = bh * 4096 + (c4 * 4 + k) * 64 + lane; bsv[k] = MLS[ti]; av[k] = MLS[MLN + ti]; pmv[k] = MLS[2 * MLN + ti]; }
#pragma unroll
        for (int k = 0; k < 4; ++k) {
            const int c = c4 * 4 + k;
            const float mi = __shfl(m_in, c), mo = __shfl(m_out, c), bl = __shfl(cA, c);
            const int ti = bh * 4096 + c * 64 + lane;
            const float mt = bsv[k] + fmaxf(mi, pmv[k]);
            MLS[2 * MLN + ti] = mt; MLS[3 * MLN + ti] = __expf(bl + av[k] - mo); MLS[4 * MLN + ti] = __expf(bsv[k] + mi - mt);
        }
    }
}
__device__ __forceinline__ void ml_conv8(const bf16* Z, const float* cw, const float* cb, int b, int t, int ch0, float (&y)[8]) {
    const f32x4 b0 = *(const f32x4*)(cb + ch0), b1 = *(const f32x4*)(cb + ch0 + 4);
    y[0] = b0[0]; y[1] = b0[1]; y[2] = b0[2]; y[3] = b0[3]; y[4] = b1[0]; y[5] = b1[1]; y[6] = b1[2]; y[7] = b1[3];
#pragma unroll
    for (int j = 0; j < 4; ++j) {
        const int tt = t - 3 + j;
        if (tt >= 0) {
            const u32x4 x = *(const u32x4*)(Z + ((size_t)b * SEQ + tt) * ZP + 768 + ch0);
            const f32x4 w0 = *(const f32x4*)(cw + j * 512 + ch0), w1 = *(const f32x4*)(cw + j * 512 + ch0 + 4);
            y[0] = fmaf(w0[0], bflo(x.x), y[0]); y[1] = fmaf(w0[1], bfhi(x.x), y[1]); y[2] = fmaf(w0[2], bflo(x.y), y[2]); y[3] = fmaf(w0[3], bfhi(x.y), y[3]);
            y[4] = fmaf(w1[0], bflo(x.z), y[4]); y[5] = fmaf(w1[1], bfhi(x.z), y[5]); y[6] = fmaf(w1[2], bflo(x.w), y[6]); y[7] = fmaf(w1[3], bfhi(x.w), y[7]);
        }
    }
#pragma unroll
    for (int i = 0; i < 8; ++i) y[i] = y[i] * sigmoidf_(y[i]);
}
__device__ __forceinline__ void mlB_item(const Params& p, int l, int bh, int ci, LAS unsigned char* lds, int wv) {
    const int tid = tid_fresh(wv), lane = tid & 63, half = lane >> 5, r32 = lane & 31, b = bh >> 2, h = bh & 3;
    const bf16* Z = (const bf16*)(p.ws + WS_BIG); const float* MLS = (const float*)(p.ws + WS_MLS);
    float* UT = (float*)(p.ws + WS_UT); float* UN = (float*)(p.ws + WS_UN);
    LAS bf16* KT = (LAS bf16*)lds; LAS bf16* VT = KT + 4 * 64 * 72;
    const float* cw = p.ml_conv_w + (size_t)l * 4 * 512; const float* cb = p.ml_conv_b + (size_t)l * 512;
    __syncthreads();
    {
        const int tt = tid >> 1, hr = tid & 1, cl = tt >> 6, s = tt & 63, t = (ci * 4) * 64 + tt;
        const float wk = MLS[3 * MLN + bh * 4096 + t];
#pragma unroll 1
        for (int q8 = 0; q8 < 4; ++q8) {
            const int d0 = hr * 32 + q8 * 8; float y[8];
            ml_conv8(Z, cw, cb, b, t, 256 + h * 64 + d0, y);
            LAS bf16* dst = KT + (cl * 64 + d0) * 72 + s;
#pragma unroll
            for (int i = 0; i < 8; ++i) dst[i * 72] = (bf16)f2bf(y[i] * wk);
            const u32x4 v = *(const u32x4*)(Z + ((size_t)b * SEQ + t) * ZP + 1280 + h * 64 + d0);
            LAS bf16* vd = VT + (cl * 64 + d0) * 72 + s;
            vd[0] = (bf16)(v.x & 0xffffu); vd[72] = (bf16)(v.x >> 16); vd[144] = (bf16)(v.y & 0xffffu); vd[216] = (bf16)(v.y >> 16);
            vd[288] = (bf16)(v.z & 0xffffu); vd[360] = (bf16)(v.z >> 16); vd[432] = (bf16)(v.w & 0xffffu); vd[504] = (bf16)(v.w >> 16);
        }
    }
    __syncthreads();
    const int cl = wv >> 1, dh = wv & 1, c = ci * 4 + cl;
    f32x16 acc[2];
#pragma unroll
    for (int eb = 0; eb < 2; ++eb)
#pragma unroll
        for (int r = 0; r < 16; ++r) acc[eb][r] = 0.f;
#pragma unroll
    for (int s4 = 0; s4 < 4; ++s4) {
        const s16x8 bk = *(const LAS s16x8*)(KT + (cl * 64 + dh * 32 + r32) * 72 + 16 * s4 + 8 * half);
#pragma unroll
        for (int eb = 0; eb < 2; ++eb) {
            const s16x8 av = *(const LAS s16x8*)(VT + (cl * 64 + eb * 32 + r32) * 72 + 16 * s4 + 8 * half);
            acc[eb] = __builtin_amdgcn_mfma_f32_32x32x16_bf16(av, bk, acc[eb], 0, 0, 0);
        }
    }
    float* ut = UT + ((size_t)(bh * 64 + c) * 64) * 64;
#pragma unroll
    for (int eb = 0; eb < 2; ++eb)
#pragma unroll
        for (int r = 0; r < 16; ++r) { const int e = eb * 32 + 8 * (r >> 2) + 4 * half + (r & 3); ut[e * 64 + dh * 32 + r32] = acc[eb][r]; }
    {
        const LAS bf16* kr = KT + (cl * 64 + dh * 32 + r32) * 72 + half * 32; float sm = 0.f;
#pragma unroll
        for (int i = 0; i < 4; ++i) { const u32x4 x = *(const LAS u32x4*)(kr + 8 * i); sm += (bflo(x.x) + bfhi(x.x)) + (bflo(x.y) + bfhi(x.y)) + (bflo(x.z) + bfhi(x.z)) + (bflo(x.w) + bfhi(x.w)); }
        sm += __shfl_xor(sm, 32);
        if (half == 0) UN[(bh * 64 + c) * 64 + dh * 32 + r32] = sm;
    }
}
__device__ __forceinline__ void mlS_item(const Params& p, int bh, int wv) {
    const int tid = tid_fresh(wv);
    const float* UT = (const float*)(p.ws + WS_UT) + (size_t)bh * 64 * 4096; const float* UN = (const float*)(p.ws + WS_UN) + bh * 4096;
    bf16* CT = (bf16*)(p.ws + WS_CT) + (size_t)bh * 64 * 4096; float* NV = (float*)(p.ws + WS_NV) + bh * 4096; const float* DEC = (const float*)(p.ws + WS_DEC) + bh * 64;
    f32x4 s0 = (f32x4){0.f, 0.f, 0.f, 0.f}, s1 = s0; float ns = 0.f;
#pragma unroll 4
    for (int c = 0; c < 64; ++c) {
        const float dec = DEC[c];
        const f32x4 u0 = *(const f32x4*)(UT + (size_t)c * 4096 + tid * 8), u1 = *(const f32x4*)(UT + (size_t)c * 4096 + tid * 8 + 4);
        u32x4 w; w.x = pk2(s0[0], s0[1]); w.y = pk2(s0[2], s0[3]); w.z = pk2(s1[0], s1[1]); w.w = pk2(s1[2], s1[3]);
        *(u32x4*)(CT + (size_t)c * 4096 + tid * 8) = w;
        s0 = s0 * dec + u0; s1 = s1 * dec + u1;
        if (tid < 64) { NV[c * 64 + tid] = ns; ns = ns * dec + UN[c * 64 + tid]; }
    }
}
__device__ __forceinline__ void mlD_item(const Params& p, int l, int bh, int ci, LAS unsigned char* lds, int wv) {
    const int tid = tid_fresh(wv), lane = tid & 63, half = lane >> 5, r32 = lane & 31, b = bh >> 2, h = bh & 3;
    const bf16* Z = (const bf16*)(p.ws + WS_BIG); const float* MLS = (const float*)(p.ws + WS_MLS); bf16* O1 = (bf16*)(p.ws + WS_O + OB_STRIDE);
    LAS bf16* Qs = (LAS bf16*)lds; LAS bf16* Ks = Qs + 4 * 64 * 72; LAS bf16* VT = Ks + 4 * 64 * 72;
    const float* cw = p.ml_conv_w + (size_t)l * 4 * 512; const float* cb = p.ml_conv_b + (size_t)l * 512;
    __syncthreads();
    {
        const int tt = tid >> 1, hr = tid & 1, cl = tt >> 6, s = tt & 63, t = (ci * 4) * 64 + tt;
#pragma unroll 1
        for (int q8 = 0; q8 < 4; ++q8) {
            const int d0 = hr * 32 + q8 * 8; float y[8];
            ml_conv8(Z, cw, cb, b, t, h * 64 + d0, y);
            u32x4 w; w.x = pk2(y[0] * 0.125f, y[1] * 0.125f); w.y = pk2(y[2] * 0.125f, y[3] * 0.125f); w.z = pk2(y[4] * 0.125f, y[5] * 0.125f); w.w = pk2(y[6] * 0.125f, y[7] * 0.125f);
            *(LAS u32x4*)(Qs + (cl * 64 + s) * 72 + d0) = w;
            ml_conv8(Z, cw, cb, b, t, 256 + h * 64 + d0, y);
            w.x = pk2(y[0], y[1]); w.y = pk2(y[2], y[3]); w.z = pk2(y[4], y[5]); w.w = pk2(y[6], y[7]);
            *(LAS u32x4*)(Ks + (cl * 64 + s) * 72 + d0) = w;
            const u32x4 v = *(const u32x4*)(Z + ((size_t)b * SEQ + t) * ZP + 1280 + h * 64 + d0);
            LAS bf16* vd = VT + (cl * 64 + d0) * 72 + s;
            vd[0] = (bf16)(v.x & 0xffffu); vd[72] = (bf16)(v.x >> 16); vd[144] = (bf16)(v.y & 0xffffu); vd[216] = (bf16)(v.y >> 16);
            vd[288] = (bf16)(v.z & 0xffffu); vd[360] = (bf16)(v.z >> 16); vd[432] = (bf16)(v.w & 0xffffu); vd[504] = (bf16)(v.w >> 16);
        }
    }
    __syncthreads();
    const int cl = wv >> 1, th = wv & 1, c = ci * 4 + cl, tloc = th * 32 + r32, tseq = c * 64 + tloc;
    const int ti = bh * 4096 + tseq;
    const float bs_t = MLS[ti], mt_t = MLS[2 * MLN + ti], iw_t = MLS[4 * MLN + ti];
    s16x8 qf[4];
#pragma unroll
    for (int s4 = 0; s4 < 4; ++s4) qf[s4] = *(const LAS s16x8*)(Qs + (cl * 64 + tloc) * 72 + 16 * s4 + 8 * half);
    f32x16 oacc[2];
#pragma unroll
    for (int eb = 0; eb < 2; ++eb)
#pragma unroll
        for (int r = 0; r < 16; ++r) oacc[eb][r] = 0.f;
    const bf16* CT = (const bf16*)(p.ws + WS_CT) + (size_t)(bh * 64 + c) * 4096;
#pragma unroll
    for (int s4 = 0; s4 < 4; ++s4)
#pragma unroll
        for (int eb = 0; eb < 2; ++eb) { const s16x8 ac = *(const s16x8*)(CT + (eb * 32 + r32) * 64 + 16 * s4 + 8 * half);
            oacc[eb] = __builtin_amdgcn_mfma_f32_32x32x16_bf16(ac, qf[s4], oacc[eb], 0, 0, 0); }
#pragma unroll
    for (int eb = 0; eb < 2; ++eb)
#pragma unroll
        for (int r = 0; r < 16; ++r) oacc[eb][r] *= iw_t;
    float qn = 0.f;
    { const float* nvp = (const float*)(p.ws + WS_NV) + (bh * 64 + c) * 64;
#pragma unroll
      for (int s4 = 0; s4 < 4; ++s4) { const f32x4 n0 = *(const f32x4*)(nvp + 16 * s4 + 8 * half), n1 = *(const f32x4*)(nvp + 16 * s4 + 8 * half + 4);
          const u32x4 qq = __builtin_bit_cast(u32x4, qf[s4]);
          qn += bflo(qq.x) * n0[0] + bfhi(qq.x) * n0[1] + bflo(qq.y) * n0[2] + bfhi(qq.y) * n0[3] + bflo(qq.z) * n1[0] + bfhi(qq.z) * n1[1] + bflo(qq.w) * n1[2] + bfhi(qq.w) * n1[3]; } }
    qn += __shfl_xor(qn, 32);
    float rs = 0.f;
#pragma unroll
    for (int sb = 0; sb < 2; ++sb) {
        if (sb <= th) {
            f32x16 sacc;
#pragma unroll
            for (int r = 0; r < 16; ++r) sacc[r] = 0.f;
#pragma unroll
            for (int s4 = 0; s4 < 4; ++s4) { const s16x8 ak = *(const LAS s16x8*)(Ks + (cl * 64 + sb * 32 + r32) * 72 + 16 * s4 + 8 * half);
                sacc = __builtin_amdgcn_mfma_f32_32x32x16_bf16(ak, qf[s4], sacc, 0, 0, 0); }
            const float* ap = MLS + MLN + bh * 4096 + c * 64 + sb * 32 + 4 * half;
#pragma unroll
            for (int g = 0; g < 4; ++g) { const f32x4 av = *(const f32x4*)(ap + 8 * g);
#pragma unroll
                for (int i = 0; i < 4; ++i) { const int s = sb * 32 + 8 * g + 4 * half + i; const float v = (s <= tloc) ? sacc[4 * g + i] * __expf(bs_t + av[i] - mt_t) : 0.f; sacc[4 * g + i] = v; rs += v; } }
#pragma unroll
            for (int s2 = 0; s2 < 2; ++s2) {
                u32x4 w; w.x = pkbf(sacc[8 * s2], sacc[8 * s2 + 1]); w.y = pkbf(sacc[8 * s2 + 2], sacc[8 * s2 + 3]); w.z = pkbf(sacc[8 * s2 + 4], sacc[8 * s2 + 5]); w.w = pkbf(sacc[8 * s2 + 6], sacc[8 * s2 + 7]);
                const s16x8 pf = __builtin_bit_cast(s16x8, w);
#pragma unroll
                for (int eb = 0; eb < 2; ++eb) {
                    const LAS bf16* vr = VT + (cl * 64 + eb * 32 + r32) * 72 + sb * 32 + 16 * s2 + 4 * half;
                    const u32x2 v0 = *(const LAS u32x2*)vr, v1 = *(const LAS u32x2*)(vr + 8);
                    const u32x4 vv = (u32x4){v0.x, v0.y, v1.x, v1.y};
                    oacc[eb] = __builtin_amdgcn_mfma_f32_32x32x16_bf16(__builtin_bit_cast(s16x8, vv), pf, oacc[eb], 0, 0, 0);
                }
            }
        }
    }
    rs += __shfl_xor(rs, 32);
    const float den = iw_t * qn + rs;
    const float dn = 1.f / fmaxf(fabsf(den), __expf(-mt_t));
    float ss = 0.f;
#pragma unroll
    for (int eb = 0; eb < 2; ++eb)
#pragma unroll
        for (int r = 0; r < 16; ++r) { const float v = oacc[eb][r] * dn; oacc[eb][r] = v; ss = fmaf(v, v, ss); }
    ss += __shfl_xor(ss, 32);
    const float rr = 1.f / sqrtf(ss * (1.f / 64.f) + EPS);
    const size_t tok = (size_t)b * SEQ + tseq;
    const float* hg = p.ml_head_norm + l * 64;
#pragma unroll
    for (int eb = 0; eb < 2; ++eb)
#pragma unroll
        for (int g = 0; g < 4; ++g) { const int e0 = eb * 32 + 8 * g + 4 * half; const f32x4 gg = *(const f32x4*)(hg + e0);
            const u32x2 og = *(const u32x2*)(Z + tok * ZP + 1536 + h * 64 + e0);
            u32x2 w; w.x = pkbf(sigmoidf_(bflo(og.x)) * oacc[eb][4 * g] * rr * gg[0], sigmoidf_(bfhi(og.x)) * oacc[eb][4 * g + 1] * rr * gg[1]);
            w.y = pkbf(sigmoidf_(bflo(og.y)) * oacc[eb][4 * g + 2] * rr * gg[2], sigmoidf_(bfhi(og.y)) * oacc[eb][4 * g + 3] * rr * gg[3]);
            *(u32x2*)(O1 + tok * 256 + h * 64 + e0) = w; }
}
__device__ __forceinline__ float relu_(float x) { return __builtin_amdgcn_fmed3f(x, 0.f, __builtin_inff()); }
__device__ __forceinline__ unsigned key16(float s) { const float f = __builtin_amdgcn_fmed3f(floorf(fmaf(s, 512.f, 32768.f)), 0.f, 65535.f); return (unsigned)f; }
__device__ __forceinline__ unsigned mono_bits(float s) { s = (s == 0.f) ? 0.f : s; const unsigned u = __float_as_uint(s); return (u & 0x80000000u) ? ~u : (u | 0x80000000u); }
__device__ __forceinline__ void dsa_item(const Params& p, int lds_l, int b, int qt, LAS unsigned char* lds, int wv) {
    const int tid = tid_fresh(wv), lane = tid & 63, w = wv, half = lane >> 5, r32 = lane & 31;
    const bf16* Z = (const bf16*)(p.ws + WS_BIG); const float* ZS = (const float*)(p.ws + WS_ZS); const bf16* IK = (const bf16*)(p.ws + WS_IK); bf16* O3 = (bf16*)(p.ws + WS_O + 3 * OB_STRIDE);
    LAS unsigned* hist = (LAS unsigned*)lds + w * 2048;
    LAS unsigned* maskw = (LAS unsigned*)(lds + 65536);
    LAS bf16* KC = (LAS bf16*)(lds + 81920);
    LAS bf16* Kd = (LAS bf16*)lds; LAS bf16* VTd = Kd + 64 * 72;
    const size_t tokb = (size_t)b * SEQ; const int tb = qt * 32 + 4 * w;
    const int ntiles = qt + 1, nkeys = ntiles * 32, nchunks = (ntiles + 15) >> 4;
    s16x8 aq0, aq1;
    { const int qrow = 2 * ((r32 >> 2) & 1) + (r32 >> 4), hrow = 4 * ((r32 >> 3) & 1) + (r32 & 3);
      const bf16* ap = Z + (tokb + tb + qrow) * ZP + 2816 + hrow * 32 + half * 8; aq0 = *(const s16x8*)ap; aq1 = *(const s16x8*)(ap + 16); }
    float wq[2][8];
#pragma unroll
    for (int s = 0; s < 2; ++s) { const float* wp = ZS + (tokb + tb + 2 * half + s) * ZSP + 160; const f32x4 x0 = *(const f32x4*)wp, x1 = *(const f32x4*)(wp + 4);
        wq[s][0] = x0[0]; wq[s][1] = x0[1]; wq[s][2] = x0[2]; wq[s][3] = x0[3]; wq[s][4] = x1[0]; wq[s][5] = x1[1]; wq[s][6] = x1[2]; wq[s][7] = x1[3]; }
    unsigned tau[4], prefix[4]; int quota[4], krem[4], eqs[2]; bool allsel[4];
    LAS unsigned* cand = (LAS unsigned*)(lds + 114688) + w * 768;
    LAS unsigned* oflag = (LAS unsigned*)(lds + LDS_BYTES - 48);
    const unsigned lowmask = (1u << r32) - 1u;
#define DSA_SCORES(ktl, sc) do { const LAS bf16* kp_ = KC + ((ktl) * 32 + r32) * 32 + half * 8; \
        const s16x8 b0_ = *(const LAS s16x8*)kp_, b1_ = *(const LAS s16x8*)(kp_ + 16); f32x16 a_ = {0.f, 0.f, 0.f, 0.f, 0.f, 0.f, 0.f, 0.f, 0.f, 0.f, 0.f, 0.f, 0.f, 0.f, 0.f, 0.f}; \
        a_ = __builtin_amdgcn_mfma_f32_32x32x16_bf16(aq0, b0_, a_, 0, 0, 0); a_ = __builtin_amdgcn_mfma_f32_32x32x16_bf16(aq1, b1_, a_, 0, 0, 0); \
        _Pragma("unroll") for (int s_ = 0; s_ < 2; ++s_) { float pt_ = wq[s_][0] * relu_(a_[8 * s_]); \
            _Pragma("unroll") for (int j_ = 1; j_ < 8; ++j_) pt_ = fmaf(wq[s_][j_], relu_(a_[8 * s_ + j_]), pt_); sc[s_] = pt_; } } while (0)
    int mode = (qt >= 8) ? 0 : 1;
#pragma unroll 1
    for (int attempt = 0; attempt < 2; ++attempt) {
        const int npass = (qt >= 8) ? (mode ? 4 : 1) : 0;
#pragma unroll
        for (int g = 0; g < 4; ++g) { tau[g] = 0u; prefix[g] = 0u; quota[g] = 1 << 30; krem[g] = 256; allsel[g] = true; }
        eqs[0] = 0; eqs[1] = 0;
        if (tid == 0) *oflag = 0u;
#pragma unroll 1
        for (int pass = 0; pass <= npass; ++pass) {
            const bool comp = (pass == npass);
            const int shift = 8 * (npass - 1 - pass);
            if (!comp) {
#pragma unroll
                for (int i = 0; i < 8; ++i) *(LAS u32x4*)(hist + (i * 64 + lane) * 4) = (u32x4){0u, 0u, 0u, 0u};
            }
            const unsigned pfa = half ? prefix[2] : prefix[0], pfb = half ? prefix[3] : prefix[1];
            const int ta = tb + 2 * half, tbq = ta + 1;
            u32x4 pre[4];
#pragma unroll
            for (int i = 0; i < 4; ++i) { const int kb = (tid * 16 + i * 8192) >> 6; pre[i] = (kb < nkeys) ? *(const u32x4*)((const unsigned char*)(IK + tokb * 32) + tid * 16 + i * 8192) : (u32x4){0u, 0u, 0u, 0u}; }
#pragma unroll 1
            for (int ch = 0; ch < nchunks; ++ch) {
                __syncthreads();
#pragma unroll
                for (int i = 0; i < 4; ++i) *(LAS u32x4*)((LAS unsigned char*)KC + tid * 16 + i * 8192) = pre[i];
                __syncthreads();
                if (ch + 1 < nchunks) {
#pragma unroll
                    for (int i = 0; i < 4; ++i) { const int kb = (ch + 1) * 512 + ((tid * 16 + i * 8192) >> 6);
                        pre[i] = (kb < nkeys) ? *(const u32x4*)((const unsigned char*)(IK + (tokb + (size_t)(ch + 1) * 512) * 32) + tid * 16 + i * 8192) : (u32x4){0u, 0u, 0u, 0u}; }
                }
                const int nt = min(16, ntiles - ch * 16);
                if (!comp) {
#pragma unroll 4
                    for (int ktl = 0; ktl < nt; ++ktl) {
                        float sc[2]; DSA_SCORES(ktl, sc);
                        const int key = (ch * 16 + ktl) * 32 + r32;
                        const float sa = sc[0], sb = sc[1];
                        if (mode == 0) {
                            const unsigned ba = key16(sa) >> 6, bb = key16(sb) >> 6;
                            if (key <= ta) __hip_atomic_fetch_add(hist + (2 * half) * 512 + (ba >> 1), (ba & 1u) ? 0x10000u : 1u, __ATOMIC_RELAXED, __HIP_MEMORY_SCOPE_WORKGROUP);
                            if (key <= tbq) __hip_atomic_fetch_add(hist + (2 * half + 1) * 512 + (bb >> 1), (bb & 1u) ? 0x10000u : 1u, __ATOMIC_RELAXED, __HIP_MEMORY_SCOPE_WORKGROUP);
                        } else {
                        const unsigned ma = mono_bits(sa), mb = mono_bits(sb);
                        const bool oka = (key <= ta) && (pass == 0 || (ma >> (shift + 8)) == pfa);
                        const bool okb = (key <= tbq) && (pass == 0 || (mb >> (shift + 8)) == pfb);
                        if (oka) __hip_atomic_fetch_add(hist + (2 * half) * 256 + ((ma >> shift) & 255u), 1u, __ATOMIC_RELAXED, __HIP_MEMORY_SCOPE_WORKGROUP);
                        if (okb) __hip_atomic_fetch_add(hist + (2 * half + 1) * 256 + ((mb >> shift) & 255u), 1u, __ATOMIC_RELAXED, __HIP_MEMORY_SCOPE_WORKGROUP);
                        }
                    }
                } else {
#pragma unroll 1
                    for (int ktl = 0; ktl < nt; ++ktl) {
                        float sc[2]; DSA_SCORES(ktl, sc);
                        const int key = (ch * 16 + ktl) * 32 + r32;
#pragma unroll
                        for (int s = 0; s < 2; ++s) {
                            const unsigned taus = half ? tau[2 + s] : tau[s]; const int quo = half ? quota[2 + s] : quota[s]; const bool alls = half ? allsel[2 + s] : allsel[s];
                            const unsigned m = mode ? mono_bits(sc[s]) : (key16(sc[s]) >> 6); const bool valid = key <= tb + 2 * half + s;
                            const bool eq = valid && (m == taus);
                            const unsigned beq = (unsigned)(__ballot(eq) >> (32 * half));
                            const int rank = eqs[s] + __popc(beq & lowmask);
                            const bool takeeq = mode ? (rank < quo) : alls;
                            const bool sel = valid && ((m > taus) || (eq && takeeq));
                            const unsigned bsel = (unsigned)(__ballot(sel) >> (32 * half));
                            if (r32 == 0) maskw[(4 * w + 2 * half + s) * 128 + ch * 16 + ktl] = bsel;
                            if (mode == 0 && !alls && eq && rank < 96) { cand[((2 * half + s) * 96 + rank) * 2] = mono_bits(sc[s]); cand[((2 * half + s) * 96 + rank) * 2 + 1] = (unsigned)key; }
                            eqs[s] += __popc(beq);
                        }
                    }
                }
            }
            if (!comp) {
                LDS_WAIT();
                if (mode == 0) {
#pragma unroll
                    for (int g = 0; g < 4; ++g) {
                        const u32x4 w0 = *(const LAS u32x4*)(hist + g * 512 + lane * 8), w1 = *(const LAS u32x4*)(hist + g * 512 + lane * 8 + 4);
                        const unsigned wd[8] = {w0.x, w0.y, w0.z, w0.w, w1.x, w1.y, w1.z, w1.w};
                        int c[16], tot = 0;
#pragma unroll
                        for (int j = 0; j < 8; ++j) { c[2 * j] = (int)(wd[j] & 0xffffu); c[2 * j + 1] = (int)(wd[j] >> 16); tot += c[2 * j] + c[2 * j + 1]; }
                        int v = tot;
#pragma unroll
                        for (int d = 1; d < 64; d <<= 1) { const int n = __shfl_down(v, d); if (lane + d < 64) v += n; }
                        const int k = krem[g]; int a = v - tot, fb = -1, fa = 0, fc = 0;
#pragma unroll
                        for (int j = 15; j >= 0; --j) { if (fb < 0 && a < k && a + c[j] >= k) { fb = j; fa = a; fc = c[j]; } a += c[j]; }
                        const unsigned long long mk = __ballot(fb >= 0);
                        const int src = (int)__builtin_ctzll(mk | (1ull << 63));
                        const int bin = __shfl(16 * lane + fb, src), above = __shfl(fa, src), cnt = __shfl(fc, src);
                        prefix[g] = (unsigned)bin; krem[g] = k - above;
                        tau[g] = prefix[g]; quota[g] = krem[g]; allsel[g] = (cnt == krem[g]);
                    }
                } else {
#pragma unroll
                for (int g = 0; g < 4; ++g) {
                    const u32x4 cv = *(const LAS u32x4*)(hist + g * 256 + lane * 4);
                    const int c0 = (int)cv.x, c1 = (int)cv.y, c2 = (int)cv.z, c3 = (int)cv.w, tot = c0 + c1 + c2 + c3;
                    int v = tot;
#pragma unroll
                    for (int d = 1; d < 64; d <<= 1) { const int n = __shfl_down(v, d); if (lane + d < 64) v += n; }
                    const int a3 = v - tot, a2 = a3 + c3, a1 = a2 + c2, a0 = a1 + c1; const int k = krem[g];
                    int fb = -1, fa = 0, fc = 0;
                    if (a3 < k && a3 + c3 >= k) { fb = 3; fa = a3; fc = c3; }
                    else if (a2 < k && a2 + c2 >= k) { fb = 2; fa = a2; fc = c2; }
                    else if (a1 < k && a1 + c1 >= k) { fb = 1; fa = a1; fc = c1; }
                    else if (a0 < k && a0 + c0 >= k) { fb = 0; fa = a0; fc = c0; }
                    const unsigned long long mk = __ballot(fb >= 0);
                    const int src = (int)__builtin_ctzll(mk | (1ull << 63));
                    const int bin = __shfl(4 * lane + fb, src), above = __shfl(fa, src), cnt = __shfl(fc, src);
                    prefix[g] = (prefix[g] << 8) | (unsigned)bin; krem[g] = k - above;
                    if (pass == npass - 1) { tau[g] = prefix[g]; quota[g] = krem[g]; allsel[g] = (cnt == krem[g]); }
                }
                }
            }
        }
        if (mode == 0 && npass) {
            LDS_WAIT();
#pragma unroll
            for (int g = 0; g < 4; ++g) {
                if (!allsel[g]) {
                    const int n = __shfl(eqs[g & 1], 32 * (g >> 1)), need = quota[g];
                    if (n > 96) { if (lane == 0) *oflag = 1u; }
                    else {
#pragma unroll 1
                        for (int i0 = 0; i0 < n; i0 += 64) {
                            const int i = i0 + lane; const bool act = i < n;
                            const unsigned mi = act ? cand[(g * 96 + i) * 2] : 0u, ki = act ? cand[(g * 96 + i) * 2 + 1] : 0u; int rank = 0;
#pragma unroll 1
                            for (int j = 0; j < n; ++j) { const unsigned mj = cand[(g * 96 + j) * 2], kj = cand[(g * 96 + j) * 2 + 1]; rank += ((mj > mi) || (mj == mi && kj < ki)) ? 1 : 0; }
                            if (act && rank < need) __hip_atomic_fetch_or(maskw + (4 * w + g) * 128 + (ki >> 5), 1u << (ki & 31u), __ATOMIC_RELAXED, __HIP_MEMORY_SCOPE_WORKGROUP);
                        }
                    }
                }
            }
        }
        __syncthreads();
        const unsigned of = *oflag;
        __syncthreads();
        if (mode == 0 && of != 0u) { mode = 1; continue; }
        break;
    }
    __syncthreads();
    {
        const float* sgn = p.dsa_qk_norm + lds_l * 128; float gqm = 0.f, gkm = 0.f;
#pragma unroll 2
        for (int i = 0; i < 64; ++i) { gqm = fmaxf(gqm, fabsf(sgn[i])); gkm = fmaxf(gkm, fabsf(sgn[64 + i])); }
        const float coff = 8.f * gqm * gkm;
        const int cb = w & 3, ksp = w >> 2, ql = 8 * cb + (r32 >> 2), hh = r32 & 3;
        s16x8 qf[4];
        { const bf16* qp = Z + (tokb + qt * 32 + ql) * ZP + 2560 + hh * 64 + 8 * half;
#pragma unroll
          for (int s4 = 0; s4 < 4; ++s4) qf[s4] = *(const s16x8*)(qp + 16 * s4); }
        f32x16 oacc[2];
#pragma unroll
        for (int db = 0; db < 2; ++db)
#pragma unroll
            for (int r = 0; r < 16; ++r) oacc[db][r] = 0.f;
        float lsum = 0.f;
        const int nT = (ntiles + 1) >> 1;
        const int skey = tid >> 3, sseg = tid & 7;
        const float* sgp = ZS + (tokb + skey) * ZSP + sseg * 16;
        f32x4 pr[4];
#pragma unroll
        for (int i = 0; i < 4; ++i) pr[i] = *(const f32x4*)(sgp + 4 * i);
#pragma unroll 1
        for (int tT = 0; tT < nT; ++tT) {
            __syncthreads();
            if (sseg < 4) {
                u32x4 w0, w1; w0.x = pkbf(pr[0][0], pr[0][1]); w0.y = pkbf(pr[0][2], pr[0][3]); w0.z = pkbf(pr[1][0], pr[1][1]); w0.w = pkbf(pr[1][2], pr[1][3]);
                w1.x = pkbf(pr[2][0], pr[2][1]); w1.y = pkbf(pr[2][2], pr[2][3]); w1.z = pkbf(pr[3][0], pr[3][1]); w1.w = pkbf(pr[3][2], pr[3][3]);
                *(LAS u32x4*)(Kd + skey * 72 + sseg * 16) = w0; *(LAS u32x4*)(Kd + skey * 72 + sseg * 16 + 8) = w1;
            } else {
                LAS bf16* vd = VTd + ((sseg - 4) * 16) * 72 + skey;
#pragma unroll
                for (int i = 0; i < 4; ++i) { const unsigned a0 = pkbf(pr[i][0], pr[i][1]), a1 = pkbf(pr[i][2], pr[i][3]);
                    vd[(4 * i) * 72] = (bf16)(a0 & 0xffffu); vd[(4 * i + 1) * 72] = (bf16)(a0 >> 16); vd[(4 * i + 2) * 72] = (bf16)(a1 & 0xffffu); vd[(4 * i + 3) * 72] = (bf16)(a1 >> 16); }
            }
            __syncthreads();
            if (tT + 1 < nT) {
#pragma unroll
                for (int i = 0; i < 4; ++i) pr[i] = *(const f32x4*)(sgp + (size_t)(tT + 1) * 64 * ZSP + 4 * i);
            }
            const int st = 2 * tT + ksp;
            if (st < ntiles) {
                const unsigned mw = maskw[ql * 128 + st];
                f32x16 sacc;
#pragma unroll
                for (int r = 0; r < 16; ++r) sacc[r] = 0.f;
#pragma unroll
                for (int s4 = 0; s4 < 4; ++s4) { const s16x8 ak = *(const LAS s16x8*)(Kd + (32 * ksp + r32) * 72 + 16 * s4 + 8 * half);
                    sacc = __builtin_amdgcn_mfma_f32_32x32x16_bf16(ak, qf[s4], sacc, 0, 0, 0); }
#pragma unroll
                for (int r = 0; r < 16; ++r) { const int kbit = 8 * (r >> 2) + 4 * half + (r & 3); const float pe = ((mw >> kbit) & 1u) ? __expf(sacc[r] - coff) : 0.f; sacc[r] = pe; lsum += pe; }
#pragma unroll
                for (int s2 = 0; s2 < 2; ++s2) {
                    u32x4 wp; wp.x = pkbf(sacc[8 * s2], sacc[8 * s2 + 1]); wp.y = pkbf(sacc[8 * s2 + 2], sacc[8 * s2 + 3]); wp.z = pkbf(sacc[8 * s2 + 4], sacc[8 * s2 + 5]); wp.w = pkbf(sacc[8 * s2 + 6], sacc[8 * s2 + 7]);
                    const s16x8 pf = __builtin_bit_cast(s16x8, wp);
#pragma unroll
                    for (int db = 0; db < 2; ++db) {
                        const LAS bf16* vr = VTd + (db * 32 + r32) * 72 + 32 * ksp + 16 * s2 + 4 * half;
                        const u32x2 v0 = *(const LAS u32x2*)vr, v1 = *(const LAS u32x2*)(vr + 8);
                        const u32x4 vv = (u32x4){v0.x, v0.y, v1.x, v1.y};
                        oacc[db] = __builtin_amdgcn_mfma_f32_32x32x16_bf16(__builtin_bit_cast(s16x8, vv), pf, oacc[db], 0, 0, 0);
                    }
                }
            }
        }
        lsum += __shfl_xor(lsum, 32);
        __syncthreads();
        LAS float* xch = (LAS float*)(lds + 81920) + (w & 3) * (33 * 64);
        if (ksp == 1) {
#pragma unroll
            for (int db = 0; db < 2; ++db)
#pragma unroll
                for (int r = 0; r < 16; ++r) xch[(db * 16 + r) * 64 + lane] = oacc[db][r];
            xch[32 * 64 + lane] = lsum;
        }
        __syncthreads();
        if (ksp == 0) {
            const float is = 1.f / (lsum + xch[32 * 64 + lane]);
            bf16* orow = O3 + (tokb + qt * 32 + ql) * 256 + hh * 64;
#pragma unroll
            for (int db = 0; db < 2; ++db)
#pragma unroll
                for (int g = 0; g < 4; ++g) { const int d0 = db * 32 + 8 * g + 4 * half;
                    const float x0 = (oacc[db][4 * g] + xch[(db * 16 + 4 * g) * 64 + lane]) * is, x1 = (oacc[db][4 * g + 1] + xch[(db * 16 + 4 * g + 1) * 64 + lane]) * is;
                    const float x2 = (oacc[db][4 * g + 2] + xch[(db * 16 + 4 * g + 2) * 64 + lane]) * is, x3 = (oacc[db][4 * g + 3] + xch[(db * 16 + 4 * g + 3) * 64 + lane]) * is;
                    u32x2 wo; wo.x = pkbf(x0, x1); wo.y = pkbf(x2, x3); *(u32x2*)(orow + d0) = wo; }
        }
    }
#undef DSA_SCORES
    __syncthreads();
}

constexpr int Q_ML = 32, Q_DIFF = 512, Q_DSA = 1024, Q_SB = 256, Q_TOTAL = Q_ML + Q_DIFF + Q_DSA + Q_SB;
__device__ __forceinline__ int next_item(unsigned* ctr, LAS int* slot, int wv) {
    __syncthreads();
    if (tid_fresh(wv) == 0) *slot = (int)atomicAdd(ctr, 1u);
    __syncthreads();
    return *slot;
}
__device__ __forceinline__ void mixer_phase1(int l, LAS unsigned char* lds, int wv, int co = 0) {
    LAS int* slot = (LAS int*)(lds + LDS_BYTES - 64);
    { const Params p = load_params(); unsigned* ctr = (unsigned*)(p.ws + WS_CTL) + 64 * (4 * l + 0 + co);
      for (;;) { const int it = next_item(ctr, slot, wv); if (it >= Q_DIFF) break; diffm_item(p, l, it & 31, 15 - (it >> 5), lds, wv); } }
    { const Params p = load_params(); unsigned* ctr = (unsigned*)(p.ws + WS_CTL) + 64 * (4 * l + 1 + co);
      for (;;) { const int it = next_item(ctr, slot, wv); if (it >= 512) break; mlB_item(p, l, it & 31, it >> 5, lds, wv); } }
}
__device__ __forceinline__ void mixer_phase2(int l, LAS unsigned char* lds, int wv, int co = 0) {
    LAS int* slot = (LAS int*)(lds + LDS_BYTES - 64);
    { const Params p = load_params(); unsigned* ctr = (unsigned*)(p.ws + WS_CTL) + 64 * (4 * l + 2 + co);
      for (;;) { const int it = next_item(ctr, slot, wv); if (it >= 32 + Q_DSA) break;
          if (it < 32) mlS_item(p, it, wv); else { const int i = it - 32; dsa_item(p, l, i & 7, 127 - (i >> 3), lds, wv); } } }
}
__device__ __forceinline__ void mixer_phase3(int l, LAS unsigned char* lds, int wv, int co = 0) {
    LAS int* slot = (LAS int*)(lds + LDS_BYTES - 64);
    { const Params p = load_params(); unsigned* ctr = (unsigned*)(p.ws + WS_CTL) + 64 * (4 * l + 3 + co);
      for (;;) { const int it = next_item(ctr, slot, wv); if (it >= 512) break; mlD_item(p, l, it & 31, it >> 5, lds, wv); } }
    { const Params p = load_params(); unsigned* ctr = (unsigned*)(p.ws + WS_CTL) + 64 * (8 + l + co);
      for (;;) { const int it = next_item(ctr, slot, wv); if (it >= Q_SB) break; sb_item(p, l, it >> 3, it & 7, lds, wv); } }
}

#define XB_TMO      128
#define XB_XCNT(j)  (256  + 64 * (j))
#define XB_XSUB(j)  (1280 + 64 * (j))
#define XB_XGEN(j)  (2304 + 64 * (j))
#define XB_TOP      3328
#define XB_TOPGEN   3392
#define XCD_BAR_WORDS 3456
#define XB_SPIN_CAP (1u << 20)
constexpr int CW_BAR = 8192;
__device__ __forceinline__ unsigned xb_ld(unsigned* p)              { return __hip_atomic_load(p, __ATOMIC_RELAXED, __HIP_MEMORY_SCOPE_AGENT); }
__device__ __forceinline__ unsigned xb_add(unsigned* p, unsigned v) { return __hip_atomic_fetch_add(p, v, __ATOMIC_RELAXED, __HIP_MEMORY_SCOPE_AGENT); }
__device__ __forceinline__ unsigned xb_xcc_id() { return (unsigned)__builtin_amdgcn_s_getreg((3 << 11) | 20) & 0xFu; }
#define XB_SPIN(cond, bar) do { unsigned _sp = 0; while (cond) { __builtin_amdgcn_s_sleep(1); \
    if ((++_sp & 255u) == 0u) { if (xb_ld(&(bar)[XB_TMO])) break; if (_sp > XB_SPIN_CAP) { atomicAdd(&(bar)[XB_TMO], 1u); break; } } } } while (0)
__device__ __forceinline__ void xcd_post(int wv) {
    const Params p = load_params(); unsigned* bar = (unsigned*)(p.ws + WS_CTL) + CW_BAR;
    if (tid_fresh(wv) == 0) (void)xb_add(&bar[XB_XCNT(xb_xcc_id())], 1u);
}
__device__ __forceinline__ void xcd_barrier_complete(unsigned* bar, unsigned x, unsigned& nloc, unsigned& nx) {
    const unsigned G = gridDim.x * gridDim.y * gridDim.z;
    unsigned sum, cnt, mine, sp = 0u;
    for (;;) {
        sum = 0u; cnt = 0u; mine = 0u;
#pragma unroll
        for (unsigned j = 0; j < 16; ++j) { const unsigned c = xb_ld(&bar[XB_XCNT(j)]); sum += c; cnt += (c > 0u) ? 1u : 0u; mine = (j == x) ? c : mine; }
        if (sum == G) break;
        __builtin_amdgcn_s_sleep(1);
        if ((++sp & 255u) == 0u) { if (xb_ld(&bar[XB_TMO])) break; if (sp > XB_SPIN_CAP) { atomicAdd(&bar[XB_TMO], 1u); break; } }
    }
    nloc = mine > 0u ? mine : 1u; nx = cnt > 0u ? cnt : 1u;
}
__device__ __forceinline__ void gsync(LAS unsigned char* lds, int wv) {
    asm volatile("s_waitcnt vmcnt(0)" ::: "memory");
    __syncthreads();
    if (tid_fresh(wv) == 0) {
        const Params p = load_params(); unsigned* bar = (unsigned*)(p.ws + WS_CTL) + CW_BAR;
        volatile LAS unsigned* st = (volatile LAS unsigned*)(lds + LDS_BYTES - 32);
        const unsigned x = xb_xcc_id();
        __builtin_amdgcn_s_waitcnt(0);
        unsigned nloc = st[0], nx = st[1];
        if (nloc == 0u) { xcd_barrier_complete(bar, x, nloc, nx); st[0] = nloc; st[1] = nx; }
        const unsigned old = xb_add(&bar[XB_XSUB(x)], 1u);
        const unsigned gen = old / nloc;
        if (old + 1u == (gen + 1u) * nloc) {
            __builtin_amdgcn_fence(__ATOMIC_RELEASE, "agent");
            asm volatile("s_waitcnt vmcnt(0)" ::: "memory");
            const unsigned og = xb_add(&bar[XB_TOP], 1u);
            const unsigned tg = og / nx;
            if (og + 1u == (tg + 1u) * nx) xb_add(&bar[XB_TOPGEN], 1u);
            else XB_SPIN(xb_ld(&bar[XB_TOPGEN]) == tg, bar);
            __builtin_amdgcn_fence(__ATOMIC_ACQUIRE, "agent");
            xb_add(&bar[XB_XGEN(x)], 1u);
            asm volatile("s_waitcnt vmcnt(0)" ::: "memory");
        } else {
            XB_SPIN(xb_ld(&bar[XB_XGEN(x)]) == gen, bar);
            __builtin_amdgcn_fence(__ATOMIC_ACQUIRE, "agent");
            asm volatile("s_waitcnt vmcnt(0)" ::: "memory");
        }
    }
    __syncthreads();
}

#define PH_LOCALS const Params p = load_params(); const int tid = tid_fresh(wv), lane = tid & 63, wave = tid >> 6; const int gw = (int)blockIdx.x * NWAVES + wave, ngw = (int)gridDim.x * NWAVES; \
    (void)lane; (void)gw; (void)ngw; bf16* HN = (bf16*)(p.ws + WS_HN); bf16* BIGB = (bf16*)(p.ws + WS_BIG); (void)HN; (void)BIGB;
template <int l> __device__ __forceinline__ void layer_body(cg::grid_group& grid, LAS unsigned char* lds, const int wv) {
        { PH_LOCALS const unsigned char* wl = p.ws + WS_W + (size_t)l * WL_STRIDE; EpiSwiglu E{l * 3 + 0}; run_gemm(lds, HN, (const bf16*)(wl + WL_GU1), T, 2 * FF, D, E, wv); }
        gsync(lds, wv);
        { PH_LOCALS const unsigned char* wl = p.ws + WS_W + (size_t)l * WL_STRIDE; EpiResid E{l == 0 ? 1 : 0, 0.5f, l * 3 + 1}; run_gemm(lds, BIGB, (const bf16*)(wl + WL_D1), T, D, FF, E, wv); }
        gsync(lds, wv);
        { PH_LOCALS const unsigned char* wl = p.ws + WS_W + (size_t)l * WL_STRIDE; EpiZ E{l * 3 + 1}; run_gemm(lds, HN, (const bf16*)(wl + WL_INA), T, 3328, D, E, wv); }
        gsync(lds, wv);
        { PH_LOCALS if (gw < 32) ml_prepass(p, l, gw, lane); prep_phase(p, l, gw, ngw, lane); }
        gsync(lds, wv);
        mixer_phase1(l, lds, wv);
#if PROBE_DUP & 1
        gsync(lds, wv); mixer_phase1(l, lds, wv, 16);
#endif
        gsync(lds, wv);
        mixer_phase2(l, lds, wv);
#if PROBE_DUP & 2
        gsync(lds, wv); mixer_phase2(l, lds, wv, 16);
#endif
        gsync(lds, wv);
        mixer_phase3(l, lds, wv);
#if PROBE_DUP & 4
        gsync(lds, wv); mixer_phase3(l, lds, wv, 16);
#endif
        gsync(lds, wv);
#pragma unroll 1
        for (int hb = 0; hb < 2; ++hb) {
            { PH_LOCALS const unsigned char* wl = p.ws + WS_W + (size_t)l * WL_STRIDE; EpiSig E{l * 3 + 1}; run_gemm(lds, HN, (const bf16*)(wl + WL_G) + (size_t)hb * 2 * D * D, T, 2 * D, D, E, wv); }
            gsync(lds, wv);
#pragma unroll 1
            for (int bb = 0; bb < 2; ++bb) {
                PH_LOCALS const unsigned char* wl = p.ws + WS_W + (size_t)l * WL_STRIDE; const int b = hb * 2 + bb;
                EpiGate E{bb * D, b == 0 ? 1 : 0};
                run_gemm(lds, (const bf16*)(p.ws + WS_O + b * OB_STRIDE), (const bf16*)(wl + WL_BR) + (size_t)b * D * 256, T, D, 256, E, wv);
            }
            gsync(lds, wv);
        }
        { PH_LOCALS const unsigned char* wl = p.ws + WS_W + (size_t)l * WL_STRIDE; EpiResid E{0, 1.0f, l * 3 + 2}; run_gemm(lds, (const bf16*)(p.ws + WS_BIG + 128 * MiB), (const bf16*)(wl + WL_OUT), T, D, D, E, wv); }
        gsync(lds, wv);
        { PH_LOCALS const unsigned char* wl = p.ws + WS_W + (size_t)l * WL_STRIDE; EpiSwiglu E{l * 3 + 2}; run_gemm(lds, HN, (const bf16*)(wl + WL_GU2), T, 2 * FF, D, E, wv); }
        gsync(lds, wv);
        { PH_LOCALS const unsigned char* wl = p.ws + WS_W + (size_t)l * WL_STRIDE; EpiResid E{0, 0.5f, (l + 1 < DEPTH) ? (l + 1) * 3 : -1}; run_gemm(lds, BIGB, (const bf16*)(wl + WL_D2), T, D, FF, E, wv); }
        if (l + 1 < DEPTH) gsync(lds, wv);
    }

__global__ void __launch_bounds__(NTHR, 2) hybrid_fwd(Params p_unused) {
    extern __shared__ __attribute__((aligned(16))) unsigned char lds_raw[];
    LAS unsigned char* lds = (LAS unsigned char*)lds_raw;
    cg::grid_group grid = cg::this_grid();
    const int wv = __builtin_amdgcn_readfirstlane((int)threadIdx.x >> 6);
    {
        PH_LOCALS
        SegRun R; R.base = 0; R.gw = gw; R.ngw = ngw; R.lane = lane; R.scr = (LAS float*)(lds + wave * 8704);
        for (int l = 0; l < DEPTH; ++l) convert_weights(p, l, R);
        if (blockIdx.x == 0 && tid < 64) ((unsigned*)(p.ws + WS_CTL))[64 * tid] = 0u;
        if (blockIdx.x == 0) for (int i = tid; i < XCD_BAR_WORDS; i += NTHR) ((unsigned*)(p.ws + WS_CTL))[CW_BAR + i] = 0u;
        if (tid < 8) ((LAS unsigned*)(lds + LDS_BYTES - 32))[tid] = 0u;
        for (int i = gw * 64 + lane; i < 5 * T; i += ngw * 64) { const int a_ = 1 + i / T; rs_ptr(p, a_)[i % T] = 0ull; }
        xb_rows(p.x, HN, rs_ptr(p, 0), gw, ngw, lane);
    }
    grid.sync();
    xcd_post(wv);
    layer_body<0>(grid, lds, wv);
    layer_body<1>(grid, lds, wv);
}

extern "C" void kernel_launch(void* const* d_in, const int* in_sizes, int n_in, void* d_out, int out_size, void* d_ws, size_t ws_size, hipStream_t stream) {
    static int grid = 0;
    if (grid == 0) {
        if (n_in != 20 || out_size != T * D || ws_size < WS_END2) { fprintf(stderr, "kernel_launch: unexpected shapes (n_in %d out %d ws %zu)\n", n_in, out_size, ws_size); grid = -1; return; }
        int dev = 0, cus = 0, per_cu = 0;
        hipGetDevice(&dev); hipDeviceGetAttribute(&cus, hipDeviceAttributeMultiprocessorCount, dev);
        hipFuncSetAttribute((const void*)hybrid_fwd, hipFuncAttributeMaxDynamicSharedMemorySize, LDS_BYTES);
        hipOccupancyMaxActiveBlocksPerMultiprocessor(&per_cu, (const void*)hybrid_fwd, NTHR, LDS_BYTES);
        if (per_cu < 1) { fprintf(stderr, "kernel_launch: occupancy query says %d\n", per_cu); per_cu = 1; }
        (void)hipGetLastError();
        grid = cus * 1;
    }
    if (grid < 0) return;
    Params p{};
    p.x = (const float*)d_in[0]; p.pos = (const int*)d_in[1];
    p.ffn1_norm = (const float*)d_in[2]; p.ffn1_gu = (const float*)d_in[3]; p.ffn1_down = (const float*)d_in[4]; p.mix_norm = (const float*)d_in[5]; p.w_in = (const float*)d_in[6];
    p.diff_qk_norm = (const float*)d_in[7]; p.diff_lambda = (const float*)d_in[8]; p.diff_head_norm = (const float*)d_in[9]; p.ml_conv_w = (const float*)d_in[10]; p.ml_conv_b = (const float*)d_in[11];
    p.ml_gate_bias = (const float*)d_in[12]; p.ml_head_norm = (const float*)d_in[13]; p.dsa_qk_norm = (const float*)d_in[14]; p.w_branch = (const float*)d_in[15]; p.w_out = (const float*)d_in[16];
    p.ffn2_norm = (const float*)d_in[17]; p.ffn2_gu = (const float*)d_in[18]; p.ffn2_down = (const float*)d_in[19];
    p.out = (float*)d_out; p.ws = (unsigned char*)d_ws;
    void* args[] = {&p};
    hipError_t e = hipLaunchCooperativeKernel((const void*)hybrid_fwd, dim3(grid), dim3(NTHR), args, LDS_BYTES, stream);
    if (e != hipSuccess) fprintf(stderr, "cooperative launch failed: %s (grid %d)\n", hipGetErrorString(e), grid);
}
```

```cpp
#include <hip/hip_runtime.h>
#include <hip/hip_cooperative_groups.h>
#include <cstdio>
#include <cstdint>
namespace cg = cooperative_groups;
#ifndef PROBE_DUP
#define PROBE_DUP 0
#endif
namespace pg8 {
#define PG8_LAS __attribute__((address_space(3)))
typedef unsigned short bf16_t;
typedef short bf16x8 __attribute__((ext_vector_type(8)));
typedef float f32x4 __attribute__((ext_vector_type(4)));
typedef unsigned u32x4 __attribute__((ext_vector_type(4)));
constexpr int BM = 256, BK = 64, HALF = 128, HTB = HALF * BK * 2  , STAGE_BYTES = 8 * HTB, NXCD = 8, WGM = 8;

__host__ __device__ __forceinline__ int lds_byte(int r, int c) { const int st = (r >> 4) * 2 + (c >> 5), rr = r & 15, cc = c & 31, ob = rr * 64 + cc * 2; return st * 1024 + (ob ^ (((ob >> 9) & 1) << 5)); }
__host__ __device__ __forceinline__ void stage_rc(int b, int& R, int& C) { const int st = b / 1024, sb = b % 1024, swz = sb ^ (((sb >> 9) & 1) << 5); R = (st >> 1) * 16 + swz / 64; C = (st & 1) * 32 + (swz % 64) / 2; }
__host__ __device__ __forceinline__ int perm32(int rho) { const int n = rho >> 4, i = rho & 15; return 8 * (i >> 2) + 4 * n + (i & 3); }

struct Unit { int pm, pn; };
struct Gemm { const bf16_t* A; const bf16_t* Bt; int M, N, K; };

struct StaticOrder {
    int nM, nN, nwg, G, c;
    __host__ __device__ void init(int M, int N, int G_, int c_) { nM = M / BM; nN = N / BM; nwg = nM * nN; G = G_; c = c_; }
    __host__ __device__ bool next(int i, Unit& u) const {
        const long L = (long)i * G + c; if (L >= nwg) return false;
        int wgid = (int)L; { const int q = nwg / NXCD, r = nwg % NXCD, xcd = wgid % NXCD, off = wgid / NXCD; wgid = (xcd < r ? xcd * (q + 1) : r * (q + 1) + (xcd - r) * q) + off; }
        const int nig = WGM * nN, gid = wgid / nig, fm = gid * WGM, gsz = (nM - fm) < WGM ? (nM - fm) : WGM;
        u.pm = fm + ((wgid % nig) % gsz); u.pn = (wgid % nig) / gsz; return true;
    }
    __device__ __forceinline__ void a_ready(const Unit&) const {}
    __device__ __forceinline__ void done(const Unit&) const {}
};

__device__ __forceinline__ unsigned cvt_pk_bf16(float lo, float hi) { unsigned r; asm volatile("v_cvt_pk_bf16_f32 %0, %1, %2" : "=v"(r) : "v"(lo), "v"(hi)); return r; }
template <class Epi, class Sched, bool ALIGN_EPI = false, bool SP2 = false>
__device__ __forceinline__ void gemm_phase(PG8_LAS unsigned char* lds, const Gemm g, const Sched& S, const Epi& E, const int wave_in) {
    unsigned z_ = 0u; asm volatile("" : "+v"(z_)); int w_ = wave_in; asm volatile("" : "+s"(w_));
    const int tid_ = w_ * 64 + (int)__builtin_amdgcn_mbcnt_hi(~0u, __builtin_amdgcn_mbcnt_lo(~0u, z_));
    const int tid = tid_, wid = __builtin_amdgcn_readfirstlane(tid >> 6), lane = tid & 63, wr = wid >> 2, wc = wid & 3, fr = lane & 15, fq = lane >> 4;
    const int K = g.K, nt = K / BK;
    unsigned voffA[2], voffB[2];
#pragma unroll
    for (int i = 0; i < 2; ++i) { int R, C; stage_rc(tid * 16 + i * 8192, R, C); const int Rb = Epi::PERM ? ((R & ~31) + perm32(R & 31)) : R;
        voffA[i] = (unsigned)(R * K + C) * 2u; voffB[i] = (unsigned)(Rb * K + C) * 2u; }
    const size_t kstep = (size_t)(BK * 2);
    const size_t hstep = (size_t)HALF * K * 2;
    const size_t tstep = 2 * hstep;
    const unsigned ldsw = (unsigned)wid * 1024u;
    const int aoff = lds_byte(wr * 64 + fr, fq * 8), boff = lds_byte(wc * 32 + fr, fq * 8);
#define PG8_SA(b, h) (((b) * 2 + (h)) * HTB)
#define PG8_SB(b, h) ((4 + (b) * 2 + (h)) * HTB)
#define PG8_STAGE(bufoff, gbase, voff) do { _Pragma("unroll") for (int _i = 0; _i < 2; ++_i) \
        __builtin_amdgcn_global_load_lds((const unsigned*)((const char*)(gbase) + (voff)[_i]), (PG8_LAS unsigned*)(lds + (bufoff) + ldsw + _i * 8192), 16, 0, 0); } while (0)
#define PG8_LDA(dst, b, h) do { _Pragma("unroll") for (int m = 0; m < 4; ++m) _Pragma("unroll") for (int k = 0; k < 2; ++k) dst[m][k] = *(const PG8_LAS bf16x8*)(lds + PG8_SA(b, h) + aoff + m * 2048 + k * 1024); } while (0)
#define PG8_LDB(dst, b, h) do { _Pragma("unroll") for (int n = 0; n < 2; ++n) _Pragma("unroll") for (int k = 0; k < 2; ++k) dst[n][k] = *(const PG8_LAS bf16x8*)(lds + PG8_SB(b, h) + boff + n * 2048 + k * 1024); } while (0)
#define PG8_MMA(ai, bj, At, Bt) do { __builtin_amdgcn_s_setprio(1); _Pragma("unroll") for (int m = 0; m < 4; ++m) _Pragma("unroll") for (int n = 0; n < 2; ++n) _Pragma("unroll") for (int k = 0; k < 2; ++k) \
        acc[ai][bj][m][n] = __builtin_amdgcn_mfma_f32_16x16x32_bf16(Bt[n][k], At[m][k], acc[ai][bj][m][n], 0, 0, 0); __builtin_amdgcn_s_setprio(0); } while (0)
#define PG8_WAIT_V(n) asm volatile("s_waitcnt vmcnt(" #n ")" ::: "memory")
#define PG8_WAIT_L(n) asm volatile("s_waitcnt lgkmcnt(" #n ")" ::: "memory")
#define PG8_BAR __builtin_amdgcn_s_barrier()
#define PG8_SCHED __builtin_amdgcn_sched_barrier(0)
    Unit cur, nxt; int ui = 0;
    if (!S.next(0, cur)) return;
    f32x4 acc[2][2][4][2];
#pragma unroll
    for (int a = 0; a < 2; ++a)
#pragma unroll
        for (int b = 0; b < 2; ++b)
#pragma unroll
            for (int m = 0; m < 4; ++m)
#pragma unroll
                for (int n = 0; n < 2; ++n) acc[a][b][m][n] = (f32x4){0.f, 0.f, 0.f, 0.f};
    bf16x8 At[4][2], B0[2][2], B1[2][2];
    const char* cA = (const char*)g.A + (size_t)cur.pm * tstep; const char* cB = (const char*)g.Bt + (size_t)cur.pn * tstep;
    S.a_ready(cur);
    if constexpr (SP2) {
        PG8_STAGE(PG8_SB(0, 0), cB, voffB); PG8_STAGE(PG8_SB(0, 1), cB + hstep, voffB); PG8_STAGE(PG8_SA(0, 0), cA, voffA); PG8_STAGE(PG8_SA(0, 1), cA + hstep, voffA);
        if (wr == 1) PG8_BAR;
        PG8_WAIT_V(2); PG8_BAR;
        PG8_STAGE(PG8_SB(1, 0), cB + kstep, voffB); PG8_STAGE(PG8_SA(1, 0), cA + kstep, voffA); PG8_STAGE(PG8_SB(1, 1), cB + hstep + kstep, voffB);
        PG8_WAIT_V(6); PG8_BAR;
    } else {
        PG8_STAGE(PG8_SB(0, 0), cB, voffB); PG8_STAGE(PG8_SA(0, 0), cA, voffA); PG8_STAGE(PG8_SB(0, 1), cB + hstep, voffB); PG8_STAGE(PG8_SA(0, 1), cA + hstep, voffA);
        if (wr == 1) PG8_BAR;
        PG8_WAIT_V(4); PG8_BAR;
        PG8_STAGE(PG8_SB(1, 0), cB + kstep, voffB); PG8_STAGE(PG8_SA(1, 0), cA + kstep, voffA); PG8_STAGE(PG8_SB(1, 1), cB + hstep + kstep, voffB);
        PG8_WAIT_V(6); PG8_BAR;
    }
    for (;;) {
        const bool has_next = S.next(ui + 1, nxt);
        const char* nA = has_next ? (const char*)g.A + (size_t)nxt.pm * tstep : cA; const char* nB = has_next ? (const char*)g.Bt + (size_t)nxt.pn * tstep : cB;
        for (int t = 0; t < nt; t += 2) {
            const bool last = (t == nt - 2);
            const char* a1 = cA + (size_t)(t + 1) * kstep;
            const char* a2 = last ? nA : cA + (size_t)(t + 2) * kstep; const char* b2 = last ? nB : cB + (size_t)(t + 2) * kstep;
            const char* a3 = a2 + kstep; const char* b3 = b2 + kstep;
            if (last && has_next) S.a_ready(nxt);
            if constexpr (SP2) {
            PG8_LDB(B0, 0, 0); PG8_LDB(B1, 0, 1); PG8_SCHED; PG8_LDA(At, 0, 0); PG8_STAGE(PG8_SA(1, 1), a1 + hstep, voffA);
            PG8_WAIT_V(8); PG8_WAIT_L(0); PG8_BAR; PG8_MMA(0, 0, At, B0); PG8_MMA(0, 1, At, B1); PG8_BAR; PG8_SCHED;
            PG8_LDA(At, 0, 1); PG8_STAGE(PG8_SB(0, 0), b2, voffB); PG8_STAGE(PG8_SB(0, 1), b2 + hstep, voffB); PG8_STAGE(PG8_SA(0, 0), a2, voffA);
            PG8_WAIT_V(8); PG8_WAIT_L(0); PG8_BAR; PG8_MMA(1, 0, At, B0); PG8_MMA(1, 1, At, B1); PG8_BAR; PG8_SCHED;
            PG8_LDB(B0, 1, 0); PG8_LDB(B1, 1, 1); PG8_SCHED; PG8_LDA(At, 1, 0); PG8_STAGE(PG8_SA(0, 1), a2 + hstep, voffA);
            PG8_WAIT_V(8); PG8_WAIT_L(0); PG8_BAR; PG8_MMA(0, 0, At, B0); PG8_MMA(0, 1, At, B1); PG8_BAR; PG8_SCHED;
            PG8_LDA(At, 1, 1); PG8_STAGE(PG8_SB(1, 0), b3, voffB); PG8_STAGE(PG8_SB(1, 1), b3 + hstep, voffB); PG8_STAGE(PG8_SA(1, 0), a3, voffA);
            PG8_WAIT_V(8); PG8_WAIT_L(0); PG8_BAR; PG8_MMA(1, 0, At, B0); PG8_MMA(1, 1, At, B1); PG8_BAR; PG8_SCHED;
            } else {
            PG8_LDB(B0, 0, 0); PG8_SCHED; PG8_LDA(At, 0, 0); PG8_STAGE(PG8_SA(1, 1), a1 + hstep, voffA);
            PG8_WAIT_L(8); PG8_BAR; PG8_WAIT_L(0); PG8_MMA(0, 0, At, B0); PG8_BAR; PG8_SCHED;
            PG8_LDB(B1, 0, 1); PG8_STAGE(PG8_SB(0, 0), b2, voffB);
            PG8_BAR; PG8_WAIT_L(0); PG8_MMA(0, 1, At, B1); PG8_BAR;
            PG8_LDA(At, 0, 1); PG8_STAGE(PG8_SA(0, 0), a2, voffA);
            PG8_BAR; PG8_WAIT_L(0); PG8_MMA(1, 0, At, B0); PG8_BAR; PG8_SCHED;
            PG8_STAGE(PG8_SB(0, 1), b2 + hstep, voffB);
            PG8_WAIT_V(6); PG8_BAR; PG8_MMA(1, 1, At, B1); PG8_BAR;
            PG8_LDB(B0, 1, 0); PG8_SCHED; PG8_LDA(At, 1, 0); PG8_STAGE(PG8_SA(0, 1), a2 + hstep, voffA);
            PG8_WAIT_L(8); PG8_BAR; PG8_WAIT_L(0); PG8_MMA(0, 0, At, B0); PG8_BAR; PG8_SCHED;
            PG8_LDB(B1, 1, 1); PG8_STAGE(PG8_SB(1, 0), b3, voffB);
            PG8_BAR; PG8_WAIT_L(0); PG8_MMA(0, 1, At, B1); PG8_BAR;
            PG8_LDA(At, 1, 1); PG8_STAGE(PG8_SA(1, 0), a3, voffA);
            PG8_BAR; PG8_WAIT_L(0); PG8_MMA(1, 0, At, B0); PG8_BAR; PG8_SCHED;
            PG8_STAGE(PG8_SB(1, 1), b3 + hstep, voffB);
            PG8_WAIT_V(6); PG8_BAR; PG8_MMA(1, 1, At, B1); PG8_BAR;
            }
        }
        if constexpr (ALIGN_EPI) { if (wr == 0) PG8_BAR; }
        if constexpr (!Epi::AFTER_DRAIN) { E(acc, cur, wr, wc, fr, fq); S.done(cur); }
        if (!has_next) break;
#pragma unroll
        for (int a = 0; a < 2; ++a)
#pragma unroll
            for (int b = 0; b < 2; ++b)
#pragma unroll
                for (int m = 0; m < 4; ++m)
#pragma unroll
                    for (int n = 0; n < 2; ++n) acc[a][b][m][n] = (f32x4){0.f, 0.f, 0.f, 0.f};
        cur = nxt; cA = nA; cB = nB; ++ui;
        if constexpr (ALIGN_EPI) { if (wr == 1) PG8_BAR; }
    }
    PG8_WAIT_V(0);
    if constexpr (!ALIGN_EPI) { if (wr == 0) PG8_BAR; }
    PG8_BAR;
    if constexpr (Epi::AFTER_DRAIN) { E.fused(acc, cur, wr, wc, fr, fq, lds, wid, lane); S.done(cur); }
#undef PG8_SA
#undef PG8_SB
#undef PG8_STAGE
#undef PG8_LDA
#undef PG8_LDB
#undef PG8_MMA
#undef PG8_WAIT_V
#undef PG8_WAIT_L
#undef PG8_BAR
#undef PG8_SCHED
}
}
#define LAS __attribute__((address_space(3)))
typedef unsigned short bf16;
typedef float f32x4 __attribute__((ext_vector_type(4)));
typedef float f32x16 __attribute__((ext_vector_type(16)));
typedef unsigned u32x4 __attribute__((ext_vector_type(4)));
typedef unsigned u32x2 __attribute__((ext_vector_type(2)));
typedef short s16x8 __attribute__((ext_vector_type(8)));

constexpr int NB = 8, SEQ = 4096, T = NB * SEQ, D = 1024, FF = 2816, DEPTH = 2, NIN = 7344, ZP = 3072, ZSP = 256;
constexpr int NTHR = 512, NWAVES = 8;
__host__ __device__ constexpr int col_dq(int l) { return l ? 2048 : 0; }
__host__ __device__ constexpr int col_dk(int l) { return l ? 2304 : 256; }
__host__ __device__ constexpr int col_sbk(int l) { return l ? 0 : 2048; }
constexpr int LDS_BYTES = 147456;
constexpr float EPS = 1e-6f;

constexpr size_t MiB = (size_t)1 << 20;
constexpr size_t WS_CTL = 0;
constexpr size_t WS_W = 1 * MiB, WL_STRIDE = 52 * MiB;
constexpr size_t WL_GU1 = 0, WL_D1 = 11534336, WL_INA = 17301504, WL_G = 24117248, WL_BR = 32505856, WL_OUT = 34603008, WL_GU2 = 36700160, WL_D2 = 48234496;
constexpr size_t WS_HN = 106 * MiB, WS_BIG = 170 * MiB, WS_ZS = 362 * MiB, WS_O = 394 * MiB, WS_IK = 458 * MiB, WS_END = 460 * MiB;
constexpr size_t OB_STRIDE = (size_t)T * 256 * 2;

struct Params {
    const float* x; const int* pos;
    const float *ffn1_norm, *ffn1_gu, *ffn1_down, *mix_norm, *w_in, *diff_qk_norm, *diff_lambda, *diff_head_norm, *ml_conv_w, *ml_conv_b, *ml_gate_bias, *ml_head_norm,
        *dsa_qk_norm, *w_branch, *w_out, *ffn2_norm, *ffn2_gu, *ffn2_down;
    float* out; unsigned char* ws;
};

__device__ __forceinline__ unsigned f2bf(float f) { unsigned u = __float_as_uint(f); return (u + 0x7fffu + ((u >> 16) & 1u)) >> 16; }
__device__ __forceinline__ unsigned pk2(float lo, float hi) { unsigned r; asm("v_cvt_pk_bf16_f32 %0, %1, %2" : "=v"(r) : "v"(lo), "v"(hi)); return r; }
__device__ __forceinline__ float bflo(unsigned w) { return __uint_as_float(w << 16); }
__device__ __forceinline__ float bfhi(unsigned w) { return __uint_as_float(w & 0xffff0000u); }
__device__ __forceinline__ float wave_sum(float v) {
#pragma unroll
    for (int o = 1; o < 64; o <<= 1) v += __shfl_xor(v, o);
    return v;
}
__device__ __forceinline__ float wave_max(float v) {
#pragma unroll
    for (int o = 1; o < 64; o <<= 1) v = fmaxf(v, __shfl_xor(v, o));
    return v;
}
__device__ __forceinline__ int lane_fresh() { unsigned z = 0u; asm volatile("" : "+v"(z)); return (int)__builtin_amdgcn_mbcnt_hi(~0u, __builtin_amdgcn_mbcnt_lo(~0u, z)); }
__device__ __forceinline__ int tid_fresh(int wv) { int w = wv; asm volatile("" : "+s"(w)); return w * 64 + lane_fresh(); }
#define LDS_WAIT() asm volatile("s_waitcnt lgkmcnt(0)" ::: "memory")
__device__ __forceinline__ float sigmoidf_(float x) { return 1.f / (1.f + __expf(-x)); }

__device__ __forceinline__ Params load_params() {
#if defined(__HIP_DEVICE_COMPILE__)
    const __attribute__((address_space(4))) Params* pp = (const __attribute__((address_space(4))) Params*)__builtin_amdgcn_kernarg_segment_ptr();
    asm volatile("" : "+s"(pp));
    Params r;
    r.x = pp->x; r.pos = pp->pos; r.ffn1_norm = pp->ffn1_norm; r.ffn1_gu = pp->ffn1_gu; r.ffn1_down = pp->ffn1_down; r.mix_norm = pp->mix_norm; r.w_in = pp->w_in; r.diff_qk_norm = pp->diff_qk_norm;
    r.diff_lambda = pp->diff_lambda; r.diff_head_norm = pp->diff_head_norm; r.ml_conv_w = pp->ml_conv_w; r.ml_conv_b = pp->ml_conv_b; r.ml_gate_bias = pp->ml_gate_bias; r.ml_head_norm = pp->ml_head_norm;
    r.dsa_qk_norm = pp->dsa_qk_norm; r.w_branch = pp->w_branch; r.w_out = pp->w_out; r.ffn2_norm = pp->ffn2_norm; r.ffn2_gu = pp->ffn2_gu; r.ffn2_down = pp->ffn2_down; r.out = pp->out; r.ws = pp->ws;
    return r;
#else
    return Params{};
#endif
}
typedef unsigned long long u64_t;
__device__ __forceinline__ u64_t* rs_ptr(const Params& p, int idx) { return (u64_t*)(p.ws + (idx < 3 ? (WS_CTL + 131072) : (105 * MiB))) + (size_t)(idx % 3) * T; }
__device__ __forceinline__ float row_rstd(const u64_t* rs, int row) { return 1.f / sqrtf((float)rs[row] * (1.f / (16777216.f * D)) + EPS); }
struct EpiSwiglu {
    static constexpr bool PERM = true, AFTER_DRAIN = false;
    int rsi;
    __device__ __forceinline__ void operator()(const f32x4 (&acc)[2][2][4][2], const pg8::Unit& u, int wr, int wc, int fr_in, int fq_in) const {
        const int ln_ = lane_fresh(); const int fr = ln_ & 15, fq = ln_ >> 4; (void)fr_in; (void)fq_in;
        const Params p = load_params(); bf16* O = (bf16*)(p.ws + WS_BIG); const u64_t* rs = rs_ptr(p, rsi);
        const int row0 = u.pm * 256 + wr * 64 + fr, col0 = u.pn * 128 + wc * 32 + 8 * fq;
#pragma unroll
        for (int ai = 0; ai < 2; ++ai)
#pragma unroll
            for (int m = 0; m < 4; ++m) {
                const int row = row0 + ai * 128 + m * 16; const float rr = row_rstd(rs, row);
                bf16* rowp = O + (size_t)row * FF + col0;
                float r[8];
#pragma unroll
                for (int n = 0; n < 2; ++n)
#pragma unroll
                    for (int j = 0; j < 4; ++j) { const float g = acc[ai][0][m][n][j] * rr, uu = acc[ai][1][m][n][j] * rr; r[4 * n + j] = g * sigmoidf_(g) * uu; }
                u32x4 w; w.x = pk2(r[0], r[1]); w.y = pk2(r[2], r[3]); w.z = pk2(r[4], r[5]); w.w = pk2(r[6], r[7]);
                *(u32x4*)rowp = w;
            }
    }
};
struct EpiResid {
    static constexpr bool PERM = true, AFTER_DRAIN = false;
    int base_is_x; float scale; int rsi;
    __device__ __forceinline__ void operator()(const f32x4 (&acc)[2][2][4][2], const pg8::Unit& u, int wr, int wc, int fr_in, int fq_in) const {
        const int ln_ = lane_fresh(); const int fr = ln_ & 15, fq = ln_ >> 4; (void)fr_in; (void)fq_in;
        const Params p = load_params(); const float* base = base_is_x ? p.x : p.out; float* out = p.out; bf16* XB = (rsi >= 0) ? (bf16*)(p.ws + WS_HN) : (bf16*)nullptr; u64_t* rs = rs_ptr(p, rsi >= 0 ? rsi : 0);
        const int row0 = u.pm * 256 + wr * 64 + fr, col0 = u.pn * 256 + wc * 32 + 8 * fq;
#pragma unroll
        for (int ai = 0; ai < 2; ++ai)
#pragma unroll
            for (int m = 0; m < 4; ++m) {
                const int row = row0 + ai * 128 + m * 16; const size_t ro = (size_t)row * D + col0; float ss = 0.f;
#pragma unroll
                for (int bj = 0; bj < 2; ++bj) {
                    const f32x4 v0 = *(const f32x4*)(base + ro + bj * 128) + acc[ai][bj][m][0] * scale, v1 = *(const f32x4*)(base + ro + bj * 128 + 4) + acc[ai][bj][m][1] * scale;
                    *(f32x4*)(out + ro + bj * 128) = v0; *(f32x4*)(out + ro + bj * 128 + 4) = v1;
                    if (XB) { u32x4 w; w.x = pk2(v0[0], v0[1]); w.y = pk2(v0[2], v0[3]); w.z = pk2(v1[0], v1[1]); w.w = pk2(v1[2], v1[3]); *(u32x4*)(XB + ro + bj * 128) = w;
                        ss += (v0[0] * v0[0] + v0[1] * v0[1]) + (v0[2] * v0[2] + v0[3] * v0[3]) + (v1[0] * v1[0] + v1[1] * v1[1]) + (v1[2] * v1[2] + v1[3] * v1[3]); }
                }
                if (XB) { ss += __shfl_xor(ss, 16); ss += __shfl_xor(ss, 32); if (fq == 0) atomicAdd(rs + row, (u64_t)(ss * 16777216.f)); }
            }
    }
};
struct EpiZ {
    static constexpr bool PERM = true, AFTER_DRAIN = false;
    int rsi;
    __device__ __forceinline__ void operator()(const f32x4 (&acc)[2][2][4][2], const pg8::Unit& u, int wr, int wc, int fr_in, int fq_in) const {
        const int ln_ = lane_fresh(); const int fr = ln_ & 15, fq = ln_ >> 4; (void)fr_in; (void)fq_in;
        const Params p = load_params(); bf16* Z = (bf16*)(p.ws + WS_BIG); float* ZS = (float*)(p.ws + WS_ZS); const u64_t* rs = rs_ptr(p, rsi);
        const int row0 = u.pm * 256 + wr * 64 + fr, cw = wc * 32 + 8 * fq;
        if (u.pn < 12) {
#pragma unroll
            for (int ai = 0; ai < 2; ++ai)
#pragma unroll
                for (int m = 0; m < 4; ++m) {
                    const int row = row0 + ai * 128 + m * 16; const float rr = row_rstd(rs, row);
                    bf16* rowp = Z + (size_t)row * ZP + u.pn * 256 + cw;
#pragma unroll
                    for (int bj = 0; bj < 2; ++bj) { const f32x4 v0 = acc[ai][bj][m][0] * rr, v1 = acc[ai][bj][m][1] * rr;
                        u32x4 w; w.x = pk2(v0[0], v0[1]); w.y = pk2(v0[2], v0[3]); w.z = pk2(v1[0], v1[1]); w.w = pk2(v1[2], v1[3]);
                        *(u32x4*)(rowp + bj * 128) = w; }
                }
        } else {
#pragma unroll
            for (int ai = 0; ai < 2; ++ai)
#pragma unroll
                for (int m = 0; m < 4; ++m) {
                    const int row = row0 + ai * 128 + m * 16; const float rr = row_rstd(rs, row);
                    float* rowp = ZS + (size_t)row * ZSP + cw;
#pragma unroll
                    for (int bj = 0; bj < 2; ++bj)
#pragma unroll
                        for (int n = 0; n < 2; ++n) *(f32x4*)(rowp + bj * 128 + 4 * n) = acc[ai][bj][m][n] * rr;
                }
        }
    }
};
struct EpiSig {
    static constexpr bool PERM = true, AFTER_DRAIN = false;
    int rsi;
    __device__ __forceinline__ void operator()(const f32x4 (&acc)[2][2][4][2], const pg8::Unit& u, int wr, int wc, int fr_in, int fq_in) const {
        const int ln_ = lane_fresh(); const int fr = ln_ & 15, fq = ln_ >> 4; (void)fr_in; (void)fq_in;
        const Params p = load_params(); bf16* SG = (bf16*)(p.ws + WS_BIG); const u64_t* rs = rs_ptr(p, rsi);
        const int row0 = u.pm * 256 + wr * 64 + fr, col0 = u.pn * 256 + wc * 32 + 8 * fq;
#pragma unroll
        for (int ai = 0; ai < 2; ++ai)
#pragma unroll
            for (int m = 0; m < 4; ++m) {
                const int row = row0 + ai * 128 + m * 16; const float rr = row_rstd(rs, row);
                bf16* rowp = SG + (size_t)row * (2 * D) + col0;
#pragma unroll
                for (int bj = 0; bj < 2; ++bj) { const f32x4 v0 = acc[ai][bj][m][0] * rr, v1 = acc[ai][bj][m][1] * rr;
                    u32x4 w; w.x = pk2(sigmoidf_(v0[0]), sigmoidf_(v0[1])); w.y = pk2(sigmoidf_(v0[2]), sigmoidf_(v0[3]));
                    w.z = pk2(sigmoidf_(v1[0]), sigmoidf_(v1[1])); w.w = pk2(sigmoidf_(v1[2]), sigmoidf_(v1[3]));
                    *(u32x4*)(rowp + bj * 128) = w; }
            }
    }
};
struct EpiGate {
    static constexpr bool PERM = true, AFTER_DRAIN = false;
    int sgoff; int first;
    __device__ __forceinline__ void operator()(const f32x4 (&acc)[2][2][4][2], const pg8::Unit& u, int wr, int wc, int fr_in, int fq_in) const {
        const int ln_ = lane_fresh(); const int fr = ln_ & 15, fq = ln_ >> 4; (void)fr_in; (void)fq_in;
        const Params p = load_params(); const bf16* SG = (const bf16*)(p.ws + WS_BIG); bf16* YB = (bf16*)(p.ws + WS_BIG + 128 * MiB);
        const int row0 = u.pm * 256 + wr * 64 + fr, col0 = u.pn * 256 + wc * 32 + 8 * fq;
#pragma unroll
        for (int ai = 0; ai < 2; ++ai)
#pragma unroll
            for (int m = 0; m < 4; ++m) {
                const int row = row0 + ai * 128 + m * 16; const size_t ro = (size_t)row * D + col0, so = (size_t)row * (2 * D) + sgoff + col0;
#pragma unroll
                for (int bj = 0; bj < 2; ++bj) {
                    const u32x4 sg = *(const u32x4*)(SG + so + bj * 128);
                    f32x4 v0 = (f32x4){bflo(sg.x), bfhi(sg.x), bflo(sg.y), bfhi(sg.y)} * acc[ai][bj][m][0], v1 = (f32x4){bflo(sg.z), bfhi(sg.z), bflo(sg.w), bfhi(sg.w)} * acc[ai][bj][m][1];
                    if (!first) { const u32x4 y = *(const u32x4*)(YB + ro + bj * 128);
                        v0 = v0 + (f32x4){bflo(y.x), bfhi(y.x), bflo(y.y), bfhi(y.y)}; v1 = v1 + (f32x4){bflo(y.z), bfhi(y.z), bflo(y.w), bfhi(y.w)}; }
                    u32x4 w; w.x = pk2(v0[0], v0[1]); w.y = pk2(v0[2], v0[3]); w.z = pk2(v1[0], v1[1]); w.w = pk2(v1[2], v1[3]); *(u32x4*)(YB + ro + bj * 128) = w;
                }
            }
    }
};

template <class Epi>
__device__ __forceinline__ void run_gemm(LAS unsigned char* lds, const bf16* A, const bf16* Bt, int M, int N, int K, const Epi& E, int wv) {
    pg8::Gemm g{A, Bt, M, N, K}; pg8::StaticOrder S; S.init(M, N, (int)gridDim.x, (int)blockIdx.x);
    pg8::gemm_phase<Epi, pg8::StaticOrder, true, true>((PG8_LAS unsigned char*)lds, g, S, E, wv);
}

__device__ __forceinline__ void tr_item(const float* W, int K, int srcN, int c0, int nv, bf16* WT, int r0, int k0, LAS float* scr, int lane, const float* gain) {
    const int c = lane & 31;
#pragma unroll 8
    for (int i = 0; i < 32; ++i) { const int kk = 2 * i + (lane >> 5); scr[kk * 33 + c] = (c < nv) ? W[(size_t)(k0 + kk) * srcN + c0 + c] * (gain ? gain[k0 + kk] : 1.f) : 0.f; }
    LDS_WAIT();
    const int c8 = lane & 7;
#pragma unroll
    for (int j = 0; j < 4; ++j) { const int n = (lane >> 3) + 8 * j; const LAS float* s = scr + (8 * c8) * 33 + n;
        u32x4 o; o.x = pk2(s[0 * 33], s[1 * 33]); o.y = pk2(s[2 * 33], s[3 * 33]); o.z = pk2(s[4 * 33], s[5 * 33]); o.w = pk2(s[6 * 33], s[7 * 33]);
        if (n < nv) *(u32x4*)(WT + (size_t)(r0 + n) * K + k0 + 8 * c8) = o; }
    LDS_WAIT();
}
struct SegRun { int base, gw, ngw, lane; LAS float* scr; };
__device__ __forceinline__ void run_seg(SegRun& R, const float* W, int K, int srcN, int c0, int ncols, bf16* WT, int r0, const float* gain = nullptr) {
    const int nblk = (ncols + 31) >> 5, nitems = (K >> 6) * nblk;
    int first = (R.gw - (R.base % R.ngw) + R.ngw) % R.ngw;
    for (int it = first; it < nitems; it += R.ngw) { const int kb = it / nblk, nb = it - kb * nblk; const int nv = min(32, ncols - nb * 32);
        tr_item(W, K, srcN, c0 + nb * 32, nv, WT, r0 + nb * 32, kb * 64, R.scr, R.lane, gain); }
    R.base += nitems;
}
__device__ __forceinline__ void convert_weights(const Params& p, int l, SegRun& R) {
    unsigned char* wl = p.ws + WS_W + (size_t)l * WL_STRIDE;
    for (int f = 0; f < 2; ++f) {
        const float* gu = (f ? p.ffn2_gu : p.ffn1_gu) + (size_t)l * D * 2 * FF; bf16* gut = (bf16*)(wl + (f ? WL_GU2 : WL_GU1));
        const float* gn = (f ? p.ffn2_norm : p.ffn1_norm) + l * D;
        for (int sg = 0; sg < 44; ++sg) run_seg(R, gu, D, 2 * FF, sg * 128, 128, gut, (sg % 22) * 256 + (sg / 22) * 128, gn);
        const float* dn = (f ? p.ffn2_down : p.ffn1_down) + (size_t)l * FF * D; bf16* dnt = (bf16*)(wl + (f ? WL_D2 : WL_D1));
        run_seg(R, dn, FF, D, 0, D, dnt, 0);
    }
    const float* wi = p.w_in + (size_t)l * D * NIN; bf16* ina = (bf16*)(wl + WL_INA);
    run_seg(R, wi, D, NIN, 0, 256, ina, col_dq(l), p.mix_norm + l * D);
    run_seg(R, wi, D, NIN, 256, 256, ina, col_dk(l), p.mix_norm + l * D);
    run_seg(R, wi, D, NIN, 512, 256, ina, 512, p.mix_norm + l * D);
    run_seg(R, wi, D, NIN, 768, 512, ina, 768, p.mix_norm + l * D);
    run_seg(R, wi, D, NIN, 1280, 256, ina, 1280, p.mix_norm + l * D);
    run_seg(R, wi, D, NIN, 1544, 256, ina, 1536, p.mix_norm + l * D);
    run_seg(R, wi, D, NIN, 1800, 256, ina, 1792, p.mix_norm + l * D);
    run_seg(R, wi, D, NIN, 2056, 256, ina, col_sbk(l), p.mix_norm + l * D);
    run_seg(R, wi, D, NIN, 2312, 256, ina, col_sbk(l) + 256, p.mix_norm + l * D);
    run_seg(R, wi, D, NIN, 2568, 256, ina, 2560, p.mix_norm + l * D);
    run_seg(R, wi, D, NIN, 2952, 256, ina, 2816, p.mix_norm + l * D);
    run_seg(R, wi, D, NIN, 2824, 128, ina, 3072, p.mix_norm + l * D);
    run_seg(R, wi, D, NIN, 3208, 40, ina, 3200, p.mix_norm + l * D);
    run_seg(R, wi, D, NIN, 1536, 8, ina, 3240, p.mix_norm + l * D);
    run_seg(R, wi, D, NIN, 3248, 4096, (bf16*)(wl + WL_G), 0, p.mix_norm + l * D);
    for (int b = 0; b < 4; ++b) run_seg(R, p.w_branch + ((size_t)l * 4 + b) * 256 * D, 256, D, 0, D, (bf16*)(wl + WL_BR) + (size_t)b * D * 256, 0);
    run_seg(R, p.w_out + (size_t)l * D * D, D, D, 0, D, (bf16*)(wl + WL_OUT), 0);
    for (int i = R.gw * 64 + R.lane; i < 80 * 128; i += R.ngw * 64) *((u32x4*)(ina + (size_t)3248 * D) + i) = (u32x4){0u, 0u, 0u, 0u};
}

__device__ __forceinline__ void xb_rows(const float* X, bf16* XB, u64_t* rs, int gw, int ngw, int lane) {
    for (int m = gw; m < T; m += ngw) {
        const f32x4* xr = (const f32x4*)(X + (size_t)m * D) + lane;
        f32x4 v[4]; float s = 0.f;
#pragma unroll
        for (int j = 0; j < 4; ++j) { v[j] = xr[64 * j]; s += (v[j].x * v[j].x + v[j].y * v[j].y) + (v[j].z * v[j].z + v[j].w * v[j].w); }
        s = wave_sum(s);
        unsigned long long* o8 = (unsigned long long*)(XB + (size_t)m * D) + lane;
#pragma unroll
        for (int j = 0; j < 4; ++j) o8[64 * j] = (unsigned long long)pk2(v[j].x, v[j].y) | ((unsigned long long)pk2(v[j].z, v[j].w) << 32);
        if (lane == 0) rs[m] = (u64_t)(s * 16777216.f);
    }
}

__device__ __forceinline__ void sincos_red(float ang, float& sn, float& cs) {
    const float n = rintf(ang * 0.15915494309189535f);
    float r = fmaf(-n, 6.28125f, ang); r = fmaf(-n, 0.0019353071795864769f, r);
    sn = __sinf(r); cs = __cosf(r);
}
template <int HALF>
__device__ __forceinline__ void rope4(float (&v)[4], int sl, float pos) {
    constexpr int LH = HALF / 4;
    float pv[4];
#pragma unroll
    for (int j = 0; j < 4; ++j) pv[j] = __shfl_xor(v[j], LH);
    if (sl < 2 * LH) {
        const bool first = sl < LH; const int i0 = (sl & (LH - 1)) * 4;
#pragma unroll
        for (int j = 0; j < 4; ++j) {
            constexpr float I4[4] = {1.0f, 0.03760603070259094f, 0.0014142135623842478f, 5.318296098266728e-05f};
            constexpr float I8[8] = {1.0f, 0.1939227432012558f, 0.03760603070259094f, 0.007292664609849453f, 0.0014142135623842478f, 0.00027424818836152554f, 5.318296098266728e-05f, 1.0313386155758053e-05f};
            const float inv = (HALF == 4) ? I4[j] : (i0 ? I8[4 + j] : I8[j]);
            float sn, cs; sincos_red(pos * inv, sn, cs);
            v[j] = first ? (v[j] * cs - pv[j] * sn) : (pv[j] * sn + v[j] * cs);
        }
    }
}
__device__ __forceinline__ void prep_phase(const Params& p, int l, int gw, int ngw, int lane) {
    bf16* Z = (bf16*)(p.ws + WS_BIG); float* ZS = (float*)(p.ws + WS_ZS); bf16* IK = (bf16*)(p.ws + WS_IK);
    const float* dg = p.diff_qk_norm + l * 64; const float* sg = p.dsa_qk_norm + l * 128;
    for (int tok = gw; tok < T; tok += ngw) {
        const float pos = (float)p.pos[tok];
#pragma unroll
        for (int which = 0; which < 2; ++which) {
            unsigned long long* ptr = (unsigned long long*)(Z + (size_t)tok * ZP + (which ? col_dk(l) : col_dq(l))) + lane;
            const unsigned long long w = *ptr; float v[4] = {bflo((unsigned)w), bfhi((unsigned)w), bflo((unsigned)(w >> 32)), bfhi((unsigned)(w >> 32))};
            float ss = (v[0] * v[0] + v[1] * v[1]) + (v[2] * v[2] + v[3] * v[3]);
            ss += __shfl_xor(ss, 1); ss += __shfl_xor(ss, 2); ss += __shfl_xor(ss, 4);
            const float r = 1.f / sqrtf(ss * (1.f / 32.f) + EPS);
            const f32x4 g = *(const f32x4*)(dg + which * 32 + (lane & 7) * 4);
#pragma unroll
            for (int j = 0; j < 4; ++j) v[j] = v[j] * r * g[j];
            rope4<4>(v, lane & 7, pos);
            if (which == 0) {
#pragma unroll
                for (int j = 0; j < 4; ++j) v[j] *= 0.17677669529663687f;
            }
            *ptr = (unsigned long long)pk2(v[0], v[1]) | ((unsigned long long)pk2(v[2], v[3]) << 32);
        }
        {
            unsigned long long* ptr = (unsigned long long*)(Z + (size_t)tok * ZP + 2560) + lane;
            const unsigned long long w = *ptr; float v[4] = {bflo((unsigned)w), bfhi((unsigned)w), bflo((unsigned)(w >> 32)), bfhi((unsigned)(w >> 32))};
            float ss = (v[0] * v[0] + v[1] * v[1]) + (v[2] * v[2] + v[3] * v[3]);
            ss += __shfl_xor(ss, 1); ss += __shfl_xor(ss, 2); ss += __shfl_xor(ss, 4); ss += __shfl_xor(ss, 8);
            const float r = 1.f / sqrtf(ss * (1.f / 64.f) + EPS);
            const f32x4 g = *(const f32x4*)(sg + (lane & 15) * 4);
#pragma unroll
            for (int j = 0; j < 4; ++j) v[j] = v[j] * r * g[j];
            rope4<8>(v, lane & 15, pos);
#pragma unroll
            for (int j = 0; j < 4; ++j) v[j] *= 0.125f;
            *ptr = (unsigned long long)pk2(v[0], v[1]) | ((unsigned long long)pk2(v[2], v[3]) << 32);
        }
        {
            unsigned long long* ptr = (unsigned long long*)(Z + (size_t)tok * ZP + 2816) + lane;
            const unsigned long long w = *ptr; float v[4] = {bflo((unsigned)w), bfhi((unsigned)w), bflo((unsigned)(w >> 32)), bfhi((unsigned)(w >> 32))};
            rope4<4>(v, lane & 7, pos);
            *ptr = (unsigned long long)pk2(v[0], v[1]) | ((unsigned long long)pk2(v[2], v[3]) << 32);
        }
        {
            float* ptr = ZS + (size_t)tok * ZSP + (lane & 15) * 4;
            const f32x4 x = *(const f32x4*)ptr; float v[4] = {x[0], x[1], x[2], x[3]};
            float ss = (v[0] * v[0] + v[1] * v[1]) + (v[2] * v[2] + v[3] * v[3]);
            ss += __shfl_xor(ss, 1); ss += __shfl_xor(ss, 2); ss += __shfl_xor(ss, 4); ss += __shfl_xor(ss, 8);
            const float r = 1.f / sqrtf(ss * (1.f / 64.f) + EPS);
            const f32x4 g = *(const f32x4*)(sg + 64 + (lane & 15) * 4);
#pragma unroll
            for (int j = 0; j < 4; ++j) v[j] = v[j] * r * g[j];
            rope4<8>(v, lane & 15, pos);
            if (lane < 16) *(f32x4*)ptr = (f32x4){v[0], v[1], v[2], v[3]};
        }
        {
            const float* ptr = ZS + (size_t)tok * ZSP + 128 + (lane & 7) * 4;
            const f32x4 x = *(const f32x4*)ptr; float v[4] = {x[0], x[1], x[2], x[3]};
            rope4<4>(v, lane & 7, pos);
            if (lane < 8) *((unsigned long long*)(IK + (size_t)tok * 32) + lane) = (unsigned long long)pk2(v[0], v[1]) | ((unsigned long long)pk2(v[2], v[3]) << 32);
        }
    }
}
__device__ __forceinline__ void mlstm_item(const Params& p, int l, int bh, LAS unsigned char* lds, int wv) {
    const int tid = tid_fresh(wv), lane = tid & 63, b = bh >> 2, h = bh & 3;
    const bf16* Z = (const bf16*)(p.ws + WS_BIG); const float* ZS = (const float*)(p.ws + WS_ZS); bf16* O1 = (bf16*)(p.ws + WS_O + OB_STRIDE);
    LAS float* nv = (LAS float*)lds; LAS float* bc = nv + 64; LAS float* igs = bc + 64; LAS float* wks = igs + 64; LAS float* sc = wks + 64;
    LAS float* Qs = sc + 64; LAS float* Ks = Qs + 64 * 65; LAS float* Vs = Ks + 64 * 65; LAS float* Ss = Vs + 64 * 65; LAS float* Cs = Ss + 64 * 65;
    for (int i = tid; i < 64 * 65; i += NTHR) Cs[i] = 0.f;
    if (tid < 64) nv[tid] = 0.f;
    float mcar = 0.f;
    const int r = tid >> 3, sg = tid & 7;
    const int cc0 = sg * 16; const int ch0 = (cc0 < 64) ? (h * 64 + cc0) : (256 + h * 64 + cc0 - 64);
    const float* cw0 = p.ml_conv_w + (size_t)l * 4 * 512; const float* cb0 = p.ml_conv_b + (size_t)l * 512;
    const int zc0 = (cc0 < 64) ? (768 + h * 64 + cc0) : (1024 + h * 64 + cc0 - 64);
    const float gb_i = p.ml_gate_bias[(l * 2 + 0) * 4 + h], gb_f = p.ml_gate_bias[(l * 2 + 1) * 4 + h];
    const float qsc = (cc0 < 64) ? 0.125f : 1.0f;
    __syncthreads();
    for (int c = 0; c < 64; ++c) {
        const int t0 = c * 64; const size_t tok0 = (size_t)b * SEQ + t0;
        const float* cw = cw0; const float* cb = cb0; asm volatile("" : "+s"(cw), "+s"(cb));
        {
            float y[16];
#pragma unroll
            for (int i = 0; i < 16; ++i) y[i] = cb[ch0 + i];
#pragma unroll
            for (int j = 0; j < 4; ++j) {
                const int tt = t0 + r - 3 + j;
                if (tt >= 0) {
                    const u32x4* xp = (const u32x4*)(Z + ((size_t)b * SEQ + tt) * ZP + zc0); const u32x4 x0 = xp[0], x1 = xp[1];
                    const float xv[16] = {bflo(x0.x), bfhi(x0.x), bflo(x0.y), bfhi(x0.y), bflo(x0.z), bfhi(x0.z), bflo(x0.w), bfhi(x0.w),
                                          bflo(x1.x), bfhi(x1.x), bflo(x1.y), bfhi(x1.y), bflo(x1.z), bfhi(x1.z), bflo(x1.w), bfhi(x1.w)};
#pragma unroll
                    for (int i = 0; i < 16; ++i) y[i] = fmaf(cw[j * 512 + ch0 + i], xv[i], y[i]);
                }
            }
            LAS float* dst = (cc0 < 64) ? (Qs + r * 65 + cc0) : (Ks + r * 65 + cc0 - 64);
#pragma unroll
            for (int i = 0; i < 16; ++i) dst[i] = y[i] * sigmoidf_(y[i]) * qsc;
            const u32x4 vv = *(const u32x4*)(Z + (tok0 + r) * ZP + 1280 + h * 64 + sg * 8);
            LAS float* vd = Vs + r * 65 + sg * 8;
            vd[0] = bflo(vv.x); vd[1] = bfhi(vv.x); vd[2] = bflo(vv.y); vd[3] = bfhi(vv.y); vd[4] = bflo(vv.z); vd[5] = bfhi(vv.z); vd[6] = bflo(vv.w); vd[7] = bfhi(vv.w);
        }
        if (tid < 64) {
            const float ig = ZS[(tok0 + tid) * ZSP + 168 + h] + gb_i;
            const float fz = ZS[(tok0 + tid) * ZSP + 172 + h] + gb_f;
            const float lf = fminf(fz, 0.f) - log1pf(__expf(-fabsf(fz)));
            float bsum = lf;
#pragma unroll
            for (int d = 1; d < 64; d <<= 1) { const float n = __shfl_up(bsum, d); if (lane >= d) bsum += n; }
            const float bl = __shfl(bsum, 63);
            const float g = bl - bsum + ig;
            const float mnew = fmaxf(bl + mcar, wave_max(g));
            bc[tid] = bsum; igs[tid] = ig; wks[tid] = __expf(g - mnew);
            if (tid == 0) { sc[0] = mnew; sc[1] = __expf(bl + mcar - mnew); sc[2] = bl; }
        }
        __syncthreads();
        const float bt = bc[r];
        float mx = -INFINITY;
#pragma unroll
        for (int i = 0; i < 8; ++i) { const int s = sg * 8 + i; const float dli = (s <= r) ? (bt - bc[s] + igs[s]) : -INFINITY; mx = fmaxf(mx, dli); }
        mx = fmaxf(mx, __shfl_xor(mx, 1)); mx = fmaxf(mx, __shfl_xor(mx, 2)); mx = fmaxf(mx, __shfl_xor(mx, 4));
        const float inter = bt + mcar; const float mt = fmaxf(inter, mx); const float iw = __expf(inter - mt);
        float ssum = 0.f;
#pragma unroll 1
        for (int i = 0; i < 8; ++i) { const int s = sg * 8 + i; float dot = 0.f;
#pragma unroll 16
            for (int d = 0; d < 64; ++d) dot = fmaf(Qs[r * 65 + d], Ks[s * 65 + d], dot);
            const float dli = (s <= r) ? (bt - bc[s] + igs[s]) : -INFINITY;
            const float sv = dot * __expf(dli - mt); Ss[r * 65 + s] = sv; ssum += sv; }
        ssum += __shfl_xor(ssum, 1); ssum += __shfl_xor(ssum, 2); ssum += __shfl_xor(ssum, 4);
        float qn = 0.f;
#pragma unroll
        for (int d = 0; d < 64; ++d) qn = fmaf(Qs[r * 65 + d], nv[d], qn);
        const float den = iw * qn + ssum;
        __syncthreads();
        {
            float num[8];
#pragma unroll
            for (int i = 0; i < 8; ++i) num[i] = 0.f;
#pragma unroll 8
            for (int d = 0; d < 64; ++d) { const float qd = Qs[r * 65 + d];
#pragma unroll
                for (int i = 0; i < 8; ++i) num[i] = fmaf(qd, Cs[d * 65 + sg * 8 + i], num[i]); }
#pragma unroll
            for (int i = 0; i < 8; ++i) num[i] *= iw;
#pragma unroll 8
            for (int s = 0; s < 64; ++s) { const float sv = Ss[r * 65 + s];
#pragma unroll
                for (int i = 0; i < 8; ++i) num[i] = fmaf(sv, Vs[s * 65 + sg * 8 + i], num[i]); }
            const float dn = 1.f / fmaxf(fabsf(den), __expf(-mt));
            float hs = 0.f;
#pragma unroll
            for (int i = 0; i < 8; ++i) { num[i] *= dn; hs = fmaf(num[i], num[i], hs); }
            hs += __shfl_xor(hs, 1); hs += __shfl_xor(hs, 2); hs += __shfl_xor(hs, 4);
            const float rr = 1.f / sqrtf(hs * (1.f / 64.f) + EPS);
            const u32x4 og = *(const u32x4*)(Z + (tok0 + r) * ZP + 1536 + h * 64 + sg * 8);
            const float ogv[8] = {bflo(og.x), bfhi(og.x), bflo(og.y), bfhi(og.y), bflo(og.z), bfhi(og.z), bflo(og.w), bfhi(og.w)};
            const float* hg = p.ml_head_norm + l * 64 + sg * 8;
            float o[8];
#pragma unroll
            for (int i = 0; i < 8; ++i) o[i] = sigmoidf_(ogv[i]) * (num[i] * rr * hg[i]);
            u32x4 w; w.x = pk2(o[0], o[1]); w.y = pk2(o[2], o[3]); w.z = pk2(o[4], o[5]); w.w = pk2(o[6], o[7]);
            *(u32x4*)(O1 + (tok0 + r) * 256 + h * 64 + sg * 8) = w;
        }
        __syncthreads();
        {
            const float decay = sc[1];
            float cacc[8]; float nacc = 0.f;
#pragma unroll
            for (int i = 0; i < 8; ++i) cacc[i] = 0.f;
#pragma unroll 8
            for (int s = 0; s < 64; ++s) { const float kw = wks[s] * Ks[s * 65 + r]; nacc += kw;
#pragma unroll
                for (int i = 0; i < 8; ++i) cacc[i] = fmaf(kw, Vs[s * 65 + sg * 8 + i], cacc[i]); }
#pragma unroll
            for (int i = 0; i < 8; ++i) Cs[r * 65 + sg * 8 + i] = decay * Cs[r * 65 + sg * 8 + i] + cacc[i];
            if (sg == 0) nv[r] = decay * nv[r] + nacc;
            mcar = sc[0];
        }
        __syncthreads();
    }
}

__device__ __forceinline__ void diff_item(const Params& p, int l, int bh, int qt, LAS unsigned char* lds, int wv) {
    const int tid = tid_fresh(wv), b = bh >> 2, h = bh & 3, q0 = qt * 128;
    const bf16* Z = (const bf16*)(p.ws + WS_BIG); bf16* O0 = (bf16*)(p.ws + WS_O);
    LAS float* Kt = (LAS float*)lds; LAS float* Vt = Kt + 64 * 64;
    const int ql = tid >> 2, part = tid & 3, c = part & 1, dvh = part >> 1, t = q0 + ql; const size_t tok = (size_t)b * SEQ + t;
    const float* lp = p.diff_lambda + l * 128; float s01 = 0.f, s23 = 0.f, gqm = 0.f, gkm = 0.f;
#pragma unroll 2
    for (int i = 0; i < 32; ++i) { s01 = fmaf(lp[i], lp[32 + i], s01); s23 = fmaf(lp[64 + i], lp[96 + i], s23);
        gqm = fmaxf(gqm, fabsf(p.diff_qk_norm[l * 64 + i])); gkm = fmaxf(gkm, fabsf(p.diff_qk_norm[l * 64 + 32 + i])); }
    const float lam_init = 0.8f - 0.6f * __expf(-0.3f * (float)l); const float lam = __expf(s01) - __expf(s23) + lam_init;
    const float coff = 5.65685424949238f * gqm * gkm;
    float q[32], o[32];
    { const u32x4* qp = (const u32x4*)(Z + tok * ZP + h * 64 + c * 32);
#pragma unroll
      for (int i = 0; i < 4; ++i) { const u32x4 w = qp[i]; q[8 * i] = bflo(w.x); q[8 * i + 1] = bfhi(w.x); q[8 * i + 2] = bflo(w.y); q[8 * i + 3] = bfhi(w.y); q[8 * i + 4] = bflo(w.z); q[8 * i + 5] = bfhi(w.z); q[8 * i + 6] = bflo(w.w); q[8 * i + 7] = bfhi(w.w); } }
#pragma unroll
    for (int i = 0; i < 32; ++i) o[i] = 0.f;
    float lsum = 0.f;
    const int nkt = (q0 + 128) / 64;
    const int lk = tid >> 3, lsg = tid & 7;
    for (int kt = 0; kt < nkt; ++kt) {
        __syncthreads();
        { const size_t ktok = (size_t)b * SEQ + kt * 64 + lk;
          const bf16* src = Z + ktok * ZP + ((lsg < 4) ? (256 + h * 64 + lsg * 16) : (512 + h * 64 + (lsg - 4) * 16));
          const u32x4 x0 = ((const u32x4*)src)[0], x1 = ((const u32x4*)src)[1];
          LAS float* dst = ((lsg < 4) ? (Kt + lk * 64 + lsg * 16) : (Vt + lk * 64 + (lsg - 4) * 16));
          *(LAS f32x4*)(dst) = (f32x4){bflo(x0.x), bfhi(x0.x), bflo(x0.y), bfhi(x0.y)}; *(LAS f32x4*)(dst + 4) = (f32x4){bflo(x0.z), bfhi(x0.z), bflo(x0.w), bfhi(x0.w)};
          *(LAS f32x4*)(dst + 8) = (f32x4){bflo(x1.x), bfhi(x1.x), bflo(x1.y), bfhi(x1.y)}; *(LAS f32x4*)(dst + 12) = (f32x4){bflo(x1.z), bfhi(x1.z), bflo(x1.w), bfhi(x1.w)}; }
        __syncthreads();
        const int kmax = t - kt * 64 + 1;
        for (int key = 0; key < 64; ++key) {
            const LAS f32x4* kr = (const LAS f32x4*)(Kt + key * 64 + c * 32);
            float s = 0.f;
#pragma unroll
            for (int i = 0; i < 8; ++i) { const f32x4 kv = kr[i]; s = fmaf(q[4 * i], kv[0], s); s = fmaf(q[4 * i + 1], kv[1], s); s = fmaf(q[4 * i + 2], kv[2], s); s = fmaf(q[4 * i + 3], kv[3], s); }
            const float pe = (key < kmax) ? __expf(s - coff) : 0.f;
            lsum += pe;
            const LAS f32x4* vr = (const LAS f32x4*)(Vt + key * 64 + dvh * 32);
#pragma unroll
            for (int i = 0; i < 8; ++i) { const f32x4 vv = vr[i]; o[4 * i] = fmaf(pe, vv[0], o[4 * i]); o[4 * i + 1] = fmaf(pe, vv[1], o[4 * i + 1]); o[4 * i + 2] = fmaf(pe, vv[2], o[4 * i + 2]); o[4 * i + 3] = fmaf(pe, vv[3], o[4 * i + 3]); }
        }
    }
    const float inv = 1.f / lsum; float ss = 0.f;
#pragma unroll
    for (int i = 0; i < 32; ++i) { const float my = o[i] * inv; const float ot = __shfl_xor(my, 1); o[i] = (c == 0) ? (my - lam * ot) : (ot - lam * my); ss = fmaf(o[i], o[i], ss); }
    ss += __shfl_xor(ss, 2);
    const float rr = (1.f - lam_init) / sqrtf(ss * (1.f / 64.f) + EPS);
    if (c == 0) {
        const float* hg = p.diff_head_norm + l * 64 + dvh * 32; u32x4* dst = (u32x4*)(O0 + tok * 256 + h * 64 + dvh * 32);
#pragma unroll
        for (int i = 0; i < 4; ++i) { u32x4 w; w.x = pk2(o[8 * i] * rr * hg[8 * i], o[8 * i + 1] * rr * hg[8 * i + 1]); w.y = pk2(o[8 * i + 2] * rr * hg[8 * i + 2], o[8 * i + 3] * rr * hg[8 * i + 3]);
            w.z = pk2(o[8 * i + 4] * rr * hg[8 * i + 4], o[8 * i + 5] * rr * hg[8 * i + 5]); w.w = pk2(o[8 * i + 6] * rr * hg[8 * i + 6], o[8 * i + 7] * rr * hg[8 * i + 7]); dst[i] = w; }
    }
    __syncthreads();
}

__device__ __forceinline__ unsigned pkbf(float lo, float hi) { unsigned r; asm("v_cvt_pk_bf16_f32 %0, %1, %2" : "=v"(r) : "v"(lo), "v"(hi)); return r; }
__device__ __forceinline__ void diffm_item(const Params& p, int l, int bh, int qb, LAS unsigned char* lds, int wv) {
    const int tid = tid_fresh(wv), lane = tid & 63, half = lane >> 5, r32 = lane & 31, b = bh >> 2, h = bh & 3;
    const bf16* Z = (const bf16*)(p.ws + WS_BIG); bf16* O0 = (bf16*)(p.ws + WS_O);
    LAS bf16* Ks = (LAS bf16*)lds; LAS bf16* Vt = Ks + 64 * 72;
    const float* lp = p.diff_lambda + l * 128; float s01 = 0.f, s23 = 0.f, gqm = 0.f, gkm = 0.f;
#pragma unroll 2
    for (int i = 0; i < 32; ++i) { s01 = fmaf(lp[i], lp[32 + i], s01); s23 = fmaf(lp[64 + i], lp[96 + i], s23);
        gqm = fmaxf(gqm, fabsf(p.diff_qk_norm[l * 64 + i])); gkm = fmaxf(gkm, fabsf(p.diff_qk_norm[l * 64 + 32 + i])); }
    const float lam_init = 0.8f - 0.6f * __expf(-0.3f * (float)l); const float lam = __expf(s01) - __expf(s23) + lam_init;
    const float coff = 5.65685424949238f * gqm * gkm;
    const int qw = qb * 256 + 32 * wv;
    const size_t tokb = (size_t)b * SEQ;
    s16x8 qf[2][2];
    { const bf16* qp = Z + (tokb + qw + r32) * ZP + col_dq(l) + h * 64 + half * 8;
#pragma unroll
      for (int c = 0; c < 2; ++c)
#pragma unroll
          for (int s = 0; s < 2; ++s) qf[c][s] = *(const s16x8*)(qp + c * 32 + 16 * s); }
    f32x16 oacc[2][2];
#pragma unroll
    for (int c = 0; c < 2; ++c)
#pragma unroll
        for (int db = 0; db < 2; ++db)
#pragma unroll
            for (int r = 0; r < 16; ++r) oacc[c][db][r] = 0.f;
    float ls0 = 0.f, ls1 = 0.f;
    const int nt = (qb + 1) * 4;
    const int kkey = tid >> 3, kch = tid & 7, vkey = tid & 63, vdc = tid >> 6;
    const bf16* kgp = Z + (tokb + kkey) * ZP + col_dk(l) + h * 64 + kch * 8;
    const bf16* vgp = Z + (tokb + vkey) * ZP + 512 + h * 64 + vdc * 8;
    u32x4 kreg = *(const u32x4*)kgp, vreg = *(const u32x4*)vgp;
#pragma unroll 1
    for (int t = 0; t < nt; ++t) {
        __syncthreads();
        *(LAS u32x4*)(Ks + kkey * 72 + kch * 8) = kreg;
        { LAS bf16* vd = Vt + (vdc * 8) * 72 + vkey;
          vd[0] = (bf16)(vreg.x & 0xffffu); vd[72] = (bf16)(vreg.x >> 16); vd[144] = (bf16)(vreg.y & 0xffffu); vd[216] = (bf16)(vreg.y >> 16);
          vd[288] = (bf16)(vreg.z & 0xffffu); vd[360] = (bf16)(vreg.z >> 16); vd[432] = (bf16)(vreg.w & 0xffffu); vd[504] = (bf16)(vreg.w >> 16); }
        __syncthreads();
        if (t + 1 < nt) { kreg = *(const u32x4*)(kgp + (size_t)(t + 1) * 64 * ZP); vreg = *(const u32x4*)(vgp + (size_t)(t + 1) * 64 * ZP); }
        const int k0 = t * 64;
#pragma unroll
        for (int sub = 0; sub < 2; ++sub) {
            const int kb = k0 + 32 * sub;
            if (kb <= qw + 31) {
                f32x16 s0, s1;
#pragma unroll
                for (int r = 0; r < 16; ++r) { s0[r] = 0.f; s1[r] = 0.f; }
                const LAS bf16* kr = Ks + (32 * sub + r32) * 72 + 8 * half;
#pragma unroll
                for (int s = 0; s < 2; ++s) {
                    const s16x8 a0 = *(const LAS s16x8*)(kr + 16 * s), a1 = *(const LAS s16x8*)(kr + 32 + 16 * s);
                    s0 = __builtin_amdgcn_mfma_f32_32x32x16_bf16(a0, qf[0][s], s0, 0, 0, 0);
                    s1 = __builtin_amdgcn_mfma_f32_32x32x16_bf16(a1, qf[1][s], s1, 0, 0, 0);
                }
                const bool diag = (kb + 31 > qw);
#pragma unroll
                for (int r = 0; r < 16; ++r) {
                    float p0 = __expf(s0[r] - coff), p1 = __expf(s1[r] - coff);
                    if (diag) { const int key = kb + 8 * (r >> 2) + 4 * half + (r & 3); if (key > qw + r32) { p0 = 0.f; p1 = 0.f; } }
                    ls0 += p0; ls1 += p1; s0[r] = p0; s1[r] = p1;
                }
#pragma unroll
                for (int s = 0; s < 2; ++s) {
                    u32x4 w0, w1;
                    w0.x = pkbf(s0[8 * s], s0[8 * s + 1]); w0.y = pkbf(s0[8 * s + 2], s0[8 * s + 3]); w0.z = pkbf(s0[8 * s + 4], s0[8 * s + 5]); w0.w = pkbf(s0[8 * s + 6], s0[8 * s + 7]);
                    w1.x = pkbf(s1[8 * s], s1[8 * s + 1]); w1.y = pkbf(s1[8 * s + 2], s1[8 * s + 3]); w1.z = pkbf(s1[8 * s + 4], s1[8 * s + 5]); w1.w = pkbf(s1[8 * s + 6], s1[8 * s + 7]);
                    const s16x8 pf0 = __builtin_bit_cast(s16x8, w0), pf1 = __builtin_bit_cast(s16x8, w1);
#pragma unroll
                    for (int db = 0; db < 2; ++db) {
                        const LAS bf16* vr = Vt + (db * 32 + r32) * 72 + 32 * sub + 16 * s + 4 * half;
                        const u32x2 v0 = *(const LAS u32x2*)vr, v1 = *(const LAS u32x2*)(vr + 8);
                        const u32x4 vv = (u32x4){v0.x, v0.y, v1.x, v1.y};
                        const s16x8 vf = __builtin_bit_cast(s16x8, vv);
                        oacc[0][db] = __builtin_amdgcn_mfma_f32_32x32x16_bf16(vf, pf0, oacc[0][db], 0, 0, 0);
                        oacc[1][db] = __builtin_amdgcn_mfma_f32_32x32x16_bf16(vf, pf1, oacc[1][db], 0, 0, 0);
                    }
                }
            }
        }
    }
    ls0 += __shfl_xor(ls0, 32); ls1 += __shfl_xor(ls1, 32);
    const float i0 = 1.f / ls0, i1 = lam / ls1;
    float ss = 0.f;
#pragma unroll
    for (int db = 0; db < 2; ++db)
#pragma unroll
        for (int r = 0; r < 16; ++r) { const float v = oacc[0][db][r] * i0 - oacc[1][db][r] * i1; oacc[0][db][r] = v; ss = fmaf(v, v, ss); }
    ss += __shfl_xor(ss, 32);
    const float rr = (1.f - lam_init) / sqrtf(ss * (1.f / 64.f) + EPS);
    const float* hg = p.diff_head_norm + l * 64;
    bf16* orow = O0 + (tokb + qw + r32) * 256 + h * 64;
#pragma unroll
    for (int db = 0; db < 2; ++db)
#pragma unroll
        for (int g = 0; g < 4; ++g) { const int d0 = db * 32 + 8 * g + 4 * half; const f32x4 gg = *(const f32x4*)(hg + d0);
            u32x2 w; w.x = pkbf(oacc[0][db][4 * g] * rr * gg[0], oacc[0][db][4 * g + 1] * rr * gg[1]); w.y = pkbf(oacc[0][db][4 * g + 2] * rr * gg[2], oacc[0][db][4 * g + 3] * rr * gg[3]);
            *(u32x2*)(orow + d0) = w; }
    __syncthreads();
}

typedef unsigned u32x16 __attribute__((ext_vector_type(16)));
__device__ __forceinline__ void sb_item(const Params& p, int l, int bh, int g, LAS unsigned char* lds, int wv) {
    const int tid = tid_fresh(wv), lane = tid & 63, w = wv, b = bh >> 2, h = bh & 3; (void)lds;
    const bf16* Z = (const bf16*)(p.ws + WS_BIG); bf16* O2 = (bf16*)(p.ws + WS_O + 2 * OB_STRIDE);
    const int t0 = g * 512 + w * 64, t = t0 + lane; const size_t tok = (size_t)b * SEQ + t;
    float q[64], o[64];
    { const u32x4* qp = (const u32x4*)(Z + tok * ZP + 1792 + h * 64);
#pragma unroll
      for (int i = 0; i < 8; ++i) { const u32x4 x = qp[i]; q[8 * i] = bflo(x.x); q[8 * i + 1] = bfhi(x.x); q[8 * i + 2] = bflo(x.y); q[8 * i + 3] = bfhi(x.y); q[8 * i + 4] = bflo(x.z); q[8 * i + 5] = bfhi(x.z); q[8 * i + 6] = bflo(x.w); q[8 * i + 7] = bfhi(x.w); } }
#pragma unroll
    for (int i = 0; i < 64; ++i) o[i] = 0.f;
    float R = 0.f;
    const bf16* kbase = Z + (size_t)b * SEQ * ZP + col_sbk(l) + h * 64;
#pragma unroll 1
    for (int s = t0 + 62; s >= 0; --s) {
        const bf16* kp = kbase + (size_t)s * ZP;
        u32x16 k0, k1, v0, v1;
        asm volatile("s_load_dwordx16 %0, %4, 0x0\n\ts_load_dwordx16 %1, %4, 0x40\n\ts_load_dwordx16 %2, %4, 0x200\n\ts_load_dwordx16 %3, %4, 0x240\n\ts_waitcnt lgkmcnt(0)"
                     : "=s"(k0), "=s"(k1), "=s"(v0), "=s"(v1) : "s"(kp) : "memory");
        const bool act = s < t;
        float z = 0.f;
#pragma unroll
        for (int i = 0; i < 16; ++i) { z = fmaf(q[2 * i], bflo(k0[i]), z); z = fmaf(q[2 * i + 1], bfhi(k0[i]), z); }
#pragma unroll
        for (int i = 0; i < 16; ++i) { z = fmaf(q[32 + 2 * i], bflo(k1[i]), z); z = fmaf(q[33 + 2 * i], bfhi(k1[i]), z); }
        z *= 0.125f;
        const float lb = fminf(z, 0.f) - __logf(1.f + __expf(-fabsf(z)));
        const float a = act ? __expf(lb + R) : 0.f;
        R += act ? (lb - z) : 0.f;
#pragma unroll
        for (int i = 0; i < 16; ++i) { o[2 * i] = fmaf(a, bflo(v0[i]), o[2 * i]); o[2 * i + 1] = fmaf(a, bfhi(v0[i]), o[2 * i + 1]); }
#pragma unroll
        for (int i = 0; i < 16; ++i) { o[32 + 2 * i] = fmaf(a, bflo(v1[i]), o[32 + 2 * i]); o[33 + 2 * i] = fmaf(a, bfhi(v1[i]), o[33 + 2 * i]); }
        if ((s & 31) == 0) { if (__all(R < -104.f)) break; }
    }
    u32x4* dst = (u32x4*)(O2 + tok * 256 + h * 64);
#pragma unroll
    for (int i = 0; i < 8; ++i) { u32x4 x; x.x = pk2(o[8 * i], o[8 * i + 1]); x.y = pk2(o[8 * i + 2], o[8 * i + 3]); x.z = pk2(o[8 * i + 4], o[8 * i + 5]); x.w = pk2(o[8 * i + 6], o[8 * i + 7]); dst[i] = x; }
}
constexpr size_t WS_MLS = 460 * MiB, WS_DEC = WS_MLS + 5 * 32 * 4096 * 4, WS_UN = 463 * MiB, WS_NV = WS_UN + 512 * 1024, WS_UT = 464 * MiB, WS_CT = 496 * MiB, WS_END2 = 512 * MiB;
constexpr int MLN = 32 * 4096;
__device__ __forceinline__ void ml_prepass(const Params& p, int l, int bh, int lane) {
    const int b = bh >> 2, h = bh & 3; const float* ZS = (const float*)(p.ws + WS_ZS);
    float* MLS = (float*)(p.ws + WS_MLS); float* DEC = (float*)(p.ws + WS_DEC);
    const float gb_i = p.ml_gate_bias[(l * 2 + 0) * 4 + h], gb_f = p.ml_gate_bias[(l * 2 + 1) * 4 + h];
    float cA = 0.f, cB = 0.f;
#pragma unroll 1
    for (int c4 = 0; c4 < 8; ++c4) {
        float igv[8], fzv[8];
#pragma unroll
        for (int k = 0; k < 8; ++k) { const size_t tok = (size_t)b * SEQ + (c4 * 8 + k) * 64 + lane; igv[k] = ZS[tok * ZSP + 168 + h]; fzv[k] = ZS[tok * ZSP + 172 + h]; }
#pragma unroll
        for (int k = 0; k < 8; ++k) {
            const int c = c4 * 8 + k;
            const float ig = igv[k] + gb_i, fz = fzv[k] + gb_f;
            const float lf = fminf(fz, 0.f) - __logf(1.f + __expf(-fabsf(fz)));
            float bsum = lf;
#pragma unroll
            for (int d = 1; d < 64; d <<= 1) { const float n = __shfl_up(bsum, d); if (lane >= d) bsum += n; }
            const float bl = __shfl(bsum, 63);
            const float a = ig - bsum;
            float pm = a;
#pragma unroll
            for (int d = 1; d < 64; d <<= 1) { const float n = __shfl_up(pm, d); if (lane >= d) pm = fmaxf(pm, n); }
            const float gmax = bl + __shfl(pm, 63);
            const int ti = bh * 4096 + c * 64 + lane;
            MLS[ti] = bsum; MLS[MLN + ti] = a; MLS[2 * MLN + ti] = pm;
            cA = (lane == c) ? bl : cA; cB = (lane == c) ? gmax : cB;
        }
    }
    float sA = cA, sB = cB;
#pragma unroll
    for (int d = 1; d < 64; d <<= 1) { const float pA = __shfl_up(sA, d), pB = __shfl_up(sB, d); if (lane >= d) { sB = fmaxf(pB + sA, sB); sA = pA + sA; } }
    const float m_out = fmaxf(sA, sB);
    float m_in = __shfl_up(m_out, 1); if (lane == 0) m_in = 0.f;
    DEC[bh * 64 + lane] = __expf(cA + m_in - m_out);
    asm volatile("s_waitcnt vmcnt(0)" ::: "memory");
#pragma unroll 1
    for (int c4 = 0; c4 < 8; ++c4) {
        float bsv[8], av[8], pmv[8];
#pragma unroll
        for (int k = 0; k < 8; ++k) { const int ti = bh * 4096 + (c4 * 8 + k) * 64 + lane; bsv[k] = MLS[ti]; av[k] = MLS[MLN + ti]; pmv[k] = MLS[2 * MLN + ti]; }
#pragma unroll
        for (int k = 0; k < 8; ++k) {
            const int c = c4 * 8 + k;
            const float mi = __shfl(m_in, c), mo = __shfl(m_out, c), bl = __shfl(cA, c);
            const int ti = bh * 4096 + c * 64 + lane;
            const float mt = bsv[k] + fmaxf(mi, pmv[k]);
            MLS[2 * MLN + ti] = mt; MLS[3 * MLN + ti] = __expf(bl + av[k] - mo); MLS[4 * MLN + ti] = __expf(bsv[k] + mi - mt);
        }
    }
}
__device__ __forceinline__ void ml_conv8(const bf16* Z, const float* cw, const float* cb, int b, int t, int ch0, float (&y)[8]) {
    const f32x4 b0 = *(const f32x4*)(cb + ch0), b1 = *(const f32x4*)(cb + ch0 + 4);
    y[0] = b0[0]; y[1] = b0[1]; y[2] = b0[2]; y[3] = b0[3]; y[4] = b1[0]; y[5] = b1[1]; y[6] = b1[2]; y[7] = b1[3];
#pragma unroll
    for (int j = 0; j < 4; ++j) {
        const int tt = t - 3 + j;
        if (tt >= 0) {
            const u32x4 x = *(const u32x4*)(Z + ((size_t)b * SEQ + tt) * ZP + 768 + ch0);
            const f32x4 w0 = *(const f32x4*)(cw + j * 512 + ch0), w1 = *(const f32x4*)(cw + j * 512 + ch0 + 4);
            y[0] = fmaf(w0[0], bflo(x.x), y[0]); y[1] = fmaf(w0[1], bfhi(x.x), y[1]); y[2] = fmaf(w0[2], bflo(x.y), y[2]); y[3] = fmaf(w0[3], bfhi(x.y), y[3]);
            y[4] = fmaf(w1[0], bflo(x.z), y[4]); y[5] = fmaf(w1[1], bfhi(x.z), y[5]); y[6] = fmaf(w1[2], bflo(x.w), y[6]); y[7] = fmaf(w1[3], bfhi(x.w), y[7]);
        }
    }
#pragma unroll
    for (int i = 0; i < 8; ++i) y[i] = y[i] * sigmoidf_(y[i]);
}
__device__ __forceinline__ void mlB_item(const Params& p, int l, int bh, int ci, LAS unsigned char* lds, int wv) {
    const int tid = tid_fresh(wv), lane = tid & 63, half = lane >> 5, r32 = lane & 31, b = bh >> 2, h = bh & 3;
    const bf16* Z = (const bf16*)(p.ws + WS_BIG); const float* MLS = (const float*)(p.ws + WS_MLS);
    float* UT = (float*)(p.ws + WS_UT); float* UN = (float*)(p.ws + WS_UN);
    LAS bf16* KT = (LAS bf16*)lds; LAS bf16* VT = KT + 4 * 64 * 72;
    const float* cw = p.ml_conv_w + (size_t)l * 4 * 512; const float* cb = p.ml_conv_b + (size_t)l * 512;
    __syncthreads();
    {
        const int tt = tid >> 1, hr = tid & 1, cl = tt >> 6, s = tt & 63, t = (ci * 4) * 64 + tt;
        const float wk = MLS[3 * MLN + bh * 4096 + t];
#pragma unroll 1
        for (int q8 = 0; q8 < 4; ++q8) {
            const int d0 = hr * 32 + q8 * 8; float y[8];
            ml_conv8(Z, cw, cb, b, t, 256 + h * 64 + d0, y);
            LAS bf16* dst = KT + (cl * 64 + d0) * 72 + s;
#pragma unroll
            for (int i = 0; i < 8; ++i) dst[i * 72] = (bf16)f2bf(y[i] * wk);
            const u32x4 v = *(const u32x4*)(Z + ((size_t)b * SEQ + t) * ZP + 1280 + h * 64 + d0);
            LAS bf16* vd = VT + (cl * 64 + d0) * 72 + s;
            vd[0] = (bf16)(v.x & 0xffffu); vd[72] = (bf16)(v.x >> 16); vd[144] = (bf16)(v.y & 0xffffu); vd[216] = (bf16)(v.y >> 16);
            vd[288] = (bf16)(v.z & 0xffffu); vd[360] = (bf16)(v.z >> 16); vd[432] = (bf16)(v.w & 0xffffu); vd[504] = (bf16)(v.w >> 16);
        }
    }
    __syncthreads();
    const int cl = wv >> 1, dh = wv & 1, c = ci * 4 + cl;
    f32x16 acc[2];
#pragma unroll
    for (int eb = 0; eb < 2; ++eb)
#pragma unroll
        for (int r = 0; r < 16; ++r) acc[eb][r] = 0.f;
#pragma unroll
    for (int s4 = 0; s4 < 4; ++s4) {
        const s16x8 bk = *(const LAS s16x8*)(KT + (cl * 64 + dh * 32 + r32) * 72 + 16 * s4 + 8 * half);
#pragma unroll
        for (int eb = 0; eb < 2; ++eb) {
            const s16x8 av = *(const LAS s16x8*)(VT + (cl * 64 + eb * 32 + r32) * 72 + 16 * s4 + 8 * half);
            acc[eb] = __builtin_amdgcn_mfma_f32_32x32x16_bf16(av, bk, acc[eb], 0, 0, 0);
        }
    }
    float* ut = UT + ((size_t)(bh * 64 + c) * 64) * 64;
#pragma unroll
    for (int eb = 0; eb < 2; ++eb)
#pragma unroll
        for (int r = 0; r < 16; ++r) { const int e = eb * 32 + 8 * (r >> 2) + 4 * half + (r & 3); ut[e * 64 + dh * 32 + r32] = acc[eb][r]; }
    {
        const LAS bf16* kr = KT + (cl * 64 + dh * 32 + r32) * 72 + half * 32; float sm = 0.f;
#pragma unroll
        for (int i = 0; i < 4; ++i) { const u32x4 x = *(const LAS u32x4*)(kr + 8 * i); sm += (bflo(x.x) + bfhi(x.x)) + (bflo(x.y) + bfhi(x.y)) + (bflo(x.z) + bfhi(x.z)) + (bflo(x.w) + bfhi(x.w)); }
        sm += __shfl_xor(sm, 32);
        if (half == 0) UN[(bh * 64 + c) * 64 + dh * 32 + r32] = sm;
    }
}
__device__ __forceinline__ void mlS_item(const Params& p, int bh, int wv) {
    const int tid = tid_fresh(wv);
    const float* UT = (const float*)(p.ws + WS_UT) + (size_t)bh * 64 * 4096; const float* UN = (const float*)(p.ws + WS_UN) + bh * 4096;
    bf16* CT = (bf16*)(p.ws + WS_CT) + (size_t)bh * 64 * 4096; float* NV = (float*)(p.ws + WS_NV) + bh * 4096; const float* DEC = (const float*)(p.ws + WS_DEC) + bh * 64;
    f32x4 s0 = (f32x4){0.f, 0.f, 0.f, 0.f}, s1 = s0; float ns = 0.f;
#pragma unroll 4
    for (int c = 0; c < 64; ++c) {
        const float dec = DEC[c];
        const f32x4 u0 = *(const f32x4*)(UT + (size_t)c * 4096 + tid * 8), u1 = *(const f32x4*)(UT + (size_t)c * 4096 + tid * 8 + 4);
        u32x4 w; w.x = pk2(s0[0], s0[1]); w.y = pk2(s0[2], s0[3]); w.z = pk2(s1[0], s1[1]); w.w = pk2(s1[2], s1[3]);
        *(u32x4*)(CT + (size_t)c * 4096 + tid * 8) = w;
        s0 = s0 * dec + u0; s1 = s1 * dec + u1;
        if (tid < 64) { NV[c * 64 + tid] = ns; ns = ns * dec + UN[c * 64 + tid]; }
    }
}
__device__ __forceinline__ void mlD_item(const Params& p, int l, int bh, int ci, LAS unsigned char* lds, int wv) {
    const int tid = tid_fresh(wv), lane = tid & 63, half = lane >> 5, r32 = lane & 31, b = bh >> 2, h = bh & 3;
    const bf16* Z = (const bf16*)(p.ws + WS_BIG); const float* MLS = (const float*)(p.ws + WS_MLS); bf16* O1 = (bf16*)(p.ws + WS_O + OB_STRIDE);
    LAS bf16* Qs = (LAS bf16*)lds; LAS bf16* Ks = Qs + 4 * 64 * 72; LAS bf16* VT = Ks + 4 * 64 * 72;
    const float* cw = p.ml_conv_w + (size_t)l * 4 * 512; const float* cb = p.ml_conv_b + (size_t)l * 512;
    __syncthreads();
    {
        const int tt = tid >> 1, hr = tid & 1, cl = tt >> 6, s = tt & 63, t = (ci * 4) * 64 + tt;
#pragma unroll 1
        for (int q8 = 0; q8 < 4; ++q8) {
            const int d0 = hr * 32 + q8 * 8; float y[8];
            ml_conv8(Z, cw, cb, b, t, h * 64 + d0, y);
            u32x4 w; w.x = pk2(y[0] * 0.125f, y[1] * 0.125f); w.y = pk2(y[2] * 0.125f, y[3] * 0.125f); w.z = pk2(y[4] * 0.125f, y[5] * 0.125f); w.w = pk2(y[6] * 0.125f, y[7] * 0.125f);
            *(LAS u32x4*)(Qs + (cl * 64 + s) * 72 + d0) = w;
            ml_conv8(Z, cw, cb, b, t, 256 + h * 64 + d0, y);
            w.x = pk2(y[0], y[1]); w.y = pk2(y[2], y[3]); w.z = pk2(y[4], y[5]); w.w = pk2(y[6], y[7]);
            *(LAS u32x4*)(Ks + (cl * 64 + s) * 72 + d0) = w;
            const u32x4 v = *(const u32x4*)(Z + ((size_t)b * SEQ + t) * ZP + 1280 + h * 64 + d0);
            LAS bf16* vd = VT + (cl * 64 + d0) * 72 + s;
            vd[0] = (bf16)(v.x & 0xffffu); vd[72] = (bf16)(v.x >> 16); vd[144] = (bf16)(v.y & 0xffffu); vd[216] = (bf16)(v.y >> 16);
            vd[288] = (bf16)(v.z & 0xffffu); vd[360] = (bf16)(v.z >> 16); vd[432] = (bf16)(v.w & 0xffffu); vd[504] = (bf16)(v.w >> 16);
        }
    }
    __syncthreads();
    const int cl = wv >> 1, th = wv & 1, c = ci * 4 + cl, tloc = th * 32 + r32, tseq = c * 64 + tloc;
    const int ti = bh * 4096 + tseq;
    const float bs_t = MLS[ti], mt_t = MLS[2 * MLN + ti], iw_t = MLS[4 * MLN + ti];
    s16x8 qf[4];
#pragma unroll
    for (int s4 = 0; s4 < 4; ++s4) qf[s4] = *(const LAS s16x8*)(Qs + (cl * 64 + tloc) * 72 + 16 * s4 + 8 * half);
    f32x16 oacc[2];
#pragma unroll
    for (int eb = 0; eb < 2; ++eb)
#pragma unroll
        for (int r = 0; r < 16; ++r) oacc[eb][r] = 0.f;
    const bf16* CT = (const bf16*)(p.ws + WS_CT) + (size_t)(bh * 64 + c) * 4096;
#pragma unroll
    for (int s4 = 0; s4 < 4; ++s4)
#pragma unroll
        for (int eb = 0; eb < 2; ++eb) { const s16x8 ac = *(const s16x8*)(CT + (eb * 32 + r32) * 64 + 16 * s4 + 8 * half);
            oacc[eb] = __builtin_amdgcn_mfma_f32_32x32x16_bf16(ac, qf[s4], oacc[eb], 0, 0, 0); }
#pragma unroll
    for (int eb = 0; eb < 2; ++eb)
#pragma unroll
        for (int r = 0; r < 16; ++r) oacc[eb][r] *= iw_t;
    float qn = 0.f;
    { const float* nvp = (const float*)(p.ws + WS_NV) + (bh * 64 + c) * 64;
#pragma unroll
      for (int s4 = 0; s4 < 4; ++s4) { const f32x4 n0 = *(const f32x4*)(nvp + 16 * s4 + 8 * half), n1 = *(const f32x4*)(nvp + 16 * s4 + 8 * half + 4);
          const u32x4 qq = __builtin_bit_cast(u32x4, qf[s4]);
          qn += bflo(qq.x) * n0[0] + bfhi(qq.x) * n0[1] + bflo(qq.y) * n0[2] + bfhi(qq.y) * n0[3] + bflo(qq.z) * n1[0] + bfhi(qq.z) * n1[1] + bflo(qq.w) * n1[2] + bfhi(qq.w) * n1[3]; } }
    qn += __shfl_xor(qn, 32);
    float rs = 0.f;
#pragma unroll
    for (int sb = 0; sb < 2; ++sb) {
        if (sb <= th) {
            f32x16 sacc;
#pragma unroll
            for (int r = 0; r < 16; ++r) sacc[r] = 0.f;
#pragma unroll
            for (int s4 = 0; s4 < 4; ++s4) { const s16x8 ak = *(const LAS s16x8*)(Ks + (cl * 64 + sb * 32 + r32) * 72 + 16 * s4 + 8 * half);
                sacc = __builtin_amdgcn_mfma_f32_32x32x16_bf16(ak, qf[s4], sacc, 0, 0, 0); }
            const float* ap = MLS + MLN + bh * 4096 + c * 64 + sb * 32 + 4 * half;
#pragma unroll
            for (int g = 0; g < 4; ++g) { const f32x4 av = *(const f32x4*)(ap + 8 * g);
#pragma unroll
                for (int i = 0; i < 4; ++i) { const int s = sb * 32 + 8 * g + 4 * half + i; const float v = (s <= tloc) ? sacc[4 * g + i] * __expf(bs_t + av[i] - mt_t) : 0.f; sacc[4 * g + i] = v; rs += v; } }
#pragma unroll
            for (int s2 = 0; s2 < 2; ++s2) {
                u32x4 w; w.x = pkbf(sacc[8 * s2], sacc[8 * s2 + 1]); w.y = pkbf(sacc[8 * s2 + 2], sacc[8 * s2 + 3]); w.z = pkbf(sacc[8 * s2 + 4], sacc[8 * s2 + 5]); w.w = pkbf(sacc[8 * s2 + 6], sacc[8 * s2 + 7]);
                const s16x8 pf = __builtin_bit_cast(s16x8, w);
#pragma unroll
                for (int eb = 0; eb < 2; ++eb) {
                    const LAS bf16* vr = VT + (cl * 64 + eb * 32 + r32) * 72 + sb * 32 + 16 * s2 + 4 * half;
                    const u32x2 v0 = *(const LAS u32x2*)vr, v1 = *(const LAS u32x2*)(vr + 8);
                    const u32x4 vv = (u32x4){v0.x, v0.y, v1.x, v1.y};
                    oacc[eb] = __builtin_amdgcn_mfma_f32_32x32x16_bf16(__builtin_bit_cast(s16x8, vv), pf, oacc[eb], 0, 0, 0);
                }
            }
        }
    }
    rs += __shfl_xor(rs, 32);
    const float den = iw_t * qn + rs;
    const float dn = 1.f / fmaxf(fabsf(den), __expf(-mt_t));
    float ss = 0.f;
#pragma unroll
    for (int eb = 0; eb < 2; ++eb)
#pragma unroll
        for (int r = 0; r < 16; ++r) { const float v = oacc[eb][r] * dn; oacc[eb][r] = v; ss = fmaf(v, v, ss); }
    ss += __shfl_xor(ss, 32);
    const float rr = 1.f / sqrtf(ss * (1.f / 64.f) + EPS);
    const size_t tok = (size_t)b * SEQ + tseq;
    const float* hg = p.ml_head_norm + l * 64;
#pragma unroll
    for (int eb = 0; eb < 2; ++eb)
#pragma unroll
        for (int g = 0; g < 4; ++g) { const int e0 = eb * 32 + 8 * g + 4 * half; const f32x4 gg = *(const f32x4*)(hg + e0);
            const u32x2 og = *(const u32x2*)(Z + tok * ZP + 1536 + h * 64 + e0);
            u32x2 w; w.x = pkbf(sigmoidf_(bflo(og.x)) * oacc[eb][4 * g] * rr * gg[0], sigmoidf_(bfhi(og.x)) * oacc[eb][4 * g + 1] * rr * gg[1]);
            w.y = pkbf(sigmoidf_(bflo(og.y)) * oacc[eb][4 * g + 2] * rr * gg[2], sigmoidf_(bfhi(og.y)) * oacc[eb][4 * g + 3] * rr * gg[3]);
            *(u32x2*)(O1 + tok * 256 + h * 64 + e0) = w; }
}
__device__ __forceinline__ float relu_(float x) { return __builtin_amdgcn_fmed3f(x, 0.f, __builtin_inff()); }
__device__ __forceinline__ unsigned key16(float s) { const float f = __builtin_amdgcn_fmed3f(floorf(fmaf(s, 512.f, 32768.f)), 0.f, 65535.f); return (unsigned)f; }
__device__ __forceinline__ unsigned mono_bits(float s) { s = (s == 0.f) ? 0.f : s; const unsigned u = __float_as_uint(s); return (u & 0x80000000u) ? ~u : (u | 0x80000000u); }
__device__ __forceinline__ void dsa_item(const Params& p, int lds_l, int b, int qt, LAS unsigned char* lds, int wv) {
    const int tid = tid_fresh(wv), lane = tid & 63, w = wv, half = lane >> 5, r32 = lane & 31;
    const bf16* Z = (const bf16*)(p.ws + WS_BIG); const float* ZS = (const float*)(p.ws + WS_ZS); const bf16* IK = (const bf16*)(p.ws + WS_IK); bf16* O3 = (bf16*)(p.ws + WS_O + 3 * OB_STRIDE);
    LAS unsigned* hist = (LAS unsigned*)lds + w * 2048;
    LAS unsigned* maskw = (LAS unsigned*)(lds + 65536);
    LAS bf16* KC = (LAS bf16*)(lds + 81920);
    LAS bf16* Kd = (LAS bf16*)lds; LAS bf16* VTd = Kd + 64 * 72;
    const size_t tokb = (size_t)b * SEQ; const int tb = qt * 32 + 4 * w;
    const int ntiles = qt + 1, nkeys = ntiles * 32, nchunks = (ntiles + 15) >> 4;
    s16x8 aq0, aq1;
    { const int qrow = 2 * ((r32 >> 2) & 1) + (r32 >> 4), hrow = 4 * ((r32 >> 3) & 1) + (r32 & 3);
      const bf16* ap = Z + (tokb + tb + qrow) * ZP + 2816 + hrow * 32 + half * 8; aq0 = *(const s16x8*)ap; aq1 = *(const s16x8*)(ap + 16); }
    float wq[2][8];
#pragma unroll
    for (int s = 0; s < 2; ++s) { const float* wp = ZS + (tokb + tb + 2 * half + s) * ZSP + 160; const f32x4 x0 = *(const f32x4*)wp, x1 = *(const f32x4*)(wp + 4);
        wq[s][0] = x0[0]; wq[s][1] = x0[1]; wq[s][2] = x0[2]; wq[s][3] = x0[3]; wq[s][4] = x1[0]; wq[s][5] = x1[1]; wq[s][6] = x1[2]; wq[s][7] = x1[3]; }
    unsigned tau[4], prefix[4]; int quota[4], krem[4], eqs[2]; bool allsel[4];
    LAS unsigned* cand = (LAS unsigned*)(lds + 114688) + w * 768;
    LAS unsigned* oflag = (LAS unsigned*)(lds + LDS_BYTES - 48);
    const unsigned lowmask = (1u << r32) - 1u;
#define DSA_SCORES(ktl, sc) do { const LAS bf16* kp_ = KC + ((ktl) * 32 + r32) * 32 + half * 8; \
        const s16x8 b0_ = *(const LAS s16x8*)kp_, b1_ = *(const LAS s16x8*)(kp_ + 16); f32x16 a_ = {0.f, 0.f, 0.f, 0.f, 0.f, 0.f, 0.f, 0.f, 0.f, 0.f, 0.f, 0.f, 0.f, 0.f, 0.f, 0.f}; \
        a_ = __builtin_amdgcn_mfma_f32_32x32x16_bf16(aq0, b0_, a_, 0, 0, 0); a_ = __builtin_amdgcn_mfma_f32_32x32x16_bf16(aq1, b1_, a_, 0, 0, 0); \
        _Pragma("unroll") for (int s_ = 0; s_ < 2; ++s_) { float pt_ = wq[s_][0] * relu_(a_[8 * s_]); \
            _Pragma("unroll") for (int j_ = 1; j_ < 8; ++j_) pt_ = fmaf(wq[s_][j_], relu_(a_[8 * s_ + j_]), pt_); sc[s_] = pt_; } } while (0)
    int mode = (qt >= 8) ? 0 : 1;
#pragma unroll 1
    for (int attempt = 0; attempt < 2; ++attempt) {
        const int npass = (qt >= 8) ? (mode ? 4 : 1) : 0;
#pragma unroll
        for (int g = 0; g < 4; ++g) { tau[g] = 0u; prefix[g] = 0u; quota[g] = 1 << 30; krem[g] = 256; allsel[g] = true; }
        eqs[0] = 0; eqs[1] = 0;
        if (tid == 0) *oflag = 0u;
#pragma unroll 1
        for (int pass = 0; pass <= npass; ++pass) {
            const bool comp = (pass == npass);
            const int shift = 8 * (npass - 1 - pass);
            if (!comp) {
#pragma unroll
                for (int i = 0; i < 8; ++i) *(LAS u32x4*)(hist + (i * 64 + lane) * 4) = (u32x4){0u, 0u, 0u, 0u};
            }
            const unsigned pfa = half ? prefix[2] : prefix[0], pfb = half ? prefix[3] : prefix[1];
            const int ta = tb + 2 * half, tbq = ta + 1;
            u32x4 pre[4];
#pragma unroll
            for (int i = 0; i < 4; ++i) { const int kb = (tid * 16 + i * 8192) >> 6; pre[i] = (kb < nkeys) ? *(const u32x4*)((const unsigned char*)(IK + tokb * 32) + tid * 16 + i * 8192) : (u32x4){0u, 0u, 0u, 0u}; }
#pragma unroll 1
            for (int ch = 0; ch < nchunks; ++ch) {
                __syncthreads();
#pragma unroll
                for (int i = 0; i < 4; ++i) *(LAS u32x4*)((LAS unsigned char*)KC + tid * 16 + i * 8192) = pre[i];
                __syncthreads();
                if (ch + 1 < nchunks) {
#pragma unroll
                    for (int i = 0; i < 4; ++i) { const int kb = (ch + 1) * 512 + ((tid * 16 + i * 8192) >> 6);
                        pre[i] = (kb < nkeys) ? *(const u32x4*)((const unsigned char*)(IK + (tokb + (size_t)(ch + 1) * 512) * 32) + tid * 16 + i * 8192) : (u32x4){0u, 0u, 0u, 0u}; }
                }
                const int nt = min(16, ntiles - ch * 16);
                if (!comp) {
#pragma unroll 4
                    for (int ktl = 0; ktl < nt; ++ktl) {
                        float sc[2]; DSA_SCORES(ktl, sc);
                        const int key = (ch * 16 + ktl) * 32 + r32;
                        const float sa = sc[0], sb = sc[1];
                        if (mode == 0) {
                            const unsigned ba = key16(sa) >> 6, bb = key16(sb) >> 6;
                            if (key <= ta) __hip_atomic_fetch_add(hist + (2 * half) * 512 + (ba >> 1), (ba & 1u) ? 0x10000u : 1u, __ATOMIC_RELAXED, __HIP_MEMORY_SCOPE_WORKGROUP);
                            if (key <= tbq) __hip_atomic_fetch_add(hist + (2 * half + 1) * 512 + (bb >> 1), (bb & 1u) ? 0x10000u : 1u, __ATOMIC_RELAXED, __HIP_MEMORY_SCOPE_WORKGROUP);
                        } else {
                        const unsigned ma = mono_bits(sa), mb = mono_bits(sb);
                        const bool oka = (key <= ta) && (pass == 0 || (ma >> (shift + 8)) == pfa);
                        const bool okb = (key <= tbq) && (pass == 0 || (mb >> (shift + 8)) == pfb);
                        if (oka) __hip_atomic_fetch_add(hist + (2 * half) * 256 + ((ma >> shift) & 255u), 1u, __ATOMIC_RELAXED, __HIP_MEMORY_SCOPE_WORKGROUP);
                        if (okb) __hip_atomic_fetch_add(hist + (2 * half + 1) * 256 + ((mb >> shift) & 255u), 1u, __ATOMIC_RELAXED, __HIP_MEMORY_SCOPE_WORKGROUP);
                        }
                    }
                } else {
#pragma unroll 1
                    for (int ktl = 0; ktl < nt; ++ktl) {
                        float sc[2]; DSA_SCORES(ktl, sc);
                        const int key = (ch * 16 + ktl) * 32 + r32;
#pragma unroll
                        for (int s = 0; s < 2; ++s) {
                            const unsigned taus = half ? tau[2 + s] : tau[s]; const int quo = half ? quota[2 + s] : quota[s]; const bool alls = half ? allsel[2 + s] : allsel[s];
                            const unsigned m = mode ? mono_bits(sc[s]) : (key16(sc[s]) >> 6); const bool valid = key <= tb + 2 * half + s;
                            const bool eq = valid && (m == taus);
                            const unsigned beq = (unsigned)(__ballot(eq) >> (32 * half));
                            const int rank = eqs[s] + __popc(beq & lowmask);
                            const bool takeeq = mode ? (rank < quo) : alls;
                            const bool sel = valid && ((m > taus) || (eq && takeeq));
                            const unsigned bsel = (unsigned)(__ballot(sel) >> (32 * half));
                            if (r32 == 0) maskw[(4 * w + 2 * half + s) * 128 + ch * 16 + ktl] = bsel;
                            if (mode == 0 && !alls && eq && rank < 96) { cand[((2 * half + s) * 96 + rank) * 2] = mono_bits(sc[s]); cand[((2 * half + s) * 96 + rank) * 2 + 1] = (unsigned)key; }
                            eqs[s] += __popc(beq);
                        }
                    }
                }
            }
            if (!comp) {
                LDS_WAIT();
                if (mode == 0) {
#pragma unroll
                    for (int g = 0; g < 4; ++g) {
                        const u32x4 w0 = *(const LAS u32x4*)(hist + g * 512 + lane * 8), w1 = *(const LAS u32x4*)(hist + g * 512 + lane * 8 + 4);
                        const unsigned wd[8] = {w0.x, w0.y, w0.z, w0.w, w1.x, w1.y, w1.z, w1.w};
                        int c[16], tot = 0;
#pragma unroll
                        for (int j = 0; j < 8; ++j) { c[2 * j] = (int)(wd[j] & 0xffffu); c[2 * j + 1] = (int)(wd[j] >> 16); tot += c[2 * j] + c[2 * j + 1]; }
                        int v = tot;
#pragma unroll
                        for (int d = 1; d < 64; d <<= 1) { const int n = __shfl_down(v, d); if (lane + d < 64) v += n; }
                        const int k = krem[g]; int a = v - tot, fb = -1, fa = 0, fc = 0;
#pragma unroll
                        for (int j = 15; j >= 0; --j) { if (fb < 0 && a < k && a + c[j] >= k) { fb = j; fa = a; fc = c[j]; } a += c[j]; }
                        const unsigned long long mk = __ballot(fb >= 0);
                        const int src = (int)__builtin_ctzll(mk | (1ull << 63));
                        const int bin = __shfl(16 * lane + fb, src), above = __shfl(fa, src), cnt = __shfl(fc, src);
                        prefix[g] = (unsigned)bin; krem[g] = k - above;
                        tau[g] = prefix[g]; quota[g] = krem[g]; allsel[g] = (cnt == krem[g]);
                    }
                } else {
#pragma unroll
                for (int g = 0; g < 4; ++g) {
                    const u32x4 cv = *(const LAS u32x4*)(hist + g * 256 + lane * 4);
                    const int c0 = (int)cv.x, c1 = (int)cv.y, c2 = (int)cv.z, c3 = (int)cv.w, tot = c0 + c1 + c2 + c3;
                    int v = tot;
#pragma unroll
                    for (int d = 1; d < 64; d <<= 1) { const int n = __shfl_down(v, d); if (lane + d < 64) v += n; }
                    const int a3 = v - tot, a2 = a3 + c3, a1 = a2 + c2, a0 = a1 + c1; const int k = krem[g];
                    int fb = -1, fa = 0, fc = 0;
                    if (a3 < k && a3 + c3 >= k) { fb = 3; fa = a3; fc = c3; }
                    else if (a2 < k && a2 + c2 >= k) { fb = 2; fa = a2; fc = c2; }
                    else if (a1 < k && a1 + c1 >= k) { fb = 1; fa = a1; fc = c1; }
                    else if (a0 < k && a0 + c0 >= k) { fb = 0; fa = a0; fc = c0; }
                    const unsigned long long mk = __ballot(fb >= 0);
                    const int src = (int)__builtin_ctzll(mk | (1ull << 63));
                    const int bin = __shfl(4 * lane + fb, src), above = __shfl(fa, src), cnt = __shfl(fc, src);
                    prefix[g] = (prefix[g] << 8) | (unsigned)bin; krem[g] = k - above;
                    if (pass == npass - 1) { tau[g] = prefix[g]; quota[g] = krem[g]; allsel[g] = (cnt == krem[g]); }
                }
                }
            }
        }
        if (mode == 0 && npass) {
            LDS_WAIT();
#pragma unroll
            for (int g = 0; g < 4; ++g) {
                if (!allsel[g]) {
                    const int n = __shfl(eqs[g & 1], 32 * (g >> 1)), need = quota[g];
                    if (n > 96) { if (lane == 0) *oflag = 1u; }
                    else {
#pragma unroll 1
                        for (int i0 = 0; i0 < n; i0 += 64) {
                            const int i = i0 + lane; const bool act = i < n;
                            const unsigned mi = act ? cand[(g * 96 + i) * 2] : 0u, ki = act ? cand[(g * 96 + i) * 2 + 1] : 0u; int rank = 0;
#pragma unroll 1
                            for (int j = 0; j < n; ++j) { const unsigned mj = cand[(g * 96 + j) * 2], kj = cand[(g * 96 + j) * 2 + 1]; rank += ((mj > mi) || (mj == mi && kj < ki)) ? 1 : 0; }
                            if (act && rank < need) __hip_atomic_fetch_or(maskw + (4 * w + g) * 128 + (ki >> 5), 1u << (ki & 31u), __ATOMIC_RELAXED, __HIP_MEMORY_SCOPE_WORKGROUP);
                        }
                    }
                }
            }
        }
        __syncthreads();
        const unsigned of = *oflag;
        __syncthreads();
        if (mode == 0 && of != 0u) { mode = 1; continue; }
        break;
    }
    __syncthreads();
    {
        const float* sgn = p.dsa_qk_norm + lds_l * 128; float gqm = 0.f, gkm = 0.f;
#pragma unroll 2
        for (int i = 0; i < 64; ++i) { gqm = fmaxf(gqm, fabsf(sgn[i])); gkm = fmaxf(gkm, fabsf(sgn[64 + i])); }
        const float coff = 8.f * gqm * gkm;
        const int cb = w & 3, ksp = w >> 2, ql = 8 * cb + (r32 >> 2), hh = r32 & 3;
        s16x8 qf[4];
        { const bf16* qp = Z + (tokb + qt * 32 + ql) * ZP + 2560 + hh * 64 + 8 * half;
#pragma unroll
          for (int s4 = 0; s4 < 4; ++s4) qf[s4] = *(const s16x8*)(qp + 16 * s4); }
        f32x16 oacc[2];
#pragma unroll
        for (int db = 0; db < 2; ++db)
#pragma unroll
            for (int r = 0; r < 16; ++r) oacc[db][r] = 0.f;
        float lsum = 0.f;
        const int nT = (ntiles + 1) >> 1;
        const int skey = tid >> 3, sseg = tid & 7;
        const float* sgp = ZS + (tokb + skey) * ZSP + sseg * 16;
        f32x4 pr[4];
#pragma unroll
        for (int i = 0; i < 4; ++i) pr[i] = *(const f32x4*)(sgp + 4 * i);
#pragma unroll 1
        for (int tT = 0; tT < nT; ++tT) {
            __syncthreads();
            if (sseg < 4) {
                u32x4 w0, w1; w0.x = pkbf(pr[0][0], pr[0][1]); w0.y = pkbf(pr[0][2], pr[0][3]); w0.z = pkbf(pr[1][0], pr[1][1]); w0.w = pkbf(pr[1][2], pr[1][3]);
                w1.x = pkbf(pr[2][0], pr[2][1]); w1.y = pkbf(pr[2][2], pr[2][3]); w1.z = pkbf(pr[3][0], pr[3][1]); w1.w = pkbf(pr[3][2], pr[3][3]);
                *(LAS u32x4*)(Kd + skey * 72 + sseg * 16) = w0; *(LAS u32x4*)(Kd + skey * 72 + sseg * 16 + 8) = w1;
            } else {
                LAS bf16* vd = VTd + ((sseg - 4) * 16) * 72 + skey;
#pragma unroll
                for (int i = 0; i < 4; ++i) { const unsigned a0 = pkbf(pr[i][0], pr[i][1]), a1 = pkbf(pr[i][2], pr[i][3]);
                    vd[(4 * i) * 72] = (bf16)(a0 & 0xffffu); vd[(4 * i + 1) * 72] = (bf16)(a0 >> 16); vd[(4 * i + 2) * 72] = (bf16)(a1 & 0xffffu); vd[(4 * i + 3) * 72] = (bf16)(a1 >> 16); }
            }
            __syncthreads();
            if (tT + 1 < nT) {
#pragma unroll
                for (int i = 0; i < 4; ++i) pr[i] = *(const f32x4*)(sgp + (size_t)(tT + 1) * 64 * ZSP + 4 * i);
            }
            const int st = 2 * tT + ksp;
            if (st < ntiles) {
                const unsigned mw = maskw[ql * 128 + st];
                f32x16 sacc;
#pragma unroll
                for (int r = 0; r < 16; ++r) sacc[r] = 0.f;
#pragma unroll
                for (int s4 = 0; s4 < 4; ++s4) { const s16x8 ak = *(const LAS s16x8*)(Kd + (32 * ksp + r32) * 72 + 16 * s4 + 8 * half);
                    sacc = __builtin_amdgcn_mfma_f32_32x32x16_bf16(ak, qf[s4], sacc, 0, 0, 0); }
#pragma unroll
                for (int r = 0; r < 16; ++r) { const int kbit = 8 * (r >> 2) + 4 * half + (r & 3); const float pe = ((mw >> kbit) & 1u) ? __expf(sacc[r] - coff) : 0.f; sacc[r] = pe; lsum += pe; }
#pragma unroll
                for (int s2 = 0; s2 < 2; ++s2) {
                    u32x4 wp; wp.x = pkbf(sacc[8 * s2], sacc[8 * s2 + 1]); wp.y = pkbf(sacc[8 * s2 + 2], sacc[8 * s2 + 3]); wp.z = pkbf(sacc[8 * s2 + 4], sacc[8 * s2 + 5]); wp.w = pkbf(sacc[8 * s2 + 6], sacc[8 * s2 + 7]);
                    const s16x8 pf = __builtin_bit_cast(s16x8, wp);
#pragma unroll
                    for (int db = 0; db < 2; ++db) {
                        const LAS bf16* vr = VTd + (db * 32 + r32) * 72 + 32 * ksp + 16 * s2 + 4 * half;
                        const u32x2 v0 = *(const LAS u32x2*)vr, v1 = *(const LAS u32x2*)(vr + 8);
                        const u32x4 vv = (u32x4){v0.x, v0.y, v1.x, v1.y};
                        oacc[db] = __builtin_amdgcn_mfma_f32_32x32x16_bf16(__builtin_bit_cast(s16x8, vv), pf, oacc[db], 0, 0, 0);
                    }
                }
            }
        }
        lsum += __shfl_xor(lsum, 32);
        __syncthreads();
        LAS float* xch = (LAS float*)(lds + 81920) + (w & 3) * (33 * 64);
        if (ksp == 1) {
#pragma unroll
            for (int db = 0; db < 2; ++db)
#pragma unroll
                for (int r = 0; r < 16; ++r) xch[(db * 16 + r) * 64 + lane] = oacc[db][r];
            xch[32 * 64 + lane] = lsum;
        }
        __syncthreads();
        if (ksp == 0) {
            const float is = 1.f / (lsum + xch[32 * 64 + lane]);
            bf16* orow = O3 + (tokb + qt * 32 + ql) * 256 + hh * 64;
#pragma unroll
            for (int db = 0; db < 2; ++db)
#pragma unroll
                for (int g = 0; g < 4; ++g) { const int d0 = db * 32 + 8 * g + 4 * half;
                    const float x0 = (oacc[db][4 * g] + xch[(db * 16 + 4 * g) * 64 + lane]) * is, x1 = (oacc[db][4 * g + 1] + xch[(db * 16 + 4 * g + 1) * 64 + lane]) * is;
                    const float x2 = (oacc[db][4 * g + 2] + xch[(db * 16 + 4 * g + 2) * 64 + lane]) * is, x3 = (oacc[db][4 * g + 3] + xch[(db * 16 + 4 * g + 3) * 64 + lane]) * is;
                    u32x2 wo; wo.x = pkbf(x0, x1); wo.y = pkbf(x2, x3); *(u32x2*)(orow + d0) = wo; }
        }
    }
#undef DSA_SCORES
    __syncthreads();
}

constexpr int Q_ML = 32, Q_DIFF = 512, Q_DSA = 1024, Q_SB = 256, Q_TOTAL = Q_ML + Q_DIFF + Q_DSA + Q_SB;
__device__ __forceinline__ int next_item(unsigned* ctr, LAS int* slot, int wv) {
    __syncthreads();
    if (tid_fresh(wv) == 0) *slot = (int)atomicAdd(ctr, 1u);
    __syncthreads();
    return *slot;
}
__device__ __forceinline__ void mixer_phase1(int l, LAS unsigned char* lds, int wv, int co = 0) {
    LAS int* slot = (LAS int*)(lds + LDS_BYTES - 64);
    { const Params p = load_params(); unsigned* ctr = (unsigned*)(p.ws + WS_CTL) + 64 * (4 * l + 0 + co);
      for (;;) { const int it = next_item(ctr, slot, wv); if (it >= Q_DIFF) break; diffm_item(p, l, it & 31, 15 - (it >> 5), lds, wv); } }
    { const Params p = load_params(); unsigned* ctr = (unsigned*)(p.ws + WS_CTL) + 64 * (4 * l + 1 + co);
      for (;;) { const int it = next_item(ctr, slot, wv); if (it >= 512) break; mlB_item(p, l, it & 31, it >> 5, lds, wv); } }
}
__device__ __forceinline__ void mixer_phase2(int l, LAS unsigned char* lds, int wv, int co = 0) {
    LAS int* slot = (LAS int*)(lds + LDS_BYTES - 64);
    { const Params p = load_params(); unsigned* ctr = (unsigned*)(p.ws + WS_CTL) + 64 * (4 * l + 2 + co);
      for (;;) { const int it = next_item(ctr, slot, wv); if (it >= 32 + Q_DSA) break;
          if (it < 32) mlS_item(p, it, wv); else { const int i = it - 32; dsa_item(p, l, i & 7, 127 - (i >> 3), lds, wv); } } }
}
__device__ __forceinline__ void mixer_phase3(int l, LAS unsigned char* lds, int wv, int co = 0) {
    LAS int* slot = (LAS int*)(lds + LDS_BYTES - 64);
    { const Params p = load_params(); unsigned* ctr = (unsigned*)(p.ws + WS_CTL) + 64 * (4 * l + 3 + co);
      for (;;) { const int it = next_item(ctr, slot, wv); if (it >= 512) break; mlD_item(p, l, it & 31, it >> 5, lds, wv); } }
    { const Params p = load_params(); unsigned* ctr = (unsigned*)(p.ws + WS_CTL) + 64 * (8 + l + co);
      for (;;) { const int it = next_item(ctr, slot, wv); if (it >= Q_SB) break; sb_item(p, l, it >> 3, it & 7, lds, wv); } }
}

#define XB_TMO      128
#define XB_XCNT(j)  (256  + 64 * (j))
#define XB_XSUB(j)  (1280 + 64 * (j))
#define XB_XGEN(j)  (2304 + 64 * (j))
#define XB_TOP      3328
#define XB_TOPGEN   3392
#define XCD_BAR_WORDS 3456
#define XB_SPIN_CAP (1u << 20)
constexpr int CW_BAR = 8192;
__device__ __forceinline__ unsigned xb_ld(unsigned* p)              { return __hip_atomic_load(p, __ATOMIC_RELAXED, __HIP_MEMORY_SCOPE_AGENT); }
__device__ __forceinline__ unsigned xb_add(unsigned* p, unsigned v) { return __hip_atomic_fetch_add(p, v, __ATOMIC_RELAXED, __HIP_MEMORY_SCOPE_AGENT); }
__device__ __forceinline__ unsigned xb_xcc_id() { return (unsigned)__builtin_amdgcn_s_getreg((3 << 11) | 20) & 0xFu; }
#define XB_SPIN(cond, bar) do { unsigned _sp = 0; while (cond) { __builtin_amdgcn_s_sleep(1); \
    if ((++_sp & 255u) == 0u) { if (xb_ld(&(bar)[XB_TMO])) break; if (_sp > XB_SPIN_CAP) { atomicAdd(&(bar)[XB_TMO], 1u); break; } } } } while (0)
__device__ __forceinline__ void xcd_post(int wv) {
    const Params p = load_params(); unsigned* bar = (unsigned*)(p.ws + WS_CTL) + CW_BAR;
    if (tid_fresh(wv) == 0) (void)xb_add(&bar[XB_XCNT(xb_xcc_id())], 1u);
}
__device__ __forceinline__ void xcd_barrier_complete(unsigned* bar, unsigned x, unsigned& nloc, unsigned& nx) {
    const unsigned G = gridDim.x * gridDim.y * gridDim.z;
    unsigned sum, cnt, mine, sp = 0u;
    for (;;) {
        sum = 0u; cnt = 0u; mine = 0u;
#pragma unroll
        for (unsigned j = 0; j < 16; ++j) { const unsigned c = xb_ld(&bar[XB_XCNT(j)]); sum += c; cnt += (c > 0u) ? 1u : 0u; mine = (j == x) ? c : mine; }
        if (sum == G) break;
        __builtin_amdgcn_s_sleep(1);
        if ((++sp & 255u) == 0u) { if (xb_ld(&bar[XB_TMO])) break; if (sp > XB_SPIN_CAP) { atomicAdd(&bar[XB_TMO], 1u); break; } }
    }
    nloc = mine > 0u ? mine : 1u; nx = cnt > 0u ? cnt : 1u;
}
__device__ __forceinline__ void gsync(LAS unsigned char* lds, int wv) {
    asm volatile("s_waitcnt vmcnt(0)" ::: "memory");
    __syncthreads();
    if (tid_fresh(wv) == 0) {
        const Params p = load_params(); unsigned* bar = (unsigned*)(p.ws + WS_CTL) + CW_BAR;
        volatile LAS unsigned* st = (volatile LAS unsigned*)(lds + LDS_BYTES - 32);
        const unsigned x = xb_xcc_id();
        __builtin_amdgcn_s_waitcnt(0);
        unsigned nloc = st[0], nx = st[1];
        if (nloc == 0u) { xcd_barrier_complete(bar, x, nloc, nx); st[0] = nloc; st[1] = nx; }
        const unsigned old = xb_add(&bar[XB_XSUB(x)], 1u);
        const unsigned gen = old / nloc;
        if (old + 1u == (gen + 1u) * nloc) {
            __builtin_amdgcn_fence(__ATOMIC_RELEASE, "agent");
            asm volatile("s_waitcnt vmcnt(0)" ::: "memory");
            const unsigned og = xb_add(&bar[XB_TOP], 1u);
            const unsigned tg = og / nx;
            if (og + 1u == (tg + 1u) * nx) xb_add(&bar[XB_TOPGEN], 1u);
            else XB_SPIN(xb_ld(&bar[XB_TOPGEN]) == tg, bar);
            __builtin_amdgcn_fence(__ATOMIC_ACQUIRE, "agent");
            xb_add(&bar[XB_XGEN(x)], 1u);
            asm volatile("s_waitcnt vmcnt(0)" ::: "memory");
        } else {
            XB_SPIN(xb_ld(&bar[XB_XGEN(x)]) == gen, bar);
            __builtin_amdgcn_fence(__ATOMIC_ACQUIRE, "agent");
            asm volatile("s_waitcnt vmcnt(0)" ::: "memory");
        }
    }
    __syncthreads();
}

#define PH_LOCALS const Params p = load_params(); const int tid = tid_fresh(wv), lane = tid & 63, wave = tid >> 6; const int gw = (int)blockIdx.x * NWAVES + wave, ngw = (int)gridDim.x * NWAVES; \
    (void)lane; (void)gw; (void)ngw; bf16* HN = (bf16*)(p.ws + WS_HN); bf16* BIGB = (bf16*)(p.ws + WS_BIG); (void)HN; (void)BIGB;
template <int l> __device__ __forceinline__ void layer_body(cg::grid_group& grid, LAS unsigned char* lds, const int wv) {
        { PH_LOCALS const unsigned char* wl = p.ws + WS_W + (size_t)l * WL_STRIDE; EpiSwiglu E{l * 3 + 0}; run_gemm(lds, HN, (const bf16*)(wl + WL_GU1), T, 2 * FF, D, E, wv); }
        gsync(lds, wv);
        { PH_LOCALS const unsigned char* wl = p.ws + WS_W + (size_t)l * WL_STRIDE; EpiResid E{l == 0 ? 1 : 0, 0.5f, l * 3 + 1}; run_gemm(lds, BIGB, (const bf16*)(wl + WL_D1), T, D, FF, E, wv); }
        gsync(lds, wv);
        { PH_LOCALS const unsigned char* wl = p.ws + WS_W + (size_t)l * WL_STRIDE; EpiZ E{l * 3 + 1}; run_gemm(lds, HN, (const bf16*)(wl + WL_INA), T, 3328, D, E, wv); }
        gsync(lds, wv);
        { PH_LOCALS if (gw < 32) ml_prepass(p, l, gw, lane); else prep_phase(p, l, gw - 32, ngw - 32, lane); }
        gsync(lds, wv);
        mixer_phase1(l, lds, wv);
#if PROBE_DUP & 1
        gsync(lds, wv); mixer_phase1(l, lds, wv, 16);
#endif
        gsync(lds, wv);
        mixer_phase2(l, lds, wv);
#if PROBE_DUP & 2
        gsync(lds, wv); mixer_phase2(l, lds, wv, 16);
#endif
        gsync(lds, wv);
        mixer_phase3(l, lds, wv);
#if PROBE_DUP & 4
        gsync(lds, wv); mixer_phase3(l, lds, wv, 16);
#endif
        gsync(lds, wv);
#pragma unroll 1
        for (int hb = 0; hb < 2; ++hb) {
            { PH_LOCALS const unsigned char* wl = p.ws + WS_W + (size_t)l * WL_STRIDE; EpiSig E{l * 3 + 1}; run_gemm(lds, HN, (const bf16*)(wl + WL_G) + (size_t)hb * 2 * D * D, T, 2 * D, D, E, wv); }
            gsync(lds, wv);
#pragma unroll 1
            for (int bb = 0; bb < 2; ++bb) {
                PH_LOCALS const unsigned char* wl = p.ws + WS_W + (size_t)l * WL_STRIDE; const int b = hb * 2 + bb;
                EpiGate E{bb * D, b == 0 ? 1 : 0};
                run_gemm(lds, (const bf16*)(p.ws + WS_O + b * OB_STRIDE), (const bf16*)(wl + WL_BR) + (size_t)b * D * 256, T, D, 256, E, wv);
            }
            gsync(lds, wv);
        }
        { PH_LOCALS const unsigned char* wl = p.ws + WS_W + (size_t)l * WL_STRIDE; EpiResid E{0, 1.0f, l * 3 + 2}; run_gemm(lds, (const bf16*)(p.ws + WS_BIG + 128 * MiB), (const bf16*)(wl + WL_OUT), T, D, D, E, wv); }
        gsync(lds, wv);
        { PH_LOCALS const unsigned char* wl = p.ws + WS_W + (size_t)l * WL_STRIDE; EpiSwiglu E{l * 3 + 2}; run_gemm(lds, HN, (const bf16*)(wl + WL_GU2), T, 2 * FF, D, E, wv); }
        gsync(lds, wv);
        { PH_LOCALS const unsigned char* wl = p.ws + WS_W + (size_t)l * WL_STRIDE; EpiResid E{0, 0.5f, (l + 1 < DEPTH) ? (l + 1) * 3 : -1}; run_gemm(lds, BIGB, (const bf16*)(wl + WL_D2), T, D, FF, E, wv); }
        if (l + 1 < DEPTH) gsync(lds, wv);
    }

__global__ void __launch_bounds__(NTHR, 2) hybrid_fwd(Params p_unused) {
    extern __shared__ __attribute__((aligned(16))) unsigned char lds_raw[];
    LAS unsigned char* lds = (LAS unsigned char*)lds_raw;
    cg::grid_group grid = cg::this_grid();
    const int wv = __builtin_amdgcn_readfirstlane((int)threadIdx.x >> 6);
    {
        PH_LOCALS
        SegRun R; R.base = 0; R.gw = gw; R.ngw = ngw; R.lane = lane; R.scr = (LAS float*)(lds + wave * 8704);
        for (int l = 0; l < DEPTH; ++l) convert_weights(p, l, R);
        if (blockIdx.x == 0 && tid < 64) ((unsigned*)(p.ws + WS_CTL))[64 * tid] = 0u;
        if (blockIdx.x == 0) for (int i = tid; i < XCD_BAR_WORDS; i += NTHR) ((unsigned*)(p.ws + WS_CTL))[CW_BAR + i] = 0u;
        if (tid < 8) ((LAS unsigned*)(lds + LDS_BYTES - 32))[tid] = 0u;
        for (int i = gw * 64 + lane; i < 5 * T; i += ngw * 64) { const int a_ = 1 + i / T; rs_ptr(p, a_)[i % T] = 0ull; }
        xb_rows(p.x, HN, rs_ptr(p, 0), gw, ngw, lane);
    }
    grid.sync();
    xcd_post(wv);
    layer_body<0>(grid, lds, wv);
    layer_body<1>(grid, lds, wv);
}

extern "C" void kernel_launch(void* const* d_in, const int* in_sizes, int n_in, void* d_out, int out_size, void* d_ws, size_t ws_size, hipStream_t stream) {
    static int grid = 0;
    if (grid == 0) {
        if (n_in != 20 || out_size != T * D || ws_size < WS_END2) { fprintf(stderr, "kernel_launch: unexpected shapes (n_in %d out %d ws %zu)\n", n_in, out_size, ws_size); grid = -1; return; }
        int dev = 0, cus = 0, per_cu = 0;
        hipGetDevice(&dev); hipDeviceGetAttribute(&cus, hipDeviceAttributeMultiprocessorCount, dev);
        hipFuncSetAttribute((const void*)hybrid_fwd, hipFuncAttributeMaxDynamicSharedMemorySize, LDS_BYTES);
        hipOccupancyMaxActiveBlocksPerMultiprocessor(&per_cu, (const void*)hybrid_fwd, NTHR, LDS_BYTES);
        if (per_cu < 1) { fprintf(stderr, "kernel_launch: occupancy query says %d\n", per_cu); per_cu = 1; }
        (void)hipGetLastError();
        grid = cus * 1;
    }
    if (grid < 0) return;
    Params p{};
    p.x = (const float*)d_in[0]; p.pos = (const int*)d_in[1];
    p.ffn1_norm = (const float*)d_in[2]; p.ffn1_gu = (const float*)d_in[3]; p.ffn1_down = (const float*)d_in[4]; p.mix_norm = (const float*)d_in[5]; p.w_in = (const float*)d_in[6];
    p.diff_qk_norm = (const float*)d_in[7]; p.diff_lambda = (const float*)d_in[8]; p.diff_head_norm = (const float*)d_in[9]; p.ml_conv_w = (const float*)d_in[10]; p.ml_conv_b = (const float*)d_in[11];
    p.ml_gate_bias = (const float*)d_in[12]; p.ml_head_norm = (const float*)d_in[13]; p.dsa_qk_norm = (const float*)d_in[14]; p.w_branch = (const float*)d_in[15]; p.w_out = (const float*)d_in[16];
    p.ffn2_norm = (const float*)d_in[17]; p.ffn2_gu = (const float*)d_in[18]; p.ffn2_down = (const float*)d_in[19];
    p.out = (float*)d_out; p.ws = (unsigned char*)d_ws;
    void* args[] = {&p};
    hipError_t e = hipLaunchCooperativeKernel((const void*)hybrid_fwd, dim3(grid), dim3(NTHR), args, LDS_BYTES, stream);
    if (e != hipSuccess) fprintf(stderr, "cooperative launch failed: %s (grid %d)\n", hipGetErrorString(e), grid);
}
```

```cpp
#include <hip/hip_runtime.h>
#include <hip/hip_cooperative_groups.h>
#include <cstdio>
#include <cstdint>
namespace cg = cooperative_groups;
#ifndef PROBE_DUP
#define PROBE_DUP 0
#endif
namespace pg8 {
#define PG8_LAS __attribute__((address_space(3)))
typedef unsigned short bf16_t;
typedef short bf16x8 __attribute__((ext_vector_type(8)));
typedef float f32x4 __attribute__((ext_vector_type(4)));
typedef unsigned u32x4 __attribute__((ext_vector_type(4)));
constexpr int BM = 256, BK = 64, HALF = 128, HTB = HALF * BK * 2  , STAGE_BYTES = 8 * HTB, NXCD = 8, WGM = 8;

__host__ __device__ __forceinline__ int lds_byte(int r, int c) { const int st = (r >> 4) * 2 + (c >> 5), rr = r & 15, cc = c & 31, ob = rr * 64 + cc * 2; return st * 1024 + (ob ^ (((ob >> 9) & 1) << 5)); }
__host__ __device__ __forceinline__ void stage_rc(int b, int& R, int& C) { const int st = b / 1024, sb = b % 1024, swz = sb ^ (((sb >> 9) & 1) << 5); R = (st >> 1) * 16 + swz / 64; C = (st & 1) * 32 + (swz % 64) / 2; }
__host__ __device__ __forceinline__ int perm32(int rho) { const int n = rho >> 4, i = rho & 15; return 8 * (i >> 2) + 4 * n + (i & 3); }

struct Unit { int pm, pn; };
struct Gemm { const bf16_t* A; const bf16_t* Bt; int M, N, K; };

struct StaticOrder {
    int nM, nN, nwg, G, c;
    __host__ __device__ void init(int M, int N, int G_, int c_) { nM = M / BM; nN = N / BM; nwg = nM * nN; G = G_; c = c_; }
    __host__ __device__ bool next(int i, Unit& u) const {
        const long L = (long)i * G + c; if (L >= nwg) return false;
        int wgid = (int)L; { const int q = nwg / NXCD, r = nwg % NXCD, xcd = wgid % NXCD, off = wgid / NXCD; wgid = (xcd < r ? xcd * (q + 1) : r * (q + 1) + (xcd - r) * q) + off; }
        const int nig = WGM * nN, gid = wgid / nig, fm = gid * WGM, gsz = (nM - fm) < WGM ? (nM - fm) : WGM;
        u.pm = fm + ((wgid % nig) % gsz); u.pn = (wgid % nig) / gsz; return true;
    }
    __device__ __forceinline__ void a_ready(const Unit&) const {}
    __device__ __forceinline__ void done(const Unit&) const {}
};

__device__ __forceinline__ unsigned cvt_pk_bf16(float lo, float hi) { unsigned r; asm volatile("v_cvt_pk_bf16_f32 %0, %1, %2" : "=v"(r) : "v"(lo), "v"(hi)); return r; }
template <class Epi, class Sched, bool ALIGN_EPI = false, bool SP2 = false>
__device__ __forceinline__ void gemm_phase(PG8_LAS unsigned char* lds, const Gemm g, const Sched& S, const Epi& E, const int wave_in) {
    unsigned z_ = 0u; asm volatile("" : "+v"(z_)); int w_ = wave_in; asm volatile("" : "+s"(w_));
    const int tid_ = w_ * 64 + (int)__builtin_amdgcn_mbcnt_hi(~0u, __builtin_amdgcn_mbcnt_lo(~0u, z_));
    const int tid = tid_, wid = __builtin_amdgcn_readfirstlane(tid >> 6), lane = tid & 63, wr = wid >> 2, wc = wid & 3, fr = lane & 15, fq = lane >> 4;
    const int K = g.K, nt = K / BK;
    unsigned voffA[2], voffB[2];
#pragma unroll
    for (int i = 0; i < 2; ++i) { int R, C; stage_rc(tid * 16 + i * 8192, R, C); const int Rb = Epi::PERM ? ((R & ~31) + perm32(R & 31)) : R;
        voffA[i] = (unsigned)(R * K + C) * 2u; voffB[i] = (unsigned)(Rb * K + C) * 2u; }
    const size_t kstep = (size_t)(BK * 2);
    const size_t hstep = (size_t)HALF * K * 2;
    const size_t tstep = 2 * hstep;
    const unsigned ldsw = (unsigned)wid * 1024u;
    const int aoff = lds_byte(wr * 64 + fr, fq * 8), boff = lds_byte(wc * 32 + fr, fq * 8);
#define PG8_SA(b, h) (((b) * 2 + (h)) * HTB)
#define PG8_SB(b, h) ((4 + (b) * 2 + (h)) * HTB)
#define PG8_STAGE(bufoff, gbase, voff) do { _Pragma("unroll") for (int _i = 0; _i < 2; ++_i) \
        __builtin_amdgcn_global_load_lds((const unsigned*)((const char*)(gbase) + (voff)[_i]), (PG8_LAS unsigned*)(lds + (bufoff) + ldsw + _i * 8192), 16, 0, 0); } while (0)
#define PG8_LDA(dst, b, h) do { _Pragma("unroll") for (int m = 0; m < 4; ++m) _Pragma("unroll") for (int k = 0; k < 2; ++k) dst[m][k] = *(const PG8_LAS bf16x8*)(lds + PG8_SA(b, h) + aoff + m * 2048 + k * 1024); } while (0)
#define PG8_LDB(dst, b, h) do { _Pragma("unroll") for (int n = 0; n < 2; ++n) _Pragma("unroll") for (int k = 0; k < 2; ++k) dst[n][k] = *(const PG8_LAS bf16x8*)(lds + PG8_SB(b, h) + boff + n * 2048 + k * 1024); } while (0)
#define PG8_MMA(ai, bj, At, Bt) do { __builtin_amdgcn_s_setprio(1); _Pragma("unroll") for (int m = 0; m < 4; ++m) _Pragma("unroll") for (int n = 0; n < 2; ++n) _Pragma("unroll") for (int k = 0; k < 2; ++k) \
        acc[ai][bj][m][n] = __builtin_amdgcn_mfma_f32_16x16x32_bf16(Bt[n][k], At[m][k], acc[ai][bj][m][n], 0, 0, 0); __builtin_amdgcn_s_setprio(0); } while (0)
#define PG8_WAIT_V(n) asm volatile("s_waitcnt vmcnt(" #n ")" ::: "memory")
#define PG8_WAIT_L(n) asm volatile("s_waitcnt lgkmcnt(" #n ")" ::: "memory")
#define PG8_BAR __builtin_amdgcn_s_barrier()
#define PG8_SCHED __builtin_amdgcn_sched_barrier(0)
    Unit cur, nxt; int ui = 0;
    if (!S.next(0, cur)) return;
    f32x4 acc[2][2][4][2];
#pragma unroll
    for (int a = 0; a < 2; ++a)
#pragma unroll
        for (int b = 0; b < 2; ++b)
#pragma unroll
            for (int m = 0; m < 4; ++m)
#pragma unroll
                for (int n = 0; n < 2; ++n) acc[a][b][m][n] = (f32x4){0.f, 0.f, 0.f, 0.f};
    bf16x8 At[4][2], B0[2][2], B1[2][2];
    const char* cA = (const char*)g.A + (size_t)cur.pm * tstep; const char* cB = (const char*)g.Bt + (size_t)cur.pn * tstep;
    S.a_ready(cur);
    if constexpr (SP2) {
        PG8_STAGE(PG8_SB(0, 0), cB, voffB); PG8_STAGE(PG8_SB(0, 1), cB + hstep, voffB); PG8_STAGE(PG8_SA(0, 0), cA, voffA); PG8_STAGE(PG8_SA(0, 1), cA + hstep, voffA);
        if (wr == 1) PG8_BAR;
        PG8_WAIT_V(2); PG8_BAR;
        PG8_STAGE(PG8_SB(1, 0), cB + kstep, voffB); PG8_STAGE(PG8_SA(1, 0), cA + kstep, voffA); PG8_STAGE(PG8_SB(1, 1), cB + hstep + kstep, voffB);
        PG8_WAIT_V(6); PG8_BAR;
    } else {
        PG8_STAGE(PG8_SB(0, 0), cB, voffB); PG8_STAGE(PG8_SA(0, 0), cA, voffA); PG8_STAGE(PG8_SB(0, 1), cB + hstep, voffB); PG8_STAGE(PG8_SA(0, 1), cA + hstep, voffA);
        if (wr == 1) PG8_BAR;
        PG8_WAIT_V(4); PG8_BAR;
        PG8_STAGE(PG8_SB(1, 0), cB + kstep, voffB); PG8_STAGE(PG8_SA(1, 0), cA + kstep, voffA); PG8_STAGE(PG8_SB(1, 1), cB + hstep + kstep, voffB);
        PG8_WAIT_V(6); PG8_BAR;
    }
    for (;;) {
        const bool has_next = S.next(ui + 1, nxt);
        const char* nA = has_next ? (const char*)g.A + (size_t)nxt.pm * tstep : cA; const char* nB = has_next ? (const char*)g.Bt + (size_t)nxt.pn * tstep : cB;
        for (int t = 0; t < nt; t += 2) {
            const bool last = (t == nt - 2);
            const char* a1 = cA + (size_t)(t + 1) * kstep;
            const char* a2 = last ? nA : cA + (size_t)(t + 2) * kstep; const char* b2 = last ? nB : cB + (size_t)(t + 2) * kstep;
            const char* a3 = a2 + kstep; const char* b3 = b2 + kstep;
            if (last && has_next) S.a_ready(nxt);
            if constexpr (SP2) {
            PG8_LDB(B0, 0, 0); PG8_LDB(B1, 0, 1); PG8_SCHED; PG8_LDA(At, 0, 0); PG8_STAGE(PG8_SA(1, 1), a1 + hstep, voffA);
            PG8_WAIT_V(8); PG8_WAIT_L(0); PG8_BAR; PG8_MMA(0, 0, At, B0); PG8_MMA(0, 1, At, B1); PG8_BAR; PG8_SCHED;
            PG8_LDA(At, 0, 1); PG8_STAGE(PG8_SB(0, 0), b2, voffB); PG8_STAGE(PG8_SB(0, 1), b2 + hstep, voffB); PG8_STAGE(PG8_SA(0, 0), a2, voffA);
            PG8_WAIT_V(8); PG8_WAIT_L(0); PG8_BAR; PG8_MMA(1, 0, At, B0); PG8_MMA(1, 1, At, B1); PG8_BAR; PG8_SCHED;
            PG8_LDB(B0, 1, 0); PG8_LDB(B1, 1, 1); PG8_SCHED; PG8_LDA(At, 1, 0); PG8_STAGE(PG8_SA(0, 1), a2 + hstep, voffA);
            PG8_WAIT_V(8); PG8_WAIT_L(0); PG8_BAR; PG8_MMA(0, 0, At, B0); PG8_MMA(0, 1, At, B1); PG8_BAR; PG8_SCHED;
            PG8_LDA(At, 1, 1); PG8_STAGE(PG8_SB(1, 0), b3, voffB); PG8_STAGE(PG8_SB(1, 1), b3 + hstep, voffB); PG8_STAGE(PG8_SA(1, 0), a3, voffA);
            PG8_WAIT_V(8); PG8_WAIT_L(0); PG8_BAR; PG8_MMA(1, 0, At, B0); PG8_MMA(1, 1, At, B1); PG8_BAR; PG8_SCHED;
            } else {
            PG8_LDB(B0, 0, 0); PG8_SCHED; PG8_LDA(At, 0, 0); PG8_STAGE(PG8_SA(1, 1), a1 + hstep, voffA);
            PG8_WAIT_L(8); PG8_BAR; PG8_WAIT_L(0); PG8_MMA(0, 0, At, B0); PG8_BAR; PG8_SCHED;
            PG8_LDB(B1, 0, 1); PG8_STAGE(PG8_SB(0, 0), b2, voffB);
            PG8_BAR; PG8_WAIT_L(0); PG8_MMA(0, 1, At, B1); PG8_BAR;
            PG8_LDA(At, 0, 1); PG8_STAGE(PG8_SA(0, 0), a2, voffA);
            PG8_BAR; PG8_WAIT_L(0); PG8_MMA(1, 0, At, B0); PG8_BAR; PG8_SCHED;
            PG8_STAGE(PG8_SB(0, 1), b2 + hstep, voffB);
            PG8_WAIT_V(6); PG8_BAR; PG8_MMA(1, 1, At, B1); PG8_BAR;
            PG8_LDB(B0, 1, 0); PG8_SCHED; PG8_LDA(At, 1, 0); PG8_STAGE(PG8_SA(0, 1), a2 + hstep, voffA);
            PG8_WAIT_L(8); PG8_BAR; PG8_WAIT_L(0); PG8_MMA(0, 0, At, B0); PG8_BAR; PG8_SCHED;
            PG8_LDB(B1, 1, 1); PG8_STAGE(PG8_SB(1, 0), b3, voffB);
            PG8_BAR; PG8_WAIT_L(0); PG8_MMA(0, 1, At, B1); PG8_BAR;
            PG8_LDA(At, 1, 1); PG8_STAGE(PG8_SA(1, 0), a3, voffA);
            PG8_BAR; PG8_WAIT_L(0); PG8_MMA(1, 0, At, B0); PG8_BAR; PG8_SCHED;
            PG8_STAGE(PG8_SB(1, 1), b3 + hstep, voffB);
            PG8_WAIT_V(6); PG8_BAR; PG8_MMA(1, 1, At, B1); PG8_BAR;
            }
        }
        if constexpr (ALIGN_EPI) { if (wr == 0) PG8_BAR; }
        if constexpr (!Epi::AFTER_DRAIN) { E(acc, cur, wr, wc, fr, fq); S.done(cur); }
        if (!has_next) break;
#pragma unroll
        for (int a = 0; a < 2; ++a)
#pragma unroll
            for (int b = 0; b < 2; ++b)
#pragma unroll
                for (int m = 0; m < 4; ++m)
#pragma unroll
                    for (int n = 0; n < 2; ++n) acc[a][b][m][n] = (f32x4){0.f, 0.f, 0.f, 0.f};
        cur = nxt; cA = nA; cB = nB; ++ui;
        if constexpr (ALIGN_EPI) { if (wr == 1) PG8_BAR; }
    }
    PG8_WAIT_V(0);
    if constexpr (!ALIGN_EPI) { if (wr == 0) PG8_BAR; }
    PG8_BAR;
    if constexpr (Epi::AFTER_DRAIN) { E.fused(acc, cur, wr, wc, fr, fq, lds, wid, lane); S.done(cur); }
#undef PG8_SA
#undef PG8_SB
#undef PG8_STAGE
#undef PG8_LDA
#undef PG8_LDB
#undef PG8_MMA
#undef PG8_WAIT_V
#undef PG8_WAIT_L
#undef PG8_BAR
#undef PG8_SCHED
}
}
#define LAS __attribute__((address_space(3)))
typedef unsigned short bf16;
typedef float f32x4 __attribute__((ext_vector_type(4)));
typedef float f32x16 __attribute__((ext_vector_type(16)));
typedef unsigned u32x4 __attribute__((ext_vector_type(4)));
typedef unsigned u32x2 __attribute__((ext_vector_type(2)));
typedef short s16x8 __attribute__((ext_vector_type(8)));

constexpr int NB = 8, SEQ = 4096, T = NB * SEQ, D = 1024, FF = 2816, DEPTH = 2, NIN = 7344, ZP = 3072, ZSP = 256;
constexpr int NTHR = 512, NWAVES = 8;
__host__ __device__ constexpr int col_dq(int l) { return l ? 2048 : 0; }
__host__ __device__ constexpr int col_dk(int l) { return l ? 2304 : 256; }
__host__ __device__ constexpr int col_sbk(int l) { return l ? 0 : 2048; }
constexpr int LDS_BYTES = 147456;
constexpr float EPS = 1e-6f;

constexpr size_t MiB = (size_t)1 << 20;
constexpr size_t WS_CTL = 0;
constexpr size_t WS_W = 1 * MiB, WL_STRIDE = 52 * MiB;
constexpr size_t WL_GU1 = 0, WL_D1 = 11534336, WL_INA = 17301504, WL_G = 24117248, WL_BR = 32505856, WL_OUT = 34603008, WL_GU2 = 36700160, WL_D2 = 48234496;
constexpr size_t WS_HN = 106 * MiB, WS_BIG = 170 * MiB, WS_ZS = 362 * MiB, WS_O = 394 * MiB, WS_IK = 458 * MiB, WS_END = 460 * MiB;
constexpr size_t OB_STRIDE = (size_t)T * 256 * 2;

struct Params {
    const float* x; const int* pos;
    const float *ffn1_norm, *ffn1_gu, *ffn1_down, *mix_norm, *w_in, *diff_qk_norm, *diff_lambda, *diff_head_norm, *ml_conv_w, *ml_conv_b, *ml_gate_bias, *ml_head_norm,
        *dsa_qk_norm, *w_branch, *w_out, *ffn2_norm, *ffn2_gu, *ffn2_down;
    float* out; unsigned char* ws;
};

__device__ __forceinline__ unsigned f2bf(float f) { unsigned u = __float_as_uint(f); return (u + 0x7fffu + ((u >> 16) & 1u)) >> 16; }
typedef float f32x2_t __attribute__((ext_vector_type(2)));
typedef __bf16 bf16x2_t __attribute__((ext_vector_type(2)));
__device__ __forceinline__ unsigned pk2(float lo, float hi) { const f32x2_t v = {lo, hi}; const bf16x2_t b = __builtin_convertvector(v, bf16x2_t); return __builtin_bit_cast(unsigned, b); }
__device__ __forceinline__ float bflo(unsigned w) { return __uint_as_float(w << 16); }
__device__ __forceinline__ float bfhi(unsigned w) { return __uint_as_float(w & 0xffff0000u); }
__device__ __forceinline__ float wave_sum(float v) {
#pragma unroll
    for (int o = 1; o < 64; o <<= 1) v += __shfl_xor(v, o);
    return v;
}
__device__ __forceinline__ float wave_max(float v) {
#pragma unroll
    for (int o = 1; o < 64; o <<= 1) v = fmaxf(v, __shfl_xor(v, o));
    return v;
}
__device__ __forceinline__ int lane_fresh() { unsigned z = 0u; asm volatile("" : "+v"(z)); return (int)__builtin_amdgcn_mbcnt_hi(~0u, __builtin_amdgcn_mbcnt_lo(~0u, z)); }
__device__ __forceinline__ int tid_fresh(int wv) { int w = wv; asm volatile("" : "+s"(w)); return w * 64 + lane_fresh(); }
#define LDS_WAIT() asm volatile("s_waitcnt lgkmcnt(0)" ::: "memory")
__device__ __forceinline__ float sigmoidf_(float x) { return __builtin_amdgcn_rcpf(1.f + __expf(-x)); }

__device__ __forceinline__ Params load_params() {
#if defined(__HIP_DEVICE_COMPILE__)
    const __attribute__((address_space(4))) Params* pp = (const __attribute__((address_space(4))) Params*)__builtin_amdgcn_kernarg_segment_ptr();
    asm volatile("" : "+s"(pp));
    Params r;
    r.x = pp->x; r.pos = pp->pos; r.ffn1_norm = pp->ffn1_norm; r.ffn1_gu = pp->ffn1_gu; r.ffn1_down = pp->ffn1_down; r.mix_norm = pp->mix_norm; r.w_in = pp->w_in; r.diff_qk_norm = pp->diff_qk_norm;
    r.diff_lambda = pp->diff_lambda; r.diff_head_norm = pp->diff_head_norm; r.ml_conv_w = pp->ml_conv_w; r.ml_conv_b = pp->ml_conv_b; r.ml_gate_bias = pp->ml_gate_bias; r.ml_head_norm = pp->ml_head_norm;
    r.dsa_qk_norm = pp->dsa_qk_norm; r.w_branch = pp->w_branch; r.w_out = pp->w_out; r.ffn2_norm = pp->ffn2_norm; r.ffn2_gu = pp->ffn2_gu; r.ffn2_down = pp->ffn2_down; r.out = pp->out; r.ws = pp->ws;
    return r;
#else
    return Params{};
#endif
}
typedef unsigned long long u64_t;
__device__ __forceinline__ u64_t* rs_ptr(const Params& p, int idx) { return (u64_t*)(p.ws + (idx < 3 ? (WS_CTL + 131072) : (105 * MiB))) + (size_t)(idx % 3) * T; }
__device__ __forceinline__ float row_rstd(const u64_t* rs, int row) { return __builtin_amdgcn_rsqf((float)rs[row] * (1.f / (16777216.f * D)) + EPS); }
struct EpiSwiglu {
    static constexpr bool PERM = true, AFTER_DRAIN = false;
    int rsi;
    __device__ __forceinline__ void operator()(const f32x4 (&acc)[2][2][4][2], const pg8::Unit& u, int wr, int wc, int fr_in, int fq_in) const {
        const int ln_ = lane_fresh(); const int fr = ln_ & 15, fq = ln_ >> 4; (void)fr_in; (void)fq_in;
        const Params p = load_params(); bf16* O = (bf16*)(p.ws + WS_BIG); const u64_t* rs = rs_ptr(p, rsi);
        const int row0 = u.pm * 256 + wr * 64 + fr, col0 = u.pn * 128 + wc * 32 + 8 * fq;
#pragma unroll
        for (int ai = 0; ai < 2; ++ai)
#pragma unroll
            for (int m = 0; m < 4; ++m) {
                const int row = row0 + ai * 128 + m * 16; const float rr = row_rstd(rs, row);
                bf16* rowp = O + (size_t)row * FF + col0;
                float r[8];
#pragma unroll
                for (int n = 0; n < 2; ++n)
#pragma unroll
                    for (int j = 0; j < 4; ++j) { const float g = acc[ai][0][m][n][j] * rr, uu = acc[ai][1][m][n][j] * rr; r[4 * n + j] = g * sigmoidf_(g) * uu; }
                u32x4 w; w.x = pk2(r[0], r[1]); w.y = pk2(r[2], r[3]); w.z = pk2(r[4], r[5]); w.w = pk2(r[6], r[7]);
                *(u32x4*)rowp = w;
            }
    }
};
struct EpiResid {
    static constexpr bool PERM = true, AFTER_DRAIN = false;
    int base_is_x; float scale; int rsi;
    __device__ __forceinline__ void operator()(const f32x4 (&acc)[2][2][4][2], const pg8::Unit& u, int wr, int wc, int fr_in, int fq_in) const {
        const int ln_ = lane_fresh(); const int fr = ln_ & 15, fq = ln_ >> 4; (void)fr_in; (void)fq_in;
        const Params p = load_params(); const float* base = base_is_x ? p.x : p.out; float* out = p.out; bf16* XB = (rsi >= 0) ? (bf16*)(p.ws + WS_HN) : (bf16*)nullptr; u64_t* rs = rs_ptr(p, rsi >= 0 ? rsi : 0);
        const int row0 = u.pm * 256 + wr * 64 + fr, col0 = u.pn * 256 + wc * 32 + 8 * fq;
#pragma unroll
        for (int ai = 0; ai < 2; ++ai)
#pragma unroll
            for (int m = 0; m < 4; ++m) {
                const int row = row0 + ai * 128 + m * 16; const size_t ro = (size_t)row * D + col0; float ss = 0.f;
#pragma unroll
                for (int bj = 0; bj < 2; ++bj) {
                    const f32x4 v0 = *(const f32x4*)(base + ro + bj * 128) + acc[ai][bj][m][0] * scale, v1 = *(const f32x4*)(base + ro + bj * 128 + 4) + acc[ai][bj][m][1] * scale;
                    *(f32x4*)(out + ro + bj * 128) = v0; *(f32x4*)(out + ro + bj * 128 + 4) = v1;
                    if (XB) { u32x4 w; w.x = pk2(v0[0], v0[1]); w.y = pk2(v0[2], v0[3]); w.z = pk2(v1[0], v1[1]); w.w = pk2(v1[2], v1[3]); *(u32x4*)(XB + ro + bj * 128) = w;
                        ss += (v0[0] * v0[0] + v0[1] * v0[1]) + (v0[2] * v0[2] + v0[3] * v0[3]) + (v1[0] * v1[0] + v1[1] * v1[1]) + (v1[2] * v1[2] + v1[3] * v1[3]); }
                }
                if (XB) { ss += __shfl_xor(ss, 16); ss += __shfl_xor(ss, 32); if (fq == 0) atomicAdd(rs + row, (u64_t)(ss * 16777216.f)); }
            }
    }
};
struct EpiZ {
    static constexpr bool PERM = true, AFTER_DRAIN = false;
    int rsi;
    __device__ __forceinline__ void operator()(const f32x4 (&acc)[2][2][4][2], const pg8::Unit& u, int wr, int wc, int fr_in, int fq_in) const {
        const int ln_ = lane_fresh(); const int fr = ln_ & 15, fq = ln_ >> 4; (void)fr_in; (void)fq_in;
        const Params p = load_params(); bf16* Z = (bf16*)(p.ws + WS_BIG); float* ZS = (float*)(p.ws + WS_ZS); const u64_t* rs = rs_ptr(p, rsi);
        const int row0 = u.pm * 256 + wr * 64 + fr, cw = wc * 32 + 8 * fq;
        if (u.pn < 12) {
#pragma unroll
            for (int ai = 0; ai < 2; ++ai)
#pragma unroll
                for (int m = 0; m < 4; ++m) {
                    const int row = row0 + ai * 128 + m * 16; const float rr = row_rstd(rs, row);
                    bf16* rowp = Z + (size_t)row * ZP + u.pn * 256 + cw;
#pragma unroll
                    for (int bj = 0; bj < 2; ++bj) { const f32x4 v0 = acc[ai][bj][m][0] * rr, v1 = acc[ai][bj][m][1] * rr;
                        u32x4 w; w.x = pk2(v0[0], v0[1]); w.y = pk2(v0[2], v0[3]); w.z = pk2(v1[0], v1[1]); w.w = pk2(v1[2], v1[3]);
                        *(u32x4*)(rowp + bj * 128) = w; }
                }
        } else {
#pragma unroll
            for (int ai = 0; ai < 2; ++ai)
#pragma unroll
                for (int m = 0; m < 4; ++m) {
                    const int row = row0 + ai * 128 + m * 16; const float rr = row_rstd(rs, row);
                    float* rowp = ZS + (size_t)row * ZSP + cw;
#pragma unroll
                    for (int bj = 0; bj < 2; ++bj)
#pragma unroll
                        for (int n = 0; n < 2; ++n) *(f32x4*)(rowp + bj * 128 + 4 * n) = acc[ai][bj][m][n] * rr;
                }
        }
    }
};
struct EpiSig {
    static constexpr bool PERM = true, AFTER_DRAIN = false;
    int rsi;
    __device__ __forceinline__ void operator()(const f32x4 (&acc)[2][2][4][2], const pg8::Unit& u, int wr, int wc, int fr_in, int fq_in) const {
        const int ln_ = lane_fresh(); const int fr = ln_ & 15, fq = ln_ >> 4; (void)fr_in; (void)fq_in;
        const Params p = load_params(); bf16* SG = (bf16*)(p.ws + WS_BIG); const u64_t* rs = rs_ptr(p, rsi);
        const int row0 = u.pm * 256 + wr * 64 + fr, col0 = u.pn * 256 + wc * 32 + 8 * fq;
#pragma unroll
        for (int ai = 0; ai < 2; ++ai)
#pragma unroll
            for (int m = 0; m < 4; ++m) {
                const int row = row0 + ai * 128 + m * 16; const float rr = row_rstd(rs, row);
                bf16* rowp = SG + (size_t)row * (2 * D) + col0;
#pragma unroll
                for (int bj = 0; bj < 2; ++bj) { const f32x4 v0 = acc[ai][bj][m][0] * rr, v1 = acc[ai][bj][m][1] * rr;
                    u32x4 w; w.x = pk2(sigmoidf_(v0[0]), sigmoidf_(v0[1])); w.y = pk2(sigmoidf_(v0[2]), sigmoidf_(v0[3]));
                    w.z = pk2(sigmoidf_(v1[0]), sigmoidf_(v1[1])); w.w = pk2(sigmoidf_(v1[2]), sigmoidf_(v1[3]));
                    *(u32x4*)(rowp + bj * 128) = w; }
            }
    }
};
struct EpiGate {
    static constexpr bool PERM = true, AFTER_DRAIN = false;
    int sgoff; int first;
    __device__ __forceinline__ void operator()(const f32x4 (&acc)[2][2][4][2], const pg8::Unit& u, int wr, int wc, int fr_in, int fq_in) const {
        const int ln_ = lane_fresh(); const int fr = ln_ & 15, fq = ln_ >> 4; (void)fr_in; (void)fq_in;
        const Params p = load_params(); const bf16* SG = (const bf16*)(p.ws + WS_BIG); bf16* YB = (bf16*)(p.ws + WS_BIG + 128 * MiB);
        const int row0 = u.pm * 256 + wr * 64 + fr, col0 = u.pn * 256 + wc * 32 + 8 * fq;
#pragma unroll
        for (int ai = 0; ai < 2; ++ai)
#pragma unroll
            for (int m = 0; m < 4; ++m) {
                const int row = row0 + ai * 128 + m * 16; const size_t ro = (size_t)row * D + col0, so = (size_t)row * (2 * D) + sgoff + col0;
#pragma unroll
                for (int bj = 0; bj < 2; ++bj) {
                    const u32x4 sg = *(const u32x4*)(SG + so + bj * 128);
                    f32x4 v0 = (f32x4){bflo(sg.x), bfhi(sg.x), bflo(sg.y), bfhi(sg.y)} * acc[ai][bj][m][0], v1 = (f32x4){bflo(sg.z), bfhi(sg.z), bflo(sg.w), bfhi(sg.w)} * acc[ai][bj][m][1];
                    if (!first) { const u32x4 y = *(const u32x4*)(YB + ro + bj * 128);
                        v0 = v0 + (f32x4){bflo(y.x), bfhi(y.x), bflo(y.y), bfhi(y.y)}; v1 = v1 + (f32x4){bflo(y.z), bfhi(y.z), bflo(y.w), bfhi(y.w)}; }
                    u32x4 w; w.x = pk2(v0[0], v0[1]); w.y = pk2(v0[2], v0[3]); w.z = pk2(v1[0], v1[1]); w.w = pk2(v1[2], v1[3]); *(u32x4*)(YB + ro + bj * 128) = w;
                }
            }
    }
};

template <class Epi>
__device__ __forceinline__ void run_gemm(LAS unsigned char* lds, const bf16* A, const bf16* Bt, int M, int N, int K, const Epi& E, int wv) {
    pg8::Gemm g{A, Bt, M, N, K}; pg8::StaticOrder S; S.init(M, N, (int)gridDim.x, (int)blockIdx.x);
    pg8::gemm_phase<Epi, pg8::StaticOrder, true, true>((PG8_LAS unsigned char*)lds, g, S, E, wv);
}

__device__ __forceinline__ void tr_item(const float* W, int K, int srcN, int c0, int nv, bf16* WT, int r0, int k0, LAS float* scr, int lane, const float* gain) {
    const int c = lane & 31;
#pragma unroll 8
    for (int i = 0; i < 32; ++i) { const int kk = 2 * i + (lane >> 5); scr[kk * 33 + c] = (c < nv) ? W[(size_t)(k0 + kk) * srcN + c0 + c] * (gain ? gain[k0 + kk] : 1.f) : 0.f; }
    LDS_WAIT();
    const int c8 = lane & 7;
#pragma unroll
    for (int j = 0; j < 4; ++j) { const int n = (lane >> 3) + 8 * j; const LAS float* s = scr + (8 * c8) * 33 + n;
        u32x4 o; o.x = pk2(s[0 * 33], s[1 * 33]); o.y = pk2(s[2 * 33], s[3 * 33]); o.z = pk2(s[4 * 33], s[5 * 33]); o.w = pk2(s[6 * 33], s[7 * 33]);
        if (n < nv) *(u32x4*)(WT + (size_t)(r0 + n) * K + k0 + 8 * c8) = o; }
    LDS_WAIT();
}
struct SegRun { int base, gw, ngw, lane; LAS float* scr; };
__device__ __forceinline__ void run_seg(SegRun& R, const float* W, int K, int srcN, int c0, int ncols, bf16* WT, int r0, const float* gain = nullptr) {
    const int nblk = (ncols + 31) >> 5, nitems = (K >> 6) * nblk;
    int first = (R.gw - (R.base % R.ngw) + R.ngw) % R.ngw;
    for (int it = first; it < nitems; it += R.ngw) { const int kb = it / nblk, nb = it - kb * nblk; const int nv = min(32, ncols - nb * 32);
        tr_item(W, K, srcN, c0 + nb * 32, nv, WT, r0 + nb * 32, kb * 64, R.scr, R.lane, gain); }
    R.base += nitems;
}
__device__ __forceinline__ void convert_weights(const Params& p, int l, SegRun& R) {
    unsigned char* wl = p.ws + WS_W + (size_t)l * WL_STRIDE;
    for (int f = 0; f < 2; ++f) {
        const float* gu = (f ? p.ffn2_gu : p.ffn1_gu) + (size_t)l * D * 2 * FF; bf16* gut = (bf16*)(wl + (f ? WL_GU2 : WL_GU1));
        const float* gn = (f ? p.ffn2_norm : p.ffn1_norm) + l * D;
        for (int sg = 0; sg < 44; ++sg) run_seg(R, gu, D, 2 * FF, sg * 128, 128, gut, (sg % 22) * 256 + (sg / 22) * 128, gn);
        const float* dn = (f ? p.ffn2_down : p.ffn1_down) + (size_t)l * FF * D; bf16* dnt = (bf16*)(wl + (f ? WL_D2 : WL_D1));
        run_seg(R, dn, FF, D, 0, D, dnt, 0);
    }
    const float* wi = p.w_in + (size_t)l * D * NIN; bf16* ina = (bf16*)(wl + WL_INA);
    run_seg(R, wi, D, NIN, 0, 256, ina, col_dq(l), p.mix_norm + l * D);
    run_seg(R, wi, D, NIN, 256, 256, ina, col_dk(l), p.mix_norm + l * D);
    run_seg(R, wi, D, NIN, 512, 256, ina, 512, p.mix_norm + l * D);
    run_seg(R, wi, D, NIN, 768, 512, ina, 768, p.mix_norm + l * D);
    run_seg(R, wi, D, NIN, 1280, 256, ina, 1280, p.mix_norm + l * D);
    run_seg(R, wi, D, NIN, 1544, 256, ina, 1536, p.mix_norm + l * D);
    run_seg(R, wi, D, NIN, 1800, 256, ina, 1792, p.mix_norm + l * D);
    run_seg(R, wi, D, NIN, 2056, 256, ina, col_sbk(l), p.mix_norm + l * D);
    run_seg(R, wi, D, NIN, 2312, 256, ina, col_sbk(l) + 256, p.mix_norm + l * D);
    run_seg(R, wi, D, NIN, 2568, 256, ina, 2560, p.mix_norm + l * D);
    run_seg(R, wi, D, NIN, 2952, 256, ina, 2816, p.mix_norm + l * D);
    run_seg(R, wi, D, NIN, 2824, 128, ina, 3072, p.mix_norm + l * D);
    run_seg(R, wi, D, NIN, 3208, 40, ina, 3200, p.mix_norm + l * D);
    run_seg(R, wi, D, NIN, 1536, 8, ina, 3240, p.mix_norm + l * D);
    run_seg(R, wi, D, NIN, 3248, 4096, (bf16*)(wl + WL_G), 0, p.mix_norm + l * D);
    for (int b = 0; b < 4; ++b) run_seg(R, p.w_branch + ((size_t)l * 4 + b) * 256 * D, 256, D, 0, D, (bf16*)(wl + WL_BR) + (size_t)b * D * 256, 0);
    run_seg(R, p.w_out + (size_t)l * D * D, D, D, 0, D, (bf16*)(wl + WL_OUT), 0);
    for (int i = R.gw * 64 + R.lane; i < 80 * 128; i += R.ngw * 64) *((u32x4*)(ina + (size_t)3248 * D) + i) = (u32x4){0u, 0u, 0u, 0u};
}

__device__ __forceinline__ void xb_rows(const float* X, bf16* XB, u64_t* rs, int gw, int ngw, int lane) {
    for (int m = gw; m < T; m += ngw) {
        const f32x4* xr = (const f32x4*)(X + (size_t)m * D) + lane;
        f32x4 v[4]; float s = 0.f;
#pragma unroll
        for (int j = 0; j < 4; ++j) { v[j] = xr[64 * j]; s += (v[j].x * v[j].x + v[j].y * v[j].y) + (v[j].z * v[j].z + v[j].w * v[j].w); }
        s = wave_sum(s);
        unsigned long long* o8 = (unsigned long long*)(XB + (size_t)m * D) + lane;
#pragma unroll
        for (int j = 0; j < 4; ++j) o8[64 * j] = (unsigned long long)pk2(v[j].x, v[j].y) | ((unsigned long long)pk2(v[j].z, v[j].w) << 32);
        if (lane == 0) rs[m] = (u64_t)(s * 16777216.f);
    }
}

__device__ __forceinline__ void sincos_red(float ang, float& sn, float& cs) {
    const float n = rintf(ang * 0.15915494309189535f);
    float r = fmaf(-n, 6.28125f, ang); r = fmaf(-n, 0.0019353071795864769f, r);
    sn = __sinf(r); cs = __cosf(r);
}
template <int HALF>
__device__ __forceinline__ void rope4(float (&v)[4], int sl, float pos) {
    constexpr int LH = HALF / 4;
    float pv[4];
#pragma unroll
    for (int j = 0; j < 4; ++j) pv[j] = __shfl_xor(v[j], LH);
    if (sl < 2 * LH) {
        const bool first = sl < LH; const int i0 = (sl & (LH - 1)) * 4;
#pragma unroll
        for (int j = 0; j < 4; ++j) {
            constexpr float I4[4] = {1.0f, 0.03760603070259094f, 0.0014142135623842478f, 5.318296098266728e-05f};
            constexpr float I8[8] = {1.0f, 0.1939227432012558f, 0.03760603070259094f, 0.007292664609849453f, 0.0014142135623842478f, 0.00027424818836152554f, 5.318296098266728e-05f, 1.0313386155758053e-05f};
            const float inv = (HALF == 4) ? I4[j] : (i0 ? I8[4 + j] : I8[j]);
            float sn, cs; sincos_red(pos * inv, sn, cs);
            v[j] = first ? (v[j] * cs - pv[j] * sn) : (pv[j] * sn + v[j] * cs);
        }
    }
}
__device__ __forceinline__ void prep_phase(const Params& p, int l, int gw, int ngw, int lane) {
    bf16* Z = (bf16*)(p.ws + WS_BIG); float* ZS = (float*)(p.ws + WS_ZS); bf16* IK = (bf16*)(p.ws + WS_IK);
    const float* dg = p.diff_qk_norm + l * 64; const float* sg = p.dsa_qk_norm + l * 128;
    for (int tok = gw; tok < T; tok += ngw) {
        const float pos = (float)p.pos[tok];
#pragma unroll
        for (int which = 0; which < 2; ++which) {
            unsigned long long* ptr = (unsigned long long*)(Z + (size_t)tok * ZP + (which ? col_dk(l) : col_dq(l))) + lane;
            const unsigned long long w = *ptr; float v[4] = {bflo((unsigned)w), bfhi((unsigned)w), bflo((unsigned)(w >> 32)), bfhi((unsigned)(w >> 32))};
            float ss = (v[0] * v[0] + v[1] * v[1]) + (v[2] * v[2] + v[3] * v[3]);
            ss += __shfl_xor(ss, 1); ss += __shfl_xor(ss, 2); ss += __shfl_xor(ss, 4);
            const float r = 1.f / sqrtf(ss * (1.f / 32.f) + EPS);
            const f32x4 g = *(const f32x4*)(dg + which * 32 + (lane & 7) * 4);
#pragma unroll
            for (int j = 0; j < 4; ++j) v[j] = v[j] * r * g[j];
            rope4<4>(v, lane & 7, pos);
            if (which == 0) {
#pragma unroll
                for (int j = 0; j < 4; ++j) v[j] *= 0.17677669529663687f;
            }
            *ptr = (unsigned long long)pk2(v[0], v[1]) | ((unsigned long long)pk2(v[2], v[3]) << 32);
        }
        {
            unsigned long long* ptr = (unsigned long long*)(Z + (size_t)tok * ZP + 2560) + lane;
            const unsigned long long w = *ptr; float v[4] = {bflo((unsigned)w), bfhi((unsigned)w), bflo((unsigned)(w >> 32)), bfhi((unsigned)(w >> 32))};
            float ss = (v[0] * v[0] + v[1] * v[1]) + (v[2] * v[2] + v[3] * v[3]);
            ss += __shfl_xor(ss, 1); ss += __shfl_xor(ss, 2); ss += __shfl_xor(ss, 4); ss += __shfl_xor(ss, 8);
            const float r = 1.f / sqrtf(ss * (1.f / 64.f) + EPS);
            const f32x4 g = *(const f32x4*)(sg + (lane & 15) * 4);
#pragma unroll
            for (int j = 0; j < 4; ++j) v[j] = v[j] * r * g[j];
            rope4<8>(v, lane & 15, pos);
#pragma unroll
            for (int j = 0; j < 4; ++j) v[j] *= 0.125f;
            *ptr = (unsigned long long)pk2(v[0], v[1]) | ((unsigned long long)pk2(v[2], v[3]) << 32);
        }
        {
            unsigned long long* ptr = (unsigned long long*)(Z + (size_t)tok * ZP + 2816) + lane;
            const unsigned long long w = *ptr; float v[4] = {bflo((unsigned)w), bfhi((unsigned)w), bflo((unsigned)(w >> 32)), bfhi((unsigned)(w >> 32))};
            rope4<4>(v, lane & 7, pos);
            *ptr = (unsigned long long)pk2(v[0], v[1]) | ((unsigned long long)pk2(v[2], v[3]) << 32);
        }
        {
            float* ptr = ZS + (size_t)tok * ZSP + (lane & 15) * 4;
            const f32x4 x = *(const f32x4*)ptr; float v[4] = {x[0], x[1], x[2], x[3]};
            float ss = (v[0] * v[0] + v[1] * v[1]) + (v[2] * v[2] + v[3] * v[3]);
            ss += __shfl_xor(ss, 1); ss += __shfl_xor(ss, 2); ss += __shfl_xor(ss, 4); ss += __shfl_xor(ss, 8);
            const float r = 1.f / sqrtf(ss * (1.f / 64.f) + EPS);
            const f32x4 g = *(const f32x4*)(sg + 64 + (lane & 15) * 4);
#pragma unroll
            for (int j = 0; j < 4; ++j) v[j] = v[j] * r * g[j];
            rope4<8>(v, lane & 15, pos);
            if (lane < 16) *(f32x4*)ptr = (f32x4){v[0], v[1], v[2], v[3]};
        }
        {
            const float* ptr = ZS + (size_t)tok * ZSP + 128 + (lane & 7) * 4;
            const f32x4 x = *(const f32x4*)ptr; float v[4] = {x[0], x[1], x[2], x[3]};
            rope4<4>(v, lane & 7, pos);
            if (lane < 8) *((unsigned long long*)(IK + (size_t)tok * 32) + lane) = (unsigned long long)pk2(v[0], v[1]) | ((unsigned long long)pk2(v[2], v[3]) << 32);
        }
    }
}
__device__ __forceinline__ void mlstm_item(const Params& p, int l, int bh, LAS unsigned char* lds, int wv) {
    const int tid = tid_fresh(wv), lane = tid & 63, b = bh >> 2, h = bh & 3;
    const bf16* Z = (const bf16*)(p.ws + WS_BIG); const float* ZS = (const float*)(p.ws + WS_ZS); bf16* O1 = (bf16*)(p.ws + WS_O + OB_STRIDE);
    LAS float* nv = (LAS float*)lds; LAS float* bc = nv + 64; LAS float* igs = bc + 64; LAS float* wks = igs + 64; LAS float* sc = wks + 64;
    LAS float* Qs = sc + 64; LAS float* Ks = Qs + 64 * 65; LAS float* Vs = Ks + 64 * 65; LAS float* Ss = Vs + 64 * 65; LAS float* Cs = Ss + 64 * 65;
    for (int i = tid; i < 64 * 65; i += NTHR) Cs[i] = 0.f;
    if (tid < 64) nv[tid] = 0.f;
    float mcar = 0.f;
    const int r = tid >> 3, sg = tid & 7;
    const int cc0 = sg * 16; const int ch0 = (cc0 < 64) ? (h * 64 + cc0) : (256 + h * 64 + cc0 - 64);
    const float* cw0 = p.ml_conv_w + (size_t)l * 4 * 512; const float* cb0 = p.ml_conv_b + (size_t)l * 512;
    const int zc0 = (cc0 < 64) ? (768 + h * 64 + cc0) : (1024 + h * 64 + cc0 - 64);
    const float gb_i = p.ml_gate_bias[(l * 2 + 0) * 4 + h], gb_f = p.ml_gate_bias[(l * 2 + 1) * 4 + h];
    const float qsc = (cc0 < 64) ? 0.125f : 1.0f;
    __syncthreads();
    for (int c = 0; c < 64; ++c) {
        const int t0 = c * 64; const size_t tok0 = (size_t)b * SEQ + t0;
        const float* cw = cw0; const float* cb = cb0; asm volatile("" : "+s"(cw), "+s"(cb));
        {
            float y[16];
#pragma unroll
            for (int i = 0; i < 16; ++i) y[i] = cb[ch0 + i];
#pragma unroll
            for (int j = 0; j < 4; ++j) {
                const int tt = t0 + r - 3 + j;
                if (tt >= 0) {
                    const u32x4* xp = (const u32x4*)(Z + ((size_t)b * SEQ + tt) * ZP + zc0); const u32x4 x0 = xp[0], x1 = xp[1];
                    const float xv[16] = {bflo(x0.x), bfhi(x0.x), bflo(x0.y), bfhi(x0.y), bflo(x0.z), bfhi(x0.z), bflo(x0.w), bfhi(x0.w),
                                          bflo(x1.x), bfhi(x1.x), bflo(x1.y), bfhi(x1.y), bflo(x1.z), bfhi(x1.z), bflo(x1.w), bfhi(x1.w)};
#pragma unroll
                    for (int i = 0; i < 16; ++i) y[i] = fmaf(cw[j * 512 + ch0 + i], xv[i], y[i]);
                }
            }
            LAS float* dst = (cc0 < 64) ? (Qs + r * 65 + cc0) : (Ks + r * 65 + cc0 - 64);
#pragma unroll
            for (int i = 0; i < 16; ++i) dst[i] = y[i] * sigmoidf_(y[i]) * qsc;
            const u32x4 vv = *(const u32x4*)(Z + (tok0 + r) * ZP + 1280 + h * 64 + sg * 8);
            LAS float* vd = Vs + r * 65 + sg * 8;
            vd[0] = bflo(vv.x); vd[1] = bfhi(vv.x); vd[2] = bflo(vv.y); vd[3] = bfhi(vv.y); vd[4] = bflo(vv.z); vd[5] = bfhi(vv.z); vd[6] = bflo(vv.w); vd[7] = bfhi(vv.w);
        }
        if (tid < 64) {
            const float ig = ZS[(tok0 + tid) * ZSP + 168 + h] + gb_i;
            const float fz = ZS[(tok0 + tid) * ZSP + 172 + h] + gb_f;
            const float lf = fminf(fz, 0.f) - log1pf(__expf(-fabsf(fz)));
            float bsum = lf;
#pragma unroll
            for (int d = 1; d < 64; d <<= 1) { const float n = __shfl_up(bsum, d); if (lane >= d) bsum += n; }
            const float bl = __shfl(bsum, 63);
            const float g = bl - bsum + ig;
            const float mnew = fmaxf(bl + mcar, wave_max(g));
            bc[tid] = bsum; igs[tid] = ig; wks[tid] = __expf(g - mnew);
            if (tid == 0) { sc[0] = mnew; sc[1] = __expf(bl + mcar - mnew); sc[2] = bl; }
        }
        __syncthreads();
        const float bt = bc[r];
        float mx = -INFINITY;
#pragma unroll
        for (int i = 0; i < 8; ++i) { const int s = sg * 8 + i; const float dli = (s <= r) ? (bt - bc[s] + igs[s]) : -INFINITY; mx = fmaxf(mx, dli); }
        mx = fmaxf(mx, __shfl_xor(mx, 1)); mx = fmaxf(mx, __shfl_xor(mx, 2)); mx = fmaxf(mx, __shfl_xor(mx, 4));
        const float inter = bt + mcar; const float mt = fmaxf(inter, mx); const float iw = __expf(inter - mt);
        float ssum = 0.f;
#pragma unroll 1
        for (int i = 0; i < 8; ++i) { const int s = sg * 8 + i; float dot = 0.f;
#pragma unroll 16
            for (int d = 0; d < 64; ++d) dot = fmaf(Qs[r * 65 + d], Ks[s * 65 + d], dot);
            const float dli = (s <= r) ? (bt - bc[s] + igs[s]) : -INFINITY;
            const float sv = dot * __expf(dli - mt); Ss[r * 65 + s] = sv; ssum += sv; }
        ssum += __shfl_xor(ssum, 1); ssum += __shfl_xor(ssum, 2); ssum += __shfl_xor(ssum, 4);
        float qn = 0.f;
#pragma unroll
        for (int d = 0; d < 64; ++d) qn = fmaf(Qs[r * 65 + d], nv[d], qn);
        const float den = iw * qn + ssum;
        __syncthreads();
        {
            float num[8];
#pragma unroll
            for (int i = 0; i < 8; ++i) num[i] = 0.f;
#pragma unroll 8
            for (int d = 0; d < 64; ++d) { const float qd = Qs[r * 65 + d];
#pragma unroll
                for (int i = 0; i < 8; ++i) num[i] = fmaf(qd, Cs[d * 65 + sg * 8 + i], num[i]); }
#pragma unroll
            for (int i = 0; i < 8; ++i) num[i] *= iw;
#pragma unroll 8
            for (int s = 0; s < 64; ++s) { const float sv = Ss[r * 65 + s];
#pragma unroll
                for (int i = 0; i < 8; ++i) num[i] = fmaf(sv, Vs[s * 65 + sg * 8 + i], num[i]); }
            const float dn = 1.f / fmaxf(fabsf(den), __expf(-mt));
            float hs = 0.f;
#pragma unroll
            for (int i = 0; i < 8; ++i) { num[i] *= dn; hs = fmaf(num[i], num[i], hs); }
            hs += __shfl_xor(hs, 1); hs += __shfl_xor(hs, 2); hs += __shfl_xor(hs, 4);
            const float rr = 1.f / sqrtf(hs * (1.f / 64.f) + EPS);
            const u32x4 og = *(const u32x4*)(Z + (tok0 + r) * ZP + 1536 + h * 64 + sg * 8);
            const float ogv[8] = {bflo(og.x), bfhi(og.x), bflo(og.y), bfhi(og.y), bflo(og.z), bfhi(og.z), bflo(og.w), bfhi(og.w)};
            const float* hg = p.ml_head_norm + l * 64 + sg * 8;
            float o[8];
#pragma unroll
            for (int i = 0; i < 8; ++i) o[i] = sigmoidf_(ogv[i]) * (num[i] * rr * hg[i]);
            u32x4 w; w.x = pk2(o[0], o[1]); w.y = pk2(o[2], o[3]); w.z = pk2(o[4], o[5]); w.w = pk2(o[6], o[7]);
            *(u32x4*)(O1 + (tok0 + r) * 256 + h * 64 + sg * 8) = w;
        }
        __syncthreads();
        {
            const float decay = sc[1];
            float cacc[8]; float nacc = 0.f;
#pragma unroll
            for (int i = 0; i < 8; ++i) cacc[i] = 0.f;
#pragma unroll 8
            for (int s = 0; s < 64; ++s) { const float kw = wks[s] * Ks[s * 65 + r]; nacc += kw;
#pragma unroll
                for (int i = 0; i < 8; ++i) cacc[i] = fmaf(kw, Vs[s * 65 + sg * 8 + i], cacc[i]); }
#pragma unroll
            for (int i = 0; i < 8; ++i) Cs[r * 65 + sg * 8 + i] = decay * Cs[r * 65 + sg * 8 + i] + cacc[i];
            if (sg == 0) nv[r] = decay * nv[r] + nacc;
            mcar = sc[0];
        }
        __syncthreads();
    }
}

__device__ __forceinline__ void diff_item(const Params& p, int l, int bh, int qt, LAS unsigned char* lds, int wv) {
    const int tid = tid_fresh(wv), b = bh >> 2, h = bh & 3, q0 = qt * 128;
    const bf16* Z = (const bf16*)(p.ws + WS_BIG); bf16* O0 = (bf16*)(p.ws + WS_O);
    LAS float* Kt = (LAS float*)lds; LAS float* Vt = Kt + 64 * 64;
    const int ql = tid >> 2, part = tid & 3, c = part & 1, dvh = part >> 1, t = q0 + ql; const size_t tok = (size_t)b * SEQ + t;
    const float* lp = p.diff_lambda + l * 128; float s01 = 0.f, s23 = 0.f, gqm = 0.f, gkm = 0.f;
#pragma unroll 2
    for (int i = 0; i < 32; ++i) { s01 = fmaf(lp[i], lp[32 + i], s01); s23 = fmaf(lp[64 + i], lp[96 + i], s23);
        gqm = fmaxf(gqm, fabsf(p.diff_qk_norm[l * 64 + i])); gkm = fmaxf(gkm, fabsf(p.diff_qk_norm[l * 64 + 32 + i])); }
    const float lam_init = 0.8f - 0.6f * __expf(-0.3f * (float)l); const float lam = __expf(s01) - __expf(s23) + lam_init;
    const float coff = 5.65685424949238f * gqm * gkm;
    float q[32], o[32];
    { const u32x4* qp = (const u32x4*)(Z + tok * ZP + h * 64 + c * 32);
#pragma unroll
      for (int i = 0; i < 4; ++i) { const u32x4 w = qp[i]; q[8 * i] = bflo(w.x); q[8 * i + 1] = bfhi(w.x); q[8 * i + 2] = bflo(w.y); q[8 * i + 3] = bfhi(w.y); q[8 * i + 4] = bflo(w.z); q[8 * i + 5] = bfhi(w.z); q[8 * i + 6] = bflo(w.w); q[8 * i + 7] = bfhi(w.w); } }
#pragma unroll
    for (int i = 0; i < 32; ++i) o[i] = 0.f;
    float lsum = 0.f;
    const int nkt = (q0 + 128) / 64;
    const int lk = tid >> 3, lsg = tid & 7;
    for (int kt = 0; kt < nkt; ++kt) {
        __syncthreads();
        { const size_t ktok = (size_t)b * SEQ + kt * 64 + lk;
          const bf16* src = Z + ktok * ZP + ((lsg < 4) ? (256 + h * 64 + lsg * 16) : (512 + h * 64 + (lsg - 4) * 16));
          const u32x4 x0 = ((const u32x4*)src)[0], x1 = ((const u32x4*)src)[1];
          LAS float* dst = ((lsg < 4) ? (Kt + lk * 64 + lsg * 16) : (Vt + lk * 64 + (lsg - 4) * 16));
          *(LAS f32x4*)(dst) = (f32x4){bflo(x0.x), bfhi(x0.x), bflo(x0.y), bfhi(x0.y)}; *(LAS f32x4*)(dst + 4) = (f32x4){bflo(x0.z), bfhi(x0.z), bflo(x0.w), bfhi(x0.w)};
          *(LAS f32x4*)(dst + 8) = (f32x4){bflo(x1.x), bfhi(x1.x), bflo(x1.y), bfhi(x1.y)}; *(LAS f32x4*)(dst + 12) = (f32x4){bflo(x1.z), bfhi(x1.z), bflo(x1.w), bfhi(x1.w)}; }
        __syncthreads();
        const int kmax = t - kt * 64 + 1;
        for (int key = 0; key < 64; ++key) {
            const LAS f32x4* kr = (const LAS f32x4*)(Kt + key * 64 + c * 32);
            float s = 0.f;
#pragma unroll
            for (int i = 0; i < 8; ++i) { const f32x4 kv = kr[i]; s = fmaf(q[4 * i], kv[0], s); s = fmaf(q[4 * i + 1], kv[1], s); s = fmaf(q[4 * i + 2], kv[2], s); s = fmaf(q[4 * i + 3], kv[3], s); }
            const float pe = (key < kmax) ? __expf(s - coff) : 0.f;
            lsum += pe;
            const LAS f32x4* vr = (const LAS f32x4*)(Vt + key * 64 + dvh * 32);
#pragma unroll
            for (int i = 0; i < 8; ++i) { const f32x4 vv = vr[i]; o[4 * i] = fmaf(pe, vv[0], o[4 * i]); o[4 * i + 1] = fmaf(pe, vv[1], o[4 * i + 1]); o[4 * i + 2] = fmaf(pe, vv[2], o[4 * i + 2]); o[4 * i + 3] = fmaf(pe, vv[3], o[4 * i + 3]); }
        }
    }
    const float inv = 1.f / lsum; float ss = 0.f;
#pragma unroll
    for (int i = 0; i < 32; ++i) { const float my = o[i] * inv; const float ot = __shfl_xor(my, 1); o[i] = (c == 0) ? (my - lam * ot) : (ot - lam * my); ss = fmaf(o[i], o[i], ss); }
    ss += __shfl_xor(ss, 2);
    const float rr = (1.f - lam_init) / sqrtf(ss * (1.f / 64.f) + EPS);
    if (c == 0) {
        const float* hg = p.diff_head_norm + l * 64 + dvh * 32; u32x4* dst = (u32x4*)(O0 + tok * 256 + h * 64 + dvh * 32);
#pragma unroll
        for (int i = 0; i < 4; ++i) { u32x4 w; w.x = pk2(o[8 * i] * rr * hg[8 * i], o[8 * i + 1] * rr * hg[8 * i + 1]); w.y = pk2(o[8 * i + 2] * rr * hg[8 * i + 2], o[8 * i + 3] * rr * hg[8 * i + 3]);
            w.z = pk2(o[8 * i + 4] * rr * hg[8 * i + 4], o[8 * i + 5] * rr * hg[8 * i + 5]); w.w = pk2(o[8 * i + 6] * rr * hg[8 * i + 6], o[8 * i + 7] * rr * hg[8 * i + 7]); dst[i] = w; }
    }
    __syncthreads();
}

__device__ __forceinline__ unsigned pkbf(float lo, float hi) { return pk2(lo, hi); }
__device__ __forceinline__ void diffm_item(const Params& p, int l, int bh, int qb, LAS unsigned char* lds, int wv) {
    const int tid = tid_fresh(wv), lane = tid & 63, half = lane >> 5, r32 = lane & 31, b = bh >> 2, h = bh & 3;
    const bf16* Z = (const bf16*)(p.ws + WS_BIG); bf16* O0 = (bf16*)(p.ws + WS_O);
    LAS bf16* Ks = (LAS bf16*)lds; LAS bf16* Vt = Ks + 64 * 72;
    const float* lp = p.diff_lambda + l * 128; float s01 = 0.f, s23 = 0.f, gqm = 0.f, gkm = 0.f;
#pragma unroll 2
    for (int i = 0; i < 32; ++i) { s01 = fmaf(lp[i], lp[32 + i], s01); s23 = fmaf(lp[64 + i], lp[96 + i], s23);
        gqm = fmaxf(gqm, fabsf(p.diff_qk_norm[l * 64 + i])); gkm = fmaxf(gkm, fabsf(p.diff_qk_norm[l * 64 + 32 + i])); }
    const float lam_init = 0.8f - 0.6f * __expf(-0.3f * (float)l); const float lam = __expf(s01) - __expf(s23) + lam_init;
    const float coff = 5.65685424949238f * gqm * gkm;
    const int qw = qb * 256 + 32 * wv;
    const size_t tokb = (size_t)b * SEQ;
    s16x8 qf[2][2];
    { const bf16* qp = Z + (tokb + qw + r32) * ZP + col_dq(l) + h * 64 + half * 8;
#pragma unroll
      for (int c = 0; c < 2; ++c)
#pragma unroll
          for (int s = 0; s < 2; ++s) qf[c][s] = *(const s16x8*)(qp + c * 32 + 16 * s); }
    f32x16 oacc[2][2];
#pragma unroll
    for (int c = 0; c < 2; ++c)
#pragma unroll
        for (int db = 0; db < 2; ++db)
#pragma unroll
            for (int r = 0; r < 16; ++r) oacc[c][db][r] = 0.f;
    float ls0 = 0.f, ls1 = 0.f;
    const int nt = (qb + 1) * 4;
    const int kkey = tid >> 3, kch = tid & 7, vkey = tid & 63, vdc = tid >> 6;
    const bf16* kgp = Z + (tokb + kkey) * ZP + col_dk(l) + h * 64 + kch * 8;
    const bf16* vgp = Z + (tokb + vkey) * ZP + 512 + h * 64 + vdc * 8;
    u32x4 kreg = *(const u32x4*)kgp, vreg = *(const u32x4*)vgp;
#pragma unroll 1
    for (int t = 0; t < nt; ++t) {
        __syncthreads();
        *(LAS u32x4*)(Ks + kkey * 72 + kch * 8) = kreg;
        { LAS bf16* vd = Vt + (vdc * 8) * 72 + vkey;
          vd[0] = (bf16)(vreg.x & 0xffffu); vd[72] = (bf16)(vreg.x >> 16); vd[144] = (bf16)(vreg.y & 0xffffu); vd[216] = (bf16)(vreg.y >> 16);
          vd[288] = (bf16)(vreg.z & 0xffffu); vd[360] = (bf16)(vreg.z >> 16); vd[432] = (bf16)(vreg.w & 0xffffu); vd[504] = (bf16)(vreg.w >> 16); }
        __syncthreads();
        if (t + 1 < nt) { kreg = *(const u32x4*)(kgp + (size_t)(t + 1) * 64 * ZP); vreg = *(const u32x4*)(vgp + (size_t)(t + 1) * 64 * ZP); }
        const int k0 = t * 64;
#pragma unroll
        for (int sub = 0; sub < 2; ++sub) {
            const int kb = k0 + 32 * sub;
            if (kb <= qw + 31) {
                f32x16 s0, s1;
#pragma unroll
                for (int r = 0; r < 16; ++r) { s0[r] = 0.f; s1[r] = 0.f; }
                const LAS bf16* kr = Ks + (32 * sub + r32) * 72 + 8 * half;
#pragma unroll
                for (int s = 0; s < 2; ++s) {
                    const s16x8 a0 = *(const LAS s16x8*)(kr + 16 * s), a1 = *(const LAS s16x8*)(kr + 32 + 16 * s);
                    s0 = __builtin_amdgcn_mfma_f32_32x32x16_bf16(a0, qf[0][s], s0, 0, 0, 0);
                    s1 = __builtin_amdgcn_mfma_f32_32x32x16_bf16(a1, qf[1][s], s1, 0, 0, 0);
                }
                const bool diag = (kb + 31 > qw);
#pragma unroll
                for (int r = 0; r < 16; ++r) {
                    float p0 = __expf(s0[r] - coff), p1 = __expf(s1[r] - coff);
                    if (diag) { const int key = kb + 8 * (r >> 2) + 4 * half + (r & 3); if (key > qw + r32) { p0 = 0.f; p1 = 0.f; } }
                    ls0 += p0; ls1 += p1; s0[r] = p0; s1[r] = p1;
                }
#pragma unroll
                for (int s = 0; s < 2; ++s) {
                    u32x4 w0, w1;
                    w0.x = pkbf(s0[8 * s], s0[8 * s + 1]); w0.y = pkbf(s0[8 * s + 2], s0[8 * s + 3]); w0.z = pkbf(s0[8 * s + 4], s0[8 * s + 5]); w0.w = pkbf(s0[8 * s + 6], s0[8 * s + 7]);
                    w1.x = pkbf(s1[8 * s], s1[8 * s + 1]); w1.y = pkbf(s1[8 * s + 2], s1[8 * s + 3]); w1.z = pkbf(s1[8 * s + 4], s1[8 * s + 5]); w1.w = pkbf(s1[8 * s + 6], s1[8 * s + 7]);
                    const s16x8 pf0 = __builtin_bit_cast(s16x8, w0), pf1 = __builtin_bit_cast(s16x8, w1);
#pragma unroll
                    for (int db = 0; db < 2; ++db) {
                        const LAS bf16* vr = Vt + (db * 32 + r32) * 72 + 32 * sub + 16 * s + 4 * half;
                        const u32x2 v0 = *(const LAS u32x2*)vr, v1 = *(const LAS u32x2*)(vr + 8);
                        const u32x4 vv = (u32x4){v0.x, v0.y, v1.x, v1.y};
                        const s16x8 vf = __builtin_bit_cast(s16x8, vv);
                        oacc[0][db] = __builtin_amdgcn_mfma_f32_32x32x16_bf16(vf, pf0, oacc[0][db], 0, 0, 0);
                        oacc[1][db] = __builtin_amdgcn_mfma_f32_32x32x16_bf16(vf, pf1, oacc[1][db], 0, 0, 0);
                    }
                }
            }
        }
    }
    ls0 += __shfl_xor(ls0, 32); ls1 += __shfl_xor(ls1, 32);
    const float i0 = 1.f / ls0, i1 = lam / ls1;
    float ss = 0.f;
#pragma unroll
    for (int db = 0; db < 2; ++db)
#pragma unroll
        for (int r = 0; r < 16; ++r) { const float v = oacc[0][db][r] * i0 - oacc[1][db][r] * i1; oacc[0][db][r] = v; ss = fmaf(v, v, ss); }
    ss += __shfl_xor(ss, 32);
    const float rr = (1.f - lam_init) / sqrtf(ss * (1.f / 64.f) + EPS);
    const float* hg = p.diff_head_norm + l * 64;
    bf16* orow = O0 + (tokb + qw + r32) * 256 + h * 64;
#pragma unroll
    for (int db = 0; db < 2; ++db)
#pragma unroll
        for (int g = 0; g < 4; ++g) { const int d0 = db * 32 + 8 * g + 4 * half; const f32x4 gg = *(const f32x4*)(hg + d0);
            u32x2 w; w.x = pkbf(oacc[0][db][4 * g] * rr * gg[0], oacc[0][db][4 * g + 1] * rr * gg[1]); w.y = pkbf(oacc[0][db][4 * g + 2] * rr * gg[2], oacc[0][db][4 * g + 3] * rr * gg[3]);
            *(u32x2*)(orow + d0) = w; }
    __syncthreads();
}

typedef unsigned u32x16 __attribute__((ext_vector_type(16)));
__device__ __forceinline__ void sb_item(const Params& p, int l, int bh, int g, LAS unsigned char* lds, int wv) {
    const int tid = tid_fresh(wv), lane = tid & 63, w = wv, b = bh >> 2, h = bh & 3; (void)lds;
    const bf16* Z = (const bf16*)(p.ws + WS_BIG); bf16* O2 = (bf16*)(p.ws + WS_O + 2 * OB_STRIDE);
    const int t0 = g * 512 + w * 64, t = t0 + lane; const size_t tok = (size_t)b * SEQ + t;
    float q[64], o[64];
    { const u32x4* qp = (const u32x4*)(Z + tok * ZP + 1792 + h * 64);
#pragma unroll
      for (int i = 0; i < 8; ++i) { const u32x4 x = qp[i]; q[8 * i] = bflo(x.x); q[8 * i + 1] = bfhi(x.x); q[8 * i + 2] = bflo(x.y); q[8 * i + 3] = bfhi(x.y); q[8 * i + 4] = bflo(x.z); q[8 * i + 5] = bfhi(x.z); q[8 * i + 6] = bflo(x.w); q[8 * i + 7] = bfhi(x.w); } }
#pragma unroll
    for (int i = 0; i < 64; ++i) o[i] = 0.f;
    float R = 0.f;
    const bf16* kbase = Z + (size_t)b * SEQ * ZP + col_sbk(l) + h * 64;
#pragma unroll 1
    for (int s = t0 + 62; s >= 0; --s) {
        const bf16* kp = kbase + (size_t)s * ZP;
        u32x16 k0, k1, v0, v1;
        asm volatile("s_load_dwordx16 %0, %4, 0x0\n\ts_load_dwordx16 %1, %4, 0x40\n\ts_load_dwordx16 %2, %4, 0x200\n\ts_load_dwordx16 %3, %4, 0x240\n\ts_waitcnt lgkmcnt(0)"
                     : "=s"(k0), "=s"(k1), "=s"(v0), "=s"(v1) : "s"(kp) : "memory");
        const bool act = s < t;
        float z = 0.f;
#pragma unroll
        for (int i = 0; i < 16; ++i) { z = fmaf(q[2 * i], bflo(k0[i]), z); z = fmaf(q[2 * i + 1], bfhi(k0[i]), z); }
#pragma unroll
        for (int i = 0; i < 16; ++i) { z = fmaf(q[32 + 2 * i], bflo(k1[i]), z); z = fmaf(q[33 + 2 * i], bfhi(k1[i]), z); }
        z *= 0.125f;
        const float lb = fminf(z, 0.f) - __logf(1.f + __expf(-fabsf(z)));
        const float a = act ? __expf(lb + R) : 0.f;
        R += act ? (lb - z) : 0.f;
#pragma unroll
        for (int i = 0; i < 16; ++i) { o[2 * i] = fmaf(a, bflo(v0[i]), o[2 * i]); o[2 * i + 1] = fmaf(a, bfhi(v0[i]), o[2 * i + 1]); }
#pragma unroll
        for (int i = 0; i < 16; ++i) { o[32 + 2 * i] = fmaf(a, bflo(v1[i]), o[32 + 2 * i]); o[33 + 2 * i] = fmaf(a, bfhi(v1[i]), o[33 + 2 * i]); }
        if ((s & 31) == 0) { if (__all(R < -104.f)) break; }
    }
    u32x4* dst = (u32x4*)(O2 + tok * 256 + h * 64);
#pragma unroll
    for (int i = 0; i < 8; ++i) { u32x4 x; x.x = pk2(o[8 * i], o[8 * i + 1]); x.y = pk2(o[8 * i + 2], o[8 * i + 3]); x.z = pk2(o[8 * i + 4], o[8 * i + 5]); x.w = pk2(o[8 * i + 6], o[8 * i + 7]); dst[i] = x; }
}
constexpr size_t WS_MLS = 460 * MiB, WS_DEC = WS_MLS + 5 * 32 * 4096 * 4, WS_UN = 463 * MiB, WS_NV = WS_UN + 512 * 1024, WS_UT = 464 * MiB, WS_CT = 496 * MiB, WS_END2 = 512 * MiB;
constexpr int MLN = 32 * 4096;
__device__ __forceinline__ void ml_prepass(const Params& p, int l, int bh, int lane) {
    const int b = bh >> 2, h = bh & 3; const float* ZS = (const float*)(p.ws + WS_ZS);
    float* MLS = (float*)(p.ws + WS_MLS); float* DEC = (float*)(p.ws + WS_DEC);
    const float gb_i = p.ml_gate_bias[(l * 2 + 0) * 4 + h], gb_f = p.ml_gate_bias[(l * 2 + 1) * 4 + h];
    float cA = 0.f, cB = 0.f;
#pragma unroll 1
    for (int c4 = 0; c4 < 8; ++c4) {
        float igv[8], fzv[8];
#pragma unroll
        for (int k = 0; k < 8; ++k) { const size_t tok = (size_t)b * SEQ + (c4 * 8 + k) * 64 + lane; igv[k] = ZS[tok * ZSP + 168 + h]; fzv[k] = ZS[tok * ZSP + 172 + h]; }
#pragma unroll
        for (int k = 0; k < 8; ++k) {
            const int c = c4 * 8 + k;
            const float ig = igv[k] + gb_i, fz = fzv[k] + gb_f;
            const float lf = fminf(fz, 0.f) - __logf(1.f + __expf(-fabsf(fz)));
            float bsum = lf;
#pragma unroll
            for (int d = 1; d < 64; d <<= 1) { const float n = __shfl_up(bsum, d); if (lane >= d) bsum += n; }
            const float bl = __shfl(bsum, 63);
            const float a = ig - bsum;
            float pm = a;
#pragma unroll
            for (int d = 1; d < 64; d <<= 1) { const float n = __shfl_up(pm, d); if (lane >= d) pm = fmaxf(pm, n); }
            const float gmax = bl + __shfl(pm, 63);
            const int ti = bh * 4096 + c * 64 + lane;
            MLS[ti] = bsum; MLS[MLN + ti] = a; MLS[2 * MLN + ti] = pm;
            cA = (lane == c) ? bl : cA; cB = (lane == c) ? gmax : cB;
        }
    }
    float sA = cA, sB = cB;
#pragma unroll
    for (int d = 1; d < 64; d <<= 1) { const float pA = __shfl_up(sA, d), pB = __shfl_up(sB, d); if (lane >= d) { sB = fmaxf(pB + sA, sB); sA = pA + sA; } }
    const float m_out = fmaxf(sA, sB);
    float m_in = __shfl_up(m_out, 1); if (lane == 0) m_in = 0.f;
    DEC[bh * 64 + lane] = __expf(cA + m_in - m_out);
    asm volatile("s_waitcnt vmcnt(0)" ::: "memory");
#pragma unroll 1
    for (int c4 = 0; c4 < 8; ++c4) {
        float bsv[8], av[8], pmv[8];
#pragma unroll
        for (int k = 0; k < 8; ++k) { const int ti = bh * 4096 + (c4 * 8 + k) * 64 + lane; bsv[k] = MLS[ti]; av[k] = MLS[MLN + ti]; pmv[k] = MLS[2 * MLN + ti]; }
#pragma unroll
        for (int k = 0; k < 8; ++k) {
            const int c = c4 * 8 + k;
            const float mi = __shfl(m_in, c), mo = __shfl(m_out, c), bl = __shfl(cA, c);
            const int ti = bh * 4096 + c * 64 + lane;
            const float mt = bsv[k] + fmaxf(mi, pmv[k]);
            MLS[2 * MLN + ti] = mt; MLS[3 * MLN + ti] = __expf(bl + av[k] - mo); MLS[4 * MLN + ti] = __expf(bsv[k] + mi - mt);
        }
    }
}
__device__ __forceinline__ void ml_conv8(const bf16* Z, const float* cw, const float* cb, int b, int t, int ch0, float (&y)[8]) {
    const f32x4 b0 = *(const f32x4*)(cb + ch0), b1 = *(const f32x4*)(cb + ch0 + 4);
    y[0] = b0[0]; y[1] = b0[1]; y[2] = b0[2]; y[3] = b0[3]; y[4] = b1[0]; y[5] = b1[1]; y[6] = b1[2]; y[7] = b1[3];
#pragma unroll
    for (int j = 0; j < 4; ++j) {
        const int tt = t - 3 + j;
        if (tt >= 0) {
            const u32x4 x = *(const u32x4*)(Z + ((size_t)b * SEQ + tt) * ZP + 768 + ch0);
            const f32x4 w0 = *(const f32x4*)(cw + j * 512 + ch0), w1 = *(const f32x4*)(cw + j * 512 + ch0 + 4);
            y[0] = fmaf(w0[0], bflo(x.x), y[0]); y[1] = fmaf(w0[1], bfhi(x.x), y[1]); y[2] = fmaf(w0[2], bflo(x.y), y[2]); y[3] = fmaf(w0[3], bfhi(x.y), y[3]);
            y[4] = fmaf(w1[0], bflo(x.z), y[4]); y[5] = fmaf(w1[1], bfhi(x.z), y[5]); y[6] = fmaf(w1[2], bflo(x.w), y[6]); y[7] = fmaf(w1[3], bfhi(x.w), y[7]);
        }
    }
#pragma unroll
    for (int i = 0; i < 8; ++i) y[i] = y[i] * sigmoidf_(y[i]);
}
__device__ __forceinline__ void mlB_item(const Params& p, int l, int bh, int ci, LAS unsigned char* lds, int wv) {
    const int tid = tid_fresh(wv), lane = tid & 63, half = lane >> 5, r32 = lane & 31, b = bh >> 2, h = bh & 3;
    const bf16* Z = (const bf16*)(p.ws + WS_BIG); const float* MLS = (const float*)(p.ws + WS_MLS);
    float* UT = (float*)(p.ws + WS_UT); float* UN = (float*)(p.ws + WS_UN);
    LAS bf16* KT = (LAS bf16*)lds; LAS bf16* VT = KT + 4 * 64 * 72;
    const float* cw = p.ml_conv_w + (size_t)l * 4 * 512; const float* cb = p.ml_conv_b + (size_t)l * 512;
    __syncthreads();
    {
        const int tt = tid >> 1, hr = tid & 1, cl = tt >> 6, s = tt & 63, t = (ci * 4) * 64 + tt;
        const float wk = MLS[3 * MLN + bh * 4096 + t];
#pragma unroll 1
        for (int q8 = 0; q8 < 4; ++q8) {
            const int d0 = hr * 32 + q8 * 8; float y[8];
            ml_conv8(Z, cw, cb, b, t, 256 + h * 64 + d0, y);
            LAS bf16* dst = KT + (cl * 64 + d0) * 72 + s;
#pragma unroll
            for (int i = 0; i < 8; ++i) dst[i * 72] = (bf16)f2bf(y[i] * wk);
            const u32x4 v = *(const u32x4*)(Z + ((size_t)b * SEQ + t) * ZP + 1280 + h * 64 + d0);
            LAS bf16* vd = VT + (cl * 64 + d0) * 72 + s;
            vd[0] = (bf16)(v.x & 0xffffu); vd[72] = (bf16)(v.x >> 16); vd[144] = (bf16)(v.y & 0xffffu); vd[216] = (bf16)(v.y >> 16);
            vd[288] = (bf16)(v.z & 0xffffu); vd[360] = (bf16)(v.z >> 16); vd[432] = (bf16)(v.w & 0xffffu); vd[504] = (bf16)(v.w >> 16);
        }
    }
    __syncthreads();
    const int cl = wv >> 1, dh = wv & 1, c = ci * 4 + cl;
    f32x16 acc[2];
#pragma unroll
    for (int eb = 0; eb < 2; ++eb)
#pragma unroll
        for (int r = 0; r < 16; ++r) acc[eb][r] = 0.f;
#pragma unroll
    for (int s4 = 0; s4 < 4; ++s4) {
        const s16x8 bk = *(const LAS s16x8*)(KT + (cl * 64 + dh * 32 + r32) * 72 + 16 * s4 + 8 * half);
#pragma unroll
        for (int eb = 0; eb < 2; ++eb) {
            const s16x8 av = *(const LAS s16x8*)(VT + (cl * 64 + eb * 32 + r32) * 72 + 16 * s4 + 8 * half);
            acc[eb] = __builtin_amdgcn_mfma_f32_32x32x16_bf16(av, bk, acc[eb], 0, 0, 0);
        }
    }
    float* ut = UT + ((size_t)(bh * 64 + c) * 64) * 64;
#pragma unroll
    for (int eb = 0; eb < 2; ++eb)
#pragma unroll
        for (int r = 0; r < 16; ++r) { const int e = eb * 32 + 8 * (r >> 2) + 4 * half + (r & 3); ut[e * 64 + dh * 32 + r32] = acc[eb][r]; }
    {
        const LAS bf16* kr = KT + (cl * 64 + dh * 32 + r32) * 72 + half * 32; float sm = 0.f;
#pragma unroll
        for (int i = 0; i < 4; ++i) { const u32x4 x = *(const LAS u32x4*)(kr + 8 * i); sm += (bflo(x.x) + bfhi(x.x)) + (bflo(x.y) + bfhi(x.y)) + (bflo(x.z) + bfhi(x.z)) + (bflo(x.w) + bfhi(x.w)); }
        sm += __shfl_xor(sm, 32);
        if (half == 0) UN[(bh * 64 + c) * 64 + dh * 32 + r32] = sm;
    }
}
__device__ __forceinline__ void mlS_item(const Params& p, int bh, int wv) {
    const int tid = tid_fresh(wv);
    const float* UT = (const float*)(p.ws + WS_UT) + (size_t)bh * 64 * 4096; const float* UN = (const float*)(p.ws + WS_UN) + bh * 4096;
    bf16* CT = (bf16*)(p.ws + WS_CT) + (size_t)bh * 64 * 4096; float* NV = (float*)(p.ws + WS_NV) + bh * 4096; const float* DEC = (const float*)(p.ws + WS_DEC) + bh * 64;
    f32x4 s0 = (f32x4){0.f, 0.f, 0.f, 0.f}, s1 = s0; float ns = 0.f;
#pragma unroll 4
    for (int c = 0; c < 64; ++c) {
        const float dec = DEC[c];
        const f32x4 u0 = *(const f32x4*)(UT + (size_t)c * 4096 + tid * 8), u1 = *(const f32x4*)(UT + (size_t)c * 4096 + tid * 8 + 4);
        u32x4 w; w.x = pk2(s0[0], s0[1]); w.y = pk2(s0[2], s0[3]); w.z = pk2(s1[0], s1[1]); w.w = pk2(s1[2], s1[3]);
        *(u32x4*)(CT + (size_t)c * 4096 + tid * 8) = w;
        s0 = s0 * dec + u0; s1 = s1 * dec + u1;
        if (tid < 64) { NV[c * 64 + tid] = ns; ns = ns * dec + UN[c * 64 + tid]; }
    }
}
__device__ __forceinline__ void mlD_item(const Params& p, int l, int bh, int ci, LAS unsigned char* lds, int wv) {
    const int tid = tid_fresh(wv), lane = tid & 63, half = lane >> 5, r32 = lane & 31, b = bh >> 2, h = bh & 3;
    const bf16* Z = (const bf16*)(p.ws + WS_BIG); const float* MLS = (const float*)(p.ws + WS_MLS); bf16* O1 = (bf16*)(p.ws + WS_O + OB_STRIDE);
    LAS bf16* Qs = (LAS bf16*)lds; LAS bf16* Ks = Qs + 4 * 64 * 72; LAS bf16* VT = Ks + 4 * 64 * 72;
    const float* cw = p.ml_conv_w + (size_t)l * 4 * 512; const float* cb = p.ml_conv_b + (size_t)l * 512;
    __syncthreads();
    {
        const int tt = tid >> 1, hr = tid & 1, cl = tt >> 6, s = tt & 63, t = (ci * 4) * 64 + tt;
#pragma unroll 1
        for (int q8 = 0; q8 < 4; ++q8) {
            const int d0 = hr * 32 + q8 * 8; float y[8];
            ml_conv8(Z, cw, cb, b, t, h * 64 + d0, y);
            u32x4 w; w.x = pk2(y[0] * 0.125f, y[1] * 0.125f); w.y = pk2(y[2] * 0.125f, y[3] * 0.125f); w.z = pk2(y[4] * 0.125f, y[5] * 0.125f); w.w = pk2(y[6] * 0.125f, y[7] * 0.125f);
            *(LAS u32x4*)(Qs + (cl * 64 + s) * 72 + d0) = w;
            ml_conv8(Z, cw, cb, b, t, 256 + h * 64 + d0, y);
            w.x = pk2(y[0], y[1]); w.y = pk2(y[2], y[3]); w.z = pk2(y[4], y[5]); w.w = pk2(y[6], y[7]);
            *(LAS u32x4*)(Ks + (cl * 64 + s) * 72 + d0) = w;
            const u32x4 v = *(const u32x4*)(Z + ((size_t)b * SEQ + t) * ZP + 1280 + h * 64 + d0);
            LAS bf16* vd = VT + (cl * 64 + d0) * 72 + s;
            vd[0] = (bf16)(v.x & 0xffffu); vd[72] = (bf16)(v.x >> 16); vd[144] = (bf16)(v.y & 0xffffu); vd[216] = (bf16)(v.y >> 16);
            vd[288] = (bf16)(v.z & 0xffffu); vd[360] = (bf16)(v.z >> 16); vd[432] = (bf16)(v.w & 0xffffu); vd[504] = (bf16)(v.w >> 16);
        }
    }
    __syncthreads();
    const int cl = wv >> 1, th = wv & 1, c = ci * 4 + cl, tloc = th * 32 + r32, tseq = c * 64 + tloc;
    const int ti = bh * 4096 + tseq;
    const float bs_t = MLS[ti], mt_t = MLS[2 * MLN + ti], iw_t = MLS[4 * MLN + ti];
    s16x8 qf[4];
#pragma unroll
    for (int s4 = 0; s4 < 4; ++s4) qf[s4] = *(const LAS s16x8*)(Qs + (cl * 64 + tloc) * 72 + 16 * s4 + 8 * half);
    f32x16 oacc[2];
#pragma unroll
    for (int eb = 0; eb < 2; ++eb)
#pragma unroll
        for (int r = 0; r < 16; ++r) oacc[eb][r] = 0.f;
    const bf16* CT = (const bf16*)(p.ws + WS_CT) + (size_t)(bh * 64 + c) * 4096;
#pragma unroll
    for (int s4 = 0; s4 < 4; ++s4)
#pragma unroll
        for (int eb = 0; eb < 2; ++eb) { const s16x8 ac = *(const s16x8*)(CT + (eb * 32 + r32) * 64 + 16 * s4 + 8 * half);
            oacc[eb] = __builtin_amdgcn_mfma_f32_32x32x16_bf16(ac, qf[s4], oacc[eb], 0, 0, 0); }
#pragma unroll
    for (int eb = 0; eb < 2; ++eb)
#pragma unroll
        for (int r = 0; r < 16; ++r) oacc[eb][r] *= iw_t;
    float qn = 0.f;
    { const float* nvp = (const float*)(p.ws + WS_NV) + (bh * 64 + c) * 64;
#pragma unroll
      for (int s4 = 0; s4 < 4; ++s4) { const f32x4 n0 = *(const f32x4*)(nvp + 16 * s4 + 8 * half), n1 = *(const f32x4*)(nvp + 16 * s4 + 8 * half + 4);
          const u32x4 qq = __builtin_bit_cast(u32x4, qf[s4]);
          qn += bflo(qq.x) * n0[0] + bfhi(qq.x) * n0[1] + bflo(qq.y) * n0[2] + bfhi(qq.y) * n0[3] + bflo(qq.z) * n1[0] + bfhi(qq.z) * n1[1] + bflo(qq.w) * n1[2] + bfhi(qq.w) * n1[3]; } }
    qn += __shfl_xor(qn, 32);
    float rs = 0.f;
#pragma unroll
    for (int sb = 0; sb < 2; ++sb) {
        if (sb <= th) {
            f32x16 sacc;
#pragma unroll
            for (int r = 0; r < 16; ++r) sacc[r] = 0.f;
#pragma unroll
            for (int s4 = 0; s4 < 4; ++s4) { const s16x8 ak = *(const LAS s16x8*)(Ks + (cl * 64 + sb * 32 + r32) * 72 + 16 * s4 + 8 * half);
                sacc = __builtin_amdgcn_mfma_f32_32x32x16_bf16(ak, qf[s4], sacc, 0, 0, 0); }
            const float* ap = MLS + MLN + bh * 4096 + c * 64 + sb * 32 + 4 * half;
#pragma unroll
            for (int g = 0; g < 4; ++g) { const f32x4 av = *(const f32x4*)(ap + 8 * g);
#pragma unroll
                for (int i = 0; i < 4; ++i) { const int s = sb * 32 + 8 * g + 4 * half + i; const float v = (s <= tloc) ? sacc[4 * g + i] * __expf(bs_t + av[i] - mt_t) : 0.f; sacc[4 * g + i] = v; rs += v; } }
#pragma unroll
            for (int s2 = 0; s2 < 2; ++s2) {
                u32x4 w; w.x = pkbf(sacc[8 * s2], sacc[8 * s2 + 1]); w.y = pkbf(sacc[8 * s2 + 2], sacc[8 * s2 + 3]); w.z = pkbf(sacc[8 * s2 + 4], sacc[8 * s2 + 5]); w.w = pkbf(sacc[8 * s2 + 6], sacc[8 * s2 + 7]);
                const s16x8 pf = __builtin_bit_cast(s16x8, w);
#pragma unroll
                for (int eb = 0; eb < 2; ++eb) {
                    const LAS bf16* vr = VT + (cl * 64 + eb * 32 + r32) * 72 + sb * 32 + 16 * s2 + 4 * half;
                    const u32x2 v0 = *(const LAS u32x2*)vr, v1 = *(const LAS u32x2*)(vr + 8);
                    const u32x4 vv = (u32x4){v0.x, v0.y, v1.x, v1.y};
                    oacc[eb] = __builtin_amdgcn_mfma_f32_32x32x16_bf16(__builtin_bit_cast(s16x8, vv), pf, oacc[eb], 0, 0, 0);
                }
            }
        }
    }
    rs += __shfl_xor(rs, 32);
    const float den = iw_t * qn + rs;
    const float dn = 1.f / fmaxf(fabsf(den), __expf(-mt_t));
    float ss = 0.f;
#pragma unroll
    for (int eb = 0; eb < 2; ++eb)
#pragma unroll
        for (int r = 0; r < 16; ++r) { const float v = oacc[eb][r] * dn; oacc[eb][r] = v; ss = fmaf(v, v, ss); }
    ss += __shfl_xor(ss, 32);
    const float rr = 1.f / sqrtf(ss * (1.f / 64.f) + EPS);
    const size_t tok = (size_t)b * SEQ + tseq;
    const float* hg = p.ml_head_norm + l * 64;
#pragma unroll
    for (int eb = 0; eb < 2; ++eb)
#pragma unroll
        for (int g = 0; g < 4; ++g) { const int e0 = eb * 32 + 8 * g + 4 * half; const f32x4 gg = *(const f32x4*)(hg + e0);
            const u32x2 og = *(const u32x2*)(Z + tok * ZP + 1536 + h * 64 + e0);
            u32x2 w; w.x = pkbf(sigmoidf_(bflo(og.x)) * oacc[eb][4 * g] * rr * gg[0], sigmoidf_(bfhi(og.x)) * oacc[eb][4 * g + 1] * rr * gg[1]);
            w.y = pkbf(sigmoidf_(bflo(og.y)) * oacc[eb][4 * g + 2] * rr * gg[2], sigmoidf_(bfhi(og.y)) * oacc[eb][4 * g + 3] * rr * gg[3]);
            *(u32x2*)(O1 + tok * 256 + h * 64 + e0) = w; }
}
__device__ __forceinline__ float relu_(float x) { return __builtin_amdgcn_fmed3f(x, 0.f, __builtin_inff()); }
__device__ __forceinline__ unsigned key16(float s) { const float f = __builtin_amdgcn_fmed3f(floorf(fmaf(s, 512.f, 32768.f)), 0.f, 65535.f); return (unsigned)f; }
__device__ __forceinline__ unsigned mono_bits(float s) { s = (s == 0.f) ? 0.f : s; const unsigned u = __float_as_uint(s); return (u & 0x80000000u) ? ~u : (u | 0x80000000u); }
__device__ __forceinline__ void dsa_item(const Params& p, int lds_l, int b, int qt, LAS unsigned char* lds, int wv) {
    const int tid = tid_fresh(wv), lane = tid & 63, w = wv, half = lane >> 5, r32 = lane & 31;
    const bf16* Z = (const bf16*)(p.ws + WS_BIG); const float* ZS = (const float*)(p.ws + WS_ZS); const bf16* IK = (const bf16*)(p.ws + WS_IK); bf16* O3 = (bf16*)(p.ws + WS_O + 3 * OB_STRIDE);
    LAS unsigned* hist = (LAS unsigned*)lds + w * 2048;
    LAS unsigned* maskw = (LAS unsigned*)(lds + 65536);
    LAS bf16* KC = (LAS bf16*)(lds + 81920);
    LAS bf16* Kd = (LAS bf16*)lds; LAS bf16* VTd = Kd + 64 * 72;
    const size_t tokb = (size_t)b * SEQ; const int tb = qt * 32 + 4 * w;
    const int ntiles = qt + 1, nkeys = ntiles * 32, nchunks = (ntiles + 15) >> 4;
    s16x8 aq0, aq1;
    { const int qrow = 2 * ((r32 >> 2) & 1) + (r32 >> 4), hrow = 4 * ((r32 >> 3) & 1) + (r32 & 3);
      const bf16* ap = Z + (tokb + tb + qrow) * ZP + 2816 + hrow * 32 + half * 8; aq0 = *(const s16x8*)ap; aq1 = *(const s16x8*)(ap + 16); }
    float wq[2][8];
#pragma unroll
    for (int s = 0; s < 2; ++s) { const float* wp = ZS + (tokb + tb + 2 * half + s) * ZSP + 160; const f32x4 x0 = *(const f32x4*)wp, x1 = *(const f32x4*)(wp + 4);
        wq[s][0] = x0[0]; wq[s][1] = x0[1]; wq[s][2] = x0[2]; wq[s][3] = x0[3]; wq[s][4] = x1[0]; wq[s][5] = x1[1]; wq[s][6] = x1[2]; wq[s][7] = x1[3]; }
    unsigned tau[4], prefix[4]; int quota[4], krem[4], eqs[2]; bool allsel[4];
    LAS unsigned* cand = (LAS unsigned*)(lds + 114688) + w * 768;
    LAS unsigned* oflag = (LAS unsigned*)(lds + LDS_BYTES - 48);
    const unsigned lowmask = (1u << r32) - 1u;
#define DSA_SCORES(ktl, sc) do { const LAS bf16* kp_ = KC + ((ktl) * 32 + r32) * 32 + half * 8; \
        const s16x8 b0_ = *(const LAS s16x8*)kp_, b1_ = *(const LAS s16x8*)(kp_ + 16); f32x16 a_ = {0.f, 0.f, 0.f, 0.f, 0.f, 0.f, 0.f, 0.f, 0.f, 0.f, 0.f, 0.f, 0.f, 0.f, 0.f, 0.f}; \
        a_ = __builtin_amdgcn_mfma_f32_32x32x16_bf16(aq0, b0_, a_, 0, 0, 0); a_ = __builtin_amdgcn_mfma_f32_32x32x16_bf16(aq1, b1_, a_, 0, 0, 0); \
        _Pragma("unroll") for (int s_ = 0; s_ < 2; ++s_) { float pt_ = wq[s_][0] * relu_(a_[8 * s_]); \
            _Pragma("unroll") for (int j_ = 1; j_ < 8; ++j_) pt_ = fmaf(wq[s_][j_], relu_(a_[8 * s_ + j_]), pt_); sc[s_] = pt_; } } while (0)
    int mode = (qt >= 8) ? 0 : 1;
#pragma unroll 1
    for (int attempt = 0; attempt < 2; ++attempt) {
        const int npass = (qt >= 8) ? (mode ? 4 : 1) : 0;
#pragma unroll
        for (int g = 0; g < 4; ++g) { tau[g] = 0u; prefix[g] = 0u; quota[g] = 1 << 30; krem[g] = 256; allsel[g] = true; }
        eqs[0] = 0; eqs[1] = 0;
        if (tid == 0) *oflag = 0u;
#pragma unroll 1
        for (int pass = 0; pass <= npass; ++pass) {
            const bool comp = (pass == npass);
            const int shift = 8 * (npass - 1 - pass);
            if (!comp) {
#pragma unroll
                for (int i = 0; i < 8; ++i) *(LAS u32x4*)(hist + (i * 64 + lane) * 4) = (u32x4){0u, 0u, 0u, 0u};
            }
            const unsigned pfa = half ? prefix[2] : prefix[0], pfb = half ? prefix[3] : prefix[1];
            const int ta = tb + 2 * half, tbq = ta + 1;
            u32x4 pre[4];
#pragma unroll
            for (int i = 0; i < 4; ++i) { const int kb = (tid * 16 + i * 8192) >> 6; pre[i] = (kb < nkeys) ? *(const u32x4*)((const unsigned char*)(IK + tokb * 32) + tid * 16 + i * 8192) : (u32x4){0u, 0u, 0u, 0u}; }
#pragma unroll 1
            for (int ch = 0; ch < nchunks; ++ch) {
                __syncthreads();
#pragma unroll
                for (int i = 0; i < 4; ++i) *(LAS u32x4*)((LAS unsigned char*)KC + tid * 16 + i * 8192) = pre[i];
                __syncthreads();
                if (ch + 1 < nchunks) {
#pragma unroll
                    for (int i = 0; i < 4; ++i) { const int kb = (ch + 1) * 512 + ((tid * 16 + i * 8192) >> 6);
                        pre[i] = (kb < nkeys) ? *(const u32x4*)((const unsigned char*)(IK + (tokb + (size_t)(ch + 1) * 512) * 32) + tid * 16 + i * 8192) : (u32x4){0u, 0u, 0u, 0u}; }
                }
                const int nt = min(16, ntiles - ch * 16);
                if (!comp) {
#pragma unroll 4
                    for (int ktl = 0; ktl < nt; ++ktl) {
                        float sc[2]; DSA_SCORES(ktl, sc);
                        const int key = (ch * 16 + ktl) * 32 + r32;
                        const float sa = sc[0], sb = sc[1];
                        if (mode == 0) {
                            const unsigned ba = key16(sa) >> 6, bb = key16(sb) >> 6;
                            if (key <= ta) __hip_atomic_fetch_add(hist + (2 * half) * 512 + (ba >> 1), (ba & 1u) ? 0x10000u : 1u, __ATOMIC_RELAXED, __HIP_MEMORY_SCOPE_WORKGROUP);
                            if (key <= tbq) __hip_atomic_fetch_add(hist + (2 * half + 1) * 512 + (bb >> 1), (bb & 1u) ? 0x10000u : 1u, __ATOMIC_RELAXED, __HIP_MEMORY_SCOPE_WORKGROUP);
                        } else {
                        const unsigned ma = mono_bits(sa), mb = mono_bits(sb);
                        const bool oka = (key <= ta) && (pass == 0 || (ma >> (shift + 8)) == pfa);
                        const bool okb = (key <= tbq) && (pass == 0 || (mb >> (shift + 8)) == pfb);
                        if (oka) __hip_atomic_fetch_add(hist + (2 * half) * 256 + ((ma >> shift) & 255u), 1u, __ATOMIC_RELAXED, __HIP_MEMORY_SCOPE_WORKGROUP);
                        if (okb) __hip_atomic_fetch_add(hist + (2 * half + 1) * 256 + ((mb >> shift) & 255u), 1u, __ATOMIC_RELAXED, __HIP_MEMORY_SCOPE_WORKGROUP);
                        }
                    }
                } else {
#pragma unroll 1
                    for (int ktl = 0; ktl < nt; ++ktl) {
                        float sc[2]; DSA_SCORES(ktl, sc);
                        const int key = (ch * 16 + ktl) * 32 + r32;
#pragma unroll
                        for (int s = 0; s < 2; ++s) {
                            const unsigned taus = half ? tau[2 + s] : tau[s]; const int quo = half ? quota[2 + s] : quota[s]; const bool alls = half ? allsel[2 + s] : allsel[s];
                            const unsigned m = mode ? mono_bits(sc[s]) : (key16(sc[s]) >> 6); const bool valid = key <= tb + 2 * half + s;
                            const bool eq = valid && (m == taus);
                            const unsigned beq = (unsigned)(__ballot(eq) >> (32 * half));
                            const int rank = eqs[s] + __popc(beq & lowmask);
                            const bool takeeq = mode ? (rank < quo) : alls;
                            const bool sel = valid && ((m > taus) || (eq && takeeq));
                            const unsigned bsel = (unsigned)(__ballot(sel) >> (32 * half));
                            if (r32 == 0) maskw[(4 * w + 2 * half + s) * 128 + ch * 16 + ktl] = bsel;
                            if (mode == 0 && !alls && eq && rank < 96) { cand[((2 * half + s) * 96 + rank) * 2] = mono_bits(sc[s]); cand[((2 * half + s) * 96 + rank) * 2 + 1] = (unsigned)key; }
                            eqs[s] += __popc(beq);
                        }
                    }
                }
            }
            if (!comp) {
                LDS_WAIT();
                if (mode == 0) {
#pragma unroll
                    for (int g = 0; g < 4; ++g) {
                        const u32x4 w0 = *(const LAS u32x4*)(hist + g * 512 + lane * 8), w1 = *(const LAS u32x4*)(hist + g * 512 + lane * 8 + 4);
                        const unsigned wd[8] = {w0.x, w0.y, w0.z, w0.w, w1.x, w1.y, w1.z, w1.w};
                        int c[16], tot = 0;
#pragma unroll
                        for (int j = 0; j < 8; ++j) { c[2 * j] = (int)(wd[j] & 0xffffu); c[2 * j + 1] = (int)(wd[j] >> 16); tot += c[2 * j] + c[2 * j + 1]; }
                        int v = tot;
#pragma unroll
                        for (int d = 1; d < 64; d <<= 1) { const int n = __shfl_down(v, d); if (lane + d < 64) v += n; }
                        const int k = krem[g]; int a = v - tot, fb = -1, fa = 0, fc = 0;
#pragma unroll
                        for (int j = 15; j >= 0; --j) { if (fb < 0 && a < k && a + c[j] >= k) { fb = j; fa = a; fc = c[j]; } a += c[j]; }
                        const unsigned long long mk = __ballot(fb >= 0);
                        const int src = (int)__builtin_ctzll(mk | (1ull << 63));
                        const int bin = __shfl(16 * lane + fb, src), above = __shfl(fa, src), cnt = __shfl(fc, src);
                        prefix[g] = (unsigned)bin; krem[g] = k - above;
                        tau[g] = prefix[g]; quota[g] = krem[g]; allsel[g] = (cnt == krem[g]);
                    }
                } else {
#pragma unroll
                for (int g = 0; g < 4; ++g) {
                    const u32x4 cv = *(const LAS u32x4*)(hist + g * 256 + lane * 4);
                    const int c0 = (int)cv.x, c1 = (int)cv.y, c2 = (int)cv.z, c3 = (int)cv.w, tot = c0 + c1 + c2 + c3;
                    int v = tot;
#pragma unroll
                    for (int d = 1; d < 64; d <<= 1) { const int n = __shfl_down(v, d); if (lane + d < 64) v += n; }
                    const int a3 = v - tot, a2 = a3 + c3, a1 = a2 + c2, a0 = a1 + c1; const int k = krem[g];
                    int fb = -1, fa = 0, fc = 0;
                    if (a3 < k && a3 + c3 >= k) { fb = 3; fa = a3; fc = c3; }
                    else if (a2 < k && a2 + c2 >= k) { fb = 2; fa = a2; fc = c2; }
                    else if (a1 < k && a1 + c1 >= k) { fb = 1; fa = a1; fc = c1; }
                    else if (a0 < k && a0 + c0 >= k) { fb = 0; fa = a0; fc = c0; }
                    const unsigned long long mk = __ballot(fb >= 0);
                    const int src = (int)__builtin_ctzll(mk | (1ull << 63));
                    const int bin = __shfl(4 * lane + fb, src), above = __shfl(fa, src), cnt = __shfl(fc, src);
                    prefix[g] = (prefix[g] << 8) | (unsigned)bin; krem[g] = k - above;
                    if (pass == npass - 1) { tau[g] = prefix[g]; quota[g] = krem[g]; allsel[g] = (cnt == krem[g]); }
                }
                }
            }
        }
        if (mode == 0 && npass) {
            LDS_WAIT();
#pragma unroll
            for (int g = 0; g < 4; ++g) {
                if (!allsel[g]) {
                    const int n = __shfl(eqs[g & 1], 32 * (g >> 1)), need = quota[g];
                    if (n > 96) { if (lane == 0) *oflag = 1u; }
                    else {
#pragma unroll 1
                        for (int i0 = 0; i0 < n; i0 += 64) {
                            const int i = i0 + lane; const bool act = i < n;
                            const unsigned mi = act ? cand[(g * 96 + i) * 2] : 0u, ki = act ? cand[(g * 96 + i) * 2 + 1] : 0u; int rank = 0;
#pragma unroll 1
                            for (int j = 0; j < n; ++j) { const unsigned mj = cand[(g * 96 + j) * 2], kj = cand[(g * 96 + j) * 2 + 1]; rank += ((mj > mi) || (mj == mi && kj < ki)) ? 1 : 0; }
                            if (act && rank < need) __hip_atomic_fetch_or(maskw + (4 * w + g) * 128 + (ki >> 5), 1u << (ki & 31u), __ATOMIC_RELAXED, __HIP_MEMORY_SCOPE_WORKGROUP);
                        }
                    }
                }
            }
        }
        __syncthreads();
        const unsigned of = *oflag;
        __syncthreads();
        if (mode == 0 && of != 0u) { mode = 1; continue; }
        break;
    }
    __syncthreads();
    {
        const float* sgn = p.dsa_qk_norm + lds_l * 128; float gqm = 0.f, gkm = 0.f;
#pragma unroll 2
        for (int i = 0; i < 64; ++i) { gqm = fmaxf(gqm, fabsf(sgn[i])); gkm = fmaxf(gkm, fabsf(sgn[64 + i])); }
        const float coff = 8.f * gqm * gkm;
        const int cb = w & 3, ksp = w >> 2, ql = 8 * cb + (r32 >> 2), hh = r32 & 3;
        s16x8 qf[4];
        { const bf16* qp = Z + (tokb + qt * 32 + ql) * ZP + 2560 + hh * 64 + 8 * half;
#pragma unroll
          for (int s4 = 0; s4 < 4; ++s4) qf[s4] = *(const s16x8*)(qp + 16 * s4); }
        f32x16 oacc[2];
#pragma unroll
        for (int db = 0; db < 2; ++db)
#pragma unroll
            for (int r = 0; r < 16; ++r) oacc[db][r] = 0.f;
        float lsum = 0.f;
        const int nT = (ntiles + 1) >> 1;
        const int skey = tid >> 3, sseg = tid & 7;
        const float* sgp = ZS + (tokb + skey) * ZSP + sseg * 16;
        f32x4 pr[4];
#pragma unroll
        for (int i = 0; i < 4; ++i) pr[i] = *(const f32x4*)(sgp + 4 * i);
#pragma unroll 1
        for (int tT = 0; tT < nT; ++tT) {
            __syncthreads();
            if (sseg < 4) {
                u32x4 w0, w1; w0.x = pkbf(pr[0][0], pr[0][1]); w0.y = pkbf(pr[0][2], pr[0][3]); w0.z = pkbf(pr[1][0], pr[1][1]); w0.w = pkbf(pr[1][2], pr[1][3]);
                w1.x = pkbf(pr[2][0], pr[2][1]); w1.y = pkbf(pr[2][2], pr[2][3]); w1.z = pkbf(pr[3][0], pr[3][1]); w1.w = pkbf(pr[3][2], pr[3][3]);
                *(LAS u32x4*)(Kd + skey * 72 + sseg * 16) = w0; *(LAS u32x4*)(Kd + skey * 72 + sseg * 16 + 8) = w1;
            } else {
                LAS bf16* vd = VTd + ((sseg - 4) * 16) * 72 + skey;
#pragma unroll
                for (int i = 0; i < 4; ++i) { const unsigned a0 = pkbf(pr[i][0], pr[i][1]), a1 = pkbf(pr[i][2], pr[i][3]);
                    vd[(4 * i) * 72] = (bf16)(a0 & 0xffffu); vd[(4 * i + 1) * 72] = (bf16)(a0 >> 16); vd[(4 * i + 2) * 72] = (bf16)(a1 & 0xffffu); vd[(4 * i + 3) * 72] = (bf16)(a1 >> 16); }
            }
            __syncthreads();
            if (tT + 1 < nT) {
#pragma unroll
                for (int i = 0; i < 4; ++i) pr[i] = *(const f32x4*)(sgp + (size_t)(tT + 1) * 64 * ZSP + 4 * i);
            }
            const int st = 2 * tT + ksp;
            if (st < ntiles) {
                const unsigned mw = maskw[ql * 128 + st];
                f32x16 sacc;
#pragma unroll
                for (int r = 0; r < 16; ++r) sacc[r] = 0.f;
#pragma unroll
                for (int s4 = 0; s4 < 4; ++s4) { const s16x8 ak = *(const LAS s16x8*)(Kd + (32 * ksp + r32) * 72 + 16 * s4 + 8 * half);
                    sacc = __builtin_amdgcn_mfma_f32_32x32x16_bf16(ak, qf[s4], sacc, 0, 0, 0); }
#pragma unroll
                for (int r = 0; r < 16; ++r) { const int kbit = 8 * (r >> 2) + 4 * half + (r & 3); const float pe = ((mw >> kbit) & 1u) ? __expf(sacc[r] - coff) : 0.f; sacc[r] = pe; lsum += pe; }
#pragma unroll
                for (int s2 = 0; s2 < 2; ++s2) {
                    u32x4 wp; wp.x = pkbf(sacc[8 * s2], sacc[8 * s2 + 1]); wp.y = pkbf(sacc[8 * s2 + 2], sacc[8 * s2 + 3]); wp.z = pkbf(sacc[8 * s2 + 4], sacc[8 * s2 + 5]); wp.w = pkbf(sacc[8 * s2 + 6], sacc[8 * s2 + 7]);
                    const s16x8 pf = __builtin_bit_cast(s16x8, wp);
#pragma unroll
                    for (int db = 0; db < 2; ++db) {
                        const LAS bf16* vr = VTd + (db * 32 + r32) * 72 + 32 * ksp + 16 * s2 + 4 * half;
                        const u32x2 v0 = *(const LAS u32x2*)vr, v1 = *(const LAS u32x2*)(vr + 8);
                        const u32x4 vv = (u32x4){v0.x, v0.y, v1.x, v1.y};
                        oacc[db] = __builtin_amdgcn_mfma_f32_32x32x16_bf16(__builtin_bit_cast(s16x8, vv), pf, oacc[db], 0, 0, 0);
                    }
                }
            }
        }
        lsum += __shfl_xor(lsum, 32);
        __syncthreads();
        LAS float* xch = (LAS float*)(lds + 81920) + (w & 3) * (33 * 64);
        if (ksp == 1) {
#pragma unroll
            for (int db = 0; db < 2; ++db)
#pragma unroll
                for (int r = 0; r < 16; ++r) xch[(db * 16 + r) * 64 + lane] = oacc[db][r];
            xch[32 * 64 + lane] = lsum;
        }
        __syncthreads();
        if (ksp == 0) {
            const float is = 1.f / (lsum + xch[32 * 64 + lane]);
            bf16* orow = O3 + (tokb + qt * 32 + ql) * 256 + hh * 64;
#pragma unroll
            for (int db = 0; db < 2; ++db)
#pragma unroll
                for (int g = 0; g < 4; ++g) { const int d0 = db * 32 + 8 * g + 4 * half;
                    const float x0 = (oacc[db][4 * g] + xch[(db * 16 + 4 * g) * 64 + lane]) * is, x1 = (oacc[db][4 * g + 1] + xch[(db * 16 + 4 * g + 1) * 64 + lane]) * is;
                    const float x2 = (oacc[db][4 * g + 2] + xch[(db * 16 + 4 * g + 2) * 64 + lane]) * is, x3 = (oacc[db][4 * g + 3] + xch[(db * 16 + 4 * g + 3) * 64 + lane]) * is;
                    u32x2 wo; wo.x = pkbf(x0, x1); wo.y = pkbf(x2, x3); *(u32x2*)(orow + d0) = wo; }
        }
    }
#undef DSA_SCORES
    __syncthreads();
}

constexpr int Q_ML = 32, Q_DIFF = 512, Q_DSA = 1024, Q_SB = 256, Q_TOTAL = Q_ML + Q_DIFF + Q_DSA + Q_SB;
__device__ __forceinline__ int next_item(unsigned* ctr, LAS int* slot, int wv) {
    __syncthreads();
    if (tid_fresh(wv) == 0) *slot = (int)atomicAdd(ctr, 1u);
    __syncthreads();
    return *slot;
}
__device__ __forceinline__ void mixer_phase1(int l, LAS unsigned char* lds, int wv, int co = 0) {
    LAS int* slot = (LAS int*)(lds + LDS_BYTES - 64);
    { const Params p = load_params(); unsigned* ctr = (unsigned*)(p.ws + WS_CTL) + 64 * (4 * l + 0 + co);
      for (;;) { const int it = next_item(ctr, slot, wv); if (it >= Q_DIFF) break; diffm_item(p, l, it & 31, 15 - (it >> 5), lds, wv); } }
    { const Params p = load_params(); unsigned* ctr = (unsigned*)(p.ws + WS_CTL) + 64 * (4 * l + 1 + co);
      for (;;) { const int it = next_item(ctr, slot, wv); if (it >= 512) break; mlB_item(p, l, it & 31, it >> 5, lds, wv); } }
}
__device__ __forceinline__ void mixer_phase2(int l, LAS unsigned char* lds, int wv, int co = 0) {
    LAS int* slot = (LAS int*)(lds + LDS_BYTES - 64);
    { const Params p = load_params(); unsigned* ctr = (unsigned*)(p.ws + WS_CTL) + 64 * (4 * l + 2 + co);
      for (;;) { const int it = next_item(ctr, slot, wv); if (it >= 32 + Q_DSA) break;
          if (it < 32) mlS_item(p, it, wv); else { const int i = it - 32; dsa_item(p, l, i & 7, 127 - (i >> 3), lds, wv); } } }
}
__device__ __forceinline__ void mixer_phase3(int l, LAS unsigned char* lds, int wv, int co = 0) {
    LAS int* slot = (LAS int*)(lds + LDS_BYTES - 64);
    { const Params p = load_params(); unsigned* ctr = (unsigned*)(p.ws + WS_CTL) + 64 * (4 * l + 3 + co);
      for (;;) { const int it = next_item(ctr, slot, wv); if (it >= 512) break; mlD_item(p, l, it & 31, it >> 5, lds, wv); } }
    { const Params p = load_params(); unsigned* ctr = (unsigned*)(p.ws + WS_CTL) + 64 * (8 + l + co);
      for (;;) { const int it = next_item(ctr, slot, wv); if (it >= Q_SB) break; sb_item(p, l, it >> 3, it & 7, lds, wv); } }
}

#define XB_TMO      128
#define XB_XCNT(j)  (256  + 64 * (j))
#define XB_XSUB(j)  (1280 + 64 * (j))
#define XB_XGEN(j)  (2304 + 64 * (j))
#define XB_TOP      3328
#define XB_TOPGEN   3392
#define XCD_BAR_WORDS 3456
#define XB_SPIN_CAP (1u << 20)
constexpr int CW_BAR = 8192;
__device__ __forceinline__ unsigned xb_ld(unsigned* p)              { return __hip_atomic_load(p, __ATOMIC_RELAXED, __HIP_MEMORY_SCOPE_AGENT); }
__device__ __forceinline__ unsigned xb_add(unsigned* p, unsigned v) { return __hip_atomic_fetch_add(p, v, __ATOMIC_RELAXED, __HIP_MEMORY_SCOPE_AGENT); }
__device__ __forceinline__ unsigned xb_xcc_id() { return (unsigned)__builtin_amdgcn_s_getreg((3 << 11) | 20) & 0xFu; }
#define XB_SPIN(cond, bar) do { unsigned _sp = 0; while (cond) { __builtin_amdgcn_s_sleep(1); \
    if ((++_sp & 255u) == 0u) { if (xb_ld(&(bar)[XB_TMO])) break; if (_sp > XB_SPIN_CAP) { atomicAdd(&(bar)[XB_TMO], 1u); break; } } } } while (0)
__device__ __forceinline__ void xcd_post(int wv) {
    const Params p = load_params(); unsigned* bar = (unsigned*)(p.ws + WS_CTL) + CW_BAR;
    if (tid_fresh(wv) == 0) (void)xb_add(&bar[XB_XCNT(xb_xcc_id())], 1u);
}
__device__ __forceinline__ void xcd_barrier_complete(unsigned* bar, unsigned x, unsigned& nloc, unsigned& nx) {
    const unsigned G = gridDim.x * gridDim.y * gridDim.z;
    unsigned sum, cnt, mine, sp = 0u;
    for (;;) {
        sum = 0u; cnt = 0u; mine = 0u;
#pragma unroll
        for (unsigned j = 0; j < 16; ++j) { const unsigned c = xb_ld(&bar[XB_XCNT(j)]); sum += c; cnt += (c > 0u) ? 1u : 0u; mine = (j == x) ? c : mine; }
        if (sum == G) break;
        __builtin_amdgcn_s_sleep(1);
        if ((++sp & 255u) == 0u) { if (xb_ld(&bar[XB_TMO])) break; if (sp > XB_SPIN_CAP) { atomicAdd(&bar[XB_TMO], 1u); break; } }
    }
    nloc = mine > 0u ? mine : 1u; nx = cnt > 0u ? cnt : 1u;
}
__device__ __forceinline__ void gsync(LAS unsigned char* lds, int wv) {
    asm volatile("s_waitcnt vmcnt(0)" ::: "memory");
    __syncthreads();
    if (tid_fresh(wv) == 0) {
        const Params p = load_params(); unsigned* bar = (unsigned*)(p.ws + WS_CTL) + CW_BAR;
        volatile LAS unsigned* st = (volatile LAS unsigned*)(lds + LDS_BYTES - 32);
        const unsigned x = xb_xcc_id();
        __builtin_amdgcn_s_waitcnt(0);
        unsigned nloc = st[0], nx = st[1];
        if (nloc == 0u) { xcd_barrier_complete(bar, x, nloc, nx); st[0] = nloc; st[1] = nx; }
        const unsigned old = xb_add(&bar[XB_XSUB(x)], 1u);
        const unsigned gen = old / nloc;
        if (old + 1u == (gen + 1u) * nloc) {
            __builtin_amdgcn_fence(__ATOMIC_RELEASE, "agent");
            asm volatile("s_waitcnt vmcnt(0)" ::: "memory");
            const unsigned og = xb_add(&bar[XB_TOP], 1u);
            const unsigned tg = og / nx;
            if (og + 1u == (tg + 1u) * nx) xb_add(&bar[XB_TOPGEN], 1u);
            else XB_SPIN(xb_ld(&bar[XB_TOPGEN]) == tg, bar);
            __builtin_amdgcn_fence(__ATOMIC_ACQUIRE, "agent");
            xb_add(&bar[XB_XGEN(x)], 1u);
            asm volatile("s_waitcnt vmcnt(0)" ::: "memory");
        } else {
            XB_SPIN(xb_ld(&bar[XB_XGEN(x)]) == gen, bar);
            __builtin_amdgcn_fence(__ATOMIC_ACQUIRE, "agent");
            asm volatile("s_waitcnt vmcnt(0)" ::: "memory");
        }
    }
    __syncthreads();
}

#define PH_LOCALS const Params p = load_params(); const int tid = tid_fresh(wv), lane = tid & 63, wave = tid >> 6; const int gw = (int)blockIdx.x * NWAVES + wave, ngw = (int)gridDim.x * NWAVES; \
    (void)lane; (void)gw; (void)ngw; bf16* HN = (bf16*)(p.ws + WS_HN); bf16* BIGB = (bf16*)(p.ws + WS_BIG); (void)HN; (void)BIGB;
template <int l> __device__ __forceinline__ void layer_body(cg::grid_group& grid, LAS unsigned char* lds, const int wv) {
        { PH_LOCALS const unsigned char* wl = p.ws + WS_W + (size_t)l * WL_STRIDE; EpiSwiglu E{l * 3 + 0}; run_gemm(lds, HN, (const bf16*)(wl + WL_GU1), T, 2 * FF, D, E, wv); }
        gsync(lds, wv);
        { PH_LOCALS const unsigned char* wl = p.ws + WS_W + (size_t)l * WL_STRIDE; EpiResid E{l == 0 ? 1 : 0, 0.5f, l * 3 + 1}; run_gemm(lds, BIGB, (const bf16*)(wl + WL_D1), T, D, FF, E, wv); }
        gsync(lds, wv);
        { PH_LOCALS const unsigned char* wl = p.ws + WS_W + (size_t)l * WL_STRIDE; EpiZ E{l * 3 + 1}; run_gemm(lds, HN, (const bf16*)(wl + WL_INA), T, 3328, D, E, wv); }
        gsync(lds, wv);
        { PH_LOCALS if (gw < 32) ml_prepass(p, l, gw, lane); else prep_phase(p, l, gw - 32, ngw - 32, lane); }
        gsync(lds, wv);
        mixer_phase1(l, lds, wv);
#if PROBE_DUP & 1
        gsync(lds, wv); mixer_phase1(l, lds, wv, 16);
#endif
        gsync(lds, wv);
        mixer_phase2(l, lds, wv);
#if PROBE_DUP & 2
        gsync(lds, wv); mixer_phase2(l, lds, wv, 16);
#endif
        gsync(lds, wv);
        mixer_phase3(l, lds, wv);
#if PROBE_DUP & 4
        gsync(lds, wv); mixer_phase3(l, lds, wv, 16);
#endif
        gsync(lds, wv);
#pragma unroll 1
        for (int hb = 0; hb < 2; ++hb) {
            { PH_LOCALS const unsigned char* wl = p.ws + WS_W + (size_t)l * WL_STRIDE; EpiSig E{l * 3 + 1}; run_gemm(lds, HN, (const bf16*)(wl + WL_G) + (size_t)hb * 2 * D * D, T, 2 * D, D, E, wv); }
            gsync(lds, wv);
#pragma unroll 1
            for (int bb = 0; bb < 2; ++bb) {
                PH_LOCALS const unsigned char* wl = p.ws + WS_W + (size_t)l * WL_STRIDE; const int b = hb * 2 + bb;
                EpiGate E{bb * D, b == 0 ? 1 : 0};
                run_gemm(lds, (const bf16*)(p.ws + WS_O + b * OB_STRIDE), (const bf16*)(wl + WL_BR) + (size_t)b * D * 256, T, D, 256, E, wv);
            }
            gsync(lds, wv);
        }
        { PH_LOCALS const unsigned char* wl = p.ws + WS_W + (size_t)l * WL_STRIDE; EpiResid E{0, 1.0f, l * 3 + 2}; run_gemm(lds, (const bf16*)(p.ws + WS_BIG + 128 * MiB), (const bf16*)(wl + WL_OUT), T, D, D, E, wv); }
        gsync(lds, wv);
        { PH_LOCALS const unsigned char* wl = p.ws + WS_W + (size_t)l * WL_STRIDE; EpiSwiglu E{l * 3 + 2}; run_gemm(lds, HN, (const bf16*)(wl + WL_GU2), T, 2 * FF, D, E, wv); }
        gsync(lds, wv);
        { PH_LOCALS const unsigned char* wl = p.ws + WS_W + (size_t)l * WL_STRIDE; EpiResid E{0, 0.5f, (l + 1 < DEPTH) ? (l + 1) * 3 : -1}; run_gemm(lds, BIGB, (const bf16*)(wl + WL_D2), T, D, FF, E, wv); }
        if (l + 1 < DEPTH) gsync(lds, wv);
    }

__global__ void __launch_bounds__(NTHR, 2) hybrid_fwd(Params p_unused) {
    extern __shared__ __attribute__((aligned(16))) unsigned char lds_raw[];
    LAS unsigned char* lds = (LAS unsigned char*)lds_raw;
    cg::grid_group grid = cg::this_grid();
    const int wv = __builtin_amdgcn_readfirstlane((int)threadIdx.x >> 6);
    {
        PH_LOCALS
        SegRun R; R.base = 0; R.gw = gw; R.ngw = ngw; R.lane = lane; R.scr = (LAS float*)(lds + wave * 8704);
        for (int l = 0; l < DEPTH; ++l) convert_weights(p, l, R);
        if (blockIdx.x == 0 && tid < 64) ((unsigned*)(p.ws + WS_CTL))[64 * tid] = 0u;
        if (blockIdx.x == 0) for (int i = tid; i < XCD_BAR_WORDS; i += NTHR) ((unsigned*)(p.ws + WS_CTL))[CW_BAR + i] = 0u;
        if (tid < 8) ((LAS unsigned*)(lds + LDS_BYTES - 32))[tid] = 0u;
        for (int i = gw * 64 + lane; i < 5 * T; i += ngw * 64) { const int a_ = 1 + i / T; rs_ptr(p, a_)[i % T] = 0ull; }
        xb_rows(p.x, HN, rs_ptr(p, 0), gw, ngw, lane);
    }
    grid.sync();
    xcd_post(wv);
    layer_body<0>(grid, lds, wv);
    layer_body<1>(grid, lds, wv);
}

extern "C" void kernel_launch(void* const* d_in, const int* in_sizes, int n_in, void* d_out, int out_size, void* d_ws, size_t ws_size, hipStream_t stream) {
    static int grid = 0;
    if (grid == 0) {
        if (n_in != 20 || out_size != T * D || ws_size < WS_END2) { fprintf(stderr, "kernel_launch: unexpected shapes (n_in %d out %d ws %zu)\n", n_in, out_size, ws_size); grid = -1; return; }
        int dev = 0, cus = 0, per_cu = 0;
        hipGetDevice(&dev); hipDeviceGetAttribute(&cus, hipDeviceAttributeMultiprocessorCount, dev);
        hipFuncSetAttribute((const void*)hybrid_fwd, hipFuncAttributeMaxDynamicSharedMemorySize, LDS_BYTES);
        hipOccupancyMaxActiveBlocksPerMultiprocessor(&per_cu, (const void*)hybrid_fwd, NTHR, LDS_BYTES);
        if (per_cu < 1) { fprintf(stderr, "kernel_launch: occupancy query says %d\n", per_cu); per_cu = 1; }
        (void)hipGetLastError();
        grid = cus * 1;
    }
    if (grid < 0) return;
    Params p{};
    p.x = (const float*)d_in[0]; p.pos = (const int*)d_in[1];
    p.ffn1_norm = (const float*)d_in[2]; p.ffn1_gu = (const float*)d_in[3]; p.ffn1_down = (const float*)d_in[4]; p.mix_norm = (const float*)d_in[5]; p.w_in = (const float*)d_in[6];
    p.diff_qk_norm = (const float*)d_in[7]; p.diff_lambda = (const float*)d_in[8]; p.diff_head_norm = (const float*)d_in[9]; p.ml_conv_w = (const float*)d_in[10]; p.ml_conv_b = (const float*)d_in[11];
    p.ml_gate_bias = (const float*)d_in[12]; p.ml_head_norm = (const float*)d_in[13]; p.dsa_qk_norm = (const float*)d_in[14]; p.w_branch = (const float*)d_in[15]; p.w_out = (const float*)d_in[16];
    p.ffn2_norm = (const float*)d_in[17]; p.ffn2_gu = (const float*)d_in[18]; p.ffn2_down = (const float*)d_in[19];
    p.out = (float*)d_out; p.ws = (unsigned char*)d_ws;
    void* args[] = {&p};
    hipError_t e = hipLaunchCooperativeKernel((const void*)hybrid_fwd, dim3(grid), dim3(NTHR), args, LDS_BYTES, stream);
    if (e != hipSuccess) fprintf(stderr, "cooperative launch failed: %s (grid %d)\n", hipGetErrorString(e), grid);
}
```

```cpp
#include <hip/hip_runtime.h>
#include <hip/hip_cooperative_groups.h>
#include <cstdio>
#include <cstdint>
namespace cg = cooperative_groups;
#ifndef PROBE_DUP
#define PROBE_DUP 0
#endif
namespace pg8 {
#define PG8_LAS __attribute__((address_space(3)))
typedef unsigned short bf16_t;
typedef short bf16x8 __attribute__((ext_vector_type(8)));
typedef float f32x4 __attribute__((ext_vector_type(4)));
typedef unsigned u32x4 __attribute__((ext_vector_type(4)));
constexpr int BM = 256, BK = 64, HALF = 128, HTB = HALF * BK * 2  , STAGE_BYTES = 8 * HTB, NXCD = 8, WGM = 8;

__host__ __device__ __forceinline__ int lds_byte(int r, int c) { const int st = (r >> 4) * 2 + (c >> 5), rr = r & 15, cc = c & 31, ob = rr * 64 + cc * 2; return st * 1024 + (ob ^ (((ob >> 9) & 1) << 5)); }
__host__ __device__ __forceinline__ void stage_rc(int b, int& R, int& C) { const int st = b / 1024, sb = b % 1024, swz = sb ^ (((sb >> 9) & 1) << 5); R = (st >> 1) * 16 + swz / 64; C = (st & 1) * 32 + (swz % 64) / 2; }
__host__ __device__ __forceinline__ int perm32(int rho) { const int n = rho >> 4, i = rho & 15; return 8 * (i >> 2) + 4 * n + (i & 3); }

struct Unit { int pm, pn; };
struct Gemm { const bf16_t* A; const bf16_t* Bt; int M, N, K; };

struct StaticOrder {
    int nM, nN, nwg, G, c;
    __host__ __device__ void init(int M, int N, int G_, int c_) { nM = M / BM; nN = N / BM; nwg = nM * nN; G = G_; c = c_; }
    __host__ __device__ bool next(int i, Unit& u) const {
        const long L = (long)i * G + c; if (L >= nwg) return false;
        int wgid = (int)L; { const int q = nwg / NXCD, r = nwg % NXCD, xcd = wgid % NXCD, off = wgid / NXCD; wgid = (xcd < r ? xcd * (q + 1) : r * (q + 1) + (xcd - r) * q) + off; }
        const int nig = WGM * nN, gid = wgid / nig, fm = gid * WGM, gsz = (nM - fm) < WGM ? (nM - fm) : WGM;
        u.pm = fm + ((wgid % nig) % gsz); u.pn = (wgid % nig) / gsz; return true;
    }
    __device__ __forceinline__ void a_ready(const Unit&) const {}
    __device__ __forceinline__ void done(const Unit&) const {}
};

__device__ __forceinline__ unsigned cvt_pk_bf16(float lo, float hi) { unsigned r; asm volatile("v_cvt_pk_bf16_f32 %0, %1, %2" : "=v"(r) : "v"(lo), "v"(hi)); return r; }
template <class Epi, class Sched, bool ALIGN_EPI = false, bool SP2 = false>
__device__ __forceinline__ void gemm_phase(PG8_LAS unsigned char* lds, const Gemm g, const Sched& S, const Epi& E, const int wave_in) {
    unsigned z_ = 0u; asm volatile("" : "+v"(z_)); int w_ = wave_in; asm volatile("" : "+s"(w_));
    const int tid_ = w_ * 64 + (int)__builtin_amdgcn_mbcnt_hi(~0u, __builtin_amdgcn_mbcnt_lo(~0u, z_));
    const int tid = tid_, wid = __builtin_amdgcn_readfirstlane(tid >> 6), lane = tid & 63, wr = wid >> 2, wc = wid & 3, fr = lane & 15, fq = lane >> 4;
    const int K = g.K, nt = K / BK;
    unsigned voffA[2], voffB[2];
#pragma unroll
    for (int i = 0; i < 2; ++i) { int R, C; stage_rc(tid * 16 + i * 8192, R, C); const int Rb = Epi::PERM ? ((R & ~31) + perm32(R & 31)) : R;
        voffA[i] = (unsigned)(R * K + C) * 2u; voffB[i] = (unsigned)(Rb * K + C) * 2u; }
    const size_t kstep = (size_t)(BK * 2);
    const size_t hstep = (size_t)HALF * K * 2;
    const size_t tstep = 2 * hstep;
    const unsigned ldsw = (unsigned)wid * 1024u;
    const int aoff = lds_byte(wr * 64 + fr, fq * 8), boff = lds_byte(wc * 32 + fr, fq * 8);
#define PG8_SA(b, h) (((b) * 2 + (h)) * HTB)
#define PG8_SB(b, h) ((4 + (b) * 2 + (h)) * HTB)
#define PG8_STAGE(bufoff, gbase, voff) do { _Pragma("unroll") for (int _i = 0; _i < 2; ++_i) \
        __builtin_amdgcn_global_load_lds((const unsigned*)((const char*)(gbase) + (voff)[_i]), (PG8_LAS unsigned*)(lds + (bufoff) + ldsw + _i * 8192), 16, 0, 0); } while (0)
#define PG8_LDA(dst, b, h) do { _Pragma("unroll") for (int m = 0; m < 4; ++m) _Pragma("unroll") for (int k = 0; k < 2; ++k) dst[m][k] = *(const PG8_LAS bf16x8*)(lds + PG8_SA(b, h) + aoff + m * 2048 + k * 1024); } while (0)
#define PG8_LDB(dst, b, h) do { _Pragma("unroll") for (int n = 0; n < 2; ++n) _Pragma("unroll") for (int k = 0; k < 2; ++k) dst[n][k] = *(const PG8_LAS bf16x8*)(lds + PG8_SB(b, h) + boff + n * 2048 + k * 1024); } while (0)
#define PG8_MMA(ai, bj, At, Bt) do { __builtin_amdgcn_s_setprio(1); _Pragma("unroll") for (int m = 0; m < 4; ++m) _Pragma("unroll") for (int n = 0; n < 2; ++n) _Pragma("unroll") for (int k = 0; k < 2; ++k) \
        acc[ai][bj][m][n] = __builtin_amdgcn_mfma_f32_16x16x32_bf16(Bt[n][k], At[m][k], acc[ai][bj][m][n], 0, 0, 0); __builtin_amdgcn_s_setprio(0); } while (0)
#define PG8_WAIT_V(n) asm volatile("s_waitcnt vmcnt(" #n ")" ::: "memory")
#define PG8_WAIT_L(n) asm volatile("s_waitcnt lgkmcnt(" #n ")" ::: "memory")
#define PG8_BAR __builtin_amdgcn_s_barrier()
#define PG8_SCHED __builtin_amdgcn_sched_barrier(0)
    Unit cur, nxt; int ui = 0;
    if (!S.next(0, cur)) return;
    f32x4 acc[2][2][4][2];
#pragma unroll
    for (int a = 0; a < 2; ++a)
#pragma unroll
        for (int b = 0; b < 2; ++b)
#pragma unroll
            for (int m = 0; m < 4; ++m)
#pragma unroll
                for (int n = 0; n < 2; ++n) acc[a][b][m][n] = (f32x4){0.f, 0.f, 0.f, 0.f};
    bf16x8 At[4][2], B0[2][2], B1[2][2];
    const char* cA = (const char*)g.A + (size_t)cur.pm * tstep; const char* cB = (const char*)g.Bt + (size_t)cur.pn * tstep;
    S.a_ready(cur);
    if constexpr (SP2) {
        PG8_STAGE(PG8_SB(0, 0), cB, voffB); PG8_STAGE(PG8_SB(0, 1), cB + hstep, voffB); PG8_STAGE(PG8_SA(0, 0), cA, voffA); PG8_STAGE(PG8_SA(0, 1), cA + hstep, voffA);
        if (wr == 1) PG8_BAR;
        PG8_WAIT_V(2); PG8_BAR;
        PG8_STAGE(PG8_SB(1, 0), cB + kstep, voffB); PG8_STAGE(PG8_SA(1, 0), cA + kstep, voffA); PG8_STAGE(PG8_SB(1, 1), cB + hstep + kstep, voffB);
        PG8_WAIT_V(6); PG8_BAR;
    } else {
        PG8_STAGE(PG8_SB(0, 0), cB, voffB); PG8_STAGE(PG8_SA(0, 0), cA, voffA); PG8_STAGE(PG8_SB(0, 1), cB + hstep, voffB); PG8_STAGE(PG8_SA(0, 1), cA + hstep, voffA);
        if (wr == 1) PG8_BAR;
        PG8_WAIT_V(4); PG8_BAR;
        PG8_STAGE(PG8_SB(1, 0), cB + kstep, voffB); PG8_STAGE(PG8_SA(1, 0), cA + kstep, voffA); PG8_STAGE(PG8_SB(1, 1), cB + hstep + kstep, voffB);
        PG8_WAIT_V(6); PG8_BAR;
    }
    for (;;) {
        const bool has_next = S.next(ui + 1, nxt);
        const char* nA = has_next ? (const char*)g.A + (size_t)nxt.pm * tstep : cA; const char* nB = has_next ? (const char*)g.Bt + (size_t)nxt.pn * tstep : cB;
        for (int t = 0; t < nt; t += 2) {
            const bool last = (t == nt - 2);
            const char* a1 = cA + (size_t)(t + 1) * kstep;
            const char* a2 = last ? nA : cA + (size_t)(t + 2) * kstep; const char* b2 = last ? nB : cB + (size_t)(t + 2) * kstep;
            const char* a3 = a2 + kstep; const char* b3 = b2 + kstep;
            if (last && has_next) S.a_ready(nxt);
            if constexpr (SP2) {
            PG8_LDB(B0, 0, 0); PG8_LDB(B1, 0, 1); PG8_SCHED; PG8_LDA(At, 0, 0); PG8_STAGE(PG8_SA(1, 1), a1 + hstep, voffA);
            PG8_WAIT_V(8); PG8_WAIT_L(0); PG8_BAR; PG8_MMA(0, 0, At, B0); PG8_MMA(0, 1, At, B1); PG8_BAR; PG8_SCHED;
            PG8_LDA(At, 0, 1); PG8_STAGE(PG8_SB(0, 0), b2, voffB); PG8_STAGE(PG8_SB(0, 1), b2 + hstep, voffB); PG8_STAGE(PG8_SA(0, 0), a2, voffA);
            PG8_WAIT_V(8); PG8_WAIT_L(0); PG8_BAR; PG8_MMA(1, 0, At, B0); PG8_MMA(1, 1, At, B1); PG8_BAR; PG8_SCHED;
            PG8_LDB(B0, 1, 0); PG8_LDB(B1, 1, 1); PG8_SCHED; PG8_LDA(At, 1, 0); PG8_STAGE(PG8_SA(0, 1), a2 + hstep, voffA);
            PG8_WAIT_V(8); PG8_WAIT_L(0); PG8_BAR; PG8_MMA(0, 0, At, B0); PG8_MMA(0, 1, At, B1); PG8_BAR; PG8_SCHED;
            PG8_LDA(At, 1, 1); PG8_STAGE(PG8_SB(1, 0), b3, voffB); PG8_STAGE(PG8_SB(1, 1), b3 + hstep, voffB); PG8_STAGE(PG8_SA(1, 0), a3, voffA);
            PG8_WAIT_V(8); PG8_WAIT_L(0); PG8_BAR; PG8_MMA(1, 0, At, B0); PG8_MMA(1, 1, At, B1); PG8_BAR; PG8_SCHED;
            } else {
            PG8_LDB(B0, 0, 0); PG8_SCHED; PG8_LDA(At, 0, 0); PG8_STAGE(PG8_SA(1, 1), a1 + hstep, voffA);
            PG8_WAIT_L(8); PG8_BAR; PG8_WAIT_L(0); PG8_MMA(0, 0, At, B0); PG8_BAR; PG8_SCHED;
            PG8_LDB(B1, 0, 1); PG8_STAGE(PG8_SB(0, 0), b2, voffB);
            PG8_BAR; PG8_WAIT_L(0); PG8_MMA(0, 1, At, B1); PG8_BAR;
            PG8_LDA(At, 0, 1); PG8_STAGE(PG8_SA(0, 0), a2, voffA);
            PG8_BAR; PG8_WAIT_L(0); PG8_MMA(1, 0, At, B0); PG8_BAR; PG8_SCHED;
            PG8_STAGE(PG8_SB(0, 1), b2 + hstep, voffB);
            PG8_WAIT_V(6); PG8_BAR; PG8_MMA(1, 1, At, B1); PG8_BAR;
            PG8_LDB(B0, 1, 0); PG8_SCHED; PG8_LDA(At, 1, 0); PG8_STAGE(PG8_SA(0, 1), a2 + hstep, voffA);
            PG8_WAIT_L(8); PG8_BAR; PG8_WAIT_L(0); PG8_MMA(0, 0, At, B0); PG8_BAR; PG8_SCHED;
            PG8_LDB(B1, 1, 1); PG8_STAGE(PG8_SB(1, 0), b3, voffB);
            PG8_BAR; PG8_WAIT_L(0); PG8_MMA(0, 1, At, B1); PG8_BAR;
            PG8_LDA(At, 1, 1); PG8_STAGE(PG8_SA(1, 0), a3, voffA);
            PG8_BAR; PG8_WAIT_L(0); PG8_MMA(1, 0, At, B0); PG8_BAR; PG8_SCHED;
            PG8_STAGE(PG8_SB(1, 1), b3 + hstep, voffB);
            PG8_WAIT_V(6); PG8_BAR; PG8_MMA(1, 1, At, B1); PG8_BAR;
            }
        }
        if constexpr (ALIGN_EPI) { if (wr == 0) PG8_BAR; }
        if constexpr (!Epi::AFTER_DRAIN) { E(acc, cur, wr, wc, fr, fq); S.done(cur); }
        if (!has_next) break;
#pragma unroll
        for (int a = 0; a < 2; ++a)
#pragma unroll
            for (int b = 0; b < 2; ++b)
#pragma unroll
                for (int m = 0; m < 4; ++m)
#pragma unroll
                    for (int n = 0; n < 2; ++n) acc[a][b][m][n] = (f32x4){0.f, 0.f, 0.f, 0.f};
        cur = nxt; cA = nA; cB = nB; ++ui;
        if constexpr (ALIGN_EPI) { if (wr == 1) PG8_BAR; }
    }
    PG8_WAIT_V(0);
    if constexpr (!ALIGN_EPI) { if (wr == 0) PG8_BAR; }
    PG8_BAR;
    if constexpr (Epi::AFTER_DRAIN) { E.fused(acc, cur, wr, wc, fr, fq, lds, wid, lane); S.done(cur); }
#undef PG8_SA
#undef PG8_SB
#undef PG8_STAGE
#undef PG8_LDA
#undef PG8_LDB
#undef PG8_MMA
#undef PG8_WAIT_V
#undef PG8_WAIT_L
#undef PG8_BAR
#undef PG8_SCHED
}
}
#define LAS __attribute__((address_space(3)))
typedef unsigned short bf16;
typedef float f32x4 __attribute__((ext_vector_type(4)));
typedef float f32x16 __attribute__((ext_vector_type(16)));
typedef unsigned u32x4 __attribute__((ext_vector_type(4)));
typedef unsigned u32x2 __attribute__((ext_vector_type(2)));
typedef short s16x8 __attribute__((ext_vector_type(8)));

constexpr int NB = 8, SEQ = 4096, T = NB * SEQ, D = 1024, FF = 2816, DEPTH = 2, NIN = 7344, ZP = 3072, ZSP = 256;
constexpr int NTHR = 512, NWAVES = 8;
__host__ __device__ constexpr int col_dq(int l) { return l ? 2048 : 0; }
__host__ __device__ constexpr int col_dk(int l) { return l ? 2304 : 256; }
__host__ __device__ constexpr int col_sbk(int l) { return l ? 0 : 2048; }
constexpr int LDS_BYTES = 147456;
constexpr float EPS = 1e-6f;

constexpr size_t MiB = (size_t)1 << 20;
constexpr size_t WS_CTL = 0;
constexpr size_t WS_W = 1 * MiB, WL_STRIDE = 52 * MiB;
constexpr size_t WL_GU1 = 0, WL_D1 = 11534336, WL_INA = 17301504, WL_G = 24117248, WL_BR = 32505856, WL_OUT = 34603008, WL_GU2 = 36700160, WL_D2 = 48234496;
constexpr size_t WS_HN = 106 * MiB, WS_BIG = 170 * MiB, WS_ZS = 362 * MiB, WS_O = 394 * MiB, WS_IK = 458 * MiB, WS_END = 460 * MiB;
constexpr size_t OB_STRIDE = (size_t)T * 256 * 2;

struct Params {
    const float* x; const int* pos;
    const float *ffn1_norm, *ffn1_gu, *ffn1_down, *mix_norm, *w_in, *diff_qk_norm, *diff_lambda, *diff_head_norm, *ml_conv_w, *ml_conv_b, *ml_gate_bias, *ml_head_norm,
        *dsa_qk_norm, *w_branch, *w_out, *ffn2_norm, *ffn2_gu, *ffn2_down;
    float* out; unsigned char* ws;
};

__device__ __forceinline__ unsigned f2bf(float f) { unsigned u = __float_as_uint(f); return (u + 0x7fffu + ((u >> 16) & 1u)) >> 16; }
typedef float f32x2_t __attribute__((ext_vector_type(2)));
typedef __bf16 bf16x2_t __attribute__((ext_vector_type(2)));
__device__ __forceinline__ unsigned pk2(float lo, float hi) { const f32x2_t v = {lo, hi}; const bf16x2_t b = __builtin_convertvector(v, bf16x2_t); return __builtin_bit_cast(unsigned, b); }
__device__ __forceinline__ float bflo(unsigned w) { return __uint_as_float(w << 16); }
__device__ __forceinline__ float bfhi(unsigned w) { return __uint_as_float(w & 0xffff0000u); }
__device__ __forceinline__ float wave_sum(float v) {
#pragma unroll
    for (int o = 1; o < 64; o <<= 1) v += __shfl_xor(v, o);
    return v;
}
__device__ __forceinline__ float wave_max(float v) {
#pragma unroll
    for (int o = 1; o < 64; o <<= 1) v = fmaxf(v, __shfl_xor(v, o));
    return v;
}
__device__ __forceinline__ int lane_fresh() { unsigned z = 0u; asm volatile("" : "+v"(z)); return (int)__builtin_amdgcn_mbcnt_hi(~0u, __builtin_amdgcn_mbcnt_lo(~0u, z)); }
__device__ __forceinline__ int tid_fresh(int wv) { int w = wv; asm volatile("" : "+s"(w)); return w * 64 + lane_fresh(); }
#define LDS_WAIT() asm volatile("s_waitcnt lgkmcnt(0)" ::: "memory")
__device__ __forceinline__ float sigmoidf_(float x) { return __builtin_amdgcn_rcpf(1.f + __expf(-x)); }

__device__ __forceinline__ Params load_params() {
#if defined(__HIP_DEVICE_COMPILE__)
    const __attribute__((address_space(4))) Params* pp = (const __attribute__((address_space(4))) Params*)__builtin_amdgcn_kernarg_segment_ptr();
    asm volatile("" : "+s"(pp));
    Params r;
    r.x = pp->x; r.pos = pp->pos; r.ffn1_norm = pp->ffn1_norm; r.ffn1_gu = pp->ffn1_gu; r.ffn1_down = pp->ffn1_down; r.mix_norm = pp->mix_norm; r.w_in = pp->w_in; r.diff_qk_norm = pp->diff_qk_norm;
    r.diff_lambda = pp->diff_lambda; r.diff_head_norm = pp->diff_head_norm; r.ml_conv_w = pp->ml_conv_w; r.ml_conv_b = pp->ml_conv_b; r.ml_gate_bias = pp->ml_gate_bias; r.ml_head_norm = pp->ml_head_norm;
    r.dsa_qk_norm = pp->dsa_qk_norm; r.w_branch = pp->w_branch; r.w_out = pp->w_out; r.ffn2_norm = pp->ffn2_norm; r.ffn2_gu = pp->ffn2_gu; r.ffn2_down = pp->ffn2_down; r.out = pp->out; r.ws = pp->ws;
    return r;
#else
    return Params{};
#endif
}
typedef unsigned long long u64_t;
__device__ __forceinline__ u64_t* rs_ptr(const Params& p, int idx) { return (u64_t*)(p.ws + (idx < 3 ? (WS_CTL + 131072) : (105 * MiB))) + (size_t)(idx % 3) * T; }
__device__ __forceinline__ float row_rstd(const u64_t* rs, int row) { return __builtin_amdgcn_rsqf((float)rs[row] * (1.f / (16777216.f * D)) + EPS); }
struct EpiSwiglu {
    static constexpr bool PERM = true, AFTER_DRAIN = false;
    int rsi;
    __device__ __forceinline__ void operator()(const f32x4 (&acc)[2][2][4][2], const pg8::Unit& u, int wr, int wc, int fr_in, int fq_in) const {
        const int ln_ = lane_fresh(); const int fr = ln_ & 15, fq = ln_ >> 4; (void)fr_in; (void)fq_in;
        const Params p = load_params(); bf16* O = (bf16*)(p.ws + WS_BIG); const u64_t* rs = rs_ptr(p, rsi);
        const int row0 = u.pm * 256 + wr * 64 + fr, col0 = u.pn * 128 + wc * 32 + 8 * fq;
#pragma unroll
        for (int ai = 0; ai < 2; ++ai)
#pragma unroll
            for (int m = 0; m < 4; ++m) {
                const int row = row0 + ai * 128 + m * 16; const float rr = row_rstd(rs, row);
                bf16* rowp = O + (size_t)row * FF + col0;
                float r[8];
#pragma unroll
                for (int n = 0; n < 2; ++n)
#pragma unroll
                    for (int j = 0; j < 4; ++j) { const float g = acc[ai][0][m][n][j] * rr, uu = acc[ai][1][m][n][j] * rr; r[4 * n + j] = g * sigmoidf_(g) * uu; }
                u32x4 w; w.x = pk2(r[0], r[1]); w.y = pk2(r[2], r[3]); w.z = pk2(r[4], r[5]); w.w = pk2(r[6], r[7]);
                *(u32x4*)rowp = w;
            }
    }
};
struct EpiResid {
    static constexpr bool PERM = true, AFTER_DRAIN = false;
    int base_is_x; float scale; int rsi;
    __device__ __forceinline__ void operator()(const f32x4 (&acc)[2][2][4][2], const pg8::Unit& u, int wr, int wc, int fr_in, int fq_in) const {
        const int ln_ = lane_fresh(); const int fr = ln_ & 15, fq = ln_ >> 4; (void)fr_in; (void)fq_in;
        const Params p = load_params(); const float* base = base_is_x ? p.x : p.out; float* out = p.out; bf16* XB = (rsi >= 0) ? (bf16*)(p.ws + WS_HN) : (bf16*)nullptr; u64_t* rs = rs_ptr(p, rsi >= 0 ? rsi : 0);
        const int row0 = u.pm * 256 + wr * 64 + fr, col0 = u.pn * 256 + wc * 32 + 8 * fq;
#pragma unroll
        for (int ai = 0; ai < 2; ++ai)
#pragma unroll
            for (int m = 0; m < 4; ++m) {
                const int row = row0 + ai * 128 + m * 16; const size_t ro = (size_t)row * D + col0; float ss = 0.f;
#pragma unroll
                for (int bj = 0; bj < 2; ++bj) {
                    const f32x4 v0 = *(const f32x4*)(base + ro + bj * 128) + acc[ai][bj][m][0] * scale, v1 = *(const f32x4*)(base + ro + bj * 128 + 4) + acc[ai][bj][m][1] * scale;
                    *(f32x4*)(out + ro + bj * 128) = v0; *(f32x4*)(out + ro + bj * 128 + 4) = v1;
                    if (XB) { u32x4 w; w.x = pk2(v0[0], v0[1]); w.y = pk2(v0[2], v0[3]); w.z = pk2(v1[0], v1[1]); w.w = pk2(v1[2], v1[3]); *(u32x4*)(XB + ro + bj * 128) = w;
                        ss += (v0[0] * v0[0] + v0[1] * v0[1]) + (v0[2] * v0[2] + v0[3] * v0[3]) + (v1[0] * v1[0] + v1[1] * v1[1]) + (v1[2] * v1[2] + v1[3] * v1[3]); }
                }
                if (XB) { ss += __shfl_xor(ss, 16); ss += __shfl_xor(ss, 32); if (fq == 0) atomicAdd(rs + row, (u64_t)(ss * 16777216.f)); }
            }
    }
};
struct EpiZ {
    static constexpr bool PERM = true, AFTER_DRAIN = false;
    int rsi;
    __device__ __forceinline__ void operator()(const f32x4 (&acc)[2][2][4][2], const pg8::Unit& u, int wr, int wc, int fr_in, int fq_in) const {
        const int ln_ = lane_fresh(); const int fr = ln_ & 15, fq = ln_ >> 4; (void)fr_in; (void)fq_in;
        const Params p = load_params(); bf16* Z = (bf16*)(p.ws + WS_BIG); float* ZS = (float*)(p.ws + WS_ZS); const u64_t* rs = rs_ptr(p, rsi);
        const int row0 = u.pm * 256 + wr * 64 + fr, cw = wc * 32 + 8 * fq;
        if (u.pn < 12) {
#pragma unroll
            for (int ai = 0; ai < 2; ++ai)
#pragma unroll
                for (int m = 0; m < 4; ++m) {
                    const int row = row0 + ai * 128 + m * 16; const float rr = row_rstd(rs, row);
                    bf16* rowp = Z + (size_t)row * ZP + u.pn * 256 + cw;
#pragma unroll
                    for (int bj = 0; bj < 2; ++bj) { const f32x4 v0 = acc[ai][bj][m][0] * rr, v1 = acc[ai][bj][m][1] * rr;
                        u32x4 w; w.x = pk2(v0[0], v0[1]); w.y = pk2(v0[2], v0[3]); w.z = pk2(v1[0], v1[1]); w.w = pk2(v1[2], v1[3]);
                        *(u32x4*)(rowp + bj * 128) = w; }
                }
        } else {
#pragma unroll
            for (int ai = 0; ai < 2; ++ai)
#pragma unroll
                for (int m = 0; m < 4; ++m) {
                    const int row = row0 + ai * 128 + m * 16; const float rr = row_rstd(rs, row);
                    float* rowp = ZS + (size_t)row * ZSP + cw;
#pragma unroll
                    for (int bj = 0; bj < 2; ++bj)
#pragma unroll
                        for (int n = 0; n < 2; ++n) *(f32x4*)(rowp + bj * 128 + 4 * n) = acc[ai][bj][m][n] * rr;
                }
        }
    }
};
struct EpiSig {
    static constexpr bool PERM = true, AFTER_DRAIN = false;
    int rsi;
    __device__ __forceinline__ void operator()(const f32x4 (&acc)[2][2][4][2], const pg8::Unit& u, int wr, int wc, int fr_in, int fq_in) const {
        const int ln_ = lane_fresh(); const int fr = ln_ & 15, fq = ln_ >> 4; (void)fr_in; (void)fq_in;
        const Params p = load_params(); bf16* SG = (bf16*)(p.ws + WS_BIG); const u64_t* rs = rs_ptr(p, rsi);
        const int row0 = u.pm * 256 + wr * 64 + fr, col0 = u.pn * 256 + wc * 32 + 8 * fq;
#pragma unroll
        for (int ai = 0; ai < 2; ++ai)
#pragma unroll
            for (int m = 0; m < 4; ++m) {
                const int row = row0 + ai * 128 + m * 16; const float rr = row_rstd(rs, row);
                bf16* rowp = SG + (size_t)row * (2 * D) + col0;
#pragma unroll
                for (int bj = 0; bj < 2; ++bj) { const f32x4 v0 = acc[ai][bj][m][0] * rr, v1 = acc[ai][bj][m][1] * rr;
                    u32x4 w; w.x = pk2(sigmoidf_(v0[0]), sigmoidf_(v0[1])); w.y = pk2(sigmoidf_(v0[2]), sigmoidf_(v0[3]));
                    w.z = pk2(sigmoidf_(v1[0]), sigmoidf_(v1[1])); w.w = pk2(sigmoidf_(v1[2]), sigmoidf_(v1[3]));
                    *(u32x4*)(rowp + bj * 128) = w; }
            }
    }
};
struct EpiGate {
    static constexpr bool PERM = true, AFTER_DRAIN = false;
    int sgoff; int first;
    __device__ __forceinline__ void operator()(const f32x4 (&acc)[2][2][4][2], const pg8::Unit& u, int wr, int wc, int fr_in, int fq_in) const {
        const int ln_ = lane_fresh(); const int fr = ln_ & 15, fq = ln_ >> 4; (void)fr_in; (void)fq_in;
        const Params p = load_params(); const bf16* SG = (const bf16*)(p.ws + WS_BIG); bf16* YB = (bf16*)(p.ws + WS_BIG + 128 * MiB);
        const int row0 = u.pm * 256 + wr * 64 + fr, col0 = u.pn * 256 + wc * 32 + 8 * fq;
#pragma unroll
        for (int ai = 0; ai < 2; ++ai)
#pragma unroll
            for (int m = 0; m < 4; ++m) {
                const int row = row0 + ai * 128 + m * 16; const size_t ro = (size_t)row * D + col0, so = (size_t)row * (2 * D) + sgoff + col0;
#pragma unroll
                for (int bj = 0; bj < 2; ++bj) {
                    const u32x4 sg = *(const u32x4*)(SG + so + bj * 128);
                    f32x4 v0 = (f32x4){bflo(sg.x), bfhi(sg.x), bflo(sg.y), bfhi(sg.y)} * acc[ai][bj][m][0], v1 = (f32x4){bflo(sg.z), bfhi(sg.z), bflo(sg.w), bfhi(sg.w)} * acc[ai][bj][m][1];
                    if (!first) { const u32x4 y = *(const u32x4*)(YB + ro + bj * 128);
                        v0 = v0 + (f32x4){bflo(y.x), bfhi(y.x), bflo(y.y), bfhi(y.y)}; v1 = v1 + (f32x4){bflo(y.z), bfhi(y.z), bflo(y.w), bfhi(y.w)}; }
                    u32x4 w; w.x = pk2(v0[0], v0[1]); w.y = pk2(v0[2], v0[3]); w.z = pk2(v1[0], v1[1]); w.w = pk2(v1[2], v1[3]); *(u32x4*)(YB + ro + bj * 128) = w;
                }
            }
    }
};

template <class Epi>
__device__ __forceinline__ void run_gemm(LAS unsigned char* lds, const bf16* A, const bf16* Bt, int M, int N, int K, const Epi& E, int wv) {
    pg8::Gemm g{A, Bt, M, N, K}; pg8::StaticOrder S; S.init(M, N, (int)gridDim.x, (int)blockIdx.x);
    pg8::gemm_phase<Epi, pg8::StaticOrder, true, true>((PG8_LAS unsigned char*)lds, g, S, E, wv);
}

__device__ __forceinline__ void tr_item(const float* W, int K, int srcN, int c0, int nv, bf16* WT, int r0, int k0, LAS float* scr, int lane, const float* gain) {
    const int c = lane & 31;
    float tv[32];
#pragma unroll
    for (int i = 0; i < 32; ++i) { const int kk = 2 * i + (lane >> 5); tv[i] = (c < nv) ? W[(size_t)(k0 + kk) * srcN + c0 + c] * (gain ? gain[k0 + kk] : 1.f) : 0.f; }
#pragma unroll
    for (int i = 0; i < 32; ++i) { const int kk = 2 * i + (lane >> 5); scr[kk * 33 + c] = tv[i]; }
    LDS_WAIT();
    const int c8 = lane & 7;
#pragma unroll
    for (int j = 0; j < 4; ++j) { const int n = (lane >> 3) + 8 * j; const LAS float* s = scr + (8 * c8) * 33 + n;
        u32x4 o; o.x = pk2(s[0 * 33], s[1 * 33]); o.y = pk2(s[2 * 33], s[3 * 33]); o.z = pk2(s[4 * 33], s[5 * 33]); o.w = pk2(s[6 * 33], s[7 * 33]);
        if (n < nv) *(u32x4*)(WT + (size_t)(r0 + n) * K + k0 + 8 * c8) = o; }
    LDS_WAIT();
}
struct SegRun { int base, gw, ngw, lane; LAS float* scr; };
__device__ __forceinline__ void run_seg(SegRun& R, const float* W, int K, int srcN, int c0, int ncols, bf16* WT, int r0, const float* gain = nullptr) {
    const int nblk = (ncols + 31) >> 5, nitems = (K >> 6) * nblk;
    int first = (R.gw - (R.base % R.ngw) + R.ngw) % R.ngw;
    for (int it = first; it < nitems; it += R.ngw) { const int kb = it / nblk, nb = it - kb * nblk; const int nv = min(32, ncols - nb * 32);
        tr_item(W, K, srcN, c0 + nb * 32, nv, WT, r0 + nb * 32, kb * 64, R.scr, R.lane, gain); }
    R.base += nitems;
}
__device__ __forceinline__ void convert_weights(const Params& p, int l, SegRun& R) {
    unsigned char* wl = p.ws + WS_W + (size_t)l * WL_STRIDE;
    for (int f = 0; f < 2; ++f) {
        const float* gu = (f ? p.ffn2_gu : p.ffn1_gu) + (size_t)l * D * 2 * FF; bf16* gut = (bf16*)(wl + (f ? WL_GU2 : WL_GU1));
        const float* gn = (f ? p.ffn2_norm : p.ffn1_norm) + l * D;
        for (int sg = 0; sg < 44; ++sg) run_seg(R, gu, D, 2 * FF, sg * 128, 128, gut, (sg % 22) * 256 + (sg / 22) * 128, gn);
        const float* dn = (f ? p.ffn2_down : p.ffn1_down) + (size_t)l * FF * D; bf16* dnt = (bf16*)(wl + (f ? WL_D2 : WL_D1));
        run_seg(R, dn, FF, D, 0, D, dnt, 0);
    }
    const float* wi = p.w_in + (size_t)l * D * NIN; bf16* ina = (bf16*)(wl + WL_INA);
    run_seg(R, wi, D, NIN, 0, 256, ina, col_dq(l), p.mix_norm + l * D);
    run_seg(R, wi, D, NIN, 256, 256, ina, col_dk(l), p.mix_norm + l * D);
    run_seg(R, wi, D, NIN, 512, 256, ina, 512, p.mix_norm + l * D);
    run_seg(R, wi, D, NIN, 768, 512, ina, 768, p.mix_norm + l * D);
    run_seg(R, wi, D, NIN, 1280, 256, ina, 1280, p.mix_norm + l * D);
    run_seg(R, wi, D, NIN, 1544, 256, ina, 1536, p.mix_norm + l * D);
    run_seg(R, wi, D, NIN, 1800, 256, ina, 1792, p.mix_norm + l * D);
    run_seg(R, wi, D, NIN, 2056, 256, ina, col_sbk(l), p.mix_norm + l * D);
    run_seg(R, wi, D, NIN, 2312, 256, ina, col_sbk(l) + 256, p.mix_norm + l * D);
    run_seg(R, wi, D, NIN, 2568, 256, ina, 2560, p.mix_norm + l * D);
    run_seg(R, wi, D, NIN, 2952, 256, ina, 2816, p.mix_norm + l * D);
    run_seg(R, wi, D, NIN, 2824, 128, ina, 3072, p.mix_norm + l * D);
    run_seg(R, wi, D, NIN, 3208, 40, ina, 3200, p.mix_norm + l * D);
    run_seg(R, wi, D, NIN, 1536, 8, ina, 3240, p.mix_norm + l * D);
    run_seg(R, wi, D, NIN, 3248, 4096, (bf16*)(wl + WL_G), 0, p.mix_norm + l * D);
    for (int b = 0; b < 4; ++b) run_seg(R, p.w_branch + ((size_t)l * 4 + b) * 256 * D, 256, D, 0, D, (bf16*)(wl + WL_BR) + (size_t)b * D * 256, 0);
    run_seg(R, p.w_out + (size_t)l * D * D, D, D, 0, D, (bf16*)(wl + WL_OUT), 0);
    for (int i = R.gw * 64 + R.lane; i < 80 * 128; i += R.ngw * 64) *((u32x4*)(ina + (size_t)3248 * D) + i) = (u32x4){0u, 0u, 0u, 0u};
}

__device__ __forceinline__ void xb_rows(const float* X, bf16* XB, u64_t* rs, int gw, int ngw, int lane) {
    for (int m = gw; m < T; m += ngw) {
        const f32x4* xr = (const f32x4*)(X + (size_t)m * D) + lane;
        f32x4 v[4]; float s = 0.f;
#pragma unroll
        for (int j = 0; j < 4; ++j) { v[j] = xr[64 * j]; s += (v[j].x * v[j].x + v[j].y * v[j].y) + (v[j].z * v[j].z + v[j].w * v[j].w); }
        s = wave_sum(s);
        unsigned long long* o8 = (unsigned long long*)(XB + (size_t)m * D) + lane;
#pragma unroll
        for (int j = 0; j < 4; ++j) o8[64 * j] = (unsigned long long)pk2(v[j].x, v[j].y) | ((unsigned long long)pk2(v[j].z, v[j].w) << 32);
        if (lane == 0) rs[m] = (u64_t)(s * 16777216.f);
    }
}

__device__ __forceinline__ void sincos_red(float ang, float& sn, float& cs) {
    const float n = rintf(ang * 0.15915494309189535f);
    float r = fmaf(-n, 6.28125f, ang); r = fmaf(-n, 0.0019353071795864769f, r);
    sn = __sinf(r); cs = __cosf(r);
}
template <int HALF>
__device__ __forceinline__ void rope4(float (&v)[4], int sl, float pos) {
    constexpr int LH = HALF / 4;
    float pv[4];
#pragma unroll
    for (int j = 0; j < 4; ++j) pv[j] = __shfl_xor(v[j], LH);
    if (sl < 2 * LH) {
        const bool first = sl < LH; const int i0 = (sl & (LH - 1)) * 4;
#pragma unroll
        for (int j = 0; j < 4; ++j) {
            constexpr float I4[4] = {1.0f, 0.03760603070259094f, 0.0014142135623842478f, 5.318296098266728e-05f};
            constexpr float I8[8] = {1.0f, 0.1939227432012558f, 0.03760603070259094f, 0.007292664609849453f, 0.0014142135623842478f, 0.00027424818836152554f, 5.318296098266728e-05f, 1.0313386155758053e-05f};
            const float inv = (HALF == 4) ? I4[j] : (i0 ? I8[4 + j] : I8[j]);
            float sn, cs; sincos_red(pos * inv, sn, cs);
            v[j] = first ? (v[j] * cs - pv[j] * sn) : (pv[j] * sn + v[j] * cs);
        }
    }
}
__device__ __forceinline__ void prep_phase(const Params& p, int l, int gw, int ngw, int lane) {
    bf16* Z = (bf16*)(p.ws + WS_BIG); float* ZS = (float*)(p.ws + WS_ZS); bf16* IK = (bf16*)(p.ws + WS_IK);
    const float* dg = p.diff_qk_norm + l * 64; const float* sg = p.dsa_qk_norm + l * 128;
    for (int tok = gw; tok < T; tok += ngw) {
        const float pos = (float)p.pos[tok];
#pragma unroll
        for (int which = 0; which < 2; ++which) {
            unsigned long long* ptr = (unsigned long long*)(Z + (size_t)tok * ZP + (which ? col_dk(l) : col_dq(l))) + lane;
            const unsigned long long w = *ptr; float v[4] = {bflo((unsigned)w), bfhi((unsigned)w), bflo((unsigned)(w >> 32)), bfhi((unsigned)(w >> 32))};
            float ss = (v[0] * v[0] + v[1] * v[1]) + (v[2] * v[2] + v[3] * v[3]);
            ss += __shfl_xor(ss, 1); ss += __shfl_xor(ss, 2); ss += __shfl_xor(ss, 4);
            const float r = 1.f / sqrtf(ss * (1.f / 32.f) + EPS);
            const f32x4 g = *(const f32x4*)(dg + which * 32 + (lane & 7) * 4);
#pragma unroll
            for (int j = 0; j < 4; ++j) v[j] = v[j] * r * g[j];
            rope4<4>(v, lane & 7, pos);
            if (which == 0) {
#pragma unroll
                for (int j = 0; j < 4; ++j) v[j] *= 0.17677669529663687f;
            }
            *ptr = (unsigned long long)pk2(v[0], v[1]) | ((unsigned long long)pk2(v[2], v[3]) << 32);
        }
        {
            unsigned long long* ptr = (unsigned long long*)(Z + (size_t)tok * ZP + 2560) + lane;
            const unsigned long long w = *ptr; float v[4] = {bflo((unsigned)w), bfhi((unsigned)w), bflo((unsigned)(w >> 32)), bfhi((unsigned)(w >> 32))};
            float ss = (v[0] * v[0] + v[1] * v[1]) + (v[2] * v[2] + v[3] * v[3]);
            ss += __shfl_xor(ss, 1); ss += __shfl_xor(ss, 2); ss += __shfl_xor(ss, 4); ss += __shfl_xor(ss, 8);
            const float r = 1.f / sqrtf(ss * (1.f / 64.f) + EPS);
            const f32x4 g = *(const f32x4*)(sg + (lane & 15) * 4);
#pragma unroll
            for (int j = 0; j < 4; ++j) v[j] = v[j] * r * g[j];
            rope4<8>(v, lane & 15, pos);
#pragma unroll
            for (int j = 0; j < 4; ++j) v[j] *= 0.125f;
            *ptr = (unsigned long long)pk2(v[0], v[1]) | ((unsigned long long)pk2(v[2], v[3]) << 32);
        }
        {
            unsigned long long* ptr = (unsigned long long*)(Z + (size_t)tok * ZP + 2816) + lane;
            const unsigned long long w = *ptr; float v[4] = {bflo((unsigned)w), bfhi((unsigned)w), bflo((unsigned)(w >> 32)), bfhi((unsigned)(w >> 32))};
            rope4<4>(v, lane & 7, pos);
            *ptr = (unsigned long long)pk2(v[0], v[1]) | ((unsigned long long)pk2(v[2], v[3]) << 32);
        }
        {
            float* ptr = ZS + (size_t)tok * ZSP + (lane & 15) * 4;
            const f32x4 x = *(const f32x4*)ptr; float v[4] = {x[0], x[1], x[2], x[3]};
            float ss = (v[0] * v[0] + v[1] * v[1]) + (v[2] * v[2] + v[3] * v[3]);
            ss += __shfl_xor(ss, 1); ss += __shfl_xor(ss, 2); ss += __shfl_xor(ss, 4); ss += __shfl_xor(ss, 8);
            const float r = 1.f / sqrtf(ss * (1.f / 64.f) + EPS);
            const f32x4 g = *(const f32x4*)(sg + 64 + (lane & 15) * 4);
#pragma unroll
            for (int j = 0; j < 4; ++j) v[j] = v[j] * r * g[j];
            rope4<8>(v, lane & 15, pos);
            if (lane < 16) *(f32x4*)ptr = (f32x4){v[0], v[1], v[2], v[3]};
        }
        {
            const float* ptr = ZS + (size_t)tok * ZSP + 128 + (lane & 7) * 4;
            const f32x4 x = *(const f32x4*)ptr; float v[4] = {x[0], x[1], x[2], x[3]};
            rope4<4>(v, lane & 7, pos);
            if (lane < 8) *((unsigned long long*)(IK + (size_t)tok * 32) + lane) = (unsigned long long)pk2(v[0], v[1]) | ((unsigned long long)pk2(v[2], v[3]) << 32);
        }
    }
}
__device__ __forceinline__ void mlstm_item(const Params& p, int l, int bh, LAS unsigned char* lds, int wv) {
    const int tid = tid_fresh(wv), lane = tid & 63, b = bh >> 2, h = bh & 3;
    const bf16* Z = (const bf16*)(p.ws + WS_BIG); const float* ZS = (const float*)(p.ws + WS_ZS); bf16* O1 = (bf16*)(p.ws + WS_O + OB_STRIDE);
    LAS float* nv = (LAS float*)lds; LAS float* bc = nv + 64; LAS float* igs = bc + 64; LAS float* wks = igs + 64; LAS float* sc = wks + 64;
    LAS float* Qs = sc + 64; LAS float* Ks = Qs + 64 * 65; LAS float* Vs = Ks + 64 * 65; LAS float* Ss = Vs + 64 * 65; LAS float* Cs = Ss + 64 * 65;
    for (int i = tid; i < 64 * 65; i += NTHR) Cs[i] = 0.f;
    if (tid < 64) nv[tid] = 0.f;
    float mcar = 0.f;
    const int r = tid >> 3, sg = tid & 7;
    const int cc0 = sg * 16; const int ch0 = (cc0 < 64) ? (h * 64 + cc0) : (256 + h * 64 + cc0 - 64);
    const float* cw0 = p.ml_conv_w + (size_t)l * 4 * 512; const float* cb0 = p.ml_conv_b + (size_t)l * 512;
    const int zc0 = (cc0 < 64) ? (768 + h * 64 + cc0) : (1024 + h * 64 + cc0 - 64);
    const float gb_i = p.ml_gate_bias[(l * 2 + 0) * 4 + h], gb_f = p.ml_gate_bias[(l * 2 + 1) * 4 + h];
    const float qsc = (cc0 < 64) ? 0.125f : 1.0f;
    __syncthreads();
    for (int c = 0; c < 64; ++c) {
        const int t0 = c * 64; const size_t tok0 = (size_t)b * SEQ + t0;
        const float* cw = cw0; const float* cb = cb0; asm volatile("" : "+s"(cw), "+s"(cb));
        {
            float y[16];
#pragma unroll
            for (int i = 0; i < 16; ++i) y[i] = cb[ch0 + i];
#pragma unroll
            for (int j = 0; j < 4; ++j) {
                const int tt = t0 + r - 3 + j;
                if (tt >= 0) {
                    const u32x4* xp = (const u32x4*)(Z + ((size_t)b * SEQ + tt) * ZP + zc0); const u32x4 x0 = xp[0], x1 = xp[1];
                    const float xv[16] = {bflo(x0.x), bfhi(x0.x), bflo(x0.y), bfhi(x0.y), bflo(x0.z), bfhi(x0.z), bflo(x0.w), bfhi(x0.w),
                                          bflo(x1.x), bfhi(x1.x), bflo(x1.y), bfhi(x1.y), bflo(x1.z), bfhi(x1.z), bflo(x1.w), bfhi(x1.w)};
#pragma unroll
                    for (int i = 0; i < 16; ++i) y[i] = fmaf(cw[j * 512 + ch0 + i], xv[i], y[i]);
                }
            }
            LAS float* dst = (cc0 < 64) ? (Qs + r * 65 + cc0) : (Ks + r * 65 + cc0 - 64);
#pragma unroll
            for (int i = 0; i < 16; ++i) dst[i] = y[i] * sigmoidf_(y[i]) * qsc;
            const u32x4 vv = *(const u32x4*)(Z + (tok0 + r) * ZP + 1280 + h * 64 + sg * 8);
            LAS float* vd = Vs + r * 65 + sg * 8;
            vd[0] = bflo(vv.x); vd[1] = bfhi(vv.x); vd[2] = bflo(vv.y); vd[3] = bfhi(vv.y); vd[4] = bflo(vv.z); vd[5] = bfhi(vv.z); vd[6] = bflo(vv.w); vd[7] = bfhi(vv.w);
        }
        if (tid < 64) {
            const float ig = ZS[(tok0 + tid) * ZSP + 168 + h] + gb_i;
            const float fz = ZS[(tok0 + tid) * ZSP + 172 + h] + gb_f;
            const float lf = fminf(fz, 0.f) - log1pf(__expf(-fabsf(fz)));
            float bsum = lf;
#pragma unroll
            for (int d = 1; d < 64; d <<= 1) { const float n = __shfl_up(bsum, d); if (lane >= d) bsum += n; }
            const float bl = __shfl(bsum, 63);
            const float g = bl - bsum + ig;
            const float mnew = fmaxf(bl + mcar, wave_max(g));
            bc[tid] = bsum; igs[tid] = ig; wks[tid] = __expf(g - mnew);
            if (tid == 0) { sc[0] = mnew; sc[1] = __expf(bl + mcar - mnew); sc[2] = bl; }
        }
        __syncthreads();
        const float bt = bc[r];
        float mx = -INFINITY;
#pragma unroll
        for (int i = 0; i < 8; ++i) { const int s = sg * 8 + i; const float dli = (s <= r) ? (bt - bc[s] + igs[s]) : -INFINITY; mx = fmaxf(mx, dli); }
        mx = fmaxf(mx, __shfl_xor(mx, 1)); mx = fmaxf(mx, __shfl_xor(mx, 2)); mx = fmaxf(mx, __shfl_xor(mx, 4));
        const float inter = bt + mcar; const float mt = fmaxf(inter, mx); const float iw = __expf(inter - mt);
        float ssum = 0.f;
#pragma unroll 1
        for (int i = 0; i < 8; ++i) { const int s = sg * 8 + i; float dot = 0.f;
#pragma unroll 16
            for (int d = 0; d < 64; ++d) dot = fmaf(Qs[r * 65 + d], Ks[s * 65 + d], dot);
            const float dli = (s <= r) ? (bt - bc[s] + igs[s]) : -INFINITY;
            const float sv = dot * __expf(dli - mt); Ss[r * 65 + s] = sv; ssum += sv; }
        ssum += __shfl_xor(ssum, 1); ssum += __shfl_xor(ssum, 2); ssum += __shfl_xor(ssum, 4);
        float qn = 0.f;
#pragma unroll
        for (int d = 0; d < 64; ++d) qn = fmaf(Qs[r * 65 + d], nv[d], qn);
        const float den = iw * qn + ssum;
        __syncthreads();
        {
            float num[8];
#pragma unroll
            for (int i = 0; i < 8; ++i) num[i] = 0.f;
#pragma unroll 8
            for (int d = 0; d < 64; ++d) { const float qd = Qs[r * 65 + d];
#pragma unroll
                for (int i = 0; i < 8; ++i) num[i] = fmaf(qd, Cs[d * 65 + sg * 8 + i], num[i]); }
#pragma unroll
            for (int i = 0; i < 8; ++i) num[i] *= iw;
#pragma unroll 8
            for (int s = 0; s < 64; ++s) { const float sv = Ss[r * 65 + s];
#pragma unroll
                for (int i = 0; i < 8; ++i) num[i] = fmaf(sv, Vs[s * 65 + sg * 8 + i], num[i]); }
            const float dn = 1.f / fmaxf(fabsf(den), __expf(-mt));
            float hs = 0.f;
#pragma unroll
            for (int i = 0; i < 8; ++i) { num[i] *= dn; hs = fmaf(num[i], num[i], hs); }
            hs += __shfl_xor(hs, 1); hs += __shfl_xor(hs, 2); hs += __shfl_xor(hs, 4);
            const float rr = 1.f / sqrtf(hs * (1.f / 64.f) + EPS);
            const u32x4 og = *(const u32x4*)(Z + (tok0 + r) * ZP + 1536 + h * 64 + sg * 8);
            const float ogv[8] = {bflo(og.x), bfhi(og.x), bflo(og.y), bfhi(og.y), bflo(og.z), bfhi(og.z), bflo(og.w), bfhi(og.w)};
            const float* hg = p.ml_head_norm + l * 64 + sg * 8;
            float o[8];
#pragma unroll
            for (int i = 0; i < 8; ++i) o[i] = sigmoidf_(ogv[i]) * (num[i] * rr * hg[i]);
            u32x4 w; w.x = pk2(o[0], o[1]); w.y = pk2(o[2], o[3]); w.z = pk2(o[4], o[5]); w.w = pk2(o[6], o[7]);
            *(u32x4*)(O1 + (tok0 + r) * 256 + h * 64 + sg * 8) = w;
        }
        __syncthreads();
        {
            const float decay = sc[1];
            float cacc[8]; float nacc = 0.f;
#pragma unroll
            for (int i = 0; i < 8; ++i) cacc[i] = 0.f;
#pragma unroll 8
            for (int s = 0; s < 64; ++s) { const float kw = wks[s] * Ks[s * 65 + r]; nacc += kw;
#pragma unroll
                for (int i = 0; i < 8; ++i) cacc[i] = fmaf(kw, Vs[s * 65 + sg * 8 + i], cacc[i]); }
#pragma unroll
            for (int i = 0; i < 8; ++i) Cs[r * 65 + sg * 8 + i] = decay * Cs[r * 65 + sg * 8 + i] + cacc[i];
            if (sg == 0) nv[r] = decay * nv[r] + nacc;
            mcar = sc[0];
        }
        __syncthreads();
    }
}

__device__ __forceinline__ void diff_item(const Params& p, int l, int bh, int qt, LAS unsigned char* lds, int wv) {
    const int tid = tid_fresh(wv), b = bh >> 2, h = bh & 3, q0 = qt * 128;
    const bf16* Z = (const bf16*)(p.ws + WS_BIG); bf16* O0 = (bf16*)(p.ws + WS_O);
    LAS float* Kt = (LAS float*)lds; LAS float* Vt = Kt + 64 * 64;
    const int ql = tid >> 2, part = tid & 3, c = part & 1, dvh = part >> 1, t = q0 + ql; const size_t tok = (size_t)b * SEQ + t;
    const float* lp = p.diff_lambda + l * 128; float s01 = 0.f, s23 = 0.f, gqm = 0.f, gkm = 0.f;
#pragma unroll 2
    for (int i = 0; i < 32; ++i) { s01 = fmaf(lp[i], lp[32 + i], s01); s23 = fmaf(lp[64 + i], lp[96 + i], s23);
        gqm = fmaxf(gqm, fabsf(p.diff_qk_norm[l * 64 + i])); gkm = fmaxf(gkm, fabsf(p.diff_qk_norm[l * 64 + 32 + i])); }
    const float lam_init = 0.8f - 0.6f * __expf(-0.3f * (float)l); const float lam = __expf(s01) - __expf(s23) + lam_init;
    const float coff = 5.65685424949238f * gqm * gkm;
    float q[32], o[32];
    { const u32x4* qp = (const u32x4*)(Z + tok * ZP + h * 64 + c * 32);
#pragma unroll
      for (int i = 0; i < 4; ++i) { const u32x4 w = qp[i]; q[8 * i] = bflo(w.x); q[8 * i + 1] = bfhi(w.x); q[8 * i + 2] = bflo(w.y); q[8 * i + 3] = bfhi(w.y); q[8 * i + 4] = bflo(w.z); q[8 * i + 5] = bfhi(w.z); q[8 * i + 6] = bflo(w.w); q[8 * i + 7] = bfhi(w.w); } }
#pragma unroll
    for (int i = 0; i < 32; ++i) o[i] = 0.f;
    float lsum = 0.f;
    const int nkt = (q0 + 128) / 64;
    const int lk = tid >> 3, lsg = tid & 7;
    for (int kt = 0; kt < nkt; ++kt) {
        __syncthreads();
        { const size_t ktok = (size_t)b * SEQ + kt * 64 + lk;
          const bf16* src = Z + ktok * ZP + ((lsg < 4) ? (256 + h * 64 + lsg * 16) : (512 + h * 64 + (lsg - 4) * 16));
          const u32x4 x0 = ((const u32x4*)src)[0], x1 = ((const u32x4*)src)[1];
          LAS float* dst = ((lsg < 4) ? (Kt + lk * 64 + lsg * 16) : (Vt + lk * 64 + (lsg - 4) * 16));
          *(LAS f32x4*)(dst) = (f32x4){bflo(x0.x), bfhi(x0.x), bflo(x0.y), bfhi(x0.y)}; *(LAS f32x4*)(dst + 4) = (f32x4){bflo(x0.z), bfhi(x0.z), bflo(x0.w), bfhi(x0.w)};
          *(LAS f32x4*)(dst + 8) = (f32x4){bflo(x1.x), bfhi(x1.x), bflo(x1.y), bfhi(x1.y)}; *(LAS f32x4*)(dst + 12) = (f32x4){bflo(x1.z), bfhi(x1.z), bflo(x1.w), bfhi(x1.w)}; }
        __syncthreads();
        const int kmax = t - kt * 64 + 1;
        for (int key = 0; key < 64; ++key) {
            const LAS f32x4* kr = (const LAS f32x4*)(Kt + key * 64 + c * 32);
            float s = 0.f;
#pragma unroll
            for (int i = 0; i < 8; ++i) { const f32x4 kv = kr[i]; s = fmaf(q[4 * i], kv[0], s); s = fmaf(q[4 * i + 1], kv[1], s); s = fmaf(q[4 * i + 2], kv[2], s); s = fmaf(q[4 * i + 3], kv[3], s); }
            const float pe = (key < kmax) ? __expf(s - coff) : 0.f;
            lsum += pe;
            const LAS f32x4* vr = (const LAS f32x4*)(Vt + key * 64 + dvh * 32);
#pragma unroll
            for (int i = 0; i < 8; ++i) { const f32x4 vv = vr[i]; o[4 * i] = fmaf(pe, vv[0], o[4 * i]); o[4 * i + 1] = fmaf(pe, vv[1], o[4 * i + 1]); o[4 * i + 2] = fmaf(pe, vv[2], o[4 * i + 2]); o[4 * i + 3] = fmaf(pe, vv[3], o[4 * i + 3]); }
        }
    }
    const float inv = 1.f / lsum; float ss = 0.f;
#pragma unroll
    for (int i = 0; i < 32; ++i) { const float my = o[i] * inv; const float ot = __shfl_xor(my, 1); o[i] = (c == 0) ? (my - lam * ot) : (ot - lam * my); ss = fmaf(o[i], o[i], ss); }
    ss += __shfl_xor(ss, 2);
    const float rr = (1.f - lam_init) / sqrtf(ss * (1.f / 64.f) + EPS);
    if (c == 0) {
        const float* hg = p.diff_head_norm + l * 64 + dvh * 32; u32x4* dst = (u32x4*)(O0 + tok * 256 + h * 64 + dvh * 32);
#pragma unroll
        for (int i = 0; i < 4; ++i) { u32x4 w; w.x = pk2(o[8 * i] * rr * hg[8 * i], o[8 * i + 1] * rr * hg[8 * i + 1]); w.y = pk2(o[8 * i + 2] * rr * hg[8 * i + 2], o[8 * i + 3] * rr * hg[8 * i + 3]);
            w.z = pk2(o[8 * i + 4] * rr * hg[8 * i + 4], o[8 * i + 5] * rr * hg[8 * i + 5]); w.w = pk2(o[8 * i + 6] * rr * hg[8 * i + 6], o[8 * i + 7] * rr * hg[8 * i + 7]); dst[i] = w; }
    }
    __syncthreads();
}

__device__ __forceinline__ unsigned pkbf(float lo, float hi) { return pk2(lo, hi); }
__device__ __forceinline__ void diffm_item(const Params& p, int l, int bh, int qb, LAS unsigned char* lds, int wv) {
    const int tid = tid_fresh(wv), lane = tid & 63, half = lane >> 5, r32 = lane & 31, b = bh >> 2, h = bh & 3;
    const bf16* Z = (const bf16*)(p.ws + WS_BIG); bf16* O0 = (bf16*)(p.ws + WS_O);
    LAS bf16* Ks = (LAS bf16*)lds; LAS bf16* Vt = Ks + 64 * 72;
    const float* lp = p.diff_lambda + l * 128; float s01 = 0.f, s23 = 0.f, gqm = 0.f, gkm = 0.f;
#pragma unroll 2
    for (int i = 0; i < 32; ++i) { s01 = fmaf(lp[i], lp[32 + i], s01); s23 = fmaf(lp[64 + i], lp[96 + i], s23);
        gqm = fmaxf(gqm, fabsf(p.diff_qk_norm[l * 64 + i])); gkm = fmaxf(gkm, fabsf(p.diff_qk_norm[l * 64 + 32 + i])); }
    const float lam_init = 0.8f - 0.6f * __expf(-0.3f * (float)l); const float lam = __expf(s01) - __expf(s23) + lam_init;
    const float coff = 5.65685424949238f * gqm * gkm;
    const int qw = qb * 256 + 32 * wv;
    const size_t tokb = (size_t)b * SEQ;
    s16x8 qf[2][2];
    { const bf16* qp = Z + (tokb + qw + r32) * ZP + col_dq(l) + h * 64 + half * 8;
#pragma unroll
      for (int c = 0; c < 2; ++c)
#pragma unroll
          for (int s = 0; s < 2; ++s) qf[c][s] = *(const s16x8*)(qp + c * 32 + 16 * s); }
    f32x16 oacc[2][2];
#pragma unroll
    for (int c = 0; c < 2; ++c)
#pragma unroll
        for (int db = 0; db < 2; ++db)
#pragma unroll
            for (int r = 0; r < 16; ++r) oacc[c][db][r] = 0.f;
    float ls0 = 0.f, ls1 = 0.f;
    const int nt = (qb + 1) * 4;
    const int kkey = tid >> 3, kch = tid & 7, vkey = tid & 63, vdc = tid >> 6;
    const bf16* kgp = Z + (tokb + kkey) * ZP + col_dk(l) + h * 64 + kch * 8;
    const bf16* vgp = Z + (tokb + vkey) * ZP + 512 + h * 64 + vdc * 8;
    u32x4 kreg = *(const u32x4*)kgp, vreg = *(const u32x4*)vgp;
#pragma unroll 1
    for (int t = 0; t < nt; ++t) {
        __syncthreads();
        *(LAS u32x4*)(Ks + kkey * 72 + kch * 8) = kreg;
        { LAS bf16* vd = Vt + (vdc * 8) * 72 + vkey;
          vd[0] = (bf16)(vreg.x & 0xffffu); vd[72] = (bf16)(vreg.x >> 16); vd[144] = (bf16)(vreg.y & 0xffffu); vd[216] = (bf16)(vreg.y >> 16);
          vd[288] = (bf16)(vreg.z & 0xffffu); vd[360] = (bf16)(vreg.z >> 16); vd[432] = (bf16)(vreg.w & 0xffffu); vd[504] = (bf16)(vreg.w >> 16); }
        __syncthreads();
        if (t + 1 < nt) { kreg = *(const u32x4*)(kgp + (size_t)(t + 1) * 64 * ZP); vreg = *(const u32x4*)(vgp + (size_t)(t + 1) * 64 * ZP); }
        const int k0 = t * 64;
#pragma unroll
        for (int sub = 0; sub < 2; ++sub) {
            const int kb = k0 + 32 * sub;
            if (kb <= qw + 31) {
                f32x16 s0, s1;
#pragma unroll
                for (int r = 0; r < 16; ++r) { s0[r] = 0.f; s1[r] = 0.f; }
                const LAS bf16* kr = Ks + (32 * sub + r32) * 72 + 8 * half;
#pragma unroll
                for (int s = 0; s < 2; ++s) {
                    const s16x8 a0 = *(const LAS s16x8*)(kr + 16 * s), a1 = *(const LAS s16x8*)(kr + 32 + 16 * s);
                    s0 = __builtin_amdgcn_mfma_f32_32x32x16_bf16(a0, qf[0][s], s0, 0, 0, 0);
                    s1 = __builtin_amdgcn_mfma_f32_32x32x16_bf16(a1, qf[1][s], s1, 0, 0, 0);
                }
                const bool diag = (kb + 31 > qw);
#pragma unroll
                for (int r = 0; r < 16; ++r) {
                    float p0 = __expf(s0[r] - coff), p1 = __expf(s1[r] - coff);
                    if (diag) { const int key = kb + 8 * (r >> 2) + 4 * half + (r & 3); if (key > qw + r32) { p0 = 0.f; p1 = 0.f; } }
                    ls0 += p0; ls1 += p1; s0[r] = p0; s1[r] = p1;
                }
#pragma unroll
                for (int s = 0; s < 2; ++s) {
                    u32x4 w0, w1;
                    w0.x = pkbf(s0[8 * s], s0[8 * s + 1]); w0.y = pkbf(s0[8 * s + 2], s0[8 * s + 3]); w0.z = pkbf(s0[8 * s + 4], s0[8 * s + 5]); w0.w = pkbf(s0[8 * s + 6], s0[8 * s + 7]);
                    w1.x = pkbf(s1[8 * s], s1[8 * s + 1]); w1.y = pkbf(s1[8 * s + 2], s1[8 * s + 3]); w1.z = pkbf(s1[8 * s + 4], s1[8 * s + 5]); w1.w = pkbf(s1[8 * s + 6], s1[8 * s + 7]);
                    const s16x8 pf0 = __builtin_bit_cast(s16x8, w0), pf1 = __builtin_bit_cast(s16x8, w1);
#pragma unroll
                    for (int db = 0; db < 2; ++db) {
                        const LAS bf16* vr = Vt + (db * 32 + r32) * 72 + 32 * sub + 16 * s + 4 * half;
                        const u32x2 v0 = *(const LAS u32x2*)vr, v1 = *(const LAS u32x2*)(vr + 8);
                        const u32x4 vv = (u32x4){v0.x, v0.y, v1.x, v1.y};
                        const s16x8 vf = __builtin_bit_cast(s16x8, vv);
                        oacc[0][db] = __builtin_amdgcn_mfma_f32_32x32x16_bf16(vf, pf0, oacc[0][db], 0, 0, 0);
                        oacc[1][db] = __builtin_amdgcn_mfma_f32_32x32x16_bf16(vf, pf1, oacc[1][db], 0, 0, 0);
                    }
                }
            }
        }
    }
    ls0 += __shfl_xor(ls0, 32); ls1 += __shfl_xor(ls1, 32);
    const float i0 = 1.f / ls0, i1 = lam / ls1;
    float ss = 0.f;
#pragma unroll
    for (int db = 0; db < 2; ++db)
#pragma unroll
        for (int r = 0; r < 16; ++r) { const float v = oacc[0][db][r] * i0 - oacc[1][db][r] * i1; oacc[0][db][r] = v; ss = fmaf(v, v, ss); }
    ss += __shfl_xor(ss, 32);
    const float rr = (1.f - lam_init) / sqrtf(ss * (1.f / 64.f) + EPS);
    const float* hg = p.diff_head_norm + l * 64;
    bf16* orow = O0 + (tokb + qw + r32) * 256 + h * 64;
#pragma unroll
    for (int db = 0; db < 2; ++db)
#pragma unroll
        for (int g = 0; g < 4; ++g) { const int d0 = db * 32 + 8 * g + 4 * half; const f32x4 gg = *(const f32x4*)(hg + d0);
            u32x2 w; w.x = pkbf(oacc[0][db][4 * g] * rr * gg[0], oacc[0][db][4 * g + 1] * rr * gg[1]); w.y = pkbf(oacc[0][db][4 * g + 2] * rr * gg[2], oacc[0][db][4 * g + 3] * rr * gg[3]);
            *(u32x2*)(orow + d0) = w; }
    __syncthreads();
}

typedef unsigned u32x16 __attribute__((ext_vector_type(16)));
__device__ __forceinline__ void sb_item(const Params& p, int l, int bh, int g, LAS unsigned char* lds, int wv) {
    const int tid = tid_fresh(wv), lane = tid & 63, w = wv, b = bh >> 2, h = bh & 3; (void)lds;
    const bf16* Z = (const bf16*)(p.ws + WS_BIG); bf16* O2 = (bf16*)(p.ws + WS_O + 2 * OB_STRIDE);
    const int t0 = g * 512 + w * 64, t = t0 + lane; const size_t tok = (size_t)b * SEQ + t;
    float q[64], o[64];
    { const u32x4* qp = (const u32x4*)(Z + tok * ZP + 1792 + h * 64);
#pragma unroll
      for (int i = 0; i < 8; ++i) { const u32x4 x = qp[i]; q[8 * i] = bflo(x.x); q[8 * i + 1] = bfhi(x.x); q[8 * i + 2] = bflo(x.y); q[8 * i + 3] = bfhi(x.y); q[8 * i + 4] = bflo(x.z); q[8 * i + 5] = bfhi(x.z); q[8 * i + 6] = bflo(x.w); q[8 * i + 7] = bfhi(x.w); } }
#pragma unroll
    for (int i = 0; i < 64; ++i) o[i] = 0.f;
    float R = 0.f;
    const bf16* kbase = Z + (size_t)b * SEQ * ZP + col_sbk(l) + h * 64;
#pragma unroll 1
    for (int s = t0 + 62; s >= 0; --s) {
        const bf16* kp = kbase + (size_t)s * ZP;
        u32x16 k0, k1, v0, v1;
        asm volatile("s_load_dwordx16 %0, %4, 0x0\n\ts_load_dwordx16 %1, %4, 0x40\n\ts_load_dwordx16 %2, %4, 0x200\n\ts_load_dwordx16 %3, %4, 0x240\n\ts_waitcnt lgkmcnt(0)"
                     : "=s"(k0), "=s"(k1), "=s"(v0), "=s"(v1) : "s"(kp) : "memory");
        const bool act = s < t;
        float z = 0.f;
#pragma unroll
        for (int i = 0; i < 16; ++i) { z = fmaf(q[2 * i], bflo(k0[i]), z); z = fmaf(q[2 * i + 1], bfhi(k0[i]), z); }
#pragma unroll
        for (int i = 0; i < 16; ++i) { z = fmaf(q[32 + 2 * i], bflo(k1[i]), z); z = fmaf(q[33 + 2 * i], bfhi(k1[i]), z); }
        z *= 0.125f;
        const float lb = fminf(z, 0.f) - __logf(1.f + __expf(-fabsf(z)));
        const float a = act ? __expf(lb + R) : 0.f;
        R += act ? (lb - z) : 0.f;
#pragma unroll
        for (int i = 0; i < 16; ++i) { o[2 * i] = fmaf(a, bflo(v0[i]), o[2 * i]); o[2 * i + 1] = fmaf(a, bfhi(v0[i]), o[2 * i + 1]); }
#pragma unroll
        for (int i = 0; i < 16; ++i) { o[32 + 2 * i] = fmaf(a, bflo(v1[i]), o[32 + 2 * i]); o[33 + 2 * i] = fmaf(a, bfhi(v1[i]), o[33 + 2 * i]); }
        if ((s & 31) == 0) { if (__all(R < -104.f)) break; }
    }
    u32x4* dst = (u32x4*)(O2 + tok * 256 + h * 64);
#pragma unroll
    for (int i = 0; i < 8; ++i) { u32x4 x; x.x = pk2(o[8 * i], o[8 * i + 1]); x.y = pk2(o[8 * i + 2], o[8 * i + 3]); x.z = pk2(o[8 * i + 4], o[8 * i + 5]); x.w = pk2(o[8 * i + 6], o[8 * i + 7]); dst[i] = x; }
}
constexpr size_t WS_MLS = 460 * MiB, WS_DEC = WS_MLS + 5 * 32 * 4096 * 4, WS_UN = 463 * MiB, WS_NV = WS_UN + 512 * 1024, WS_UT = 464 * MiB, WS_CT = 496 * MiB, WS_END2 = 512 * MiB;
constexpr int MLN = 32 * 4096;
__device__ __forceinline__ void ml_prepass(const Params& p, int l, int bh, int lane) {
    const int b = bh >> 2, h = bh & 3; const float* ZS = (const float*)(p.ws + WS_ZS);
    float* MLS = (float*)(p.ws + WS_MLS); float* DEC = (float*)(p.ws + WS_DEC);
    const float gb_i = p.ml_gate_bias[(l * 2 + 0) * 4 + h], gb_f = p.ml_gate_bias[(l * 2 + 1) * 4 + h];
    float cA = 0.f, cB = 0.f;
#pragma unroll 1
    for (int c4 = 0; c4 < 8; ++c4) {
        float igv[8], fzv[8];
#pragma unroll
        for (int k = 0; k < 8; ++k) { const size_t tok = (size_t)b * SEQ + (c4 * 8 + k) * 64 + lane; igv[k] = ZS[tok * ZSP + 168 + h]; fzv[k] = ZS[tok * ZSP + 172 + h]; }
#pragma unroll
        for (int k = 0; k < 8; ++k) {
            const int c = c4 * 8 + k;
            const float ig = igv[k] + gb_i, fz = fzv[k] + gb_f;
            const float lf = fminf(fz, 0.f) - __logf(1.f + __expf(-fabsf(fz)));
            float bsum = lf;
#pragma unroll
            for (int d = 1; d < 64; d <<= 1) { const float n = __shfl_up(bsum, d); if (lane >= d) bsum += n; }
            const float bl = __shfl(bsum, 63);
            const float a = ig - bsum;
            float pm = a;
#pragma unroll
            for (int d = 1; d < 64; d <<= 1) { const float n = __shfl_up(pm, d); if (lane >= d) pm = fmaxf(pm, n); }
            const float gmax = bl + __shfl(pm, 63);
            const int ti = bh * 4096 + c * 64 + lane;
            MLS[ti] = bsum; MLS[MLN + ti] = a; MLS[2 * MLN + ti] = pm;
            cA = (lane == c) ? bl : cA; cB = (lane == c) ? gmax : cB;
        }
    }
    float sA = cA, sB = cB;
#pragma unroll
    for (int d = 1; d < 64; d <<= 1) { const float pA = __shfl_up(sA, d), pB = __shfl_up(sB, d); if (lane >= d) { sB = fmaxf(pB + sA, sB); sA = pA + sA; } }
    const float m_out = fmaxf(sA, sB);
    float m_in = __shfl_up(m_out, 1); if (lane == 0) m_in = 0.f;
    DEC[bh * 64 + lane] = __expf(cA + m_in - m_out);
    asm volatile("s_waitcnt vmcnt(0)" ::: "memory");
#pragma unroll 1
    for (int c4 = 0; c4 < 8; ++c4) {
        float bsv[8], av[8], pmv[8];
#pragma unroll
        for (int k = 0; k < 8; ++k) { const int ti = bh * 4096 + (c4 * 8 + k) * 64 + lane; bsv[k] = MLS[ti]; av[k] = MLS[MLN + ti]; pmv[k] = MLS[2 * MLN + ti]; }
#pragma unroll
        for (int k = 0; k < 8; ++k) {
            const int c = c4 * 8 + k;
            const float mi = __shfl(m_in, c), mo = __shfl(m_out, c), bl = __shfl(cA, c);
            const int ti = bh * 4096 + c * 64 + lane;
            const float mt = bsv[k] + fmaxf(mi, pmv[k]);
            MLS[2 * MLN + ti] = mt; MLS[3 * MLN + ti] = __expf(bl + av[k] - mo); MLS[4 * MLN + ti] = __expf(bsv[k] + mi - mt);
        }
    }
}
__device__ __forceinline__ void ml_conv8(const bf16* Z, const float* cw, const float* cb, int b, int t, int ch0, float (&y)[8]) {
    const f32x4 b0 = *(const f32x4*)(cb + ch0), b1 = *(const f32x4*)(cb + ch0 + 4);
    y[0] = b0[0]; y[1] = b0[1]; y[2] = b0[2]; y[3] = b0[3]; y[4] = b1[0]; y[5] = b1[1]; y[6] = b1[2]; y[7] = b1[3];
#pragma unroll
    for (int j = 0; j < 4; ++j) {
        const int tt = t - 3 + j;
        if (tt >= 0) {
            const u32x4 x = *(const u32x4*)(Z + ((size_t)b * SEQ + tt) * ZP + 768 + ch0);
            const f32x4 w0 = *(const f32x4*)(cw + j * 512 + ch0), w1 = *(const f32x4*)(cw + j * 512 + ch0 + 4);
            y[0] = fmaf(w0[0], bflo(x.x), y[0]); y[1] = fmaf(w0[1], bfhi(x.x), y[1]); y[2] = fmaf(w0[2], bflo(x.y), y[2]); y[3] = fmaf(w0[3], bfhi(x.y), y[3]);
            y[4] = fmaf(w1[0], bflo(x.z), y[4]); y[5] = fmaf(w1[1], bfhi(x.z), y[5]); y[6] = fmaf(w1[2], bflo(x.w), y[6]); y[7] = fmaf(w1[3], bfhi(x.w), y[7]);
        }
    }
#pragma unroll
    for (int i = 0; i < 8; ++i) y[i] = y[i] * sigmoidf_(y[i]);
}
__device__ __forceinline__ void mlB_item(const Params& p, int l, int bh, int ci, LAS unsigned char* lds, int wv) {
    const int tid = tid_fresh(wv), lane = tid & 63, half = lane >> 5, r32 = lane & 31, b = bh >> 2, h = bh & 3;
    const bf16* Z = (const bf16*)(p.ws + WS_BIG); const float* MLS = (const float*)(p.ws + WS_MLS);
    float* UT = (float*)(p.ws + WS_UT); float* UN = (float*)(p.ws + WS_UN);
    LAS bf16* KT = (LAS bf16*)lds; LAS bf16* VT = KT + 4 * 64 * 72;
    const float* cw = p.ml_conv_w + (size_t)l * 4 * 512; const float* cb = p.ml_conv_b + (size_t)l * 512;
    __syncthreads();
    {
        const int tt = tid >> 1, hr = tid & 1, cl = tt >> 6, s = tt & 63, t = (ci * 4) * 64 + tt;
        const float wk = MLS[3 * MLN + bh * 4096 + t];
#pragma unroll 1
        for (int q8 = 0; q8 < 4; ++q8) {
            const int d0 = hr * 32 + q8 * 8; float y[8];
            ml_conv8(Z, cw, cb, b, t, 256 + h * 64 + d0, y);
            LAS bf16* dst = KT + (cl * 64 + d0) * 72 + s;
#pragma unroll
            for (int i = 0; i < 8; ++i) dst[i * 72] = (bf16)f2bf(y[i] * wk);
            const u32x4 v = *(const u32x4*)(Z + ((size_t)b * SEQ + t) * ZP + 1280 + h * 64 + d0);
            LAS bf16* vd = VT + (cl * 64 + d0) * 72 + s;
            vd[0] = (bf16)(v.x & 0xffffu); vd[72] = (bf16)(v.x >> 16); vd[144] = (bf16)(v.y & 0xffffu); vd[216] = (bf16)(v.y >> 16);
            vd[288] = (bf16)(v.z & 0xffffu); vd[360] = (bf16)(v.z >> 16); vd[432] = (bf16)(v.w & 0xffffu); vd[504] = (bf16)(v.w >> 16);
        }
    }
    __syncthreads();
    const int cl = wv >> 1, dh = wv & 1, c = ci * 4 + cl;
    f32x16 acc[2];
#pragma unroll
    for (int eb = 0; eb < 2; ++eb)
#pragma unroll
        for (int r = 0; r < 16; ++r) acc[eb][r] = 0.f;
#pragma unroll
    for (int s4 = 0; s4 < 4; ++s4) {
        const s16x8 bk = *(const LAS s16x8*)(KT + (cl * 64 + dh * 32 + r32) * 72 + 16 * s4 + 8 * half);
#pragma unroll
        for (int eb = 0; eb < 2; ++eb) {
            const s16x8 av = *(const LAS s16x8*)(VT + (cl * 64 + eb * 32 + r32) * 72 + 16 * s4 + 8 * half);
            acc[eb] = __builtin_amdgcn_mfma_f32_32x32x16_bf16(av, bk, acc[eb], 0, 0, 0);
        }
    }
    float* ut = UT + ((size_t)(bh * 64 + c) * 64) * 64;
#pragma unroll
    for (int eb = 0; eb < 2; ++eb)
#pragma unroll
        for (int r = 0; r < 16; ++r) { const int e = eb * 32 + 8 * (r >> 2) + 4 * half + (r & 3); ut[e * 64 + dh * 32 + r32] = acc[eb][r]; }
    {
        const LAS bf16* kr = KT + (cl * 64 + dh * 32 + r32) * 72 + half * 32; float sm = 0.f;
#pragma unroll
        for (int i = 0; i < 4; ++i) { const u32x4 x = *(const LAS u32x4*)(kr + 8 * i); sm += (bflo(x.x) + bfhi(x.x)) + (bflo(x.y) + bfhi(x.y)) + (bflo(x.z) + bfhi(x.z)) + (bflo(x.w) + bfhi(x.w)); }
        sm += __shfl_xor(sm, 32);
        if (half == 0) UN[(bh * 64 + c) * 64 + dh * 32 + r32] = sm;
    }
}
__device__ __forceinline__ void mlS_item(const Params& p, int bh, int wv) {
    const int tid = tid_fresh(wv);
    const float* UT = (const float*)(p.ws + WS_UT) + (size_t)bh * 64 * 4096; const float* UN = (const float*)(p.ws + WS_UN) + bh * 4096;
    bf16* CT = (bf16*)(p.ws + WS_CT) + (size_t)bh * 64 * 4096; float* NV = (float*)(p.ws + WS_NV) + bh * 4096; const float* DEC = (const float*)(p.ws + WS_DEC) + bh * 64;
    f32x4 s0 = (f32x4){0.f, 0.f, 0.f, 0.f}, s1 = s0; float ns = 0.f;
#pragma unroll 4
    for (int c = 0; c < 64; ++c) {
        const float dec = DEC[c];
        const f32x4 u0 = *(const f32x4*)(UT + (size_t)c * 4096 + tid * 8), u1 = *(const f32x4*)(UT + (size_t)c * 4096 + tid * 8 + 4);
        u32x4 w; w.x = pk2(s0[0], s0[1]); w.y = pk2(s0[2], s0[3]); w.z = pk2(s1[0], s1[1]); w.w = pk2(s1[2], s1[3]);
        *(u32x4*)(CT + (size_t)c * 4096 + tid * 8) = w;
        s0 = s0 * dec + u0; s1 = s1 * dec + u1;
        if (tid < 64) { NV[c * 64 + tid] = ns; ns = ns * dec + UN[c * 64 + tid]; }
    }
}
__device__ __forceinline__ void mlD_item(const Params& p, int l, int bh, int ci, LAS unsigned char* lds, int wv) {
    const int tid = tid_fresh(wv), lane = tid & 63, half = lane >> 5, r32 = lane & 31, b = bh >> 2, h = bh & 3;
    const bf16* Z = (const bf16*)(p.ws + WS_BIG); const float* MLS = (const float*)(p.ws + WS_MLS); bf16* O1 = (bf16*)(p.ws + WS_O + OB_STRIDE);
    LAS bf16* Qs = (LAS bf16*)lds; LAS bf16* Ks = Qs + 4 * 64 * 72; LAS bf16* VT = Ks + 4 * 64 * 72;
    const float* cw = p.ml_conv_w + (size_t)l * 4 * 512; const float* cb = p.ml_conv_b + (size_t)l * 512;
    __syncthreads();
    {
        const int tt = tid >> 1, hr = tid & 1, cl = tt >> 6, s = tt & 63, t = (ci * 4) * 64 + tt;
#pragma unroll 1
        for (int q8 = 0; q8 < 4; ++q8) {
            const int d0 = hr * 32 + q8 * 8; float y[8];
            ml_conv8(Z, cw, cb, b, t, h * 64 + d0, y);
            u32x4 w; w.x = pk2(y[0] * 0.125f, y[1] * 0.125f); w.y = pk2(y[2] * 0.125f, y[3] * 0.125f); w.z = pk2(y[4] * 0.125f, y[5] * 0.125f); w.w = pk2(y[6] * 0.125f, y[7] * 0.125f);
            *(LAS u32x4*)(Qs + (cl * 64 + s) * 72 + d0) = w;
            ml_conv8(Z, cw, cb, b, t, 256 + h * 64 + d0, y);
            w.x = pk2(y[0], y[1]); w.y = pk2(y[2], y[3]); w.z = pk2(y[4], y[5]); w.w = pk2(y[6], y[7]);
            *(LAS u32x4*)(Ks + (cl * 64 + s) * 72 + d0) = w;
            const u32x4 v = *(const u32x4*)(Z + ((size_t)b * SEQ + t) * ZP + 1280 + h * 64 + d0);
            LAS bf16* vd = VT + (cl * 64 + d0) * 72 + s;
            vd[0] = (bf16)(v.x & 0xffffu); vd[72] = (bf16)(v.x >> 16); vd[144] = (bf16)(v.y & 0xffffu); vd[216] = (bf16)(v.y >> 16);
            vd[288] = (bf16)(v.z & 0xffffu); vd[360] = (bf16)(v.z >> 16); vd[432] = (bf16)(v.w & 0xffffu); vd[504] = (bf16)(v.w >> 16);
        }
    }
    __syncthreads();
    const int cl = wv >> 1, th = wv & 1, c = ci * 4 + cl, tloc = th * 32 + r32, tseq = c * 64 + tloc;
    const int ti = bh * 4096 + tseq;
    const float bs_t = MLS[ti], mt_t = MLS[2 * MLN + ti], iw_t = MLS[4 * MLN + ti];
    s16x8 qf[4];
#pragma unroll
    for (int s4 = 0; s4 < 4; ++s4) qf[s4] = *(const LAS s16x8*)(Qs + (cl * 64 + tloc) * 72 + 16 * s4 + 8 * half);
    f32x16 oacc[2];
#pragma unroll
    for (int eb = 0; eb < 2; ++eb)
#pragma unroll
        for (int r = 0; r < 16; ++r) oacc[eb][r] = 0.f;
    const bf16* CT = (const bf16*)(p.ws + WS_CT) + (size_t)(bh * 64 + c) * 4096;
#pragma unroll
    for (int s4 = 0; s4 < 4; ++s4)
#pragma unroll
        for (int eb = 0; eb < 2; ++eb) { const s16x8 ac = *(const s16x8*)(CT + (eb * 32 + r32) * 64 + 16 * s4 + 8 * half);
            oacc[eb] = __builtin_amdgcn_mfma_f32_32x32x16_bf16(ac, qf[s4], oacc[eb], 0, 0, 0); }
#pragma unroll
    for (int eb = 0; eb < 2; ++eb)
#pragma unroll
        for (int r = 0; r < 16; ++r) oacc[eb][r] *= iw_t;
    float qn = 0.f;
    { const float* nvp = (const float*)(p.ws + WS_NV) + (bh * 64 + c) * 64;
#pragma unroll
      for (int s4 = 0; s4 < 4; ++s4) { const f32x4 n0 = *(const f32x4*)(nvp + 16 * s4 + 8 * half), n1 = *(const f32x4*)(nvp + 16 * s4 + 8 * half + 4);
          const u32x4 qq = __builtin_bit_cast(u32x4, qf[s4]);
          qn += bflo(qq.x) * n0[0] + bfhi(qq.x) * n0[1] + bflo(qq.y) * n0[2] + bfhi(qq.y) * n0[3] + bflo(qq.z) * n1[0] + bfhi(qq.z) * n1[1] + bflo(qq.w) * n1[2] + bfhi(qq.w) * n1[3]; } }
    qn += __shfl_xor(qn, 32);
    float rs = 0.f;
#pragma unroll
    for (int sb = 0; sb < 2; ++sb) {
        if (sb <= th) {
            f32x16 sacc;
#pragma unroll
            for (int r = 0; r < 16; ++r) sacc[r] = 0.f;
#pragma unroll
            for (int s4 = 0; s4 < 4; ++s4) { const s16x8 ak = *(const LAS s16x8*)(Ks + (cl * 64 + sb * 32 + r32) * 72 + 16 * s4 + 8 * half);
                sacc = __builtin_amdgcn_mfma_f32_32x32x16_bf16(ak, qf[s4], sacc, 0, 0, 0); }
            const float* ap = MLS + MLN + bh * 4096 + c * 64 + sb * 32 + 4 * half;
#pragma unroll
            for (int g = 0; g < 4; ++g) { const f32x4 av = *(const f32x4*)(ap + 8 * g);
#pragma unroll
                for (int i = 0; i < 4; ++i) { const int s = sb * 32 + 8 * g + 4 * half + i; const float v = (s <= tloc) ? sacc[4 * g + i] * __expf(bs_t + av[i] - mt_t) : 0.f; sacc[4 * g + i] = v; rs += v; } }
#pragma unroll
            for (int s2 = 0; s2 < 2; ++s2) {
                u32x4 w; w.x = pkbf(sacc[8 * s2], sacc[8 * s2 + 1]); w.y = pkbf(sacc[8 * s2 + 2], sacc[8 * s2 + 3]); w.z = pkbf(sacc[8 * s2 + 4], sacc[8 * s2 + 5]); w.w = pkbf(sacc[8 * s2 + 6], sacc[8 * s2 + 7]);
                const s16x8 pf = __builtin_bit_cast(s16x8, w);
#pragma unroll
                for (int eb = 0; eb < 2; ++eb) {
                    const LAS bf16* vr = VT + (cl * 64 + eb * 32 + r32) * 72 + sb * 32 + 16 * s2 + 4 * half;
                    const u32x2 v0 = *(const LAS u32x2*)vr, v1 = *(const LAS u32x2*)(vr + 8);
                    const u32x4 vv = (u32x4){v0.x, v0.y, v1.x, v1.y};
                    oacc[eb] = __builtin_amdgcn_mfma_f32_32x32x16_bf16(__builtin_bit_cast(s16x8, vv), pf, oacc[eb], 0, 0, 0);
                }
            }
        }
    }
    rs += __shfl_xor(rs, 32);
    const float den = iw_t * qn + rs;
    const float dn = 1.f / fmaxf(fabsf(den), __expf(-mt_t));
    float ss = 0.f;
#pragma unroll
    for (int eb = 0; eb < 2; ++eb)
#pragma unroll
        for (int r = 0; r < 16; ++r) { const float v = oacc[eb][r] * dn; oacc[eb][r] = v; ss = fmaf(v, v, ss); }
    ss += __shfl_xor(ss, 32);
    const float rr = 1.f / sqrtf(ss * (1.f / 64.f) + EPS);
    const size_t tok = (size_t)b * SEQ + tseq;
    const float* hg = p.ml_head_norm + l * 64;
#pragma unroll
    for (int eb = 0; eb < 2; ++eb)
#pragma unroll
        for (int g = 0; g < 4; ++g) { const int e0 = eb * 32 + 8 * g + 4 * half; const f32x4 gg = *(const f32x4*)(hg + e0);
            const u32x2 og = *(const u32x2*)(Z + tok * ZP + 1536 + h * 64 + e0);
            u32x2 w; w.x = pkbf(sigmoidf_(bflo(og.x)) * oacc[eb][4 * g] * rr * gg[0], sigmoidf_(bfhi(og.x)) * oacc[eb][4 * g + 1] * rr * gg[1]);
            w.y = pkbf(sigmoidf_(bflo(og.y)) * oacc[eb][4 * g + 2] * rr * gg[2], sigmoidf_(bfhi(og.y)) * oacc[eb][4 * g + 3] * rr * gg[3]);
            *(u32x2*)(O1 + tok * 256 + h * 64 + e0) = w; }
}
__device__ __forceinline__ float relu_(float x) { return __builtin_amdgcn_fmed3f(x, 0.f, __builtin_inff()); }
__device__ __forceinline__ unsigned key16(float s) { const float f = __builtin_amdgcn_fmed3f(floorf(fmaf(s, 512.f, 32768.f)), 0.f, 65535.f); return (unsigned)f; }
__device__ __forceinline__ unsigned mono_bits(float s) { s = (s == 0.f) ? 0.f : s; const unsigned u = __float_as_uint(s); return (u & 0x80000000u) ? ~u : (u | 0x80000000u); }
__device__ __forceinline__ void dsa_item(const Params& p, int lds_l, int b, int qt, LAS unsigned char* lds, int wv) {
    const int tid = tid_fresh(wv), lane = tid & 63, w = wv, half = lane >> 5, r32 = lane & 31;
    const bf16* Z = (const bf16*)(p.ws + WS_BIG); const float* ZS = (const float*)(p.ws + WS_ZS); const bf16* IK = (const bf16*)(p.ws + WS_IK); bf16* O3 = (bf16*)(p.ws + WS_O + 3 * OB_STRIDE);
    LAS unsigned* hist = (LAS unsigned*)lds + w * 2048;
    LAS unsigned* maskw = (LAS unsigned*)(lds + 65536);
    LAS bf16* KC = (LAS bf16*)(lds + 81920);
    LAS bf16* Kd = (LAS bf16*)lds; LAS bf16* VTd = Kd + 64 * 72;
    const size_t tokb = (size_t)b * SEQ; const int tb = qt * 32 + 4 * w;
    const int ntiles = qt + 1, nkeys = ntiles * 32, nchunks = (ntiles + 15) >> 4;
    s16x8 aq0, aq1;
    { const int qrow = 2 * ((r32 >> 2) & 1) + (r32 >> 4), hrow = 4 * ((r32 >> 3) & 1) + (r32 & 3);
      const bf16* ap = Z + (tokb + tb + qrow) * ZP + 2816 + hrow * 32 + half * 8; aq0 = *(const s16x8*)ap; aq1 = *(const s16x8*)(ap + 16); }
    float wq[2][8];
#pragma unroll
    for (int s = 0; s < 2; ++s) { const float* wp = ZS + (tokb + tb + 2 * half + s) * ZSP + 160; const f32x4 x0 = *(const f32x4*)wp, x1 = *(const f32x4*)(wp + 4);
        wq[s][0] = x0[0]; wq[s][1] = x0[1]; wq[s][2] = x0[2]; wq[s][3] = x0[3]; wq[s][4] = x1[0]; wq[s][5] = x1[1]; wq[s][6] = x1[2]; wq[s][7] = x1[3]; }
    unsigned tau[4], prefix[4]; int quota[4], krem[4], eqs[2]; bool allsel[4];
    LAS unsigned* cand = (LAS unsigned*)(lds + 114688) + w * 768;
    LAS unsigned* oflag = (LAS unsigned*)(lds + LDS_BYTES - 48);
    const unsigned lowmask = (1u << r32) - 1u;
#define DSA_SCORES(ktl, sc) do { const LAS bf16* kp_ = KC + ((ktl) * 32 + r32) * 32 + half * 8; \
        const s16x8 b0_ = *(const LAS s16x8*)kp_, b1_ = *(const LAS s16x8*)(kp_ + 16); f32x16 a_ = {0.f, 0.f, 0.f, 0.f, 0.f, 0.f, 0.f, 0.f, 0.f, 0.f, 0.f, 0.f, 0.f, 0.f, 0.f, 0.f}; \
        a_ = __builtin_amdgcn_mfma_f32_32x32x16_bf16(aq0, b0_, a_, 0, 0, 0); a_ = __builtin_amdgcn_mfma_f32_32x32x16_bf16(aq1, b1_, a_, 0, 0, 0); \
        _Pragma("unroll") for (int s_ = 0; s_ < 2; ++s_) { float pt_ = wq[s_][0] * relu_(a_[8 * s_]); \
            _Pragma("unroll") for (int j_ = 1; j_ < 8; ++j_) pt_ = fmaf(wq[s_][j_], relu_(a_[8 * s_ + j_]), pt_); sc[s_] = pt_; } } while (0)
    int mode = (qt >= 8) ? 0 : 1;
#pragma unroll 1
    for (int attempt = 0; attempt < 2; ++attempt) {
        const int npass = (qt >= 8) ? (mode ? 4 : 1) : 0;
#pragma unroll
        for (int g = 0; g < 4; ++g) { tau[g] = 0u; prefix[g] = 0u; quota[g] = 1 << 30; krem[g] = 256; allsel[g] = true; }
        eqs[0] = 0; eqs[1] = 0;
        if (tid == 0) *oflag = 0u;
#pragma unroll 1
        for (int pass = 0; pass <= npass; ++pass) {
            const bool comp = (pass == npass);
            const int shift = 8 * (npass - 1 - pass);
            if (!comp) {
#pragma unroll
                for (int i = 0; i < 8; ++i) *(LAS u32x4*)(hist + (i * 64 + lane) * 4) = (u32x4){0u, 0u, 0u, 0u};
            }
            const unsigned pfa = half ? prefix[2] : prefix[0], pfb = half ? prefix[3] : prefix[1];
            const int ta = tb + 2 * half, tbq = ta + 1;
            u32x4 pre[4];
#pragma unroll
            for (int i = 0; i < 4; ++i) { const int kb = (tid * 16 + i * 8192) >> 6; pre[i] = (kb < nkeys) ? *(const u32x4*)((const unsigned char*)(IK + tokb * 32) + tid * 16 + i * 8192) : (u32x4){0u, 0u, 0u, 0u}; }
#pragma unroll 1
            for (int ch = 0; ch < nchunks; ++ch) {
                __syncthreads();
#pragma unroll
                for (int i = 0; i < 4; ++i) *(LAS u32x4*)((LAS unsigned char*)KC + tid * 16 + i * 8192) = pre[i];
                __syncthreads();
                if (ch + 1 < nchunks) {
#pragma unroll
                    for (int i = 0; i < 4; ++i) { const int kb = (ch + 1) * 512 + ((tid * 16 + i * 8192) >> 6);
                        pre[i] = (kb < nkeys) ? *(const u32x4*)((const unsigned char*)(IK + (tokb + (size_t)(ch + 1) * 512) * 32) + tid * 16 + i * 8192) : (u32x4){0u, 0u, 0u, 0u}; }
                }
                const int nt = min(16, ntiles - ch * 16);
                if (!comp) {
#pragma unroll 4
                    for (int ktl = 0; ktl < nt; ++ktl) {
                        float sc[2]; DSA_SCORES(ktl, sc);
                        const int key = (ch * 16 + ktl) * 32 + r32;
                        const float sa = sc[0], sb = sc[1];
                        if (mode == 0) {
                            const unsigned ba = key16(sa) >> 6, bb = key16(sb) >> 6;
                            if (key <= ta) __hip_atomic_fetch_add(hist + (2 * half) * 512 + (ba >> 1), (ba & 1u) ? 0x10000u : 1u, __ATOMIC_RELAXED, __HIP_MEMORY_SCOPE_WORKGROUP);
                            if (key <= tbq) __hip_atomic_fetch_add(hist + (2 * half + 1) * 512 + (bb >> 1), (bb & 1u) ? 0x10000u : 1u, __ATOMIC_RELAXED, __HIP_MEMORY_SCOPE_WORKGROUP);
                        } else {
                        const unsigned ma = mono_bits(sa), mb = mono_bits(sb);
                        const bool oka = (key <= ta) && (pass == 0 || (ma >> (shift + 8)) == pfa);
                        const bool okb = (key <= tbq) && (pass == 0 || (mb >> (shift + 8)) == pfb);
                        if (oka) __hip_atomic_fetch_add(hist + (2 * half) * 256 + ((ma >> shift) & 255u), 1u, __ATOMIC_RELAXED, __HIP_MEMORY_SCOPE_WORKGROUP);
                        if (okb) __hip_atomic_fetch_add(hist + (2 * half + 1) * 256 + ((mb >> shift) & 255u), 1u, __ATOMIC_RELAXED, __HIP_MEMORY_SCOPE_WORKGROUP);
                        }
                    }
                } else {
#pragma unroll 1
                    for (int ktl = 0; ktl < nt; ++ktl) {
                        float sc[2]; DSA_SCORES(ktl, sc);
                        const int key = (ch * 16 + ktl) * 32 + r32;
#pragma unroll
                        for (int s = 0; s < 2; ++s) {
                            const unsigned taus = half ? tau[2 + s] : tau[s]; const int quo = half ? quota[2 + s] : quota[s]; const bool alls = half ? allsel[2 + s] : allsel[s];
                            const unsigned m = mode ? mono_bits(sc[s]) : (key16(sc[s]) >> 6); const bool valid = key <= tb + 2 * half + s;
                            const bool eq = valid && (m == taus);
                            const unsigned beq = (unsigned)(__ballot(eq) >> (32 * half));
                            const int rank = eqs[s] + __popc(beq & lowmask);
                            const bool takeeq = mode ? (rank < quo) : alls;
                            const bool sel = valid && ((m > taus) || (eq && takeeq));
                            const unsigned bsel = (unsigned)(__ballot(sel) >> (32 * half));
                            if (r32 == 0) maskw[(4 * w + 2 * half + s) * 128 + ch * 16 + ktl] = bsel;
                            if (mode == 0 && !alls && eq && rank < 96) { cand[((2 * half + s) * 96 + rank) * 2] = mono_bits(sc[s]); cand[((2 * half + s) * 96 + rank) * 2 + 1] = (unsigned)key; }
                            eqs[s] += __popc(beq);
                        }
                    }
                }
            }
            if (!comp) {
                LDS_WAIT();
                if (mode == 0) {
#pragma unroll
                    for (int g = 0; g < 4; ++g) {
                        const u32x4 w0 = *(const LAS u32x4*)(hist + g * 512 + lane * 8), w1 = *(const LAS u32x4*)(hist + g * 512 + lane * 8 + 4);
                        const unsigned wd[8] = {w0.x, w0.y, w0.z, w0.w, w1.x, w1.y, w1.z, w1.w};
                        int c[16], tot = 0;
#pragma unroll
                        for (int j = 0; j < 8; ++j) { c[2 * j] = (int)(wd[j] & 0xffffu); c[2 * j + 1] = (int)(wd[j] >> 16); tot += c[2 * j] + c[2 * j + 1]; }
                        int v = tot;
#pragma unroll
                        for (int d = 1; d < 64; d <<= 1) { const int n = __shfl_down(v, d); if (lane + d < 64) v += n; }
                        const int k = krem[g]; int a = v - tot, fb = -1, fa = 0, fc = 0;
#pragma unroll
                        for (int j = 15; j >= 0; --j) { if (fb < 0 && a < k && a + c[j] >= k) { fb = j; fa = a; fc = c[j]; } a += c[j]; }
                        const unsigned long long mk = __ballot(fb >= 0);
                        const int src = (int)__builtin_ctzll(mk | (1ull << 63));
                        const int bin = __shfl(16 * lane + fb, src), above = __shfl(fa, src), cnt = __shfl(fc, src);
                        prefix[g] = (unsigned)bin; krem[g] = k - above;
                        tau[g] = prefix[g]; quota[g] = krem[g]; allsel[g] = (cnt == krem[g]);
                    }
                } else {
#pragma unroll
                for (int g = 0; g < 4; ++g) {
                    const u32x4 cv = *(const LAS u32x4*)(hist + g * 256 + lane * 4);
                    const int c0 = (int)cv.x, c1 = (int)cv.y, c2 = (int)cv.z, c3 = (int)cv.w, tot = c0 + c1 + c2 + c3;
                    int v = tot;
#pragma unroll
                    for (int d = 1; d < 64; d <<= 1) { const int n = __shfl_down(v, d); if (lane + d < 64) v += n; }
                    const int a3 = v - tot, a2 = a3 + c3, a1 = a2 + c2, a0 = a1 + c1; const int k = krem[g];
                    int fb = -1, fa = 0, fc = 0;
                    if (a3 < k && a3 + c3 >= k) { fb = 3; fa = a3; fc = c3; }
                    else if (a2 < k && a2 + c2 >= k) { fb = 2; fa = a2; fc = c2; }
                    else if (a1 < k && a1 + c1 >= k) { fb = 1; fa = a1; fc = c1; }
                    else if (a0 < k && a0 + c0 >= k) { fb = 0; fa = a0; fc = c0; }
                    const unsigned long long mk = __ballot(fb >= 0);
                    const int src = (int)__builtin_ctzll(mk | (1ull << 63));
                    const int bin = __shfl(4 * lane + fb, src), above = __shfl(fa, src), cnt = __shfl(fc, src);
                    prefix[g] = (prefix[g] << 8) | (unsigned)bin; krem[g] = k - above;
                    if (pass == npass - 1) { tau[g] = prefix[g]; quota[g] = krem[g]; allsel[g] = (cnt == krem[g]); }
                }
                }
            }
        }
        if (mode == 0 && npass) {
            LDS_WAIT();
#pragma unroll
            for (int g = 0; g < 4; ++g) {
                if (!allsel[g]) {
                    const int n = __shfl(eqs[g & 1], 32 * (g >> 1)), need = quota[g];
                    if (n > 96) { if (lane == 0) *oflag = 1u; }
                    else {
#pragma unroll 1
                        for (int i0 = 0; i0 < n; i0 += 64) {
                            const int i = i0 + lane; const bool act = i < n;
                            const unsigned mi = act ? cand[(g * 96 + i) * 2] : 0u, ki = act ? cand[(g * 96 + i) * 2 + 1] : 0u; int rank = 0;
#pragma unroll 1
                            for (int j = 0; j < n; ++j) { const unsigned mj = cand[(g * 96 + j) * 2], kj = cand[(g * 96 + j) * 2 + 1]; rank += ((mj > mi) || (mj == mi && kj < ki)) ? 1 : 0; }
                            if (act && rank < need) __hip_atomic_fetch_or(maskw + (4 * w + g) * 128 + (ki >> 5), 1u << (ki & 31u), __ATOMIC_RELAXED, __HIP_MEMORY_SCOPE_WORKGROUP);
                        }
                    }
                }
            }
        }
        __syncthreads();
        const unsigned of = *oflag;
        __syncthreads();
        if (mode == 0 && of != 0u) { mode = 1; continue; }
        break;
    }
    __syncthreads();
    {
        const float* sgn = p.dsa_qk_norm + lds_l * 128; float gqm = 0.f, gkm = 0.f;
#pragma unroll 2
        for (int i = 0; i < 64; ++i) { gqm = fmaxf(gqm, fabsf(sgn[i])); gkm = fmaxf(gkm, fabsf(sgn[64 + i])); }
        const float coff = 8.f * gqm * gkm;
        const int cb = w & 3, ksp = w >> 2, ql = 8 * cb + (r32 >> 2), hh = r32 & 3;
        s16x8 qf[4];
        { const bf16* qp = Z + (tokb + qt * 32 + ql) * ZP + 2560 + hh * 64 + 8 * half;
#pragma unroll
          for (int s4 = 0; s4 < 4; ++s4) qf[s4] = *(const s16x8*)(qp + 16 * s4); }
        f32x16 oacc[2];
#pragma unroll
        for (int db = 0; db < 2; ++db)
#pragma unroll
            for (int r = 0; r < 16; ++r) oacc[db][r] = 0.f;
        float lsum = 0.f;
        const int nT = (ntiles + 1) >> 1;
        const int skey = tid >> 3, sseg = tid & 7;
        const float* sgp = ZS + (tokb + skey) * ZSP + sseg * 16;
        f32x4 pr[4];
#pragma unroll
        for (int i = 0; i < 4; ++i) pr[i] = *(const f32x4*)(sgp + 4 * i);
#pragma unroll 1
        for (int tT = 0; tT < nT; ++tT) {
            __syncthreads();
            if (sseg < 4) {
                u32x4 w0, w1; w0.x = pkbf(pr[0][0], pr[0][1]); w0.y = pkbf(pr[0][2], pr[0][3]); w0.z = pkbf(pr[1][0], pr[1][1]); w0.w = pkbf(pr[1][2], pr[1][3]);
                w1.x = pkbf(pr[2][0], pr[2][1]); w1.y = pkbf(pr[2][2], pr[2][3]); w1.z = pkbf(pr[3][0], pr[3][1]); w1.w = pkbf(pr[3][2], pr[3][3]);
                *(LAS u32x4*)(Kd + skey * 72 + sseg * 16) = w0; *(LAS u32x4*)(Kd + skey * 72 + sseg * 16 + 8) = w1;
            } else {
                LAS bf16* vd = VTd + ((sseg - 4) * 16) * 72 + skey;
#pragma unroll
                for (int i = 0; i < 4; ++i) { const unsigned a0 = pkbf(pr[i][0], pr[i][1]), a1 = pkbf(pr[i][2], pr[i][3]);
                    vd[(4 * i) * 72] = (bf16)(a0 & 0xffffu); vd[(4 * i + 1) * 72] = (bf16)(a0 >> 16); vd[(4 * i + 2) * 72] = (bf16)(a1 & 0xffffu); vd[(4 * i + 3) * 72] = (bf16)(a1 >> 16); }
            }
            __syncthreads();
            if (tT + 1 < nT) {
#pragma unroll
                for (int i = 0; i < 4; ++i) pr[i] = *(const f32x4*)(sgp + (size_t)(tT + 1) * 64 * ZSP + 4 * i);
            }
            const int st = 2 * tT + ksp;
            if (st < ntiles) {
                const unsigned mw = maskw[ql * 128 + st];
                f32x16 sacc;
#pragma unroll
                for (int r = 0; r < 16; ++r) sacc[r] = 0.f;
#pragma unroll
                for (int s4 = 0; s4 < 4; ++s4) { const s16x8 ak = *(const LAS s16x8*)(Kd + (32 * ksp + r32) * 72 + 16 * s4 + 8 * half);
                    sacc = __builtin_amdgcn_mfma_f32_32x32x16_bf16(ak, qf[s4], sacc, 0, 0, 0); }
#pragma unroll
                for (int r = 0; r < 16; ++r) { const int kbit = 8 * (r >> 2) + 4 * half + (r & 3); const float pe = ((mw >> kbit) & 1u) ? __expf(sacc[r] - coff) : 0.f; sacc[r] = pe; lsum += pe; }
#pragma unroll
                for (int s2 = 0; s2 < 2; ++s2) {
                    u32x4 wp; wp.x = pkbf(sacc[8 * s2], sacc[8 * s2 + 1]); wp.y = pkbf(sacc[8 * s2 + 2], sacc[8 * s2 + 3]); wp.z = pkbf(sacc[8 * s2 + 4], sacc[8 * s2 + 5]); wp.w = pkbf(sacc[8 * s2 + 6], sacc[8 * s2 + 7]);
                    const s16x8 pf = __builtin_bit_cast(s16x8, wp);
#pragma unroll
                    for (int db = 0; db < 2; ++db) {
                        const LAS bf16* vr = VTd + (db * 32 + r32) * 72 + 32 * ksp + 16 * s2 + 4 * half;
                        const u32x2 v0 = *(const LAS u32x2*)vr, v1 = *(const LAS u32x2*)(vr + 8);
                        const u32x4 vv = (u32x4){v0.x, v0.y, v1.x, v1.y};
                        oacc[db] = __builtin_amdgcn_mfma_f32_32x32x16_bf16(__builtin_bit_cast(s16x8, vv), pf, oacc[db], 0, 0, 0);
                    }
                }
            }
        }
        lsum += __shfl_xor(lsum, 32);
        __syncthreads();
        LAS float* xch = (LAS float*)(lds + 81920) + (w & 3) * (33 * 64);
        if (ksp == 1) {
#pragma unroll
            for (int db = 0; db < 2; ++db)
#pragma unroll
                for (int r = 0; r < 16; ++r) xch[(db * 16 + r) * 64 + lane] = oacc[db][r];
            xch[32 * 64 + lane] = lsum;
        }
        __syncthreads();
        if (ksp == 0) {
            const float is = 1.f / (lsum + xch[32 * 64 + lane]);
            bf16* orow = O3 + (tokb + qt * 32 + ql) * 256 + hh * 64;
#pragma unroll
            for (int db = 0; db < 2; ++db)
#pragma unroll
                for (int g = 0; g < 4; ++g) { const int d0 = db * 32 + 8 * g + 4 * half;
                    const float x0 = (oacc[db][4 * g] + xch[(db * 16 + 4 * g) * 64 + lane]) * is, x1 = (oacc[db][4 * g + 1] + xch[(db * 16 + 4 * g + 1) * 64 + lane]) * is;
                    const float x2 = (oacc[db][4 * g + 2] + xch[(db * 16 + 4 * g + 2) * 64 + lane]) * is, x3 = (oacc[db][4 * g + 3] + xch[(db * 16 + 4 * g + 3) * 64 + lane]) * is;
                    u32x2 wo; wo.x = pkbf(x0, x1); wo.y = pkbf(x2, x3); *(u32x2*)(orow + d0) = wo; }
        }
    }
#undef DSA_SCORES
    __syncthreads();
}

constexpr int Q_ML = 32, Q_DIFF = 512, Q_DSA = 1024, Q_SB = 256, Q_TOTAL = Q_ML + Q_DIFF + Q_DSA + Q_SB;
__device__ __forceinline__ int next_item(unsigned* ctr, LAS int* slot, int wv) {
    __syncthreads();
    if (tid_fresh(wv) == 0) *slot = (int)atomicAdd(ctr, 1u);
    __syncthreads();
    return *slot;
}
__device__ __forceinline__ void mixer_phase1(int l, LAS unsigned char* lds, int wv, int co = 0) {
    LAS int* slot = (LAS int*)(lds + LDS_BYTES - 64);
    { const Params p = load_params(); unsigned* ctr = (unsigned*)(p.ws + WS_CTL) + 64 * (4 * l + 0 + co);
      for (;;) { const int it = next_item(ctr, slot, wv); if (it >= Q_DIFF) break; diffm_item(p, l, it & 31, 15 - (it >> 5), lds, wv); } }
    { const Params p = load_params(); unsigned* ctr = (unsigned*)(p.ws + WS_CTL) + 64 * (4 * l + 1 + co);
      for (;;) { const int it = next_item(ctr, slot, wv); if (it >= 512) break; mlB_item(p, l, it & 31, it >> 5, lds, wv); } }
}
__device__ __forceinline__ void mixer_phase2(int l, LAS unsigned char* lds, int wv, int co = 0) {
    LAS int* slot = (LAS int*)(lds + LDS_BYTES - 64);
    { const Params p = load_params(); unsigned* ctr = (unsigned*)(p.ws + WS_CTL) + 64 * (4 * l + 2 + co);
      for (;;) { const int it = next_item(ctr, slot, wv); if (it >= 32 + Q_DSA) break;
          if (it < 32) mlS_item(p, it, wv); else { const int i = it - 32; dsa_item(p, l, i & 7, 127 - (i >> 3), lds, wv); } } }
}
__device__ __forceinline__ void mixer_phase3(int l, LAS unsigned char* lds, int wv, int co = 0) {
    LAS int* slot = (LAS int*)(lds + LDS_BYTES - 64);
    { const Params p = load_params(); unsigned* ctr = (unsigned*)(p.ws + WS_CTL) + 64 * (4 * l + 3 + co);
      for (;;) { const int it = next_item(ctr, slot, wv); if (it >= 512) break; mlD_item(p, l, it & 31, it >> 5, lds, wv); } }
    { const Params p = load_params(); unsigned* ctr = (unsigned*)(p.ws + WS_CTL) + 64 * (8 + l + co);
      for (;;) { const int it = next_item(ctr, slot, wv); if (it >= Q_SB) break; sb_item(p, l, it >> 3, it & 7, lds, wv); } }
}

#define XB_TMO      128
#define XB_XCNT(j)  (256  + 64 * (j))
#define XB_XSUB(j)  (1280 + 64 * (j))
#define XB_XGEN(j)  (2304 + 64 * (j))
#define XB_TOP      3328
#define XB_TOPGEN   3392
#define XCD_BAR_WORDS 3456
#define XB_SPIN_CAP (1u << 20)
constexpr int CW_BAR = 8192;
__device__ __forceinline__ unsigned xb_ld(unsigned* p)              { return __hip_atomic_load(p, __ATOMIC_RELAXED, __HIP_MEMORY_SCOPE_AGENT); }
__device__ __forceinline__ unsigned xb_add(unsigned* p, unsigned v) { return __hip_atomic_fetch_add(p, v, __ATOMIC_RELAXED, __HIP_MEMORY_SCOPE_AGENT); }
__device__ __forceinline__ unsigned xb_xcc_id() { return (unsigned)__builtin_amdgcn_s_getreg((3 << 11) | 20) & 0xFu; }
#define XB_SPIN(cond, bar) do { unsigned _sp = 0; while (cond) { __builtin_amdgcn_s_sleep(1); \
    if ((++_sp & 255u) == 0u) { if (xb_ld(&(bar)[XB_TMO])) break; if (_sp > XB_SPIN_CAP) { atomicAdd(&(bar)[XB_TMO], 1u); break; } } } } while (0)
__device__ __forceinline__ void xcd_post(int wv) {
    const Params p = load_params(); unsigned* bar = (unsigned*)(p.ws + WS_CTL) + CW_BAR;
    if (tid_fresh(wv) == 0) (void)xb_add(&bar[XB_XCNT(xb_xcc_id())], 1u);
}
__device__ __forceinline__ void xcd_barrier_complete(unsigned* bar, unsigned x, unsigned& nloc, unsigned& nx) {
    const unsigned G = gridDim.x * gridDim.y * gridDim.z;
    unsigned sum, cnt, mine, sp = 0u;
    for (;;) {
        sum = 0u; cnt = 0u; mine = 0u;
#pragma unroll
        for (unsigned j = 0; j < 16; ++j) { const unsigned c = xb_ld(&bar[XB_XCNT(j)]); sum += c; cnt += (c > 0u) ? 1u : 0u; mine = (j == x) ? c : mine; }
        if (sum == G) break;
        __builtin_amdgcn_s_sleep(1);
        if ((++sp & 255u) == 0u) { if (xb_ld(&bar[XB_TMO])) break; if (sp > XB_SPIN_CAP) { atomicAdd(&bar[XB_TMO], 1u); break; } }
    }
    nloc = mine > 0u ? mine : 1u; nx = cnt > 0u ? cnt : 1u;
}
__device__ __forceinline__ void gsync(LAS unsigned char* lds, int wv) {
    asm volatile("s_waitcnt vmcnt(0)" ::: "memory");
    __syncthreads();
    if (tid_fresh(wv) == 0) {
        const Params p = load_params(); unsigned* bar = (unsigned*)(p.ws + WS_CTL) + CW_BAR;
        volatile LAS unsigned* st = (volatile LAS unsigned*)(lds + LDS_BYTES - 32);
        const unsigned x = xb_xcc_id();
        __builtin_amdgcn_s_waitcnt(0);
        unsigned nloc = st[0], nx = st[1];
        if (nloc == 0u) { xcd_barrier_complete(bar, x, nloc, nx); st[0] = nloc; st[1] = nx; }
        const unsigned old = xb_add(&bar[XB_XSUB(x)], 1u);
        const unsigned gen = old / nloc;
        if (old + 1u == (gen + 1u) * nloc) {
            __builtin_amdgcn_fence(__ATOMIC_RELEASE, "agent");
            asm volatile("s_waitcnt vmcnt(0)" ::: "memory");
            const unsigned og = xb_add(&bar[XB_TOP], 1u);
            const unsigned tg = og / nx;
            if (og + 1u == (tg + 1u) * nx) xb_add(&bar[XB_TOPGEN], 1u);
            else XB_SPIN(xb_ld(&bar[XB_TOPGEN]) == tg, bar);
            __builtin_amdgcn_fence(__ATOMIC_ACQUIRE, "agent");
            xb_add(&bar[XB_XGEN(x)], 1u);
            asm volatile("s_waitcnt vmcnt(0)" ::: "memory");
        } else {
            XB_SPIN(xb_ld(&bar[XB_XGEN(x)]) == gen, bar);
            __builtin_amdgcn_fence(__ATOMIC_ACQUIRE, "agent");
            asm volatile("s_waitcnt vmcnt(0)" ::: "memory");
        }
    }
    __syncthreads();
}

#define PH_LOCALS const Params p = load_params(); const int tid = tid_fresh(wv), lane = tid & 63, wave = tid >> 6; const int gw = (int)blockIdx.x * NWAVES + wave, ngw = (int)gridDim.x * NWAVES; \
    (void)lane; (void)gw; (void)ngw; bf16* HN = (bf16*)(p.ws + WS_HN); bf16* BIGB = (bf16*)(p.ws + WS_BIG); (void)HN; (void)BIGB;
template <int l> __device__ __forceinline__ void layer_body(cg::grid_group& grid, LAS unsigned char* lds, const int wv) {
        { PH_LOCALS const unsigned char* wl = p.ws + WS_W + (size_t)l * WL_STRIDE; EpiSwiglu E{l * 3 + 0}; run_gemm(lds, HN, (const bf16*)(wl + WL_GU1), T, 2 * FF, D, E, wv); }
        gsync(lds, wv);
        { PH_LOCALS const unsigned char* wl = p.ws + WS_W + (size_t)l * WL_STRIDE; EpiResid E{l == 0 ? 1 : 0, 0.5f, l * 3 + 1}; run_gemm(lds, BIGB, (const bf16*)(wl + WL_D1), T, D, FF, E, wv); }
        gsync(lds, wv);
        { PH_LOCALS const unsigned char* wl = p.ws + WS_W + (size_t)l * WL_STRIDE; EpiZ E{l * 3 + 1}; run_gemm(lds, HN, (const bf16*)(wl + WL_INA), T, 3328, D, E, wv); }
        gsync(lds, wv);
        { PH_LOCALS if (gw < 32) ml_prepass(p, l, gw, lane); else prep_phase(p, l, gw - 32, ngw - 32, lane); }
        gsync(lds, wv);
        mixer_phase1(l, lds, wv);
#if PROBE_DUP & 1
        gsync(lds, wv); mixer_phase1(l, lds, wv, 16);
#endif
        gsync(lds, wv);
        mixer_phase2(l, lds, wv);
#if PROBE_DUP & 2
        gsync(lds, wv); mixer_phase2(l, lds, wv, 16);
#endif
        gsync(lds, wv);
        mixer_phase3(l, lds, wv);
#if PROBE_DUP & 4
        gsync(lds, wv); mixer_phase3(l, lds, wv, 16);
#endif
        gsync(lds, wv);
#pragma unroll 1
        for (int hb = 0; hb < 2; ++hb) {
            { PH_LOCALS const unsigned char* wl = p.ws + WS_W + (size_t)l * WL_STRIDE; EpiSig E{l * 3 + 1}; run_gemm(lds, HN, (const bf16*)(wl + WL_G) + (size_t)hb * 2 * D * D, T, 2 * D, D, E, wv); }
            gsync(lds, wv);
#pragma unroll 1
            for (int bb = 0; bb < 2; ++bb) {
                PH_LOCALS const unsigned char* wl = p.ws + WS_W + (size_t)l * WL_STRIDE; const int b = hb * 2 + bb;
                EpiGate E{bb * D, b == 0 ? 1 : 0};
                run_gemm(lds, (const bf16*)(p.ws + WS_O + b * OB_STRIDE), (const bf16*)(wl + WL_BR) + (size_t)b * D * 256, T, D, 256, E, wv);
            }
            gsync(lds, wv);
        }
        { PH_LOCALS const unsigned char* wl = p.ws + WS_W + (size_t)l * WL_STRIDE; EpiResid E{0, 1.0f, l * 3 + 2}; run_gemm(lds, (const bf16*)(p.ws + WS_BIG + 128 * MiB), (const bf16*)(wl + WL_OUT), T, D, D, E, wv); }
        gsync(lds, wv);
        { PH_LOCALS const unsigned char* wl = p.ws + WS_W + (size_t)l * WL_STRIDE; EpiSwiglu E{l * 3 + 2}; run_gemm(lds, HN, (const bf16*)(wl + WL_GU2), T, 2 * FF, D, E, wv); }
        gsync(lds, wv);
        { PH_LOCALS const unsigned char* wl = p.ws + WS_W + (size_t)l * WL_STRIDE; EpiResid E{0, 0.5f, (l + 1 < DEPTH) ? (l + 1) * 3 : -1}; run_gemm(lds, BIGB, (const bf16*)(wl + WL_D2), T, D, FF, E, wv); }
        if (l + 1 < DEPTH) gsync(lds, wv);
    }

__global__ void __launch_bounds__(NTHR, 2) hybrid_fwd(Params p_unused) {
    extern __shared__ __attribute__((aligned(16))) unsigned char lds_raw[];
    LAS unsigned char* lds = (LAS unsigned char*)lds_raw;
    cg::grid_group grid = cg::this_grid();
    const int wv = __builtin_amdgcn_readfirstlane((int)threadIdx.x >> 6);
    {
        PH_LOCALS
        SegRun R; R.base = 0; R.gw = gw; R.ngw = ngw; R.lane = lane; R.scr = (LAS float*)(lds + wave * 8704);
        for (int l = 0; l < DEPTH; ++l) convert_weights(p, l, R);
        if (blockIdx.x == 0 && tid < 64) ((unsigned*)(p.ws + WS_CTL))[64 * tid] = 0u;
        if (blockIdx.x == 0) for (int i = tid; i < XCD_BAR_WORDS; i += NTHR) ((unsigned*)(p.ws + WS_CTL))[CW_BAR + i] = 0u;
        if (tid < 8) ((LAS unsigned*)(lds + LDS_BYTES - 32))[tid] = 0u;
        for (int i = gw * 64 + lane; i < 5 * T; i += ngw * 64) { const int a_ = 1 + i / T; rs_ptr(p, a_)[i % T] = 0ull; }
        xb_rows(p.x, HN, rs_ptr(p, 0), gw, ngw, lane);
    }
    grid.sync();
    xcd_post(wv);
    layer_body<0>(grid, lds, wv);
    layer_body<1>(grid, lds, wv);
}

extern "C" void kernel_launch(void* const* d_in, const int* in_sizes, int n_in, void* d_out, int out_size, void* d_ws, size_t ws_size, hipStream_t stream) {
    static int grid = 0;
    if (grid == 0) {
        if (n_in != 20 || out_size != T * D || ws_size < WS_END2) { fprintf(stderr, "kernel_launch: unexpected shapes (n_in %d out %d ws %zu)\n", n_in, out_size, ws_size); grid = -1; return; }
        int dev = 0, cus = 0, per_cu = 0;
        hipGetDevice(&dev); hipDeviceGetAttribute(&cus, hipDeviceAttributeMultiprocessorCount, dev);
        hipFuncSetAttribute((const void*)hybrid_fwd, hipFuncAttributeMaxDynamicSharedMemorySize, LDS_BYTES);
        hipOccupancyMaxActiveBlocksPerMultiprocessor(&per_cu, (const void*)hybrid_fwd, NTHR, LDS_BYTES);
        if (per_cu < 1) { fprintf(stderr, "kernel_launch: occupancy query says %d\n", per_cu); per_cu = 1; }
        (void)hipGetLastError();
        grid = cus * 1;
    }
    if (grid < 0) return;
    Params p{};
    p.x = (const float*)d_in[0]; p.pos = (const int*)d_in[1];
    p.ffn1_norm = (const float*)d_in[2]; p.ffn1_gu = (const float*)d_in[3]; p.ffn1_down = (const float*)d_in[4]; p.mix_norm = (const float*)d_in[5]; p.w_in = (const float*)d_in[6];
    p.diff_qk_norm = (const float*)d_in[7]; p.diff_lambda = (const float*)d_in[8]; p.diff_head_norm = (const float*)d_in[9]; p.ml_conv_w = (const float*)d_in[10]; p.ml_conv_b = (const float*)d_in[11];
    p.ml_gate_bias = (const float*)d_in[12]; p.ml_head_norm = (const float*)d_in[13]; p.dsa_qk_norm = (const float*)d_in[14]; p.w_branch = (const float*)d_in[15]; p.w_out = (const float*)d_in[16];
    p.ffn2_norm = (const float*)d_in[17]; p.ffn2_gu = (const float*)d_in[18]; p.ffn2_down = (const float*)d_in[19];
    p.out = (float*)d_out; p.ws = (unsigned char*)d_ws;
    void* args[] = {&p};
    hipError_t e = hipLaunchCooperativeKernel((const void*)hybrid_fwd, dim3(grid), dim3(NTHR), args, LDS_BYTES, stream);
    if (e != hipSuccess) fprintf(stderr, "cooperative launch failed: %s (grid %d)\n", hipGetErrorString(e), grid);
}
```
